# Optimizing an MI355X kernel written in HIP

```python
import jax, jax.numpy as jnp
from jax import lax
import numpy as np

D_MODEL = 1024
BATCH = 16
SEQ = 2048
DEPTH = 2
DEC_BATCH = 32
DEC_SEQ = 64
PAST_LEN = 4096

CHUNK = 64
N_EVEN = (DEPTH + 1) // 2
N_ODD = DEPTH // 2
EPS = 1e-6
A_HEADS = 16
A_KV_HEADS = 4
A_HEAD_DIM = 64
A_GROUP = A_HEADS // A_KV_HEADS
A_WIDTH = A_HEADS * A_HEAD_DIM
WINDOW = 128
WIN_CHUNKS = -(-WINDOW // CHUNK)
WIN_ROWS = WIN_CHUNKS * CHUNK
B_HEADS = 4
B_DK = 128
B_DV = 256
B_WIDTH = B_HEADS * B_DV
B_LOWRANK = 16
B_GATE_NORM = 16.0
C_WIDTH = 1536
C_BLOCKS = 8
C_BLOCK = C_WIDTH // C_BLOCKS
CONV_W = 4
LRU_C = 8.0
MIX_EVEN = A_WIDTH + B_WIDTH
SPLIT_EVEN = (A_WIDTH, A_KV_HEADS * A_HEAD_DIM, A_KV_HEADS * A_HEAD_DIM,
              B_HEADS * B_DK, B_HEADS * B_DK, B_WIDTH, B_LOWRANK, MIX_EVEN)
IN_EVEN = sum(SPLIT_EVEN)
IN_ODD = 2 * C_WIDTH

kernel_name = "hybrid_swa_gla_rglru_stream_step"


def _rmsnorm(x, g):
    xf = x.astype(jnp.float32)
    y = xf * lax.rsqrt(jnp.mean(xf * xf, axis=-1, keepdims=True) + EPS) * g.astype(jnp.float32)
    return y.astype(x.dtype)


def _split(z, sizes):
    offs = [int(o) for o in np.cumsum(sizes)[:-1]]
    return jnp.split(z, offs, axis=-1)


def _alibi_slopes():
    return 2.0 ** (-8.0 * jnp.arange(1, A_HEADS + 1, dtype=jnp.float32) / A_HEADS)


def _band(t):
    b, tl = t.shape[:2]
    nc = tl // CHUNK
    tp = jnp.pad(t, ((0, 0), (WIN_ROWS, 0), (0, 0), (0, 0)))
    tp = tp.reshape(b, nc + WIN_CHUNKS, CHUNK, t.shape[2], t.shape[3])
    return jnp.concatenate([tp[:, w:w + nc] for w in range(WIN_CHUNKS + 1)], axis=2)


def _sink_alibi_attention(qb, kb, vb, key_ok, sinks):
    lq, lk = qb.shape[2], kb.shape[2]
    s = jnp.einsum('bnikgd,bnjkd->bnkgij', qb, kb).astype(jnp.float32) * (A_HEAD_DIM ** -0.5)
    dist = jnp.abs(WIN_ROWS + jnp.arange(lq)[:, None] - jnp.arange(lk)[None, :]).astype(jnp.float32)
    slopes = _alibi_slopes().reshape(A_KV_HEADS, A_GROUP)
    s = s - slopes[:, :, None, None] * dist
    s = jnp.where(key_ok[None, :, None, None, None, :], s, jnp.float32(-1e30))
    sk = jnp.broadcast_to(sinks.astype(jnp.float32).reshape(A_KV_HEADS, A_GROUP)[:, :, None, None],
                          s.shape[:-1] + (1,))
    p = jax.nn.softmax(jnp.concatenate([s, sk], axis=-1), axis=-1)[..., :-1]
    o = jnp.einsum('bnkgij,bnjkd->bnikgd', p.astype(vb.dtype), vb)
    return o


def _gla(q, k, v, g, s0, blk):
    b, tl, h, dk = q.shape
    dv = v.shape[-1]
    n = tl // blk
    q = q.astype(jnp.float32).reshape(b, n, blk, h, dk)
    k = k.astype(jnp.float32).reshape(b, n, blk, h, dk)
    v = v.astype(jnp.float32).reshape(b, n, blk, h, dv)
    G = jnp.cumsum(g.reshape(b, n, blk, h, dk), axis=2)
    g_last = G[:, :, -1]
    qg = q * jnp.exp(G)
    kg = k * jnp.exp(-G)
    a = jnp.einsum('bnihd,bnjhd->bnhij', qg, kg)
    a = jnp.where(jnp.tril(jnp.ones((blk, blk), bool)), a, 0.0)
    o = jnp.einsum('bnhij,bnjhe->bnihe', a, v)
    kd = k * jnp.exp(g_last[:, :, None] - G)
    ds = jnp.einsum('bnjhd,bnjhe->bnhde', kd, v)

    def step(S, inp):
        dec, d = inp
        return jnp.exp(dec)[..., None] * S + d, S

    s_fin, s_in = lax.scan(step, s0, (jnp.moveaxis(g_last, 1, 0), jnp.moveaxis(ds, 1, 0)))
    o = o + jnp.einsum('bnihd,bnhde->bnihe', qg, jnp.moveaxis(s_in, 0, 1))
    return o.reshape(b, tl, h, dv), s_fin


def _even_layer(x, past, norm_g, w_in, w_lr, b_lr, sinks, gla_g, w_out):
    b, tl, _ = x.shape
    h = _rmsnorm(x, norm_g)
    z = h @ w_in
    aq, ak, av, bq, bk, bv, blr, gate = _split(z, SPLIT_EVEN)
    aq = aq.reshape(b, tl, A_KV_HEADS, A_GROUP, A_HEAD_DIM)
    ak = ak.reshape(b, tl, A_KV_HEADS, A_HEAD_DIM)
    av = av.reshape(b, tl, A_KV_HEADS, A_HEAD_DIM)
    if past is None:
        nc = tl // CHUNK
        qb = aq.reshape(b, nc, CHUNK, A_KV_HEADS, A_GROUP, A_HEAD_DIM)
        kb, vb = _band(ak), _band(av)
        key_pos = (jnp.arange(nc)[:, None] - WIN_CHUNKS) * CHUNK + jnp.arange(WIN_ROWS + CHUNK)[None, :]
        key_ok = key_pos >= 0
        new_k, new_v = ak[:, -WIN_ROWS:], av[:, -WIN_ROWS:]
        s0 = jnp.zeros((b, B_HEADS, B_DK, B_DV), jnp.float32)
        blk = CHUNK
    else:
        ck, cv, s0 = past
        qb = aq[:, None]
        kb = jnp.concatenate([ck.astype(ak.dtype), ak], axis=1)[:, None]
        vb = jnp.concatenate([cv.astype(av.dtype), av], axis=1)[:, None]
        key_ok = jnp.ones((1, WIN_ROWS + tl), bool)
        new_k, new_v = ak, av
        blk = tl
    ao = _sink_alibi_attention(qb, kb, vb, key_ok, sinks).reshape(b, tl, A_WIDTH)
    glog = jax.nn.log_sigmoid((blr @ w_lr + b_lr).astype(jnp.float32)) / B_GATE_NORM
    bo, s_new = _gla(bq.reshape(b, tl, B_HEADS, B_DK) * (B_DK ** -0.5),
                     bk.reshape(b, tl, B_HEADS, B_DK),
                     bv.reshape(b, tl, B_HEADS, B_DV),
                     glog.reshape(b, tl, B_HEADS, B_DK),
                     s0.astype(jnp.float32), blk)
    bo = _rmsnorm(bo, gla_g).reshape(b, tl, B_WIDTH).astype(x.dtype)
    y = jnp.concatenate([ao.astype(x.dtype), bo], axis=-1) * jax.nn.silu(gate)
    return x + y @ w_out, new_k, new_v, s_new


def _blockdiag(u, w, bias):
    b, tl = u.shape[:2]
    y = jnp.einsum('btnc,ncd->btnd', u.reshape(b, tl, C_BLOCKS, C_BLOCK), w)
    return y.reshape(b, tl, C_WIDTH) + bias


def _lin_comb(l, r):
    a1, b1 = l
    a2, b2 = r
    return a1 * a2, a2 * b1 + b2


def _odd_layer(x, hist, h0, norm_g, w_in, conv_w, conv_b, w_ra, b_ra, w_ri, b_ri, lam, w_out):
    b, tl, _ = x.shape
    h = _rmsnorm(x, norm_g)
    xb, gate = _split(h @ w_in, (C_WIDTH, C_WIDTH))
    xp = jnp.concatenate([hist.astype(xb.dtype), xb], axis=1)
    u = sum(xp[:, j:j + tl] * conv_w[j] for j in range(CONV_W)) + conv_b
    new_conv = xp[:, -(CONV_W - 1):]
    rg = jax.nn.sigmoid(_blockdiag(u, w_ra, b_ra).astype(jnp.float32))
    ig = jax.nn.sigmoid(_blockdiag(u, w_ri, b_ri).astype(jnp.float32))
    log_a = -LRU_C * rg * jax.nn.softplus(-lam.astype(jnp.float32))
    a = jnp.exp(log_a)
    bterm = jnp.sqrt(-jnp.expm1(2.0 * log_a)) * ig * u.astype(jnp.float32)
    bterm = bterm.at[:, 0].add(a[:, 0] * h0.astype(jnp.float32))
    _, hs = lax.associative_scan(_lin_comb, (a, bterm), axis=1)
    y = hs.astype(x.dtype) * jax.nn.silu(gate)
    return x + y @ w_out, new_conv, hs[:, -1]


def setup_inputs(seed: int = 0) -> dict:
    key = jax.random.key(seed)
    ks = jax.random.split(key, 32)
    f32 = jnp.float32
    nrm = lambda k, s, sc: jax.random.normal(k, s, f32) * sc
    u = jax.random.uniform(ks[26], (N_ODD, C_WIDTH), f32, 0.9, 0.999) ** (1.0 / LRU_C)
    return {
        "x_prompt": nrm(ks[0], (BATCH, SEQ, D_MODEL), 1.0),
        "x_sample": nrm(ks[1], (DEC_BATCH, DEC_SEQ, D_MODEL), 1.0),
        "cache_swa_k": nrm(ks[2], (N_EVEN, DEC_BATCH, WIN_ROWS, A_KV_HEADS, A_HEAD_DIM), 1.0),
        "cache_swa_v": nrm(ks[3], (N_EVEN, DEC_BATCH, WIN_ROWS, A_KV_HEADS, A_HEAD_DIM), 1.0),
        "state_gla": nrm(ks[4], (N_EVEN, DEC_BATCH, B_HEADS, B_DK, B_DV), 1.0),
        "cache_conv": nrm(ks[5], (N_ODD, DEC_BATCH, CONV_W - 1, C_WIDTH), 1.0),
        "state_lru": nrm(ks[6], (N_ODD, DEC_BATCH, C_WIDTH), 1.0),
        "norm_even": 1.0 + nrm(ks[7], (N_EVEN, D_MODEL), 0.02),
        "w_in_even": nrm(ks[8], (N_EVEN, D_MODEL, IN_EVEN), D_MODEL ** -0.5),
        "w_gate_lr": nrm(ks[9], (N_EVEN, B_LOWRANK, B_HEADS * B_DK), B_LOWRANK ** -0.5),
        "b_gate_lr": nrm(ks[10], (N_EVEN, B_HEADS * B_DK), 0.1),
        "sinks": nrm(ks[11], (N_EVEN, A_HEADS), 0.5),
        "gla_norm": 1.0 + nrm(ks[12], (N_EVEN, B_DV), 0.02),
        "w_out_even": nrm(ks[13], (N_EVEN, MIX_EVEN, D_MODEL), MIX_EVEN ** -0.5),
        "norm_odd": 1.0 + nrm(ks[14], (N_ODD, D_MODEL), 0.02),
        "w_in_odd": nrm(ks[15], (N_ODD, D_MODEL, IN_ODD), D_MODEL ** -0.5),
        "conv_w": nrm(ks[16], (N_ODD, CONV_W, C_WIDTH), CONV_W ** -0.5),
        "conv_b": nrm(ks[17], (N_ODD, C_WIDTH), 0.02),
        "w_rg_a": nrm(ks[18], (N_ODD, C_BLOCKS, C_BLOCK, C_BLOCK), C_BLOCK ** -0.5),
        "b_rg_a": nrm(ks[19], (N_ODD, C_WIDTH), 0.02),
        "w_rg_i": nrm(ks[20], (N_ODD, C_BLOCKS, C_BLOCK, C_BLOCK), C_BLOCK ** -0.5),
        "b_rg_i": nrm(ks[21], (N_ODD, C_WIDTH), 0.02),
        "lru_lambda": jnp.log(u / (1.0 - u)),
        "w_out_odd": nrm(ks[22], (N_ODD, C_WIDTH, D_MODEL), C_WIDTH ** -0.5),
        "norm_final": 1.0 + nrm(ks[23], (D_MODEL,), 0.02),
    }


def reference(x_prompt, x_sample, cache_swa_k, cache_swa_v, state_gla, cache_conv, state_lru,
              norm_even, w_in_even, w_gate_lr, b_gate_lr, sinks, gla_norm, w_out_even,
              norm_odd, w_in_odd, conv_w, conv_b, w_rg_a, b_rg_a, w_rg_i, b_rg_i, lru_lambda,
              w_out_odd, norm_final):
    xp, xs = x_prompt, x_sample
    pk, pv, pg, pc, pl = [], [], [], [], []
    sk, sv, sg, sc, sl = [], [], [], [], []
    for layer in range(DEPTH):
        if layer % 2 == 0:
            e = layer // 2
            wts = (norm_even[e], w_in_even[e], w_gate_lr[e], b_gate_lr[e], sinks[e], gla_norm[e], w_out_even[e])
            xp, k_, v_, s_ = _even_layer(xp, None, *wts)
            pk.append(k_); pv.append(v_); pg.append(s_)
            xs, k_, v_, s_ = _even_layer(xs, (cache_swa_k[e], cache_swa_v[e], state_gla[e]), *wts)
            sk.append(k_); sv.append(v_); sg.append(s_)
        else:
            o = layer // 2
            wts = (norm_odd[o], w_in_odd[o], conv_w[o], conv_b[o], w_rg_a[o], b_rg_a[o],
                   w_rg_i[o], b_rg_i[o], lru_lambda[o], w_out_odd[o])
            hist0 = jnp.zeros((xp.shape[0], CONV_W - 1, C_WIDTH), xp.dtype)
            h00 = jnp.zeros((xp.shape[0], C_WIDTH), jnp.float32)
            xp, c_, l_ = _odd_layer(xp, hist0, h00, *wts)
            pc.append(c_); pl.append(l_)
            xs, c_, l_ = _odd_layer(xs, cache_conv[o], state_lru[o], *wts)
            sc.append(c_); sl.append(l_)
    y_prompt = _rmsnorm(xp, norm_final)
    y_sample = _rmsnorm(xs, norm_final)
    new_swa_k_prompt = jnp.stack(pk)
    new_swa_v_prompt = jnp.stack(pv)
    new_gla_prompt = jnp.stack(pg)
    new_conv_prompt = jnp.stack(pc)
    new_lru_prompt = jnp.stack(pl)
    new_swa_k_sample = jnp.stack(sk)
    new_swa_v_sample = jnp.stack(sv)
    new_gla_sample = jnp.stack(sg)
    new_conv_sample = jnp.stack(sc)
    new_lru_sample = jnp.stack(sl)
    return (y_prompt, y_sample, new_swa_k_prompt, new_swa_v_prompt, new_gla_prompt, new_conv_prompt,
            new_lru_prompt, new_swa_k_sample, new_swa_v_sample, new_gla_sample, new_conv_sample,
            new_lru_sample)
```

```cpp
#include <hip/hip_runtime.h>
#include <hip/hip_cooperative_groups.h>
#include <cstdio>
namespace cg = cooperative_groups;

#ifndef ONE_LAUNCH
#define ONE_LAUNCH 0
#endif

#define LAS __attribute__((address_space(3)))
typedef unsigned short bf16_t;
typedef short bf16x8 __attribute__((ext_vector_type(8)));
typedef short bf16x4 __attribute__((ext_vector_type(4)));
typedef float f32x4 __attribute__((ext_vector_type(4)));
typedef unsigned u32x4 __attribute__((ext_vector_type(4)));
typedef unsigned u32x2 __attribute__((ext_vector_type(2)));

constexpr int T_P = 32768, T_S = 2048, T = T_P + T_S, DM = 1024;
constexpr int NE_PAD = 5888;
constexpr int LDS_BYTES = 155648;
constexpr int NTHR = 512;
constexpr float EPS = 1e-6f;

constexpr size_t WS_WINE = 0;
constexpr size_t WS_WOUTE = WS_WINE + (size_t)NE_PAD * 1024 * 2;
constexpr size_t WS_WINO = WS_WOUTE + (size_t)1024 * 2048 * 2;
constexpr size_t WS_WOUTO = WS_WINO + (size_t)3072 * 1024 * 2;
constexpr size_t WS_WA = WS_WOUTO + (size_t)1024 * 1536 * 2;
constexpr size_t WS_WI = WS_WA + (size_t)8 * 192 * 192 * 2;
constexpr size_t WS_XB = WS_WI + (size_t)8 * 192 * 192 * 2;
constexpr size_t WS_RSTD0 = WS_XB + (size_t)T * 1024 * 2;
constexpr size_t WS_RSQ1 = WS_RSTD0 + (size_t)T * 4;
constexpr size_t WS_RSQ2 = WS_RSQ1 + (size_t)T * 4;
constexpr size_t WS_BOSQ = WS_RSQ2 + (size_t)T * 4;
constexpr size_t WS_Q = WS_BOSQ + (size_t)T * 16;
constexpr size_t WS_K = WS_Q + (size_t)T * 1024 * 2;
constexpr size_t WS_V = WS_K + (size_t)T * 256 * 2;
constexpr size_t WS_BQ = WS_V + (size_t)T * 256 * 2;
constexpr size_t WS_BK = WS_BQ + (size_t)T * 512 * 2;
constexpr size_t WS_BV = WS_BK + (size_t)T * 512 * 2;
constexpr size_t WS_GATE = WS_BV + (size_t)T * 1024 * 2;
constexpr size_t WS_BLR = WS_GATE + (size_t)T * 2048 * 2;
constexpr size_t WS_END = WS_BLR + (size_t)T * 16 * 4;
constexpr size_t WS_Z2 = WS_Q;
constexpr size_t WS_Y2 = WS_GATE;
static_assert(WS_Z2 + (size_t)T * 3072 * 2 <= WS_GATE, "Z2 alias");

constexpr size_t O_Y = 0;
constexpr size_t O_KP = (size_t)T * 1024;
constexpr size_t O_VP = O_KP + 524288;
constexpr size_t O_GP = O_VP + 524288;
constexpr size_t O_CP = O_GP + 2097152;
constexpr size_t O_LP = O_CP + 73728;
constexpr size_t O_KS = O_LP + 24576;
constexpr size_t O_VS = O_KS + 524288;
constexpr size_t O_GS = O_VS + 524288;
constexpr size_t O_CS = O_GS + 4194304;
constexpr size_t O_LS = O_CS + 147456;
constexpr size_t O_END = O_LS + 49152;

struct Params {
    const float* in[25];
    float* out;
    unsigned char* ws;
    int ph_lo, ph_hi;
};

__device__ __forceinline__ unsigned cvt_pk_bf16(float lo, float hi) { unsigned r; asm volatile("v_cvt_pk_bf16_f32 %0, %1, %2" : "=v"(r) : "v"(lo), "v"(hi)); return r; }
__device__ __forceinline__ bf16_t f2bf(float f) { return (bf16_t)(cvt_pk_bf16(f, 0.f) & 0xffffu); }
__device__ __forceinline__ float bf2f(bf16_t b) { return __uint_as_float(((unsigned)b) << 16); }
__device__ __forceinline__ float bflo(unsigned w) { return __uint_as_float(w << 16); }
__device__ __forceinline__ float bfhi(unsigned w) { return __uint_as_float(w & 0xffff0000u); }
__device__ __forceinline__ float siluf(float x) { return x / (1.f + __expf(-x)); }
__device__ __forceinline__ float sigmf(float x) { return 1.f / (1.f + __expf(-x)); }
__device__ __forceinline__ bf16x8 pack8(const f32x4& a, const f32x4& b) {
    u32x4 p; p.x = cvt_pk_bf16(a[0], a[1]); p.y = cvt_pk_bf16(a[2], a[3]); p.z = cvt_pk_bf16(b[0], b[1]); p.w = cvt_pk_bf16(b[2], b[3]);
    return __builtin_bit_cast(bf16x8, p);
}
__device__ __forceinline__ bf16x8 cat4(const bf16x4 a, const bf16x4 b) { bf16x8 r; r[0] = a[0]; r[1] = a[1]; r[2] = a[2]; r[3] = a[3]; r[4] = b[0]; r[5] = b[1]; r[6] = b[2]; r[7] = b[3]; return r; }
#define MFMA16(a, b, c) __builtin_amdgcn_mfma_f32_16x16x32_bf16((a), (b), (c), 0, 0, 0)

namespace pg8 {
constexpr int BM = 256, BK = 64, HALF = 128, HTB = HALF * BK * 2, STAGE_BYTES = 8 * HTB, NXCD = 8, WGM = 8;
__device__ __forceinline__ int lds_byte(int r, int c) { const int st = (r >> 4) * 2 + (c >> 5), rr = r & 15, cc = c & 31, ob = rr * 64 + cc * 2; return st * 1024 + (ob ^ (((ob >> 9) & 1) << 5)); }
__device__ __forceinline__ void stage_rc(int b, int& R, int& C) { const int st = b / 1024, sb = b % 1024, swz = sb ^ (((sb >> 9) & 1) << 5); R = (st >> 1) * 16 + swz / 64; C = (st & 1) * 32 + (swz % 64) / 2; }
struct Unit { int pm, pn; };
struct Gemm { const bf16_t* A; const bf16_t* Bt; int M, N, K; };
struct StaticOrder {
    int nM, nN, nwg, G, c;
    __device__ void init(int M, int N, int G_, int c_) { nM = M / BM; nN = N / BM; nwg = nM * nN; G = G_; c = c_; }
    __device__ __forceinline__ bool next(int i, Unit& u) const {
        const long Lx = (long)i * G + c; if (Lx >= nwg) return false;
        int wgid = (int)Lx; { const int q = nwg / NXCD, r = nwg % NXCD, xcd = wgid % NXCD, off = wgid / NXCD; wgid = (xcd < r ? xcd * (q + 1) : r * (q + 1) + (xcd - r) * q) + off; }
        const int nig = WGM * nN, gid = wgid / nig, fm = gid * WGM, gsz = (nM - fm) < WGM ? (nM - fm) : WGM;
        u.pm = fm + ((wgid % nig) % gsz); u.pn = (wgid % nig) / gsz; return true;
    }
};

template <class Epi>
__device__ __forceinline__ void gemm_phase(LAS unsigned char* lds, const Gemm g, const StaticOrder& S, const Epi& E) {
    const int tid = threadIdx.x, wid = __builtin_amdgcn_readfirstlane(tid >> 6), lane = tid & 63, wr = wid >> 2, wc = wid & 3, fr = lane & 15, fq = lane >> 4;
    const int K = g.K, nt = K / BK;
    unsigned voffA[2];
#pragma unroll
    for (int i = 0; i < 2; ++i) { int R, C; stage_rc(tid * 16 + i * 8192, R, C); voffA[i] = (unsigned)(R * K + C) * 2u; }
    const size_t kstep = (size_t)(BK * 2);
    const size_t hstep = (size_t)HALF * K * 2;
    const size_t tstep = 2 * hstep;
    const unsigned ldsw = (unsigned)wid * 1024u;
    const int aoff = lds_byte(wr * 64 + fr, fq * 8), boff = lds_byte(wc * 32 + fr, fq * 8);
#define PG8_SA(b, h) (((b) * 2 + (h)) * HTB)
#define PG8_SB(b, h) ((4 + (b) * 2 + (h)) * HTB)
#define PG8_STAGE(bufoff, gbase, voff) do { _Pragma("unroll") for (int _i = 0; _i < 2; ++_i) \
        __builtin_amdgcn_global_load_lds((const unsigned*)((const char*)(gbase) + (voff)[_i]), (LAS unsigned*)(lds + (bufoff) + ldsw + _i * 8192), 16, 0, 0); } while (0)
#define PG8_LDA(dst, b, h) do { _Pragma("unroll") for (int m = 0; m < 4; ++m) _Pragma("unroll") for (int k = 0; k < 2; ++k) dst[m][k] = *(const LAS bf16x8*)(lds + PG8_SA(b, h) + aoff + m * 2048 + k * 1024); } while (0)
#define PG8_LDB(dst, b, h) do { _Pragma("unroll") for (int n = 0; n < 2; ++n) _Pragma("unroll") for (int k = 0; k < 2; ++k) dst[n][k] = *(const LAS bf16x8*)(lds + PG8_SB(b, h) + boff + n * 2048 + k * 1024); } while (0)
#define PG8_MMA(ai, bj, At, Bt) do { __builtin_amdgcn_s_setprio(1); _Pragma("unroll") for (int m = 0; m < 4; ++m) _Pragma("unroll") for (int n = 0; n < 2; ++n) _Pragma("unroll") for (int k = 0; k < 2; ++k) \
        acc[ai][bj][m][n] = __builtin_amdgcn_mfma_f32_16x16x32_bf16(Bt[n][k], At[m][k], acc[ai][bj][m][n], 0, 0, 0); __builtin_amdgcn_s_setprio(0); } while (0)
#define PG8_WAIT_V(n) asm volatile("s_waitcnt vmcnt(" #n ")" ::: "memory")
#define PG8_WAIT_L(n) asm volatile("s_waitcnt lgkmcnt(" #n ")" ::: "memory")
#define PG8_BAR __builtin_amdgcn_s_barrier()
#define PG8_SCHED __builtin_amdgcn_sched_barrier(0)
    Unit cur, nxt; int ui = 0;
    if (!S.next(0, cur)) return;
    f32x4 acc[2][2][4][2];
#pragma unroll
    for (int a = 0; a < 2; ++a)
#pragma unroll
        for (int b = 0; b < 2; ++b)
#pragma unroll
            for (int m = 0; m < 4; ++m)
#pragma unroll
                for (int n = 0; n < 2; ++n) acc[a][b][m][n] = (f32x4){0.f, 0.f, 0.f, 0.f};
    bf16x8 At[4][2], B0[2][2], B1[2][2];
    const char* cA = (const char*)g.A + (size_t)cur.pm * tstep; const char* cB = (const char*)g.Bt + (size_t)cur.pn * tstep;
    PG8_STAGE(PG8_SB(0, 0), cB, voffA); PG8_STAGE(PG8_SA(0, 0), cA, voffA); PG8_STAGE(PG8_SB(0, 1), cB + hstep, voffA); PG8_STAGE(PG8_SA(0, 1), cA + hstep, voffA);
    if (wr == 1) PG8_BAR;
    PG8_WAIT_V(4); PG8_BAR;
    PG8_STAGE(PG8_SB(1, 0), cB + kstep, voffA); PG8_STAGE(PG8_SA(1, 0), cA + kstep, voffA); PG8_STAGE(PG8_SB(1, 1), cB + hstep + kstep, voffA);
    PG8_WAIT_V(6); PG8_BAR;
    for (;;) {
        const bool has_next = S.next(ui + 1, nxt);
        const char* nA = has_next ? (const char*)g.A + (size_t)nxt.pm * tstep : cA; const char* nB = has_next ? (const char*)g.Bt + (size_t)nxt.pn * tstep : cB;
        for (int t = 0; t < nt; t += 2) {
            const bool last = (t == nt - 2);
            const char* a1 = cA + (size_t)(t + 1) * kstep;
            const char* a2 = last ? nA : cA + (size_t)(t + 2) * kstep; const char* b2 = last ? nB : cB + (size_t)(t + 2) * kstep;
            const char* a3 = a2 + kstep; const char* b3 = b2 + kstep;
            PG8_LDB(B0, 0, 0); PG8_SCHED; PG8_LDA(At, 0, 0); PG8_STAGE(PG8_SA(1, 1), a1 + hstep, voffA);
            PG8_WAIT_L(8); PG8_BAR; PG8_WAIT_L(0); PG8_MMA(0, 0, At, B0); PG8_BAR; PG8_SCHED;
            PG8_LDB(B1, 0, 1); PG8_STAGE(PG8_SB(0, 0), b2, voffA);
            PG8_BAR; PG8_WAIT_L(0); PG8_MMA(0, 1, At, B1); PG8_BAR;
            PG8_LDA(At, 0, 1); PG8_STAGE(PG8_SA(0, 0), a2, voffA);
            PG8_BAR; PG8_WAIT_L(0); PG8_MMA(1, 0, At, B0); PG8_BAR; PG8_SCHED;
            PG8_STAGE(PG8_SB(0, 1), b2 + hstep, voffA);
            PG8_WAIT_V(6); PG8_BAR; PG8_MMA(1, 1, At, B1); PG8_BAR;
            PG8_LDB(B0, 1, 0); PG8_SCHED; PG8_LDA(At, 1, 0); PG8_STAGE(PG8_SA(0, 1), a2 + hstep, voffA);
            PG8_WAIT_L(8); PG8_BAR; PG8_WAIT_L(0); PG8_MMA(0, 0, At, B0); PG8_BAR; PG8_SCHED;
            PG8_LDB(B1, 1, 1); PG8_STAGE(PG8_SB(1, 0), b3, voffA);
            PG8_BAR; PG8_WAIT_L(0); PG8_MMA(0, 1, At, B1); PG8_BAR;
            PG8_LDA(At, 1, 1); PG8_STAGE(PG8_SA(1, 0), a3, voffA);
            PG8_BAR; PG8_WAIT_L(0); PG8_MMA(1, 0, At, B0); PG8_BAR; PG8_SCHED;
            PG8_STAGE(PG8_SB(1, 1), b3 + hstep, voffA);
            PG8_WAIT_V(6); PG8_BAR; PG8_MMA(1, 1, At, B1); PG8_BAR;
        }
        E(acc, cur, wr, wc, fr, fq);
        if (!has_next) break;
#pragma unroll
        for (int a = 0; a < 2; ++a)
#pragma unroll
            for (int b = 0; b < 2; ++b)
#pragma unroll
                for (int m = 0; m < 4; ++m)
#pragma unroll
                    for (int n = 0; n < 2; ++n) acc[a][b][m][n] = (f32x4){0.f, 0.f, 0.f, 0.f};
        cur = nxt; cA = nA; cB = nB; ++ui;
    }
    PG8_WAIT_V(0);
    if (wr == 0) PG8_BAR;
    PG8_BAR;
#undef PG8_SA
#undef PG8_SB
#undef PG8_STAGE
#undef PG8_LDA
#undef PG8_LDB
#undef PG8_MMA
#undef PG8_WAIT_V
#undef PG8_WAIT_L
#undef PG8_BAR
#undef PG8_SCHED
}
}

typedef f32x4 AccT[2][2][4][2];

struct EpiInEven {
    unsigned char* ws; float* out; const float* rstd;
    __device__ __forceinline__ void operator()(const AccT& acc, const pg8::Unit& u, int wr, int wc, int fr, int fq) const {
        const int pn = u.pn;
        bf16_t* base; int ld, coff; float sc = 1.f;
        if (pn < 4) { base = (bf16_t*)(ws + WS_Q); ld = 1024; coff = pn * 256; sc = 0.125f; }
        else if (pn == 4) { base = (bf16_t*)(ws + WS_K); ld = 256; coff = 0; }
        else if (pn == 5) { base = (bf16_t*)(ws + WS_V); ld = 256; coff = 0; }
        else if (pn < 8) { base = (bf16_t*)(ws + WS_BQ); ld = 512; coff = (pn - 6) * 256; sc = 0.08838834764831845f; }
        else if (pn < 10) { base = (bf16_t*)(ws + WS_BK); ld = 512; coff = (pn - 8) * 256; }
        else if (pn < 14) { base = (bf16_t*)(ws + WS_BV); ld = 1024; coff = (pn - 10) * 256; }
        else if (pn < 22) { base = (bf16_t*)(ws + WS_GATE); ld = 2048; coff = (pn - 14) * 256; }
        else { base = nullptr; ld = 0; coff = 0; }
        const int row0 = u.pm * 256 + wr * 64 + fr;
        if (pn == 22) {
            if (wc == 0) {
                float* blr = (float*)(ws + WS_BLR);
#pragma unroll
                for (int ai = 0; ai < 2; ++ai)
#pragma unroll
                    for (int m = 0; m < 4; ++m) { const int row = row0 + ai * 128 + m * 16; const float rs = rstd[row]; *(f32x4*)(blr + (size_t)row * 16 + 4 * fq) = acc[ai][0][m][0] * rs; }
            }
            return;
        }
        const bool kv = (pn == 4 || pn == 5);
        float* okv_p = out + (pn == 4 ? O_KP : O_VP); float* okv_s = out + (pn == 4 ? O_KS : O_VS);
#pragma unroll
        for (int ai = 0; ai < 2; ++ai)
#pragma unroll
            for (int m = 0; m < 4; ++m) {
                const int row = row0 + ai * 128 + m * 16; const float rs = rstd[row] * sc;
                bf16_t* rowp = base + (size_t)row * ld + coff + wc * 32 + 4 * fq;
                float* orow = nullptr;
                if (kv) {
                    if (row >= T_P) orow = okv_s + (size_t)(row - T_P) * 256;
                    else { const int b = row >> 11, t = row & 2047; if (t >= 1920) orow = okv_p + (size_t)(b * 128 + t - 1920) * 256; }
                }
#pragma unroll
                for (int bj = 0; bj < 2; ++bj)
#pragma unroll
                    for (int n = 0; n < 2; ++n) {
                        const f32x4 v = acc[ai][bj][m][n] * rs;
                        u32x2 w; w.x = cvt_pk_bf16(v[0], v[1]); w.y = cvt_pk_bf16(v[2], v[3]);
                        *(u32x2*)(rowp + bj * 128 + n * 16) = w;
                        if (kv && orow) *(f32x4*)(orow + bj * 128 + wc * 32 + n * 16 + 4 * fq) = v;
                    }
            }
    }
};

template <bool WRITE_BF>
struct EpiOutRes {
    const float* xin_p; const float* xin_s; float* xo; bf16_t* xb; float* rowsq;
    __device__ __forceinline__ void operator()(const AccT& acc, const pg8::Unit& u, int wr, int wc, int fr, int fq) const {
        const int row0 = u.pm * 256 + wr * 64 + fr, col0 = u.pn * 256 + wc * 32 + 4 * fq;
#pragma unroll
        for (int ai = 0; ai < 2; ++ai)
#pragma unroll
            for (int m = 0; m < 4; ++m) {
                const int row = row0 + ai * 128 + m * 16;
                const float* xr = (row < T_P) ? xin_p + (size_t)row * 1024 : xin_s + (size_t)(row - T_P) * 1024;
                float ss = 0.f;
#pragma unroll
                for (int bj = 0; bj < 2; ++bj)
#pragma unroll
                    for (int n = 0; n < 2; ++n) {
                        const int col = col0 + bj * 128 + n * 16;
                        const f32x4 v = acc[ai][bj][m][n] + *(const f32x4*)(xr + col);
                        *(f32x4*)(xo + (size_t)row * 1024 + col) = v;
                        if (WRITE_BF) { u32x2 w; w.x = cvt_pk_bf16(v[0], v[1]); w.y = cvt_pk_bf16(v[2], v[3]); *(u32x2*)(xb + (size_t)row * 1024 + col) = w; }
                        ss += v[0] * v[0] + v[1] * v[1] + v[2] * v[2] + v[3] * v[3];
                    }
                ss += __shfl_xor(ss, 16); ss += __shfl_xor(ss, 32);
                if (fq == 0) atomicAdd(rowsq + row, ss);
            }
    }
};

struct EpiInOdd {
    bf16_t* z2; const float* rowsq;
    __device__ __forceinline__ void operator()(const AccT& acc, const pg8::Unit& u, int wr, int wc, int fr, int fq) const {
        const int row0 = u.pm * 256 + wr * 64 + fr, col0 = u.pn * 256 + wc * 32 + 4 * fq;
#pragma unroll
        for (int ai = 0; ai < 2; ++ai)
#pragma unroll
            for (int m = 0; m < 4; ++m) {
                const int row = row0 + ai * 128 + m * 16; const float rs = rsqrtf(rowsq[row] * (1.f / 1024.f) + EPS);
#pragma unroll
                for (int bj = 0; bj < 2; ++bj)
#pragma unroll
                    for (int n = 0; n < 2; ++n) {
                        const f32x4 v = acc[ai][bj][m][n] * rs;
                        u32x2 w; w.x = cvt_pk_bf16(v[0], v[1]); w.y = cvt_pk_bf16(v[2], v[3]);
                        *(u32x2*)(z2 + (size_t)row * 3072 + col0 + bj * 128 + n * 16) = w;
                    }
            }
    }
};

template <int MODE>
__device__ __forceinline__ void transpose_w(const float* __restrict__ src, int K, int Nsrc, bf16_t* __restrict__ dst, int Ndst, const float* __restrict__ gain, long gtid, long gsz) {
    const long total = (long)(K / 8) * Ndst;
    for (long it = gtid; it < total; it += gsz) {
        const int n = (int)(it % Ndst), k8 = (int)(it / Ndst);
        int sc = n;
        if (MODE == 1) { if (n < 3584) sc = n; else if (n < 5632) sc = n + 16; else if (n < 5648) sc = n - 5632 + 3584; else sc = -1; }
        u32x4 w = {0u, 0u, 0u, 0u};
        if (sc >= 0) {
            const float* s = src + (size_t)(k8 * 8) * Nsrc + sc;
            float v0 = s[0], v1 = s[(size_t)Nsrc], v2 = s[(size_t)2 * Nsrc], v3 = s[(size_t)3 * Nsrc], v4 = s[(size_t)4 * Nsrc], v5 = s[(size_t)5 * Nsrc], v6 = s[(size_t)6 * Nsrc], v7 = s[(size_t)7 * Nsrc];
            if (gain) { const f32x4 g0 = *(const f32x4*)(gain + k8 * 8), g1 = *(const f32x4*)(gain + k8 * 8 + 4); v0 *= g0[0]; v1 *= g0[1]; v2 *= g0[2]; v3 *= g0[3]; v4 *= g1[0]; v5 *= g1[1]; v6 *= g1[2]; v7 *= g1[3]; }
            w.x = cvt_pk_bf16(v0, v1); w.y = cvt_pk_bf16(v2, v3); w.z = cvt_pk_bf16(v4, v5); w.w = cvt_pk_bf16(v6, v7);
        }
        *(u32x4*)(dst + (size_t)n * K + k8 * 8) = w;
    }
}

__device__ __forceinline__ void phase0(const Params& p) {
    unsigned char* ws = p.ws;
    const long gtid = (long)blockIdx.x * NTHR + threadIdx.x, gsz = (long)gridDim.x * NTHR;
    transpose_w<1>(p.in[8], 1024, 5648, (bf16_t*)(ws + WS_WINE), NE_PAD, p.in[7], gtid, gsz);
    transpose_w<0>(p.in[13], 2048, 1024, (bf16_t*)(ws + WS_WOUTE), 1024, nullptr, gtid, gsz);
    transpose_w<0>(p.in[15], 1024, 3072, (bf16_t*)(ws + WS_WINO), 3072, p.in[14], gtid, gsz);
    transpose_w<0>(p.in[23], 1536, 1024, (bf16_t*)(ws + WS_WOUTO), 1024, nullptr, gtid, gsz);
    for (int nb = 0; nb < 8; ++nb) {
        transpose_w<0>(p.in[18] + nb * 192 * 192, 192, 192, (bf16_t*)(ws + WS_WA) + nb * 192 * 192, 192, nullptr, gtid, gsz);
        transpose_w<0>(p.in[20] + nb * 192 * 192, 192, 192, (bf16_t*)(ws + WS_WI) + nb * 192 * 192, 192, nullptr, gtid, gsz);
    }
    { float* z = (float*)(ws + WS_RSQ1); const long nz = (long)T * 6; for (long i = gtid; i < nz; i += gsz) z[i] = 0.f; }
    const int lane = threadIdx.x & 63; const int gw = (int)(gtid >> 6), nw = (int)(gsz >> 6);
    bf16_t* xb = (bf16_t*)(ws + WS_XB); float* rstd = (float*)(ws + WS_RSTD0);
    for (int row = gw; row < T; row += nw) {
        const float* xr = (row < T_P) ? p.in[0] + (size_t)row * 1024 : p.in[1] + (size_t)(row - T_P) * 1024;
        float ss = 0.f;
#pragma unroll
        for (int i = 0; i < 4; ++i) {
            const f32x4 v = *(const f32x4*)(xr + i * 256 + lane * 4);
            ss += v[0] * v[0] + v[1] * v[1] + v[2] * v[2] + v[3] * v[3];
            u32x2 w; w.x = cvt_pk_bf16(v[0], v[1]); w.y = cvt_pk_bf16(v[2], v[3]);
            *(u32x2*)(xb + (size_t)row * 1024 + i * 256 + lane * 4) = w;
        }
#pragma unroll
        for (int o = 32; o >= 1; o >>= 1) ss += __shfl_xor(ss, o);
        if (lane == 0) rstd[row] = rsqrtf(ss * (1.f / 1024.f) + EPS);
    }
}

__device__ __forceinline__ void attn_item(const Params& p, LAS unsigned char* L, int item) {
    unsigned char* ws = p.ws;
    const int tid = threadIdx.x, lane = tid & 63, w = tid >> 6, r16 = lane & 15, q4 = lane >> 4;
    LAS bf16_t* Ks = (LAS bf16_t*)L;
    LAS bf16_t* Vt = (LAS bf16_t*)(L + 192 * 72 * 2);
    const bf16_t* Qb = (const bf16_t*)(ws + WS_Q); const bf16_t* Kb = (const bf16_t*)(ws + WS_K); const bf16_t* Vb = (const bf16_t*)(ws + WS_V);
    bf16_t* Yb = (bf16_t*)(ws + WS_GATE);
    const bool smp = item >= 2048;
    int b, c, kh; size_t row0;
    if (!smp) { kh = item & 3; c = (item >> 2) & 31; b = item >> 7; row0 = (size_t)b * 2048 + c * 64; }
    else { const int i2 = item - 2048; kh = i2 & 3; b = i2 >> 2; c = 0; row0 = (size_t)T_P + b * 64; }
#pragma unroll
    for (int i = 0; i < 3; ++i) {
        const int idx = tid + i * 512, key = idx >> 3, dg = idx & 7;
        u32x4 kv = {0u, 0u, 0u, 0u}, vv = {0u, 0u, 0u, 0u};
        if (!smp) {
            const int pos = c * 64 - 128 + key;
            if (pos >= 0) { const size_t r = (size_t)b * 2048 + pos; kv = *(const u32x4*)(Kb + r * 256 + kh * 64 + dg * 8); vv = *(const u32x4*)(Vb + r * 256 + kh * 64 + dg * 8); }
        } else {
            if (key < 128) {
                const size_t o = ((size_t)(b * 128 + key) * 4 + kh) * 64 + dg * 8;
                const f32x4 k0 = *(const f32x4*)(p.in[2] + o), k1 = *(const f32x4*)(p.in[2] + o + 4), v0 = *(const f32x4*)(p.in[3] + o), v1 = *(const f32x4*)(p.in[3] + o + 4);
                kv.x = cvt_pk_bf16(k0[0], k0[1]); kv.y = cvt_pk_bf16(k0[2], k0[3]); kv.z = cvt_pk_bf16(k1[0], k1[1]); kv.w = cvt_pk_bf16(k1[2], k1[3]);
                vv.x = cvt_pk_bf16(v0[0], v0[1]); vv.y = cvt_pk_bf16(v0[2], v0[3]); vv.z = cvt_pk_bf16(v1[0], v1[1]); vv.w = cvt_pk_bf16(v1[2], v1[3]);
            } else { const size_t r = (size_t)T_P + b * 64 + key - 128; kv = *(const u32x4*)(Kb + r * 256 + kh * 64 + dg * 8); vv = *(const u32x4*)(Vb + r * 256 + kh * 64 + dg * 8); }
        }
        *(LAS u32x4*)(Ks + key * 72 + dg * 8) = kv;
#pragma unroll
        for (int e = 0; e < 8; ++e) Vt[(dg * 8 + e) * 200 + key] = (bf16_t)(vv[e >> 1] >> ((e & 1) * 16));
    }
    __syncthreads();
    const int g = w >> 1, i0 = (w & 1) * 32, h = kh * 4 + g;
    const float slope = exp2f(-0.5f * (float)(h + 1));
    const float sink = p.in[11][h];
#pragma unroll 1
    for (int qt = 0; qt < 2; ++qt) {
        const int i = i0 + qt * 16 + r16;
        bf16x8 qf[2];
#pragma unroll
        for (int ks = 0; ks < 2; ++ks) qf[ks] = *(const bf16x8*)(Qb + (row0 + i) * 1024 + h * 64 + ks * 32 + q4 * 8);
        f32x4 sacc[12];
#pragma unroll
        for (int kt = 0; kt < 12; ++kt) {
            const bf16x8 kf0 = *(const LAS bf16x8*)(Ks + (kt * 16 + r16) * 72 + q4 * 8), kf1 = *(const LAS bf16x8*)(Ks + (kt * 16 + r16) * 72 + 32 + q4 * 8);
            f32x4 a = {0.f, 0.f, 0.f, 0.f}; a = MFMA16(kf0, qf[0], a); a = MFMA16(kf1, qf[1], a); sacc[kt] = a;
        }
        float m = -3e38f;
#pragma unroll
        for (int kt = 0; kt < 12; ++kt)
#pragma unroll
            for (int jj = 0; jj < 4; ++jj) {
                const int j = kt * 16 + q4 * 4 + jj;
                float sv = sacc[kt][jj] - slope * fabsf((float)(128 + i - j));
                if (!smp && (c * 64 - 128 + j) < 0) sv = -1e30f;
                sacc[kt][jj] = sv; m = fmaxf(m, sv);
            }
        m = fmaxf(m, __shfl_xor(m, 16)); m = fmaxf(m, __shfl_xor(m, 32)); m = fmaxf(m, sink);
        float l = 0.f;
#pragma unroll
        for (int kt = 0; kt < 12; ++kt)
#pragma unroll
            for (int jj = 0; jj < 4; ++jj) { const float pr = __expf(sacc[kt][jj] - m); sacc[kt][jj] = pr; l += pr; }
        l += __shfl_xor(l, 16); l += __shfl_xor(l, 32); l += __expf(sink - m);
        const float inv = 1.f / l;
        f32x4 oacc[4];
#pragma unroll
        for (int dt = 0; dt < 4; ++dt) oacc[dt] = (f32x4){0.f, 0.f, 0.f, 0.f};
#pragma unroll
        for (int kb = 0; kb < 6; ++kb) {
            const bf16x8 pf = pack8(sacc[2 * kb], sacc[2 * kb + 1]);
#pragma unroll
            for (int dt = 0; dt < 4; ++dt) {
                const LAS bf16_t* vp = Vt + (dt * 16 + r16) * 200 + kb * 32 + q4 * 4;
                const bf16x8 vf = cat4(*(const LAS bf16x4*)vp, *(const LAS bf16x4*)(vp + 16));
                oacc[dt] = MFMA16(vf, pf, oacc[dt]);
            }
        }
#pragma unroll
        for (int dt = 0; dt < 4; ++dt) {
            const size_t off = (row0 + i) * 2048 + h * 64 + dt * 16 + q4 * 4;
            const u32x2 gv = *(const u32x2*)(Yb + off);
            const f32x4 o = oacc[dt] * inv;
            u32x2 wv; wv.x = cvt_pk_bf16(o[0] * siluf(bflo(gv.x)), o[1] * siluf(bfhi(gv.x))); wv.y = cvt_pk_bf16(o[2] * siluf(bflo(gv.y)), o[3] * siluf(bfhi(gv.y)));
            *(u32x2*)(Yb + off) = wv;
        }
    }
    __syncthreads();
}

__device__ __forceinline__ void gla_item(const Params& p, LAS unsigned char* L, int item) {
    unsigned char* ws = p.ws;
    const int tid = threadIdx.x, lane = tid & 63, w = tid >> 6, r16 = lane & 15, q4 = lane >> 4;
    LAS bf16_t* QG = (LAS bf16_t*)L;
    LAS bf16_t* KG = (LAS bf16_t*)(L + 17408);
    LAS bf16_t* KDt = (LAS bf16_t*)(L + 34816);
    LAS bf16_t* Vt = (LAS bf16_t*)(L + 53248);
    LAS float* BLRs = (LAS float*)(L + 62464);
    LAS float* GT = (LAS float*)(L + 66560);
    LAS float* GL = (LAS float*)(L + 68608);
    const bool smp = item >= 256;
    const int i2 = smp ? item - 256 : item;
    const int b = i2 >> 4, h = (i2 >> 2) & 3, sl = i2 & 3, e0 = sl * 64;
    const int nch = smp ? 1 : 32;
    const size_t rbase = smp ? (size_t)T_P + b * 64 : (size_t)b * 2048;
    const bf16_t* BQ = (const bf16_t*)(ws + WS_BQ); const bf16_t* BKb = (const bf16_t*)(ws + WS_BK); bf16_t* BV = (bf16_t*)(ws + WS_BV);
    const float* BLR = (const float*)(ws + WS_BLR); float* BOSQ = (float*)(ws + WS_BOSQ);
    const int c = tid & 127, tg = tid >> 7;
    float wl[16];
#pragma unroll
    for (int r = 0; r < 16; ++r) wl[r] = p.in[9][r * 512 + h * 128 + c];
    const float bl = p.in[10][h * 128 + c];
    const int et = w & 3, ip = w >> 2;
    f32x4 Sacc[8];
#pragma unroll
    for (int d8 = 0; d8 < 8; ++d8) {
        if (smp) {
#pragma unroll
            for (int jj = 0; jj < 4; ++jj) Sacc[d8][jj] = p.in[4][((size_t)(b * 4 + h) * 128 + d8 * 16 + q4 * 4 + jj) * 256 + e0 + et * 16 + r16];
        } else Sacc[d8] = (f32x4){0.f, 0.f, 0.f, 0.f};
    }
    for (int ci = 0; ci < nch; ++ci) {
        const size_t r0 = rbase + (size_t)ci * 64;
        if (tid < 256) *(LAS f32x4*)(BLRs + tid * 4) = *(const f32x4*)(BLR + r0 * 16 + tid * 4);
        {
            const int t = tid >> 3, eg = tid & 7;
            const u32x4 vv = *(const u32x4*)(BV + (r0 + t) * 1024 + h * 256 + e0 + eg * 8);
#pragma unroll
            for (int e = 0; e < 8; ++e) Vt[(eg * 8 + e) * 72 + t] = (bf16_t)(vv[e >> 1] >> ((e & 1) * 16));
        }
        __syncthreads();
        float gl[16]; float cs = 0.f;
#pragma unroll
        for (int tt = 0; tt < 16; ++tt) {
            const int t = tg * 16 + tt;
            float x = bl;
#pragma unroll
            for (int r4 = 0; r4 < 4; ++r4) { const f32x4 bv = *(const LAS f32x4*)(BLRs + t * 16 + r4 * 4); x += bv[0] * wl[r4 * 4] + bv[1] * wl[r4 * 4 + 1] + bv[2] * wl[r4 * 4 + 2] + bv[3] * wl[r4 * 4 + 3]; }
            const float gg = (fminf(x, 0.f) - log1pf(__expf(-fabsf(x)))) * (1.f / 16.f);
            cs += gg; gl[tt] = cs;
        }
        GT[tg * 128 + c] = cs;
        __syncthreads();
        float pre = 0.f, tot = 0.f;
#pragma unroll
        for (int g2 = 0; g2 < 4; ++g2) { const float v = GT[g2 * 128 + c]; if (g2 < tg) pre += v; tot += v; }
        if (tg == 0) GL[c] = __expf(tot);
#pragma unroll
        for (int tt = 0; tt < 16; ++tt) {
            const int t = tg * 16 + tt; const float G = pre + gl[tt];
            const float qv = bf2f(BQ[(r0 + t) * 512 + h * 128 + c]), kv = bf2f(BKb[(r0 + t) * 512 + h * 128 + c]);
            QG[t * 136 + c] = f2bf(qv * __expf(G)); KG[t * 136 + c] = f2bf(kv * __expf(-G)); KDt[c * 72 + t] = f2bf(kv * __expf(tot - G));
        }
        __syncthreads();
        f32x4 at[4][2];
#pragma unroll
        for (int jt = 0; jt < 4; ++jt)
#pragma unroll
            for (int x2 = 0; x2 < 2; ++x2) at[jt][x2] = (f32x4){0.f, 0.f, 0.f, 0.f};
#pragma unroll
        for (int ks = 0; ks < 4; ++ks) {
            bf16x8 qf[2];
#pragma unroll
            for (int x2 = 0; x2 < 2; ++x2) qf[x2] = *(const LAS bf16x8*)(QG + ((ip * 2 + x2) * 16 + r16) * 136 + ks * 32 + q4 * 8);
#pragma unroll
            for (int jt = 0; jt < 4; ++jt) {
                const bf16x8 kf = *(const LAS bf16x8*)(KG + (jt * 16 + r16) * 136 + ks * 32 + q4 * 8);
#pragma unroll
                for (int x2 = 0; x2 < 2; ++x2) at[jt][x2] = MFMA16(kf, qf[x2], at[jt][x2]);
            }
        }
#pragma unroll
        for (int jt = 0; jt < 4; ++jt)
#pragma unroll
            for (int x2 = 0; x2 < 2; ++x2)
#pragma unroll
                for (int jj = 0; jj < 4; ++jj) { const int j = jt * 16 + q4 * 4 + jj, i = (ip * 2 + x2) * 16 + r16; if (j > i) at[jt][x2][jj] = 0.f; }
        f32x4 ot[2];
        ot[0] = (f32x4){0.f, 0.f, 0.f, 0.f}; ot[1] = (f32x4){0.f, 0.f, 0.f, 0.f};
#pragma unroll
        for (int jb = 0; jb < 2; ++jb) {
            const LAS bf16_t* vp = Vt + (et * 16 + r16) * 72 + jb * 32 + q4 * 4;
            const bf16x8 vf = cat4(*(const LAS bf16x4*)vp, *(const LAS bf16x4*)(vp + 16));
#pragma unroll
            for (int x2 = 0; x2 < 2; ++x2) { const bf16x8 pf = pack8(at[2 * jb][x2], at[2 * jb + 1][x2]); ot[x2] = MFMA16(vf, pf, ot[x2]); }
        }
#pragma unroll
        for (int db = 0; db < 4; ++db) {
            const bf16x8 sf = pack8(Sacc[2 * db], Sacc[2 * db + 1]);
#pragma unroll
            for (int x2 = 0; x2 < 2; ++x2) {
                const LAS bf16_t* qp = QG + ((ip * 2 + x2) * 16 + r16) * 136 + db * 32 + q4 * 4;
                const bf16x8 qv = cat4(*(const LAS bf16x4*)qp, *(const LAS bf16x4*)(qp + 16));
                ot[x2] = MFMA16(sf, qv, ot[x2]);
            }
        }
#pragma unroll
        for (int x2 = 0; x2 < 2; ++x2) {
            const size_t row = r0 + (ip * 2 + x2) * 16 + r16;
            const f32x4 o = ot[x2];
            u32x2 wv; wv.x = cvt_pk_bf16(o[0], o[1]); wv.y = cvt_pk_bf16(o[2], o[3]);
            *(u32x2*)(BV + row * 1024 + h * 256 + e0 + et * 16 + q4 * 4) = wv;
            float ss = o[0] * o[0] + o[1] * o[1] + o[2] * o[2] + o[3] * o[3];
            ss += __shfl_xor(ss, 16); ss += __shfl_xor(ss, 32);
            if (q4 == 0) atomicAdd(BOSQ + row * 4 + h, ss);
        }
#pragma unroll
        for (int d8 = 0; d8 < 8; ++d8) {
            const f32x4 dec = *(const LAS f32x4*)(GL + d8 * 16 + q4 * 4);
            Sacc[d8] = Sacc[d8] * dec;
        }
#pragma unroll
        for (int jb = 0; jb < 2; ++jb) {
            const bf16x8 vf = *(const LAS bf16x8*)(Vt + (et * 16 + r16) * 72 + jb * 32 + q4 * 8);
#pragma unroll
            for (int d8 = 0; d8 < 8; ++d8) {
                const bf16x8 kf = *(const LAS bf16x8*)(KDt + (d8 * 16 + r16) * 72 + jb * 32 + q4 * 8);
                Sacc[d8] = MFMA16(kf, vf, Sacc[d8]);
            }
        }
        __syncthreads();
    }
    if (ip == 0) {
        float* og = p.out + (smp ? O_GS : O_GP);
#pragma unroll
        for (int d8 = 0; d8 < 8; ++d8)
#pragma unroll
            for (int jj = 0; jj < 4; ++jj) og[((size_t)(b * 4 + h) * 128 + d8 * 16 + q4 * 4 + jj) * 256 + e0 + et * 16 + r16] = Sacc[d8][jj];
    }
}

__device__ __forceinline__ void phase2(const Params& p, LAS unsigned char* L) {
    for (int it = blockIdx.x; it < 768; it += gridDim.x) gla_item(p, L, it);
    for (int it = blockIdx.x; it < 2176; it += gridDim.x) attn_item(p, L, it);
}

__device__ __forceinline__ void phase3(const Params& p) {
    unsigned char* ws = p.ws;
    const bf16_t* BV = (const bf16_t*)(ws + WS_BV); bf16_t* Yb = (bf16_t*)(ws + WS_GATE); const float* BOSQ = (const float*)(ws + WS_BOSQ);
    const float* gg = p.in[12];
    const long gtid = (long)blockIdx.x * NTHR + threadIdx.x, gsz = (long)gridDim.x * NTHR;
    const long total = (long)T * 128;
    for (long it = gtid; it < total; it += gsz) {
        const long row = it >> 7; const int c8 = (int)(it & 127) * 8, h = c8 >> 8;
        const float rs = rsqrtf(BOSQ[row * 4 + h] * (1.f / 256.f) + EPS);
        const u32x4 bo = *(const u32x4*)(BV + row * 1024 + c8);
        const u32x4 gt = *(const u32x4*)(Yb + row * 2048 + 1024 + c8);
        const f32x4 g0 = *(const f32x4*)(gg + (c8 & 255)), g1 = *(const f32x4*)(gg + (c8 & 255) + 4);
        u32x4 o;
        o.x = cvt_pk_bf16(bflo(bo.x) * rs * g0[0] * siluf(bflo(gt.x)), bfhi(bo.x) * rs * g0[1] * siluf(bfhi(gt.x)));
        o.y = cvt_pk_bf16(bflo(bo.y) * rs * g0[2] * siluf(bflo(gt.y)), bfhi(bo.y) * rs * g0[3] * siluf(bfhi(gt.y)));
        o.z = cvt_pk_bf16(bflo(bo.z) * rs * g1[0] * siluf(bflo(gt.z)), bfhi(bo.z) * rs * g1[1] * siluf(bfhi(gt.z)));
        o.w = cvt_pk_bf16(bflo(bo.w) * rs * g1[2] * siluf(bflo(gt.w)), bfhi(bo.w) * rs * g1[3] * siluf(bfhi(gt.w)));
        *(u32x4*)(Yb + row * 2048 + 1024 + c8) = o;
    }
}

__device__ __forceinline__ void lru_item(const Params& p, LAS unsigned char* L, int item) {
    unsigned char* ws = p.ws;
    const int tid = threadIdx.x, lane = tid & 63, w = tid >> 6, r16 = lane & 15, q4 = lane >> 4;
    LAS bf16_t* Wl = (LAS bf16_t*)L;
    LAS bf16_t* U = (LAS bf16_t*)(L + 76800);
    LAS float* Aa = (LAS float*)(L + 102400);
    LAS float* Bb = (LAS float*)(L + 126976);
    const bool smp = item >= 256;
    const int i2 = smp ? item - 256 : item;
    const int b = i2 >> 4, nb = (i2 >> 1) & 7, hf = i2 & 1;
    const int nch = smp ? 1 : 32;
    const size_t rbase = smp ? (size_t)T_P + b * 64 : (size_t)b * 2048;
    const bf16_t* Z2 = (const bf16_t*)(ws + WS_Z2); bf16_t* Y2 = (bf16_t*)(ws + WS_Y2);
    const bf16_t* WA = (const bf16_t*)(ws + WS_WA) + nb * 192 * 192; const bf16_t* WI = (const bf16_t*)(ws + WS_WI) + nb * 192 * 192;
    for (int idx = tid; idx < 192 * 24; idx += NTHR) {
        const int r = idx / 24, g8 = idx % 24;
        const bf16_t* src = (r < 96) ? WA + (size_t)(hf * 96 + r) * 192 + g8 * 8 : WI + (size_t)(hf * 96 + r - 96) * 192 + g8 * 8;
        *(LAS u32x4*)(Wl + r * 200 + g8 * 8) = *(const u32x4*)src;
    }
    const int cgp = tid % 24, tq = tid / 24;
    const int chc = nb * 192 + cgp * 8;
    float cw[4][8], cb[8];
#pragma unroll
    for (int j = 0; j < 4; ++j)
#pragma unroll
        for (int e = 0; e < 8; ++e) cw[j][e] = p.in[16][j * 1536 + chc + e];
#pragma unroll
    for (int e = 0; e < 8; ++e) cb[e] = p.in[17][chc + e];
    const int mt = w & 3, pg = w >> 2;
    float bra[3], bri[3], sp[3];
#pragma unroll
    for (int cp = 0; cp < 3; ++cp) {
        const int ch = nb * 192 + hf * 96 + (pg * 3 + cp) * 16 + r16;
        bra[cp] = p.in[19][ch]; bri[cp] = p.in[21][ch];
        const float lam = p.in[22][ch];
        sp[cp] = fmaxf(-lam, 0.f) + log1pf(__expf(-fabsf(lam)));
    }
    float hcar = 0.f;
    if (smp && tid < 96) hcar = p.in[6][b * 1536 + nb * 192 + hf * 96 + tid];
    for (int ci = 0; ci < nch; ++ci) {
        const size_t r0 = rbase + (size_t)ci * 64;
        if (tid < 480) {
            for (int t = tq; t < 64; t += 20) {
                float acc[8];
#pragma unroll
                for (int e = 0; e < 8; ++e) acc[e] = cb[e];
#pragma unroll
                for (int j = 0; j < 4; ++j) {
                    const int pos = ci * 64 + t - 3 + j;
                    float xv[8];
                    if (pos >= 0) {
                        const u32x4 xw = *(const u32x4*)(Z2 + (rbase + pos) * 3072 + chc);
                        xv[0] = bflo(xw.x); xv[1] = bfhi(xw.x); xv[2] = bflo(xw.y); xv[3] = bfhi(xw.y); xv[4] = bflo(xw.z); xv[5] = bfhi(xw.z); xv[6] = bflo(xw.w); xv[7] = bfhi(xw.w);
                        if (hf == 0 && j == 3 && ci == nch - 1 && t >= 61) {
                            float* oc = p.out + (smp ? O_CS : O_CP) + ((size_t)b * 3 + (t - 61)) * 1536 + chc;
                            *(f32x4*)oc = (f32x4){xv[0], xv[1], xv[2], xv[3]}; *(f32x4*)(oc + 4) = (f32x4){xv[4], xv[5], xv[6], xv[7]};
                        }
                    } else if (smp) {
                        const float* hp = p.in[5] + ((size_t)b * 3 + (3 + pos)) * 1536 + chc;
                        const f32x4 h0 = *(const f32x4*)hp, h1 = *(const f32x4*)(hp + 4);
                        xv[0] = h0[0]; xv[1] = h0[1]; xv[2] = h0[2]; xv[3] = h0[3]; xv[4] = h1[0]; xv[5] = h1[1]; xv[6] = h1[2]; xv[7] = h1[3];
                    } else {
#pragma unroll
                        for (int e = 0; e < 8; ++e) xv[e] = 0.f;
                    }
#pragma unroll
                    for (int e = 0; e < 8; ++e) acc[e] += xv[e] * cw[j][e];
                }
                u32x4 uw; uw.x = cvt_pk_bf16(acc[0], acc[1]); uw.y = cvt_pk_bf16(acc[2], acc[3]); uw.z = cvt_pk_bf16(acc[4], acc[5]); uw.w = cvt_pk_bf16(acc[6], acc[7]);
                *(LAS u32x4*)(U + t * 200 + cgp * 8) = uw;
            }
        }
        __syncthreads();
        f32x4 ga[3], gi[3];
#pragma unroll
        for (int cp = 0; cp < 3; ++cp) { ga[cp] = (f32x4){0.f, 0.f, 0.f, 0.f}; gi[cp] = (f32x4){0.f, 0.f, 0.f, 0.f}; }
#pragma unroll
        for (int ks = 0; ks < 6; ++ks) {
            const bf16x8 uf = *(const LAS bf16x8*)(U + (mt * 16 + r16) * 200 + ks * 32 + q4 * 8);
#pragma unroll
            for (int cp = 0; cp < 3; ++cp) {
                const int ct = pg * 3 + cp;
                const bf16x8 wa = *(const LAS bf16x8*)(Wl + (ct * 16 + r16) * 200 + ks * 32 + q4 * 8), wi = *(const LAS bf16x8*)(Wl + (96 + ct * 16 + r16) * 200 + ks * 32 + q4 * 8);
                ga[cp] = MFMA16(uf, wa, ga[cp]); gi[cp] = MFMA16(uf, wi, gi[cp]);
            }
        }
#pragma unroll
        for (int cp = 0; cp < 3; ++cp) {
            const int cl = (pg * 3 + cp) * 16 + r16;
#pragma unroll
            for (int jj = 0; jj < 4; ++jj) {
                const int t = mt * 16 + q4 * 4 + jj;
                const float rg = sigmf(ga[cp][jj] + bra[cp]), ig = sigmf(gi[cp][jj] + bri[cp]);
                const float la = -8.f * rg * sp[cp];
                const float a = __expf(la);
                const float uu = bf2f(U[t * 200 + hf * 96 + cl]);
                const float bt = sqrtf(-expm1f(2.f * la)) * ig * uu;
                Aa[t * 96 + cl] = a; Bb[t * 96 + cl] = bt;
            }
        }
        __syncthreads();
        if (tid < 96) {
            float hh = hcar;
#pragma unroll 8
            for (int t = 0; t < 64; ++t) { hh = Aa[t * 96 + tid] * hh + Bb[t * 96 + tid]; Bb[t * 96 + tid] = hh; }
            hcar = hh;
        }
        __syncthreads();
        for (int idx = tid; idx < 768; idx += NTHR) {
            const int t = idx / 12, g8 = idx % 12;
            const int ch = nb * 192 + hf * 96 + g8 * 8;
            const u32x4 gt = *(const u32x4*)(Z2 + (r0 + t) * 3072 + 1536 + ch);
            const f32x4 h0 = *(const LAS f32x4*)(Bb + t * 96 + g8 * 8), h1 = *(const LAS f32x4*)(Bb + t * 96 + g8 * 8 + 4);
            u32x4 o;
            o.x = cvt_pk_bf16(h0[0] * siluf(bflo(gt.x)), h0[1] * siluf(bfhi(gt.x)));
            o.y = cvt_pk_bf16(h0[2] * siluf(bflo(gt.y)), h0[3] * siluf(bfhi(gt.y)));
            o.z = cvt_pk_bf16(h1[0] * siluf(bflo(gt.z)), h1[1] * siluf(bfhi(gt.z)));
            o.w = cvt_pk_bf16(h1[2] * siluf(bflo(gt.w)), h1[3] * siluf(bfhi(gt.w)));
            *(u32x4*)(Y2 + (r0 + t) * 1536 + ch) = o;
        }
        __syncthreads();
    }
    if (tid < 96) p.out[(smp ? O_LS : O_LP) + (size_t)b * 1536 + nb * 192 + hf * 96 + tid] = hcar;
    __syncthreads();
}

__device__ __forceinline__ void phase6(const Params& p, LAS unsigned char* L) {
    for (int it = blockIdx.x; it < 768; it += gridDim.x) lru_item(p, L, it);
}

__device__ __forceinline__ void phase8(const Params& p) {
    const float* rsq = (const float*)(p.ws + WS_RSQ2); const float* g = p.in[24]; float* y = p.out;
    const long gtid = (long)blockIdx.x * NTHR + threadIdx.x, gsz = (long)gridDim.x * NTHR;
    const long total = (long)T * 256;
    for (long it = gtid; it < total; it += gsz) {
        const long row = it >> 8; const int c4 = (int)(it & 255) * 4;
        const float rs = rsqrtf(rsq[row] * (1.f / 1024.f) + EPS);
        const f32x4 v = *(const f32x4*)(y + row * 1024 + c4), gv = *(const f32x4*)(g + c4);
        *(f32x4*)(y + row * 1024 + c4) = v * rs * gv;
    }
}

__global__ void __launch_bounds__(NTHR) mega(Params p) {
    extern __shared__ __attribute__((aligned(16))) unsigned char lds_raw[];
    LAS unsigned char* L = (LAS unsigned char*)lds_raw;
    cg::grid_group grid = cg::this_grid();
    unsigned char* ws = p.ws;
    const int lo = p.ph_lo, hi = p.ph_hi;
#ifndef PHMASK
#define PHMASK 0x1ff
#endif
#define IN(k) (((PHMASK >> (k)) & 1) && lo <= (k) && (k) < hi)
#define SEAM(k) do { if (IN(k) && IN((k) + 1)) grid.sync(); } while (0)
    if (IN(0)) phase0(p);
    SEAM(0);
    if (IN(1)) {
        pg8::Gemm g{(const bf16_t*)(ws + WS_XB), (const bf16_t*)(ws + WS_WINE), T, NE_PAD, 1024};
        pg8::StaticOrder S; S.init(T, NE_PAD, gridDim.x, blockIdx.x);
        EpiInEven E{ws, p.out, (const float*)(ws + WS_RSTD0)};
        pg8::gemm_phase<EpiInEven>(L, g, S, E);
    }
    SEAM(1);
    if (IN(2)) phase2(p, L);
    SEAM(2);
    if (IN(3)) phase3(p);
    SEAM(3);
    if (IN(4)) {
        pg8::Gemm g{(const bf16_t*)(ws + WS_GATE), (const bf16_t*)(ws + WS_WOUTE), T, 1024, 2048};
        pg8::StaticOrder S; S.init(T, 1024, gridDim.x, blockIdx.x);
        EpiOutRes<true> E{p.in[0], p.in[1], p.out, (bf16_t*)(ws + WS_XB), (float*)(ws + WS_RSQ1)};
        pg8::gemm_phase<EpiOutRes<true>>(L, g, S, E);
    }
    SEAM(4);
    if (IN(5)) {
        pg8::Gemm g{(const bf16_t*)(ws + WS_XB), (const bf16_t*)(ws + WS_WINO), T, 3072, 1024};
        pg8::StaticOrder S; S.init(T, 3072, gridDim.x, blockIdx.x);
        EpiInOdd E{(bf16_t*)(ws + WS_Z2), (const float*)(ws + WS_RSQ1)};
        pg8::gemm_phase<EpiInOdd>(L, g, S, E);
    }
    SEAM(5);
    if (IN(6)) phase6(p, L);
    SEAM(6);
    if (IN(7)) {
        pg8::Gemm g{(const bf16_t*)(ws + WS_Y2), (const bf16_t*)(ws + WS_WOUTO), T, 1024, 1536};
        pg8::StaticOrder S; S.init(T, 1024, gridDim.x, blockIdx.x);
        EpiOutRes<false> E{p.out, p.out + (size_t)T_P * 1024, p.out, nullptr, (float*)(ws + WS_RSQ2)};
        pg8::gemm_phase<EpiOutRes<false>>(L, g, S, E);
    }
    SEAM(7);
    if (IN(8)) phase8(p);
#undef IN
#undef SEAM
}

extern "C" void kernel_launch(void* const* d_in, const int* in_sizes, int n_in, void* d_out, int out_size, void* d_ws, size_t ws_size, hipStream_t stream) {
    static int grid_blocks = 0;
    if (grid_blocks == 0) {
        if (n_in != 25 || (size_t)out_size != O_END || ws_size < WS_END) { fprintf(stderr, "kernel_launch: unexpected shapes n_in %d out %d ws %zu (need %zu)\n", n_in, out_size, ws_size, (size_t)WS_END); grid_blocks = -1; return; }
        int dev = 0, cus = 0, per_cu = 0;
        (void)hipGetDevice(&dev);
        (void)hipDeviceGetAttribute(&cus, hipDeviceAttributeMultiprocessorCount, dev);
        if (hipFuncSetAttribute((const void*)mega, hipFuncAttributeMaxDynamicSharedMemorySize, LDS_BYTES) != hipSuccess) { fprintf(stderr, "kernel_launch: hipFuncSetAttribute failed\n"); }
        if (hipOccupancyMaxActiveBlocksPerMultiprocessor(&per_cu, (const void*)mega, NTHR, LDS_BYTES) != hipSuccess || per_cu < 1) per_cu = 1;
        (void)hipGetLastError();
        grid_blocks = cus * per_cu;
        if (grid_blocks <= 0) grid_blocks = 256;
    }
    if (grid_blocks < 0) return;
    Params p{};
    for (int i = 0; i < 25; ++i) p.in[i] = (const float*)d_in[i];
    p.out = (float*)d_out; p.ws = (unsigned char*)d_ws;
#if ONE_LAUNCH
    p.ph_lo = 0; p.ph_hi = 9;
    { void* args[] = {&p}; hipError_t e = hipLaunchCooperativeKernel((const void*)mega, dim3(grid_blocks), dim3(NTHR), args, LDS_BYTES, stream);
      if (e != hipSuccess) fprintf(stderr, "cooperative launch failed: %s (grid %d)\n", hipGetErrorString(e), grid_blocks); }
#else
    for (int ph = 0; ph < 9; ++ph) {
        p.ph_lo = ph; p.ph_hi = ph + 1;
        void* args[] = {&p}; hipError_t e = hipLaunchCooperativeKernel((const void*)mega, dim3(grid_blocks), dim3(NTHR), args, LDS_BYTES, stream);
        if (e != hipSuccess) fprintf(stderr, "cooperative launch %d failed: %s (grid %d)\n", ph, hipGetErrorString(e), grid_blocks);
    }
#endif
}
```

```cpp
#include <hip/hip_runtime.h>
#include <hip/hip_cooperative_groups.h>
#include <cstdio>
namespace cg = cooperative_groups;

#ifndef ONE_LAUNCH
#define ONE_LAUNCH 1
#endif

#define LAS __attribute__((address_space(3)))
typedef unsigned short bf16_t;
typedef short bf16x8 __attribute__((ext_vector_type(8)));
typedef short bf16x4 __attribute__((ext_vector_type(4)));
typedef float f32x4 __attribute__((ext_vector_type(4)));
typedef unsigned u32x4 __attribute__((ext_vector_type(4)));
typedef unsigned u32x2 __attribute__((ext_vector_type(2)));

constexpr int T_P = 32768, T_S = 2048, T = T_P + T_S, DM = 1024;
constexpr int NE_PAD = 5888;
constexpr int LDS_BYTES = 159744;
constexpr int NTHR = 512;
constexpr float EPS = 1e-6f;

constexpr size_t WS_WINE = 0;
constexpr size_t WS_WOUTE = WS_WINE + (size_t)NE_PAD * 1024 * 2;
constexpr size_t WS_WINO = WS_WOUTE + (size_t)1024 * 2048 * 2;
constexpr size_t WS_WOUTO = WS_WINO + (size_t)3072 * 1024 * 2;
constexpr size_t WS_WA = WS_WOUTO + (size_t)1024 * 1536 * 2;
constexpr size_t WS_WI = WS_WA + (size_t)8 * 192 * 192 * 2;
constexpr size_t WS_XB = WS_WI + (size_t)8 * 192 * 192 * 2;
constexpr size_t WS_RSTD0 = WS_XB + (size_t)T * 1024 * 2;
constexpr size_t WS_RSQ1 = WS_RSTD0 + (size_t)T * 4;
constexpr size_t WS_RSQ2 = WS_RSQ1 + (size_t)T * 4;
constexpr size_t WS_BOSQ = WS_RSQ2 + (size_t)T * 4;
constexpr size_t WS_Q = WS_BOSQ + (size_t)T * 16;
constexpr size_t WS_K = WS_Q + (size_t)T * 1024 * 2;
constexpr size_t WS_V = WS_K + (size_t)T * 256 * 2;
constexpr size_t WS_BQ = WS_V + (size_t)T * 256 * 2;
constexpr size_t WS_BK = WS_BQ + (size_t)T * 512 * 2;
constexpr size_t WS_BV = WS_BK + (size_t)T * 512 * 2;
constexpr size_t WS_GATE = WS_BV + (size_t)T * 1024 * 2;
constexpr size_t WS_BLR = WS_GATE + (size_t)T * 2048 * 2;
constexpr size_t WS_END = WS_BLR + (size_t)T * 16 * 4;
constexpr size_t WS_Z2 = WS_Q;
constexpr size_t WS_Y2 = WS_GATE;
static_assert(WS_Z2 + (size_t)T * 3072 * 2 <= WS_GATE, "Z2 alias");

constexpr size_t O_Y = 0;
constexpr size_t O_KP = (size_t)T * 1024;
constexpr size_t O_VP = O_KP + 524288;
constexpr size_t O_GP = O_VP + 524288;
constexpr size_t O_CP = O_GP + 2097152;
constexpr size_t O_LP = O_CP + 73728;
constexpr size_t O_KS = O_LP + 24576;
constexpr size_t O_VS = O_KS + 524288;
constexpr size_t O_GS = O_VS + 524288;
constexpr size_t O_CS = O_GS + 4194304;
constexpr size_t O_LS = O_CS + 147456;
constexpr size_t O_END = O_LS + 49152;

struct Params {
    const float* in[25];
    float* out;
    unsigned char* ws;
    int ph_lo, ph_hi;
};

__device__ __forceinline__ unsigned cvt_pk_bf16(float lo, float hi) { unsigned r; asm volatile("v_cvt_pk_bf16_f32 %0, %1, %2" : "=v"(r) : "v"(lo), "v"(hi)); return r; }
__device__ __forceinline__ bf16_t f2bf(float f) { return (bf16_t)(cvt_pk_bf16(f, 0.f) & 0xffffu); }
__device__ __forceinline__ float bf2f(bf16_t b) { return __uint_as_float(((unsigned)b) << 16); }
__device__ __forceinline__ float bflo(unsigned w) { return __uint_as_float(w << 16); }
__device__ __forceinline__ float bfhi(unsigned w) { return __uint_as_float(w & 0xffff0000u); }
__device__ __forceinline__ float rcpf_(float x) { return __builtin_amdgcn_rcpf(x); }
__device__ __forceinline__ float siluf(float x) { return x * rcpf_(1.f + __expf(-x)); }
__device__ __forceinline__ float sigmf(float x) { return rcpf_(1.f + __expf(-x)); }
__device__ __forceinline__ void lds_barrier() { asm volatile("s_waitcnt lgkmcnt(0)" ::: "memory"); __builtin_amdgcn_s_barrier(); asm volatile("" ::: "memory"); }
__device__ __forceinline__ bf16x8 pack8(const f32x4& a, const f32x4& b) {
    u32x4 p; p.x = cvt_pk_bf16(a[0], a[1]); p.y = cvt_pk_bf16(a[2], a[3]); p.z = cvt_pk_bf16(b[0], b[1]); p.w = cvt_pk_bf16(b[2], b[3]);
    return __builtin_bit_cast(bf16x8, p);
}
__device__ __forceinline__ bf16x8 cat4(const bf16x4 a, const bf16x4 b) { bf16x8 r; r[0] = a[0]; r[1] = a[1]; r[2] = a[2]; r[3] = a[3]; r[4] = b[0]; r[5] = b[1]; r[6] = b[2]; r[7] = b[3]; return r; }
#define MFMA16(a, b, c) __builtin_amdgcn_mfma_f32_16x16x32_bf16((a), (b), (c), 0, 0, 0)

namespace pg8 {
constexpr int BM = 256, BK = 64, HALF = 128, HTB = HALF * BK * 2, STAGE_BYTES = 8 * HTB, NXCD = 8, WGM = 8;
__device__ __forceinline__ int lds_byte(int r, int c) { const int st = (r >> 4) * 2 + (c >> 5), rr = r & 15, cc = c & 31, ob = rr * 64 + cc * 2; return st * 1024 + (ob ^ (((ob >> 9) & 1) << 5)); }
__device__ __forceinline__ void stage_rc(int b, int& R, int& C) { const int st = b / 1024, sb = b % 1024, swz = sb ^ (((sb >> 9) & 1) << 5); R = (st >> 1) * 16 + swz / 64; C = (st & 1) * 32 + (swz % 64) / 2; }
struct Unit { int pm, pn; };
struct Gemm { const bf16_t* A; const bf16_t* Bt; int M, N, K; };
struct StaticOrder {
    int nM, nN, nwg, G, c;
    __device__ void init(int M, int N, int G_, int c_) { nM = M / BM; nN = N / BM; nwg = nM * nN; G = G_; c = c_; }
    __device__ __forceinline__ bool next(int i, Unit& u) const {
        const long Lx = (long)i * G + c; if (Lx >= nwg) return false;
        int wgid = (int)Lx; { const int q = nwg / NXCD, r = nwg % NXCD, xcd = wgid % NXCD, off = wgid / NXCD; wgid = (xcd < r ? xcd * (q + 1) : r * (q + 1) + (xcd - r) * q) + off; }
        const int nig = WGM * nN, gid = wgid / nig, fm = gid * WGM, gsz = (nM - fm) < WGM ? (nM - fm) : WGM;
        u.pm = fm + ((wgid % nig) % gsz); u.pn = (wgid % nig) / gsz; return true;
    }
};

template <class Epi>
__device__ __forceinline__ void gemm_phase(LAS unsigned char* lds, const Gemm g, const StaticOrder& S, const Epi& E) {
    const int tid = threadIdx.x, wid = __builtin_amdgcn_readfirstlane(tid >> 6), lane = tid & 63, wr = wid >> 2, wc = wid & 3, fr = lane & 15, fq = lane >> 4;
    const int K = g.K, nt = K / BK;
    unsigned voffA[2];
#pragma unroll
    for (int i = 0; i < 2; ++i) { int R, C; stage_rc(tid * 16 + i * 8192, R, C); voffA[i] = (unsigned)(R * K + C) * 2u; }
    const size_t kstep = (size_t)(BK * 2);
    const size_t hstep = (size_t)HALF * K * 2;
    const size_t tstep = 2 * hstep;
    const unsigned ldsw = (unsigned)wid * 1024u;
    const int aoff = lds_byte(wr * 64 + fr, fq * 8), boff = lds_byte(wc * 32 + fr, fq * 8);
#define PG8_SA(b, h) (((b) * 2 + (h)) * HTB)
#define PG8_SB(b, h) ((4 + (b) * 2 + (h)) * HTB)
#define PG8_STAGE(bufoff, gbase, voff) do { _Pragma("unroll") for (int _i = 0; _i < 2; ++_i) \
        __builtin_amdgcn_global_load_lds((const unsigned*)((const char*)(gbase) + (voff)[_i]), (LAS unsigned*)(lds + (bufoff) + ldsw + _i * 8192), 16, 0, 0); } while (0)
#define PG8_LDA(dst, b, h) do { _Pragma("unroll") for (int m = 0; m < 4; ++m) _Pragma("unroll") for (int k = 0; k < 2; ++k) dst[m][k] = *(const LAS bf16x8*)(lds + PG8_SA(b, h) + aoff + m * 2048 + k * 1024); } while (0)
#define PG8_LDB(dst, b, h) do { _Pragma("unroll") for (int n = 0; n < 2; ++n) _Pragma("unroll") for (int k = 0; k < 2; ++k) dst[n][k] = *(const LAS bf16x8*)(lds + PG8_SB(b, h) + boff + n * 2048 + k * 1024); } while (0)
#define PG8_MMA(ai, bj, At, Bt) do { __builtin_amdgcn_s_setprio(1); _Pragma("unroll") for (int m = 0; m < 4; ++m) _Pragma("unroll") for (int n = 0; n < 2; ++n) _Pragma("unroll") for (int k = 0; k < 2; ++k) \
        acc[ai][bj][m][n] = __builtin_amdgcn_mfma_f32_16x16x32_bf16(Bt[n][k], At[m][k], acc[ai][bj][m][n], 0, 0, 0); __builtin_amdgcn_s_setprio(0); } while (0)
#define PG8_WAIT_V(n) asm volatile("s_waitcnt vmcnt(" #n ")" ::: "memory")
#define PG8_WAIT_L(n) asm volatile("s_waitcnt lgkmcnt(" #n ")" ::: "memory")
#define PG8_BAR __builtin_amdgcn_s_barrier()
#define PG8_SCHED __builtin_amdgcn_sched_barrier(0)
    Unit cur, nxt; int ui = 0;
    if (!S.next(0, cur)) return;
    f32x4 acc[2][2][4][2];
#pragma unroll
    for (int a = 0; a < 2; ++a)
#pragma unroll
        for (int b = 0; b < 2; ++b)
#pragma unroll
            for (int m = 0; m < 4; ++m)
#pragma unroll
                for (int n = 0; n < 2; ++n) acc[a][b][m][n] = (f32x4){0.f, 0.f, 0.f, 0.f};
    bf16x8 At[4][2], B0[2][2], B1[2][2];
    const char* cA = (const char*)g.A + (size_t)cur.pm * tstep; const char* cB = (const char*)g.Bt + (size_t)cur.pn * tstep;
    PG8_STAGE(PG8_SB(0, 0), cB, voffA); PG8_STAGE(PG8_SA(0, 0), cA, voffA); PG8_STAGE(PG8_SB(0, 1), cB + hstep, voffA); PG8_STAGE(PG8_SA(0, 1), cA + hstep, voffA);
    if (wr == 1) PG8_BAR;
    PG8_WAIT_V(4); PG8_BAR;
    PG8_STAGE(PG8_SB(1, 0), cB + kstep, voffA); PG8_STAGE(PG8_SA(1, 0), cA + kstep, voffA); PG8_STAGE(PG8_SB(1, 1), cB + hstep + kstep, voffA);
    PG8_WAIT_V(6); PG8_BAR;
    for (;;) {
        const bool has_next = S.next(ui + 1, nxt);
        const char* nA = has_next ? (const char*)g.A + (size_t)nxt.pm * tstep : cA; const char* nB = has_next ? (const char*)g.Bt + (size_t)nxt.pn * tstep : cB;
        for (int t = 0; t < nt; t += 2) {
            const bool last = (t == nt - 2);
            const char* a1 = cA + (size_t)(t + 1) * kstep;
            const char* a2 = last ? nA : cA + (size_t)(t + 2) * kstep; const char* b2 = last ? nB : cB + (size_t)(t + 2) * kstep;
            const char* a3 = a2 + kstep; const char* b3 = b2 + kstep;
            PG8_LDB(B0, 0, 0); PG8_SCHED; PG8_LDA(At, 0, 0); PG8_STAGE(PG8_SA(1, 1), a1 + hstep, voffA);
            PG8_WAIT_L(8); PG8_BAR; PG8_WAIT_L(0); PG8_MMA(0, 0, At, B0); PG8_BAR; PG8_SCHED;
            PG8_LDB(B1, 0, 1); PG8_STAGE(PG8_SB(0, 0), b2, voffA);
            PG8_BAR; PG8_WAIT_L(0); PG8_MMA(0, 1, At, B1); PG8_BAR;
            PG8_LDA(At, 0, 1); PG8_STAGE(PG8_SA(0, 0), a2, voffA);
            PG8_BAR; PG8_WAIT_L(0); PG8_MMA(1, 0, At, B0); PG8_BAR; PG8_SCHED;
            PG8_STAGE(PG8_SB(0, 1), b2 + hstep, voffA);
            PG8_WAIT_V(6); PG8_BAR; PG8_MMA(1, 1, At, B1); PG8_BAR;
            PG8_LDB(B0, 1, 0); PG8_SCHED; PG8_LDA(At, 1, 0); PG8_STAGE(PG8_SA(0, 1), a2 + hstep, voffA);
            PG8_WAIT_L(8); PG8_BAR; PG8_WAIT_L(0); PG8_MMA(0, 0, At, B0); PG8_BAR; PG8_SCHED;
            PG8_LDB(B1, 1, 1); PG8_STAGE(PG8_SB(1, 0), b3, voffA);
            PG8_BAR; PG8_WAIT_L(0); PG8_MMA(0, 1, At, B1); PG8_BAR;
            PG8_LDA(At, 1, 1); PG8_STAGE(PG8_SA(1, 0), a3, voffA);
            PG8_BAR; PG8_WAIT_L(0); PG8_MMA(1, 0, At, B0); PG8_BAR; PG8_SCHED;
            PG8_STAGE(PG8_SB(1, 1), b3 + hstep, voffA);
            PG8_WAIT_V(6); PG8_BAR; PG8_MMA(1, 1, At, B1); PG8_BAR;
        }
        E(acc, cur, wr, wc, fr, fq);
        if (!has_next) break;
#pragma unroll
        for (int a = 0; a < 2; ++a)
#pragma unroll
            for (int b = 0; b < 2; ++b)
#pragma unroll
                for (int m = 0; m < 4; ++m)
#pragma unroll
                    for (int n = 0; n < 2; ++n) acc[a][b][m][n] = (f32x4){0.f, 0.f, 0.f, 0.f};
        cur = nxt; cA = nA; cB = nB; ++ui;
    }
    PG8_WAIT_V(0);
    if (wr == 0) PG8_BAR;
    PG8_BAR;
#undef PG8_SA
#undef PG8_SB
#undef PG8_STAGE
#undef PG8_LDA
#undef PG8_LDB
#undef PG8_MMA
#undef PG8_WAIT_V
#undef PG8_WAIT_L
#undef PG8_BAR
#undef PG8_SCHED
}
}

typedef f32x4 AccT[2][2][4][2];

struct EpiInEven {
    unsigned char* ws; float* out; const float* rstd;
    __device__ __forceinline__ void operator()(const AccT& acc, const pg8::Unit& u, int wr, int wc, int fr, int fq) const {
        const int pn = u.pn;
        bf16_t* base; int ld, coff; float sc = 1.f;
        if (pn < 4) { base = (bf16_t*)(ws + WS_Q); ld = 1024; coff = pn * 256; sc = 0.125f; }
        else if (pn == 4) { base = (bf16_t*)(ws + WS_K); ld = 256; coff = 0; }
        else if (pn == 5) { base = (bf16_t*)(ws + WS_V); ld = 256; coff = 0; }
        else if (pn < 8) { base = (bf16_t*)(ws + WS_BQ); ld = 512; coff = (pn - 6) * 256; sc = 0.08838834764831845f; }
        else if (pn < 10) { base = (bf16_t*)(ws + WS_BK); ld = 512; coff = (pn - 8) * 256; }
        else if (pn < 14) { base = (bf16_t*)(ws + WS_BV); ld = 1024; coff = (pn - 10) * 256; }
        else if (pn < 22) { base = (bf16_t*)(ws + WS_GATE); ld = 2048; coff = (pn - 14) * 256; }
        else { base = nullptr; ld = 0; coff = 0; }
        const int row0 = u.pm * 256 + wr * 64 + fr;
        if (pn == 22) {
            if (wc == 0) {
                float* blr = (float*)(ws + WS_BLR);
#pragma unroll
                for (int ai = 0; ai < 2; ++ai)
#pragma unroll
                    for (int m = 0; m < 4; ++m) { const int row = row0 + ai * 128 + m * 16; const float rs = rstd[row]; *(f32x4*)(blr + (size_t)row * 16 + 4 * fq) = acc[ai][0][m][0] * rs; }
            }
            return;
        }
        const bool kv = (pn == 4 || pn == 5);
        float* okv_p = out + (pn == 4 ? O_KP : O_VP); float* okv_s = out + (pn == 4 ? O_KS : O_VS);
#pragma unroll
        for (int ai = 0; ai < 2; ++ai)
#pragma unroll
            for (int m = 0; m < 4; ++m) {
                const int row = row0 + ai * 128 + m * 16; const float rs = rstd[row] * sc;
                bf16_t* rowp = base + (size_t)row * ld + coff + wc * 32 + 4 * fq;
                float* orow = nullptr;
                if (kv) {
                    if (row >= T_P) orow = okv_s + (size_t)(row - T_P) * 256;
                    else { const int b = row >> 11, t = row & 2047; if (t >= 1920) orow = okv_p + (size_t)(b * 128 + t - 1920) * 256; }
                }
#pragma unroll
                for (int bj = 0; bj < 2; ++bj)
#pragma unroll
                    for (int n = 0; n < 2; ++n) {
                        const f32x4 v = acc[ai][bj][m][n] * rs;
                        u32x2 w; w.x = cvt_pk_bf16(v[0], v[1]); w.y = cvt_pk_bf16(v[2], v[3]);
                        *(u32x2*)(rowp + bj * 128 + n * 16) = w;
                        if (kv && orow) *(f32x4*)(orow + bj * 128 + wc * 32 + n * 16 + 4 * fq) = v;
                    }
            }
    }
};

template <bool WRITE_BF>
struct EpiOutRes {
    const float* xin_p; const float* xin_s; float* xo; bf16_t* xb; float* rowsq;
    __device__ __forceinline__ void operator()(const AccT& acc, const pg8::Unit& u, int wr, int wc, int fr, int fq) const {
        const int row0 = u.pm * 256 + wr * 64 + fr, col0 = u.pn * 256 + wc * 32 + 4 * fq;
#pragma unroll
        for (int ai = 0; ai < 2; ++ai)
#pragma unroll
            for (int m = 0; m < 4; ++m) {
                const int row = row0 + ai * 128 + m * 16;
                const float* xr = (row < T_P) ? xin_p + (size_t)row * 1024 : xin_s + (size_t)(row - T_P) * 1024;
                float ss = 0.f;
#pragma unroll
                for (int bj = 0; bj < 2; ++bj)
#pragma unroll
                    for (int n = 0; n < 2; ++n) {
                        const int col = col0 + bj * 128 + n * 16;
                        const f32x4 v = acc[ai][bj][m][n] + *(const f32x4*)(xr + col);
                        *(f32x4*)(xo + (size_t)row * 1024 + col) = v;
                        if (WRITE_BF) { u32x2 w; w.x = cvt_pk_bf16(v[0], v[1]); w.y = cvt_pk_bf16(v[2], v[3]); *(u32x2*)(xb + (size_t)row * 1024 + col) = w; }
                        ss += v[0] * v[0] + v[1] * v[1] + v[2] * v[2] + v[3] * v[3];
                    }
                ss += __shfl_xor(ss, 16); ss += __shfl_xor(ss, 32);
                if (fq == 0) atomicAdd(rowsq + row, ss);
            }
    }
};

struct EpiInOdd {
    bf16_t* z2; const float* rowsq;
    __device__ __forceinline__ void operator()(const AccT& acc, const pg8::Unit& u, int wr, int wc, int fr, int fq) const {
        const int row0 = u.pm * 256 + wr * 64 + fr, col0 = u.pn * 256 + wc * 32 + 4 * fq;
#pragma unroll
        for (int ai = 0; ai < 2; ++ai)
#pragma unroll
            for (int m = 0; m < 4; ++m) {
                const int row = row0 + ai * 128 + m * 16; const float rs = rsqrtf(rowsq[row] * (1.f / 1024.f) + EPS);
#pragma unroll
                for (int bj = 0; bj < 2; ++bj)
#pragma unroll
                    for (int n = 0; n < 2; ++n) {
                        const f32x4 v = acc[ai][bj][m][n] * rs;
                        u32x2 w; w.x = cvt_pk_bf16(v[0], v[1]); w.y = cvt_pk_bf16(v[2], v[3]);
                        *(u32x2*)(z2 + (size_t)row * 3072 + col0 + bj * 128 + n * 16) = w;
                    }
            }
    }
};

template <int MODE>
__device__ __forceinline__ void transpose_w(const float* __restrict__ src, int K, int Nsrc, bf16_t* __restrict__ dst, int Ndst, const float* __restrict__ gain, long gtid, long gsz) {
    const long total = (long)(K / 8) * Ndst;
    for (long it = gtid; it < total; it += gsz) {
        const int n = (int)(it % Ndst), k8 = (int)(it / Ndst);
        int sc = n;
        if (MODE == 1) { if (n < 3584) sc = n; else if (n < 5632) sc = n + 16; else if (n < 5648) sc = n - 5632 + 3584; else sc = -1; }
        u32x4 w = {0u, 0u, 0u, 0u};
        if (sc >= 0) {
            const float* s = src + (size_t)(k8 * 8) * Nsrc + sc;
            float v0 = s[0], v1 = s[(size_t)Nsrc], v2 = s[(size_t)2 * Nsrc], v3 = s[(size_t)3 * Nsrc], v4 = s[(size_t)4 * Nsrc], v5 = s[(size_t)5 * Nsrc], v6 = s[(size_t)6 * Nsrc], v7 = s[(size_t)7 * Nsrc];
            if (gain) { const f32x4 g0 = *(const f32x4*)(gain + k8 * 8), g1 = *(const f32x4*)(gain + k8 * 8 + 4); v0 *= g0[0]; v1 *= g0[1]; v2 *= g0[2]; v3 *= g0[3]; v4 *= g1[0]; v5 *= g1[1]; v6 *= g1[2]; v7 *= g1[3]; }
            w.x = cvt_pk_bf16(v0, v1); w.y = cvt_pk_bf16(v2, v3); w.z = cvt_pk_bf16(v4, v5); w.w = cvt_pk_bf16(v6, v7);
        }
        *(u32x4*)(dst + (size_t)n * K + k8 * 8) = w;
    }
}

__device__ __forceinline__ void phase0(const Params& p) {
    unsigned char* ws = p.ws;
    const long gtid = (long)blockIdx.x * NTHR + threadIdx.x, gsz = (long)gridDim.x * NTHR;
    transpose_w<1>(p.in[8], 1024, 5648, (bf16_t*)(ws + WS_WINE), NE_PAD, p.in[7], gtid, gsz);
    transpose_w<0>(p.in[13], 2048, 1024, (bf16_t*)(ws + WS_WOUTE), 1024, nullptr, gtid, gsz);
    transpose_w<0>(p.in[15], 1024, 3072, (bf16_t*)(ws + WS_WINO), 3072, p.in[14], gtid, gsz);
    transpose_w<0>(p.in[23], 1536, 1024, (bf16_t*)(ws + WS_WOUTO), 1024, nullptr, gtid, gsz);
    for (int nb = 0; nb < 8; ++nb) {
        transpose_w<0>(p.in[18] + nb * 192 * 192, 192, 192, (bf16_t*)(ws + WS_WA) + nb * 192 * 192, 192, nullptr, gtid, gsz);
        transpose_w<0>(p.in[20] + nb * 192 * 192, 192, 192, (bf16_t*)(ws + WS_WI) + nb * 192 * 192, 192, nullptr, gtid, gsz);
    }
    { float* z = (float*)(ws + WS_RSQ1); const long nz = (long)T * 6; for (long i = gtid; i < nz; i += gsz) z[i] = 0.f; }
    const int lane = threadIdx.x & 63; const int gw = (int)(gtid >> 6), nw = (int)(gsz >> 6);
    bf16_t* xb = (bf16_t*)(ws + WS_XB); float* rstd = (float*)(ws + WS_RSTD0);
    for (int row = gw; row < T; row += nw) {
        const float* xr = (row < T_P) ? p.in[0] + (size_t)row * 1024 : p.in[1] + (size_t)(row - T_P) * 1024;
        float ss = 0.f;
#pragma unroll
        for (int i = 0; i < 4; ++i) {
            const f32x4 v = *(const f32x4*)(xr + i * 256 + lane * 4);
            ss += v[0] * v[0] + v[1] * v[1] + v[2] * v[2] + v[3] * v[3];
            u32x2 w; w.x = cvt_pk_bf16(v[0], v[1]); w.y = cvt_pk_bf16(v[2], v[3]);
            *(u32x2*)(xb + (size_t)row * 1024 + i * 256 + lane * 4) = w;
        }
#pragma unroll
        for (int o = 32; o >= 1; o >>= 1) ss += __shfl_xor(ss, o);
        if (lane == 0) rstd[row] = rsqrtf(ss * (1.f / 1024.f) + EPS);
    }
}

__device__ __forceinline__ void attn_item(const Params& p, LAS unsigned char* L, int item, bf16_t* Yd, int ldd) {
    unsigned char* ws = p.ws;
    const int tid = threadIdx.x, lane = tid & 63, w = tid >> 6, r16 = lane & 15, q4 = lane >> 4;
    LAS bf16_t* Ks = (LAS bf16_t*)L;
    LAS bf16_t* Vt = (LAS bf16_t*)(L + 192 * 72 * 2);
    const bf16_t* Qb = (const bf16_t*)(ws + WS_Q); const bf16_t* Kb = (const bf16_t*)(ws + WS_K); const bf16_t* Vb = (const bf16_t*)(ws + WS_V);
    bf16_t* Yb = (bf16_t*)(ws + WS_GATE);
    const bool smp = item >= 2048;
    int b, c, kh; size_t row0;
    if (!smp) { kh = item & 3; c = (item >> 2) & 31; b = item >> 7; row0 = (size_t)b * 2048 + c * 64; }
    else { const int i2 = item - 2048; kh = i2 & 3; b = i2 >> 2; c = 0; row0 = (size_t)T_P + b * 64; }
#pragma unroll
    for (int i = 0; i < 3; ++i) {
        const int idx = tid + i * 512, key = idx >> 3, dg = idx & 7;
        u32x4 kv = {0u, 0u, 0u, 0u}, vv = {0u, 0u, 0u, 0u};
        if (!smp) {
            const int pos = c * 64 - 128 + key;
            if (pos >= 0) { const size_t r = (size_t)b * 2048 + pos; kv = *(const u32x4*)(Kb + r * 256 + kh * 64 + dg * 8); vv = *(const u32x4*)(Vb + r * 256 + kh * 64 + dg * 8); }
        } else {
            if (key < 128) {
                const size_t o = ((size_t)(b * 128 + key) * 4 + kh) * 64 + dg * 8;
                const f32x4 k0 = *(const f32x4*)(p.in[2] + o), k1 = *(const f32x4*)(p.in[2] + o + 4), v0 = *(const f32x4*)(p.in[3] + o), v1 = *(const f32x4*)(p.in[3] + o + 4);
                kv.x = cvt_pk_bf16(k0[0], k0[1]); kv.y = cvt_pk_bf16(k0[2], k0[3]); kv.z = cvt_pk_bf16(k1[0], k1[1]); kv.w = cvt_pk_bf16(k1[2], k1[3]);
                vv.x = cvt_pk_bf16(v0[0], v0[1]); vv.y = cvt_pk_bf16(v0[2], v0[3]); vv.z = cvt_pk_bf16(v1[0], v1[1]); vv.w = cvt_pk_bf16(v1[2], v1[3]);
            } else { const size_t r = (size_t)T_P + b * 64 + key - 128; kv = *(const u32x4*)(Kb + r * 256 + kh * 64 + dg * 8); vv = *(const u32x4*)(Vb + r * 256 + kh * 64 + dg * 8); }
        }
        *(LAS u32x4*)(Ks + key * 72 + dg * 8) = kv;
#pragma unroll
        for (int e = 0; e < 8; ++e) Vt[(dg * 8 + e) * 200 + key] = (bf16_t)(vv[e >> 1] >> ((e & 1) * 16));
    }
    __syncthreads();
    const int g = w >> 1, i0 = (w & 1) * 32, h = kh * 4 + g;
    const float slope = exp2f(-0.5f * (float)(h + 1));
    const float sink = p.in[11][h];
#pragma unroll 1
    for (int qt = 0; qt < 2; ++qt) {
        const int i = i0 + qt * 16 + r16;
        bf16x8 qf[2];
#pragma unroll
        for (int ks = 0; ks < 2; ++ks) qf[ks] = *(const bf16x8*)(Qb + (row0 + i) * 1024 + h * 64 + ks * 32 + q4 * 8);
        f32x4 sacc[12];
#pragma unroll
        for (int kt = 0; kt < 12; ++kt) {
            const bf16x8 kf0 = *(const LAS bf16x8*)(Ks + (kt * 16 + r16) * 72 + q4 * 8), kf1 = *(const LAS bf16x8*)(Ks + (kt * 16 + r16) * 72 + 32 + q4 * 8);
            f32x4 a = {0.f, 0.f, 0.f, 0.f}; a = MFMA16(kf0, qf[0], a); a = MFMA16(kf1, qf[1], a); sacc[kt] = a;
        }
        float m = -3e38f;
#pragma unroll
        for (int kt = 0; kt < 12; ++kt)
#pragma unroll
            for (int jj = 0; jj < 4; ++jj) {
                const int j = kt * 16 + q4 * 4 + jj;
                float sv = sacc[kt][jj] - slope * fabsf((float)(128 + i - j));
                if (!smp && (c * 64 - 128 + j) < 0) sv = -1e30f;
                sacc[kt][jj] = sv; m = fmaxf(m, sv);
            }
        m = fmaxf(m, __shfl_xor(m, 16)); m = fmaxf(m, __shfl_xor(m, 32)); m = fmaxf(m, sink);
        float l = 0.f;
#pragma unroll
        for (int kt = 0; kt < 12; ++kt)
#pragma unroll
            for (int jj = 0; jj < 4; ++jj) { const float pr = __expf(sacc[kt][jj] - m); sacc[kt][jj] = pr; l += pr; }
        l += __shfl_xor(l, 16); l += __shfl_xor(l, 32); l += __expf(sink - m);
        const float inv = 1.f / l;
        f32x4 oacc[4];
#pragma unroll
        for (int dt = 0; dt < 4; ++dt) oacc[dt] = (f32x4){0.f, 0.f, 0.f, 0.f};
#pragma unroll
        for (int kb = 0; kb < 6; ++kb) {
            const bf16x8 pf = pack8(sacc[2 * kb], sacc[2 * kb + 1]);
#pragma unroll
            for (int dt = 0; dt < 4; ++dt) {
                const LAS bf16_t* vp = Vt + (dt * 16 + r16) * 200 + kb * 32 + q4 * 4;
                const bf16x8 vf = cat4(*(const LAS bf16x4*)vp, *(const LAS bf16x4*)(vp + 16));
                oacc[dt] = MFMA16(vf, pf, oacc[dt]);
            }
        }
#pragma unroll
        for (int dt = 0; dt < 4; ++dt) {
            const size_t off = (row0 + i) * 2048 + h * 64 + dt * 16 + q4 * 4;
            const u32x2 gv = *(const u32x2*)(Yb + off);
            const f32x4 o = oacc[dt] * inv;
            u32x2 wv; wv.x = cvt_pk_bf16(o[0] * siluf(bflo(gv.x)), o[1] * siluf(bfhi(gv.x))); wv.y = cvt_pk_bf16(o[2] * siluf(bflo(gv.y)), o[3] * siluf(bfhi(gv.y)));
            *(u32x2*)(Yd + (row0 + i) * ldd + h * 64 + dt * 16 + q4 * 4) = wv;
        }
    }
    __syncthreads();
}

__device__ __forceinline__ void gla_item(const Params& p, LAS unsigned char* L, int item) {
    unsigned char* ws = p.ws;
    const int tid = threadIdx.x, lane = tid & 63, w = tid >> 6, r16 = lane & 15, q4 = lane >> 4;
    LAS bf16_t* QG = (LAS bf16_t*)L;
    LAS bf16_t* KG = (LAS bf16_t*)(L + 17408);
    LAS bf16_t* KDt = (LAS bf16_t*)(L + 34816);
    LAS bf16_t* Vt = (LAS bf16_t*)(L + 53248);
    LAS float* BLRs = (LAS float*)(L + 62464);
    LAS float* GT = (LAS float*)(L + 66560);
    LAS float* GL = (LAS float*)(L + 68608);
    const bool smp = item >= 256;
    const int i2 = smp ? item - 256 : item;
    const int b = i2 >> 4, h = (i2 >> 2) & 3, sl = i2 & 3, e0 = sl * 64;
    const int nch = smp ? 1 : 32;
    const size_t rbase = smp ? (size_t)T_P + b * 64 : (size_t)b * 2048;
    const bf16_t* BQ = (const bf16_t*)(ws + WS_BQ); const bf16_t* BKb = (const bf16_t*)(ws + WS_BK); bf16_t* BV = (bf16_t*)(ws + WS_BV);
    const float* BLR = (const float*)(ws + WS_BLR); float* BOSQ = (float*)(ws + WS_BOSQ);
    const int c = tid & 127, tg = tid >> 7;
    float wl[16];
#pragma unroll
    for (int r = 0; r < 16; ++r) wl[r] = p.in[9][r * 512 + h * 128 + c];
    const float bl = p.in[10][h * 128 + c];
    const int et = w & 3, ip = w >> 2;
    f32x4 Sacc[8];
#pragma unroll
    for (int d8 = 0; d8 < 8; ++d8) {
        if (smp) {
#pragma unroll
            for (int jj = 0; jj < 4; ++jj) Sacc[d8][jj] = p.in[4][((size_t)(b * 4 + h) * 128 + d8 * 16 + q4 * 4 + jj) * 256 + e0 + et * 16 + r16];
        } else Sacc[d8] = (f32x4){0.f, 0.f, 0.f, 0.f};
    }
    f32x4 pblr = {0.f, 0.f, 0.f, 0.f}; u32x4 pv; bf16_t pq[16], pk[16];
    {
        if (tid < 256) pblr = *(const f32x4*)(BLR + rbase * 16 + tid * 4);
        pv = *(const u32x4*)(BV + (rbase + (tid >> 3)) * 1024 + h * 256 + e0 + (tid & 7) * 8);
#pragma unroll
        for (int tt = 0; tt < 16; ++tt) { const size_t r = rbase + tg * 16 + tt; pq[tt] = BQ[r * 512 + h * 128 + c]; pk[tt] = BKb[r * 512 + h * 128 + c]; }
    }
    for (int ci = 0; ci < nch; ++ci) {
        const size_t r0 = rbase + (size_t)ci * 64;
        const bool more = (ci + 1 < nch);
        if (tid < 256) *(LAS f32x4*)(BLRs + tid * 4) = pblr;
        {
            const int t = tid >> 3, eg = tid & 7;
#pragma unroll
            for (int e = 0; e < 8; ++e) Vt[(eg * 8 + e) * 72 + t] = (bf16_t)(pv[e >> 1] >> ((e & 1) * 16));
        }
        lds_barrier();
        if (more) {
            if (tid < 256) pblr = *(const f32x4*)(BLR + (r0 + 64) * 16 + tid * 4);
            pv = *(const u32x4*)(BV + (r0 + 64 + (tid >> 3)) * 1024 + h * 256 + e0 + (tid & 7) * 8);
        }
        float gl[16]; float cs = 0.f;
#pragma unroll
        for (int tt = 0; tt < 16; ++tt) {
            const int t = tg * 16 + tt;
            float x = bl;
#pragma unroll
            for (int r4 = 0; r4 < 4; ++r4) { const f32x4 bv = *(const LAS f32x4*)(BLRs + t * 16 + r4 * 4); x += bv[0] * wl[r4 * 4] + bv[1] * wl[r4 * 4 + 1] + bv[2] * wl[r4 * 4 + 2] + bv[3] * wl[r4 * 4 + 3]; }
            const float gg = (fminf(x, 0.f) - __logf(1.f + __expf(-fabsf(x)))) * (1.f / 16.f);
            cs += gg; gl[tt] = cs;
        }
        GT[tg * 128 + c] = cs;
        lds_barrier();
        float pre = 0.f, tot = 0.f;
#pragma unroll
        for (int g2 = 0; g2 < 4; ++g2) { const float v = GT[g2 * 128 + c]; if (g2 < tg) pre += v; tot += v; }
        const float etot = __expf(tot);
        if (tg == 0) GL[c] = etot;
#pragma unroll
        for (int tt = 0; tt < 16; ++tt) {
            const int t = tg * 16 + tt; const float G = pre + gl[tt];
            const float qv = bf2f(pq[tt]), kv = bf2f(pk[tt]);
            const float eg = __expf(G), ieg = rcpf_(eg), kgv = kv * ieg;
            QG[t * 136 + c] = f2bf(qv * eg); KG[t * 136 + c] = f2bf(kgv); KDt[c * 72 + t] = f2bf(kgv * etot);
        }
        if (more) {
#pragma unroll
            for (int tt = 0; tt < 16; ++tt) { const size_t r = r0 + 64 + tg * 16 + tt; pq[tt] = BQ[r * 512 + h * 128 + c]; pk[tt] = BKb[r * 512 + h * 128 + c]; }
        }
        lds_barrier();
        f32x4 at[4][2];
#pragma unroll
        for (int jt = 0; jt < 4; ++jt)
#pragma unroll
            for (int x2 = 0; x2 < 2; ++x2) at[jt][x2] = (f32x4){0.f, 0.f, 0.f, 0.f};
#pragma unroll
        for (int ks = 0; ks < 4; ++ks) {
            bf16x8 qf[2];
#pragma unroll
            for (int x2 = 0; x2 < 2; ++x2) qf[x2] = *(const LAS bf16x8*)(QG + ((ip * 2 + x2) * 16 + r16) * 136 + ks * 32 + q4 * 8);
#pragma unroll
            for (int jt = 0; jt < 4; ++jt) {
                const bf16x8 kf = *(const LAS bf16x8*)(KG + (jt * 16 + r16) * 136 + ks * 32 + q4 * 8);
#pragma unroll
                for (int x2 = 0; x2 < 2; ++x2) at[jt][x2] = MFMA16(kf, qf[x2], at[jt][x2]);
            }
        }
#pragma unroll
        for (int jt = 0; jt < 4; ++jt)
#pragma unroll
            for (int x2 = 0; x2 < 2; ++x2)
#pragma unroll
                for (int jj = 0; jj < 4; ++jj) { const int j = jt * 16 + q4 * 4 + jj, i = (ip * 2 + x2) * 16 + r16; if (j > i) at[jt][x2][jj] = 0.f; }
        f32x4 ot[2];
        ot[0] = (f32x4){0.f, 0.f, 0.f, 0.f}; ot[1] = (f32x4){0.f, 0.f, 0.f, 0.f};
#pragma unroll
        for (int jb = 0; jb < 2; ++jb) {
            const LAS bf16_t* vp = Vt + (et * 16 + r16) * 72 + jb * 32 + q4 * 4;
            const bf16x8 vf = cat4(*(const LAS bf16x4*)vp, *(const LAS bf16x4*)(vp + 16));
#pragma unroll
            for (int x2 = 0; x2 < 2; ++x2) { const bf16x8 pf = pack8(at[2 * jb][x2], at[2 * jb + 1][x2]); ot[x2] = MFMA16(vf, pf, ot[x2]); }
        }
#pragma unroll
        for (int db = 0; db < 4; ++db) {
            const bf16x8 sf = pack8(Sacc[2 * db], Sacc[2 * db + 1]);
#pragma unroll
            for (int x2 = 0; x2 < 2; ++x2) {
                const LAS bf16_t* qp = QG + ((ip * 2 + x2) * 16 + r16) * 136 + db * 32 + q4 * 4;
                const bf16x8 qv = cat4(*(const LAS bf16x4*)qp, *(const LAS bf16x4*)(qp + 16));
                ot[x2] = MFMA16(sf, qv, ot[x2]);
            }
        }
#pragma unroll
        for (int x2 = 0; x2 < 2; ++x2) {
            const size_t row = r0 + (ip * 2 + x2) * 16 + r16;
            const f32x4 o = ot[x2];
            u32x2 wv; wv.x = cvt_pk_bf16(o[0], o[1]); wv.y = cvt_pk_bf16(o[2], o[3]);
            *(u32x2*)(BV + row * 1024 + h * 256 + e0 + et * 16 + q4 * 4) = wv;
            float ss = o[0] * o[0] + o[1] * o[1] + o[2] * o[2] + o[3] * o[3];
            ss += __shfl_xor(ss, 16); ss += __shfl_xor(ss, 32);
            if (q4 == 0) atomicAdd(BOSQ + row * 4 + h, ss);
        }
#pragma unroll
        for (int d8 = 0; d8 < 8; ++d8) {
            const f32x4 dec = *(const LAS f32x4*)(GL + d8 * 16 + q4 * 4);
            Sacc[d8] = Sacc[d8] * dec;
        }
#pragma unroll
        for (int jb = 0; jb < 2; ++jb) {
            const bf16x8 vf = *(const LAS bf16x8*)(Vt + (et * 16 + r16) * 72 + jb * 32 + q4 * 8);
#pragma unroll
            for (int d8 = 0; d8 < 8; ++d8) {
                const bf16x8 kf = *(const LAS bf16x8*)(KDt + (d8 * 16 + r16) * 72 + jb * 32 + q4 * 8);
                Sacc[d8] = MFMA16(kf, vf, Sacc[d8]);
            }
        }
        lds_barrier();
    }
    if (ip == 0) {
        float* og = p.out + (smp ? O_GS : O_GP);
#pragma unroll
        for (int d8 = 0; d8 < 8; ++d8)
#pragma unroll
            for (int jj = 0; jj < 4; ++jj) og[((size_t)(b * 4 + h) * 128 + d8 * 16 + q4 * 4 + jj) * 256 + e0 + et * 16 + r16] = Sacc[d8][jj];
    }
}

__device__ __forceinline__ void phase2(const Params& p, LAS unsigned char* L) {
    for (int it = blockIdx.x; it < 768; it += gridDim.x) gla_item(p, L, it);
#ifdef PROBE_ATTN2
    for (int it = blockIdx.x; it < 2176; it += gridDim.x) attn_item(p, L, it, (bf16_t*)(p.ws + WS_XB), 1024);
#endif
    for (int it = blockIdx.x; it < 2176; it += gridDim.x) attn_item(p, L, it, (bf16_t*)(p.ws + WS_GATE), 2048);
}

__device__ __forceinline__ void phase3(const Params& p) {
    unsigned char* ws = p.ws;
    const bf16_t* BV = (const bf16_t*)(ws + WS_BV); bf16_t* Yb = (bf16_t*)(ws + WS_GATE); const float* BOSQ = (const float*)(ws + WS_BOSQ);
    const float* gg = p.in[12];
    const long gtid = (long)blockIdx.x * NTHR + threadIdx.x, gsz = (long)gridDim.x * NTHR;
    const long total = (long)T * 128;
    for (long it = gtid; it < total; it += gsz) {
        const long row = it >> 7; const int c8 = (int)(it & 127) * 8, h = c8 >> 8;
        const float rs = rsqrtf(BOSQ[row * 4 + h] * (1.f / 256.f) + EPS);
        const u32x4 bo = *(const u32x4*)(BV + row * 1024 + c8);
        const u32x4 gt = *(const u32x4*)(Yb + row * 2048 + 1024 + c8);
        const f32x4 g0 = *(const f32x4*)(gg + (c8 & 255)), g1 = *(const f32x4*)(gg + (c8 & 255) + 4);
        u32x4 o;
        o.x = cvt_pk_bf16(bflo(bo.x) * rs * g0[0] * siluf(bflo(gt.x)), bfhi(bo.x) * rs * g0[1] * siluf(bfhi(gt.x)));
        o.y = cvt_pk_bf16(bflo(bo.y) * rs * g0[2] * siluf(bflo(gt.y)), bfhi(bo.y) * rs * g0[3] * siluf(bfhi(gt.y)));
        o.z = cvt_pk_bf16(bflo(bo.z) * rs * g1[0] * siluf(bflo(gt.z)), bfhi(bo.z) * rs * g1[1] * siluf(bfhi(gt.z)));
        o.w = cvt_pk_bf16(bflo(bo.w) * rs * g1[2] * siluf(bflo(gt.w)), bfhi(bo.w) * rs * g1[3] * siluf(bfhi(gt.w)));
        *(u32x4*)(Yb + row * 2048 + 1024 + c8) = o;
    }
}

__device__ __forceinline__ void unpack8(const u32x4 w, float (&v)[8]) { v[0] = bflo(w.x); v[1] = bfhi(w.x); v[2] = bflo(w.y); v[3] = bfhi(w.y); v[4] = bflo(w.z); v[5] = bfhi(w.z); v[6] = bflo(w.w); v[7] = bfhi(w.w); }
__device__ __forceinline__ void lru_item(const Params& p, LAS unsigned char* L, int item) {
    unsigned char* ws = p.ws;
    const int tid = threadIdx.x, lane = tid & 63, w = tid >> 6, r16 = lane & 15, q4 = lane >> 4;
    LAS bf16_t* Wl = (LAS bf16_t*)L;
    LAS bf16_t* U = (LAS bf16_t*)(L + 76800);
    LAS float* Aa = (LAS float*)(L + 102400);
    LAS float* Bb = (LAS float*)(L + 126976);
    LAS float* SP = (LAS float*)(L + 151552);
    LAS float* SH = (LAS float*)(L + 153088);
    LAS float* HC = (LAS float*)(L + 154624);
    LAS float* CW = (LAS float*)(L + 155392);
    const bool smp = item >= 256;
    const int i2 = smp ? item - 256 : item;
    const int b = i2 >> 4, nb = (i2 >> 1) & 7, hf = i2 & 1;
    const int nch = smp ? 1 : 32;
    const unsigned rbase = smp ? (unsigned)T_P + b * 64 : (unsigned)b * 2048;
    const bf16_t* Z2 = (const bf16_t*)(ws + WS_Z2); bf16_t* Y2 = (bf16_t*)(ws + WS_Y2);
    const bf16_t* WA = (const bf16_t*)(ws + WS_WA) + nb * 192 * 192; const bf16_t* WI = (const bf16_t*)(ws + WS_WI) + nb * 192 * 192;
    for (int idx = tid; idx < 192 * 24; idx += NTHR) {
        const int r = idx / 24, g8 = idx % 24;
        const bf16_t* src = (r < 96) ? WA + (size_t)(hf * 96 + r) * 192 + g8 * 8 : WI + (size_t)(hf * 96 + r - 96) * 192 + g8 * 8;
        *(LAS u32x4*)(Wl + r * 200 + g8 * 8) = *(const u32x4*)src;
    }
    const bool cthr = tid < 384;
    const int cgp = tid % 24, tq = (tid / 24) & 15;
    const int chc = nb * 192 + cgp * 8;
    for (int idx = tid; idx < 5 * 192; idx += NTHR) { const int j = idx / 192, cc = idx % 192; CW[idx] = (j < 4) ? p.in[16][j * 1536 + nb * 192 + cc] : p.in[17][nb * 192 + cc]; }
    const int mt = w & 3, pg = w >> 2;
    float bra[3], bri[3], sp[3];
#pragma unroll
    for (int cp = 0; cp < 3; ++cp) {
        const int ch = nb * 192 + hf * 96 + (pg * 3 + cp) * 16 + r16;
        bra[cp] = p.in[19][ch]; bri[cp] = p.in[21][ch];
        const float lam = p.in[22][ch];
        sp[cp] = 8.f * (fmaxf(-lam, 0.f) + log1pf(__expf(-fabsf(lam))));
    }
    if (tid < 96) HC[tid] = smp ? p.in[6][b * 1536 + nb * 192 + hf * 96 + tid] : 0.f;
    const int sch0 = tid % 96, sseg0 = (tid / 96) & 3;
    const int ot0 = tid / 12, og0 = tid % 12, ot1 = (tid + 512) / 12, og1 = (tid + 512) % 12;
    const bool o1 = tid < 256;
    const int och0 = nb * 192 + hf * 96 + og0 * 8, och1 = nb * 192 + hf * 96 + og1 * 8;
    lds_barrier();
    u32x4 xr[7]; u32x4 pg0, pg1 = {0u, 0u, 0u, 0u};
#pragma unroll
    for (int r = 0; r < 7; ++r) {
        xr[r] = (u32x4){0u, 0u, 0u, 0u};
        const int pos = 4 * tq - 3 + r;
        if (cthr) {
            if (pos >= 0) xr[r] = *(const u32x4*)(Z2 + (unsigned)((rbase + pos) * 3072u + chc));
            else if (smp) {
                const float* hp = p.in[5] + ((size_t)b * 3 + (3 + pos)) * 1536 + chc;
                const f32x4 h0 = *(const f32x4*)hp, h1 = *(const f32x4*)(hp + 4);
                xr[r].x = cvt_pk_bf16(h0[0], h0[1]); xr[r].y = cvt_pk_bf16(h0[2], h0[3]); xr[r].z = cvt_pk_bf16(h1[0], h1[1]); xr[r].w = cvt_pk_bf16(h1[2], h1[3]);
            }
        }
    }
    pg0 = *(const u32x4*)(Z2 + (unsigned)((rbase + ot0) * 3072u + 1536 + och0));
    if (o1) pg1 = *(const u32x4*)(Z2 + (unsigned)((rbase + ot1) * 3072u + 1536 + och1));
    for (int ci = 0; ci < nch; ++ci) {
        const unsigned r0 = rbase + (unsigned)ci * 64;
        const bool more = (ci + 1 < nch);
        int sch = sch0, sseg = sseg0;
        asm volatile("" : "+v"(sch), "+v"(sseg));
        if (cthr) {
            float xv[7][8];
#pragma unroll
            for (int r = 0; r < 7; ++r) unpack8(xr[r], xv[r]);
            if (hf == 0 && !more && tq == 15) {
                float* oc = p.out + (smp ? O_CS : O_CP) + (size_t)b * 3 * 1536 + chc;
#pragma unroll
                for (int r = 0; r < 3; ++r) { *(f32x4*)(oc + r * 1536) = (f32x4){xv[4 + r][0], xv[4 + r][1], xv[4 + r][2], xv[4 + r][3]}; *(f32x4*)(oc + r * 1536 + 4) = (f32x4){xv[4 + r][4], xv[4 + r][5], xv[4 + r][6], xv[4 + r][7]}; }
            }
            float cw[5][8];
#pragma unroll
            for (int j = 0; j < 5; ++j) { const f32x4 c0 = *(const LAS f32x4*)(CW + j * 192 + cgp * 8), c1 = *(const LAS f32x4*)(CW + j * 192 + cgp * 8 + 4);
                cw[j][0] = c0[0]; cw[j][1] = c0[1]; cw[j][2] = c0[2]; cw[j][3] = c0[3]; cw[j][4] = c1[0]; cw[j][5] = c1[1]; cw[j][6] = c1[2]; cw[j][7] = c1[3]; }
#pragma unroll
            for (int tk = 0; tk < 4; ++tk) {
                float acc[8];
#pragma unroll
                for (int e = 0; e < 8; ++e) acc[e] = cw[4][e] + xv[tk][e] * cw[0][e] + xv[tk + 1][e] * cw[1][e] + xv[tk + 2][e] * cw[2][e] + xv[tk + 3][e] * cw[3][e];
                u32x4 uw; uw.x = cvt_pk_bf16(acc[0], acc[1]); uw.y = cvt_pk_bf16(acc[2], acc[3]); uw.z = cvt_pk_bf16(acc[4], acc[5]); uw.w = cvt_pk_bf16(acc[6], acc[7]);
                *(LAS u32x4*)(U + (4 * tq + tk) * 200 + cgp * 8) = uw;
            }
            if (more) {
#pragma unroll
                for (int r = 0; r < 7; ++r) xr[r] = *(const u32x4*)(Z2 + (unsigned)((r0 + 64 + 4 * tq - 3 + r) * 3072u + chc));
            }
        }
        lds_barrier();
        f32x4 ga[3], gi[3];
#pragma unroll
        for (int cp = 0; cp < 3; ++cp) { ga[cp] = (f32x4){0.f, 0.f, 0.f, 0.f}; gi[cp] = (f32x4){0.f, 0.f, 0.f, 0.f}; }
#pragma unroll 2
        for (int ks = 0; ks < 6; ++ks) {
            const bf16x8 uf = *(const LAS bf16x8*)(U + (mt * 16 + r16) * 200 + ks * 32 + q4 * 8);
#pragma unroll
            for (int cp = 0; cp < 3; ++cp) {
                const int ct = pg * 3 + cp;
                const bf16x8 wa = *(const LAS bf16x8*)(Wl + (ct * 16 + r16) * 200 + ks * 32 + q4 * 8), wi = *(const LAS bf16x8*)(Wl + (96 + ct * 16 + r16) * 200 + ks * 32 + q4 * 8);
                ga[cp] = MFMA16(uf, wa, ga[cp]); gi[cp] = MFMA16(uf, wi, gi[cp]);
            }
        }
#pragma unroll
        for (int cp = 0; cp < 3; ++cp) {
            const int cl = (pg * 3 + cp) * 16 + r16;
#pragma unroll
            for (int jj = 0; jj < 4; ++jj) {
                const int t = mt * 16 + q4 * 4 + jj;
                const float rg = sigmf(ga[cp][jj] + bra[cp]), ig = sigmf(gi[cp][jj] + bri[cp]);
                const float z = rg * sp[cp];
                const float a = __expf(-z);
                const float z2 = z + z;
                const float om = (z2 < 0.05f) ? z2 * (1.f - z2 * (0.5f - z2 * (0.16666667f - z2 * 0.041666668f))) : 1.f - a * a;
                const float uu = bf2f(U[t * 200 + hf * 96 + cl]);
                Aa[t * 96 + cl] = a; Bb[t * 96 + cl] = __builtin_amdgcn_sqrtf(om) * ig * uu;
            }
        }
        lds_barrier();
        if (cthr) {
            float P = 1.f, H = 0.f;
#pragma unroll
            for (int t = 0; t < 16; ++t) { const float a = Aa[(sseg * 16 + t) * 96 + sch]; H = a * H + Bb[(sseg * 16 + t) * 96 + sch]; P *= a; }
            SP[sseg * 96 + sch] = P; SH[sseg * 96 + sch] = H;
        }
        lds_barrier();
        if (cthr) {
            float hh = HC[(ci & 1) * 96 + sch];
#pragma unroll
            for (int sg = 0; sg < 3; ++sg) if (sg < sseg) hh = SP[sg * 96 + sch] * hh + SH[sg * 96 + sch];
#pragma unroll
            for (int t = 0; t < 16; ++t) { hh = Aa[(sseg * 16 + t) * 96 + sch] * hh + Bb[(sseg * 16 + t) * 96 + sch]; Bb[(sseg * 16 + t) * 96 + sch] = hh; }
            if (sseg == 3) HC[((ci + 1) & 1) * 96 + sch] = hh;
        }
        lds_barrier();
        {
            const f32x4 h0 = *(const LAS f32x4*)(Bb + ot0 * 96 + og0 * 8), h1 = *(const LAS f32x4*)(Bb + ot0 * 96 + og0 * 8 + 4);
            u32x4 o;
            o.x = cvt_pk_bf16(h0[0] * siluf(bflo(pg0.x)), h0[1] * siluf(bfhi(pg0.x)));
            o.y = cvt_pk_bf16(h0[2] * siluf(bflo(pg0.y)), h0[3] * siluf(bfhi(pg0.y)));
            o.z = cvt_pk_bf16(h1[0] * siluf(bflo(pg0.z)), h1[1] * siluf(bfhi(pg0.z)));
            o.w = cvt_pk_bf16(h1[2] * siluf(bflo(pg0.w)), h1[3] * siluf(bfhi(pg0.w)));
            *(u32x4*)(Y2 + (unsigned)((r0 + ot0) * 1536u + och0)) = o;
            if (more) pg0 = *(const u32x4*)(Z2 + (unsigned)((r0 + 64 + ot0) * 3072u + 1536 + och0));
        }
        if (o1) {
            const f32x4 h0 = *(const LAS f32x4*)(Bb + ot1 * 96 + og1 * 8), h1 = *(const LAS f32x4*)(Bb + ot1 * 96 + og1 * 8 + 4);
            u32x4 o;
            o.x = cvt_pk_bf16(h0[0] * siluf(bflo(pg1.x)), h0[1] * siluf(bfhi(pg1.x)));
            o.y = cvt_pk_bf16(h0[2] * siluf(bflo(pg1.y)), h0[3] * siluf(bfhi(pg1.y)));
            o.z = cvt_pk_bf16(h1[0] * siluf(bflo(pg1.z)), h1[1] * siluf(bfhi(pg1.z)));
            o.w = cvt_pk_bf16(h1[2] * siluf(bflo(pg1.w)), h1[3] * siluf(bfhi(pg1.w)));
            *(u32x4*)(Y2 + (unsigned)((r0 + ot1) * 1536u + och1)) = o;
            if (more) pg1 = *(const u32x4*)(Z2 + (unsigned)((r0 + 64 + ot1) * 3072u + 1536 + och1));
        }
        lds_barrier();
    }
    if (tid < 96) p.out[(smp ? O_LS : O_LP) + (size_t)b * 1536 + nb * 192 + hf * 96 + tid] = HC[(nch & 1) * 96 + tid];
    lds_barrier();
}

__device__ __forceinline__ void phase6(const Params& p, LAS unsigned char* L) {
    for (int it = blockIdx.x; it < 768; it += gridDim.x) lru_item(p, L, it);
}

__device__ __forceinline__ void phase8(const Params& p) {
    const float* rsq = (const float*)(p.ws + WS_RSQ2); const float* g = p.in[24]; float* y = p.out;
    const long gtid = (long)blockIdx.x * NTHR + threadIdx.x, gsz = (long)gridDim.x * NTHR;
    const long total = (long)T * 256;
    for (long it = gtid; it < total; it += gsz) {
        const long row = it >> 8; const int c4 = (int)(it & 255) * 4;
        const float rs = rsqrtf(rsq[row] * (1.f / 1024.f) + EPS);
        const f32x4 v = *(const f32x4*)(y + row * 1024 + c4), gv = *(const f32x4*)(g + c4);
        *(f32x4*)(y + row * 1024 + c4) = v * rs * gv;
    }
}

__global__ void __launch_bounds__(NTHR) mega(Params p) {
    extern __shared__ __attribute__((aligned(16))) unsigned char lds_raw[];
    LAS unsigned char* L = (LAS unsigned char*)lds_raw;
    cg::grid_group grid = cg::this_grid();
    unsigned char* ws = p.ws;
    const int lo = p.ph_lo, hi = p.ph_hi;
#ifndef PHMASK
#define PHMASK 0x1ff
#endif
#define IN(k) (((PHMASK >> (k)) & 1) && lo <= (k) && (k) < hi)
#define SEAM(k) do { if (IN(k) && IN((k) + 1)) grid.sync(); } while (0)
    if (IN(0)) phase0(p);
    SEAM(0);
    if (IN(1)) {
        pg8::Gemm g{(const bf16_t*)(ws + WS_XB), (const bf16_t*)(ws + WS_WINE), T, NE_PAD, 1024};
        pg8::StaticOrder S; S.init(T, NE_PAD, gridDim.x, blockIdx.x);
        EpiInEven E{ws, p.out, (const float*)(ws + WS_RSTD0)};
        pg8::gemm_phase<EpiInEven>(L, g, S, E);
    }
    SEAM(1);
    if (IN(2)) phase2(p, L);
    SEAM(2);
    if (IN(3)) phase3(p);
    SEAM(3);
    if (IN(4)) {
        pg8::Gemm g{(const bf16_t*)(ws + WS_GATE), (const bf16_t*)(ws + WS_WOUTE), T, 1024, 2048};
        pg8::StaticOrder S; S.init(T, 1024, gridDim.x, blockIdx.x);
        EpiOutRes<true> E{p.in[0], p.in[1], p.out, (bf16_t*)(ws + WS_XB), (float*)(ws + WS_RSQ1)};
        pg8::gemm_phase<EpiOutRes<true>>(L, g, S, E);
    }
    SEAM(4);
    if (IN(5)) {
        pg8::Gemm g{(const bf16_t*)(ws + WS_XB), (const bf16_t*)(ws + WS_WINO), T, 3072, 1024};
        pg8::StaticOrder S; S.init(T, 3072, gridDim.x, blockIdx.x);
        EpiInOdd E{(bf16_t*)(ws + WS_Z2), (const float*)(ws + WS_RSQ1)};
        pg8::gemm_phase<EpiInOdd>(L, g, S, E);
    }
    SEAM(5);
    if (IN(6)) phase6(p, L);
    SEAM(6);
    if (IN(7)) {
        pg8::Gemm g{(const bf16_t*)(ws + WS_Y2), (const bf16_t*)(ws + WS_WOUTO), T, 1024, 1536};
        pg8::StaticOrder S; S.init(T, 1024, gridDim.x, blockIdx.x);
        EpiOutRes<false> E{p.out, p.out + (size_t)T_P * 1024, p.out, nullptr, (float*)(ws + WS_RSQ2)};
        pg8::gemm_phase<EpiOutRes<false>>(L, g, S, E);
    }
    SEAM(7);
    if (IN(8)) phase8(p);
#undef IN
#undef SEAM
}

extern "C" void kernel_launch(void* const* d_in, const int* in_sizes, int n_in, void* d_out, int out_size, void* d_ws, size_t ws_size, hipStream_t stream) {
    static int grid_blocks = 0;
    if (grid_blocks == 0) {
        if (n_in != 25 || (size_t)out_size != O_END || ws_size < WS_END) { fprintf(stderr, "kernel_launch: unexpected shapes n_in %d out %d ws %zu (need %zu)\n", n_in, out_size, ws_size, (size_t)WS_END); grid_blocks = -1; return; }
        int dev = 0, cus = 0, per_cu = 0;
        (void)hipGetDevice(&dev);
        (void)hipDeviceGetAttribute(&cus, hipDeviceAttributeMultiprocessorCount, dev);
        if (hipFuncSetAttribute((const void*)mega, hipFuncAttributeMaxDynamicSharedMemorySize, LDS_BYTES) != hipSuccess) { fprintf(stderr, "kernel_launch: hipFuncSetAttribute failed\n"); }
        if (hipOccupancyMaxActiveBlocksPerMultiprocessor(&per_cu, (const void*)mega, NTHR, LDS_BYTES) != hipSuccess || per_cu < 1) per_cu = 1;
        (void)hipGetLastError();
        grid_blocks = cus * per_cu;
        if (grid_blocks <= 0) grid_blocks = 256;
    }
    if (grid_blocks < 0) return;
    Params p{};
    for (int i = 0; i < 25; ++i) p.in[i] = (const float*)d_in[i];
    p.out = (float*)d_out; p.ws = (unsigned char*)d_ws;
#if ONE_LAUNCH
#ifdef PROBE_X
    { const int seq[3][2] = {{0, PROBE_Y + 1}, {PROBE_X, PROBE_Y + 1}, {PROBE_Y + 1, 9}};
      for (int li = 0; li < 3; ++li) { if (seq[li][0] >= seq[li][1]) continue; p.ph_lo = seq[li][0]; p.ph_hi = seq[li][1]; void* args[] = {&p};
        hipError_t e = hipLaunchCooperativeKernel((const void*)mega, dim3(grid_blocks), dim3(NTHR), args, LDS_BYTES, stream);
        if (e != hipSuccess) fprintf(stderr, "cooperative launch failed: %s (grid %d)\n", hipGetErrorString(e), grid_blocks); } }
#else
    p.ph_lo = 0; p.ph_hi = 9;
    { void* args[] = {&p}; hipError_t e = hipLaunchCooperativeKernel((const void*)mega, dim3(grid_blocks), dim3(NTHR), args, LDS_BYTES, stream);
      if (e != hipSuccess) fprintf(stderr, "cooperative launch failed: %s (grid %d)\n", hipGetErrorString(e), grid_blocks); }
#endif
#else
    for (int ph = 0; ph < 9; ++ph) {
        p.ph_lo = ph; p.ph_hi = ph + 1;
        void* args[] = {&p}; hipError_t e = hipLaunchCooperativeKernel((const void*)mega, dim3(grid_blocks), dim3(NTHR), args, LDS_BYTES, stream);
        if (e != hipSuccess) fprintf(stderr, "cooperative launch %d failed: %s (grid %d)\n", ph, hipGetErrorString(e), grid_blocks);
    }
#endif
}
```

```cpp
#include <hip/hip_runtime.h>
#include <hip/hip_cooperative_groups.h>
#include <cstdio>
namespace cg = cooperative_groups;

#ifndef ONE_LAUNCH
#define ONE_LAUNCH 1
#endif

#define LAS __attribute__((address_space(3)))
typedef unsigned short bf16_t;
typedef short bf16x8 __attribute__((ext_vector_type(8)));
typedef short bf16x4 __attribute__((ext_vector_type(4)));
typedef float f32x4 __attribute__((ext_vector_type(4)));
typedef unsigned u32x4 __attribute__((ext_vector_type(4)));
typedef unsigned u32x2 __attribute__((ext_vector_type(2)));

constexpr int T_P = 32768, T_S = 2048, T = T_P + T_S, DM = 1024;
constexpr int NE_PAD = 6144;
constexpr int LDS_BYTES = 159744;
constexpr int NTHR = 512;
constexpr float EPS = 1e-6f;

constexpr size_t WS_WINE = 0;
constexpr size_t WS_WOUTE = WS_WINE + (size_t)NE_PAD * 1024 * 2;
constexpr size_t WS_WINO = WS_WOUTE + (size_t)1024 * 2048 * 2;
constexpr size_t WS_WOUTO = WS_WINO + (size_t)3072 * 1024 * 2;
constexpr size_t WS_WA = WS_WOUTO + (size_t)1024 * 1536 * 2;
constexpr size_t WS_WI = WS_WA + (size_t)8 * 192 * 192 * 2;
constexpr size_t WS_XB = WS_WI + (size_t)8 * 192 * 192 * 2;
constexpr size_t WS_RSTD0 = WS_XB + (size_t)T * 1024 * 2;
constexpr size_t WS_RSQ1 = WS_RSTD0 + (size_t)T * 4;
constexpr size_t WS_RSQ2 = WS_RSQ1 + (size_t)T * 4;
constexpr size_t WS_BOSQ = WS_RSQ2 + (size_t)T * 4;
constexpr size_t WS_Q = WS_BOSQ + (size_t)T * 16;
constexpr size_t WS_K = WS_Q + (size_t)T * 1024 * 2;
constexpr size_t WS_V = WS_K + (size_t)T * 256 * 2;
constexpr size_t WS_BQ = WS_V + (size_t)T * 256 * 2;
constexpr size_t WS_BK = WS_BQ + (size_t)T * 512 * 2;
constexpr size_t WS_BV = WS_BK + (size_t)T * 512 * 2;
constexpr size_t WS_GATE = WS_BV + (size_t)T * 1024 * 2;
constexpr size_t WS_BLR = WS_GATE + (size_t)T * 2048 * 2;
constexpr size_t WS_END = WS_BLR + (size_t)T * 512 * 2;
constexpr size_t WS_Z2 = WS_Q;
constexpr size_t WS_Y2 = WS_GATE;
static_assert(WS_Z2 + (size_t)T * 3072 * 2 <= WS_GATE, "Z2 alias");

constexpr size_t O_Y = 0;
constexpr size_t O_KP = (size_t)T * 1024;
constexpr size_t O_VP = O_KP + 524288;
constexpr size_t O_GP = O_VP + 524288;
constexpr size_t O_CP = O_GP + 2097152;
constexpr size_t O_LP = O_CP + 73728;
constexpr size_t O_KS = O_LP + 24576;
constexpr size_t O_VS = O_KS + 524288;
constexpr size_t O_GS = O_VS + 524288;
constexpr size_t O_CS = O_GS + 4194304;
constexpr size_t O_LS = O_CS + 147456;
constexpr size_t O_END = O_LS + 49152;

struct Params {
    const float* in[25];
    float* out;
    unsigned char* ws;
    int ph_lo, ph_hi;
};

__device__ __forceinline__ unsigned cvt_pk_bf16(float lo, float hi) { unsigned r; asm volatile("v_cvt_pk_bf16_f32 %0, %1, %2" : "=v"(r) : "v"(lo), "v"(hi)); return r; }
__device__ __forceinline__ bf16_t f2bf(float f) { return (bf16_t)(cvt_pk_bf16(f, 0.f) & 0xffffu); }
__device__ __forceinline__ float bf2f(bf16_t b) { return __uint_as_float(((unsigned)b) << 16); }
__device__ __forceinline__ float bflo(unsigned w) { return __uint_as_float(w << 16); }
__device__ __forceinline__ float bfhi(unsigned w) { return __uint_as_float(w & 0xffff0000u); }
__device__ __forceinline__ float rcpf_(float x) { return __builtin_amdgcn_rcpf(x); }
__device__ __forceinline__ float siluf(float x) { return x * rcpf_(1.f + __expf(-x)); }
__device__ __forceinline__ float sigmf(float x) { return rcpf_(1.f + __expf(-x)); }
__device__ __forceinline__ void lds_barrier() { asm volatile("s_waitcnt lgkmcnt(0)" ::: "memory"); __builtin_amdgcn_s_barrier(); asm volatile("" ::: "memory"); }
__device__ __forceinline__ bf16x8 pack8(const f32x4& a, const f32x4& b) {
    u32x4 p; p.x = cvt_pk_bf16(a[0], a[1]); p.y = cvt_pk_bf16(a[2], a[3]); p.z = cvt_pk_bf16(b[0], b[1]); p.w = cvt_pk_bf16(b[2], b[3]);
    return __builtin_bit_cast(bf16x8, p);
}
__device__ __forceinline__ bf16x8 cat4(const bf16x4 a, const bf16x4 b) { bf16x8 r; r[0] = a[0]; r[1] = a[1]; r[2] = a[2]; r[3] = a[3]; r[4] = b[0]; r[5] = b[1]; r[6] = b[2]; r[7] = b[3]; return r; }
#define MFMA16(a, b, c) __builtin_amdgcn_mfma_f32_16x16x32_bf16((a), (b), (c), 0, 0, 0)

namespace pg8 {
constexpr int BM = 256, BK = 64, HALF = 128, HTB = HALF * BK * 2, STAGE_BYTES = 8 * HTB, NXCD = 8, WGM = 8;
__device__ __forceinline__ int lds_byte(int r, int c) { const int st = (r >> 4) * 2 + (c >> 5), rr = r & 15, cc = c & 31, ob = rr * 64 + cc * 2; return st * 1024 + (ob ^ (((ob >> 9) & 1) << 5)); }
__device__ __forceinline__ int perm32(int rho) { const int n = rho >> 4, i = rho & 15; return 8 * (i >> 2) + 4 * n + (i & 3); }
__device__ __forceinline__ void stage_rc(int b, int& R, int& C) { const int st = b / 1024, sb = b % 1024, swz = sb ^ (((sb >> 9) & 1) << 5); R = (st >> 1) * 16 + swz / 64; C = (st & 1) * 32 + (swz % 64) / 2; }
struct Unit { int pm, pn; };
struct Gemm { const bf16_t* A; const bf16_t* Bt; int M, N, K; };
struct StaticOrder {
    int nM, nN, nwg, G, c;
    __device__ void init(int M, int N, int G_, int c_) { nM = M / BM; nN = N / BM; nwg = nM * nN; G = G_; c = c_; }
    __device__ __forceinline__ bool next(int i, Unit& u) const {
        const long Lx = (long)i * G + c; if (Lx >= nwg) return false;
        int wgid = (int)Lx; { const int q = nwg / NXCD, r = nwg % NXCD, xcd = wgid % NXCD, off = wgid / NXCD; wgid = (xcd < r ? xcd * (q + 1) : r * (q + 1) + (xcd - r) * q) + off; }
        const int nig = WGM * nN, gid = wgid / nig, fm = gid * WGM, gsz = (nM - fm) < WGM ? (nM - fm) : WGM;
        u.pm = fm + ((wgid % nig) % gsz); u.pn = (wgid % nig) / gsz; return true;
    }
};

template <class Epi>
__device__ __forceinline__ void gemm_phase(LAS unsigned char* lds, const Gemm g, const StaticOrder& S, const Epi& E) {
    const int tid = threadIdx.x, wid = __builtin_amdgcn_readfirstlane(tid >> 6), lane = tid & 63, wr = wid >> 2, wc = wid & 3, fr = lane & 15, fq = lane >> 4;
    const int K = g.K, nt = K / BK;
    unsigned voffA[2], voffB[2];
#pragma unroll
    for (int i = 0; i < 2; ++i) { int R, C; stage_rc(tid * 16 + i * 8192, R, C); const int Rb = Epi::PERM ? ((R & ~31) + perm32(R & 31)) : R;
        voffA[i] = (unsigned)(R * K + C) * 2u; voffB[i] = (unsigned)(Rb * K + C) * 2u; }
    const size_t kstep = (size_t)(BK * 2);
    const size_t hstep = (size_t)HALF * K * 2;
    const size_t tstep = 2 * hstep;
    const unsigned ldsw = (unsigned)wid * 1024u;
    const int aoff = lds_byte(wr * 64 + fr, fq * 8), boff = lds_byte(wc * 32 + fr, fq * 8);
#define PG8_SA(b, h) (((b) * 2 + (h)) * HTB)
#define PG8_SB(b, h) ((4 + (b) * 2 + (h)) * HTB)
#define PG8_STAGE(bufoff, gbase, voff) do { _Pragma("unroll") for (int _i = 0; _i < 2; ++_i) \
        __builtin_amdgcn_global_load_lds((const unsigned*)((const char*)(gbase) + (voff)[_i]), (LAS unsigned*)(lds + (bufoff) + ldsw + _i * 8192), 16, 0, 0); } while (0)
#define PG8_LDA(dst, b, h) do { _Pragma("unroll") for (int m = 0; m < 4; ++m) _Pragma("unroll") for (int k = 0; k < 2; ++k) dst[m][k] = *(const LAS bf16x8*)(lds + PG8_SA(b, h) + aoff + m * 2048 + k * 1024); } while (0)
#define PG8_LDB(dst, b, h) do { _Pragma("unroll") for (int n = 0; n < 2; ++n) _Pragma("unroll") for (int k = 0; k < 2; ++k) dst[n][k] = *(const LAS bf16x8*)(lds + PG8_SB(b, h) + boff + n * 2048 + k * 1024); } while (0)
#define PG8_MMA(ai, bj, At, Bt) do { __builtin_amdgcn_s_setprio(1); _Pragma("unroll") for (int m = 0; m < 4; ++m) _Pragma("unroll") for (int n = 0; n < 2; ++n) _Pragma("unroll") for (int k = 0; k < 2; ++k) \
        acc[ai][bj][m][n] = __builtin_amdgcn_mfma_f32_16x16x32_bf16(Bt[n][k], At[m][k], acc[ai][bj][m][n], 0, 0, 0); __builtin_amdgcn_s_setprio(0); } while (0)
#define PG8_WAIT_V(n) asm volatile("s_waitcnt vmcnt(" #n ")" ::: "memory")
#define PG8_WAIT_L(n) asm volatile("s_waitcnt lgkmcnt(" #n ")" ::: "memory")
#define PG8_BAR __builtin_amdgcn_s_barrier()
#define PG8_SCHED __builtin_amdgcn_sched_barrier(0)
    Unit cur, nxt; int ui = 0;
    if (!S.next(0, cur)) return;
    f32x4 acc[2][2][4][2];
#pragma unroll
    for (int a = 0; a < 2; ++a)
#pragma unroll
        for (int b = 0; b < 2; ++b)
#pragma unroll
            for (int m = 0; m < 4; ++m)
#pragma unroll
                for (int n = 0; n < 2; ++n) acc[a][b][m][n] = (f32x4){0.f, 0.f, 0.f, 0.f};
    bf16x8 At[4][2], B0[2][2], B1[2][2];
    const char* cA = (const char*)g.A + (size_t)cur.pm * tstep; const char* cB = (const char*)g.Bt + (size_t)cur.pn * tstep;
    PG8_STAGE(PG8_SB(0, 0), cB, voffB); PG8_STAGE(PG8_SA(0, 0), cA, voffA); PG8_STAGE(PG8_SB(0, 1), cB + hstep, voffB); PG8_STAGE(PG8_SA(0, 1), cA + hstep, voffA);
    if (wr == 1) PG8_BAR;
    PG8_WAIT_V(4); PG8_BAR;
    PG8_STAGE(PG8_SB(1, 0), cB + kstep, voffB); PG8_STAGE(PG8_SA(1, 0), cA + kstep, voffA); PG8_STAGE(PG8_SB(1, 1), cB + hstep + kstep, voffB);
    PG8_WAIT_V(6); PG8_BAR;
    for (;;) {
        const bool has_next = S.next(ui + 1, nxt);
        const char* nA = has_next ? (const char*)g.A + (size_t)nxt.pm * tstep : cA; const char* nB = has_next ? (const char*)g.Bt + (size_t)nxt.pn * tstep : cB;
        for (int t = 0; t < nt; t += 2) {
            const bool last = (t == nt - 2);
            const char* a1 = cA + (size_t)(t + 1) * kstep;
            const char* a2 = last ? nA : cA + (size_t)(t + 2) * kstep; const char* b2 = last ? nB : cB + (size_t)(t + 2) * kstep;
            const char* a3 = a2 + kstep; const char* b3 = b2 + kstep;
            PG8_LDB(B0, 0, 0); PG8_SCHED; PG8_LDA(At, 0, 0); PG8_STAGE(PG8_SA(1, 1), a1 + hstep, voffA);
            PG8_WAIT_L(8); PG8_BAR; PG8_WAIT_L(0); PG8_MMA(0, 0, At, B0); PG8_BAR; PG8_SCHED;
            PG8_LDB(B1, 0, 1); PG8_STAGE(PG8_SB(0, 0), b2, voffB);
            PG8_BAR; PG8_WAIT_L(0); PG8_MMA(0, 1, At, B1); PG8_BAR;
            PG8_LDA(At, 0, 1); PG8_STAGE(PG8_SA(0, 0), a2, voffA);
            PG8_BAR; PG8_WAIT_L(0); PG8_MMA(1, 0, At, B0); PG8_BAR; PG8_SCHED;
            PG8_STAGE(PG8_SB(0, 1), b2 + hstep, voffB);
            PG8_WAIT_V(6); PG8_BAR; PG8_MMA(1, 1, At, B1); PG8_BAR;
            PG8_LDB(B0, 1, 0); PG8_SCHED; PG8_LDA(At, 1, 0); PG8_STAGE(PG8_SA(0, 1), a2 + hstep, voffA);
            PG8_WAIT_L(8); PG8_BAR; PG8_WAIT_L(0); PG8_MMA(0, 0, At, B0); PG8_BAR; PG8_SCHED;
            PG8_LDB(B1, 1, 1); PG8_STAGE(PG8_SB(1, 0), b3, voffB);
            PG8_BAR; PG8_WAIT_L(0); PG8_MMA(0, 1, At, B1); PG8_BAR;
            PG8_LDA(At, 1, 1); PG8_STAGE(PG8_SA(1, 0), a3, voffA);
            PG8_BAR; PG8_WAIT_L(0); PG8_MMA(1, 0, At, B0); PG8_BAR; PG8_SCHED;
            PG8_STAGE(PG8_SB(1, 1), b3 + hstep, voffB);
            PG8_WAIT_V(6); PG8_BAR; PG8_MMA(1, 1, At, B1); PG8_BAR;
        }
        E(acc, cur, wr, wc, fr, fq);
        if (!has_next) break;
#pragma unroll
        for (int a = 0; a < 2; ++a)
#pragma unroll
            for (int b = 0; b < 2; ++b)
#pragma unroll
                for (int m = 0; m < 4; ++m)
#pragma unroll
                    for (int n = 0; n < 2; ++n) acc[a][b][m][n] = (f32x4){0.f, 0.f, 0.f, 0.f};
        cur = nxt; cA = nA; cB = nB; ++ui;
    }
    PG8_WAIT_V(0);
    if (wr == 0) PG8_BAR;
    PG8_BAR;
#undef PG8_SA
#undef PG8_SB
#undef PG8_STAGE
#undef PG8_LDA
#undef PG8_LDB
#undef PG8_MMA
#undef PG8_WAIT_V
#undef PG8_WAIT_L
#undef PG8_BAR
#undef PG8_SCHED
}
}

typedef f32x4 AccT[2][2][4][2];

struct EpiInEven {
    static constexpr bool PERM = true;
    unsigned char* ws; float* out; const float* rstd; const float* blr_b;
    __device__ __forceinline__ void operator()(const AccT& acc, const pg8::Unit& u, int wr, int wc, int fr, int fq) const {
        const int pn = u.pn;
        bf16_t* base; int ld, coff; float sc = 1.f;
        if (pn < 4) { base = (bf16_t*)(ws + WS_Q); ld = 1024; coff = pn * 256; sc = 0.125f; }
        else if (pn == 4) { base = (bf16_t*)(ws + WS_K); ld = 256; coff = 0; }
        else if (pn == 5) { base = (bf16_t*)(ws + WS_V); ld = 256; coff = 0; }
        else if (pn < 8) { base = (bf16_t*)(ws + WS_BQ); ld = 512; coff = (pn - 6) * 256; sc = 0.08838834764831845f; }
        else if (pn < 10) { base = (bf16_t*)(ws + WS_BK); ld = 512; coff = (pn - 8) * 256; }
        else if (pn < 14) { base = (bf16_t*)(ws + WS_BV); ld = 1024; coff = (pn - 10) * 256; }
        else if (pn < 22) { base = (bf16_t*)(ws + WS_GATE); ld = 2048; coff = (pn - 14) * 256; }
        else { base = (bf16_t*)(ws + WS_BLR); ld = 512; coff = (pn - 22) * 256; }
        const int row0 = u.pm * 256 + wr * 64 + fr;
        const int ct = wc * 32 + 8 * fq;
        if (pn >= 22) {
#pragma unroll
            for (int ai = 0; ai < 2; ++ai)
#pragma unroll
                for (int m = 0; m < 4; ++m) {
                    const int row = row0 + ai * 128 + m * 16; const float rs = rstd[row];
#pragma unroll
                    for (int bj = 0; bj < 2; ++bj) {
                        const int cg = coff + ct + bj * 128;
                        const f32x4 b0 = *(const f32x4*)(blr_b + cg), b1 = *(const f32x4*)(blr_b + cg + 4);
                        f32x4 x0 = acc[ai][bj][m][0] * rs + b0, x1 = acc[ai][bj][m][1] * rs + b1;
#pragma unroll
                        for (int j = 0; j < 4; ++j) { x0[j] = (fminf(x0[j], 0.f) - __logf(1.f + __expf(-fabsf(x0[j])))) * (1.f / 16.f); x1[j] = (fminf(x1[j], 0.f) - __logf(1.f + __expf(-fabsf(x1[j])))) * (1.f / 16.f); }
                        u32x4 w; w.x = cvt_pk_bf16(x0[0], x0[1]); w.y = cvt_pk_bf16(x0[2], x0[3]); w.z = cvt_pk_bf16(x1[0], x1[1]); w.w = cvt_pk_bf16(x1[2], x1[3]);
                        *(u32x4*)(base + (size_t)row * 512 + cg) = w;
                    }
                }
            return;
        }
        const bool kv = (pn == 4 || pn == 5);
        float* okv_p = out + (pn == 4 ? O_KP : O_VP); float* okv_s = out + (pn == 4 ? O_KS : O_VS);
#pragma unroll
        for (int ai = 0; ai < 2; ++ai)
#pragma unroll
            for (int m = 0; m < 4; ++m) {
                const int row = row0 + ai * 128 + m * 16; const float rs = rstd[row] * sc;
                bf16_t* rowp = base + (size_t)row * ld + coff + ct;
                float* orow = nullptr;
                if (kv) {
                    if (row >= T_P) orow = okv_s + (size_t)(row - T_P) * 256;
                    else { const int b = row >> 11, t = row & 2047; if (t >= 1920) orow = okv_p + (size_t)(b * 128 + t - 1920) * 256; }
                }
#pragma unroll
                for (int bj = 0; bj < 2; ++bj) {
                    const f32x4 v0 = acc[ai][bj][m][0] * rs, v1 = acc[ai][bj][m][1] * rs;
                    u32x4 w; w.x = cvt_pk_bf16(v0[0], v0[1]); w.y = cvt_pk_bf16(v0[2], v0[3]); w.z = cvt_pk_bf16(v1[0], v1[1]); w.w = cvt_pk_bf16(v1[2], v1[3]);
                    *(u32x4*)(rowp + bj * 128) = w;
                    if (kv && orow) { *(f32x4*)(orow + bj * 128 + ct) = v0; *(f32x4*)(orow + bj * 128 + ct + 4) = v1; }
                }
            }
    }
};

template <bool WRITE_BF>
struct EpiOutRes {
    static constexpr bool PERM = false;
    const float* xin_p; const float* xin_s; float* xo; bf16_t* xb; float* rowsq;
    __device__ __forceinline__ void operator()(const AccT& acc, const pg8::Unit& u, int wr, int wc, int fr, int fq) const {
        const int row0 = u.pm * 256 + wr * 64 + fr, col0 = u.pn * 256 + wc * 32 + 4 * fq;
#pragma unroll
        for (int ai = 0; ai < 2; ++ai)
#pragma unroll
            for (int m = 0; m < 4; ++m) {
                const int row = row0 + ai * 128 + m * 16;
                const float* xr = (row < T_P) ? xin_p + (size_t)row * 1024 : xin_s + (size_t)(row - T_P) * 1024;
                float ss = 0.f;
#pragma unroll
                for (int bj = 0; bj < 2; ++bj)
#pragma unroll
                    for (int n = 0; n < 2; ++n) {
                        const int col = col0 + bj * 128 + n * 16;
                        const f32x4 v = acc[ai][bj][m][n] + *(const f32x4*)(xr + col);
                        *(f32x4*)(xo + (size_t)row * 1024 + col) = v;
                        if (WRITE_BF) { u32x2 w; w.x = cvt_pk_bf16(v[0], v[1]); w.y = cvt_pk_bf16(v[2], v[3]); *(u32x2*)(xb + (size_t)row * 1024 + col) = w; }
                        ss += v[0] * v[0] + v[1] * v[1] + v[2] * v[2] + v[3] * v[3];
                    }
                ss += __shfl_xor(ss, 16); ss += __shfl_xor(ss, 32);
                if (fq == 0) atomicAdd(rowsq + row, ss);
            }
    }
};

struct EpiInOdd {
    static constexpr bool PERM = true;
    bf16_t* z2; const float* rowsq;
    __device__ __forceinline__ void operator()(const AccT& acc, const pg8::Unit& u, int wr, int wc, int fr, int fq) const {
        const int row0 = u.pm * 256 + wr * 64 + fr, col0 = u.pn * 256 + wc * 32 + 8 * fq;
#pragma unroll
        for (int ai = 0; ai < 2; ++ai)
#pragma unroll
            for (int m = 0; m < 4; ++m) {
                const int row = row0 + ai * 128 + m * 16; const float rs = rsqrtf(rowsq[row] * (1.f / 1024.f) + EPS);
#pragma unroll
                for (int bj = 0; bj < 2; ++bj) {
                    const f32x4 v0 = acc[ai][bj][m][0] * rs, v1 = acc[ai][bj][m][1] * rs;
                    u32x4 w; w.x = cvt_pk_bf16(v0[0], v0[1]); w.y = cvt_pk_bf16(v0[2], v0[3]); w.z = cvt_pk_bf16(v1[0], v1[1]); w.w = cvt_pk_bf16(v1[2], v1[3]);
                    *(u32x4*)(z2 + (size_t)row * 3072 + col0 + bj * 128) = w;
                }
            }
    }
};

template <int MODE>
__device__ __forceinline__ void transpose_w(const float* __restrict__ src, int K, int Nsrc, bf16_t* __restrict__ dst, int Ndst, const float* __restrict__ gain, long gtid, long gsz) {
    const long total = (long)(K / 8) * Ndst;
    for (long it = gtid; it < total; it += gsz) {
        const int n = (int)(it % Ndst), k8 = (int)(it / Ndst);
        int sc = n;
        if (MODE == 1) { if (n < 3584) sc = n; else sc = n + 16; }
        u32x4 w = {0u, 0u, 0u, 0u};
        if (sc >= 0) {
            const float* s = src + (size_t)(k8 * 8) * Nsrc + sc;
            float v0 = s[0], v1 = s[(size_t)Nsrc], v2 = s[(size_t)2 * Nsrc], v3 = s[(size_t)3 * Nsrc], v4 = s[(size_t)4 * Nsrc], v5 = s[(size_t)5 * Nsrc], v6 = s[(size_t)6 * Nsrc], v7 = s[(size_t)7 * Nsrc];
            if (gain) { const f32x4 g0 = *(const f32x4*)(gain + k8 * 8), g1 = *(const f32x4*)(gain + k8 * 8 + 4); v0 *= g0[0]; v1 *= g0[1]; v2 *= g0[2]; v3 *= g0[3]; v4 *= g1[0]; v5 *= g1[1]; v6 *= g1[2]; v7 *= g1[3]; }
            w.x = cvt_pk_bf16(v0, v1); w.y = cvt_pk_bf16(v2, v3); w.z = cvt_pk_bf16(v4, v5); w.w = cvt_pk_bf16(v6, v7);
        }
        *(u32x4*)(dst + (size_t)n * K + k8 * 8) = w;
    }
}

__device__ __forceinline__ void phase0(const Params& p) {
    unsigned char* ws = p.ws;
    const long gtid = (long)blockIdx.x * NTHR + threadIdx.x, gsz = (long)gridDim.x * NTHR;
    transpose_w<1>(p.in[8], 1024, 5648, (bf16_t*)(ws + WS_WINE), 5632, p.in[7], gtid, gsz);
    for (long it = gtid; it < 128L * 512; it += gsz) {
        const int n = (int)(it & 511), k8 = (int)(it >> 9);
        float wl[16];
#pragma unroll
        for (int r = 0; r < 16; ++r) wl[r] = p.in[9][r * 512 + n];
        float v[8];
#pragma unroll
        for (int i = 0; i < 8; ++i) {
            const float* wr_ = p.in[8] + (size_t)(k8 * 8 + i) * 5648 + 3584;
            float a = 0.f;
#pragma unroll
            for (int r4 = 0; r4 < 4; ++r4) { const f32x4 x = *(const f32x4*)(wr_ + r4 * 4); a += x[0] * wl[r4 * 4] + x[1] * wl[r4 * 4 + 1] + x[2] * wl[r4 * 4 + 2] + x[3] * wl[r4 * 4 + 3]; }
            v[i] = a * p.in[7][k8 * 8 + i];
        }
        u32x4 w; w.x = cvt_pk_bf16(v[0], v[1]); w.y = cvt_pk_bf16(v[2], v[3]); w.z = cvt_pk_bf16(v[4], v[5]); w.w = cvt_pk_bf16(v[6], v[7]);
        *(u32x4*)((bf16_t*)(ws + WS_WINE) + (size_t)(5632 + n) * 1024 + k8 * 8) = w;
    }
    transpose_w<0>(p.in[13], 2048, 1024, (bf16_t*)(ws + WS_WOUTE), 1024, nullptr, gtid, gsz);
    transpose_w<0>(p.in[15], 1024, 3072, (bf16_t*)(ws + WS_WINO), 3072, p.in[14], gtid, gsz);
    transpose_w<0>(p.in[23], 1536, 1024, (bf16_t*)(ws + WS_WOUTO), 1024, nullptr, gtid, gsz);
    for (int nb = 0; nb < 8; ++nb) {
        transpose_w<0>(p.in[18] + nb * 192 * 192, 192, 192, (bf16_t*)(ws + WS_WA) + nb * 192 * 192, 192, nullptr, gtid, gsz);
        transpose_w<0>(p.in[20] + nb * 192 * 192, 192, 192, (bf16_t*)(ws + WS_WI) + nb * 192 * 192, 192, nullptr, gtid, gsz);
    }
    { float* z = (float*)(ws + WS_RSQ1); const long nz = (long)T * 6; for (long i = gtid; i < nz; i += gsz) z[i] = 0.f; }
    const int lane = threadIdx.x & 63; const int gw = (int)(gtid >> 6), nw = (int)(gsz >> 6);
    bf16_t* xb = (bf16_t*)(ws + WS_XB); float* rstd = (float*)(ws + WS_RSTD0);
    for (int row = gw; row < T; row += nw) {
        const float* xr = (row < T_P) ? p.in[0] + (size_t)row * 1024 : p.in[1] + (size_t)(row - T_P) * 1024;
        float ss = 0.f;
#pragma unroll
        for (int i = 0; i < 4; ++i) {
            const f32x4 v = *(const f32x4*)(xr + i * 256 + lane * 4);
            ss += v[0] * v[0] + v[1] * v[1] + v[2] * v[2] + v[3] * v[3];
            u32x2 w; w.x = cvt_pk_bf16(v[0], v[1]); w.y = cvt_pk_bf16(v[2], v[3]);
            *(u32x2*)(xb + (size_t)row * 1024 + i * 256 + lane * 4) = w;
        }
#pragma unroll
        for (int o = 32; o >= 1; o >>= 1) ss += __shfl_xor(ss, o);
        if (lane == 0) rstd[row] = rsqrtf(ss * (1.f / 1024.f) + EPS);
    }
}

__device__ __forceinline__ void attn_item(const Params& p, LAS unsigned char* L, int item, bf16_t* Yd, int ldd) {
    unsigned char* ws = p.ws;
    const int tid = threadIdx.x, lane = tid & 63, w = tid >> 6, r16 = lane & 15, q4 = lane >> 4;
    LAS bf16_t* Ks = (LAS bf16_t*)L;
    LAS bf16_t* Vt = (LAS bf16_t*)(L + 192 * 72 * 2);
    const bf16_t* Qb = (const bf16_t*)(ws + WS_Q); const bf16_t* Kb = (const bf16_t*)(ws + WS_K); const bf16_t* Vb = (const bf16_t*)(ws + WS_V);
    bf16_t* Yb = (bf16_t*)(ws + WS_GATE);
    const bool smp = item >= 2048;
    int b, c, kh; size_t row0;
    if (!smp) { kh = item & 3; c = (item >> 2) & 31; b = item >> 7; row0 = (size_t)b * 2048 + c * 64; }
    else { const int i2 = item - 2048; kh = i2 & 3; b = i2 >> 2; c = 0; row0 = (size_t)T_P + b * 64; }
#pragma unroll
    for (int i = 0; i < 3; ++i) {
        const int idx = tid + i * 512, key = idx >> 3, dg = idx & 7;
        u32x4 kv = {0u, 0u, 0u, 0u}, vv = {0u, 0u, 0u, 0u};
        if (!smp) {
            const int pos = c * 64 - 128 + key;
            if (pos >= 0) { const size_t r = (size_t)b * 2048 + pos; kv = *(const u32x4*)(Kb + r * 256 + kh * 64 + dg * 8); vv = *(const u32x4*)(Vb + r * 256 + kh * 64 + dg * 8); }
        } else {
            if (key < 128) {
                const size_t o = ((size_t)(b * 128 + key) * 4 + kh) * 64 + dg * 8;
                const f32x4 k0 = *(const f32x4*)(p.in[2] + o), k1 = *(const f32x4*)(p.in[2] + o + 4), v0 = *(const f32x4*)(p.in[3] + o), v1 = *(const f32x4*)(p.in[3] + o + 4);
                kv.x = cvt_pk_bf16(k0[0], k0[1]); kv.y = cvt_pk_bf16(k0[2], k0[3]); kv.z = cvt_pk_bf16(k1[0], k1[1]); kv.w = cvt_pk_bf16(k1[2], k1[3]);
                vv.x = cvt_pk_bf16(v0[0], v0[1]); vv.y = cvt_pk_bf16(v0[2], v0[3]); vv.z = cvt_pk_bf16(v1[0], v1[1]); vv.w = cvt_pk_bf16(v1[2], v1[3]);
            } else { const size_t r = (size_t)T_P + b * 64 + key - 128; kv = *(const u32x4*)(Kb + r * 256 + kh * 64 + dg * 8); vv = *(const u32x4*)(Vb + r * 256 + kh * 64 + dg * 8); }
        }
        *(LAS u32x4*)(Ks + key * 72 + dg * 8) = kv;
#pragma unroll
        for (int e = 0; e < 8; ++e) Vt[(dg * 8 + e) * 200 + key] = (bf16_t)(vv[e >> 1] >> ((e & 1) * 16));
    }
    __syncthreads();
    const int g = w >> 1, i0 = (w & 1) * 32, h = kh * 4 + g;
    const float slope = exp2f(-0.5f * (float)(h + 1));
    const float sink = p.in[11][h];
#pragma unroll 1
    for (int qt = 0; qt < 2; ++qt) {
        const int i = i0 + qt * 16 + r16;
        bf16x8 qf[2];
#pragma unroll
        for (int ks = 0; ks < 2; ++ks) qf[ks] = *(const bf16x8*)(Qb + (row0 + i) * 1024 + h * 64 + ks * 32 + q4 * 8);
        f32x4 sacc[12];
#pragma unroll
        for (int kt = 0; kt < 12; ++kt) {
            const bf16x8 kf0 = *(const LAS bf16x8*)(Ks + (kt * 16 + r16) * 72 + q4 * 8), kf1 = *(const LAS bf16x8*)(Ks + (kt * 16 + r16) * 72 + 32 + q4 * 8);
            f32x4 a = {0.f, 0.f, 0.f, 0.f}; a = MFMA16(kf0, qf[0], a); a = MFMA16(kf1, qf[1], a); sacc[kt] = a;
        }
        float m = -3e38f;
#pragma unroll
        for (int kt = 0; kt < 12; ++kt)
#pragma unroll
            for (int jj = 0; jj < 4; ++jj) {
                const int j = kt * 16 + q4 * 4 + jj;
                float sv = sacc[kt][jj] - slope * fabsf((float)(128 + i - j));
                if (!smp && (c * 64 - 128 + j) < 0) sv = -1e30f;
                sacc[kt][jj] = sv; m = fmaxf(m, sv);
            }
        m = fmaxf(m, __shfl_xor(m, 16)); m = fmaxf(m, __shfl_xor(m, 32)); m = fmaxf(m, sink);
        float l = 0.f;
#pragma unroll
        for (int kt = 0; kt < 12; ++kt)
#pragma unroll
            for (int jj = 0; jj < 4; ++jj) { const float pr = __expf(sacc[kt][jj] - m); sacc[kt][jj] = pr; l += pr; }
        l += __shfl_xor(l, 16); l += __shfl_xor(l, 32); l += __expf(sink - m);
        const float inv = 1.f / l;
        f32x4 oacc[4];
#pragma unroll
        for (int dt = 0; dt < 4; ++dt) oacc[dt] = (f32x4){0.f, 0.f, 0.f, 0.f};
#pragma unroll
        for (int kb = 0; kb < 6; ++kb) {
            const bf16x8 pf = pack8(sacc[2 * kb], sacc[2 * kb + 1]);
#pragma unroll
            for (int dt = 0; dt < 4; ++dt) {
                const LAS bf16_t* vp = Vt + (dt * 16 + r16) * 200 + kb * 32 + q4 * 4;
                const bf16x8 vf = cat4(*(const LAS bf16x4*)vp, *(const LAS bf16x4*)(vp + 16));
                oacc[dt] = MFMA16(vf, pf, oacc[dt]);
            }
        }
#pragma unroll
        for (int dt = 0; dt < 4; ++dt) {
            const size_t off = (row0 + i) * 2048 + h * 64 + dt * 16 + q4 * 4;
            const u32x2 gv = *(const u32x2*)(Yb + off);
            const f32x4 o = oacc[dt] * inv;
            u32x2 wv; wv.x = cvt_pk_bf16(o[0] * siluf(bflo(gv.x)), o[1] * siluf(bfhi(gv.x))); wv.y = cvt_pk_bf16(o[2] * siluf(bflo(gv.y)), o[3] * siluf(bfhi(gv.y)));
            *(u32x2*)(Yd + (row0 + i) * ldd + h * 64 + dt * 16 + q4 * 4) = wv;
        }
    }
    __syncthreads();
}

__device__ __forceinline__ void gla_item(const Params& p, LAS unsigned char* L, int item) {
    unsigned char* ws = p.ws;
    const int tid = threadIdx.x, lane = tid & 63, w = tid >> 6, r16 = lane & 15, q4 = lane >> 4;
    LAS bf16_t* QG = (LAS bf16_t*)L;
    LAS bf16_t* KG = (LAS bf16_t*)(L + 17408);
    LAS bf16_t* KDt = (LAS bf16_t*)(L + 34816);
    LAS bf16_t* Vt = (LAS bf16_t*)(L + 53248);
    LAS float* BLRs = (LAS float*)(L + 62464);
    LAS float* GT = (LAS float*)(L + 66560);
    LAS float* GL = (LAS float*)(L + 68608);
    const bool smp = item >= 256;
    const int i2 = smp ? item - 256 : item;
    const int b = i2 >> 4, h = (i2 >> 2) & 3, sl = i2 & 3, e0 = sl * 64;
    const int nch = smp ? 1 : 32;
    const size_t rbase = smp ? (size_t)T_P + b * 64 : (size_t)b * 2048;
    const bf16_t* BQ = (const bf16_t*)(ws + WS_BQ); const bf16_t* BKb = (const bf16_t*)(ws + WS_BK); bf16_t* BV = (bf16_t*)(ws + WS_BV);
    const bf16_t* GB = (const bf16_t*)(ws + WS_BLR); float* BOSQ = (float*)(ws + WS_BOSQ);
    const int c = tid & 127, tg = tid >> 7;
    const int et = w & 3, ip = w >> 2;
    f32x4 Sacc[8];
#pragma unroll
    for (int d8 = 0; d8 < 8; ++d8) {
        if (smp) {
#pragma unroll
            for (int jj = 0; jj < 4; ++jj) Sacc[d8][jj] = p.in[4][((size_t)(b * 4 + h) * 128 + d8 * 16 + q4 * 4 + jj) * 256 + e0 + et * 16 + r16];
        } else Sacc[d8] = (f32x4){0.f, 0.f, 0.f, 0.f};
    }
    u32x4 pv; bf16_t pq[16], pk[16], pgv[16];
    {
        pv = *(const u32x4*)(BV + (rbase + (tid >> 3)) * 1024 + h * 256 + e0 + (tid & 7) * 8);
#pragma unroll
        for (int tt = 0; tt < 16; ++tt) { const size_t r = rbase + tg * 16 + tt; pq[tt] = BQ[r * 512 + h * 128 + c]; pk[tt] = BKb[r * 512 + h * 128 + c]; pgv[tt] = GB[r * 512 + h * 128 + c]; }
    }
    for (int ci = 0; ci < nch; ++ci) {
        const size_t r0 = rbase + (size_t)ci * 64;
        const bool more = (ci + 1 < nch);
        {
            const int t = tid >> 3, eg = tid & 7;
#pragma unroll
            for (int e = 0; e < 8; ++e) Vt[(eg * 8 + e) * 72 + t] = (bf16_t)(pv[e >> 1] >> ((e & 1) * 16));
        }
        if (more) {
            pv = *(const u32x4*)(BV + (r0 + 64 + (tid >> 3)) * 1024 + h * 256 + e0 + (tid & 7) * 8);
        }
        float gl[16]; float cs = 0.f;
#pragma unroll
        for (int tt = 0; tt < 16; ++tt) { cs += bf2f(pgv[tt]); gl[tt] = cs; }
        GT[tg * 128 + c] = cs;
        lds_barrier();
        float pre = 0.f, tot = 0.f;
#pragma unroll
        for (int g2 = 0; g2 < 4; ++g2) { const float v = GT[g2 * 128 + c]; if (g2 < tg) pre += v; tot += v; }
        const float etot = __expf(tot);
        if (tg == 0) GL[c] = etot;
#pragma unroll
        for (int tt = 0; tt < 16; ++tt) {
            const int t = tg * 16 + tt; const float G = pre + gl[tt];
            const float qv = bf2f(pq[tt]), kv = bf2f(pk[tt]);
            const float eg = __expf(G), ieg = rcpf_(eg), kgv = kv * ieg;
            QG[t * 136 + c] = f2bf(qv * eg); KG[t * 136 + c] = f2bf(kgv); KDt[c * 72 + t] = f2bf(kgv * etot);
        }
        if (more) {
#pragma unroll
            for (int tt = 0; tt < 16; ++tt) { const size_t r = r0 + 64 + tg * 16 + tt; pq[tt] = BQ[r * 512 + h * 128 + c]; pk[tt] = BKb[r * 512 + h * 128 + c]; pgv[tt] = GB[r * 512 + h * 128 + c]; }
        }
        lds_barrier();
        f32x4 at[4][2];
#pragma unroll
        for (int jt = 0; jt < 4; ++jt)
#pragma unroll
            for (int x2 = 0; x2 < 2; ++x2) at[jt][x2] = (f32x4){0.f, 0.f, 0.f, 0.f};
#pragma unroll
        for (int ks = 0; ks < 4; ++ks) {
            bf16x8 qf[2];
#pragma unroll
            for (int x2 = 0; x2 < 2; ++x2) qf[x2] = *(const LAS bf16x8*)(QG + ((ip * 2 + x2) * 16 + r16) * 136 + ks * 32 + q4 * 8);
#pragma unroll
            for (int jt = 0; jt < 4; ++jt) {
                const bf16x8 kf = *(const LAS bf16x8*)(KG + (jt * 16 + r16) * 136 + ks * 32 + q4 * 8);
#pragma unroll
                for (int x2 = 0; x2 < 2; ++x2) at[jt][x2] = MFMA16(kf, qf[x2], at[jt][x2]);
            }
        }
#pragma unroll
        for (int jt = 0; jt < 4; ++jt)
#pragma unroll
            for (int x2 = 0; x2 < 2; ++x2)
#pragma unroll
                for (int jj = 0; jj < 4; ++jj) { const int j = jt * 16 + q4 * 4 + jj, i = (ip * 2 + x2) * 16 + r16; if (j > i) at[jt][x2][jj] = 0.f; }
        f32x4 ot[2];
        ot[0] = (f32x4){0.f, 0.f, 0.f, 0.f}; ot[1] = (f32x4){0.f, 0.f, 0.f, 0.f};
#pragma unroll
        for (int jb = 0; jb < 2; ++jb) {
            const LAS bf16_t* vp = Vt + (et * 16 + r16) * 72 + jb * 32 + q4 * 4;
            const bf16x8 vf = cat4(*(const LAS bf16x4*)vp, *(const LAS bf16x4*)(vp + 16));
#pragma unroll
            for (int x2 = 0; x2 < 2; ++x2) { const bf16x8 pf = pack8(at[2 * jb][x2], at[2 * jb + 1][x2]); ot[x2] = MFMA16(vf, pf, ot[x2]); }
        }
#pragma unroll
        for (int db = 0; db < 4; ++db) {
            const bf16x8 sf = pack8(Sacc[2 * db], Sacc[2 * db + 1]);
#pragma unroll
            for (int x2 = 0; x2 < 2; ++x2) {
                const LAS bf16_t* qp = QG + ((ip * 2 + x2) * 16 + r16) * 136 + db * 32 + q4 * 4;
                const bf16x8 qv = cat4(*(const LAS bf16x4*)qp, *(const LAS bf16x4*)(qp + 16));
                ot[x2] = MFMA16(sf, qv, ot[x2]);
            }
        }
#pragma unroll
        for (int x2 = 0; x2 < 2; ++x2) {
            const size_t row = r0 + (ip * 2 + x2) * 16 + r16;
            const f32x4 o = ot[x2];
            u32x2 wv; wv.x = cvt_pk_bf16(o[0], o[1]); wv.y = cvt_pk_bf16(o[2], o[3]);
            *(u32x2*)(BV + row * 1024 + h * 256 + e0 + et * 16 + q4 * 4) = wv;
            float ss = o[0] * o[0] + o[1] * o[1] + o[2] * o[2] + o[3] * o[3];
            ss += __shfl_xor(ss, 16); ss += __shfl_xor(ss, 32);
            if (q4 == 0) atomicAdd(BOSQ + row * 4 + h, ss);
        }
#pragma unroll
        for (int d8 = 0; d8 < 8; ++d8) {
            const f32x4 dec = *(const LAS f32x4*)(GL + d8 * 16 + q4 * 4);
            Sacc[d8] = Sacc[d8] * dec;
        }
#pragma unroll
        for (int jb = 0; jb < 2; ++jb) {
            const bf16x8 vf = *(const LAS bf16x8*)(Vt + (et * 16 + r16) * 72 + jb * 32 + q4 * 8);
#pragma unroll
            for (int d8 = 0; d8 < 8; ++d8) {
                const bf16x8 kf = *(const LAS bf16x8*)(KDt + (d8 * 16 + r16) * 72 + jb * 32 + q4 * 8);
                Sacc[d8] = MFMA16(kf, vf, Sacc[d8]);
            }
        }
        lds_barrier();
    }
    if (ip == 0) {
        float* og = p.out + (smp ? O_GS : O_GP);
#pragma unroll
        for (int d8 = 0; d8 < 8; ++d8)
#pragma unroll
            for (int jj = 0; jj < 4; ++jj) og[((size_t)(b * 4 + h) * 128 + d8 * 16 + q4 * 4 + jj) * 256 + e0 + et * 16 + r16] = Sacc[d8][jj];
    }
}

__device__ __forceinline__ void phase2(const Params& p, LAS unsigned char* L) {
    for (int it = blockIdx.x; it < 768; it += gridDim.x) gla_item(p, L, it);
#ifdef PROBE_ATTN2
    for (int it = blockIdx.x; it < 2176; it += gridDim.x) attn_item(p, L, it, (bf16_t*)(p.ws + WS_XB), 1024);
#endif
    for (int it = blockIdx.x; it < 2176; it += gridDim.x) attn_item(p, L, it, (bf16_t*)(p.ws + WS_GATE), 2048);
}

__device__ __forceinline__ void phase3(const Params& p) {
    unsigned char* ws = p.ws;
    const bf16_t* BV = (const bf16_t*)(ws + WS_BV); bf16_t* Yb = (bf16_t*)(ws + WS_GATE); const float* BOSQ = (const float*)(ws + WS_BOSQ);
    const float* gg = p.in[12];
    const long gtid = (long)blockIdx.x * NTHR + threadIdx.x, gsz = (long)gridDim.x * NTHR;
    const long total = (long)T * 128;
    for (long it = gtid; it < total; it += gsz) {
        const long row = it >> 7; const int c8 = (int)(it & 127) * 8, h = c8 >> 8;
        const float rs = rsqrtf(BOSQ[row * 4 + h] * (1.f / 256.f) + EPS);
        const u32x4 bo = *(const u32x4*)(BV + row * 1024 + c8);
        const u32x4 gt = *(const u32x4*)(Yb + row * 2048 + 1024 + c8);
        const f32x4 g0 = *(const f32x4*)(gg + (c8 & 255)), g1 = *(const f32x4*)(gg + (c8 & 255) + 4);
        u32x4 o;
        o.x = cvt_pk_bf16(bflo(bo.x) * rs * g0[0] * siluf(bflo(gt.x)), bfhi(bo.x) * rs * g0[1] * siluf(bfhi(gt.x)));
        o.y = cvt_pk_bf16(bflo(bo.y) * rs * g0[2] * siluf(bflo(gt.y)), bfhi(bo.y) * rs * g0[3] * siluf(bfhi(gt.y)));
        o.z = cvt_pk_bf16(bflo(bo.z) * rs * g1[0] * siluf(bflo(gt.z)), bfhi(bo.z) * rs * g1[1] * siluf(bfhi(gt.z)));
        o.w = cvt_pk_bf16(bflo(bo.w) * rs * g1[2] * siluf(bflo(gt.w)), bfhi(bo.w) * rs * g1[3] * siluf(bfhi(gt.w)));
        *(u32x4*)(Yb + row * 2048 + 1024 + c8) = o;
    }
}

__device__ __forceinline__ void unpack8(const u32x4 w, float (&v)[8]) { v[0] = bflo(w.x); v[1] = bfhi(w.x); v[2] = bflo(w.y); v[3] = bfhi(w.y); v[4] = bflo(w.z); v[5] = bfhi(w.z); v[6] = bflo(w.w); v[7] = bfhi(w.w); }
__device__ __forceinline__ void lru_item(const Params& p, LAS unsigned char* L, int item) {
    unsigned char* ws = p.ws;
    const int tid = threadIdx.x, lane = tid & 63, w = tid >> 6, r16 = lane & 15, q4 = lane >> 4;
    LAS bf16_t* Wl = (LAS bf16_t*)L;
    LAS bf16_t* U = (LAS bf16_t*)(L + 76800);
    LAS float* Aa = (LAS float*)(L + 102400);
    LAS float* Bb = (LAS float*)(L + 126976);
    LAS float* SP = (LAS float*)(L + 151552);
    LAS float* SH = (LAS float*)(L + 153088);
    LAS float* HC = (LAS float*)(L + 154624);
    LAS float* CW = (LAS float*)(L + 155392);
    const bool smp = item >= 256;
    const int i2 = smp ? item - 256 : item;
    const int b = i2 >> 4, nb = (i2 >> 1) & 7, hf = i2 & 1;
    const int nch = smp ? 1 : 32;
    const unsigned rbase = smp ? (unsigned)T_P + b * 64 : (unsigned)b * 2048;
    const bf16_t* Z2 = (const bf16_t*)(ws + WS_Z2); bf16_t* Y2 = (bf16_t*)(ws + WS_Y2);
    const bf16_t* WA = (const bf16_t*)(ws + WS_WA) + nb * 192 * 192; const bf16_t* WI = (const bf16_t*)(ws + WS_WI) + nb * 192 * 192;
    for (int idx = tid; idx < 192 * 24; idx += NTHR) {
        const int r = idx / 24, g8 = idx % 24;
        const bf16_t* src = (r < 96) ? WA + (size_t)(hf * 96 + r) * 192 + g8 * 8 : WI + (size_t)(hf * 96 + r - 96) * 192 + g8 * 8;
        *(LAS u32x4*)(Wl + r * 200 + g8 * 8) = *(const u32x4*)src;
    }
    const bool cthr = tid < 384;
    const int cgp = tid % 24, tq = (tid / 24) & 15;
    const int chc = nb * 192 + cgp * 8;
    for (int idx = tid; idx < 5 * 192; idx += NTHR) { const int j = idx / 192, cc = idx % 192; CW[idx] = (j < 4) ? p.in[16][j * 1536 + nb * 192 + cc] : p.in[17][nb * 192 + cc]; }
    const int mt = w & 3, pg = w >> 2;
    float bra[3], bri[3], sp[3];
#pragma unroll
    for (int cp = 0; cp < 3; ++cp) {
        const int ch = nb * 192 + hf * 96 + (pg * 3 + cp) * 16 + r16;
        bra[cp] = p.in[19][ch]; bri[cp] = p.in[21][ch];
        const float lam = p.in[22][ch];
        sp[cp] = 8.f * (fmaxf(-lam, 0.f) + log1pf(__expf(-fabsf(lam))));
    }
    if (tid < 96) HC[tid] = smp ? p.in[6][b * 1536 + nb * 192 + hf * 96 + tid] : 0.f;
    const int sch0 = tid % 96, sseg0 = (tid / 96) & 3;
    const int ot0 = tid / 12, og0 = tid % 12, ot1 = (tid + 512) / 12, og1 = (tid + 512) % 12;
    const bool o1 = tid < 256;
    const int och0 = nb * 192 + hf * 96 + og0 * 8, och1 = nb * 192 + hf * 96 + og1 * 8;
    lds_barrier();
    u32x4 xr[7]; u32x4 pg0, pg1 = {0u, 0u, 0u, 0u};
#pragma unroll
    for (int r = 0; r < 7; ++r) {
        xr[r] = (u32x4){0u, 0u, 0u, 0u};
        const int pos = 4 * tq - 3 + r;
        if (cthr) {
            if (pos >= 0) xr[r] = *(const u32x4*)(Z2 + (unsigned)((rbase + pos) * 3072u + chc));
            else if (smp) {
                const float* hp = p.in[5] + ((size_t)b * 3 + (3 + pos)) * 1536 + chc;
                const f32x4 h0 = *(const f32x4*)hp, h1 = *(const f32x4*)(hp + 4);
                xr[r].x = cvt_pk_bf16(h0[0], h0[1]); xr[r].y = cvt_pk_bf16(h0[2], h0[3]); xr[r].z = cvt_pk_bf16(h1[0], h1[1]); xr[r].w = cvt_pk_bf16(h1[2], h1[3]);
            }
        }
    }
    pg0 = *(const u32x4*)(Z2 + (unsigned)((rbase + ot0) * 3072u + 1536 + och0));
    if (o1) pg1 = *(const u32x4*)(Z2 + (unsigned)((rbase + ot1) * 3072u + 1536 + och1));
    for (int ci = 0; ci < nch; ++ci) {
        const unsigned r0 = rbase + (unsigned)ci * 64;
        const bool more = (ci + 1 < nch);
        int sch = sch0, sseg = sseg0;
        asm volatile("" : "+v"(sch), "+v"(sseg));
        if (cthr) {
            float xv[7][8];
#pragma unroll
            for (int r = 0; r < 7; ++r) unpack8(xr[r], xv[r]);
            if (hf == 0 && !more && tq == 15) {
                float* oc = p.out + (smp ? O_CS : O_CP) + (size_t)b * 3 * 1536 + chc;
#pragma unroll
                for (int r = 0; r < 3; ++r) { *(f32x4*)(oc + r * 1536) = (f32x4){xv[4 + r][0], xv[4 + r][1], xv[4 + r][2], xv[4 + r][3]}; *(f32x4*)(oc + r * 1536 + 4) = (f32x4){xv[4 + r][4], xv[4 + r][5], xv[4 + r][6], xv[4 + r][7]}; }
            }
            float cw[5][8];
#pragma unroll
            for (int j = 0; j < 5; ++j) { const f32x4 c0 = *(const LAS f32x4*)(CW + j * 192 + cgp * 8), c1 = *(const LAS f32x4*)(CW + j * 192 + cgp * 8 + 4);
                cw[j][0] = c0[0]; cw[j][1] = c0[1]; cw[j][2] = c0[2]; cw[j][3] = c0[3]; cw[j][4] = c1[0]; cw[j][5] = c1[1]; cw[j][6] = c1[2]; cw[j][7] = c1[3]; }
#pragma unroll
            for (int tk = 0; tk < 4; ++tk) {
                float acc[8];
#pragma unroll
                for (int e = 0; e < 8; ++e) acc[e] = cw[4][e] + xv[tk][e] * cw[0][e] + xv[tk + 1][e] * cw[1][e] + xv[tk + 2][e] * cw[2][e] + xv[tk + 3][e] * cw[3][e];
                u32x4 uw; uw.x = cvt_pk_bf16(acc[0], acc[1]); uw.y = cvt_pk_bf16(acc[2], acc[3]); uw.z = cvt_pk_bf16(acc[4], acc[5]); uw.w = cvt_pk_bf16(acc[6], acc[7]);
                *(LAS u32x4*)(U + (4 * tq + tk) * 200 + cgp * 8) = uw;
            }
            if (more) {
#pragma unroll
                for (int r = 0; r < 7; ++r) xr[r] = *(const u32x4*)(Z2 + (unsigned)((r0 + 64 + 4 * tq - 3 + r) * 3072u + chc));
            }
        }
        lds_barrier();
        f32x4 ga[3], gi[3];
#pragma unroll
        for (int cp = 0; cp < 3; ++cp) { ga[cp] = (f32x4){0.f, 0.f, 0.f, 0.f}; gi[cp] = (f32x4){0.f, 0.f, 0.f, 0.f}; }
#pragma unroll 2
        for (int ks = 0; ks < 6; ++ks) {
            const bf16x8 uf = *(const LAS bf16x8*)(U + (mt * 16 + r16) * 200 + ks * 32 + q4 * 8);
#pragma unroll
            for (int cp = 0; cp < 3; ++cp) {
                const int ct = pg * 3 + cp;
                const bf16x8 wa = *(const LAS bf16x8*)(Wl + (ct * 16 + r16) * 200 + ks * 32 + q4 * 8), wi = *(const LAS bf16x8*)(Wl + (96 + ct * 16 + r16) * 200 + ks * 32 + q4 * 8);
                ga[cp] = MFMA16(uf, wa, ga[cp]); gi[cp] = MFMA16(uf, wi, gi[cp]);
            }
        }
#pragma unroll
        for (int cp = 0; cp < 3; ++cp) {
            const int cl = (pg * 3 + cp) * 16 + r16;
#pragma unroll
            for (int jj = 0; jj < 4; ++jj) {
                const int t = mt * 16 + q4 * 4 + jj;
                const float rg = sigmf(ga[cp][jj] + bra[cp]), ig = sigmf(gi[cp][jj] + bri[cp]);
                const float z = rg * sp[cp];
                const float a = __expf(-z);
                const float z2 = z + z;
                const float om = (z2 < 0.05f) ? z2 * (1.f - z2 * (0.5f - z2 * (0.16666667f - z2 * 0.041666668f))) : 1.f - a * a;
                const float uu = bf2f(U[t * 200 + hf * 96 + cl]);
                Aa[t * 96 + cl] = a; Bb[t * 96 + cl] = __builtin_amdgcn_sqrtf(om) * ig * uu;
            }
        }
        lds_barrier();
        if (cthr) {
            float P = 1.f, H = 0.f;
#pragma unroll
            for (int t = 0; t < 16; ++t) { const float a = Aa[(sseg * 16 + t) * 96 + sch]; H = a * H + Bb[(sseg * 16 + t) * 96 + sch]; P *= a; }
            SP[sseg * 96 + sch] = P; SH[sseg * 96 + sch] = H;
        }
        lds_barrier();
        if (cthr) {
            float hh = HC[(ci & 1) * 96 + sch];
#pragma unroll
            for (int sg = 0; sg < 3; ++sg) if (sg < sseg) hh = SP[sg * 96 + sch] * hh + SH[sg * 96 + sch];
#pragma unroll
            for (int t = 0; t < 16; ++t) { hh = Aa[(sseg * 16 + t) * 96 + sch] * hh + Bb[(sseg * 16 + t) * 96 + sch]; Bb[(sseg * 16 + t) * 96 + sch] = hh; }
            if (sseg == 3) HC[((ci + 1) & 1) * 96 + sch] = hh;
        }
        lds_barrier();
        {
            const f32x4 h0 = *(const LAS f32x4*)(Bb + ot0 * 96 + og0 * 8), h1 = *(const LAS f32x4*)(Bb + ot0 * 96 + og0 * 8 + 4);
            u32x4 o;
            o.x = cvt_pk_bf16(h0[0] * siluf(bflo(pg0.x)), h0[1] * siluf(bfhi(pg0.x)));
            o.y = cvt_pk_bf16(h0[2] * siluf(bflo(pg0.y)), h0[3] * siluf(bfhi(pg0.y)));
            o.z = cvt_pk_bf16(h1[0] * siluf(bflo(pg0.z)), h1[1] * siluf(bfhi(pg0.z)));
            o.w = cvt_pk_bf16(h1[2] * siluf(bflo(pg0.w)), h1[3] * siluf(bfhi(pg0.w)));
            *(u32x4*)(Y2 + (unsigned)((r0 + ot0) * 1536u + och0)) = o;
            if (more) pg0 = *(const u32x4*)(Z2 + (unsigned)((r0 + 64 + ot0) * 3072u + 1536 + och0));
        }
        if (o1) {
            const f32x4 h0 = *(const LAS f32x4*)(Bb + ot1 * 96 + og1 * 8), h1 = *(const LAS f32x4*)(Bb + ot1 * 96 + og1 * 8 + 4);
            u32x4 o;
            o.x = cvt_pk_bf16(h0[0] * siluf(bflo(pg1.x)), h0[1] * siluf(bfhi(pg1.x)));
            o.y = cvt_pk_bf16(h0[2] * siluf(bflo(pg1.y)), h0[3] * siluf(bfhi(pg1.y)));
            o.z = cvt_pk_bf16(h1[0] * siluf(bflo(pg1.z)), h1[1] * siluf(bfhi(pg1.z)));
            o.w = cvt_pk_bf16(h1[2] * siluf(bflo(pg1.w)), h1[3] * siluf(bfhi(pg1.w)));
            *(u32x4*)(Y2 + (unsigned)((r0 + ot1) * 1536u + och1)) = o;
            if (more) pg1 = *(const u32x4*)(Z2 + (unsigned)((r0 + 64 + ot1) * 3072u + 1536 + och1));
        }
        lds_barrier();
    }
    if (tid < 96) p.out[(smp ? O_LS : O_LP) + (size_t)b * 1536 + nb * 192 + hf * 96 + tid] = HC[(nch & 1) * 96 + tid];
    lds_barrier();
}

__device__ __forceinline__ void phase6(const Params& p, LAS unsigned char* L) {
    for (int it = blockIdx.x; it < 768; it += gridDim.x) lru_item(p, L, it);
}

__device__ __forceinline__ void phase8(const Params& p) {
    const float* rsq = (const float*)(p.ws + WS_RSQ2); const float* g = p.in[24]; float* y = p.out;
    const long gtid = (long)blockIdx.x * NTHR + threadIdx.x, gsz = (long)gridDim.x * NTHR;
    const long total = (long)T * 256;
    for (long it = gtid; it < total; it += gsz) {
        const long row = it >> 8; const int c4 = (int)(it & 255) * 4;
        const float rs = rsqrtf(rsq[row] * (1.f / 1024.f) + EPS);
        const f32x4 v = *(const f32x4*)(y + row * 1024 + c4), gv = *(const f32x4*)(g + c4);
        *(f32x4*)(y + row * 1024 + c4) = v * rs * gv;
    }
}

__global__ void __launch_bounds__(NTHR) mega(Params p) {
    extern __shared__ __attribute__((aligned(16))) unsigned char lds_raw[];
    LAS unsigned char* L = (LAS unsigned char*)lds_raw;
    cg::grid_group grid = cg::this_grid();
    unsigned char* ws = p.ws;
    const int lo = p.ph_lo, hi = p.ph_hi;
#ifndef PHMASK
#define PHMASK 0x1ff
#endif
#define IN(k) (((PHMASK >> (k)) & 1) && lo <= (k) && (k) < hi)
#define SEAM(k) do { if (IN(k) && IN((k) + 1)) grid.sync(); } while (0)
    if (IN(0)) phase0(p);
    SEAM(0);
    if (IN(1)) {
        pg8::Gemm g{(const bf16_t*)(ws + WS_XB), (const bf16_t*)(ws + WS_WINE), T, NE_PAD, 1024};
        pg8::StaticOrder S; S.init(T, NE_PAD, gridDim.x, blockIdx.x);
        EpiInEven E{ws, p.out, (const float*)(ws + WS_RSTD0), p.in[10]};
        pg8::gemm_phase<EpiInEven>(L, g, S, E);
    }
    SEAM(1);
    if (IN(2)) phase2(p, L);
    SEAM(2);
    if (IN(3)) phase3(p);
    SEAM(3);
    if (IN(4)) {
        pg8::Gemm g{(const bf16_t*)(ws + WS_GATE), (const bf16_t*)(ws + WS_WOUTE), T, 1024, 2048};
        pg8::StaticOrder S; S.init(T, 1024, gridDim.x, blockIdx.x);
        EpiOutRes<true> E{p.in[0], p.in[1], p.out, (bf16_t*)(ws + WS_XB), (float*)(ws + WS_RSQ1)};
        pg8::gemm_phase<EpiOutRes<true>>(L, g, S, E);
    }
    SEAM(4);
    if (IN(5)) {
        pg8::Gemm g{(const bf16_t*)(ws + WS_XB), (const bf16_t*)(ws + WS_WINO), T, 3072, 1024};
        pg8::StaticOrder S; S.init(T, 3072, gridDim.x, blockIdx.x);
        EpiInOdd E{(bf16_t*)(ws + WS_Z2), (const float*)(ws + WS_RSQ1)};
        pg8::gemm_phase<EpiInOdd>(L, g, S, E);
    }
    SEAM(5);
    if (IN(6)) phase6(p, L);
    SEAM(6);
    if (IN(7)) {
        pg8::Gemm g{(const bf16_t*)(ws + WS_Y2), (const bf16_t*)(ws + WS_WOUTO), T, 1024, 1536};
        pg8::StaticOrder S; S.init(T, 1024, gridDim.x, blockIdx.x);
        EpiOutRes<false> E{p.out, p.out + (size_t)T_P * 1024, p.out, nullptr, (float*)(ws + WS_RSQ2)};
        pg8::gemm_phase<EpiOutRes<false>>(L, g, S, E);
    }
    SEAM(7);
    if (IN(8)) phase8(p);
#undef IN
#undef SEAM
}

extern "C" void kernel_launch(void* const* d_in, const int* in_sizes, int n_in, void* d_out, int out_size, void* d_ws, size_t ws_size, hipStream_t stream) {
    static int grid_blocks = 0;
    if (grid_blocks == 0) {
        if (n_in != 25 || (size_t)out_size != O_END || ws_size < WS_END) { fprintf(stderr, "kernel_launch: unexpected shapes n_in %d out %d ws %zu (need %zu)\n", n_in, out_size, ws_size, (size_t)WS_END); grid_blocks = -1; return; }
        int dev = 0, cus = 0, per_cu = 0;
        (void)hipGetDevice(&dev);
        (void)hipDeviceGetAttribute(&cus, hipDeviceAttributeMultiprocessorCount, dev);
        if (hipFuncSetAttribute((const void*)mega, hipFuncAttributeMaxDynamicSharedMemorySize, LDS_BYTES) != hipSuccess) { fprintf(stderr, "kernel_launch: hipFuncSetAttribute failed\n"); }
        if (hipOccupancyMaxActiveBlocksPerMultiprocessor(&per_cu, (const void*)mega, NTHR, LDS_BYTES) != hipSuccess || per_cu < 1) per_cu = 1;
        (void)hipGetLastError();
        grid_blocks = cus * per_cu;
        if (grid_blocks <= 0) grid_blocks = 256;
    }
    if (grid_blocks < 0) return;
    Params p{};
    for (int i = 0; i < 25; ++i) p.in[i] = (const float*)d_in[i];
    p.out = (float*)d_out; p.ws = (unsigned char*)d_ws;
#if ONE_LAUNCH
#ifdef PROBE_X
    { const int seq[3][2] = {{0, PROBE_Y + 1}, {PROBE_X, PROBE_Y + 1}, {PROBE_Y + 1, 9}};
      for (int li = 0; li < 3; ++li) { if (seq[li][0] >= seq[li][1]) continue; p.ph_lo = seq[li][0]; p.ph_hi = seq[li][1]; void* args[] = {&p};
        hipError_t e = hipLaunchCooperativeKernel((const void*)mega, dim3(grid_blocks), dim3(NTHR), args, LDS_BYTES, stream);
        if (e != hipSuccess) fprintf(stderr, "cooperative launch failed: %s (grid %d)\n", hipGetErrorString(e), grid_blocks); } }
#else
    p.ph_lo = 0; p.ph_hi = 9;
    { void* args[] = {&p}; hipError_t e = hipLaunchCooperativeKernel((const void*)mega, dim3(grid_blocks), dim3(NTHR), args, LDS_BYTES, stream);
      if (e != hipSuccess) fprintf(stderr, "cooperative launch failed: %s (grid %d)\n", hipGetErrorString(e), grid_blocks); }
#endif
#else
    for (int ph = 0; ph < 9; ++ph) {
        p.ph_lo = ph; p.ph_hi = ph + 1;
        void* args[] = {&p}; hipError_t e = hipLaunchCooperativeKernel((const void*)mega, dim3(grid_blocks), dim3(NTHR), args, LDS_BYTES, stream);
        if (e != hipSuccess) fprintf(stderr, "cooperative launch %d failed: %s (grid %d)\n", ph, hipGetErrorString(e), grid_blocks);
    }
#endif
}
```

```cpp
#include <hip/hip_runtime.h>
#include <hip/hip_cooperative_groups.h>
#include <cstdio>
namespace cg = cooperative_groups;

#ifndef ONE_LAUNCH
#define ONE_LAUNCH 1
#endif

#define LAS __attribute__((address_space(3)))
typedef unsigned short bf16_t;
typedef short bf16x8 __attribute__((ext_vector_type(8)));
typedef short bf16x4 __attribute__((ext_vector_type(4)));
typedef float f32x4 __attribute__((ext_vector_type(4)));
typedef unsigned u32x4 __attribute__((ext_vector_type(4)));
typedef unsigned u32x2 __attribute__((ext_vector_type(2)));

constexpr int T_P = 32768, T_S = 2048, T = T_P + T_S, DM = 1024;
constexpr int NE_PAD = 6144;
constexpr int LDS_BYTES = 159744;
constexpr int NTHR = 512;
constexpr float EPS = 1e-6f;

constexpr size_t WS_WINE = 0;
constexpr size_t WS_WOUTE = WS_WINE + (size_t)NE_PAD * 1024 * 2;
constexpr size_t WS_WINO = WS_WOUTE + (size_t)1024 * 2048 * 2;
constexpr size_t WS_WOUTO = WS_WINO + (size_t)3072 * 1024 * 2;
constexpr size_t WS_WA = WS_WOUTO + (size_t)1024 * 1536 * 2;
constexpr size_t WS_WI = WS_WA + (size_t)8 * 192 * 192 * 2;
constexpr size_t WS_XB = WS_WI + (size_t)8 * 192 * 192 * 2;
constexpr size_t WS_RSTD0 = WS_XB + (size_t)T * 1024 * 2;
constexpr size_t WS_RSQ1 = WS_RSTD0 + (size_t)T * 4;
constexpr size_t WS_RSQ2 = WS_RSQ1 + (size_t)T * 4;
constexpr size_t WS_BOSQ = WS_RSQ2 + (size_t)T * 4;
constexpr size_t WS_Q = WS_BOSQ + (size_t)T * 16;
constexpr size_t WS_K = WS_Q + (size_t)T * 1024 * 2;
constexpr size_t WS_V = WS_K + (size_t)T * 256 * 2;
constexpr size_t WS_BQ = WS_V + (size_t)T * 256 * 2;
constexpr size_t WS_BK = WS_BQ + (size_t)T * 512 * 2;
constexpr size_t WS_BV = WS_BK + (size_t)T * 512 * 2;
constexpr size_t WS_GATE = WS_BV + (size_t)T * 1024 * 2;
constexpr size_t WS_BLR = WS_GATE + (size_t)T * 2048 * 2;
constexpr size_t WS_END = WS_BLR + (size_t)T * 512 * 2;
constexpr size_t WS_Z2 = WS_Q;
constexpr size_t WS_Y2 = WS_GATE;
static_assert(WS_Z2 + (size_t)T * 3072 * 2 <= WS_GATE, "Z2 alias");

constexpr size_t O_Y = 0;
constexpr size_t O_KP = (size_t)T * 1024;
constexpr size_t O_VP = O_KP + 524288;
constexpr size_t O_GP = O_VP + 524288;
constexpr size_t O_CP = O_GP + 2097152;
constexpr size_t O_LP = O_CP + 73728;
constexpr size_t O_KS = O_LP + 24576;
constexpr size_t O_VS = O_KS + 524288;
constexpr size_t O_GS = O_VS + 524288;
constexpr size_t O_CS = O_GS + 4194304;
constexpr size_t O_LS = O_CS + 147456;
constexpr size_t O_END = O_LS + 49152;

struct Params {
    const float* in[25];
    float* out;
    unsigned char* ws;
    int ph_lo, ph_hi;
};

__device__ __forceinline__ unsigned cvt_pk_bf16(float lo, float hi) { unsigned r; asm volatile("v_cvt_pk_bf16_f32 %0, %1, %2" : "=v"(r) : "v"(lo), "v"(hi)); return r; }
__device__ __forceinline__ bf16_t f2bf(float f) { return (bf16_t)(cvt_pk_bf16(f, 0.f) & 0xffffu); }
__device__ __forceinline__ float bf2f(bf16_t b) { return __uint_as_float(((unsigned)b) << 16); }
__device__ __forceinline__ float bflo(unsigned w) { return __uint_as_float(w << 16); }
__device__ __forceinline__ float bfhi(unsigned w) { return __uint_as_float(w & 0xffff0000u); }
__device__ __forceinline__ float rcpf_(float x) { return __builtin_amdgcn_rcpf(x); }
__device__ __forceinline__ float siluf(float x) { return x * rcpf_(1.f + __expf(-x)); }
__device__ __forceinline__ float sigmf(float x) { return rcpf_(1.f + __expf(-x)); }
__device__ __forceinline__ void lds_barrier() { asm volatile("s_waitcnt lgkmcnt(0)" ::: "memory"); __builtin_amdgcn_s_barrier(); asm volatile("" ::: "memory"); }
__device__ __forceinline__ bf16x8 pack8(const f32x4& a, const f32x4& b) {
    u32x4 p; p.x = cvt_pk_bf16(a[0], a[1]); p.y = cvt_pk_bf16(a[2], a[3]); p.z = cvt_pk_bf16(b[0], b[1]); p.w = cvt_pk_bf16(b[2], b[3]);
    return __builtin_bit_cast(bf16x8, p);
}
__device__ __forceinline__ bf16x8 cat4(const bf16x4 a, const bf16x4 b) { bf16x8 r; r[0] = a[0]; r[1] = a[1]; r[2] = a[2]; r[3] = a[3]; r[4] = b[0]; r[5] = b[1]; r[6] = b[2]; r[7] = b[3]; return r; }
__device__ __forceinline__ void unpack8(const u32x4 w, float (&v)[8]) { v[0] = bflo(w.x); v[1] = bfhi(w.x); v[2] = bflo(w.y); v[3] = bfhi(w.y); v[4] = bflo(w.z); v[5] = bfhi(w.z); v[6] = bflo(w.w); v[7] = bfhi(w.w); }
#define MFMA16(a, b, c) __builtin_amdgcn_mfma_f32_16x16x32_bf16((a), (b), (c), 0, 0, 0)

namespace pg8 {
constexpr int BM = 256, BK = 64, HALF = 128, HTB = HALF * BK * 2, STAGE_BYTES = 8 * HTB, NXCD = 8, WGM = 8;
__device__ __forceinline__ int lds_byte(int r, int c) { const int st = (r >> 4) * 2 + (c >> 5), rr = r & 15, cc = c & 31, ob = rr * 64 + cc * 2; return st * 1024 + (ob ^ (((ob >> 9) & 1) << 5)); }
__device__ __forceinline__ int perm32(int rho) { const int n = rho >> 4, i = rho & 15; return 8 * (i >> 2) + 4 * n + (i & 3); }
__device__ __forceinline__ void stage_rc(int b, int& R, int& C) { const int st = b / 1024, sb = b % 1024, swz = sb ^ (((sb >> 9) & 1) << 5); R = (st >> 1) * 16 + swz / 64; C = (st & 1) * 32 + (swz % 64) / 2; }
struct Unit { int pm, pn; };
struct Gemm { const bf16_t* A; const bf16_t* Bt; int M, N, K; };
struct StaticOrder {
    int nM, nN, nwg, G, c;
    __device__ void init(int M, int N, int G_, int c_) { nM = M / BM; nN = N / BM; nwg = nM * nN; G = G_; c = c_; }
    __device__ __forceinline__ bool next(int i, Unit& u) const {
        const long Lx = (long)i * G + c; if (Lx >= nwg) return false;
        int wgid = (int)Lx; { const int q = nwg / NXCD, r = nwg % NXCD, xcd = wgid % NXCD, off = wgid / NXCD; wgid = (xcd < r ? xcd * (q + 1) : r * (q + 1) + (xcd - r) * q) + off; }
        const int nig = WGM * nN, gid = wgid / nig, fm = gid * WGM, gsz = (nM - fm) < WGM ? (nM - fm) : WGM;
        u.pm = fm + ((wgid % nig) % gsz); u.pn = (wgid % nig) / gsz; return true;
    }
};

template <class Epi>
__device__ __forceinline__ void gemm_phase(LAS unsigned char* lds, const Gemm g, const StaticOrder& S, const Epi& E) {
    const int tid = threadIdx.x, wid = __builtin_amdgcn_readfirstlane(tid >> 6), lane = tid & 63, wr = wid >> 2, wc = wid & 3, fr = lane & 15, fq = lane >> 4;
    const int K = g.K, nt = K / BK;
    unsigned voffA[2], voffB[2];
#pragma unroll
    for (int i = 0; i < 2; ++i) { int R, C; stage_rc(tid * 16 + i * 8192, R, C); const int Rb = Epi::PERM ? ((R & ~31) + perm32(R & 31)) : R;
        voffA[i] = (unsigned)(R * K + C) * 2u; voffB[i] = (unsigned)(Rb * K + C) * 2u; }
    const size_t kstep = (size_t)(BK * 2);
    const size_t hstep = (size_t)HALF * K * 2;
    const size_t tstep = 2 * hstep;
    const unsigned ldsw = (unsigned)wid * 1024u;
    const int aoff = lds_byte(wr * 64 + fr, fq * 8), boff = lds_byte(wc * 32 + fr, fq * 8);
#define PG8_SA(b, h) (((b) * 2 + (h)) * HTB)
#define PG8_SB(b, h) ((4 + (b) * 2 + (h)) * HTB)
#define PG8_STAGE(bufoff, gbase, voff) do { _Pragma("unroll") for (int _i = 0; _i < 2; ++_i) \
        __builtin_amdgcn_global_load_lds((const unsigned*)((const char*)(gbase) + (voff)[_i]), (LAS unsigned*)(lds + (bufoff) + ldsw + _i * 8192), 16, 0, 0); } while (0)
#define PG8_LDA(dst, b, h) do { _Pragma("unroll") for (int m = 0; m < 4; ++m) _Pragma("unroll") for (int k = 0; k < 2; ++k) dst[m][k] = *(const LAS bf16x8*)(lds + PG8_SA(b, h) + aoff + m * 2048 + k * 1024); } while (0)
#define PG8_LDB(dst, b, h) do { _Pragma("unroll") for (int n = 0; n < 2; ++n) _Pragma("unroll") for (int k = 0; k < 2; ++k) dst[n][k] = *(const LAS bf16x8*)(lds + PG8_SB(b, h) + boff + n * 2048 + k * 1024); } while (0)
#define PG8_MMA(ai, bj, At, Bt) do { __builtin_amdgcn_s_setprio(1); _Pragma("unroll") for (int m = 0; m < 4; ++m) _Pragma("unroll") for (int n = 0; n < 2; ++n) _Pragma("unroll") for (int k = 0; k < 2; ++k) \
        acc[ai][bj][m][n] = __builtin_amdgcn_mfma_f32_16x16x32_bf16(Bt[n][k], At[m][k], acc[ai][bj][m][n], 0, 0, 0); __builtin_amdgcn_s_setprio(0); } while (0)
#define PG8_WAIT_V(n) asm volatile("s_waitcnt vmcnt(" #n ")" ::: "memory")
#define PG8_WAIT_L(n) asm volatile("s_waitcnt lgkmcnt(" #n ")" ::: "memory")
#define PG8_BAR __builtin_amdgcn_s_barrier()
#define PG8_SCHED __builtin_amdgcn_sched_barrier(0)
    Unit cur, nxt; int ui = 0;
    if (!S.next(0, cur)) return;
    f32x4 acc[2][2][4][2];
#pragma unroll
    for (int a = 0; a < 2; ++a)
#pragma unroll
        for (int b = 0; b < 2; ++b)
#pragma unroll
            for (int m = 0; m < 4; ++m)
#pragma unroll
                for (int n = 0; n < 2; ++n) acc[a][b][m][n] = (f32x4){0.f, 0.f, 0.f, 0.f};
    bf16x8 At[4][2], B0[2][2], B1[2][2];
    const char* cA = (const char*)g.A + (size_t)cur.pm * tstep; const char* cB = (const char*)g.Bt + (size_t)cur.pn * tstep;
    PG8_STAGE(PG8_SB(0, 0), cB, voffB); PG8_STAGE(PG8_SA(0, 0), cA, voffA); PG8_STAGE(PG8_SB(0, 1), cB + hstep, voffB); PG8_STAGE(PG8_SA(0, 1), cA + hstep, voffA);
    if (wr == 1) PG8_BAR;
    PG8_WAIT_V(4); PG8_BAR;
    PG8_STAGE(PG8_SB(1, 0), cB + kstep, voffB); PG8_STAGE(PG8_SA(1, 0), cA + kstep, voffA); PG8_STAGE(PG8_SB(1, 1), cB + hstep + kstep, voffB);
    PG8_WAIT_V(6); PG8_BAR;
    for (;;) {
        const bool has_next = S.next(ui + 1, nxt);
        const char* nA = has_next ? (const char*)g.A + (size_t)nxt.pm * tstep : cA; const char* nB = has_next ? (const char*)g.Bt + (size_t)nxt.pn * tstep : cB;
        for (int t = 0; t < nt; t += 2) {
            const bool last = (t == nt - 2);
            const char* a1 = cA + (size_t)(t + 1) * kstep;
            const char* a2 = last ? nA : cA + (size_t)(t + 2) * kstep; const char* b2 = last ? nB : cB + (size_t)(t + 2) * kstep;
            const char* a3 = a2 + kstep; const char* b3 = b2 + kstep;
            PG8_LDB(B0, 0, 0); PG8_SCHED; PG8_LDA(At, 0, 0); PG8_STAGE(PG8_SA(1, 1), a1 + hstep, voffA);
            PG8_WAIT_L(8); PG8_BAR; PG8_WAIT_L(0); PG8_MMA(0, 0, At, B0); PG8_BAR; PG8_SCHED;
            PG8_LDB(B1, 0, 1); PG8_STAGE(PG8_SB(0, 0), b2, voffB);
            PG8_BAR; PG8_WAIT_L(0); PG8_MMA(0, 1, At, B1); PG8_BAR;
            PG8_LDA(At, 0, 1); PG8_STAGE(PG8_SA(0, 0), a2, voffA);
            PG8_BAR; PG8_WAIT_L(0); PG8_MMA(1, 0, At, B0); PG8_BAR; PG8_SCHED;
            PG8_STAGE(PG8_SB(0, 1), b2 + hstep, voffB);
            PG8_WAIT_V(6); PG8_BAR; PG8_MMA(1, 1, At, B1); PG8_BAR;
            PG8_LDB(B0, 1, 0); PG8_SCHED; PG8_LDA(At, 1, 0); PG8_STAGE(PG8_SA(0, 1), a2 + hstep, voffA);
            PG8_WAIT_L(8); PG8_BAR; PG8_WAIT_L(0); PG8_MMA(0, 0, At, B0); PG8_BAR; PG8_SCHED;
            PG8_LDB(B1, 1, 1); PG8_STAGE(PG8_SB(1, 0), b3, voffB);
            PG8_BAR; PG8_WAIT_L(0); PG8_MMA(0, 1, At, B1); PG8_BAR;
            PG8_LDA(At, 1, 1); PG8_STAGE(PG8_SA(1, 0), a3, voffA);
            PG8_BAR; PG8_WAIT_L(0); PG8_MMA(1, 0, At, B0); PG8_BAR; PG8_SCHED;
            PG8_STAGE(PG8_SB(1, 1), b3 + hstep, voffB);
            PG8_WAIT_V(6); PG8_BAR; PG8_MMA(1, 1, At, B1); PG8_BAR;
        }
        E(acc, cur, wr, wc, fr, fq);
        if (!has_next) break;
#pragma unroll
        for (int a = 0; a < 2; ++a)
#pragma unroll
            for (int b = 0; b < 2; ++b)
#pragma unroll
                for (int m = 0; m < 4; ++m)
#pragma unroll
                    for (int n = 0; n < 2; ++n) acc[a][b][m][n] = (f32x4){0.f, 0.f, 0.f, 0.f};
        cur = nxt; cA = nA; cB = nB; ++ui;
    }
    PG8_WAIT_V(0);
    if (wr == 0) PG8_BAR;
    PG8_BAR;
#undef PG8_SA
#undef PG8_SB
#undef PG8_STAGE
#undef PG8_LDA
#undef PG8_LDB
#undef PG8_MMA
#undef PG8_WAIT_V
#undef PG8_WAIT_L
#undef PG8_BAR
#undef PG8_SCHED
}
}

typedef f32x4 AccT[2][2][4][2];

struct EpiInEven {
    static constexpr bool PERM = true;
    unsigned char* ws; float* out; const float* rstd; const float* blr_b;
    __device__ __forceinline__ void operator()(const AccT& acc, const pg8::Unit& u, int wr, int wc, int fr, int fq) const {
        const int pn = u.pn;
        bf16_t* base; int ld, coff; float sc = 1.f;
        if (pn < 4) { base = (bf16_t*)(ws + WS_Q); ld = 1024; coff = pn * 256; sc = 0.125f; }
        else if (pn == 4) { base = (bf16_t*)(ws + WS_K); ld = 256; coff = 0; }
        else if (pn == 5) { base = (bf16_t*)(ws + WS_V); ld = 256; coff = 0; }
        else if (pn < 8) { base = (bf16_t*)(ws + WS_BQ); ld = 512; coff = (pn - 6) * 256; sc = 0.08838834764831845f; }
        else if (pn < 10) { base = (bf16_t*)(ws + WS_BK); ld = 512; coff = (pn - 8) * 256; }
        else if (pn < 14) { base = (bf16_t*)(ws + WS_BV); ld = 1024; coff = (pn - 10) * 256; }
        else if (pn < 22) { base = (bf16_t*)(ws + WS_GATE); ld = 2048; coff = (pn - 14) * 256; }
        else { base = (bf16_t*)(ws + WS_BLR); ld = 512; coff = (pn - 22) * 256; }
        const int row0 = u.pm * 256 + wr * 64 + fr;
        const int ct = wc * 32 + 8 * fq;
        if (pn >= 22) {
#pragma unroll
            for (int ai = 0; ai < 2; ++ai)
#pragma unroll
                for (int m = 0; m < 4; ++m) {
                    const int row = row0 + ai * 128 + m * 16; const float rs = rstd[row];
#pragma unroll
                    for (int bj = 0; bj < 2; ++bj) {
                        const int cg = coff + ct + bj * 128;
                        const f32x4 b0 = *(const f32x4*)(blr_b + cg), b1 = *(const f32x4*)(blr_b + cg + 4);
                        f32x4 x0 = acc[ai][bj][m][0] * rs + b0, x1 = acc[ai][bj][m][1] * rs + b1;
#pragma unroll
                        for (int j = 0; j < 4; ++j) { x0[j] = (fminf(x0[j], 0.f) - __logf(1.f + __expf(-fabsf(x0[j])))) * (1.f / 16.f); x1[j] = (fminf(x1[j], 0.f) - __logf(1.f + __expf(-fabsf(x1[j])))) * (1.f / 16.f); }
                        u32x4 w; w.x = cvt_pk_bf16(x0[0], x0[1]); w.y = cvt_pk_bf16(x0[2], x0[3]); w.z = cvt_pk_bf16(x1[0], x1[1]); w.w = cvt_pk_bf16(x1[2], x1[3]);
                        *(u32x4*)(base + (size_t)row * 512 + cg) = w;
                    }
                }
            return;
        }
        const bool kv = (pn == 4 || pn == 5);
        float* okv_p = out + (pn == 4 ? O_KP : O_VP); float* okv_s = out + (pn == 4 ? O_KS : O_VS);
#pragma unroll
        for (int ai = 0; ai < 2; ++ai)
#pragma unroll
            for (int m = 0; m < 4; ++m) {
                const int row = row0 + ai * 128 + m * 16; const float rs = rstd[row] * sc;
                bf16_t* rowp = base + (size_t)row * ld + coff + ct;
                float* orow = nullptr;
                if (kv) {
                    if (row >= T_P) orow = okv_s + (size_t)(row - T_P) * 256;
                    else { const int b = row >> 11, t = row & 2047; if (t >= 1920) orow = okv_p + (size_t)(b * 128 + t - 1920) * 256; }
                }
#pragma unroll
                for (int bj = 0; bj < 2; ++bj) {
                    const f32x4 v0 = acc[ai][bj][m][0] * rs, v1 = acc[ai][bj][m][1] * rs;
                    u32x4 w; w.x = cvt_pk_bf16(v0[0], v0[1]); w.y = cvt_pk_bf16(v0[2], v0[3]); w.z = cvt_pk_bf16(v1[0], v1[1]); w.w = cvt_pk_bf16(v1[2], v1[3]);
                    *(u32x4*)(rowp + bj * 128) = w;
                    if (kv && orow) { *(f32x4*)(orow + bj * 128 + ct) = v0; *(f32x4*)(orow + bj * 128 + ct + 4) = v1; }
                }
            }
    }
};

template <bool WRITE_BF>
struct EpiOutRes {
    static constexpr bool PERM = false;
    const float* xin_p; const float* xin_s; float* xo; bf16_t* xb; float* rowsq;
    __device__ __forceinline__ void operator()(const AccT& acc, const pg8::Unit& u, int wr, int wc, int fr, int fq) const {
        const int row0 = u.pm * 256 + wr * 64 + fr, col0 = u.pn * 256 + wc * 32 + 4 * fq;
#pragma unroll
        for (int ai = 0; ai < 2; ++ai)
#pragma unroll
            for (int m = 0; m < 4; ++m) {
                const int row = row0 + ai * 128 + m * 16;
                const float* xr = (row < T_P) ? xin_p + (size_t)row * 1024 : xin_s + (size_t)(row - T_P) * 1024;
                float ss = 0.f;
#pragma unroll
                for (int bj = 0; bj < 2; ++bj)
#pragma unroll
                    for (int n = 0; n < 2; ++n) {
                        const int col = col0 + bj * 128 + n * 16;
                        const f32x4 v = acc[ai][bj][m][n] + *(const f32x4*)(xr + col);
                        *(f32x4*)(xo + (size_t)row * 1024 + col) = v;
                        if (WRITE_BF) { u32x2 w; w.x = cvt_pk_bf16(v[0], v[1]); w.y = cvt_pk_bf16(v[2], v[3]); *(u32x2*)(xb + (size_t)row * 1024 + col) = w; }
                        ss += v[0] * v[0] + v[1] * v[1] + v[2] * v[2] + v[3] * v[3];
                    }
                ss += __shfl_xor(ss, 16); ss += __shfl_xor(ss, 32);
                if (fq == 0) atomicAdd(rowsq + row, ss);
            }
    }
};

struct EpiInOdd {
    static constexpr bool PERM = true;
    bf16_t* z2; const float* rowsq;
    __device__ __forceinline__ void operator()(const AccT& acc, const pg8::Unit& u, int wr, int wc, int fr, int fq) const {
        const int row0 = u.pm * 256 + wr * 64 + fr, col0 = u.pn * 256 + wc * 32 + 8 * fq;
#pragma unroll
        for (int ai = 0; ai < 2; ++ai)
#pragma unroll
            for (int m = 0; m < 4; ++m) {
                const int row = row0 + ai * 128 + m * 16; const float rs = rsqrtf(rowsq[row] * (1.f / 1024.f) + EPS);
#pragma unroll
                for (int bj = 0; bj < 2; ++bj) {
                    const f32x4 v0 = acc[ai][bj][m][0] * rs, v1 = acc[ai][bj][m][1] * rs;
                    u32x4 w; w.x = cvt_pk_bf16(v0[0], v0[1]); w.y = cvt_pk_bf16(v0[2], v0[3]); w.z = cvt_pk_bf16(v1[0], v1[1]); w.w = cvt_pk_bf16(v1[2], v1[3]);
                    *(u32x4*)(z2 + (size_t)row * 3072 + col0 + bj * 128) = w;
                }
            }
    }
};

template <int MODE>
__device__ __forceinline__ void transpose_w(const float* __restrict__ src, int K, int Nsrc, bf16_t* __restrict__ dst, int Ndst, const float* __restrict__ gain, long gtid, long gsz) {
    const long total = (long)(K / 8) * Ndst;
    for (long it = gtid; it < total; it += gsz) {
        const int n = (int)(it % Ndst), k8 = (int)(it / Ndst);
        int sc = n;
        if (MODE == 1) { if (n < 3584) sc = n; else sc = n + 16; }
        u32x4 w = {0u, 0u, 0u, 0u};
        if (sc >= 0) {
            const float* s = src + (size_t)(k8 * 8) * Nsrc + sc;
            float v0 = s[0], v1 = s[(size_t)Nsrc], v2 = s[(size_t)2 * Nsrc], v3 = s[(size_t)3 * Nsrc], v4 = s[(size_t)4 * Nsrc], v5 = s[(size_t)5 * Nsrc], v6 = s[(size_t)6 * Nsrc], v7 = s[(size_t)7 * Nsrc];
            if (gain) { const f32x4 g0 = *(const f32x4*)(gain + k8 * 8), g1 = *(const f32x4*)(gain + k8 * 8 + 4); v0 *= g0[0]; v1 *= g0[1]; v2 *= g0[2]; v3 *= g0[3]; v4 *= g1[0]; v5 *= g1[1]; v6 *= g1[2]; v7 *= g1[3]; }
            w.x = cvt_pk_bf16(v0, v1); w.y = cvt_pk_bf16(v2, v3); w.z = cvt_pk_bf16(v4, v5); w.w = cvt_pk_bf16(v6, v7);
        }
        *(u32x4*)(dst + (size_t)n * K + k8 * 8) = w;
    }
}

__device__ __forceinline__ void phase0(const Params& p) {
    unsigned char* ws = p.ws;
    const long gtid = (long)blockIdx.x * NTHR + threadIdx.x, gsz = (long)gridDim.x * NTHR;
    transpose_w<1>(p.in[8], 1024, 5648, (bf16_t*)(ws + WS_WINE), 5632, p.in[7], gtid, gsz);
    for (long it = gtid; it < 128L * 512; it += gsz) {
        const int n = (int)(it & 511), k8 = (int)(it >> 9);
        float wl[16];
#pragma unroll
        for (int r = 0; r < 16; ++r) wl[r] = p.in[9][r * 512 + n];
        float v[8];
#pragma unroll
        for (int i = 0; i < 8; ++i) {
            const float* wr_ = p.in[8] + (size_t)(k8 * 8 + i) * 5648 + 3584;
            float a = 0.f;
#pragma unroll
            for (int r4 = 0; r4 < 4; ++r4) { const f32x4 x = *(const f32x4*)(wr_ + r4 * 4); a += x[0] * wl[r4 * 4] + x[1] * wl[r4 * 4 + 1] + x[2] * wl[r4 * 4 + 2] + x[3] * wl[r4 * 4 + 3]; }
            v[i] = a * p.in[7][k8 * 8 + i];
        }
        u32x4 w; w.x = cvt_pk_bf16(v[0], v[1]); w.y = cvt_pk_bf16(v[2], v[3]); w.z = cvt_pk_bf16(v[4], v[5]); w.w = cvt_pk_bf16(v[6], v[7]);
        *(u32x4*)((bf16_t*)(ws + WS_WINE) + (size_t)(5632 + n) * 1024 + k8 * 8) = w;
    }
    transpose_w<0>(p.in[13], 2048, 1024, (bf16_t*)(ws + WS_WOUTE), 1024, nullptr, gtid, gsz);
    transpose_w<0>(p.in[15], 1024, 3072, (bf16_t*)(ws + WS_WINO), 3072, p.in[14], gtid, gsz);
    transpose_w<0>(p.in[23], 1536, 1024, (bf16_t*)(ws + WS_WOUTO), 1024, nullptr, gtid, gsz);
    for (int nb = 0; nb < 8; ++nb) {
        transpose_w<0>(p.in[18] + nb * 192 * 192, 192, 192, (bf16_t*)(ws + WS_WA) + nb * 192 * 192, 192, nullptr, gtid, gsz);
        transpose_w<0>(p.in[20] + nb * 192 * 192, 192, 192, (bf16_t*)(ws + WS_WI) + nb * 192 * 192, 192, nullptr, gtid, gsz);
    }
    { float* z = (float*)(ws + WS_RSQ1); const long nz = (long)T * 6; for (long i = gtid; i < nz; i += gsz) z[i] = 0.f; }
    const int lane = threadIdx.x & 63; const int gw = (int)(gtid >> 6), nw = (int)(gsz >> 6);
    bf16_t* xb = (bf16_t*)(ws + WS_XB); float* rstd = (float*)(ws + WS_RSTD0);
    for (int row = gw; row < T; row += nw) {
        const float* xr = (row < T_P) ? p.in[0] + (size_t)row * 1024 : p.in[1] + (size_t)(row - T_P) * 1024;
        float ss = 0.f;
#pragma unroll
        for (int i = 0; i < 4; ++i) {
            const f32x4 v = *(const f32x4*)(xr + i * 256 + lane * 4);
            ss += v[0] * v[0] + v[1] * v[1] + v[2] * v[2] + v[3] * v[3];
            u32x2 w; w.x = cvt_pk_bf16(v[0], v[1]); w.y = cvt_pk_bf16(v[2], v[3]);
            *(u32x2*)(xb + (size_t)row * 1024 + i * 256 + lane * 4) = w;
        }
#pragma unroll
        for (int o = 32; o >= 1; o >>= 1) ss += __shfl_xor(ss, o);
        if (lane == 0) rstd[row] = rsqrtf(ss * (1.f / 1024.f) + EPS);
    }
}

__device__ __forceinline__ void attn_item(const Params& p, LAS unsigned char* L, int item, bf16_t* Yd, int ldd) {
    unsigned char* ws = p.ws;
    const int tid = threadIdx.x, lane = tid & 63, w = tid >> 6, r16 = lane & 15, q4 = lane >> 4;
    LAS bf16_t* Ks = (LAS bf16_t*)L;
    LAS bf16_t* Vt = (LAS bf16_t*)(L + 192 * 72 * 2);
    const bf16_t* Qb = (const bf16_t*)(ws + WS_Q); const bf16_t* Kb = (const bf16_t*)(ws + WS_K); const bf16_t* Vb = (const bf16_t*)(ws + WS_V);
    bf16_t* Yb = (bf16_t*)(ws + WS_GATE);
    const bool smp = item >= 2048;
    int b, c, kh; size_t row0;
    if (!smp) { kh = item & 3; c = (item >> 2) & 31; b = item >> 7; row0 = (size_t)b * 2048 + c * 64; }
    else { const int i2 = item - 2048; kh = i2 & 3; b = i2 >> 2; c = 0; row0 = (size_t)T_P + b * 64; }
#pragma unroll
    for (int i = 0; i < 3; ++i) {
        const int idx = tid + i * 512, key = idx >> 3, dg = idx & 7;
        u32x4 kv = {0u, 0u, 0u, 0u}, vv = {0u, 0u, 0u, 0u};
        if (!smp) {
            const int pos = c * 64 - 128 + key;
            if (pos >= 0) { const size_t r = (size_t)b * 2048 + pos; kv = *(const u32x4*)(Kb + r * 256 + kh * 64 + dg * 8); vv = *(const u32x4*)(Vb + r * 256 + kh * 64 + dg * 8); }
        } else {
            if (key < 128) {
                const size_t o = ((size_t)(b * 128 + key) * 4 + kh) * 64 + dg * 8;
                const f32x4 k0 = *(const f32x4*)(p.in[2] + o), k1 = *(const f32x4*)(p.in[2] + o + 4), v0 = *(const f32x4*)(p.in[3] + o), v1 = *(const f32x4*)(p.in[3] + o + 4);
                kv.x = cvt_pk_bf16(k0[0], k0[1]); kv.y = cvt_pk_bf16(k0[2], k0[3]); kv.z = cvt_pk_bf16(k1[0], k1[1]); kv.w = cvt_pk_bf16(k1[2], k1[3]);
                vv.x = cvt_pk_bf16(v0[0], v0[1]); vv.y = cvt_pk_bf16(v0[2], v0[3]); vv.z = cvt_pk_bf16(v1[0], v1[1]); vv.w = cvt_pk_bf16(v1[2], v1[3]);
            } else { const size_t r = (size_t)T_P + b * 64 + key - 128; kv = *(const u32x4*)(Kb + r * 256 + kh * 64 + dg * 8); vv = *(const u32x4*)(Vb + r * 256 + kh * 64 + dg * 8); }
        }
        *(LAS u32x4*)(Ks + key * 72 + dg * 8) = kv;
#pragma unroll
        for (int e = 0; e < 8; ++e) Vt[(dg * 8 + e) * 200 + key] = (bf16_t)(vv[e >> 1] >> ((e & 1) * 16));
    }
    __syncthreads();
    const int g = w >> 1, i0 = (w & 1) * 32, h = kh * 4 + g;
    const float slope = exp2f(-0.5f * (float)(h + 1));
    const float sink = p.in[11][h];
#pragma unroll 1
    for (int qt = 0; qt < 2; ++qt) {
        const int i = i0 + qt * 16 + r16;
        bf16x8 qf[2];
#pragma unroll
        for (int ks = 0; ks < 2; ++ks) qf[ks] = *(const bf16x8*)(Qb + (row0 + i) * 1024 + h * 64 + ks * 32 + q4 * 8);
        f32x4 sacc[12];
#pragma unroll
        for (int kt = 0; kt < 12; ++kt) {
            const bf16x8 kf0 = *(const LAS bf16x8*)(Ks + (kt * 16 + r16) * 72 + q4 * 8), kf1 = *(const LAS bf16x8*)(Ks + (kt * 16 + r16) * 72 + 32 + q4 * 8);
            f32x4 a = {0.f, 0.f, 0.f, 0.f}; a = MFMA16(kf0, qf[0], a); a = MFMA16(kf1, qf[1], a); sacc[kt] = a;
        }
        float m = -3e38f;
#pragma unroll
        for (int kt = 0; kt < 12; ++kt)
#pragma unroll
            for (int jj = 0; jj < 4; ++jj) {
                const int j = kt * 16 + q4 * 4 + jj;
                float sv = sacc[kt][jj] - slope * fabsf((float)(128 + i - j));
                if (!smp && (c * 64 - 128 + j) < 0) sv = -1e30f;
                sacc[kt][jj] = sv; m = fmaxf(m, sv);
            }
        m = fmaxf(m, __shfl_xor(m, 16)); m = fmaxf(m, __shfl_xor(m, 32)); m = fmaxf(m, sink);
        float l = 0.f;
#pragma unroll
        for (int kt = 0; kt < 12; ++kt)
#pragma unroll
            for (int jj = 0; jj < 4; ++jj) { const float pr = __expf(sacc[kt][jj] - m); sacc[kt][jj] = pr; l += pr; }
        l += __shfl_xor(l, 16); l += __shfl_xor(l, 32); l += __expf(sink - m);
        const float inv = 1.f / l;
        f32x4 oacc[4];
#pragma unroll
        for (int dt = 0; dt < 4; ++dt) oacc[dt] = (f32x4){0.f, 0.f, 0.f, 0.f};
#pragma unroll
        for (int kb = 0; kb < 6; ++kb) {
            const bf16x8 pf = pack8(sacc[2 * kb], sacc[2 * kb + 1]);
#pragma unroll
            for (int dt = 0; dt < 4; ++dt) {
                const LAS bf16_t* vp = Vt + (dt * 16 + r16) * 200 + kb * 32 + q4 * 4;
                const bf16x8 vf = cat4(*(const LAS bf16x4*)vp, *(const LAS bf16x4*)(vp + 16));
                oacc[dt] = MFMA16(vf, pf, oacc[dt]);
            }
        }
#pragma unroll
        for (int dt = 0; dt < 4; ++dt) {
            const size_t off = (row0 + i) * 2048 + h * 64 + dt * 16 + q4 * 4;
            const u32x2 gv = *(const u32x2*)(Yb + off);
            const f32x4 o = oacc[dt] * inv;
            u32x2 wv; wv.x = cvt_pk_bf16(o[0] * siluf(bflo(gv.x)), o[1] * siluf(bfhi(gv.x))); wv.y = cvt_pk_bf16(o[2] * siluf(bflo(gv.y)), o[3] * siluf(bfhi(gv.y)));
            *(u32x2*)(Yd + (row0 + i) * ldd + h * 64 + dt * 16 + q4 * 4) = wv;
        }
    }
    __syncthreads();
}

__device__ __forceinline__ void gla_item(const Params& p, LAS unsigned char* L, int item) {
    unsigned char* ws = p.ws;
    const int tid = threadIdx.x, lane = tid & 63, w = tid >> 6, r16 = lane & 15, q4 = lane >> 4;
    LAS bf16_t* QG = (LAS bf16_t*)L;
    LAS bf16_t* KG = (LAS bf16_t*)(L + 17408);
    LAS bf16_t* Vs = (LAS bf16_t*)(L + 34816);
    LAS bf16_t* Gs = (LAS bf16_t*)(L + 44032);
    LAS float* Gf = (LAS float*)(L + 61440);
    LAS float* GT = (LAS float*)(L + 94208);
    LAS float* GL = (LAS float*)(L + 96256);
    const unsigned lbase = (unsigned)(size_t)L;
    const bool smp = item >= 256;
    const int i2 = smp ? item - 256 : item;
    const int b = i2 >> 4, h = (i2 >> 2) & 3, sl = i2 & 3, e0 = sl * 64;
    const int nch = smp ? 1 : 32;
    const unsigned rbase = smp ? (unsigned)T_P + b * 64 : (unsigned)b * 2048;
    const bf16_t* BQ = (const bf16_t*)(ws + WS_BQ); const bf16_t* BKb = (const bf16_t*)(ws + WS_BK); bf16_t* BV = (bf16_t*)(ws + WS_BV);
    const bf16_t* GB = (const bf16_t*)(ws + WS_BLR); float* BOSQP = (float*)(ws + WS_XB);
    const int c = tid & 127, tg = tid >> 7;
    const int pt0 = tid >> 4, pt1 = (tid + 512) >> 4, poc = tid & 15;
    const int vt = tid >> 3, veo = tid & 7;
    const int et = w & 3, ip = w >> 2;
    f32x4 Sacc[8];
#pragma unroll
    for (int d8 = 0; d8 < 8; ++d8) {
        if (smp) {
#pragma unroll
            for (int jj = 0; jj < 4; ++jj) Sacc[d8][jj] = p.in[4][((size_t)(b * 4 + h) * 128 + d8 * 16 + q4 * 4 + jj) * 256 + e0 + et * 16 + r16];
        } else Sacc[d8] = (f32x4){0.f, 0.f, 0.f, 0.f};
    }
    const int tq_ = r16 >> 2, tp_ = r16 & 3;
    const unsigned v2a = lbase + 34816u + (unsigned)(((q4 * 4 + tq_) * 72 + et * 16 + 4 * tp_) * 2);
    const unsigned v4a = lbase + 34816u + (unsigned)(((q4 * 8 + tq_) * 72 + et * 16 + 4 * tp_) * 2);
    const unsigned k4a = lbase + 17408u + (unsigned)(((q4 * 8 + tq_) * 136 + 4 * tp_) * 2);
    u32x4 pq0, pq1, pk0, pk1, pg0, pg1, pv;
    {
        const unsigned o0 = (rbase + pt0) * 512u + h * 128 + poc * 8, o1 = (rbase + pt1) * 512u + h * 128 + poc * 8;
        pq0 = *(const u32x4*)(BQ + o0); pq1 = *(const u32x4*)(BQ + o1); pk0 = *(const u32x4*)(BKb + o0); pk1 = *(const u32x4*)(BKb + o1);
        pg0 = *(const u32x4*)(GB + o0); pg1 = *(const u32x4*)(GB + o1);
        pv = *(const u32x4*)(BV + (rbase + vt) * 1024u + h * 256 + e0 + veo * 8);
    }
    f32x4 po0 = {0.f, 0.f, 0.f, 0.f}, po1 = {0.f, 0.f, 0.f, 0.f}; unsigned prow = 0; bool pend = false;
#define GLA_STORE_OUT() do { \
            _Pragma("unroll") for (int x2 = 0; x2 < 2; ++x2) { \
                const unsigned row = prow + (ip * 2 + x2) * 16 + r16; \
                const f32x4 o = x2 ? po1 : po0; \
                u32x2 wv; wv.x = cvt_pk_bf16(o[0], o[1]); wv.y = cvt_pk_bf16(o[2], o[3]); \
                *(u32x2*)(BV + row * 1024u + h * 256 + e0 + et * 16 + q4 * 4) = wv; \
                float ss = o[0] * o[0] + o[1] * o[1] + o[2] * o[2] + o[3] * o[3]; \
                ss += __shfl_xor(ss, 16); ss += __shfl_xor(ss, 32); \
                if (q4 == 0) BOSQP[row * 64u + h * 16 + sl * 4 + et] = ss; \
            } } while (0)
    for (int ci = 0; ci < nch; ++ci) {
        const unsigned r0 = rbase + (unsigned)ci * 64;
        const bool more = (ci + 1 < nch);
        *(LAS u32x4*)(Gs + pt0 * 136 + poc * 8) = pg0; *(LAS u32x4*)(Gs + pt1 * 136 + poc * 8) = pg1;
        *(LAS u32x4*)(Vs + vt * 72 + veo * 8) = pv;
        lds_barrier();
        if (pend) GLA_STORE_OUT();
        if (more) pv = *(const u32x4*)(BV + (r0 + 64 + vt) * 1024u + h * 256 + e0 + veo * 8);
        {
            float cs = 0.f;
#pragma unroll
            for (int tt = 0; tt < 16; ++tt) { cs += bf2f(Gs[(tg * 16 + tt) * 136 + c]); Gf[(tg * 16 + tt) * 128 + c] = cs; }
            GT[tg * 128 + c] = cs;
        }
        lds_barrier();
#pragma unroll
        for (int i = 0; i < 2; ++i) {
            const int t = i ? pt1 : pt0; const int tgp = t >> 4;
            const u32x4 qw = i ? pq1 : pq0, kw = i ? pk1 : pk0;
            float G[8], tot[8];
            { const f32x4 a0 = *(const LAS f32x4*)(Gf + t * 128 + poc * 8), a1 = *(const LAS f32x4*)(Gf + t * 128 + poc * 8 + 4);
              G[0] = a0[0]; G[1] = a0[1]; G[2] = a0[2]; G[3] = a0[3]; G[4] = a1[0]; G[5] = a1[1]; G[6] = a1[2]; G[7] = a1[3]; }
#pragma unroll
            for (int j = 0; j < 8; ++j) tot[j] = 0.f;
#pragma unroll
            for (int g2 = 0; g2 < 4; ++g2) {
                const f32x4 a0 = *(const LAS f32x4*)(GT + g2 * 128 + poc * 8), a1 = *(const LAS f32x4*)(GT + g2 * 128 + poc * 8 + 4);
                const float sel = (g2 < tgp) ? 1.f : 0.f;
                G[0] += sel * a0[0]; G[1] += sel * a0[1]; G[2] += sel * a0[2]; G[3] += sel * a0[3]; G[4] += sel * a1[0]; G[5] += sel * a1[1]; G[6] += sel * a1[2]; G[7] += sel * a1[3];
                tot[0] += a0[0]; tot[1] += a0[1]; tot[2] += a0[2]; tot[3] += a0[3]; tot[4] += a1[0]; tot[5] += a1[1]; tot[6] += a1[2]; tot[7] += a1[3];
            }
            if (i == 0 && tid < 16) {
#pragma unroll
                for (int j = 0; j < 8; ++j) GL[poc * 8 + j] = __expf(tot[j]);
            }
            float qv[8], kv[8];
            unpack8(qw, qv); unpack8(kw, kv);
#pragma unroll
            for (int j = 0; j < 8; ++j) { const float eg = __expf(G[j]); qv[j] *= eg; kv[j] *= rcpf_(eg); }
            u32x4 qo, ko;
            qo.x = cvt_pk_bf16(qv[0], qv[1]); qo.y = cvt_pk_bf16(qv[2], qv[3]); qo.z = cvt_pk_bf16(qv[4], qv[5]); qo.w = cvt_pk_bf16(qv[6], qv[7]);
            ko.x = cvt_pk_bf16(kv[0], kv[1]); ko.y = cvt_pk_bf16(kv[2], kv[3]); ko.z = cvt_pk_bf16(kv[4], kv[5]); ko.w = cvt_pk_bf16(kv[6], kv[7]);
            *(LAS u32x4*)(QG + t * 136 + poc * 8) = qo; *(LAS u32x4*)(KG + t * 136 + poc * 8) = ko;
        }
        if (more) {
            const unsigned o0 = (r0 + 64 + pt0) * 512u + h * 128 + poc * 8, o1 = (r0 + 64 + pt1) * 512u + h * 128 + poc * 8;
            pq0 = *(const u32x4*)(BQ + o0); pq1 = *(const u32x4*)(BQ + o1); pk0 = *(const u32x4*)(BKb + o0); pk1 = *(const u32x4*)(BKb + o1);
            pg0 = *(const u32x4*)(GB + o0); pg1 = *(const u32x4*)(GB + o1);
        }
        lds_barrier();
        f32x4 at[4][2];
#pragma unroll
        for (int jt = 0; jt < 4; ++jt)
#pragma unroll
            for (int x2 = 0; x2 < 2; ++x2) at[jt][x2] = (f32x4){0.f, 0.f, 0.f, 0.f};
#pragma unroll
        for (int ks = 0; ks < 4; ++ks) {
            bf16x8 qf[2];
#pragma unroll
            for (int x2 = 0; x2 < 2; ++x2) qf[x2] = *(const LAS bf16x8*)(QG + ((ip * 2 + x2) * 16 + r16) * 136 + ks * 32 + q4 * 8);
#pragma unroll
            for (int jt = 0; jt < 4; ++jt) {
                const bf16x8 kf = *(const LAS bf16x8*)(KG + (jt * 16 + r16) * 136 + ks * 32 + q4 * 8);
#pragma unroll
                for (int x2 = 0; x2 < 2; ++x2) at[jt][x2] = MFMA16(kf, qf[x2], at[jt][x2]);
            }
        }
#pragma unroll
        for (int jt = 0; jt < 4; ++jt)
#pragma unroll
            for (int x2 = 0; x2 < 2; ++x2)
#pragma unroll
                for (int jj = 0; jj < 4; ++jj) { const int j = jt * 16 + q4 * 4 + jj, i = (ip * 2 + x2) * 16 + r16; if (j > i) at[jt][x2][jj] = 0.f; }
        f32x4 ot[2];
        ot[0] = (f32x4){0.f, 0.f, 0.f, 0.f}; ot[1] = (f32x4){0.f, 0.f, 0.f, 0.f};
        {
            bf16x4 a0, a1, b0, b1;
            asm volatile("ds_read_b64_tr_b16 %0, %4\n\tds_read_b64_tr_b16 %1, %4 offset:2304\n\tds_read_b64_tr_b16 %2, %4 offset:4608\n\tds_read_b64_tr_b16 %3, %4 offset:6912\n\ts_waitcnt lgkmcnt(0)"
                         : "=&v"(a0), "=&v"(a1), "=&v"(b0), "=&v"(b1) : "v"(v2a) : "memory");
            const bf16x8 vf0 = cat4(a0, a1), vf1 = cat4(b0, b1);
#pragma unroll
            for (int x2 = 0; x2 < 2; ++x2) { ot[x2] = MFMA16(vf0, pack8(at[0][x2], at[1][x2]), ot[x2]); ot[x2] = MFMA16(vf1, pack8(at[2][x2], at[3][x2]), ot[x2]); }
        }
#pragma unroll
        for (int db = 0; db < 4; ++db) {
            const bf16x8 sf = pack8(Sacc[2 * db], Sacc[2 * db + 1]);
#pragma unroll
            for (int x2 = 0; x2 < 2; ++x2) {
                const LAS bf16_t* qp = QG + ((ip * 2 + x2) * 16 + r16) * 136 + db * 32 + q4 * 4;
                const bf16x8 qv = cat4(*(const LAS bf16x4*)qp, *(const LAS bf16x4*)(qp + 16));
                ot[x2] = MFMA16(sf, qv, ot[x2]);
            }
        }
        po0 = ot[0]; po1 = ot[1]; prow = r0; pend = true;
#pragma unroll
        for (int jb = 0; jb < 2; ++jb) {
            bf16x4 kl[8], kh[8], vl, vh;
            const unsigned ka = k4a + (unsigned)(jb * 32 * 272), va = v4a + (unsigned)(jb * 32 * 144);
            asm volatile("ds_read_b64_tr_b16 %0, %18 offset:0\n\t"
                "ds_read_b64_tr_b16 %1, %18 offset:1088\n\t"
                "ds_read_b64_tr_b16 %2, %18 offset:32\n\t"
                "ds_read_b64_tr_b16 %3, %18 offset:1120\n\t"
                "ds_read_b64_tr_b16 %4, %18 offset:64\n\t"
                "ds_read_b64_tr_b16 %5, %18 offset:1152\n\t"
                "ds_read_b64_tr_b16 %6, %18 offset:96\n\t"
                "ds_read_b64_tr_b16 %7, %18 offset:1184\n\t"
                "ds_read_b64_tr_b16 %8, %18 offset:128\n\t"
                "ds_read_b64_tr_b16 %9, %18 offset:1216\n\t"
                "ds_read_b64_tr_b16 %10, %18 offset:160\n\t"
                "ds_read_b64_tr_b16 %11, %18 offset:1248\n\t"
                "ds_read_b64_tr_b16 %12, %18 offset:192\n\t"
                "ds_read_b64_tr_b16 %13, %18 offset:1280\n\t"
                "ds_read_b64_tr_b16 %14, %18 offset:224\n\t"
                "ds_read_b64_tr_b16 %15, %18 offset:1312\n\t"
                "ds_read_b64_tr_b16 %16, %19\n\t"
                "ds_read_b64_tr_b16 %17, %19 offset:576\n\t"
                "s_waitcnt lgkmcnt(0)"
                         : "=&v"(kl[0]), "=&v"(kh[0]), "=&v"(kl[1]), "=&v"(kh[1]), "=&v"(kl[2]), "=&v"(kh[2]), "=&v"(kl[3]), "=&v"(kh[3]), "=&v"(kl[4]), "=&v"(kh[4]), "=&v"(kl[5]), "=&v"(kh[5]), "=&v"(kl[6]), "=&v"(kh[6]), "=&v"(kl[7]), "=&v"(kh[7]), "=&v"(vl), "=&v"(vh) : "v"(ka), "v"(va) : "memory");
            const bf16x8 vf = cat4(vl, vh);
#pragma unroll
            for (int d8 = 0; d8 < 8; ++d8) Sacc[d8] = MFMA16(cat4(kl[d8], kh[d8]), vf, Sacc[d8]);
        }
#pragma unroll
        for (int d8 = 0; d8 < 8; ++d8) {
            const f32x4 dec = *(const LAS f32x4*)(GL + d8 * 16 + q4 * 4);
            Sacc[d8] = Sacc[d8] * dec;
        }
        lds_barrier();
    }
    if (pend) GLA_STORE_OUT();
#undef GLA_STORE_OUT
    if (ip == 0) {
        float* og = p.out + (smp ? O_GS : O_GP);
#pragma unroll
        for (int d8 = 0; d8 < 8; ++d8)
#pragma unroll
            for (int jj = 0; jj < 4; ++jj) og[((size_t)(b * 4 + h) * 128 + d8 * 16 + q4 * 4 + jj) * 256 + e0 + et * 16 + r16] = Sacc[d8][jj];
    }
}

__device__ __forceinline__ void phase2(const Params& p, LAS unsigned char* L) {
    for (int it = blockIdx.x; it < 768; it += gridDim.x) gla_item(p, L, it);
#ifdef PROBE_ATTN2
    for (int it = blockIdx.x; it < 2176; it += gridDim.x) attn_item(p, L, it, (bf16_t*)(p.ws + WS_XB), 1024);
#endif
    for (int it = blockIdx.x; it < 2176; it += gridDim.x) attn_item(p, L, it, (bf16_t*)(p.ws + WS_GATE), 2048);
}

__device__ __forceinline__ void phase3(const Params& p) {
    unsigned char* ws = p.ws;
    const bf16_t* BV = (const bf16_t*)(ws + WS_BV); bf16_t* Yb = (bf16_t*)(ws + WS_GATE); const float* BOSQP = (const float*)(ws + WS_XB);
    const float* gg = p.in[12];
    const long gtid = (long)blockIdx.x * NTHR + threadIdx.x, gsz = (long)gridDim.x * NTHR;
    const long total = (long)T * 128;
    for (long it = gtid; it < total; it += gsz) {
        const long row = it >> 7; const int c8 = (int)(it & 127) * 8, h = c8 >> 8;
        float sq;
        { const f32x4 s0 = *(const f32x4*)(BOSQP + row * 64 + h * 16), s1 = *(const f32x4*)(BOSQP + row * 64 + h * 16 + 4), s2 = *(const f32x4*)(BOSQP + row * 64 + h * 16 + 8), s3 = *(const f32x4*)(BOSQP + row * 64 + h * 16 + 12);
          sq = ((s0[0] + s0[1]) + (s0[2] + s0[3])) + ((s1[0] + s1[1]) + (s1[2] + s1[3])) + ((s2[0] + s2[1]) + (s2[2] + s2[3])) + ((s3[0] + s3[1]) + (s3[2] + s3[3])); }
        const float rs = rsqrtf(sq * (1.f / 256.f) + EPS);
        const u32x4 bo = *(const u32x4*)(BV + row * 1024 + c8);
        const u32x4 gt = *(const u32x4*)(Yb + row * 2048 + 1024 + c8);
        const f32x4 g0 = *(const f32x4*)(gg + (c8 & 255)), g1 = *(const f32x4*)(gg + (c8 & 255) + 4);
        u32x4 o;
        o.x = cvt_pk_bf16(bflo(bo.x) * rs * g0[0] * siluf(bflo(gt.x)), bfhi(bo.x) * rs * g0[1] * siluf(bfhi(gt.x)));
        o.y = cvt_pk_bf16(bflo(bo.y) * rs * g0[2] * siluf(bflo(gt.y)), bfhi(bo.y) * rs * g0[3] * siluf(bfhi(gt.y)));
        o.z = cvt_pk_bf16(bflo(bo.z) * rs * g1[0] * siluf(bflo(gt.z)), bfhi(bo.z) * rs * g1[1] * siluf(bfhi(gt.z)));
        o.w = cvt_pk_bf16(bflo(bo.w) * rs * g1[2] * siluf(bflo(gt.w)), bfhi(bo.w) * rs * g1[3] * siluf(bfhi(gt.w)));
        *(u32x4*)(Yb + row * 2048 + 1024 + c8) = o;
    }
}

__device__ __forceinline__ void lru_item(const Params& p, LAS unsigned char* L, int item) {
    unsigned char* ws = p.ws;
    const int tid = threadIdx.x, lane = tid & 63, w = tid >> 6, r16 = lane & 15, q4 = lane >> 4;
    LAS bf16_t* Wl = (LAS bf16_t*)L;
    LAS bf16_t* U = (LAS bf16_t*)(L + 76800);
    LAS float* Aa = (LAS float*)(L + 102400);
    LAS float* Bb = (LAS float*)(L + 126976);
    LAS float* SP = (LAS float*)(L + 151552);
    LAS float* SH = (LAS float*)(L + 153088);
    LAS float* HC = (LAS float*)(L + 154624);
    LAS float* CW = (LAS float*)(L + 155392);
    const bool smp = item >= 256;
    const int i2 = smp ? item - 256 : item;
    const int b = i2 >> 4, nb = (i2 >> 1) & 7, hf = i2 & 1;
    const int nch = smp ? 1 : 32;
    const unsigned rbase = smp ? (unsigned)T_P + b * 64 : (unsigned)b * 2048;
    const bf16_t* Z2 = (const bf16_t*)(ws + WS_Z2); bf16_t* Y2 = (bf16_t*)(ws + WS_Y2);
    const bf16_t* WA = (const bf16_t*)(ws + WS_WA) + nb * 192 * 192; const bf16_t* WI = (const bf16_t*)(ws + WS_WI) + nb * 192 * 192;
    for (int idx = tid; idx < 192 * 24; idx += NTHR) {
        const int r = idx / 24, g8 = idx % 24;
        const bf16_t* src = (r < 96) ? WA + (size_t)(hf * 96 + r) * 192 + g8 * 8 : WI + (size_t)(hf * 96 + r - 96) * 192 + g8 * 8;
        *(LAS u32x4*)(Wl + r * 200 + g8 * 8) = *(const u32x4*)src;
    }
    const bool cthr = tid < 384;
    const int cgp = tid % 24, tq = (tid / 24) & 15;
    const int chc = nb * 192 + cgp * 8;
    for (int idx = tid; idx < 5 * 192; idx += NTHR) { const int j = idx / 192, cc = idx % 192; CW[idx] = (j < 4) ? p.in[16][j * 1536 + nb * 192 + cc] : p.in[17][nb * 192 + cc]; }
    const int mt = w & 3, pg = w >> 2;
    float bra[3], bri[3], sp[3];
#pragma unroll
    for (int cp = 0; cp < 3; ++cp) {
        const int ch = nb * 192 + hf * 96 + (pg * 3 + cp) * 16 + r16;
        bra[cp] = p.in[19][ch]; bri[cp] = p.in[21][ch];
        const float lam = p.in[22][ch];
        sp[cp] = 8.f * (fmaxf(-lam, 0.f) + log1pf(__expf(-fabsf(lam))));
    }
    if (tid < 96) HC[tid] = smp ? p.in[6][b * 1536 + nb * 192 + hf * 96 + tid] : 0.f;
    const int sch0 = tid % 96, sseg0 = (tid / 96) & 3;
    const int ot0 = tid / 12, og0 = tid % 12, ot1 = (tid + 512) / 12, og1 = (tid + 512) % 12;
    const bool o1 = tid < 256;
    const int och0 = nb * 192 + hf * 96 + og0 * 8, och1 = nb * 192 + hf * 96 + og1 * 8;
    lds_barrier();
    u32x4 xr[7]; u32x4 pg0, pg1 = {0u, 0u, 0u, 0u};
#pragma unroll
    for (int r = 0; r < 7; ++r) {
        xr[r] = (u32x4){0u, 0u, 0u, 0u};
        const int pos = 4 * tq - 3 + r;
        if (cthr) {
            if (pos >= 0) xr[r] = *(const u32x4*)(Z2 + (unsigned)((rbase + pos) * 3072u + chc));
            else if (smp) {
                const float* hp = p.in[5] + ((size_t)b * 3 + (3 + pos)) * 1536 + chc;
                const f32x4 h0 = *(const f32x4*)hp, h1 = *(const f32x4*)(hp + 4);
                xr[r].x = cvt_pk_bf16(h0[0], h0[1]); xr[r].y = cvt_pk_bf16(h0[2], h0[3]); xr[r].z = cvt_pk_bf16(h1[0], h1[1]); xr[r].w = cvt_pk_bf16(h1[2], h1[3]);
            }
        }
    }
    pg0 = *(const u32x4*)(Z2 + (unsigned)((rbase + ot0) * 3072u + 1536 + och0));
    if (o1) pg1 = *(const u32x4*)(Z2 + (unsigned)((rbase + ot1) * 3072u + 1536 + och1));
    u32x4 so0 = {0u, 0u, 0u, 0u}, so1 = {0u, 0u, 0u, 0u}; unsigned sr = 0; bool spend = false;
    for (int ci = 0; ci < nch; ++ci) {
        const unsigned r0 = rbase + (unsigned)ci * 64;
        const bool more = (ci + 1 < nch);
        int sch = sch0, sseg = sseg0;
        asm volatile("" : "+v"(sch), "+v"(sseg));
        if (cthr) {
            float xv[7][8];
#pragma unroll
            for (int r = 0; r < 7; ++r) unpack8(xr[r], xv[r]);
            if (hf == 0 && !more && tq == 15) {
                float* oc = p.out + (smp ? O_CS : O_CP) + (size_t)b * 3 * 1536 + chc;
#pragma unroll
                for (int r = 0; r < 3; ++r) { *(f32x4*)(oc + r * 1536) = (f32x4){xv[4 + r][0], xv[4 + r][1], xv[4 + r][2], xv[4 + r][3]}; *(f32x4*)(oc + r * 1536 + 4) = (f32x4){xv[4 + r][4], xv[4 + r][5], xv[4 + r][6], xv[4 + r][7]}; }
            }
            float cw[5][8];
#pragma unroll
            for (int j = 0; j < 5; ++j) { const f32x4 c0 = *(const LAS f32x4*)(CW + j * 192 + cgp * 8), c1 = *(const LAS f32x4*)(CW + j * 192 + cgp * 8 + 4);
                cw[j][0] = c0[0]; cw[j][1] = c0[1]; cw[j][2] = c0[2]; cw[j][3] = c0[3]; cw[j][4] = c1[0]; cw[j][5] = c1[1]; cw[j][6] = c1[2]; cw[j][7] = c1[3]; }
#pragma unroll
            for (int tk = 0; tk < 4; ++tk) {
                float acc[8];
#pragma unroll
                for (int e = 0; e < 8; ++e) acc[e] = cw[4][e] + xv[tk][e] * cw[0][e] + xv[tk + 1][e] * cw[1][e] + xv[tk + 2][e] * cw[2][e] + xv[tk + 3][e] * cw[3][e];
                u32x4 uw; uw.x = cvt_pk_bf16(acc[0], acc[1]); uw.y = cvt_pk_bf16(acc[2], acc[3]); uw.z = cvt_pk_bf16(acc[4], acc[5]); uw.w = cvt_pk_bf16(acc[6], acc[7]);
                *(LAS u32x4*)(U + (4 * tq + tk) * 200 + cgp * 8) = uw;
            }
            if (more) {
#pragma unroll
                for (int r = 0; r < 7; ++r) xr[r] = *(const u32x4*)(Z2 + (unsigned)((r0 + 64 + 4 * tq - 3 + r) * 3072u + chc));
            }
        }
        lds_barrier();
        if (spend) { *(u32x4*)(Y2 + (unsigned)((sr + ot0) * 1536u + och0)) = so0; if (o1) *(u32x4*)(Y2 + (unsigned)((sr + ot1) * 1536u + och1)) = so1; }
        f32x4 ga[3], gi[3];
#pragma unroll
        for (int cp = 0; cp < 3; ++cp) { ga[cp] = (f32x4){0.f, 0.f, 0.f, 0.f}; gi[cp] = (f32x4){0.f, 0.f, 0.f, 0.f}; }
#pragma unroll 2
        for (int ks = 0; ks < 6; ++ks) {
            const bf16x8 uf = *(const LAS bf16x8*)(U + (mt * 16 + r16) * 200 + ks * 32 + q4 * 8);
#pragma unroll
            for (int cp = 0; cp < 3; ++cp) {
                const int ct = pg * 3 + cp;
                const bf16x8 wa = *(const LAS bf16x8*)(Wl + (ct * 16 + r16) * 200 + ks * 32 + q4 * 8), wi = *(const LAS bf16x8*)(Wl + (96 + ct * 16 + r16) * 200 + ks * 32 + q4 * 8);
                ga[cp] = MFMA16(uf, wa, ga[cp]); gi[cp] = MFMA16(uf, wi, gi[cp]);
            }
        }
#pragma unroll
        for (int cp = 0; cp < 3; ++cp) {
            const int cl = (pg * 3 + cp) * 16 + r16;
#pragma unroll
            for (int jj = 0; jj < 4; ++jj) {
                const int t = mt * 16 + q4 * 4 + jj;
                const float rg = sigmf(ga[cp][jj] + bra[cp]), ig = sigmf(gi[cp][jj] + bri[cp]);
                const float z = rg * sp[cp];
                const float a = __expf(-z);
                const float z2 = z + z;
                const float om = (z2 < 0.05f) ? z2 * (1.f - z2 * (0.5f - z2 * (0.16666667f - z2 * 0.041666668f))) : 1.f - a * a;
                const float uu = bf2f(U[t * 200 + hf * 96 + cl]);
                Aa[t * 96 + cl] = a; Bb[t * 96 + cl] = __builtin_amdgcn_sqrtf(om) * ig * uu;
            }
        }
        lds_barrier();
        if (cthr) {
            float P = 1.f, H = 0.f;
#pragma unroll
            for (int t = 0; t < 16; ++t) { const float a = Aa[(sseg * 16 + t) * 96 + sch]; H = a * H + Bb[(sseg * 16 + t) * 96 + sch]; P *= a; }
            SP[sseg * 96 + sch] = P; SH[sseg * 96 + sch] = H;
        }
        lds_barrier();
        if (cthr) {
            float hh = HC[(ci & 1) * 96 + sch];
#pragma unroll
            for (int sg = 0; sg < 3; ++sg) if (sg < sseg) hh = SP[sg * 96 + sch] * hh + SH[sg * 96 + sch];
#pragma unroll
            for (int t = 0; t < 16; ++t) { hh = Aa[(sseg * 16 + t) * 96 + sch] * hh + Bb[(sseg * 16 + t) * 96 + sch]; Bb[(sseg * 16 + t) * 96 + sch] = hh; }
            if (sseg == 3) HC[((ci + 1) & 1) * 96 + sch] = hh;
        }
        lds_barrier();
        {
            const f32x4 h0 = *(const LAS f32x4*)(Bb + ot0 * 96 + og0 * 8), h1 = *(const LAS f32x4*)(Bb + ot0 * 96 + og0 * 8 + 4);
            u32x4 o;
            o.x = cvt_pk_bf16(h0[0] * siluf(bflo(pg0.x)), h0[1] * siluf(bfhi(pg0.x)));
            o.y = cvt_pk_bf16(h0[2] * siluf(bflo(pg0.y)), h0[3] * siluf(bfhi(pg0.y)));
            o.z = cvt_pk_bf16(h1[0] * siluf(bflo(pg0.z)), h1[1] * siluf(bfhi(pg0.z)));
            o.w = cvt_pk_bf16(h1[2] * siluf(bflo(pg0.w)), h1[3] * siluf(bfhi(pg0.w)));
            so0 = o;
            if (more) pg0 = *(const u32x4*)(Z2 + (unsigned)((r0 + 64 + ot0) * 3072u + 1536 + och0));
        }
        if (o1) {
            const f32x4 h0 = *(const LAS f32x4*)(Bb + ot1 * 96 + og1 * 8), h1 = *(const LAS f32x4*)(Bb + ot1 * 96 + og1 * 8 + 4);
            u32x4 o;
            o.x = cvt_pk_bf16(h0[0] * siluf(bflo(pg1.x)), h0[1] * siluf(bfhi(pg1.x)));
            o.y = cvt_pk_bf16(h0[2] * siluf(bflo(pg1.y)), h0[3] * siluf(bfhi(pg1.y)));
            o.z = cvt_pk_bf16(h1[0] * siluf(bflo(pg1.z)), h1[1] * siluf(bfhi(pg1.z)));
            o.w = cvt_pk_bf16(h1[2] * siluf(bflo(pg1.w)), h1[3] * siluf(bfhi(pg1.w)));
            so1 = o;
            if (more) pg1 = *(const u32x4*)(Z2 + (unsigned)((r0 + 64 + ot1) * 3072u + 1536 + och1));
        }
        sr = r0; spend = true;
        lds_barrier();
    }
    if (spend) { *(u32x4*)(Y2 + (unsigned)((sr + ot0) * 1536u + och0)) = so0; if (o1) *(u32x4*)(Y2 + (unsigned)((sr + ot1) * 1536u + och1)) = so1; }
    if (tid < 96) p.out[(smp ? O_LS : O_LP) + (size_t)b * 1536 + nb * 192 + hf * 96 + tid] = HC[(nch & 1) * 96 + tid];
    lds_barrier();
}

__device__ __forceinline__ void phase6(const Params& p, LAS unsigned char* L) {
    for (int it = blockIdx.x; it < 768; it += gridDim.x) lru_item(p, L, it);
}

__device__ __forceinline__ void phase8(const Params& p) {
    const float* rsq = (const float*)(p.ws + WS_RSQ2); const float* g = p.in[24]; float* y = p.out;
    const long gtid = (long)blockIdx.x * NTHR + threadIdx.x, gsz = (long)gridDim.x * NTHR;
    const long total = (long)T * 256;
    for (long it = gtid; it < total; it += gsz) {
        const long row = it >> 8; const int c4 = (int)(it & 255) * 4;
        const float rs = rsqrtf(rsq[row] * (1.f / 1024.f) + EPS);
        const f32x4 v = *(const f32x4*)(y + row * 1024 + c4), gv = *(const f32x4*)(g + c4);
        *(f32x4*)(y + row * 1024 + c4) = v * rs * gv;
    }
}

__global__ void __launch_bounds__(NTHR) mega(Params p) {
    extern __shared__ __attribute__((aligned(16))) unsigned char lds_raw[];
    LAS unsigned char* L = (LAS unsigned char*)lds_raw;
    cg::grid_group grid = cg::this_grid();
    unsigned char* ws = p.ws;
    const int lo = p.ph_lo, hi = p.ph_hi;
#ifndef PHMASK
#define PHMASK 0x1ff
#endif
#define IN(k) (((PHMASK >> (k)) & 1) && lo <= (k) && (k) < hi)
#define SEAM(k) do { if (IN(k) && IN((k) + 1)) grid.sync(); } while (0)
    if (IN(0)) phase0(p);
    SEAM(0);
    if (IN(1)) {
        pg8::Gemm g{(const bf16_t*)(ws + WS_XB), (const bf16_t*)(ws + WS_WINE), T, NE_PAD, 1024};
        pg8::StaticOrder S; S.init(T, NE_PAD, gridDim.x, blockIdx.x);
        EpiInEven E{ws, p.out, (const float*)(ws + WS_RSTD0), p.in[10]};
        pg8::gemm_phase<EpiInEven>(L, g, S, E);
    }
    SEAM(1);
    if (IN(2)) phase2(p, L);
    SEAM(2);
    if (IN(3)) phase3(p);
    SEAM(3);
    if (IN(4)) {
        pg8::Gemm g{(const bf16_t*)(ws + WS_GATE), (const bf16_t*)(ws + WS_WOUTE), T, 1024, 2048};
        pg8::StaticOrder S; S.init(T, 1024, gridDim.x, blockIdx.x);
        EpiOutRes<true> E{p.in[0], p.in[1], p.out, (bf16_t*)(ws + WS_XB), (float*)(ws + WS_RSQ1)};
        pg8::gemm_phase<EpiOutRes<true>>(L, g, S, E);
    }
    SEAM(4);
    if (IN(5)) {
        pg8::Gemm g{(const bf16_t*)(ws + WS_XB), (const bf16_t*)(ws + WS_WINO), T, 3072, 1024};
        pg8::StaticOrder S; S.init(T, 3072, gridDim.x, blockIdx.x);
        EpiInOdd E{(bf16_t*)(ws + WS_Z2), (const float*)(ws + WS_RSQ1)};
        pg8::gemm_phase<EpiInOdd>(L, g, S, E);
    }
    SEAM(5);
    if (IN(6)) phase6(p, L);
    SEAM(6);
    if (IN(7)) {
        pg8::Gemm g{(const bf16_t*)(ws + WS_Y2), (const bf16_t*)(ws + WS_WOUTO), T, 1024, 1536};
        pg8::StaticOrder S; S.init(T, 1024, gridDim.x, blockIdx.x);
        EpiOutRes<false> E{p.out, p.out + (size_t)T_P * 1024, p.out, nullptr, (float*)(ws + WS_RSQ2)};
        pg8::gemm_phase<EpiOutRes<false>>(L, g, S, E);
    }
    SEAM(7);
    if (IN(8)) phase8(p);
#undef IN
#undef SEAM
}

extern "C" void kernel_launch(void* const* d_in, const int* in_sizes, int n_in, void* d_out, int out_size, void* d_ws, size_t ws_size, hipStream_t stream) {
    static int grid_blocks = 0;
    if (grid_blocks == 0) {
        if (n_in != 25 || (size_t)out_size != O_END || ws_size < WS_END) { fprintf(stderr, "kernel_launch: unexpected shapes n_in %d out %d ws %zu (need %zu)\n", n_in, out_size, ws_size, (size_t)WS_END); grid_blocks = -1; return; }
        int dev = 0, cus = 0, per_cu = 0;
        (void)hipGetDevice(&dev);
        (void)hipDeviceGetAttribute(&cus, hipDeviceAttributeMultiprocessorCount, dev);
        if (hipFuncSetAttribute((const void*)mega, hipFuncAttributeMaxDynamicSharedMemorySize, LDS_BYTES) != hipSuccess) { fprintf(stderr, "kernel_launch: hipFuncSetAttribute failed\n"); }
        if (hipOccupancyMaxActiveBlocksPerMultiprocessor(&per_cu, (const void*)mega, NTHR, LDS_BYTES) != hipSuccess || per_cu < 1) per_cu = 1;
        (void)hipGetLastError();
        grid_blocks = cus * per_cu;
        if (grid_blocks <= 0) grid_blocks = 256;
    }
    if (grid_blocks < 0) return;
    Params p{};
    for (int i = 0; i < 25; ++i) p.in[i] = (const float*)d_in[i];
    p.out = (float*)d_out; p.ws = (unsigned char*)d_ws;
#if ONE_LAUNCH
#ifdef PROBE_X
    { const int seq[3][2] = {{0, PROBE_Y + 1}, {PROBE_X, PROBE_Y + 1}, {PROBE_Y + 1, 9}};
      for (int li = 0; li < 3; ++li) { if (seq[li][0] >= seq[li][1]) continue; p.ph_lo = seq[li][0]; p.ph_hi = seq[li][1]; void* args[] = {&p};
        hipError_t e = hipLaunchCooperativeKernel((const void*)mega, dim3(grid_blocks), dim3(NTHR), args, LDS_BYTES, stream);
        if (e != hipSuccess) fprintf(stderr, "cooperative launch failed: %s (grid %d)\n", hipGetErrorString(e), grid_blocks); } }
#else
    p.ph_lo = 0; p.ph_hi = 9;
    { void* args[] = {&p}; hipError_t e = hipLaunchCooperativeKernel((const void*)mega, dim3(grid_blocks), dim3(NTHR), args, LDS_BYTES, stream);
      if (e != hipSuccess) fprintf(stderr, "cooperative launch failed: %s (grid %d)\n", hipGetErrorString(e), grid_blocks); }
#endif
#else
    for (int ph = 0; ph < 9; ++ph) {
        p.ph_lo = ph; p.ph_hi = ph + 1;
        void* args[] = {&p}; hipError_t e = hipLaunchCooperativeKernel((const void*)mega, dim3(grid_blocks), dim3(NTHR), args, LDS_BYTES, stream);
        if (e != hipSuccess) fprintf(stderr, "cooperative launch %d failed: %s (grid %d)\n", ph, hipGetErrorString(e), grid_blocks);
    }
#endif
}
```

```cpp
#include <hip/hip_runtime.h>
#include <hip/hip_cooperative_groups.h>
#include <cstdio>
namespace cg = cooperative_groups;

#ifndef ONE_LAUNCH
#define ONE_LAUNCH 1
#endif

#define LAS __attribute__((address_space(3)))
typedef unsigned short bf16_t;
typedef short bf16x8 __attribute__((ext_vector_type(8)));
typedef short bf16x4 __attribute__((ext_vector_type(4)));
typedef float f32x4 __attribute__((ext_vector_type(4)));
typedef unsigned u32x4 __attribute__((ext_vector_type(4)));
typedef unsigned u32x2 __attribute__((ext_vector_type(2)));

constexpr int T_P = 32768, T_S = 2048, T = T_P + T_S, DM = 1024;
constexpr int NE_PAD = 6144;
constexpr int LDS_BYTES = 159744;
constexpr int NTHR = 512;
constexpr float EPS = 1e-6f;

constexpr size_t WS_WINE = 0;
constexpr size_t WS_WOUTE = WS_WINE + (size_t)NE_PAD * 1024 * 2;
constexpr size_t WS_WINO = WS_WOUTE + (size_t)1024 * 2048 * 2;
constexpr size_t WS_WOUTO = WS_WINO + (size_t)3072 * 1024 * 2;
constexpr size_t WS_WA = WS_WOUTO + (size_t)1024 * 1536 * 2;
constexpr size_t WS_WI = WS_WA + (size_t)8 * 192 * 192 * 2;
constexpr size_t WS_XB = WS_WI + (size_t)8 * 192 * 192 * 2;
constexpr size_t WS_RSTD0 = WS_XB + (size_t)T * 1024 * 2;
constexpr size_t WS_RSQ1 = WS_RSTD0 + (size_t)T * 4;
constexpr size_t WS_RSQ2 = WS_RSQ1 + (size_t)T * 4;
constexpr size_t WS_BOSQ = WS_RSQ2 + (size_t)T * 4;
constexpr size_t WS_Q = WS_BOSQ + (size_t)T * 16;
constexpr size_t WS_K = WS_Q + (size_t)T * 1024 * 2;
constexpr size_t WS_V = WS_K + (size_t)T * 256 * 2;
constexpr size_t WS_BQ = WS_V + (size_t)T * 256 * 2;
constexpr size_t WS_BK = WS_BQ + (size_t)T * 512 * 2;
constexpr size_t WS_BV = WS_BK + (size_t)T * 512 * 2;
constexpr size_t WS_GATE = WS_BV + (size_t)T * 1024 * 2;
constexpr size_t WS_BLR = WS_GATE + (size_t)T * 2048 * 2;
constexpr size_t WS_END = WS_BLR + (size_t)T * 512 * 2;
constexpr size_t WS_Z2 = WS_Q;
constexpr size_t WS_Y2 = WS_GATE;
static_assert(WS_Z2 + (size_t)T * 3072 * 2 <= WS_GATE, "Z2 alias");

constexpr size_t O_Y = 0;
constexpr size_t O_KP = (size_t)T * 1024;
constexpr size_t O_VP = O_KP + 524288;
constexpr size_t O_GP = O_VP + 524288;
constexpr size_t O_CP = O_GP + 2097152;
constexpr size_t O_LP = O_CP + 73728;
constexpr size_t O_KS = O_LP + 24576;
constexpr size_t O_VS = O_KS + 524288;
constexpr size_t O_GS = O_VS + 524288;
constexpr size_t O_CS = O_GS + 4194304;
constexpr size_t O_LS = O_CS + 147456;
constexpr size_t O_END = O_LS + 49152;

struct Params {
    const float* in[25];
    float* out;
    unsigned char* ws;
    int ph_lo, ph_hi;
};

__device__ __forceinline__ unsigned cvt_pk_bf16(float lo, float hi) { unsigned r; asm volatile("v_cvt_pk_bf16_f32 %0, %1, %2" : "=v"(r) : "v"(lo), "v"(hi)); return r; }
__device__ __forceinline__ bf16_t f2bf(float f) { return (bf16_t)(cvt_pk_bf16(f, 0.f) & 0xffffu); }
__device__ __forceinline__ float bf2f(bf16_t b) { return __uint_as_float(((unsigned)b) << 16); }
__device__ __forceinline__ float bflo(unsigned w) { return __uint_as_float(w << 16); }
__device__ __forceinline__ float bfhi(unsigned w) { return __uint_as_float(w & 0xffff0000u); }
__device__ __forceinline__ float rcpf_(float x) { return __builtin_amdgcn_rcpf(x); }
__device__ __forceinline__ float siluf(float x) { return x * rcpf_(1.f + __expf(-x)); }
__device__ __forceinline__ float sigmf(float x) { return rcpf_(1.f + __expf(-x)); }
__device__ __forceinline__ void lds_barrier() { asm volatile("s_waitcnt lgkmcnt(0)" ::: "memory"); __builtin_amdgcn_s_barrier(); asm volatile("" ::: "memory"); }
__device__ __forceinline__ bf16x8 pack8(const f32x4& a, const f32x4& b) {
    u32x4 p; p.x = cvt_pk_bf16(a[0], a[1]); p.y = cvt_pk_bf16(a[2], a[3]); p.z = cvt_pk_bf16(b[0], b[1]); p.w = cvt_pk_bf16(b[2], b[3]);
    return __builtin_bit_cast(bf16x8, p);
}
__device__ __forceinline__ bf16x8 cat4(const bf16x4 a, const bf16x4 b) { bf16x8 r; r[0] = a[0]; r[1] = a[1]; r[2] = a[2]; r[3] = a[3]; r[4] = b[0]; r[5] = b[1]; r[6] = b[2]; r[7] = b[3]; return r; }
__device__ __forceinline__ void unpack8(const u32x4 w, float (&v)[8]) { v[0] = bflo(w.x); v[1] = bfhi(w.x); v[2] = bflo(w.y); v[3] = bfhi(w.y); v[4] = bflo(w.z); v[5] = bfhi(w.z); v[6] = bflo(w.w); v[7] = bfhi(w.w); }
#define MFMA16(a, b, c) __builtin_amdgcn_mfma_f32_16x16x32_bf16((a), (b), (c), 0, 0, 0)

namespace pg8 {
constexpr int BM = 256, BK = 64, HALF = 128, HTB = HALF * BK * 2, STAGE_BYTES = 8 * HTB, NXCD = 8, WGM = 8;
__device__ __forceinline__ int lds_byte(int r, int c) { const int st = (r >> 4) * 2 + (c >> 5), rr = r & 15, cc = c & 31, ob = rr * 64 + cc * 2; return st * 1024 + (ob ^ (((ob >> 9) & 1) << 5)); }
__device__ __forceinline__ int perm32(int rho) { const int n = rho >> 4, i = rho & 15; return 8 * (i >> 2) + 4 * n + (i & 3); }
__device__ __forceinline__ void stage_rc(int b, int& R, int& C) { const int st = b / 1024, sb = b % 1024, swz = sb ^ (((sb >> 9) & 1) << 5); R = (st >> 1) * 16 + swz / 64; C = (st & 1) * 32 + (swz % 64) / 2; }
struct Unit { int pm, pn; };
struct Gemm { const bf16_t* A; const bf16_t* Bt; int M, N, K; };
struct StaticOrder {
    int nM, nN, nwg, G, c;
    __device__ void init(int M, int N, int G_, int c_) { nM = M / BM; nN = N / BM; nwg = nM * nN; G = G_; c = c_; }
    __device__ __forceinline__ bool next(int i, Unit& u) const {
        const long Lx = (long)i * G + c; if (Lx >= nwg) return false;
        int wgid = (int)Lx; { const int q = nwg / NXCD, r = nwg % NXCD, xcd = wgid % NXCD, off = wgid / NXCD; wgid = (xcd < r ? xcd * (q + 1) : r * (q + 1) + (xcd - r) * q) + off; }
        const int nig = WGM * nN, gid = wgid / nig, fm = gid * WGM, gsz = (nM - fm) < WGM ? (nM - fm) : WGM;
        u.pm = fm + ((wgid % nig) % gsz); u.pn = (wgid % nig) / gsz; return true;
    }
};

template <class Epi>
__device__ __forceinline__ void gemm_phase(LAS unsigned char* lds, const Gemm g, const StaticOrder& S, const Epi& E) {
    const int tid = threadIdx.x, wid = __builtin_amdgcn_readfirstlane(tid >> 6), lane = tid & 63, wr = wid >> 2, wc = wid & 3, fr = lane & 15, fq = lane >> 4;
    const int K = g.K, nt = K / BK;
    unsigned voffA[2], voffB[2];
#pragma unroll
    for (int i = 0; i < 2; ++i) { int R, C; stage_rc(tid * 16 + i * 8192, R, C); const int Rb = Epi::PERM ? ((R & ~31) + perm32(R & 31)) : R;
        voffA[i] = (unsigned)(R * K + C) * 2u; voffB[i] = (unsigned)(Rb * K + C) * 2u; }
    const size_t kstep = (size_t)(BK * 2);
    const size_t hstep = (size_t)HALF * K * 2;
    const size_t tstep = 2 * hstep;
    const unsigned ldsw = (unsigned)wid * 1024u;
    const int aoff = lds_byte(wr * 64 + fr, fq * 8), boff = lds_byte(wc * 32 + fr, fq * 8);
#define PG8_SA(b, h) (((b) * 2 + (h)) * HTB)
#define PG8_SB(b, h) ((4 + (b) * 2 + (h)) * HTB)
#define PG8_STAGE(bufoff, gbase, voff) do { _Pragma("unroll") for (int _i = 0; _i < 2; ++_i) \
        __builtin_amdgcn_global_load_lds((const unsigned*)((const char*)(gbase) + (voff)[_i]), (LAS unsigned*)(lds + (bufoff) + ldsw + _i * 8192), 16, 0, 0); } while (0)
#define PG8_LDA(dst, b, h) do { _Pragma("unroll") for (int m = 0; m < 4; ++m) _Pragma("unroll") for (int k = 0; k < 2; ++k) dst[m][k] = *(const LAS bf16x8*)(lds + PG8_SA(b, h) + aoff + m * 2048 + k * 1024); } while (0)
#define PG8_LDB(dst, b, h) do { _Pragma("unroll") for (int n = 0; n < 2; ++n) _Pragma("unroll") for (int k = 0; k < 2; ++k) dst[n][k] = *(const LAS bf16x8*)(lds + PG8_SB(b, h) + boff + n * 2048 + k * 1024); } while (0)
#define PG8_MMA(ai, bj, At, Bt) do { __builtin_amdgcn_s_setprio(1); _Pragma("unroll") for (int m = 0; m < 4; ++m) _Pragma("unroll") for (int n = 0; n < 2; ++n) _Pragma("unroll") for (int k = 0; k < 2; ++k) \
        acc[ai][bj][m][n] = __builtin_amdgcn_mfma_f32_16x16x32_bf16(Bt[n][k], At[m][k], acc[ai][bj][m][n], 0, 0, 0); __builtin_amdgcn_s_setprio(0); } while (0)
#define PG8_WAIT_V(n) asm volatile("s_waitcnt vmcnt(" #n ")" ::: "memory")
#define PG8_WAIT_L(n) asm volatile("s_waitcnt lgkmcnt(" #n ")" ::: "memory")
#define PG8_BAR __builtin_amdgcn_s_barrier()
#define PG8_SCHED __builtin_amdgcn_sched_barrier(0)
    Unit cur, nxt; int ui = 0;
    if (!S.next(0, cur)) return;
    f32x4 acc[2][2][4][2];
#pragma unroll
    for (int a = 0; a < 2; ++a)
#pragma unroll
        for (int b = 0; b < 2; ++b)
#pragma unroll
            for (int m = 0; m < 4; ++m)
#pragma unroll
                for (int n = 0; n < 2; ++n) acc[a][b][m][n] = (f32x4){0.f, 0.f, 0.f, 0.f};
    bf16x8 At[4][2], B0[2][2], B1[2][2];
    const char* cA = (const char*)g.A + (size_t)cur.pm * tstep; const char* cB = (const char*)g.Bt + (size_t)cur.pn * tstep;
    PG8_STAGE(PG8_SB(0, 0), cB, voffB); PG8_STAGE(PG8_SA(0, 0), cA, voffA); PG8_STAGE(PG8_SB(0, 1), cB + hstep, voffB); PG8_STAGE(PG8_SA(0, 1), cA + hstep, voffA);
    if (wr == 1) PG8_BAR;
    PG8_WAIT_V(4); PG8_BAR;
    PG8_STAGE(PG8_SB(1, 0), cB + kstep, voffB); PG8_STAGE(PG8_SA(1, 0), cA + kstep, voffA); PG8_STAGE(PG8_SB(1, 1), cB + hstep + kstep, voffB);
    PG8_WAIT_V(6); PG8_BAR;
    for (;;) {
        const bool has_next = S.next(ui + 1, nxt);
        const char* nA = has_next ? (const char*)g.A + (size_t)nxt.pm * tstep : cA; const char* nB = has_next ? (const char*)g.Bt + (size_t)nxt.pn * tstep : cB;
        for (int t = 0; t < nt; t += 2) {
            const bool last = (t == nt - 2);
            const char* a1 = cA + (size_t)(t + 1) * kstep;
            const char* a2 = last ? nA : cA + (size_t)(t + 2) * kstep; const char* b2 = last ? nB : cB + (size_t)(t + 2) * kstep;
            const char* a3 = a2 + kstep; const char* b3 = b2 + kstep;
            PG8_LDB(B0, 0, 0); PG8_SCHED; PG8_LDA(At, 0, 0); PG8_STAGE(PG8_SA(1, 1), a1 + hstep, voffA);
            PG8_WAIT_L(8); PG8_BAR; PG8_WAIT_L(0); PG8_MMA(0, 0, At, B0); PG8_BAR; PG8_SCHED;
            PG8_LDB(B1, 0, 1); PG8_STAGE(PG8_SB(0, 0), b2, voffB);
            PG8_BAR; PG8_WAIT_L(0); PG8_MMA(0, 1, At, B1); PG8_BAR;
            PG8_LDA(At, 0, 1); PG8_STAGE(PG8_SA(0, 0), a2, voffA);
            PG8_BAR; PG8_WAIT_L(0); PG8_MMA(1, 0, At, B0); PG8_BAR; PG8_SCHED;
            PG8_STAGE(PG8_SB(0, 1), b2 + hstep, voffB);
            PG8_WAIT_V(6); PG8_BAR; PG8_MMA(1, 1, At, B1); PG8_BAR;
            PG8_LDB(B0, 1, 0); PG8_SCHED; PG8_LDA(At, 1, 0); PG8_STAGE(PG8_SA(0, 1), a2 + hstep, voffA);
            PG8_WAIT_L(8); PG8_BAR; PG8_WAIT_L(0); PG8_MMA(0, 0, At, B0); PG8_BAR; PG8_SCHED;
            PG8_LDB(B1, 1, 1); PG8_STAGE(PG8_SB(1, 0), b3, voffB);
            PG8_BAR; PG8_WAIT_L(0); PG8_MMA(0, 1, At, B1); PG8_BAR;
            PG8_LDA(At, 1, 1); PG8_STAGE(PG8_SA(1, 0), a3, voffA);
            PG8_BAR; PG8_WAIT_L(0); PG8_MMA(1, 0, At, B0); PG8_BAR; PG8_SCHED;
            PG8_STAGE(PG8_SB(1, 1), b3 + hstep, voffB);
            PG8_WAIT_V(6); PG8_BAR; PG8_MMA(1, 1, At, B1); PG8_BAR;
        }
        E(acc, cur, wr, wc, fr, fq);
        if (!has_next) break;
#pragma unroll
        for (int a = 0; a < 2; ++a)
#pragma unroll
            for (int b = 0; b < 2; ++b)
#pragma unroll
                for (int m = 0; m < 4; ++m)
#pragma unroll
                    for (int n = 0; n < 2; ++n) acc[a][b][m][n] = (f32x4){0.f, 0.f, 0.f, 0.f};
        cur = nxt; cA = nA; cB = nB; ++ui;
    }
    PG8_WAIT_V(0);
    if (wr == 0) PG8_BAR;
    PG8_BAR;
#undef PG8_SA
#undef PG8_SB
#undef PG8_STAGE
#undef PG8_LDA
#undef PG8_LDB
#undef PG8_MMA
#undef PG8_WAIT_V
#undef PG8_WAIT_L
#undef PG8_BAR
#undef PG8_SCHED
}
}

typedef f32x4 AccT[2][2][4][2];

struct EpiInEven {
    static constexpr bool PERM = true;
    unsigned char* ws; float* out; const float* rstd; const float* blr_b;
    __device__ __forceinline__ void operator()(const AccT& acc, const pg8::Unit& u, int wr, int wc, int fr, int fq) const {
        const int pn = u.pn;
        bf16_t* base; int ld, coff; float sc = 1.f;
        if (pn < 4) { base = (bf16_t*)(ws + WS_Q); ld = 1024; coff = pn * 256; sc = 0.125f; }
        else if (pn == 4) { base = (bf16_t*)(ws + WS_K); ld = 256; coff = 0; }
        else if (pn == 5) { base = (bf16_t*)(ws + WS_V); ld = 256; coff = 0; }
        else if (pn < 8) { base = (bf16_t*)(ws + WS_BQ); ld = 512; coff = (pn - 6) * 256; sc = 0.08838834764831845f; }
        else if (pn < 10) { base = (bf16_t*)(ws + WS_BK); ld = 512; coff = (pn - 8) * 256; }
        else if (pn < 14) { base = (bf16_t*)(ws + WS_BV); ld = 1024; coff = (pn - 10) * 256; }
        else if (pn < 22) { base = (bf16_t*)(ws + WS_GATE); ld = 2048; coff = (pn - 14) * 256; }
        else { base = (bf16_t*)(ws + WS_BLR); ld = 512; coff = (pn - 22) * 256; }
        const int row0 = u.pm * 256 + wr * 64 + fr;
        const int ct = wc * 32 + 8 * fq;
        if (pn >= 22) {
#pragma unroll
            for (int ai = 0; ai < 2; ++ai)
#pragma unroll
                for (int m = 0; m < 4; ++m) {
                    const int row = row0 + ai * 128 + m * 16; const float rs = rstd[row];
#pragma unroll
                    for (int bj = 0; bj < 2; ++bj) {
                        const int cg = coff + ct + bj * 128;
                        const f32x4 b0 = *(const f32x4*)(blr_b + cg), b1 = *(const f32x4*)(blr_b + cg + 4);
                        f32x4 x0 = acc[ai][bj][m][0] * rs + b0, x1 = acc[ai][bj][m][1] * rs + b1;
#pragma unroll
                        for (int j = 0; j < 4; ++j) { x0[j] = (fminf(x0[j], 0.f) - __logf(1.f + __expf(-fabsf(x0[j])))) * (1.f / 16.f); x1[j] = (fminf(x1[j], 0.f) - __logf(1.f + __expf(-fabsf(x1[j])))) * (1.f / 16.f); }
                        u32x4 w; w.x = cvt_pk_bf16(x0[0], x0[1]); w.y = cvt_pk_bf16(x0[2], x0[3]); w.z = cvt_pk_bf16(x1[0], x1[1]); w.w = cvt_pk_bf16(x1[2], x1[3]);
                        *(u32x4*)(base + (size_t)row * 512 + cg) = w;
                    }
                }
            return;
        }
        const bool kv = (pn == 4 || pn == 5);
        float* okv_p = out + (pn == 4 ? O_KP : O_VP); float* okv_s = out + (pn == 4 ? O_KS : O_VS);
#pragma unroll
        for (int ai = 0; ai < 2; ++ai)
#pragma unroll
            for (int m = 0; m < 4; ++m) {
                const int row = row0 + ai * 128 + m * 16; const float rs = rstd[row] * sc;
                bf16_t* rowp = base + (size_t)row * ld + coff + ct;
                float* orow = nullptr;
                if (kv) {
                    if (row >= T_P) orow = okv_s + (size_t)(row - T_P) * 256;
                    else { const int b = row >> 11, t = row & 2047; if (t >= 1920) orow = okv_p + (size_t)(b * 128 + t - 1920) * 256; }
                }
#pragma unroll
                for (int bj = 0; bj < 2; ++bj) {
                    const f32x4 v0 = acc[ai][bj][m][0] * rs, v1 = acc[ai][bj][m][1] * rs;
                    u32x4 w; w.x = cvt_pk_bf16(v0[0], v0[1]); w.y = cvt_pk_bf16(v0[2], v0[3]); w.z = cvt_pk_bf16(v1[0], v1[1]); w.w = cvt_pk_bf16(v1[2], v1[3]);
                    *(u32x4*)(rowp + bj * 128) = w;
                    if (kv && orow) { *(f32x4*)(orow + bj * 128 + ct) = v0; *(f32x4*)(orow + bj * 128 + ct + 4) = v1; }
                }
            }
    }
};

template <bool WRITE_BF>
struct EpiOutRes {
    static constexpr bool PERM = false;
    const float* xin_p; const float* xin_s; float* xo; bf16_t* xb; float* rowsq;
    __device__ __forceinline__ void operator()(const AccT& acc, const pg8::Unit& u, int wr, int wc, int fr, int fq) const {
        const int row0 = u.pm * 256 + wr * 64 + fr, col0 = u.pn * 256 + wc * 32 + 4 * fq;
#pragma unroll
        for (int ai = 0; ai < 2; ++ai)
#pragma unroll
            for (int m = 0; m < 4; ++m) {
                const int row = row0 + ai * 128 + m * 16;
                const float* xr = (row < T_P) ? xin_p + (size_t)row * 1024 : xin_s + (size_t)(row - T_P) * 1024;
                float ss = 0.f;
#pragma unroll
                for (int bj = 0; bj < 2; ++bj)
#pragma unroll
                    for (int n = 0; n < 2; ++n) {
                        const int col = col0 + bj * 128 + n * 16;
                        const f32x4 v = acc[ai][bj][m][n] + *(const f32x4*)(xr + col);
                        *(f32x4*)(xo + (size_t)row * 1024 + col) = v;
                        if (WRITE_BF) { u32x2 w; w.x = cvt_pk_bf16(v[0], v[1]); w.y = cvt_pk_bf16(v[2], v[3]); *(u32x2*)(xb + (size_t)row * 1024 + col) = w; }
                        ss += v[0] * v[0] + v[1] * v[1] + v[2] * v[2] + v[3] * v[3];
                    }
                ss += __shfl_xor(ss, 16); ss += __shfl_xor(ss, 32);
                if (fq == 0) atomicAdd(rowsq + row, ss);
            }
    }
};

struct EpiInOdd {
    static constexpr bool PERM = true;
    bf16_t* z2; const float* rowsq;
    __device__ __forceinline__ void operator()(const AccT& acc, const pg8::Unit& u, int wr, int wc, int fr, int fq) const {
        const int row0 = u.pm * 256 + wr * 64 + fr, col0 = u.pn * 256 + wc * 32 + 8 * fq;
#pragma unroll
        for (int ai = 0; ai < 2; ++ai)
#pragma unroll
            for (int m = 0; m < 4; ++m) {
                const int row = row0 + ai * 128 + m * 16; const float rs = rsqrtf(rowsq[row] * (1.f / 1024.f) + EPS);
#pragma unroll
                for (int bj = 0; bj < 2; ++bj) {
                    const f32x4 v0 = acc[ai][bj][m][0] * rs, v1 = acc[ai][bj][m][1] * rs;
                    u32x4 w; w.x = cvt_pk_bf16(v0[0], v0[1]); w.y = cvt_pk_bf16(v0[2], v0[3]); w.z = cvt_pk_bf16(v1[0], v1[1]); w.w = cvt_pk_bf16(v1[2], v1[3]);
                    *(u32x4*)(z2 + (size_t)row * 3072 + col0 + bj * 128) = w;
                }
            }
    }
};

template <int MODE>
__device__ __forceinline__ void transpose_w(const float* __restrict__ src, int K, int Nsrc, bf16_t* __restrict__ dst, int Ndst, const float* __restrict__ gain, long gtid, long gsz) {
    const long total = (long)(K / 8) * Ndst;
#pragma unroll 4
    for (long it = gtid; it < total; it += gsz) {
        const int n = (int)(it % Ndst), k8 = (int)(it / Ndst);
        int sc = n;
        if (MODE == 1) { if (n < 3584) sc = n; else sc = n + 16; }
        u32x4 w = {0u, 0u, 0u, 0u};
        if (sc >= 0) {
            const float* s = src + (size_t)(k8 * 8) * Nsrc + sc;
            float v0 = s[0], v1 = s[(size_t)Nsrc], v2 = s[(size_t)2 * Nsrc], v3 = s[(size_t)3 * Nsrc], v4 = s[(size_t)4 * Nsrc], v5 = s[(size_t)5 * Nsrc], v6 = s[(size_t)6 * Nsrc], v7 = s[(size_t)7 * Nsrc];
            if (gain) { const f32x4 g0 = *(const f32x4*)(gain + k8 * 8), g1 = *(const f32x4*)(gain + k8 * 8 + 4); v0 *= g0[0]; v1 *= g0[1]; v2 *= g0[2]; v3 *= g0[3]; v4 *= g1[0]; v5 *= g1[1]; v6 *= g1[2]; v7 *= g1[3]; }
            w.x = cvt_pk_bf16(v0, v1); w.y = cvt_pk_bf16(v2, v3); w.z = cvt_pk_bf16(v4, v5); w.w = cvt_pk_bf16(v6, v7);
        }
        *(u32x4*)(dst + (size_t)n * K + k8 * 8) = w;
    }
}

__device__ __forceinline__ void phase0(const Params& p) {
    unsigned char* ws = p.ws;
    const long gtid = (long)blockIdx.x * NTHR + threadIdx.x, gsz = (long)gridDim.x * NTHR;
    transpose_w<1>(p.in[8], 1024, 5648, (bf16_t*)(ws + WS_WINE), 5632, p.in[7], gtid, gsz);
    for (long it = gtid; it < 128L * 512; it += gsz) {
        const int n = (int)(it & 511), k8 = (int)(it >> 9);
        float wl[16];
#pragma unroll
        for (int r = 0; r < 16; ++r) wl[r] = p.in[9][r * 512 + n];
        float v[8];
#pragma unroll
        for (int i = 0; i < 8; ++i) {
            const float* wr_ = p.in[8] + (size_t)(k8 * 8 + i) * 5648 + 3584;
            float a = 0.f;
#pragma unroll
            for (int r4 = 0; r4 < 4; ++r4) { const f32x4 x = *(const f32x4*)(wr_ + r4 * 4); a += x[0] * wl[r4 * 4] + x[1] * wl[r4 * 4 + 1] + x[2] * wl[r4 * 4 + 2] + x[3] * wl[r4 * 4 + 3]; }
            v[i] = a * p.in[7][k8 * 8 + i];
        }
        u32x4 w; w.x = cvt_pk_bf16(v[0], v[1]); w.y = cvt_pk_bf16(v[2], v[3]); w.z = cvt_pk_bf16(v[4], v[5]); w.w = cvt_pk_bf16(v[6], v[7]);
        *(u32x4*)((bf16_t*)(ws + WS_WINE) + (size_t)(5632 + n) * 1024 + k8 * 8) = w;
    }
    transpose_w<0>(p.in[13], 2048, 1024, (bf16_t*)(ws + WS_WOUTE), 1024, nullptr, gtid, gsz);
    transpose_w<0>(p.in[15], 1024, 3072, (bf16_t*)(ws + WS_WINO), 3072, p.in[14], gtid, gsz);
    transpose_w<0>(p.in[23], 1536, 1024, (bf16_t*)(ws + WS_WOUTO), 1024, nullptr, gtid, gsz);
    for (int nb = 0; nb < 8; ++nb) {
        transpose_w<0>(p.in[18] + nb * 192 * 192, 192, 192, (bf16_t*)(ws + WS_WA) + nb * 192 * 192, 192, nullptr, gtid, gsz);
        transpose_w<0>(p.in[20] + nb * 192 * 192, 192, 192, (bf16_t*)(ws + WS_WI) + nb * 192 * 192, 192, nullptr, gtid, gsz);
    }
    { float* z = (float*)(ws + WS_RSQ1); const long nz = (long)T * 6; for (long i = gtid; i < nz; i += gsz) z[i] = 0.f; }
    const int lane = threadIdx.x & 63; const int gw = (int)(gtid >> 6), nw = (int)(gsz >> 6);
    bf16_t* xb = (bf16_t*)(ws + WS_XB); float* rstd = (float*)(ws + WS_RSTD0);
#pragma unroll 4
    for (int row = gw; row < T; row += nw) {
        const float* xr = (row < T_P) ? p.in[0] + (size_t)row * 1024 : p.in[1] + (size_t)(row - T_P) * 1024;
        float ss = 0.f;
#pragma unroll
        for (int i = 0; i < 4; ++i) {
            const f32x4 v = *(const f32x4*)(xr + i * 256 + lane * 4);
            ss += v[0] * v[0] + v[1] * v[1] + v[2] * v[2] + v[3] * v[3];
            u32x2 w; w.x = cvt_pk_bf16(v[0], v[1]); w.y = cvt_pk_bf16(v[2], v[3]);
            *(u32x2*)(xb + (size_t)row * 1024 + i * 256 + lane * 4) = w;
        }
#pragma unroll
        for (int o = 32; o >= 1; o >>= 1) ss += __shfl_xor(ss, o);
        if (lane == 0) rstd[row] = rsqrtf(ss * (1.f / 1024.f) + EPS);
    }
}

__device__ __forceinline__ void attn_item(const Params& p, LAS unsigned char* L, int item, bf16_t* Yd, int ldd) {
    unsigned char* ws = p.ws;
    const int tid = threadIdx.x, lane = tid & 63, w = tid >> 6, r16 = lane & 15, q4 = lane >> 4;
    LAS bf16_t* Ks = (LAS bf16_t*)L;
    LAS bf16_t* Vs = (LAS bf16_t*)(L + 192 * 72 * 2);
    const unsigned vbase = (unsigned)(size_t)L + 192u * 72u * 2u;
    const bf16_t* Qb = (const bf16_t*)(ws + WS_Q); const bf16_t* Kb = (const bf16_t*)(ws + WS_K); const bf16_t* Vb = (const bf16_t*)(ws + WS_V);
    const bf16_t* Yb = (const bf16_t*)(ws + WS_GATE);
    const bool smp = item >= 2048;
    int b, c, kh; size_t row0;
    if (!smp) { kh = item & 3; c = (item >> 2) & 31; b = item >> 7; row0 = (size_t)b * 2048 + c * 64; }
    else { const int i2 = item - 2048; kh = i2 & 3; b = i2 >> 2; c = 0; row0 = (size_t)T_P + b * 64; }
    const int g = w >> 1, i0 = (w & 1) * 32, h = kh * 4 + g;
    bf16x8 qf[2][2]; u32x2 gv[2][4];
#pragma unroll
    for (int qt = 0; qt < 2; ++qt) {
#pragma unroll
        for (int ks = 0; ks < 2; ++ks) qf[qt][ks] = *(const bf16x8*)(Qb + (row0 + i0 + qt * 16 + r16) * 1024 + h * 64 + ks * 32 + q4 * 8);
#pragma unroll
        for (int dt = 0; dt < 4; ++dt) gv[qt][dt] = *(const u32x2*)(Yb + (row0 + i0 + qt * 16 + r16) * 2048 + h * 64 + dt * 16 + q4 * 4);
    }
#pragma unroll
    for (int i = 0; i < 3; ++i) {
        const int idx = tid + i * 512, key = idx >> 3, dg = idx & 7;
        u32x4 kv = {0u, 0u, 0u, 0u}, vv = {0u, 0u, 0u, 0u};
        if (!smp) {
            const int pos = c * 64 - 128 + key;
            if (pos >= 0) { const size_t r = (size_t)b * 2048 + pos; kv = *(const u32x4*)(Kb + r * 256 + kh * 64 + dg * 8); vv = *(const u32x4*)(Vb + r * 256 + kh * 64 + dg * 8); }
        } else {
            if (key < 128) {
                const size_t o = ((size_t)(b * 128 + key) * 4 + kh) * 64 + dg * 8;
                const f32x4 k0 = *(const f32x4*)(p.in[2] + o), k1 = *(const f32x4*)(p.in[2] + o + 4), v0 = *(const f32x4*)(p.in[3] + o), v1 = *(const f32x4*)(p.in[3] + o + 4);
                kv.x = cvt_pk_bf16(k0[0], k0[1]); kv.y = cvt_pk_bf16(k0[2], k0[3]); kv.z = cvt_pk_bf16(k1[0], k1[1]); kv.w = cvt_pk_bf16(k1[2], k1[3]);
                vv.x = cvt_pk_bf16(v0[0], v0[1]); vv.y = cvt_pk_bf16(v0[2], v0[3]); vv.z = cvt_pk_bf16(v1[0], v1[1]); vv.w = cvt_pk_bf16(v1[2], v1[3]);
            } else { const size_t r = (size_t)T_P + b * 64 + key - 128; kv = *(const u32x4*)(Kb + r * 256 + kh * 64 + dg * 8); vv = *(const u32x4*)(Vb + r * 256 + kh * 64 + dg * 8); }
        }
        *(LAS u32x4*)(Ks + key * 72 + dg * 8) = kv;
        *(LAS u32x4*)(Vs + key * 72 + dg * 8) = vv;
    }
    __syncthreads();
    const float slope = exp2f(-0.5f * (float)(h + 1));
    const float sink = p.in[11][h];
    const unsigned va = vbase + (unsigned)(((q4 * 4 + (r16 >> 2)) * 72 + 4 * (r16 & 3)) * 2);
#pragma unroll
    for (int qt = 0; qt < 2; ++qt) {
        const int i = i0 + qt * 16 + r16;
        f32x4 sacc[12];
#pragma unroll
        for (int kt = 0; kt < 12; ++kt) {
            const bf16x8 kf0 = *(const LAS bf16x8*)(Ks + (kt * 16 + r16) * 72 + q4 * 8), kf1 = *(const LAS bf16x8*)(Ks + (kt * 16 + r16) * 72 + 32 + q4 * 8);
            f32x4 a = {0.f, 0.f, 0.f, 0.f}; a = MFMA16(kf0, qf[qt][0], a); a = MFMA16(kf1, qf[qt][1], a); sacc[kt] = a;
        }
        float m = -3e38f;
#pragma unroll
        for (int kt = 0; kt < 12; ++kt)
#pragma unroll
            for (int jj = 0; jj < 4; ++jj) {
                const int j = kt * 16 + q4 * 4 + jj;
                float sv = sacc[kt][jj] - slope * fabsf((float)(128 + i - j));
                if (!smp && (c * 64 - 128 + j) < 0) sv = -1e30f;
                sacc[kt][jj] = sv; m = fmaxf(m, sv);
            }
        m = fmaxf(m, __shfl_xor(m, 16)); m = fmaxf(m, __shfl_xor(m, 32)); m = fmaxf(m, sink);
        float l = 0.f;
#pragma unroll
        for (int kt = 0; kt < 12; ++kt)
#pragma unroll
            for (int jj = 0; jj < 4; ++jj) { const float pr = __expf(sacc[kt][jj] - m); sacc[kt][jj] = pr; l += pr; }
        l += __shfl_xor(l, 16); l += __shfl_xor(l, 32); l += __expf(sink - m);
        const float inv = 1.f / l;
        f32x4 oacc[4];
#pragma unroll
        for (int dt = 0; dt < 4; ++dt) oacc[dt] = (f32x4){0.f, 0.f, 0.f, 0.f};
#pragma unroll
        for (int kb = 0; kb < 6; ++kb) {
            const bf16x8 pf = pack8(sacc[2 * kb], sacc[2 * kb + 1]);
            bf16x4 l0, h0, l1, h1, l2, h2, l3, h3;
            const unsigned vk = va + (unsigned)(kb * 32 * 144);
            asm volatile("ds_read_b64_tr_b16 %0, %8\n\tds_read_b64_tr_b16 %1, %8 offset:2304\n\t"
                         "ds_read_b64_tr_b16 %2, %8 offset:32\n\tds_read_b64_tr_b16 %3, %8 offset:2336\n\t"
                         "ds_read_b64_tr_b16 %4, %8 offset:64\n\tds_read_b64_tr_b16 %5, %8 offset:2368\n\t"
                         "ds_read_b64_tr_b16 %6, %8 offset:96\n\tds_read_b64_tr_b16 %7, %8 offset:2400\n\t"
                         "s_waitcnt lgkmcnt(0)"
                         : "=&v"(l0), "=&v"(h0), "=&v"(l1), "=&v"(h1), "=&v"(l2), "=&v"(h2), "=&v"(l3), "=&v"(h3) : "v"(vk) : "memory");
            oacc[0] = MFMA16(cat4(l0, h0), pf, oacc[0]); oacc[1] = MFMA16(cat4(l1, h1), pf, oacc[1]);
            oacc[2] = MFMA16(cat4(l2, h2), pf, oacc[2]); oacc[3] = MFMA16(cat4(l3, h3), pf, oacc[3]);
        }
#pragma unroll
        for (int dt = 0; dt < 4; ++dt) {
            const u32x2 gq = gv[qt][dt];
            const f32x4 o = oacc[dt] * inv;
            u32x2 wv; wv.x = cvt_pk_bf16(o[0] * siluf(bflo(gq.x)), o[1] * siluf(bfhi(gq.x))); wv.y = cvt_pk_bf16(o[2] * siluf(bflo(gq.y)), o[3] * siluf(bfhi(gq.y)));
            *(u32x2*)(Yd + (row0 + i) * ldd + h * 64 + dt * 16 + q4 * 4) = wv;
        }
    }
    __syncthreads();
}

__device__ __forceinline__ void gla_item(const Params& p, LAS unsigned char* L, int item) {
    unsigned char* ws = p.ws;
    const int tid = threadIdx.x, lane = tid & 63, w = tid >> 6, r16 = lane & 15, q4 = lane >> 4;
    LAS bf16_t* QG = (LAS bf16_t*)L;
    LAS bf16_t* KG = (LAS bf16_t*)(L + 17408);
    LAS bf16_t* Vs = (LAS bf16_t*)(L + 34816);
    LAS bf16_t* Gs = (LAS bf16_t*)(L + 44032);
    LAS float* Gf = (LAS float*)(L + 61440);
    LAS float* GT = (LAS float*)(L + 94208);
    LAS float* GL = (LAS float*)(L + 96256);
    const unsigned lbase = (unsigned)(size_t)L;
    const bool smp = item >= 256;
    const int i2 = smp ? item - 256 : item;
    const int b = i2 >> 4, h = (i2 >> 2) & 3, sl = i2 & 3, e0 = sl * 64;
    const int nch = smp ? 1 : 32;
    const unsigned rbase = smp ? (unsigned)T_P + b * 64 : (unsigned)b * 2048;
    const bf16_t* BQ = (const bf16_t*)(ws + WS_BQ); const bf16_t* BKb = (const bf16_t*)(ws + WS_BK); bf16_t* BV = (bf16_t*)(ws + WS_BV);
    const bf16_t* GB = (const bf16_t*)(ws + WS_BLR); float* BOSQP = (float*)(ws + WS_XB);
    const int c = tid & 127, tg = tid >> 7;
    const int pt0 = tid >> 4, pt1 = (tid + 512) >> 4, poc = tid & 15;
    const int vt = tid >> 3, veo = tid & 7;
    const int et = w & 3, ip = w >> 2;
    f32x4 Sacc[8];
#pragma unroll
    for (int d8 = 0; d8 < 8; ++d8) {
        if (smp) {
#pragma unroll
            for (int jj = 0; jj < 4; ++jj) Sacc[d8][jj] = p.in[4][((size_t)(b * 4 + h) * 128 + d8 * 16 + q4 * 4 + jj) * 256 + e0 + et * 16 + r16];
        } else Sacc[d8] = (f32x4){0.f, 0.f, 0.f, 0.f};
    }
    const int tq_ = r16 >> 2, tp_ = r16 & 3;
    const unsigned v2a = lbase + 34816u + (unsigned)(((q4 * 4 + tq_) * 72 + et * 16 + 4 * tp_) * 2);
    const unsigned v4a = lbase + 34816u + (unsigned)(((q4 * 8 + tq_) * 72 + et * 16 + 4 * tp_) * 2);
    const unsigned k4a = lbase + 17408u + (unsigned)(((q4 * 8 + tq_) * 136 + 4 * tp_) * 2);
    u32x4 pq0, pq1, pk0, pk1, pg0, pg1, pv;
    {
        const unsigned o0 = (rbase + pt0) * 512u + h * 128 + poc * 8, o1 = (rbase + pt1) * 512u + h * 128 + poc * 8;
        pq0 = *(const u32x4*)(BQ + o0); pq1 = *(const u32x4*)(BQ + o1); pk0 = *(const u32x4*)(BKb + o0); pk1 = *(const u32x4*)(BKb + o1);
        pg0 = *(const u32x4*)(GB + o0); pg1 = *(const u32x4*)(GB + o1);
        pv = *(const u32x4*)(BV + (rbase + vt) * 1024u + h * 256 + e0 + veo * 8);
    }
    f32x4 po0 = {0.f, 0.f, 0.f, 0.f}, po1 = {0.f, 0.f, 0.f, 0.f}; unsigned prow = 0; bool pend = false;
#define GLA_STORE_OUT() do { \
            _Pragma("unroll") for (int x2 = 0; x2 < 2; ++x2) { \
                const unsigned row = prow + (ip * 2 + x2) * 16 + r16; \
                const f32x4 o = x2 ? po1 : po0; \
                u32x2 wv; wv.x = cvt_pk_bf16(o[0], o[1]); wv.y = cvt_pk_bf16(o[2], o[3]); \
                *(u32x2*)(BV + row * 1024u + h * 256 + e0 + et * 16 + q4 * 4) = wv; \
                float ss = o[0] * o[0] + o[1] * o[1] + o[2] * o[2] + o[3] * o[3]; \
                ss += __shfl_xor(ss, 16); ss += __shfl_xor(ss, 32); \
                if (q4 == 0) BOSQP[row * 64u + h * 16 + sl * 4 + et] = ss; \
            } } while (0)
    for (int ci = 0; ci < nch; ++ci) {
        const unsigned r0 = rbase + (unsigned)ci * 64;
        const bool more = (ci + 1 < nch);
        *(LAS u32x4*)(Gs + pt0 * 136 + poc * 8) = pg0; *(LAS u32x4*)(Gs + pt1 * 136 + poc * 8) = pg1;
        *(LAS u32x4*)(Vs + vt * 72 + veo * 8) = pv;
        lds_barrier();
        if (pend) GLA_STORE_OUT();
        if (more) pv = *(const u32x4*)(BV + (r0 + 64 + vt) * 1024u + h * 256 + e0 + veo * 8);
        {
            float cs = 0.f;
#pragma unroll
            for (int tt = 0; tt < 16; ++tt) { cs += bf2f(Gs[(tg * 16 + tt) * 136 + c]); Gf[(tg * 16 + tt) * 128 + c] = cs; }
            GT[tg * 128 + c] = cs;
        }
        lds_barrier();
#pragma unroll
        for (int i = 0; i < 2; ++i) {
            const int t = i ? pt1 : pt0; const int tgp = t >> 4;
            const u32x4 qw = i ? pq1 : pq0, kw = i ? pk1 : pk0;
            float G[8], tot[8];
            { const f32x4 a0 = *(const LAS f32x4*)(Gf + t * 128 + poc * 8), a1 = *(const LAS f32x4*)(Gf + t * 128 + poc * 8 + 4);
              G[0] = a0[0]; G[1] = a0[1]; G[2] = a0[2]; G[3] = a0[3]; G[4] = a1[0]; G[5] = a1[1]; G[6] = a1[2]; G[7] = a1[3]; }
#pragma unroll
            for (int j = 0; j < 8; ++j) tot[j] = 0.f;
#pragma unroll
            for (int g2 = 0; g2 < 4; ++g2) {
                const f32x4 a0 = *(const LAS f32x4*)(GT + g2 * 128 + poc * 8), a1 = *(const LAS f32x4*)(GT + g2 * 128 + poc * 8 + 4);
                const float sel = (g2 < tgp) ? 1.f : 0.f;
                G[0] += sel * a0[0]; G[1] += sel * a0[1]; G[2] += sel * a0[2]; G[3] += sel * a0[3]; G[4] += sel * a1[0]; G[5] += sel * a1[1]; G[6] += sel * a1[2]; G[7] += sel * a1[3];
                tot[0] += a0[0]; tot[1] += a0[1]; tot[2] += a0[2]; tot[3] += a0[3]; tot[4] += a1[0]; tot[5] += a1[1]; tot[6] += a1[2]; tot[7] += a1[3];
            }
            if (i == 0 && tid < 16) {
#pragma unroll
                for (int j = 0; j < 8; ++j) GL[poc * 8 + j] = __expf(tot[j]);
            }
            float qv[8], kv[8];
            unpack8(qw, qv); unpack8(kw, kv);
#pragma unroll
            for (int j = 0; j < 8; ++j) { const float eg = __expf(G[j]); qv[j] *= eg; kv[j] *= rcpf_(eg); }
            u32x4 qo, ko;
            qo.x = cvt_pk_bf16(qv[0], qv[1]); qo.y = cvt_pk_bf16(qv[2], qv[3]); qo.z = cvt_pk_bf16(qv[4], qv[5]); qo.w = cvt_pk_bf16(qv[6], qv[7]);
            ko.x = cvt_pk_bf16(kv[0], kv[1]); ko.y = cvt_pk_bf16(kv[2], kv[3]); ko.z = cvt_pk_bf16(kv[4], kv[5]); ko.w = cvt_pk_bf16(kv[6], kv[7]);
            *(LAS u32x4*)(QG + t * 136 + poc * 8) = qo; *(LAS u32x4*)(KG + t * 136 + poc * 8) = ko;
        }
        if (more) {
            const unsigned o0 = (r0 + 64 + pt0) * 512u + h * 128 + poc * 8, o1 = (r0 + 64 + pt1) * 512u + h * 128 + poc * 8;
            pq0 = *(const u32x4*)(BQ + o0); pq1 = *(const u32x4*)(BQ + o1); pk0 = *(const u32x4*)(BKb + o0); pk1 = *(const u32x4*)(BKb + o1);
            pg0 = *(const u32x4*)(GB + o0); pg1 = *(const u32x4*)(GB + o1);
        }
        lds_barrier();
        f32x4 at[4][2];
#pragma unroll
        for (int jt = 0; jt < 4; ++jt)
#pragma unroll
            for (int x2 = 0; x2 < 2; ++x2) at[jt][x2] = (f32x4){0.f, 0.f, 0.f, 0.f};
#pragma unroll
        for (int ks = 0; ks < 4; ++ks) {
            bf16x8 qf[2];
#pragma unroll
            for (int x2 = 0; x2 < 2; ++x2) qf[x2] = *(const LAS bf16x8*)(QG + ((ip * 2 + x2) * 16 + r16) * 136 + ks * 32 + q4 * 8);
#pragma unroll
            for (int jt = 0; jt < 4; ++jt) {
                const bf16x8 kf = *(const LAS bf16x8*)(KG + (jt * 16 + r16) * 136 + ks * 32 + q4 * 8);
#pragma unroll
                for (int x2 = 0; x2 < 2; ++x2) at[jt][x2] = MFMA16(kf, qf[x2], at[jt][x2]);
            }
        }
#pragma unroll
        for (int jt = 0; jt < 4; ++jt)
#pragma unroll
            for (int x2 = 0; x2 < 2; ++x2)
#pragma unroll
                for (int jj = 0; jj < 4; ++jj) { const int j = jt * 16 + q4 * 4 + jj, i = (ip * 2 + x2) * 16 + r16; if (j > i) at[jt][x2][jj] = 0.f; }
        f32x4 ot[2];
        ot[0] = (f32x4){0.f, 0.f, 0.f, 0.f}; ot[1] = (f32x4){0.f, 0.f, 0.f, 0.f};
        {
            bf16x4 a0, a1, b0, b1;
            asm volatile("ds_read_b64_tr_b16 %0, %4\n\tds_read_b64_tr_b16 %1, %4 offset:2304\n\tds_read_b64_tr_b16 %2, %4 offset:4608\n\tds_read_b64_tr_b16 %3, %4 offset:6912\n\ts_waitcnt lgkmcnt(0)"
                         : "=&v"(a0), "=&v"(a1), "=&v"(b0), "=&v"(b1) : "v"(v2a) : "memory");
            const bf16x8 vf0 = cat4(a0, a1), vf1 = cat4(b0, b1);
#pragma unroll
            for (int x2 = 0; x2 < 2; ++x2) { ot[x2] = MFMA16(vf0, pack8(at[0][x2], at[1][x2]), ot[x2]); ot[x2] = MFMA16(vf1, pack8(at[2][x2], at[3][x2]), ot[x2]); }
        }
#pragma unroll
        for (int db = 0; db < 4; ++db) {
            const bf16x8 sf = pack8(Sacc[2 * db], Sacc[2 * db + 1]);
#pragma unroll
            for (int x2 = 0; x2 < 2; ++x2) {
                const LAS bf16_t* qp = QG + ((ip * 2 + x2) * 16 + r16) * 136 + db * 32 + q4 * 4;
                const bf16x8 qv = cat4(*(const LAS bf16x4*)qp, *(const LAS bf16x4*)(qp + 16));
                ot[x2] = MFMA16(sf, qv, ot[x2]);
            }
        }
        po0 = ot[0]; po1 = ot[1]; prow = r0; pend = true;
#pragma unroll
        for (int jb = 0; jb < 2; ++jb) {
            bf16x4 kl[8], kh[8], vl, vh;
            const unsigned ka = k4a + (unsigned)(jb * 32 * 272), va = v4a + (unsigned)(jb * 32 * 144);
            asm volatile("ds_read_b64_tr_b16 %0, %18 offset:0\n\t"
                "ds_read_b64_tr_b16 %1, %18 offset:1088\n\t"
                "ds_read_b64_tr_b16 %2, %18 offset:32\n\t"
                "ds_read_b64_tr_b16 %3, %18 offset:1120\n\t"
                "ds_read_b64_tr_b16 %4, %18 offset:64\n\t"
                "ds_read_b64_tr_b16 %5, %18 offset:1152\n\t"
                "ds_read_b64_tr_b16 %6, %18 offset:96\n\t"
                "ds_read_b64_tr_b16 %7, %18 offset:1184\n\t"
                "ds_read_b64_tr_b16 %8, %18 offset:128\n\t"
                "ds_read_b64_tr_b16 %9, %18 offset:1216\n\t"
                "ds_read_b64_tr_b16 %10, %18 offset:160\n\t"
                "ds_read_b64_tr_b16 %11, %18 offset:1248\n\t"
                "ds_read_b64_tr_b16 %12, %18 offset:192\n\t"
                "ds_read_b64_tr_b16 %13, %18 offset:1280\n\t"
                "ds_read_b64_tr_b16 %14, %18 offset:224\n\t"
                "ds_read_b64_tr_b16 %15, %18 offset:1312\n\t"
                "ds_read_b64_tr_b16 %16, %19\n\t"
                "ds_read_b64_tr_b16 %17, %19 offset:576\n\t"
                "s_waitcnt lgkmcnt(0)"
                         : "=&v"(kl[0]), "=&v"(kh[0]), "=&v"(kl[1]), "=&v"(kh[1]), "=&v"(kl[2]), "=&v"(kh[2]), "=&v"(kl[3]), "=&v"(kh[3]), "=&v"(kl[4]), "=&v"(kh[4]), "=&v"(kl[5]), "=&v"(kh[5]), "=&v"(kl[6]), "=&v"(kh[6]), "=&v"(kl[7]), "=&v"(kh[7]), "=&v"(vl), "=&v"(vh) : "v"(ka), "v"(va) : "memory");
            const bf16x8 vf = cat4(vl, vh);
#pragma unroll
            for (int d8 = 0; d8 < 8; ++d8) Sacc[d8] = MFMA16(cat4(kl[d8], kh[d8]), vf, Sacc[d8]);
        }
#pragma unroll
        for (int d8 = 0; d8 < 8; ++d8) {
            const f32x4 dec = *(const LAS f32x4*)(GL + d8 * 16 + q4 * 4);
            Sacc[d8] = Sacc[d8] * dec;
        }
        lds_barrier();
    }
    if (pend) GLA_STORE_OUT();
#undef GLA_STORE_OUT
    if (ip == 0) {
        float* og = p.out + (smp ? O_GS : O_GP);
#pragma unroll
        for (int d8 = 0; d8 < 8; ++d8)
#pragma unroll
            for (int jj = 0; jj < 4; ++jj) og[((size_t)(b * 4 + h) * 128 + d8 * 16 + q4 * 4 + jj) * 256 + e0 + et * 16 + r16] = Sacc[d8][jj];
    }
}

__device__ __forceinline__ void phase2(const Params& p, LAS unsigned char* L) {
    for (int it = blockIdx.x; it < 768; it += gridDim.x) gla_item(p, L, it);
#ifdef PROBE_ATTN2
    for (int it = blockIdx.x; it < 2176; it += gridDim.x) attn_item(p, L, it, (bf16_t*)(p.ws + WS_XB), 1024);
#endif
    for (int it = blockIdx.x; it < 2176; it += gridDim.x) attn_item(p, L, it, (bf16_t*)(p.ws + WS_GATE), 2048);
}

__device__ __forceinline__ void phase3(const Params& p) {
    unsigned char* ws = p.ws;
    const bf16_t* BV = (const bf16_t*)(ws + WS_BV); bf16_t* Yb = (bf16_t*)(ws + WS_GATE); const float* BOSQP = (const float*)(ws + WS_XB);
    const float* gg = p.in[12];
    const long gtid = (long)blockIdx.x * NTHR + threadIdx.x, gsz = (long)gridDim.x * NTHR;
    const long total = (long)T * 128;
    for (long it = gtid; it < total; it += gsz) {
        const long row = it >> 7; const int c8 = (int)(it & 127) * 8, h = c8 >> 8;
        float sq;
        { const f32x4 s0 = *(const f32x4*)(BOSQP + row * 64 + h * 16), s1 = *(const f32x4*)(BOSQP + row * 64 + h * 16 + 4), s2 = *(const f32x4*)(BOSQP + row * 64 + h * 16 + 8), s3 = *(const f32x4*)(BOSQP + row * 64 + h * 16 + 12);
          sq = ((s0[0] + s0[1]) + (s0[2] + s0[3])) + ((s1[0] + s1[1]) + (s1[2] + s1[3])) + ((s2[0] + s2[1]) + (s2[2] + s2[3])) + ((s3[0] + s3[1]) + (s3[2] + s3[3])); }
        const float rs = rsqrtf(sq * (1.f / 256.f) + EPS);
        const u32x4 bo = *(const u32x4*)(BV + row * 1024 + c8);
        const u32x4 gt = *(const u32x4*)(Yb + row * 2048 + 1024 + c8);
        const f32x4 g0 = *(const f32x4*)(gg + (c8 & 255)), g1 = *(const f32x4*)(gg + (c8 & 255) + 4);
        u32x4 o;
        o.x = cvt_pk_bf16(bflo(bo.x) * rs * g0[0] * siluf(bflo(gt.x)), bfhi(bo.x) * rs * g0[1] * siluf(bfhi(gt.x)));
        o.y = cvt_pk_bf16(bflo(bo.y) * rs * g0[2] * siluf(bflo(gt.y)), bfhi(bo.y) * rs * g0[3] * siluf(bfhi(gt.y)));
        o.z = cvt_pk_bf16(bflo(bo.z) * rs * g1[0] * siluf(bflo(gt.z)), bfhi(bo.z) * rs * g1[1] * siluf(bfhi(gt.z)));
        o.w = cvt_pk_bf16(bflo(bo.w) * rs * g1[2] * siluf(bflo(gt.w)), bfhi(bo.w) * rs * g1[3] * siluf(bfhi(gt.w)));
        *(u32x4*)(Yb + row * 2048 + 1024 + c8) = o;
    }
}

__device__ __forceinline__ void lru_item(const Params& p, LAS unsigned char* L, int item) {
    unsigned char* ws = p.ws;
    const int tid = threadIdx.x, lane = tid & 63, w = tid >> 6, r16 = lane & 15, q4 = lane >> 4;
    LAS bf16_t* Wl = (LAS bf16_t*)L;
    LAS bf16_t* U = (LAS bf16_t*)(L + 76800);
    LAS float* Aa = (LAS float*)(L + 102400);
    LAS float* Bb = (LAS float*)(L + 126976);
    LAS float* SP = (LAS float*)(L + 151552);
    LAS float* SH = (LAS float*)(L + 153088);
    LAS float* HC = (LAS float*)(L + 154624);
    LAS float* CW = (LAS float*)(L + 155392);
    const bool smp = item >= 256;
    const int i2 = smp ? item - 256 : item;
    const int b = i2 >> 4, nb = (i2 >> 1) & 7, hf = i2 & 1;
    const int nch = smp ? 1 : 32;
    const unsigned rbase = smp ? (unsigned)T_P + b * 64 : (unsigned)b * 2048;
    const bf16_t* Z2 = (const bf16_t*)(ws + WS_Z2); bf16_t* Y2 = (bf16_t*)(ws + WS_Y2);
    const bf16_t* WA = (const bf16_t*)(ws + WS_WA) + nb * 192 * 192; const bf16_t* WI = (const bf16_t*)(ws + WS_WI) + nb * 192 * 192;
    for (int idx = tid; idx < 192 * 24; idx += NTHR) {
        const int r = idx / 24, g8 = idx % 24;
        const bf16_t* src = (r < 96) ? WA + (size_t)(hf * 96 + r) * 192 + g8 * 8 : WI + (size_t)(hf * 96 + r - 96) * 192 + g8 * 8;
        *(LAS u32x4*)(Wl + r * 200 + g8 * 8) = *(const u32x4*)src;
    }
    const bool cthr = tid < 384;
    const int cgp = tid % 24, tq = (tid / 24) & 15;
    const int chc = nb * 192 + cgp * 8;
    for (int idx = tid; idx < 5 * 192; idx += NTHR) { const int j = idx / 192, cc = idx % 192; CW[idx] = (j < 4) ? p.in[16][j * 1536 + nb * 192 + cc] : p.in[17][nb * 192 + cc]; }
    const int mt = w & 3, pg = w >> 2;
    float bra[3], bri[3], sp[3];
#pragma unroll
    for (int cp = 0; cp < 3; ++cp) {
        const int ch = nb * 192 + hf * 96 + (pg * 3 + cp) * 16 + r16;
        bra[cp] = p.in[19][ch]; bri[cp] = p.in[21][ch];
        const float lam = p.in[22][ch];
        sp[cp] = 8.f * (fmaxf(-lam, 0.f) + log1pf(__expf(-fabsf(lam))));
    }
    if (tid < 96) HC[tid] = smp ? p.in[6][b * 1536 + nb * 192 + hf * 96 + tid] : 0.f;
    const int sch0 = tid % 96, sseg0 = (tid / 96) & 3;
    const int ot0 = tid / 12, og0 = tid % 12, ot1 = (tid + 512) / 12, og1 = (tid + 512) % 12;
    const bool o1 = tid < 256;
    const int och0 = nb * 192 + hf * 96 + og0 * 8, och1 = nb * 192 + hf * 96 + og1 * 8;
    lds_barrier();
    u32x4 xr[7]; u32x4 pg0, pg1 = {0u, 0u, 0u, 0u};
#pragma unroll
    for (int r = 0; r < 7; ++r) {
        xr[r] = (u32x4){0u, 0u, 0u, 0u};
        const int pos = 4 * tq - 3 + r;
        if (cthr) {
            if (pos >= 0) xr[r] = *(const u32x4*)(Z2 + (unsigned)((rbase + pos) * 3072u + chc));
            else if (smp) {
                const float* hp = p.in[5] + ((size_t)b * 3 + (3 + pos)) * 1536 + chc;
                const f32x4 h0 = *(const f32x4*)hp, h1 = *(const f32x4*)(hp + 4);
                xr[r].x = cvt_pk_bf16(h0[0], h0[1]); xr[r].y = cvt_pk_bf16(h0[2], h0[3]); xr[r].z = cvt_pk_bf16(h1[0], h1[1]); xr[r].w = cvt_pk_bf16(h1[2], h1[3]);
            }
        }
    }
    pg0 = *(const u32x4*)(Z2 + (unsigned)((rbase + ot0) * 3072u + 1536 + och0));
    if (o1) pg1 = *(const u32x4*)(Z2 + (unsigned)((rbase + ot1) * 3072u + 1536 + och1));
    u32x4 so0 = {0u, 0u, 0u, 0u}, so1 = {0u, 0u, 0u, 0u}; unsigned sr = 0; bool spend = false;
    for (int ci = 0; ci < nch; ++ci) {
        const unsigned r0 = rbase + (unsigned)ci * 64;
        const bool more = (ci + 1 < nch);
        int sch = sch0, sseg = sseg0;
        asm volatile("" : "+v"(sch), "+v"(sseg));
        if (cthr) {
            float xv[7][8];
#pragma unroll
            for (int r = 0; r < 7; ++r) unpack8(xr[r], xv[r]);
            if (hf == 0 && !more && tq == 15) {
                float* oc = p.out + (smp ? O_CS : O_CP) + (size_t)b * 3 * 1536 + chc;
#pragma unroll
                for (int r = 0; r < 3; ++r) { *(f32x4*)(oc + r * 1536) = (f32x4){xv[4 + r][0], xv[4 + r][1], xv[4 + r][2], xv[4 + r][3]}; *(f32x4*)(oc + r * 1536 + 4) = (f32x4){xv[4 + r][4], xv[4 + r][5], xv[4 + r][6], xv[4 + r][7]}; }
            }
            float cw[5][8];
#pragma unroll
            for (int j = 0; j < 5; ++j) { const f32x4 c0 = *(const LAS f32x4*)(CW + j * 192 + cgp * 8), c1 = *(const LAS f32x4*)(CW + j * 192 + cgp * 8 + 4);
                cw[j][0] = c0[0]; cw[j][1] = c0[1]; cw[j][2] = c0[2]; cw[j][3] = c0[3]; cw[j][4] = c1[0]; cw[j][5] = c1[1]; cw[j][6] = c1[2]; cw[j][7] = c1[3]; }
#pragma unroll
            for (int tk = 0; tk < 4; ++tk) {
                float acc[8];
#pragma unroll
                for (int e = 0; e < 8; ++e) acc[e] = cw[4][e] + xv[tk][e] * cw[0][e] + xv[tk + 1][e] * cw[1][e] + xv[tk + 2][e] * cw[2][e] + xv[tk + 3][e] * cw[3][e];
                u32x4 uw; uw.x = cvt_pk_bf16(acc[0], acc[1]); uw.y = cvt_pk_bf16(acc[2], acc[3]); uw.z = cvt_pk_bf16(acc[4], acc[5]); uw.w = cvt_pk_bf16(acc[6], acc[7]);
                *(LAS u32x4*)(U + (4 * tq + tk) * 200 + cgp * 8) = uw;
            }
            if (more) {
#pragma unroll
                for (int r = 0; r < 7; ++r) xr[r] = *(const u32x4*)(Z2 + (unsigned)((r0 + 64 + 4 * tq - 3 + r) * 3072u + chc));
            }
        }
        lds_barrier();
        if (spend) { *(u32x4*)(Y2 + (unsigned)((sr + ot0) * 1536u + och0)) = so0; if (o1) *(u32x4*)(Y2 + (unsigned)((sr + ot1) * 1536u + och1)) = so1; }
        f32x4 ga[3], gi[3];
#pragma unroll
        for (int cp = 0; cp < 3; ++cp) { ga[cp] = (f32x4){0.f, 0.f, 0.f, 0.f}; gi[cp] = (f32x4){0.f, 0.f, 0.f, 0.f}; }
#pragma unroll 2
        for (int ks = 0; ks < 6; ++ks) {
            const bf16x8 uf = *(const LAS bf16x8*)(U + (mt * 16 + r16) * 200 + ks * 32 + q4 * 8);
#pragma unroll
            for (int cp = 0; cp < 3; ++cp) {
                const int ct = pg * 3 + cp;
                const bf16x8 wa = *(const LAS bf16x8*)(Wl + (ct * 16 + r16) * 200 + ks * 32 + q4 * 8), wi = *(const LAS bf16x8*)(Wl + (96 + ct * 16 + r16) * 200 + ks * 32 + q4 * 8);
                ga[cp] = MFMA16(uf, wa, ga[cp]); gi[cp] = MFMA16(uf, wi, gi[cp]);
            }
        }
#pragma unroll
        for (int cp = 0; cp < 3; ++cp) {
            const int cl = (pg * 3 + cp) * 16 + r16;
#pragma unroll
            for (int jj = 0; jj < 4; ++jj) {
                const int t = mt * 16 + q4 * 4 + jj;
                const float rg = sigmf(ga[cp][jj] + bra[cp]), ig = sigmf(gi[cp][jj] + bri[cp]);
                const float z = rg * sp[cp];
                const float a = __expf(-z);
                const float z2 = z + z;
                const float om = (z2 < 0.05f) ? z2 * (1.f - z2 * (0.5f - z2 * (0.16666667f - z2 * 0.041666668f))) : 1.f - a * a;
                const float uu = bf2f(U[t * 200 + hf * 96 + cl]);
                Aa[t * 96 + cl] = a; Bb[t * 96 + cl] = __builtin_amdgcn_sqrtf(om) * ig * uu;
            }
        }
        lds_barrier();
        if (cthr) {
            float P = 1.f, H = 0.f;
#pragma unroll
            for (int t = 0; t < 16; ++t) { const float a = Aa[(sseg * 16 + t) * 96 + sch]; H = a * H + Bb[(sseg * 16 + t) * 96 + sch]; P *= a; }
            SP[sseg * 96 + sch] = P; SH[sseg * 96 + sch] = H;
        }
        lds_barrier();
        if (cthr) {
            float hh = HC[(ci & 1) * 96 + sch];
#pragma unroll
            for (int sg = 0; sg < 3; ++sg) if (sg < sseg) hh = SP[sg * 96 + sch] * hh + SH[sg * 96 + sch];
#pragma unroll
            for (int t = 0; t < 16; ++t) { hh = Aa[(sseg * 16 + t) * 96 + sch] * hh + Bb[(sseg * 16 + t) * 96 + sch]; Bb[(sseg * 16 + t) * 96 + sch] = hh; }
            if (sseg == 3) HC[((ci + 1) & 1) * 96 + sch] = hh;
        }
        lds_barrier();
        {
            const f32x4 h0 = *(const LAS f32x4*)(Bb + ot0 * 96 + og0 * 8), h1 = *(const LAS f32x4*)(Bb + ot0 * 96 + og0 * 8 + 4);
            u32x4 o;
            o.x = cvt_pk_bf16(h0[0] * siluf(bflo(pg0.x)), h0[1] * siluf(bfhi(pg0.x)));
            o.y = cvt_pk_bf16(h0[2] * siluf(bflo(pg0.y)), h0[3] * siluf(bfhi(pg0.y)));
            o.z = cvt_pk_bf16(h1[0] * siluf(bflo(pg0.z)), h1[1] * siluf(bfhi(pg0.z)));
            o.w = cvt_pk_bf16(h1[2] * siluf(bflo(pg0.w)), h1[3] * siluf(bfhi(pg0.w)));
            so0 = o;
            if (more) pg0 = *(const u32x4*)(Z2 + (unsigned)((r0 + 64 + ot0) * 3072u + 1536 + och0));
        }
        if (o1) {
            const f32x4 h0 = *(const LAS f32x4*)(Bb + ot1 * 96 + og1 * 8), h1 = *(const LAS f32x4*)(Bb + ot1 * 96 + og1 * 8 + 4);
            u32x4 o;
            o.x = cvt_pk_bf16(h0[0] * siluf(bflo(pg1.x)), h0[1] * siluf(bfhi(pg1.x)));
            o.y = cvt_pk_bf16(h0[2] * siluf(bflo(pg1.y)), h0[3] * siluf(bfhi(pg1.y)));
            o.z = cvt_pk_bf16(h1[0] * siluf(bflo(pg1.z)), h1[1] * siluf(bfhi(pg1.z)));
            o.w = cvt_pk_bf16(h1[2] * siluf(bflo(pg1.w)), h1[3] * siluf(bfhi(pg1.w)));
            so1 = o;
            if (more) pg1 = *(const u32x4*)(Z2 + (unsigned)((r0 + 64 + ot1) * 3072u + 1536 + och1));
        }
        sr = r0; spend = true;
        lds_barrier();
    }
    if (spend) { *(u32x4*)(Y2 + (unsigned)((sr + ot0) * 1536u + och0)) = so0; if (o1) *(u32x4*)(Y2 + (unsigned)((sr + ot1) * 1536u + och1)) = so1; }
    if (tid < 96) p.out[(smp ? O_LS : O_LP) + (size_t)b * 1536 + nb * 192 + hf * 96 + tid] = HC[(nch & 1) * 96 + tid];
    lds_barrier();
}

__device__ __forceinline__ void phase6(const Params& p, LAS unsigned char* L) {
    for (int it = blockIdx.x; it < 768; it += gridDim.x) lru_item(p, L, it);
}

__device__ __forceinline__ void phase8(const Params& p) {
    const float* rsq = (const float*)(p.ws + WS_RSQ2); const float* g = p.in[24]; float* y = p.out;
    const long gtid = (long)blockIdx.x * NTHR + threadIdx.x, gsz = (long)gridDim.x * NTHR;
    const long total = (long)T * 256;
    for (long it = gtid; it < total; it += gsz) {
        const long row = it >> 8; const int c4 = (int)(it & 255) * 4;
        const float rs = rsqrtf(rsq[row] * (1.f / 1024.f) + EPS);
        const f32x4 v = *(const f32x4*)(y + row * 1024 + c4), gv = *(const f32x4*)(g + c4);
        *(f32x4*)(y + row * 1024 + c4) = v * rs * gv;
    }
}

__global__ void __launch_bounds__(NTHR) mega(Params p) {
    extern __shared__ __attribute__((aligned(16))) unsigned char lds_raw[];
    LAS unsigned char* L = (LAS unsigned char*)lds_raw;
    cg::grid_group grid = cg::this_grid();
    unsigned char* ws = p.ws;
    const int lo = p.ph_lo, hi = p.ph_hi;
#ifndef PHMASK
#define PHMASK 0x1ff
#endif
#define IN(k) (((PHMASK >> (k)) & 1) && lo <= (k) && (k) < hi)
#define SEAM(k) do { if (IN(k) && IN((k) + 1)) grid.sync(); } while (0)
    if (IN(0)) phase0(p);
    SEAM(0);
    if (IN(1)) {
        pg8::Gemm g{(const bf16_t*)(ws + WS_XB), (const bf16_t*)(ws + WS_WINE), T, NE_PAD, 1024};
        pg8::StaticOrder S; S.init(T, NE_PAD, gridDim.x, blockIdx.x);
        EpiInEven E{ws, p.out, (const float*)(ws + WS_RSTD0), p.in[10]};
        pg8::gemm_phase<EpiInEven>(L, g, S, E);
    }
    SEAM(1);
    if (IN(2)) phase2(p, L);
    SEAM(2);
    if (IN(3)) phase3(p);
    SEAM(3);
    if (IN(4)) {
        pg8::Gemm g{(const bf16_t*)(ws + WS_GATE), (const bf16_t*)(ws + WS_WOUTE), T, 1024, 2048};
        pg8::StaticOrder S; S.init(T, 1024, gridDim.x, blockIdx.x);
        EpiOutRes<true> E{p.in[0], p.in[1], p.out, (bf16_t*)(ws + WS_XB), (float*)(ws + WS_RSQ1)};
        pg8::gemm_phase<EpiOutRes<true>>(L, g, S, E);
    }
    SEAM(4);
    if (IN(5)) {
        pg8::Gemm g{(const bf16_t*)(ws + WS_XB), (const bf16_t*)(ws + WS_WINO), T, 3072, 1024};
        pg8::StaticOrder S; S.init(T, 3072, gridDim.x, blockIdx.x);
        EpiInOdd E{(bf16_t*)(ws + WS_Z2), (const float*)(ws + WS_RSQ1)};
        pg8::gemm_phase<EpiInOdd>(L, g, S, E);
    }
    SEAM(5);
    if (IN(6)) phase6(p, L);
    SEAM(6);
    if (IN(7)) {
        pg8::Gemm g{(const bf16_t*)(ws + WS_Y2), (const bf16_t*)(ws + WS_WOUTO), T, 1024, 1536};
        pg8::StaticOrder S; S.init(T, 1024, gridDim.x, blockIdx.x);
        EpiOutRes<false> E{p.out, p.out + (size_t)T_P * 1024, p.out, nullptr, (float*)(ws + WS_RSQ2)};
        pg8::gemm_phase<EpiOutRes<false>>(L, g, S, E);
    }
    SEAM(7);
    if (IN(8)) phase8(p);
#undef IN
#undef SEAM
}

extern "C" void kernel_launch(void* const* d_in, const int* in_sizes, int n_in, void* d_out, int out_size, void* d_ws, size_t ws_size, hipStream_t stream) {
    static int grid_blocks = 0;
    if (grid_blocks == 0) {
        if (n_in != 25 || (size_t)out_size != O_END || ws_size < WS_END) { fprintf(stderr, "kernel_launch: unexpected shapes n_in %d out %d ws %zu (need %zu)\n", n_in, out_size, ws_size, (size_t)WS_END); grid_blocks = -1; return; }
        int dev = 0, cus = 0, per_cu = 0;
        (void)hipGetDevice(&dev);
        (void)hipDeviceGetAttribute(&cus, hipDeviceAttributeMultiprocessorCount, dev);
        if (hipFuncSetAttribute((const void*)mega, hipFuncAttributeMaxDynamicSharedMemorySize, LDS_BYTES) != hipSuccess) { fprintf(stderr, "kernel_launch: hipFuncSetAttribute failed\n"); }
        if (hipOccupancyMaxActiveBlocksPerMultiprocessor(&per_cu, (const void*)mega, NTHR, LDS_BYTES) != hipSuccess || per_cu < 1) per_cu = 1;
        (void)hipGetLastError();
        grid_blocks = cus * per_cu;
        if (grid_blocks <= 0) grid_blocks = 256;
    }
    if (grid_blocks < 0) return;
    Params p{};
    for (int i = 0; i < 25; ++i) p.in[i] = (const float*)d_in[i];
    p.out = (float*)d_out; p.ws = (unsigned char*)d_ws;
#if ONE_LAUNCH
#ifdef PROBE_X
    { const int seq[3][2] = {{0, PROBE_Y + 1}, {PROBE_X, PROBE_Y + 1}, {PROBE_Y + 1, 9}};
      for (int li = 0; li < 3; ++li) { if (seq[li][0] >= seq[li][1]) continue; p.ph_lo = seq[li][0]; p.ph_hi = seq[li][1]; void* args[] = {&p};
        hipError_t e = hipLaunchCooperativeKernel((const void*)mega, dim3(grid_blocks), dim3(NTHR), args, LDS_BYTES, stream);
        if (e != hipSuccess) fprintf(stderr, "cooperative launch failed: %s (grid %d)\n", hipGetErrorString(e), grid_blocks); } }
#else
    p.ph_lo = 0; p.ph_hi = 9;
    { void* args[] = {&p}; hipError_t e = hipLaunchCooperativeKernel((const void*)mega, dim3(grid_blocks), dim3(NTHR), args, LDS_BYTES, stream);
      if (e != hipSuccess) fprintf(stderr, "cooperative launch failed: %s (grid %d)\n", hipGetErrorString(e), grid_blocks); }
#endif
#else
    for (int ph = 0; ph < 9; ++ph) {
        p.ph_lo = ph; p.ph_hi = ph + 1;
        void* args[] = {&p}; hipError_t e = hipLaunchCooperativeKernel((const void*)mega, dim3(grid_blocks), dim3(NTHR), args, LDS_BYTES, stream);
        if (e != hipSuccess) fprintf(stderr, "cooperative launch %d failed: %s (grid %d)\n", ph, hipGetErrorString(e), grid_blocks);
    }
#endif
}
```

```cpp
#include <hip/hip_runtime.h>
#include <hip/hip_cooperative_groups.h>
#include <cstdio>
namespace cg = cooperative_groups;

#ifndef ONE_LAUNCH
#define ONE_LAUNCH 1
#endif

#define LAS __attribute__((address_space(3)))
typedef unsigned short bf16_t;
typedef short bf16x8 __attribute__((ext_vector_type(8)));
typedef short bf16x4 __attribute__((ext_vector_type(4)));
typedef float f32x4 __attribute__((ext_vector_type(4)));
typedef unsigned u32x4 __attribute__((ext_vector_type(4)));
typedef unsigned u32x2 __attribute__((ext_vector_type(2)));

constexpr int T_P = 32768, T_S = 2048, T = T_P + T_S, DM = 1024;
constexpr int NE_PAD = 6144;
constexpr int LDS_BYTES = 159744;
constexpr int NTHR = 512;
constexpr float EPS = 1e-6f;

constexpr size_t WS_WINE = 0;
constexpr size_t WS_WOUTE = WS_WINE + (size_t)NE_PAD * 1024 * 2;
constexpr size_t WS_WINO = WS_WOUTE + (size_t)1024 * 2048 * 2;
constexpr size_t WS_WOUTO = WS_WINO + (size_t)3072 * 1024 * 2;
constexpr size_t WS_WA = WS_WOUTO + (size_t)1024 * 1536 * 2;
constexpr size_t WS_WI = WS_WA + (size_t)8 * 192 * 192 * 2;
constexpr size_t WS_XB = WS_WI + (size_t)8 * 192 * 192 * 2;
constexpr size_t WS_RSTD0 = WS_XB + (size_t)T * 1024 * 2;
constexpr size_t WS_RSQ1 = WS_RSTD0 + (size_t)T * 4;
constexpr size_t WS_RSQ2 = WS_RSQ1 + (size_t)T * 4;
constexpr size_t WS_BOSQ = WS_RSQ2 + (size_t)T * 4;
constexpr size_t WS_Q = WS_BOSQ + (size_t)T * 16;
constexpr size_t WS_K = WS_Q + (size_t)T * 1024 * 2;
constexpr size_t WS_V = WS_K + (size_t)T * 256 * 2;
constexpr size_t WS_BQ = WS_V + (size_t)T * 256 * 2;
constexpr size_t WS_BK = WS_BQ + (size_t)T * 512 * 2;
constexpr size_t WS_BV = WS_BK + (size_t)T * 512 * 2;
constexpr size_t WS_GATE = WS_BV + (size_t)T * 1024 * 2;
constexpr size_t WS_BLR = WS_GATE + (size_t)T * 2048 * 2;
constexpr size_t WS_END = WS_BLR + (size_t)T * 512 * 2;
constexpr size_t WS_BAR = WS_END;
constexpr size_t WS_TOTAL = WS_BAR + 16384;
constexpr size_t WS_Z2 = WS_Q;
constexpr size_t WS_Y2 = WS_GATE;
static_assert(WS_Z2 + (size_t)T * 3072 * 2 <= WS_GATE, "Z2 alias");

constexpr size_t O_Y = 0;
constexpr size_t O_KP = (size_t)T * 1024;
constexpr size_t O_VP = O_KP + 524288;
constexpr size_t O_GP = O_VP + 524288;
constexpr size_t O_CP = O_GP + 2097152;
constexpr size_t O_LP = O_CP + 73728;
constexpr size_t O_KS = O_LP + 24576;
constexpr size_t O_VS = O_KS + 524288;
constexpr size_t O_GS = O_VS + 524288;
constexpr size_t O_CS = O_GS + 4194304;
constexpr size_t O_LS = O_CS + 147456;
constexpr size_t O_END = O_LS + 49152;

struct Params {
    const float* in[25];
    float* out;
    unsigned char* ws;
    int ph_lo, ph_hi;
};

__device__ __forceinline__ unsigned cvt_pk_bf16(float lo, float hi) { unsigned r; asm volatile("v_cvt_pk_bf16_f32 %0, %1, %2" : "=v"(r) : "v"(lo), "v"(hi)); return r; }
__device__ __forceinline__ bf16_t f2bf(float f) { return (bf16_t)(cvt_pk_bf16(f, 0.f) & 0xffffu); }
__device__ __forceinline__ float bf2f(bf16_t b) { return __uint_as_float(((unsigned)b) << 16); }
__device__ __forceinline__ float bflo(unsigned w) { return __uint_as_float(w << 16); }
__device__ __forceinline__ float bfhi(unsigned w) { return __uint_as_float(w & 0xffff0000u); }
__device__ __forceinline__ float rcpf_(float x) { return __builtin_amdgcn_rcpf(x); }
__device__ __forceinline__ float siluf(float x) { return x * rcpf_(1.f + __expf(-x)); }
__device__ __forceinline__ float sigmf(float x) { return rcpf_(1.f + __expf(-x)); }
__device__ __forceinline__ void lds_barrier() { asm volatile("s_waitcnt lgkmcnt(0)" ::: "memory"); __builtin_amdgcn_s_barrier(); asm volatile("" ::: "memory"); }
__device__ __forceinline__ bf16x8 pack8(const f32x4& a, const f32x4& b) {
    u32x4 p; p.x = cvt_pk_bf16(a[0], a[1]); p.y = cvt_pk_bf16(a[2], a[3]); p.z = cvt_pk_bf16(b[0], b[1]); p.w = cvt_pk_bf16(b[2], b[3]);
    return __builtin_bit_cast(bf16x8, p);
}
__device__ __forceinline__ bf16x8 cat4(const bf16x4 a, const bf16x4 b) { bf16x8 r; r[0] = a[0]; r[1] = a[1]; r[2] = a[2]; r[3] = a[3]; r[4] = b[0]; r[5] = b[1]; r[6] = b[2]; r[7] = b[3]; return r; }
__device__ __forceinline__ void unpack8(const u32x4 w, float (&v)[8]) { v[0] = bflo(w.x); v[1] = bfhi(w.x); v[2] = bflo(w.y); v[3] = bfhi(w.y); v[4] = bflo(w.z); v[5] = bfhi(w.z); v[6] = bflo(w.w); v[7] = bfhi(w.w); }
#define MFMA16(a, b, c) __builtin_amdgcn_mfma_f32_16x16x32_bf16((a), (b), (c), 0, 0, 0)

namespace pg8 {
constexpr int BM = 256, BK = 64, HALF = 128, HTB = HALF * BK * 2, STAGE_BYTES = 8 * HTB, NXCD = 8, WGM = 8;
__device__ __forceinline__ int lds_byte(int r, int c) { const int st = (r >> 4) * 2 + (c >> 5), rr = r & 15, cc = c & 31, ob = rr * 64 + cc * 2; return st * 1024 + (ob ^ (((ob >> 9) & 1) << 5)); }
__device__ __forceinline__ int perm32(int rho) { const int n = rho >> 4, i = rho & 15; return 8 * (i >> 2) + 4 * n + (i & 3); }
__device__ __forceinline__ void stage_rc(int b, int& R, int& C) { const int st = b / 1024, sb = b % 1024, swz = sb ^ (((sb >> 9) & 1) << 5); R = (st >> 1) * 16 + swz / 64; C = (st & 1) * 32 + (swz % 64) / 2; }
struct Unit { int pm, pn; };
struct Gemm { const bf16_t* A; const bf16_t* Bt; int M, N, K; };
struct StaticOrder {
    int nM, nN, nwg, G, c;
    __device__ void init(int M, int N, int G_, int c_) { nM = M / BM; nN = N / BM; nwg = nM * nN; G = G_; c = c_; }
    __device__ __forceinline__ bool next(int i, Unit& u) const {
        const long Lx = (long)i * G + c; if (Lx >= nwg) return false;
        int wgid = (int)Lx; { const int q = nwg / NXCD, r = nwg % NXCD, xcd = wgid % NXCD, off = wgid / NXCD; wgid = (xcd < r ? xcd * (q + 1) : r * (q + 1) + (xcd - r) * q) + off; }
        const int nig = WGM * nN, gid = wgid / nig, fm = gid * WGM, gsz = (nM - fm) < WGM ? (nM - fm) : WGM;
        u.pm = fm + ((wgid % nig) % gsz); u.pn = (wgid % nig) / gsz; return true;
    }
};

template <class Epi>
__device__ __forceinline__ void gemm_phase(LAS unsigned char* lds, const Gemm g, const StaticOrder& S, const Epi& E) {
    const int tid = threadIdx.x, wid = __builtin_amdgcn_readfirstlane(tid >> 6), lane = tid & 63, wr = wid >> 2, wc = wid & 3, fr = lane & 15, fq = lane >> 4;
    const int K = g.K, nt = K / BK;
    unsigned voffA[2], voffB[2];
#pragma unroll
    for (int i = 0; i < 2; ++i) { int R, C; stage_rc(tid * 16 + i * 8192, R, C); const int Rb = Epi::PERM ? ((R & ~31) + perm32(R & 31)) : R;
        voffA[i] = (unsigned)(R * K + C) * 2u; voffB[i] = (unsigned)(Rb * K + C) * 2u; }
    const size_t kstep = (size_t)(BK * 2);
    const size_t hstep = (size_t)HALF * K * 2;
    const size_t tstep = 2 * hstep;
    const unsigned ldsw = (unsigned)wid * 1024u;
    const int aoff = lds_byte(wr * 64 + fr, fq * 8), boff = lds_byte(wc * 32 + fr, fq * 8);
#define PG8_SA(b, h) (((b) * 2 + (h)) * HTB)
#define PG8_SB(b, h) ((4 + (b) * 2 + (h)) * HTB)
#define PG8_STAGE(bufoff, gbase, voff) do { _Pragma("unroll") for (int _i = 0; _i < 2; ++_i) \
        __builtin_amdgcn_global_load_lds((const unsigned*)((const char*)(gbase) + (voff)[_i]), (LAS unsigned*)(lds + (bufoff) + ldsw + _i * 8192), 16, 0, 0); } while (0)
#define PG8_LDA(dst, b, h) do { _Pragma("unroll") for (int m = 0; m < 4; ++m) _Pragma("unroll") for (int k = 0; k < 2; ++k) dst[m][k] = *(const LAS bf16x8*)(lds + PG8_SA(b, h) + aoff + m * 2048 + k * 1024); } while (0)
#define PG8_LDB(dst, b, h) do { _Pragma("unroll") for (int n = 0; n < 2; ++n) _Pragma("unroll") for (int k = 0; k < 2; ++k) dst[n][k] = *(const LAS bf16x8*)(lds + PG8_SB(b, h) + boff + n * 2048 + k * 1024); } while (0)
#define PG8_MMA(ai, bj, At, Bt) do { __builtin_amdgcn_s_setprio(1); _Pragma("unroll") for (int m = 0; m < 4; ++m) _Pragma("unroll") for (int n = 0; n < 2; ++n) _Pragma("unroll") for (int k = 0; k < 2; ++k) \
        acc[ai][bj][m][n] = __builtin_amdgcn_mfma_f32_16x16x32_bf16(Bt[n][k], At[m][k], acc[ai][bj][m][n], 0, 0, 0); __builtin_amdgcn_s_setprio(0); } while (0)
#define PG8_WAIT_V(n) asm volatile("s_waitcnt vmcnt(" #n ")" ::: "memory")
#define PG8_WAIT_L(n) asm volatile("s_waitcnt lgkmcnt(" #n ")" ::: "memory")
#define PG8_BAR __builtin_amdgcn_s_barrier()
#define PG8_SCHED __builtin_amdgcn_sched_barrier(0)
    Unit cur, nxt; int ui = 0;
    if (!S.next(0, cur)) return;
    f32x4 acc[2][2][4][2];
#pragma unroll
    for (int a = 0; a < 2; ++a)
#pragma unroll
        for (int b = 0; b < 2; ++b)
#pragma unroll
            for (int m = 0; m < 4; ++m)
#pragma unroll
                for (int n = 0; n < 2; ++n) acc[a][b][m][n] = (f32x4){0.f, 0.f, 0.f, 0.f};
    bf16x8 At[4][2], B0[2][2], B1[2][2];
    const char* cA = (const char*)g.A + (size_t)cur.pm * tstep; const char* cB = (const char*)g.Bt + (size_t)cur.pn * tstep;
    PG8_STAGE(PG8_SB(0, 0), cB, voffB); PG8_STAGE(PG8_SA(0, 0), cA, voffA); PG8_STAGE(PG8_SB(0, 1), cB + hstep, voffB); PG8_STAGE(PG8_SA(0, 1), cA + hstep, voffA);
    if (wr == 1) PG8_BAR;
    PG8_WAIT_V(4); PG8_BAR;
    PG8_STAGE(PG8_SB(1, 0), cB + kstep, voffB); PG8_STAGE(PG8_SA(1, 0), cA + kstep, voffA); PG8_STAGE(PG8_SB(1, 1), cB + hstep + kstep, voffB);
    PG8_WAIT_V(6); PG8_BAR;
    for (;;) {
        const bool has_next = S.next(ui + 1, nxt);
        const char* nA = has_next ? (const char*)g.A + (size_t)nxt.pm * tstep : cA; const char* nB = has_next ? (const char*)g.Bt + (size_t)nxt.pn * tstep : cB;
        for (int t = 0; t < nt; t += 2) {
            const bool last = (t == nt - 2);
            const char* a1 = cA + (size_t)(t + 1) * kstep;
            const char* a2 = last ? nA : cA + (size_t)(t + 2) * kstep; const char* b2 = last ? nB : cB + (size_t)(t + 2) * kstep;
            const char* a3 = a2 + kstep; const char* b3 = b2 + kstep;
            PG8_LDB(B0, 0, 0); PG8_SCHED; PG8_LDA(At, 0, 0); PG8_STAGE(PG8_SA(1, 1), a1 + hstep, voffA);
            PG8_WAIT_L(8); PG8_BAR; PG8_WAIT_L(0); PG8_MMA(0, 0, At, B0); PG8_BAR; PG8_SCHED;
            PG8_LDB(B1, 0, 1); PG8_STAGE(PG8_SB(0, 0), b2, voffB);
            PG8_BAR; PG8_WAIT_L(0); PG8_MMA(0, 1, At, B1); PG8_BAR;
            PG8_LDA(At, 0, 1); PG8_STAGE(PG8_SA(0, 0), a2, voffA);
            PG8_BAR; PG8_WAIT_L(0); PG8_MMA(1, 0, At, B0); PG8_BAR; PG8_SCHED;
            PG8_STAGE(PG8_SB(0, 1), b2 + hstep, voffB);
            PG8_WAIT_V(6); PG8_BAR; PG8_MMA(1, 1, At, B1); PG8_BAR;
            PG8_LDB(B0, 1, 0); PG8_SCHED; PG8_LDA(At, 1, 0); PG8_STAGE(PG8_SA(0, 1), a2 + hstep, voffA);
            PG8_WAIT_L(8); PG8_BAR; PG8_WAIT_L(0); PG8_MMA(0, 0, At, B0); PG8_BAR; PG8_SCHED;
            PG8_LDB(B1, 1, 1); PG8_STAGE(PG8_SB(1, 0), b3, voffB);
            PG8_BAR; PG8_WAIT_L(0); PG8_MMA(0, 1, At, B1); PG8_BAR;
            PG8_LDA(At, 1, 1); PG8_STAGE(PG8_SA(1, 0), a3, voffA);
            PG8_BAR; PG8_WAIT_L(0); PG8_MMA(1, 0, At, B0); PG8_BAR; PG8_SCHED;
            PG8_STAGE(PG8_SB(1, 1), b3 + hstep, voffB);
            PG8_WAIT_V(6); PG8_BAR; PG8_MMA(1, 1, At, B1); PG8_BAR;
        }
        E(acc, cur, wr, wc, fr, fq);
        if (!has_next) break;
#pragma unroll
        for (int a = 0; a < 2; ++a)
#pragma unroll
            for (int b = 0; b < 2; ++b)
#pragma unroll
                for (int m = 0; m < 4; ++m)
#pragma unroll
                    for (int n = 0; n < 2; ++n) acc[a][b][m][n] = (f32x4){0.f, 0.f, 0.f, 0.f};
        cur = nxt; cA = nA; cB = nB; ++ui;
    }
    PG8_WAIT_V(0);
    if (wr == 0) PG8_BAR;
    PG8_BAR;
#undef PG8_SA
#undef PG8_SB
#undef PG8_STAGE
#undef PG8_LDA
#undef PG8_LDB
#undef PG8_MMA
#undef PG8_WAIT_V
#undef PG8_WAIT_L
#undef PG8_BAR
#undef PG8_SCHED
}
}

typedef f32x4 AccT[2][2][4][2];

struct EpiInEven {
    static constexpr bool PERM = true;
    unsigned char* ws; float* out; const float* rstd; const float* blr_b;
    __device__ __forceinline__ void operator()(const AccT& acc, const pg8::Unit& u, int wr, int wc, int fr, int fq) const {
        const int pn = u.pn;
        bf16_t* base; int ld, coff; float sc = 1.f;
        if (pn < 4) { base = (bf16_t*)(ws + WS_Q); ld = 1024; coff = pn * 256; sc = 0.125f; }
        else if (pn == 4) { base = (bf16_t*)(ws + WS_K); ld = 256; coff = 0; }
        else if (pn == 5) { base = (bf16_t*)(ws + WS_V); ld = 256; coff = 0; }
        else if (pn < 8) { base = (bf16_t*)(ws + WS_BQ); ld = 512; coff = (pn - 6) * 256; sc = 0.08838834764831845f; }
        else if (pn < 10) { base = (bf16_t*)(ws + WS_BK); ld = 512; coff = (pn - 8) * 256; }
        else if (pn < 14) { base = (bf16_t*)(ws + WS_BV); ld = 1024; coff = (pn - 10) * 256; }
        else if (pn < 22) { base = (bf16_t*)(ws + WS_GATE); ld = 2048; coff = (pn - 14) * 256; }
        else { base = (bf16_t*)(ws + WS_BLR); ld = 512; coff = (pn - 22) * 256; }
        const int row0 = u.pm * 256 + wr * 64 + fr;
        const int ct = wc * 32 + 8 * fq;
        if (pn >= 22) {
#pragma unroll
            for (int ai = 0; ai < 2; ++ai)
#pragma unroll
                for (int m = 0; m < 4; ++m) {
                    const int row = row0 + ai * 128 + m * 16; const float rs = rstd[row];
#pragma unroll
                    for (int bj = 0; bj < 2; ++bj) {
                        const int cg = coff + ct + bj * 128;
                        const f32x4 b0 = *(const f32x4*)(blr_b + cg), b1 = *(const f32x4*)(blr_b + cg + 4);
                        f32x4 x0 = acc[ai][bj][m][0] * rs + b0, x1 = acc[ai][bj][m][1] * rs + b1;
#pragma unroll
                        for (int j = 0; j < 4; ++j) { x0[j] = (fminf(x0[j], 0.f) - __logf(1.f + __expf(-fabsf(x0[j])))) * (1.f / 16.f); x1[j] = (fminf(x1[j], 0.f) - __logf(1.f + __expf(-fabsf(x1[j])))) * (1.f / 16.f); }
                        u32x4 w; w.x = cvt_pk_bf16(x0[0], x0[1]); w.y = cvt_pk_bf16(x0[2], x0[3]); w.z = cvt_pk_bf16(x1[0], x1[1]); w.w = cvt_pk_bf16(x1[2], x1[3]);
                        *(u32x4*)(base + (size_t)row * 512 + cg) = w;
                    }
                }
            return;
        }
        const bool kv = (pn == 4 || pn == 5);
        float* okv_p = out + (pn == 4 ? O_KP : O_VP); float* okv_s = out + (pn == 4 ? O_KS : O_VS);
#pragma unroll
        for (int ai = 0; ai < 2; ++ai)
#pragma unroll
            for (int m = 0; m < 4; ++m) {
                const int row = row0 + ai * 128 + m * 16; const float rs = rstd[row] * sc;
                bf16_t* rowp = base + (size_t)row * ld + coff + ct;
                float* orow = nullptr;
                if (kv) {
                    if (row >= T_P) orow = okv_s + (size_t)(row - T_P) * 256;
                    else { const int b = row >> 11, t = row & 2047; if (t >= 1920) orow = okv_p + (size_t)(b * 128 + t - 1920) * 256; }
                }
#pragma unroll
                for (int bj = 0; bj < 2; ++bj) {
                    const f32x4 v0 = acc[ai][bj][m][0] * rs, v1 = acc[ai][bj][m][1] * rs;
                    u32x4 w; w.x = cvt_pk_bf16(v0[0], v0[1]); w.y = cvt_pk_bf16(v0[2], v0[3]); w.z = cvt_pk_bf16(v1[0], v1[1]); w.w = cvt_pk_bf16(v1[2], v1[3]);
                    *(u32x4*)(rowp + bj * 128) = w;
                    if (kv && orow) { *(f32x4*)(orow + bj * 128 + ct) = v0; *(f32x4*)(orow + bj * 128 + ct + 4) = v1; }
                }
            }
    }
};

template <bool WRITE_BF>
struct EpiOutRes {
    static constexpr bool PERM = false;
    const float* xin_p; const float* xin_s; float* xo; bf16_t* xb; float* rowsq;
    __device__ __forceinline__ void operator()(const AccT& acc, const pg8::Unit& u, int wr, int wc, int fr, int fq) const {
        const int row0 = u.pm * 256 + wr * 64 + fr, col0 = u.pn * 256 + wc * 32 + 4 * fq;
#pragma unroll
        for (int ai = 0; ai < 2; ++ai)
#pragma unroll
            for (int m = 0; m < 4; ++m) {
                const int row = row0 + ai * 128 + m * 16;
                const float* xr = (row < T_P) ? xin_p + (size_t)row * 1024 : xin_s + (size_t)(row - T_P) * 1024;
                float ss = 0.f;
#pragma unroll
                for (int bj = 0; bj < 2; ++bj)
#pragma unroll
                    for (int n = 0; n < 2; ++n) {
                        const int col = col0 + bj * 128 + n * 16;
                        const f32x4 v = acc[ai][bj][m][n] + *(const f32x4*)(xr + col);
                        *(f32x4*)(xo + (size_t)row * 1024 + col) = v;
                        if (WRITE_BF) { u32x2 w; w.x = cvt_pk_bf16(v[0], v[1]); w.y = cvt_pk_bf16(v[2], v[3]); *(u32x2*)(xb + (size_t)row * 1024 + col) = w; }
                        ss += v[0] * v[0] + v[1] * v[1] + v[2] * v[2] + v[3] * v[3];
                    }
                ss += __shfl_xor(ss, 16); ss += __shfl_xor(ss, 32);
                if (fq == 0) atomicAdd(rowsq + row, ss);
            }
    }
};

struct EpiInOdd {
    static constexpr bool PERM = true;
    bf16_t* z2; const float* rowsq;
    __device__ __forceinline__ void operator()(const AccT& acc, const pg8::Unit& u, int wr, int wc, int fr, int fq) const {
        const int row0 = u.pm * 256 + wr * 64 + fr, col0 = u.pn * 256 + wc * 32 + 8 * fq;
#pragma unroll
        for (int ai = 0; ai < 2; ++ai)
#pragma unroll
            for (int m = 0; m < 4; ++m) {
                const int row = row0 + ai * 128 + m * 16; const float rs = rsqrtf(rowsq[row] * (1.f / 1024.f) + EPS);
#pragma unroll
                for (int bj = 0; bj < 2; ++bj) {
                    const f32x4 v0 = acc[ai][bj][m][0] * rs, v1 = acc[ai][bj][m][1] * rs;
                    u32x4 w; w.x = cvt_pk_bf16(v0[0], v0[1]); w.y = cvt_pk_bf16(v0[2], v0[3]); w.z = cvt_pk_bf16(v1[0], v1[1]); w.w = cvt_pk_bf16(v1[2], v1[3]);
                    *(u32x4*)(z2 + (size_t)row * 3072 + col0 + bj * 128) = w;
                }
            }
    }
};

template <int MODE>
__device__ __forceinline__ void transpose_w(const float* __restrict__ src, int K, int Nsrc, bf16_t* __restrict__ dst, int Ndst, const float* __restrict__ gain, long gtid, long gsz) {
    const long total = (long)(K / 8) * Ndst;
#pragma unroll 4
    for (long it = gtid; it < total; it += gsz) {
        const int n = (int)(it % Ndst), k8 = (int)(it / Ndst);
        int sc = n;
        if (MODE == 1) { if (n < 3584) sc = n; else sc = n + 16; }
        u32x4 w = {0u, 0u, 0u, 0u};
        if (sc >= 0) {
            const float* s = src + (size_t)(k8 * 8) * Nsrc + sc;
            float v0 = s[0], v1 = s[(size_t)Nsrc], v2 = s[(size_t)2 * Nsrc], v3 = s[(size_t)3 * Nsrc], v4 = s[(size_t)4 * Nsrc], v5 = s[(size_t)5 * Nsrc], v6 = s[(size_t)6 * Nsrc], v7 = s[(size_t)7 * Nsrc];
            if (gain) { const f32x4 g0 = *(const f32x4*)(gain + k8 * 8), g1 = *(const f32x4*)(gain + k8 * 8 + 4); v0 *= g0[0]; v1 *= g0[1]; v2 *= g0[2]; v3 *= g0[3]; v4 *= g1[0]; v5 *= g1[1]; v6 *= g1[2]; v7 *= g1[3]; }
            w.x = cvt_pk_bf16(v0, v1); w.y = cvt_pk_bf16(v2, v3); w.z = cvt_pk_bf16(v4, v5); w.w = cvt_pk_bf16(v6, v7);
        }
        *(u32x4*)(dst + (size_t)n * K + k8 * 8) = w;
    }
}

__device__ __forceinline__ void phase0(const Params& p) {
    unsigned char* ws = p.ws;
    const long gtid = (long)blockIdx.x * NTHR + threadIdx.x, gsz = (long)gridDim.x * NTHR;
    transpose_w<1>(p.in[8], 1024, 5648, (bf16_t*)(ws + WS_WINE), 5632, p.in[7], gtid, gsz);
    for (long it = gtid; it < 128L * 512; it += gsz) {
        const int n = (int)(it & 511), k8 = (int)(it >> 9);
        float wl[16];
#pragma unroll
        for (int r = 0; r < 16; ++r) wl[r] = p.in[9][r * 512 + n];
        float v[8];
#pragma unroll
        for (int i = 0; i < 8; ++i) {
            const float* wr_ = p.in[8] + (size_t)(k8 * 8 + i) * 5648 + 3584;
            float a = 0.f;
#pragma unroll
            for (int r4 = 0; r4 < 4; ++r4) { const f32x4 x = *(const f32x4*)(wr_ + r4 * 4); a += x[0] * wl[r4 * 4] + x[1] * wl[r4 * 4 + 1] + x[2] * wl[r4 * 4 + 2] + x[3] * wl[r4 * 4 + 3]; }
            v[i] = a * p.in[7][k8 * 8 + i];
        }
        u32x4 w; w.x = cvt_pk_bf16(v[0], v[1]); w.y = cvt_pk_bf16(v[2], v[3]); w.z = cvt_pk_bf16(v[4], v[5]); w.w = cvt_pk_bf16(v[6], v[7]);
        *(u32x4*)((bf16_t*)(ws + WS_WINE) + (size_t)(5632 + n) * 1024 + k8 * 8) = w;
    }
    transpose_w<0>(p.in[13], 2048, 1024, (bf16_t*)(ws + WS_WOUTE), 1024, nullptr, gtid, gsz);
    transpose_w<0>(p.in[15], 1024, 3072, (bf16_t*)(ws + WS_WINO), 3072, p.in[14], gtid, gsz);
    transpose_w<0>(p.in[23], 1536, 1024, (bf16_t*)(ws + WS_WOUTO), 1024, nullptr, gtid, gsz);
    for (int nb = 0; nb < 8; ++nb) {
        transpose_w<0>(p.in[18] + nb * 192 * 192, 192, 192, (bf16_t*)(ws + WS_WA) + nb * 192 * 192, 192, nullptr, gtid, gsz);
        transpose_w<0>(p.in[20] + nb * 192 * 192, 192, 192, (bf16_t*)(ws + WS_WI) + nb * 192 * 192, 192, nullptr, gtid, gsz);
    }
    { float* z = (float*)(ws + WS_RSQ1); const long nz = (long)T * 2; for (long i = gtid; i < nz; i += gsz) z[i] = 0.f; }
    const int lane = threadIdx.x & 63; const int gw = (int)(gtid >> 6), nw = (int)(gsz >> 6);
    bf16_t* xb = (bf16_t*)(ws + WS_XB); float* rstd = (float*)(ws + WS_RSTD0);
#pragma unroll 4
    for (int row = gw; row < T; row += nw) {
        const float* xr = (row < T_P) ? p.in[0] + (size_t)row * 1024 : p.in[1] + (size_t)(row - T_P) * 1024;
        float ss = 0.f;
#pragma unroll
        for (int i = 0; i < 4; ++i) {
            const f32x4 v = *(const f32x4*)(xr + i * 256 + lane * 4);
            ss += v[0] * v[0] + v[1] * v[1] + v[2] * v[2] + v[3] * v[3];
            u32x2 w; w.x = cvt_pk_bf16(v[0], v[1]); w.y = cvt_pk_bf16(v[2], v[3]);
            *(u32x2*)(xb + (size_t)row * 1024 + i * 256 + lane * 4) = w;
        }
#pragma unroll
        for (int o = 32; o >= 1; o >>= 1) ss += __shfl_xor(ss, o);
        if (lane == 0) rstd[row] = rsqrtf(ss * (1.f / 1024.f) + EPS);
    }
}

__device__ __forceinline__ void attn_item(const Params& p, LAS unsigned char* L, int item, bf16_t* Yd, int ldd) {
    unsigned char* ws = p.ws;
    const int tid = threadIdx.x, lane = tid & 63, w = tid >> 6, r16 = lane & 15, q4 = lane >> 4;
    LAS bf16_t* Ks = (LAS bf16_t*)L;
    LAS bf16_t* Vs = (LAS bf16_t*)(L + 192 * 72 * 2);
    const unsigned vbase = (unsigned)(size_t)L + 192u * 72u * 2u;
    const bf16_t* Qb = (const bf16_t*)(ws + WS_Q); const bf16_t* Kb = (const bf16_t*)(ws + WS_K); const bf16_t* Vb = (const bf16_t*)(ws + WS_V);
    const bf16_t* Yb = (const bf16_t*)(ws + WS_GATE);
    const bool smp = item >= 2048;
    int b, c, kh; size_t row0;
    if (!smp) { kh = item & 3; c = (item >> 2) & 31; b = item >> 7; row0 = (size_t)b * 2048 + c * 64; }
    else { const int i2 = item - 2048; kh = i2 & 3; b = i2 >> 2; c = 0; row0 = (size_t)T_P + b * 64; }
    const int g = w >> 1, i0 = (w & 1) * 32, h = kh * 4 + g;
    bf16x8 qf[2][2];
#pragma unroll
    for (int qt = 0; qt < 2; ++qt) {
#pragma unroll
        for (int ks = 0; ks < 2; ++ks) qf[qt][ks] = *(const bf16x8*)(Qb + (row0 + i0 + qt * 16 + r16) * 1024 + h * 64 + ks * 32 + q4 * 8);
    }
#pragma unroll
    for (int i = 0; i < 3; ++i) {
        const int idx = tid + i * 512, key = idx >> 3, dg = idx & 7;
        u32x4 kv = {0u, 0u, 0u, 0u}, vv = {0u, 0u, 0u, 0u};
        if (!smp) {
            const int pos = c * 64 - 128 + key;
            if (pos >= 0) { const size_t r = (size_t)b * 2048 + pos; kv = *(const u32x4*)(Kb + r * 256 + kh * 64 + dg * 8); vv = *(const u32x4*)(Vb + r * 256 + kh * 64 + dg * 8); }
        } else {
            if (key < 128) {
                const size_t o = ((size_t)(b * 128 + key) * 4 + kh) * 64 + dg * 8;
                const f32x4 k0 = *(const f32x4*)(p.in[2] + o), k1 = *(const f32x4*)(p.in[2] + o + 4), v0 = *(const f32x4*)(p.in[3] + o), v1 = *(const f32x4*)(p.in[3] + o + 4);
                kv.x = cvt_pk_bf16(k0[0], k0[1]); kv.y = cvt_pk_bf16(k0[2], k0[3]); kv.z = cvt_pk_bf16(k1[0], k1[1]); kv.w = cvt_pk_bf16(k1[2], k1[3]);
                vv.x = cvt_pk_bf16(v0[0], v0[1]); vv.y = cvt_pk_bf16(v0[2], v0[3]); vv.z = cvt_pk_bf16(v1[0], v1[1]); vv.w = cvt_pk_bf16(v1[2], v1[3]);
            } else { const size_t r = (size_t)T_P + b * 64 + key - 128; kv = *(const u32x4*)(Kb + r * 256 + kh * 64 + dg * 8); vv = *(const u32x4*)(Vb + r * 256 + kh * 64 + dg * 8); }
        }
        *(LAS u32x4*)(Ks + key * 72 + dg * 8) = kv;
        *(LAS u32x4*)(Vs + key * 72 + dg * 8) = vv;
    }
    __syncthreads();
    const float slope = exp2f(-0.5f * (float)(h + 1));
    const float sink = p.in[11][h];
    const unsigned va = vbase + (unsigned)(((q4 * 4 + (r16 >> 2)) * 72 + 4 * (r16 & 3)) * 2);
#pragma unroll 1
    for (int qt = 0; qt < 2; ++qt) {
        const int i = i0 + qt * 16 + r16;
        const bf16x8 qa = qt ? qf[1][0] : qf[0][0], qb = qt ? qf[1][1] : qf[0][1];
        u32x2 gv[4];
#pragma unroll
        for (int dt = 0; dt < 4; ++dt) gv[dt] = *(const u32x2*)(Yb + (row0 + i) * 2048 + h * 64 + dt * 16 + q4 * 4);
        f32x4 sacc[12];
#pragma unroll
        for (int kt = 0; kt < 12; ++kt) {
            const bf16x8 kf0 = *(const LAS bf16x8*)(Ks + (kt * 16 + r16) * 72 + q4 * 8), kf1 = *(const LAS bf16x8*)(Ks + (kt * 16 + r16) * 72 + 32 + q4 * 8);
            f32x4 a = {0.f, 0.f, 0.f, 0.f}; a = MFMA16(kf0, qa, a); a = MFMA16(kf1, qb, a); sacc[kt] = a;
        }
        float m = -3e38f;
#pragma unroll
        for (int kt = 0; kt < 12; ++kt)
#pragma unroll
            for (int jj = 0; jj < 4; ++jj) {
                const int j = kt * 16 + q4 * 4 + jj;
                float sv = sacc[kt][jj] - slope * fabsf((float)(128 + i - j));
                if (!smp && (c * 64 - 128 + j) < 0) sv = -1e30f;
                sacc[kt][jj] = sv; m = fmaxf(m, sv);
            }
        m = fmaxf(m, __shfl_xor(m, 16)); m = fmaxf(m, __shfl_xor(m, 32)); m = fmaxf(m, sink);
        float l = 0.f;
#pragma unroll
        for (int kt = 0; kt < 12; ++kt)
#pragma unroll
            for (int jj = 0; jj < 4; ++jj) { const float pr = __expf(sacc[kt][jj] - m); sacc[kt][jj] = pr; l += pr; }
        l += __shfl_xor(l, 16); l += __shfl_xor(l, 32); l += __expf(sink - m);
        const float inv = 1.f / l;
        f32x4 oacc[4];
#pragma unroll
        for (int dt = 0; dt < 4; ++dt) oacc[dt] = (f32x4){0.f, 0.f, 0.f, 0.f};
#pragma unroll
        for (int kb = 0; kb < 6; ++kb) {
            const bf16x8 pf = pack8(sacc[2 * kb], sacc[2 * kb + 1]);
            bf16x4 l0, h0, l1, h1, l2, h2, l3, h3;
            const unsigned vk = va + (unsigned)(kb * 32 * 144);
            asm volatile("ds_read_b64_tr_b16 %0, %8\n\tds_read_b64_tr_b16 %1, %8 offset:2304\n\t"
                         "ds_read_b64_tr_b16 %2, %8 offset:32\n\tds_read_b64_tr_b16 %3, %8 offset:2336\n\t"
                         "ds_read_b64_tr_b16 %4, %8 offset:64\n\tds_read_b64_tr_b16 %5, %8 offset:2368\n\t"
                         "ds_read_b64_tr_b16 %6, %8 offset:96\n\tds_read_b64_tr_b16 %7, %8 offset:2400\n\t"
                         "s_waitcnt lgkmcnt(0)"
                         : "=&v"(l0), "=&v"(h0), "=&v"(l1), "=&v"(h1), "=&v"(l2), "=&v"(h2), "=&v"(l3), "=&v"(h3) : "v"(vk) : "memory");
            oacc[0] = MFMA16(cat4(l0, h0), pf, oacc[0]); oacc[1] = MFMA16(cat4(l1, h1), pf, oacc[1]);
            oacc[2] = MFMA16(cat4(l2, h2), pf, oacc[2]); oacc[3] = MFMA16(cat4(l3, h3), pf, oacc[3]);
        }
#pragma unroll
        for (int dt = 0; dt < 4; ++dt) {
            const u32x2 gq = gv[dt];
            const f32x4 o = oacc[dt] * inv;
            u32x2 wv; wv.x = cvt_pk_bf16(o[0] * siluf(bflo(gq.x)), o[1] * siluf(bfhi(gq.x))); wv.y = cvt_pk_bf16(o[2] * siluf(bflo(gq.y)), o[3] * siluf(bfhi(gq.y)));
            *(u32x2*)(Yd + (row0 + i) * ldd + h * 64 + dt * 16 + q4 * 4) = wv;
        }
    }
    __syncthreads();
}

constexpr size_t WS_ET = WS_XB + 9437184;
constexpr size_t WS_AB = WS_XB + 16777216;
static_assert(WS_AB + (size_t)T * 256 * 2 <= WS_RSTD0, "XB scratch overflow");

__device__ __forceinline__ void gla_prep_item(const Params& p, LAS unsigned char* L, int item) {
    unsigned char* ws = p.ws;
    const int tid = threadIdx.x, lane = tid & 63, w = tid >> 6, r16 = lane & 15, q4 = lane >> 4;
    LAS bf16_t* QG = (LAS bf16_t*)L;
    LAS bf16_t* KG = (LAS bf16_t*)(L + 17408);
    LAS bf16_t* Gs = (LAS bf16_t*)(L + 34816);
    LAS float* Gf = (LAS float*)(L + 52224);
    LAS float* GT = (LAS float*)(L + 84992);
    int b, h; unsigned row0;
    if (item < 2048) { h = item & 3; const int c = (item >> 2) & 31; b = item >> 7; row0 = (unsigned)b * 2048 + c * 64; }
    else { const int i2 = item - 2048; h = i2 & 3; b = i2 >> 2; row0 = (unsigned)T_P + b * 64; }
    bf16_t* BQ = (bf16_t*)(ws + WS_BQ); bf16_t* BKb = (bf16_t*)(ws + WS_BK); const bf16_t* GB = (const bf16_t*)(ws + WS_BLR);
    float* ET = (float*)(ws + WS_ET); bf16_t* AB = (bf16_t*)(ws + WS_AB);
    const int c = tid & 127, tg = tid >> 7;
    const int pt0 = tid >> 4, pt1 = (tid + 512) >> 4, poc = tid & 15;
    const unsigned o0 = (row0 + pt0) * 512u + h * 128 + poc * 8, o1 = (row0 + pt1) * 512u + h * 128 + poc * 8;
    const u32x4 pg0 = *(const u32x4*)(GB + o0), pg1 = *(const u32x4*)(GB + o1);
    const u32x4 pq0 = *(const u32x4*)(BQ + o0), pq1 = *(const u32x4*)(BQ + o1), pk0 = *(const u32x4*)(BKb + o0), pk1 = *(const u32x4*)(BKb + o1);
    *(LAS u32x4*)(Gs + pt0 * 136 + poc * 8) = pg0; *(LAS u32x4*)(Gs + pt1 * 136 + poc * 8) = pg1;
    lds_barrier();
    {
        float cs = 0.f;
#pragma unroll
        for (int tt = 0; tt < 16; ++tt) { cs += bf2f(Gs[(tg * 16 + tt) * 136 + c]); Gf[(tg * 16 + tt) * 128 + c] = cs; }
        GT[tg * 128 + c] = cs;
    }
    lds_barrier();
#pragma unroll
    for (int i = 0; i < 2; ++i) {
        const int t = i ? pt1 : pt0; const int tgp = t >> 4;
        const u32x4 qw = i ? pq1 : pq0, kw = i ? pk1 : pk0;
        float G[8], tot[8];
        { const f32x4 a0 = *(const LAS f32x4*)(Gf + t * 128 + poc * 8), a1 = *(const LAS f32x4*)(Gf + t * 128 + poc * 8 + 4);
          G[0] = a0[0]; G[1] = a0[1]; G[2] = a0[2]; G[3] = a0[3]; G[4] = a1[0]; G[5] = a1[1]; G[6] = a1[2]; G[7] = a1[3]; }
#pragma unroll
        for (int j = 0; j < 8; ++j) tot[j] = 0.f;
#pragma unroll
        for (int g2 = 0; g2 < 4; ++g2) {
            const f32x4 a0 = *(const LAS f32x4*)(GT + g2 * 128 + poc * 8), a1 = *(const LAS f32x4*)(GT + g2 * 128 + poc * 8 + 4);
            const float sel = (g2 < tgp) ? 1.f : 0.f;
            G[0] += sel * a0[0]; G[1] += sel * a0[1]; G[2] += sel * a0[2]; G[3] += sel * a0[3]; G[4] += sel * a1[0]; G[5] += sel * a1[1]; G[6] += sel * a1[2]; G[7] += sel * a1[3];
            tot[0] += a0[0]; tot[1] += a0[1]; tot[2] += a0[2]; tot[3] += a0[3]; tot[4] += a1[0]; tot[5] += a1[1]; tot[6] += a1[2]; tot[7] += a1[3];
        }
        if (i == 0 && tid < 16) {
            float* ep = ET + (size_t)(row0 >> 6) * 512 + h * 128 + poc * 8;
            *(f32x4*)ep = (f32x4){__expf(tot[0]), __expf(tot[1]), __expf(tot[2]), __expf(tot[3])};
            *(f32x4*)(ep + 4) = (f32x4){__expf(tot[4]), __expf(tot[5]), __expf(tot[6]), __expf(tot[7])};
        }
        float qv[8], kv[8];
        unpack8(qw, qv); unpack8(kw, kv);
#pragma unroll
        for (int j = 0; j < 8; ++j) { const float eg = __expf(G[j]); qv[j] *= eg; kv[j] *= rcpf_(eg); }
        u32x4 qo, ko;
        qo.x = cvt_pk_bf16(qv[0], qv[1]); qo.y = cvt_pk_bf16(qv[2], qv[3]); qo.z = cvt_pk_bf16(qv[4], qv[5]); qo.w = cvt_pk_bf16(qv[6], qv[7]);
        ko.x = cvt_pk_bf16(kv[0], kv[1]); ko.y = cvt_pk_bf16(kv[2], kv[3]); ko.z = cvt_pk_bf16(kv[4], kv[5]); ko.w = cvt_pk_bf16(kv[6], kv[7]);
        *(LAS u32x4*)(QG + t * 136 + poc * 8) = qo; *(LAS u32x4*)(KG + t * 136 + poc * 8) = ko;
        *(u32x4*)(BQ + (i ? o1 : o0)) = qo; *(u32x4*)(BKb + (i ? o1 : o0)) = ko;
    }
    lds_barrier();
    {
        const int it = w >> 1, jt0 = (w & 1) * 2;
        f32x4 at[2];
        at[0] = (f32x4){0.f, 0.f, 0.f, 0.f}; at[1] = (f32x4){0.f, 0.f, 0.f, 0.f};
#pragma unroll
        for (int ks = 0; ks < 4; ++ks) {
            const bf16x8 qf = *(const LAS bf16x8*)(QG + (it * 16 + r16) * 136 + ks * 32 + q4 * 8);
#pragma unroll
            for (int t2 = 0; t2 < 2; ++t2) {
                const bf16x8 kf = *(const LAS bf16x8*)(KG + ((jt0 + t2) * 16 + r16) * 136 + ks * 32 + q4 * 8);
                at[t2] = MFMA16(kf, qf, at[t2]);
            }
        }
        const int i = it * 16 + r16;
#pragma unroll
        for (int t2 = 0; t2 < 2; ++t2) {
            f32x4 v = at[t2];
#pragma unroll
            for (int jj = 0; jj < 4; ++jj) { const int j = (jt0 + t2) * 16 + q4 * 4 + jj; if (j > i) v[jj] = 0.f; }
            u32x2 wv; wv.x = cvt_pk_bf16(v[0], v[1]); wv.y = cvt_pk_bf16(v[2], v[3]);
            *(u32x2*)(AB + (size_t)(row0 + i) * 256 + h * 64 + (jt0 + t2) * 16 + q4 * 4) = wv;
        }
    }
    lds_barrier();
}

__device__ __forceinline__ void gla_scan_item(const Params& p, LAS unsigned char* L, int item, bool dummy) {
    unsigned char* ws = p.ws;
    const int tid = threadIdx.x, lane = tid & 63, w = tid >> 6, r16 = lane & 15, q4 = lane >> 4;
    LAS bf16_t* QG = (LAS bf16_t*)L;
    LAS bf16_t* KG = (LAS bf16_t*)(L + 17408);
    LAS bf16_t* Vs = (LAS bf16_t*)(L + 34816);
    LAS bf16_t* As = (LAS bf16_t*)(L + 44032);
    LAS float* GL = (LAS float*)(L + 53248);
    const unsigned lbase = (unsigned)(size_t)L;
    const bool smp = item >= 256;
    const int i2 = smp ? item - 256 : item;
    const int b = i2 >> 4, h = (i2 >> 2) & 3, sl = i2 & 3, e0 = sl * 64;
    const int nch = smp ? 1 : 32;
    const unsigned rbase = smp ? (unsigned)T_P + b * 64 : (unsigned)b * 2048;
    const bf16_t* BQ = (const bf16_t*)(ws + WS_BQ); const bf16_t* BKb = (const bf16_t*)(ws + WS_BK); bf16_t* BV = (bf16_t*)(ws + WS_BV);
    const float* ET = (const float*)(ws + WS_ET); const bf16_t* AB = (const bf16_t*)(ws + WS_AB); float* BOSQP = dummy ? p.out + 20000000 : (float*)(ws + WS_XB);
    bf16_t* BVo = dummy ? (bf16_t*)p.out : BV;
    const int pt0 = tid >> 4, pt1 = (tid + 512) >> 4, poc = tid & 15;
    const int vt = tid >> 3, veo = tid & 7;
    const int et = w & 3, ip = w >> 2;
    f32x4 Sacc[8];
#pragma unroll
    for (int d8 = 0; d8 < 8; ++d8) {
        if (smp) {
#pragma unroll
            for (int jj = 0; jj < 4; ++jj) Sacc[d8][jj] = p.in[4][((size_t)(b * 4 + h) * 128 + d8 * 16 + q4 * 4 + jj) * 256 + e0 + et * 16 + r16];
        } else Sacc[d8] = (f32x4){0.f, 0.f, 0.f, 0.f};
    }
    const int tq_ = r16 >> 2, tp_ = r16 & 3;
    const unsigned v4a = lbase + 34816u + (unsigned)(((q4 * 8 + tq_) * 72 + et * 16 + 4 * tp_) * 2);
    const unsigned k4a = lbase + 17408u + (unsigned)(((q4 * 8 + tq_) * 136 + 4 * tp_) * 2);
    struct Pre { u32x4 q0, q1, k0, k1, a, v; f32x4 e; };
    Pre PA, PB;
    PA.e = (f32x4){0.f, 0.f, 0.f, 0.f}; PB.e = (f32x4){0.f, 0.f, 0.f, 0.f};
#define GLA_PREFETCH(P, R) do { \
        const unsigned o0_ = ((R) + pt0) * 512u + h * 128 + poc * 8, o1_ = ((R) + pt1) * 512u + h * 128 + poc * 8; \
        P.q0 = *(const u32x4*)(BQ + o0_); P.q1 = *(const u32x4*)(BQ + o1_); P.k0 = *(const u32x4*)(BKb + o0_); P.k1 = *(const u32x4*)(BKb + o1_); \
        P.a = *(const u32x4*)(AB + ((R) + vt) * 256u + h * 64 + veo * 8); \
        P.v = *(const u32x4*)(BV + ((R) + vt) * 1024u + h * 256 + e0 + veo * 8); \
        if (tid < 32) P.e = *(const f32x4*)(ET + ((R) >> 6) * 512u + h * 128 + tid * 4); } while (0)
    GLA_PREFETCH(PA, rbase);
    if (nch > 1) GLA_PREFETCH(PB, rbase + 64);
    f32x4 po0 = {0.f, 0.f, 0.f, 0.f}, po1 = {0.f, 0.f, 0.f, 0.f}; unsigned prow = 0; bool pend = false;
#define GLA_STORE_OUT() do { \
            _Pragma("unroll") for (int x2 = 0; x2 < 2; ++x2) { \
                const unsigned row = prow + (ip * 2 + x2) * 16 + r16; \
                const f32x4 o = x2 ? po1 : po0; \
                u32x2 wv; wv.x = cvt_pk_bf16(o[0], o[1]); wv.y = cvt_pk_bf16(o[2], o[3]); \
                *(u32x2*)(BVo + row * 1024u + h * 256 + e0 + et * 16 + q4 * 4) = wv; \
                float ss = o[0] * o[0] + o[1] * o[1] + o[2] * o[2] + o[3] * o[3]; \
                ss += __shfl_xor(ss, 16); ss += __shfl_xor(ss, 32); \
                if (q4 == 0) BOSQP[row * 64u + h * 16 + sl * 4 + et] = ss; \
            } } while (0)
#define GLA_CHUNK(P, CI) do { \
        const unsigned r0 = rbase + (unsigned)(CI) * 64; \
        *(LAS u32x4*)(QG + pt0 * 136 + poc * 8) = P.q0; *(LAS u32x4*)(QG + pt1 * 136 + poc * 8) = P.q1; \
        *(LAS u32x4*)(KG + pt0 * 136 + poc * 8) = P.k0; *(LAS u32x4*)(KG + pt1 * 136 + poc * 8) = P.k1; \
        *(LAS u32x4*)(As + vt * 72 + veo * 8) = P.a; *(LAS u32x4*)(Vs + vt * 72 + veo * 8) = P.v; \
        if (tid < 32) *(LAS f32x4*)(GL + tid * 4) = P.e; \
        lds_barrier(); \
        if (pend) GLA_STORE_OUT(); \
        if ((CI) + 2 < nch) GLA_PREFETCH(P, r0 + 128); \
        bf16x8 vf[2]; \
        { bf16x4 a0, a1, b0, b1; \
          asm volatile("ds_read_b64_tr_b16 %0, %4\n\tds_read_b64_tr_b16 %1, %4 offset:576\n\tds_read_b64_tr_b16 %2, %4 offset:4608\n\tds_read_b64_tr_b16 %3, %4 offset:5184\n\ts_waitcnt lgkmcnt(0)" \
                       : "=&v"(a0), "=&v"(a1), "=&v"(b0), "=&v"(b1) : "v"(v4a) : "memory"); \
          vf[0] = cat4(a0, a1); vf[1] = cat4(b0, b1); } \
        f32x4 ot[2]; \
        ot[0] = (f32x4){0.f, 0.f, 0.f, 0.f}; ot[1] = (f32x4){0.f, 0.f, 0.f, 0.f}; \
        _Pragma("unroll") for (int x2 = 0; x2 < 2; ++x2) \
            _Pragma("unroll") for (int jb = 0; jb < 2; ++jb) { \
                const bf16x8 af = *(const LAS bf16x8*)(As + ((ip * 2 + x2) * 16 + r16) * 72 + jb * 32 + q4 * 8); \
                ot[x2] = MFMA16(vf[jb], af, ot[x2]); } \
        _Pragma("unroll") for (int db = 0; db < 4; ++db) { \
            const bf16x8 sf = pack8(Sacc[2 * db], Sacc[2 * db + 1]); \
            _Pragma("unroll") for (int x2 = 0; x2 < 2; ++x2) { \
                const LAS bf16_t* qp = QG + ((ip * 2 + x2) * 16 + r16) * 136 + db * 32 + q4 * 4; \
                const bf16x8 qv = cat4(*(const LAS bf16x4*)qp, *(const LAS bf16x4*)(qp + 16)); \
                ot[x2] = MFMA16(sf, qv, ot[x2]); } } \
        po0 = ot[0]; po1 = ot[1]; prow = r0; pend = true; \
        _Pragma("unroll") for (int jb = 0; jb < 2; ++jb) { \
            bf16x4 kl[8], kh[8]; \
            const unsigned ka = k4a + (unsigned)(jb * 32 * 272); \
            asm volatile("ds_read_b64_tr_b16 %0, %16 offset:0\n\t" "ds_read_b64_tr_b16 %1, %16 offset:1088\n\t" "ds_read_b64_tr_b16 %2, %16 offset:32\n\t" "ds_read_b64_tr_b16 %3, %16 offset:1120\n\t" "ds_read_b64_tr_b16 %4, %16 offset:64\n\t" "ds_read_b64_tr_b16 %5, %16 offset:1152\n\t" "ds_read_b64_tr_b16 %6, %16 offset:96\n\t" "ds_read_b64_tr_b16 %7, %16 offset:1184\n\t" "ds_read_b64_tr_b16 %8, %16 offset:128\n\t" "ds_read_b64_tr_b16 %9, %16 offset:1216\n\t" "ds_read_b64_tr_b16 %10, %16 offset:160\n\t" "ds_read_b64_tr_b16 %11, %16 offset:1248\n\t" "ds_read_b64_tr_b16 %12, %16 offset:192\n\t" "ds_read_b64_tr_b16 %13, %16 offset:1280\n\t" "ds_read_b64_tr_b16 %14, %16 offset:224\n\t" "ds_read_b64_tr_b16 %15, %16 offset:1312\n\t" "s_waitcnt lgkmcnt(0)" \
                         : "=&v"(kl[0]), "=&v"(kh[0]), "=&v"(kl[1]), "=&v"(kh[1]), "=&v"(kl[2]), "=&v"(kh[2]), "=&v"(kl[3]), "=&v"(kh[3]), "=&v"(kl[4]), "=&v"(kh[4]), "=&v"(kl[5]), "=&v"(kh[5]), "=&v"(kl[6]), "=&v"(kh[6]), "=&v"(kl[7]), "=&v"(kh[7]) : "v"(ka) : "memory"); \
            _Pragma("unroll") for (int d8 = 0; d8 < 8; ++d8) Sacc[d8] = MFMA16(cat4(kl[d8], kh[d8]), vf[jb], Sacc[d8]); } \
        _Pragma("unroll") for (int d8 = 0; d8 < 8; ++d8) { \
            const f32x4 dec = *(const LAS f32x4*)(GL + d8 * 16 + q4 * 4); \
            Sacc[d8] = Sacc[d8] * dec; } \
        lds_barrier(); \
    } while (0)
    for (int ci = 0; ci < nch; ci += 2) {
        GLA_CHUNK(PA, ci);
        if (ci + 1 < nch) GLA_CHUNK(PB, ci + 1);
    }
    if (pend) GLA_STORE_OUT();
#undef GLA_STORE_OUT
#undef GLA_PREFETCH
#undef GLA_CHUNK
    if (ip == 0 && !dummy) {
        float* og = p.out + (smp ? O_GS : O_GP);
#pragma unroll
        for (int d8 = 0; d8 < 8; ++d8)
#pragma unroll
            for (int jj = 0; jj < 4; ++jj) og[((size_t)(b * 4 + h) * 128 + d8 * 16 + q4 * 4 + jj) * 256 + e0 + et * 16 + r16] = Sacc[d8][jj];
    }
}

__device__ __forceinline__ void phase2a(const Params& p, LAS unsigned char* L) {
#ifndef NO_PREP
    for (int it = blockIdx.x; it < 2176; it += gridDim.x) gla_prep_item(p, L, it);
#endif
#ifndef NO_ATTN
    for (int it = blockIdx.x; it < 2176; it += gridDim.x) attn_item(p, L, it, (bf16_t*)(p.ws + WS_GATE), 2048);
#endif
}
__device__ __forceinline__ void phase2b(const Params& p, LAS unsigned char* L) {
#ifndef NO_SCAN
#ifdef PROBE_SCAN2
    for (int it = blockIdx.x; it < 768; it += gridDim.x) gla_scan_item(p, L, it, true);
#endif
    if (gridDim.x == 256) {
        const int xcd = blockIdx.x & 7, loc = blockIdx.x >> 3;
        const int base = (xcd * 8 + (loc >> 2)) * 4 + (loc & 3);
        gla_scan_item(p, L, base, false); gla_scan_item(p, L, 256 + base, false); gla_scan_item(p, L, 512 + base, false);
    } else {
        for (int it = blockIdx.x; it < 768; it += gridDim.x) gla_scan_item(p, L, it, false);
    }
#endif
}

__device__ __forceinline__ void phase3(const Params& p) {
    unsigned char* ws = p.ws;
    const bf16_t* BV = (const bf16_t*)(ws + WS_BV); bf16_t* Yb = (bf16_t*)(ws + WS_GATE); const float* BOSQP = (const float*)(ws + WS_XB);
    const float* gg = p.in[12];
    const long gtid = (long)blockIdx.x * NTHR + threadIdx.x, gsz = (long)gridDim.x * NTHR;
    const long total = (long)T * 128;
    for (long it = gtid; it < total; it += gsz) {
        const long row = it >> 7; const int c8 = (int)(it & 127) * 8, h = c8 >> 8;
        float sq;
        { const f32x4 s0 = *(const f32x4*)(BOSQP + row * 64 + h * 16), s1 = *(const f32x4*)(BOSQP + row * 64 + h * 16 + 4), s2 = *(const f32x4*)(BOSQP + row * 64 + h * 16 + 8), s3 = *(const f32x4*)(BOSQP + row * 64 + h * 16 + 12);
          sq = ((s0[0] + s0[1]) + (s0[2] + s0[3])) + ((s1[0] + s1[1]) + (s1[2] + s1[3])) + ((s2[0] + s2[1]) + (s2[2] + s2[3])) + ((s3[0] + s3[1]) + (s3[2] + s3[3])); }
        const float rs = rsqrtf(sq * (1.f / 256.f) + EPS);
        const u32x4 bo = *(const u32x4*)(BV + row * 1024 + c8);
        const u32x4 gt = *(const u32x4*)(Yb + row * 2048 + 1024 + c8);
        const f32x4 g0 = *(const f32x4*)(gg + (c8 & 255)), g1 = *(const f32x4*)(gg + (c8 & 255) + 4);
        u32x4 o;
        o.x = cvt_pk_bf16(bflo(bo.x) * rs * g0[0] * siluf(bflo(gt.x)), bfhi(bo.x) * rs * g0[1] * siluf(bfhi(gt.x)));
        o.y = cvt_pk_bf16(bflo(bo.y) * rs * g0[2] * siluf(bflo(gt.y)), bfhi(bo.y) * rs * g0[3] * siluf(bfhi(gt.y)));
        o.z = cvt_pk_bf16(bflo(bo.z) * rs * g1[0] * siluf(bflo(gt.z)), bfhi(bo.z) * rs * g1[1] * siluf(bfhi(gt.z)));
        o.w = cvt_pk_bf16(bflo(bo.w) * rs * g1[2] * siluf(bflo(gt.w)), bfhi(bo.w) * rs * g1[3] * siluf(bfhi(gt.w)));
        *(u32x4*)(Yb + row * 2048 + 1024 + c8) = o;
    }
}

__device__ __forceinline__ void lru_item(const Params& p, LAS unsigned char* L, int item) {
    unsigned char* ws = p.ws;
    const int tid = threadIdx.x, lane = tid & 63, w = tid >> 6, r16 = lane & 15, q4 = lane >> 4;
    LAS bf16_t* Wl = (LAS bf16_t*)L;
    LAS bf16_t* U = (LAS bf16_t*)(L + 76800);
    LAS float* Aa = (LAS float*)(L + 102400);
    LAS float* Bb = (LAS float*)(L + 126976);
    LAS float* SP = (LAS float*)(L + 151552);
    LAS float* SH = (LAS float*)(L + 153088);
    LAS float* HC = (LAS float*)(L + 154624);
    LAS float* CW = (LAS float*)(L + 155392);
    const bool smp = item >= 256;
    const int i2 = smp ? item - 256 : item;
    const int b = i2 >> 4, nb = (i2 >> 1) & 7, hf = i2 & 1;
    const int nch = smp ? 1 : 32;
    const unsigned rbase = smp ? (unsigned)T_P + b * 64 : (unsigned)b * 2048;
    const bf16_t* Z2 = (const bf16_t*)(ws + WS_Z2); bf16_t* Y2 = (bf16_t*)(ws + WS_Y2);
    const bf16_t* WA = (const bf16_t*)(ws + WS_WA) + nb * 192 * 192; const bf16_t* WI = (const bf16_t*)(ws + WS_WI) + nb * 192 * 192;
    for (int idx = tid; idx < 192 * 24; idx += NTHR) {
        const int r = idx / 24, g8 = idx % 24;
        const bf16_t* src = (r < 96) ? WA + (size_t)(hf * 96 + r) * 192 + g8 * 8 : WI + (size_t)(hf * 96 + r - 96) * 192 + g8 * 8;
        *(LAS u32x4*)(Wl + r * 200 + g8 * 8) = *(const u32x4*)src;
    }
    const bool cthr = tid < 384;
    const int cgp = tid % 24, tq = (tid / 24) & 15;
    const int chc = nb * 192 + cgp * 8;
    for (int idx = tid; idx < 5 * 192; idx += NTHR) { const int j = idx / 192, cc = idx % 192; CW[idx] = (j < 4) ? p.in[16][j * 1536 + nb * 192 + cc] : p.in[17][nb * 192 + cc]; }
    const int mt = w & 3, pg = w >> 2;
    float bra[3], bri[3], sp[3];
#pragma unroll
    for (int cp = 0; cp < 3; ++cp) {
        const int ch = nb * 192 + hf * 96 + (pg * 3 + cp) * 16 + r16;
        bra[cp] = p.in[19][ch]; bri[cp] = p.in[21][ch];
        const float lam = p.in[22][ch];
        sp[cp] = 8.f * (fmaxf(-lam, 0.f) + log1pf(__expf(-fabsf(lam))));
    }
    if (tid < 96) HC[tid] = smp ? p.in[6][b * 1536 + nb * 192 + hf * 96 + tid] : 0.f;
    const int sch0 = tid % 96, sseg0 = (tid / 96) & 3;
    const int ot0 = tid / 12, og0 = tid % 12, ot1 = (tid + 512) / 12, og1 = (tid + 512) % 12;
    const bool o1 = tid < 256;
    const int och0 = nb * 192 + hf * 96 + og0 * 8, och1 = nb * 192 + hf * 96 + og1 * 8;
    lds_barrier();
    u32x4 xr[7]; u32x4 pg0, pg1 = {0u, 0u, 0u, 0u};
#pragma unroll
    for (int r = 0; r < 7; ++r) {
        xr[r] = (u32x4){0u, 0u, 0u, 0u};
        const int pos = 4 * tq - 3 + r;
        if (cthr) {
            if (pos >= 0) xr[r] = *(const u32x4*)(Z2 + (unsigned)((rbase + pos) * 3072u + chc));
            else if (smp) {
                const float* hp = p.in[5] + ((size_t)b * 3 + (3 + pos)) * 1536 + chc;
                const f32x4 h0 = *(const f32x4*)hp, h1 = *(const f32x4*)(hp + 4);
                xr[r].x = cvt_pk_bf16(h0[0], h0[1]); xr[r].y = cvt_pk_bf16(h0[2], h0[3]); xr[r].z = cvt_pk_bf16(h1[0], h1[1]); xr[r].w = cvt_pk_bf16(h1[2], h1[3]);
            }
        }
    }
    pg0 = *(const u32x4*)(Z2 + (unsigned)((rbase + ot0) * 3072u + 1536 + och0));
    if (o1) pg1 = *(const u32x4*)(Z2 + (unsigned)((rbase + ot1) * 3072u + 1536 + och1));
    u32x4 so0 = {0u, 0u, 0u, 0u}, so1 = {0u, 0u, 0u, 0u}; unsigned sr = 0; bool spend = false;
    for (int ci = 0; ci < nch; ++ci) {
        const unsigned r0 = rbase + (unsigned)ci * 64;
        const bool more = (ci + 1 < nch);
        int sch = sch0, sseg = sseg0;
        asm volatile("" : "+v"(sch), "+v"(sseg));
        if (cthr) {
            float xv[7][8];
#pragma unroll
            for (int r = 0; r < 7; ++r) unpack8(xr[r], xv[r]);
            if (hf == 0 && !more && tq == 15) {
                float* oc = p.out + (smp ? O_CS : O_CP) + (size_t)b * 3 * 1536 + chc;
#pragma unroll
                for (int r = 0; r < 3; ++r) { *(f32x4*)(oc + r * 1536) = (f32x4){xv[4 + r][0], xv[4 + r][1], xv[4 + r][2], xv[4 + r][3]}; *(f32x4*)(oc + r * 1536 + 4) = (f32x4){xv[4 + r][4], xv[4 + r][5], xv[4 + r][6], xv[4 + r][7]}; }
            }
            float cw[5][8];
#pragma unroll
            for (int j = 0; j < 5; ++j) { const f32x4 c0 = *(const LAS f32x4*)(CW + j * 192 + cgp * 8), c1 = *(const LAS f32x4*)(CW + j * 192 + cgp * 8 + 4);
                cw[j][0] = c0[0]; cw[j][1] = c0[1]; cw[j][2] = c0[2]; cw[j][3] = c0[3]; cw[j][4] = c1[0]; cw[j][5] = c1[1]; cw[j][6] = c1[2]; cw[j][7] = c1[3]; }
#pragma unroll
            for (int tk = 0; tk < 4; ++tk) {
                float acc[8];
#pragma unroll
                for (int e = 0; e < 8; ++e) acc[e] = cw[4][e] + xv[tk][e] * cw[0][e] + xv[tk + 1][e] * cw[1][e] + xv[tk + 2][e] * cw[2][e] + xv[tk + 3][e] * cw[3][e];
                u32x4 uw; uw.x = cvt_pk_bf16(acc[0], acc[1]); uw.y = cvt_pk_bf16(acc[2], acc[3]); uw.z = cvt_pk_bf16(acc[4], acc[5]); uw.w = cvt_pk_bf16(acc[6], acc[7]);
                *(LAS u32x4*)(U + (4 * tq + tk) * 200 + cgp * 8) = uw;
            }
            if (more) {
#pragma unroll
                for (int r = 0; r < 7; ++r) xr[r] = *(const u32x4*)(Z2 + (unsigned)((r0 + 64 + 4 * tq - 3 + r) * 3072u + chc));
            }
        }
        lds_barrier();
        if (spend) { *(u32x4*)(Y2 + (unsigned)((sr + ot0) * 1536u + och0)) = so0; if (o1) *(u32x4*)(Y2 + (unsigned)((sr + ot1) * 1536u + och1)) = so1; }
        f32x4 ga[3], gi[3];
#pragma unroll
        for (int cp = 0; cp < 3; ++cp) { ga[cp] = (f32x4){0.f, 0.f, 0.f, 0.f}; gi[cp] = (f32x4){0.f, 0.f, 0.f, 0.f}; }
#pragma unroll 2
        for (int ks = 0; ks < 6; ++ks) {
            const bf16x8 uf = *(const LAS bf16x8*)(U + (mt * 16 + r16) * 200 + ks * 32 + q4 * 8);
#pragma unroll
            for (int cp = 0; cp < 3; ++cp) {
                const int ct = pg * 3 + cp;
                const bf16x8 wa = *(const LAS bf16x8*)(Wl + (ct * 16 + r16) * 200 + ks * 32 + q4 * 8), wi = *(const LAS bf16x8*)(Wl + (96 + ct * 16 + r16) * 200 + ks * 32 + q4 * 8);
                ga[cp] = MFMA16(uf, wa, ga[cp]); gi[cp] = MFMA16(uf, wi, gi[cp]);
            }
        }
#pragma unroll
        for (int cp = 0; cp < 3; ++cp) {
            const int cl = (pg * 3 + cp) * 16 + r16;
#pragma unroll
            for (int jj = 0; jj < 4; ++jj) {
                const int t = mt * 16 + q4 * 4 + jj;
                const float rg = sigmf(ga[cp][jj] + bra[cp]), ig = sigmf(gi[cp][jj] + bri[cp]);
                const float z = rg * sp[cp];
                const float a = __expf(-z);
                const float z2 = z + z;
                const float om = (z2 < 0.05f) ? z2 * (1.f - z2 * (0.5f - z2 * (0.16666667f - z2 * 0.041666668f))) : 1.f - a * a;
                const float uu = bf2f(U[t * 200 + hf * 96 + cl]);
                Aa[t * 96 + cl] = a; Bb[t * 96 + cl] = __builtin_amdgcn_sqrtf(om) * ig * uu;
            }
        }
        lds_barrier();
        if (cthr) {
            float P = 1.f, H = 0.f;
#pragma unroll
            for (int t = 0; t < 16; ++t) { const float a = Aa[(sseg * 16 + t) * 96 + sch]; H = a * H + Bb[(sseg * 16 + t) * 96 + sch]; P *= a; }
            SP[sseg * 96 + sch] = P; SH[sseg * 96 + sch] = H;
        }
        lds_barrier();
        if (cthr) {
            float hh = HC[(ci & 1) * 96 + sch];
#pragma unroll
            for (int sg = 0; sg < 3; ++sg) if (sg < sseg) hh = SP[sg * 96 + sch] * hh + SH[sg * 96 + sch];
#pragma unroll
            for (int t = 0; t < 16; ++t) { hh = Aa[(sseg * 16 + t) * 96 + sch] * hh + Bb[(sseg * 16 + t) * 96 + sch]; Bb[(sseg * 16 + t) * 96 + sch] = hh; }
            if (sseg == 3) HC[((ci + 1) & 1) * 96 + sch] = hh;
        }
        lds_barrier();
        {
            const f32x4 h0 = *(const LAS f32x4*)(Bb + ot0 * 96 + og0 * 8), h1 = *(const LAS f32x4*)(Bb + ot0 * 96 + og0 * 8 + 4);
            u32x4 o;
            o.x = cvt_pk_bf16(h0[0] * siluf(bflo(pg0.x)), h0[1] * siluf(bfhi(pg0.x)));
            o.y = cvt_pk_bf16(h0[2] * siluf(bflo(pg0.y)), h0[3] * siluf(bfhi(pg0.y)));
            o.z = cvt_pk_bf16(h1[0] * siluf(bflo(pg0.z)), h1[1] * siluf(bfhi(pg0.z)));
            o.w = cvt_pk_bf16(h1[2] * siluf(bflo(pg0.w)), h1[3] * siluf(bfhi(pg0.w)));
            so0 = o;
            if (more) pg0 = *(const u32x4*)(Z2 + (unsigned)((r0 + 64 + ot0) * 3072u + 1536 + och0));
        }
        if (o1) {
            const f32x4 h0 = *(const LAS f32x4*)(Bb + ot1 * 96 + og1 * 8), h1 = *(const LAS f32x4*)(Bb + ot1 * 96 + og1 * 8 + 4);
            u32x4 o;
            o.x = cvt_pk_bf16(h0[0] * siluf(bflo(pg1.x)), h0[1] * siluf(bfhi(pg1.x)));
            o.y = cvt_pk_bf16(h0[2] * siluf(bflo(pg1.y)), h0[3] * siluf(bfhi(pg1.y)));
            o.z = cvt_pk_bf16(h1[0] * siluf(bflo(pg1.z)), h1[1] * siluf(bfhi(pg1.z)));
            o.w = cvt_pk_bf16(h1[2] * siluf(bflo(pg1.w)), h1[3] * siluf(bfhi(pg1.w)));
            so1 = o;
            if (more) pg1 = *(const u32x4*)(Z2 + (unsigned)((r0 + 64 + ot1) * 3072u + 1536 + och1));
        }
        sr = r0; spend = true;
        lds_barrier();
    }
    if (spend) { *(u32x4*)(Y2 + (unsigned)((sr + ot0) * 1536u + och0)) = so0; if (o1) *(u32x4*)(Y2 + (unsigned)((sr + ot1) * 1536u + och1)) = so1; }
    if (tid < 96) p.out[(smp ? O_LS : O_LP) + (size_t)b * 1536 + nb * 192 + hf * 96 + tid] = HC[(nch & 1) * 96 + tid];
    lds_barrier();
}

__device__ __forceinline__ void phase6(const Params& p, LAS unsigned char* L) {
    for (int it = blockIdx.x; it < 768; it += gridDim.x) lru_item(p, L, it);
}

__device__ __forceinline__ void phase8(const Params& p) {
    const float* rsq = (const float*)(p.ws + WS_RSQ2); const float* g = p.in[24]; float* y = p.out;
    const long gtid = (long)blockIdx.x * NTHR + threadIdx.x, gsz = (long)gridDim.x * NTHR;
    const long total = (long)T * 256;
    for (long it = gtid; it < total; it += gsz) {
        const long row = it >> 8; const int c4 = (int)(it & 255) * 4;
        const float rs = rsqrtf(rsq[row] * (1.f / 1024.f) + EPS);
        const f32x4 v = *(const f32x4*)(y + row * 1024 + c4), gv = *(const f32x4*)(g + c4);
        *(f32x4*)(y + row * 1024 + c4) = v * rs * gv;
    }
}


#define XB_TMO      128
#define XB_XCNT(j)  (256  + 64 * (j))
#define XB_XSUB(j)  (1280 + 64 * (j))
#define XB_XGEN(j)  (2304 + 64 * (j))
#define XB_TOP      3328
#define XB_TOPGEN   3392
#define XCD_BAR_WORDS 3456
#define XB_SPIN_CAP (1u << 18)
__device__ __forceinline__ unsigned xb_ld(unsigned* p)              { return __hip_atomic_load(p, __ATOMIC_RELAXED, __HIP_MEMORY_SCOPE_AGENT); }
__device__ __forceinline__ unsigned xb_add(unsigned* p, unsigned v) { return __hip_atomic_fetch_add(p, v, __ATOMIC_RELAXED, __HIP_MEMORY_SCOPE_AGENT); }
__device__ __forceinline__ unsigned xb_xcc_id() { return (unsigned)__builtin_amdgcn_s_getreg((3 << 11) | 20) & 0xFu; }
#define XB_SPIN(cond, bar) do { unsigned _sp = 0; while (cond) { __builtin_amdgcn_s_sleep(1); \
    if ((++_sp & 255u) == 0u) { if (xb_ld(&(bar)[XB_TMO])) break; if (_sp > XB_SPIN_CAP) { atomicAdd(&(bar)[XB_TMO], 1u); break; } } } } while (0)
struct XcdBarrier { unsigned* bar; unsigned x; volatile LAS unsigned* st; };
__device__ __forceinline__ XcdBarrier xcd_barrier_post(unsigned* bar, volatile LAS unsigned* st) {
    XcdBarrier b; b.bar = bar; b.x = xb_xcc_id(); b.st = st;
    if (threadIdx.x == 0) (void)xb_add(&bar[XB_XCNT(b.x)], 1u);
    return b;
}
__device__ __forceinline__ void xcd_barrier_complete(unsigned* bar, unsigned x, unsigned& nloc, unsigned& nx) {
    const unsigned G = gridDim.x * gridDim.y * gridDim.z;
    unsigned sum, cnt, mine, sp = 0u;
    for (;;) {
        sum = 0u; cnt = 0u; mine = 0u;
#pragma unroll
        for (unsigned j = 0; j < 16; ++j) { const unsigned c = xb_ld(&bar[XB_XCNT(j)]); sum += c; cnt += (c > 0u) ? 1u : 0u; mine = (j == x) ? c : mine; }
        if (sum == G) break;
        __builtin_amdgcn_s_sleep(1);
        if ((++sp & 255u) == 0u) { if (xb_ld(&bar[XB_TMO])) break; if (sp > XB_SPIN_CAP) { atomicAdd(&bar[XB_TMO], 1u); break; } }
    }
    nloc = mine > 0u ? mine : 1u; nx = cnt > 0u ? cnt : 1u;
}
__device__ __forceinline__ void xcd_barrier(const XcdBarrier& b) {
    asm volatile("s_waitcnt vmcnt(0)" ::: "memory");
    __syncthreads();
    if (threadIdx.x == 0) {
        unsigned* bar = b.bar;
        __builtin_amdgcn_s_waitcnt(0);
        unsigned nloc = b.st[0], nx = b.st[1];
        if (nloc == 0u) { xcd_barrier_complete(bar, b.x, nloc, nx); b.st[0] = nloc; b.st[1] = nx; }
        const unsigned old = xb_add(&bar[XB_XSUB(b.x)], 1u);
        const unsigned gen = old / nloc;
        if (old + 1u == (gen + 1u) * nloc) {
            __builtin_amdgcn_fence(__ATOMIC_RELEASE, "agent");
            asm volatile("s_waitcnt vmcnt(0)" ::: "memory");
            const unsigned og = xb_add(&bar[XB_TOP], 1u);
            const unsigned tg = og / nx;
            if (og + 1u == (tg + 1u) * nx) xb_add(&bar[XB_TOPGEN], 1u);
            else XB_SPIN(xb_ld(&bar[XB_TOPGEN]) == tg, bar);
            __builtin_amdgcn_fence(__ATOMIC_ACQUIRE, "agent");
            xb_add(&bar[XB_XGEN(b.x)], 1u);
            asm volatile("s_waitcnt vmcnt(0)" ::: "memory");
        } else {
            XB_SPIN(xb_ld(&bar[XB_XGEN(b.x)]) == gen, bar);
            __builtin_amdgcn_fence(__ATOMIC_ACQUIRE, "agent");
            asm volatile("s_waitcnt vmcnt(0)" ::: "memory");
        }
    }
    __syncthreads();
}

__global__ void __launch_bounds__(NTHR) mega(Params p) {
    extern __shared__ __attribute__((aligned(16))) unsigned char lds_raw[];
    LAS unsigned char* L = (LAS unsigned char*)lds_raw;
    cg::grid_group grid = cg::this_grid();
    unsigned char* ws = p.ws;
    const int lo = p.ph_lo, hi = p.ph_hi;
    LAS unsigned* stw = (LAS unsigned*)(L + (LDS_BYTES - 16));
    if (threadIdx.x < 4) stw[threadIdx.x] = 0u;
    __syncthreads();
    const XcdBarrier xb = xcd_barrier_post((unsigned*)(ws + WS_BAR), (volatile LAS unsigned*)stw);
#ifndef PHMASK
#define PHMASK 0x1ff
#endif
#define IN(k) (((PHMASK >> (k)) & 1) && lo <= (k) && (k) < hi)
#define SEAM(k) do { if (IN(k) && IN((k) + 1)) { if ((k) == 0) grid.sync(); else xcd_barrier(xb); } } while (0)
    if (IN(0)) phase0(p);
    SEAM(0);
    if (IN(1)) {
        pg8::Gemm g{(const bf16_t*)(ws + WS_XB), (const bf16_t*)(ws + WS_WINE), T, NE_PAD, 1024};
        pg8::StaticOrder S; S.init(T, NE_PAD, gridDim.x, blockIdx.x);
        EpiInEven E{ws, p.out, (const float*)(ws + WS_RSTD0), p.in[10]};
        pg8::gemm_phase<EpiInEven>(L, g, S, E);
    }
    SEAM(1);
    if (IN(2)) { phase2a(p, L); xcd_barrier(xb); phase2b(p, L); }
    SEAM(2);
    if (IN(3)) phase3(p);
    SEAM(3);
    if (IN(4)) {
        pg8::Gemm g{(const bf16_t*)(ws + WS_GATE), (const bf16_t*)(ws + WS_WOUTE), T, 1024, 2048};
        pg8::StaticOrder S; S.init(T, 1024, gridDim.x, blockIdx.x);
        EpiOutRes<true> E{p.in[0], p.in[1], p.out, (bf16_t*)(ws + WS_XB), (float*)(ws + WS_RSQ1)};
        pg8::gemm_phase<EpiOutRes<true>>(L, g, S, E);
    }
    SEAM(4);
    if (IN(5)) {
        pg8::Gemm g{(const bf16_t*)(ws + WS_XB), (const bf16_t*)(ws + WS_WINO), T, 3072, 1024};
        pg8::StaticOrder S; S.init(T, 3072, gridDim.x, blockIdx.x);
        EpiInOdd E{(bf16_t*)(ws + WS_Z2), (const float*)(ws + WS_RSQ1)};
        pg8::gemm_phase<EpiInOdd>(L, g, S, E);
    }
    SEAM(5);
    if (IN(6)) phase6(p, L);
    SEAM(6);
    if (IN(7)) {
        pg8::Gemm g{(const bf16_t*)(ws + WS_Y2), (const bf16_t*)(ws + WS_WOUTO), T, 1024, 1536};
        pg8::StaticOrder S; S.init(T, 1024, gridDim.x, blockIdx.x);
        EpiOutRes<false> E{p.out, p.out + (size_t)T_P * 1024, p.out, nullptr, (float*)(ws + WS_RSQ2)};
        pg8::gemm_phase<EpiOutRes<false>>(L, g, S, E);
    }
    SEAM(7);
    if (IN(8)) phase8(p);
#undef IN
#undef SEAM
}

extern "C" void kernel_launch(void* const* d_in, const int* in_sizes, int n_in, void* d_out, int out_size, void* d_ws, size_t ws_size, hipStream_t stream) {
    static int grid_blocks = 0;
    if (grid_blocks == 0) {
        if (n_in != 25 || (size_t)out_size != O_END || ws_size < WS_TOTAL) { fprintf(stderr, "kernel_launch: unexpected shapes n_in %d out %d ws %zu (need %zu)\n", n_in, out_size, ws_size, (size_t)WS_END); grid_blocks = -1; return; }
        int dev = 0, cus = 0, per_cu = 0;
        (void)hipGetDevice(&dev);
        (void)hipDeviceGetAttribute(&cus, hipDeviceAttributeMultiprocessorCount, dev);
        if (hipFuncSetAttribute((const void*)mega, hipFuncAttributeMaxDynamicSharedMemorySize, LDS_BYTES) != hipSuccess) { fprintf(stderr, "kernel_launch: hipFuncSetAttribute failed\n"); }
        if (hipOccupancyMaxActiveBlocksPerMultiprocessor(&per_cu, (const void*)mega, NTHR, LDS_BYTES) != hipSuccess || per_cu < 1) per_cu = 1;
        (void)hipGetLastError();
        grid_blocks = cus * per_cu;
        if (grid_blocks <= 0) grid_blocks = 256;
    }
    if (grid_blocks < 0) return;
    Params p{};
    for (int i = 0; i < 25; ++i) p.in[i] = (const float*)d_in[i];
    p.out = (float*)d_out; p.ws = (unsigned char*)d_ws;
#if ONE_LAUNCH
#ifdef PROBE_X
    { const int seq[3][2] = {{0, PROBE_Y + 1}, {PROBE_X, PROBE_Y + 1}, {PROBE_Y + 1, 9}};
      for (int li = 0; li < 3; ++li) { if (seq[li][0] >= seq[li][1]) continue; p.ph_lo = seq[li][0]; p.ph_hi = seq[li][1]; void* args[] = {&p};
        (void)hipMemsetAsync((char*)d_ws + WS_BAR, 0, 16384, stream);
        hipError_t e = hipLaunchCooperativeKernel((const void*)mega, dim3(grid_blocks), dim3(NTHR), args, LDS_BYTES, stream);
        if (e != hipSuccess) fprintf(stderr, "cooperative launch failed: %s (grid %d)\n", hipGetErrorString(e), grid_blocks); } }
#else
    p.ph_lo = 0; p.ph_hi = 9;
    (void)hipMemsetAsync((char*)d_ws + WS_BAR, 0, 16384, stream);
    { void* args[] = {&p}; hipError_t e = hipLaunchCooperativeKernel((const void*)mega, dim3(grid_blocks), dim3(NTHR), args, LDS_BYTES, stream);
      if (e != hipSuccess) fprintf(stderr, "cooperative launch failed: %s (grid %d)\n", hipGetErrorString(e), grid_blocks); }
#endif
#else
    for (int ph = 0; ph < 9; ++ph) {
        p.ph_lo = ph; p.ph_hi = ph + 1;
        (void)hipMemsetAsync((char*)d_ws + WS_BAR, 0, 16384, stream);
        void* args[] = {&p}; hipError_t e = hipLaunchCooperativeKernel((const void*)mega, dim3(grid_blocks), dim3(NTHR), args, LDS_BYTES, stream);
        if (e != hipSuccess) fprintf(stderr, "cooperative launch %d failed: %s (grid %d)\n", ph, hipGetErrorString(e), grid_blocks);
    }
#endif
}
```

```cpp
#include <hip/hip_runtime.h>
#include <hip/hip_cooperative_groups.h>
#include <cstdio>
namespace cg = cooperative_groups;

#ifndef ONE_LAUNCH
#define ONE_LAUNCH 1
#endif

#define LAS __attribute__((address_space(3)))
typedef unsigned short bf16_t;
typedef short bf16x8 __attribute__((ext_vector_type(8)));
typedef short bf16x4 __attribute__((ext_vector_type(4)));
typedef float f32x4 __attribute__((ext_vector_type(4)));
typedef unsigned u32x4 __attribute__((ext_vector_type(4)));
typedef unsigned u32x2 __attribute__((ext_vector_type(2)));

constexpr int T_P = 32768, T_S = 2048, T = T_P + T_S, DM = 1024;
constexpr int NE_PAD = 6144;
constexpr int LDS_BYTES = 159744;
constexpr int NTHR = 512;
constexpr float EPS = 1e-6f;

constexpr size_t WS_WINE = 0;
constexpr size_t WS_WOUTE = WS_WINE + (size_t)NE_PAD * 1024 * 2;
constexpr size_t WS_WINO = WS_WOUTE + (size_t)1024 * 2048 * 2;
constexpr size_t WS_WOUTO = WS_WINO + (size_t)3072 * 1024 * 2;
constexpr size_t WS_WA = WS_WOUTO + (size_t)1024 * 1536 * 2;
constexpr size_t WS_WI = WS_WA + (size_t)8 * 192 * 192 * 2;
constexpr size_t WS_XB = WS_WI + (size_t)8 * 192 * 192 * 2;
constexpr size_t WS_RSTD0 = WS_XB + (size_t)T * 1024 * 2;
constexpr size_t WS_RSQ1 = WS_RSTD0 + (size_t)T * 4;
constexpr size_t WS_RSQ2 = WS_RSQ1 + (size_t)T * 4;
constexpr size_t WS_BOSQ = WS_RSQ2 + (size_t)T * 4;
constexpr size_t WS_Q = WS_BOSQ + (size_t)T * 16;
constexpr size_t WS_K = WS_Q + (size_t)T * 1024 * 2;
constexpr size_t WS_V = WS_K + (size_t)T * 256 * 2;
constexpr size_t WS_BQ = WS_V + (size_t)T * 256 * 2;
constexpr size_t WS_BK = WS_BQ + (size_t)T * 512 * 2;
constexpr size_t WS_BV = WS_BK + (size_t)T * 512 * 2;
constexpr size_t WS_GATE = WS_BV + (size_t)T * 1024 * 2;
constexpr size_t WS_BLR = WS_GATE + (size_t)T * 2048 * 2;
constexpr size_t WS_END = WS_BLR + (size_t)T * 512 * 2;
constexpr size_t WS_BAR = WS_END;
constexpr size_t WS_TOTAL = WS_BAR + 16384;
constexpr size_t WS_Z2 = WS_Q;
constexpr size_t WS_Y2 = WS_GATE;
static_assert(WS_Z2 + (size_t)T * 3072 * 2 <= WS_GATE, "Z2 alias");

constexpr size_t O_Y = 0;
constexpr size_t O_KP = (size_t)T * 1024;
constexpr size_t O_VP = O_KP + 524288;
constexpr size_t O_GP = O_VP + 524288;
constexpr size_t O_CP = O_GP + 2097152;
constexpr size_t O_LP = O_CP + 73728;
constexpr size_t O_KS = O_LP + 24576;
constexpr size_t O_VS = O_KS + 524288;
constexpr size_t O_GS = O_VS + 524288;
constexpr size_t O_CS = O_GS + 4194304;
constexpr size_t O_LS = O_CS + 147456;
constexpr size_t O_END = O_LS + 49152;

struct Params {
    const float* in[25];
    float* out;
    unsigned char* ws;
    int ph_lo, ph_hi;
};

__device__ __forceinline__ unsigned cvt_pk_bf16(float lo, float hi) { unsigned r; asm volatile("v_cvt_pk_bf16_f32 %0, %1, %2" : "=v"(r) : "v"(lo), "v"(hi)); return r; }
__device__ __forceinline__ bf16_t f2bf(float f) { return (bf16_t)(cvt_pk_bf16(f, 0.f) & 0xffffu); }
__device__ __forceinline__ float bf2f(bf16_t b) { return __uint_as_float(((unsigned)b) << 16); }
__device__ __forceinline__ float bflo(unsigned w) { return __uint_as_float(w << 16); }
__device__ __forceinline__ float bfhi(unsigned w) { return __uint_as_float(w & 0xffff0000u); }
__device__ __forceinline__ float rcpf_(float x) { return __builtin_amdgcn_rcpf(x); }
__device__ __forceinline__ float siluf(float x) { return x * rcpf_(1.f + __expf(-x)); }
__device__ __forceinline__ float sigmf(float x) { return rcpf_(1.f + __expf(-x)); }
__device__ __forceinline__ void lds_barrier() { asm volatile("s_waitcnt lgkmcnt(0)" ::: "memory"); __builtin_amdgcn_s_barrier(); asm volatile("" ::: "memory"); }
__device__ __forceinline__ bf16x8 pack8(const f32x4& a, const f32x4& b) {
    u32x4 p; p.x = cvt_pk_bf16(a[0], a[1]); p.y = cvt_pk_bf16(a[2], a[3]); p.z = cvt_pk_bf16(b[0], b[1]); p.w = cvt_pk_bf16(b[2], b[3]);
    return __builtin_bit_cast(bf16x8, p);
}
__device__ __forceinline__ bf16x8 cat4(const bf16x4 a, const bf16x4 b) { bf16x8 r; r[0] = a[0]; r[1] = a[1]; r[2] = a[2]; r[3] = a[3]; r[4] = b[0]; r[5] = b[1]; r[6] = b[2]; r[7] = b[3]; return r; }
__device__ __forceinline__ void unpack8(const u32x4 w, float (&v)[8]) { v[0] = bflo(w.x); v[1] = bfhi(w.x); v[2] = bflo(w.y); v[3] = bfhi(w.y); v[4] = bflo(w.z); v[5] = bfhi(w.z); v[6] = bflo(w.w); v[7] = bfhi(w.w); }
#define MFMA16(a, b, c) __builtin_amdgcn_mfma_f32_16x16x32_bf16((a), (b), (c), 0, 0, 0)

namespace pg8 {
constexpr int BM = 256, BK = 64, HALF = 128, HTB = HALF * BK * 2, STAGE_BYTES = 8 * HTB, NXCD = 8, WGM = 8;
__device__ __forceinline__ int lds_byte(int r, int c) { const int st = (r >> 4) * 2 + (c >> 5), rr = r & 15, cc = c & 31, ob = rr * 64 + cc * 2; return st * 1024 + (ob ^ (((ob >> 9) & 1) << 5)); }
__device__ __forceinline__ int perm32(int rho) { const int n = rho >> 4, i = rho & 15; return 8 * (i >> 2) + 4 * n + (i & 3); }
__device__ __forceinline__ void stage_rc(int b, int& R, int& C) { const int st = b / 1024, sb = b % 1024, swz = sb ^ (((sb >> 9) & 1) << 5); R = (st >> 1) * 16 + swz / 64; C = (st & 1) * 32 + (swz % 64) / 2; }
struct Unit { int pm, pn; };
struct Gemm { const bf16_t* A; const bf16_t* Bt; int M, N, K; };
struct StaticOrder {
    int nM, nN, nwg, G, c;
    __device__ void init(int M, int N, int G_, int c_) { nM = M / BM; nN = N / BM; nwg = nM * nN; G = G_; c = c_; }
    __device__ __forceinline__ bool next(int i, Unit& u) const {
        const long Lx = (long)i * G + c; if (Lx >= nwg) return false;
        int wgid = (int)Lx; { const int q = nwg / NXCD, r = nwg % NXCD, xcd = wgid % NXCD, off = wgid / NXCD; wgid = (xcd < r ? xcd * (q + 1) : r * (q + 1) + (xcd - r) * q) + off; }
        const int nig = WGM * nN, gid = wgid / nig, fm = gid * WGM, gsz = (nM - fm) < WGM ? (nM - fm) : WGM;
        u.pm = fm + ((wgid % nig) % gsz); u.pn = (wgid % nig) / gsz; return true;
    }
};

template <class Epi>
__device__ __forceinline__ void gemm_phase(LAS unsigned char* lds, const Gemm g, const StaticOrder& S, const Epi& E) {
    const int tid = threadIdx.x, wid = __builtin_amdgcn_readfirstlane(tid >> 6), lane = tid & 63, wr = wid >> 2, wc = wid & 3, fr = lane & 15, fq = lane >> 4;
    const int K = g.K, nt = K / BK;
    unsigned voffA[2], voffB[2];
#pragma unroll
    for (int i = 0; i < 2; ++i) { int R, C; stage_rc(tid * 16 + i * 8192, R, C); const int Rb = Epi::PERM ? ((R & ~31) + perm32(R & 31)) : R;
        voffA[i] = (unsigned)(R * K + C) * 2u; voffB[i] = (unsigned)(Rb * K + C) * 2u; }
    const size_t kstep = (size_t)(BK * 2);
    const size_t hstep = (size_t)HALF * K * 2;
    const size_t tstep = 2 * hstep;
    const unsigned ldsw = (unsigned)wid * 1024u;
    const int aoff = lds_byte(wr * 64 + fr, fq * 8), boff = lds_byte(wc * 32 + fr, fq * 8);
#define PG8_SA(b, h) (((b) * 2 + (h)) * HTB)
#define PG8_SB(b, h) ((4 + (b) * 2 + (h)) * HTB)
#define PG8_STAGE(bufoff, gbase, voff) do { _Pragma("unroll") for (int _i = 0; _i < 2; ++_i) \
        __builtin_amdgcn_global_load_lds((const unsigned*)((const char*)(gbase) + (voff)[_i]), (LAS unsigned*)(lds + (bufoff) + ldsw + _i * 8192), 16, 0, 0); } while (0)
#define PG8_LDA(dst, b, h) do { _Pragma("unroll") for (int m = 0; m < 4; ++m) _Pragma("unroll") for (int k = 0; k < 2; ++k) dst[m][k] = *(const LAS bf16x8*)(lds + PG8_SA(b, h) + aoff + m * 2048 + k * 1024); } while (0)
#define PG8_LDB(dst, b, h) do { _Pragma("unroll") for (int n = 0; n < 2; ++n) _Pragma("unroll") for (int k = 0; k < 2; ++k) dst[n][k] = *(const LAS bf16x8*)(lds + PG8_SB(b, h) + boff + n * 2048 + k * 1024); } while (0)
#define PG8_MMA(ai, bj, At, Bt) do { __builtin_amdgcn_s_setprio(1); _Pragma("unroll") for (int m = 0; m < 4; ++m) _Pragma("unroll") for (int n = 0; n < 2; ++n) _Pragma("unroll") for (int k = 0; k < 2; ++k) \
        acc[ai][bj][m][n] = __builtin_amdgcn_mfma_f32_16x16x32_bf16(Bt[n][k], At[m][k], acc[ai][bj][m][n], 0, 0, 0); __builtin_amdgcn_s_setprio(0); } while (0)
#define PG8_WAIT_V(n) asm volatile("s_waitcnt vmcnt(" #n ")" ::: "memory")
#define PG8_WAIT_L(n) asm volatile("s_waitcnt lgkmcnt(" #n ")" ::: "memory")
#define PG8_BAR __builtin_amdgcn_s_barrier()
#define PG8_SCHED __builtin_amdgcn_sched_barrier(0)
    Unit cur, nxt; int ui = 0;
    if (!S.next(0, cur)) return;
    f32x4 acc[2][2][4][2];
#pragma unroll
    for (int a = 0; a < 2; ++a)
#pragma unroll
        for (int b = 0; b < 2; ++b)
#pragma unroll
            for (int m = 0; m < 4; ++m)
#pragma unroll
                for (int n = 0; n < 2; ++n) acc[a][b][m][n] = (f32x4){0.f, 0.f, 0.f, 0.f};
    bf16x8 At[4][2], B0[2][2], B1[2][2];
    const char* cA = (const char*)g.A + (size_t)cur.pm * tstep; const char* cB = (const char*)g.Bt + (size_t)cur.pn * tstep;
    PG8_STAGE(PG8_SB(0, 0), cB, voffB); PG8_STAGE(PG8_SA(0, 0), cA, voffA); PG8_STAGE(PG8_SB(0, 1), cB + hstep, voffB); PG8_STAGE(PG8_SA(0, 1), cA + hstep, voffA);
    if (wr == 1) PG8_BAR;
    PG8_WAIT_V(4); PG8_BAR;
    PG8_STAGE(PG8_SB(1, 0), cB + kstep, voffB); PG8_STAGE(PG8_SA(1, 0), cA + kstep, voffA); PG8_STAGE(PG8_SB(1, 1), cB + hstep + kstep, voffB);
    PG8_WAIT_V(6); PG8_BAR;
    for (;;) {
        const bool has_next = S.next(ui + 1, nxt);
        const char* nA = has_next ? (const char*)g.A + (size_t)nxt.pm * tstep : cA; const char* nB = has_next ? (const char*)g.Bt + (size_t)nxt.pn * tstep : cB;
        for (int t = 0; t < nt; t += 2) {
            const bool last = (t == nt - 2);
            const char* a1 = cA + (size_t)(t + 1) * kstep;
            const char* a2 = last ? nA : cA + (size_t)(t + 2) * kstep; const char* b2 = last ? nB : cB + (size_t)(t + 2) * kstep;
            const char* a3 = a2 + kstep; const char* b3 = b2 + kstep;
            PG8_LDB(B0, 0, 0); PG8_SCHED; PG8_LDA(At, 0, 0); PG8_STAGE(PG8_SA(1, 1), a1 + hstep, voffA);
            PG8_WAIT_L(8); PG8_BAR; PG8_WAIT_L(0); PG8_MMA(0, 0, At, B0); PG8_BAR; PG8_SCHED;
            PG8_LDB(B1, 0, 1); PG8_STAGE(PG8_SB(0, 0), b2, voffB);
            PG8_BAR; PG8_WAIT_L(0); PG8_MMA(0, 1, At, B1); PG8_BAR;
            PG8_LDA(At, 0, 1); PG8_STAGE(PG8_SA(0, 0), a2, voffA);
            PG8_BAR; PG8_WAIT_L(0); PG8_MMA(1, 0, At, B0); PG8_BAR; PG8_SCHED;
            PG8_STAGE(PG8_SB(0, 1), b2 + hstep, voffB);
            PG8_WAIT_V(6); PG8_BAR; PG8_MMA(1, 1, At, B1); PG8_BAR;
            PG8_LDB(B0, 1, 0); PG8_SCHED; PG8_LDA(At, 1, 0); PG8_STAGE(PG8_SA(0, 1), a2 + hstep, voffA);
            PG8_WAIT_L(8); PG8_BAR; PG8_WAIT_L(0); PG8_MMA(0, 0, At, B0); PG8_BAR; PG8_SCHED;
            PG8_LDB(B1, 1, 1); PG8_STAGE(PG8_SB(1, 0), b3, voffB);
            PG8_BAR; PG8_WAIT_L(0); PG8_MMA(0, 1, At, B1); PG8_BAR;
            PG8_LDA(At, 1, 1); PG8_STAGE(PG8_SA(1, 0), a3, voffA);
            PG8_BAR; PG8_WAIT_L(0); PG8_MMA(1, 0, At, B0); PG8_BAR; PG8_SCHED;
            PG8_STAGE(PG8_SB(1, 1), b3 + hstep, voffB);
            PG8_WAIT_V(6); PG8_BAR; PG8_MMA(1, 1, At, B1); PG8_BAR;
        }
        E(acc, cur, wr, wc, fr, fq);
        if (!has_next) break;
#pragma unroll
        for (int a = 0; a < 2; ++a)
#pragma unroll
            for (int b = 0; b < 2; ++b)
#pragma unroll
                for (int m = 0; m < 4; ++m)
#pragma unroll
                    for (int n = 0; n < 2; ++n) acc[a][b][m][n] = (f32x4){0.f, 0.f, 0.f, 0.f};
        cur = nxt; cA = nA; cB = nB; ++ui;
    }
    PG8_WAIT_V(0);
    if (wr == 0) PG8_BAR;
    PG8_BAR;
#undef PG8_SA
#undef PG8_SB
#undef PG8_STAGE
#undef PG8_LDA
#undef PG8_LDB
#undef PG8_MMA
#undef PG8_WAIT_V
#undef PG8_WAIT_L
#undef PG8_BAR
#undef PG8_SCHED
}
}

typedef f32x4 AccT[2][2][4][2];

struct EpiInEven {
    static constexpr bool PERM = true;
    unsigned char* ws; float* out; const float* rstd; const float* blr_b;
    __device__ __forceinline__ void operator()(const AccT& acc, const pg8::Unit& u, int wr, int wc, int fr, int fq) const {
        const int pn = u.pn;
        bf16_t* base; int ld, coff; float sc = 1.f;
        if (pn < 4) { base = (bf16_t*)(ws + WS_Q); ld = 1024; coff = pn * 256; sc = 0.125f; }
        else if (pn == 4) { base = (bf16_t*)(ws + WS_K); ld = 256; coff = 0; }
        else if (pn == 5) { base = (bf16_t*)(ws + WS_V); ld = 256; coff = 0; }
        else if (pn < 8) { base = (bf16_t*)(ws + WS_BQ); ld = 512; coff = (pn - 6) * 256; sc = 0.08838834764831845f; }
        else if (pn < 10) { base = (bf16_t*)(ws + WS_BK); ld = 512; coff = (pn - 8) * 256; }
        else if (pn < 14) { base = (bf16_t*)(ws + WS_BV); ld = 1024; coff = (pn - 10) * 256; }
        else if (pn < 22) { base = (bf16_t*)(ws + WS_GATE); ld = 2048; coff = (pn - 14) * 256; }
        else { base = (bf16_t*)(ws + WS_BLR); ld = 512; coff = (pn - 22) * 256; }
        const int row0 = u.pm * 256 + wr * 64 + fr;
        const int ct = wc * 32 + 8 * fq;
        float rsv[8];
#pragma unroll
        for (int it = 0; it < 8; ++it) rsv[it] = rstd[row0 + (it >> 2) * 128 + (it & 3) * 16];
        if (pn >= 22) {
#pragma unroll
            for (int ai = 0; ai < 2; ++ai)
#pragma unroll
                for (int m = 0; m < 4; ++m) {
                    const int row = row0 + ai * 128 + m * 16; const float rs = rsv[ai * 4 + m];
#pragma unroll
                    for (int bj = 0; bj < 2; ++bj) {
                        const int cg = coff + ct + bj * 128;
                        const f32x4 b0 = *(const f32x4*)(blr_b + cg), b1 = *(const f32x4*)(blr_b + cg + 4);
                        f32x4 x0 = acc[ai][bj][m][0] * rs + b0, x1 = acc[ai][bj][m][1] * rs + b1;
#pragma unroll
                        for (int j = 0; j < 4; ++j) { x0[j] = (fminf(x0[j], 0.f) - __logf(1.f + __expf(-fabsf(x0[j])))) * (1.f / 16.f); x1[j] = (fminf(x1[j], 0.f) - __logf(1.f + __expf(-fabsf(x1[j])))) * (1.f / 16.f); }
                        u32x4 w; w.x = cvt_pk_bf16(x0[0], x0[1]); w.y = cvt_pk_bf16(x0[2], x0[3]); w.z = cvt_pk_bf16(x1[0], x1[1]); w.w = cvt_pk_bf16(x1[2], x1[3]);
                        *(u32x4*)(base + (size_t)row * 512 + cg) = w;
                    }
                }
            return;
        }
        const bool kv = (pn == 4 || pn == 5);
        float* okv_p = out + (pn == 4 ? O_KP : O_VP); float* okv_s = out + (pn == 4 ? O_KS : O_VS);
#pragma unroll
        for (int ai = 0; ai < 2; ++ai)
#pragma unroll
            for (int m = 0; m < 4; ++m) {
                const int row = row0 + ai * 128 + m * 16; const float rs = rsv[ai * 4 + m] * sc;
                bf16_t* rowp = base + (size_t)row * ld + coff + ct;
                float* orow = nullptr;
                if (kv) {
                    if (row >= T_P) orow = okv_s + (size_t)(row - T_P) * 256;
                    else { const int b = row >> 11, t = row & 2047; if (t >= 1920) orow = okv_p + (size_t)(b * 128 + t - 1920) * 256; }
                }
#pragma unroll
                for (int bj = 0; bj < 2; ++bj) {
                    const f32x4 v0 = acc[ai][bj][m][0] * rs, v1 = acc[ai][bj][m][1] * rs;
                    u32x4 w; w.x = cvt_pk_bf16(v0[0], v0[1]); w.y = cvt_pk_bf16(v0[2], v0[3]); w.z = cvt_pk_bf16(v1[0], v1[1]); w.w = cvt_pk_bf16(v1[2], v1[3]);
                    *(u32x4*)(rowp + bj * 128) = w;
                    if (kv && orow) { *(f32x4*)(orow + bj * 128 + ct) = v0; *(f32x4*)(orow + bj * 128 + ct + 4) = v1; }
                }
            }
    }
};

template <bool WRITE_BF>
struct EpiOutRes {
    static constexpr bool PERM = false;
    const float* xin_p; const float* xin_s; float* xo; bf16_t* xb; float* rowsq;
    __device__ __forceinline__ void operator()(const AccT& acc, const pg8::Unit& u, int wr, int wc, int fr, int fq) const {
        const int row0 = u.pm * 256 + wr * 64 + fr, col0 = u.pn * 256 + wc * 32 + 4 * fq;
        f32x4 r[3][4];
#define EOR_LOAD(S, IT) do { const int row_ = row0 + ((IT) >> 2) * 128 + ((IT) & 3) * 16; \
            const float* xr_ = (row_ < T_P) ? xin_p + (size_t)row_ * 1024 : xin_s + (size_t)(row_ - T_P) * 1024; \
            r[S][0] = *(const f32x4*)(xr_ + col0); r[S][1] = *(const f32x4*)(xr_ + col0 + 16); r[S][2] = *(const f32x4*)(xr_ + col0 + 128); r[S][3] = *(const f32x4*)(xr_ + col0 + 144); } while (0)
        EOR_LOAD(0, 0); EOR_LOAD(1, 1);
#pragma unroll
        for (int it = 0; it < 8; ++it) {
            if (it + 2 < 8) { if ((it + 2) % 3 == 0) EOR_LOAD(0, it + 2); else if ((it + 2) % 3 == 1) EOR_LOAD(1, it + 2); else EOR_LOAD(2, it + 2); }
            const int ai = it >> 2, m = it & 3;
            const int row = row0 + ai * 128 + m * 16;
            float ss = 0.f;
#pragma unroll
            for (int bj = 0; bj < 2; ++bj)
#pragma unroll
                for (int n = 0; n < 2; ++n) {
                    const int col = col0 + bj * 128 + n * 16;
                    const f32x4 v = acc[ai][bj][m][n] + r[it % 3][bj * 2 + n];
                    *(f32x4*)(xo + (size_t)row * 1024 + col) = v;
                    if (WRITE_BF) { u32x2 w; w.x = cvt_pk_bf16(v[0], v[1]); w.y = cvt_pk_bf16(v[2], v[3]); *(u32x2*)(xb + (size_t)row * 1024 + col) = w; }
                    ss += v[0] * v[0] + v[1] * v[1] + v[2] * v[2] + v[3] * v[3];
                }
            ss += __shfl_xor(ss, 16); ss += __shfl_xor(ss, 32);
            if (fq == 0) atomicAdd(rowsq + row, ss);
        }
#undef EOR_LOAD
    }
};

struct EpiInOdd {
    static constexpr bool PERM = true;
    bf16_t* z2; const float* rowsq;
    __device__ __forceinline__ void operator()(const AccT& acc, const pg8::Unit& u, int wr, int wc, int fr, int fq) const {
        const int row0 = u.pm * 256 + wr * 64 + fr, col0 = u.pn * 256 + wc * 32 + 8 * fq;
        float rsv[8];
#pragma unroll
        for (int it = 0; it < 8; ++it) rsv[it] = rowsq[row0 + (it >> 2) * 128 + (it & 3) * 16];
#pragma unroll
        for (int ai = 0; ai < 2; ++ai)
#pragma unroll
            for (int m = 0; m < 4; ++m) {
                const int row = row0 + ai * 128 + m * 16; const float rs = rsqrtf(rsv[ai * 4 + m] * (1.f / 1024.f) + EPS);
#pragma unroll
                for (int bj = 0; bj < 2; ++bj) {
                    const f32x4 v0 = acc[ai][bj][m][0] * rs, v1 = acc[ai][bj][m][1] * rs;
                    u32x4 w; w.x = cvt_pk_bf16(v0[0], v0[1]); w.y = cvt_pk_bf16(v0[2], v0[3]); w.z = cvt_pk_bf16(v1[0], v1[1]); w.w = cvt_pk_bf16(v1[2], v1[3]);
                    *(u32x4*)(z2 + (size_t)row * 3072 + col0 + bj * 128) = w;
                }
            }
    }
};

template <int MODE>
__device__ __forceinline__ void transpose_w(const float* __restrict__ src, int K, int Nsrc, bf16_t* __restrict__ dst, int Ndst, const float* __restrict__ gain, long gtid, long gsz) {
    const long total = (long)(K / 8) * Ndst;
#pragma unroll 4
    for (long it = gtid; it < total; it += gsz) {
        const int n = (int)(it % Ndst), k8 = (int)(it / Ndst);
        int sc = n;
        if (MODE == 1) { if (n < 3584) sc = n; else sc = n + 16; }
        u32x4 w = {0u, 0u, 0u, 0u};
        if (sc >= 0) {
            const float* s = src + (size_t)(k8 * 8) * Nsrc + sc;
            float v0 = s[0], v1 = s[(size_t)Nsrc], v2 = s[(size_t)2 * Nsrc], v3 = s[(size_t)3 * Nsrc], v4 = s[(size_t)4 * Nsrc], v5 = s[(size_t)5 * Nsrc], v6 = s[(size_t)6 * Nsrc], v7 = s[(size_t)7 * Nsrc];
            if (gain) { const f32x4 g0 = *(const f32x4*)(gain + k8 * 8), g1 = *(const f32x4*)(gain + k8 * 8 + 4); v0 *= g0[0]; v1 *= g0[1]; v2 *= g0[2]; v3 *= g0[3]; v4 *= g1[0]; v5 *= g1[1]; v6 *= g1[2]; v7 *= g1[3]; }
            w.x = cvt_pk_bf16(v0, v1); w.y = cvt_pk_bf16(v2, v3); w.z = cvt_pk_bf16(v4, v5); w.w = cvt_pk_bf16(v6, v7);
        }
        *(u32x4*)(dst + (size_t)n * K + k8 * 8) = w;
    }
}

__device__ __forceinline__ void phase0(const Params& p) {
    unsigned char* ws = p.ws;
    const long gtid = (long)blockIdx.x * NTHR + threadIdx.x, gsz = (long)gridDim.x * NTHR;
    transpose_w<1>(p.in[8], 1024, 5648, (bf16_t*)(ws + WS_WINE), 5632, p.in[7], gtid, gsz);
    for (long it = gtid; it < 128L * 512; it += gsz) {
        const int n = (int)(it & 511), k8 = (int)(it >> 9);
        float wl[16];
#pragma unroll
        for (int r = 0; r < 16; ++r) wl[r] = p.in[9][r * 512 + n];
        float v[8];
#pragma unroll
        for (int i = 0; i < 8; ++i) {
            const float* wr_ = p.in[8] + (size_t)(k8 * 8 + i) * 5648 + 3584;
            float a = 0.f;
#pragma unroll
            for (int r4 = 0; r4 < 4; ++r4) { const f32x4 x = *(const f32x4*)(wr_ + r4 * 4); a += x[0] * wl[r4 * 4] + x[1] * wl[r4 * 4 + 1] + x[2] * wl[r4 * 4 + 2] + x[3] * wl[r4 * 4 + 3]; }
            v[i] = a * p.in[7][k8 * 8 + i];
        }
        u32x4 w; w.x = cvt_pk_bf16(v[0], v[1]); w.y = cvt_pk_bf16(v[2], v[3]); w.z = cvt_pk_bf16(v[4], v[5]); w.w = cvt_pk_bf16(v[6], v[7]);
        *(u32x4*)((bf16_t*)(ws + WS_WINE) + (size_t)(5632 + n) * 1024 + k8 * 8) = w;
    }
    transpose_w<0>(p.in[13], 2048, 1024, (bf16_t*)(ws + WS_WOUTE), 1024, nullptr, gtid, gsz);
    transpose_w<0>(p.in[15], 1024, 3072, (bf16_t*)(ws + WS_WINO), 3072, p.in[14], gtid, gsz);
    transpose_w<0>(p.in[23], 1536, 1024, (bf16_t*)(ws + WS_WOUTO), 1024, nullptr, gtid, gsz);
    for (int nb = 0; nb < 8; ++nb) {
        transpose_w<0>(p.in[18] + nb * 192 * 192, 192, 192, (bf16_t*)(ws + WS_WA) + nb * 192 * 192, 192, nullptr, gtid, gsz);
        transpose_w<0>(p.in[20] + nb * 192 * 192, 192, 192, (bf16_t*)(ws + WS_WI) + nb * 192 * 192, 192, nullptr, gtid, gsz);
    }
    { float* z = (float*)(ws + WS_RSQ1); const long nz = (long)T * 2; for (long i = gtid; i < nz; i += gsz) z[i] = 0.f; }
    const int lane = threadIdx.x & 63; const int gw = (int)(gtid >> 6), nw = (int)(gsz >> 6);
    bf16_t* xb = (bf16_t*)(ws + WS_XB); float* rstd = (float*)(ws + WS_RSTD0);
#pragma unroll 4
    for (int row = gw; row < T; row += nw) {
        const float* xr = (row < T_P) ? p.in[0] + (size_t)row * 1024 : p.in[1] + (size_t)(row - T_P) * 1024;
        float ss = 0.f;
#pragma unroll
        for (int i = 0; i < 4; ++i) {
            const f32x4 v = *(const f32x4*)(xr + i * 256 + lane * 4);
            ss += v[0] * v[0] + v[1] * v[1] + v[2] * v[2] + v[3] * v[3];
            u32x2 w; w.x = cvt_pk_bf16(v[0], v[1]); w.y = cvt_pk_bf16(v[2], v[3]);
            *(u32x2*)(xb + (size_t)row * 1024 + i * 256 + lane * 4) = w;
        }
#pragma unroll
        for (int o = 32; o >= 1; o >>= 1) ss += __shfl_xor(ss, o);
        if (lane == 0) rstd[row] = rsqrtf(ss * (1.f / 1024.f) + EPS);
    }
}

__device__ __forceinline__ void attn_item(const Params& p, LAS unsigned char* L, int item, bf16_t* Yd, int ldd) {
    unsigned char* ws = p.ws;
    const int tid = threadIdx.x, lane = tid & 63, w = tid >> 6, r16 = lane & 15, q4 = lane >> 4;
    LAS bf16_t* Ks = (LAS bf16_t*)L;
    LAS bf16_t* Vs = (LAS bf16_t*)(L + 192 * 72 * 2);
    const unsigned vbase = (unsigned)(size_t)L + 192u * 72u * 2u;
    const bf16_t* Qb = (const bf16_t*)(ws + WS_Q); const bf16_t* Kb = (const bf16_t*)(ws + WS_K); const bf16_t* Vb = (const bf16_t*)(ws + WS_V);
    const bf16_t* Yb = (const bf16_t*)(ws + WS_GATE);
    const bool smp = item >= 2048;
    int b, c, kh; size_t row0;
    if (!smp) { kh = item & 3; c = (item >> 2) & 31; b = item >> 7; row0 = (size_t)b * 2048 + c * 64; }
    else { const int i2 = item - 2048; kh = i2 & 3; b = i2 >> 2; c = 0; row0 = (size_t)T_P + b * 64; }
    const int g = w >> 1, i0 = (w & 1) * 32, h = kh * 4 + g;
    bf16x8 qf[2][2];
#pragma unroll
    for (int qt = 0; qt < 2; ++qt) {
#pragma unroll
        for (int ks = 0; ks < 2; ++ks) qf[qt][ks] = *(const bf16x8*)(Qb + (row0 + i0 + qt * 16 + r16) * 1024 + h * 64 + ks * 32 + q4 * 8);
    }
#pragma unroll
    for (int i = 0; i < 3; ++i) {
        const int idx = tid + i * 512, key = idx >> 3, dg = idx & 7;
        u32x4 kv = {0u, 0u, 0u, 0u}, vv = {0u, 0u, 0u, 0u};
        if (!smp) {
            const int pos = c * 64 - 128 + key;
            if (pos >= 0) { const size_t r = (size_t)b * 2048 + pos; kv = *(const u32x4*)(Kb + r * 256 + kh * 64 + dg * 8); vv = *(const u32x4*)(Vb + r * 256 + kh * 64 + dg * 8); }
        } else {
            if (key < 128) {
                const size_t o = ((size_t)(b * 128 + key) * 4 + kh) * 64 + dg * 8;
                const f32x4 k0 = *(const f32x4*)(p.in[2] + o), k1 = *(const f32x4*)(p.in[2] + o + 4), v0 = *(const f32x4*)(p.in[3] + o), v1 = *(const f32x4*)(p.in[3] + o + 4);
                kv.x = cvt_pk_bf16(k0[0], k0[1]); kv.y = cvt_pk_bf16(k0[2], k0[3]); kv.z = cvt_pk_bf16(k1[0], k1[1]); kv.w = cvt_pk_bf16(k1[2], k1[3]);
                vv.x = cvt_pk_bf16(v0[0], v0[1]); vv.y = cvt_pk_bf16(v0[2], v0[3]); vv.z = cvt_pk_bf16(v1[0], v1[1]); vv.w = cvt_pk_bf16(v1[2], v1[3]);
            } else { const size_t r = (size_t)T_P + b * 64 + key - 128; kv = *(const u32x4*)(Kb + r * 256 + kh * 64 + dg * 8); vv = *(const u32x4*)(Vb + r * 256 + kh * 64 + dg * 8); }
        }
        *(LAS u32x4*)(Ks + key * 72 + dg * 8) = kv;
        *(LAS u32x4*)(Vs + key * 72 + dg * 8) = vv;
    }
    __syncthreads();
    const float slope = exp2f(-0.5f * (float)(h + 1));
    const float sink = p.in[11][h];
    const unsigned va = vbase + (unsigned)(((q4 * 4 + (r16 >> 2)) * 72 + 4 * (r16 & 3)) * 2);
#pragma unroll 1
    for (int qt = 0; qt < 2; ++qt) {
        const int i = i0 + qt * 16 + r16;
        const bf16x8 qa = qt ? qf[1][0] : qf[0][0], qb = qt ? qf[1][1] : qf[0][1];
        u32x2 gv[4];
#pragma unroll
        for (int dt = 0; dt < 4; ++dt) gv[dt] = *(const u32x2*)(Yb + (row0 + i) * 2048 + h * 64 + dt * 16 + q4 * 4);
        f32x4 sacc[12];
#pragma unroll
        for (int kt = 0; kt < 12; ++kt) {
            const bf16x8 kf0 = *(const LAS bf16x8*)(Ks + (kt * 16 + r16) * 72 + q4 * 8), kf1 = *(const LAS bf16x8*)(Ks + (kt * 16 + r16) * 72 + 32 + q4 * 8);
            f32x4 a = {0.f, 0.f, 0.f, 0.f}; a = MFMA16(kf0, qa, a); a = MFMA16(kf1, qb, a); sacc[kt] = a;
        }
        float m = -3e38f;
#pragma unroll
        for (int kt = 0; kt < 12; ++kt)
#pragma unroll
            for (int jj = 0; jj < 4; ++jj) {
                const int j = kt * 16 + q4 * 4 + jj;
                float sv = sacc[kt][jj] - slope * fabsf((float)(128 + i - j));
                if (!smp && (c * 64 - 128 + j) < 0) sv = -1e30f;
                sacc[kt][jj] = sv; m = fmaxf(m, sv);
            }
        m = fmaxf(m, __shfl_xor(m, 16)); m = fmaxf(m, __shfl_xor(m, 32)); m = fmaxf(m, sink);
        float l = 0.f;
#pragma unroll
        for (int kt = 0; kt < 12; ++kt)
#pragma unroll
            for (int jj = 0; jj < 4; ++jj) { const float pr = __expf(sacc[kt][jj] - m); sacc[kt][jj] = pr; l += pr; }
        l += __shfl_xor(l, 16); l += __shfl_xor(l, 32); l += __expf(sink - m);
        const float inv = 1.f / l;
        f32x4 oacc[4];
#pragma unroll
        for (int dt = 0; dt < 4; ++dt) oacc[dt] = (f32x4){0.f, 0.f, 0.f, 0.f};
#pragma unroll
        for (int kb = 0; kb < 6; ++kb) {
            const bf16x8 pf = pack8(sacc[2 * kb], sacc[2 * kb + 1]);
            bf16x4 l0, h0, l1, h1, l2, h2, l3, h3;
            const unsigned vk = va + (unsigned)(kb * 32 * 144);
            asm volatile("ds_read_b64_tr_b16 %0, %8\n\tds_read_b64_tr_b16 %1, %8 offset:2304\n\t"
                         "ds_read_b64_tr_b16 %2, %8 offset:32\n\tds_read_b64_tr_b16 %3, %8 offset:2336\n\t"
                         "ds_read_b64_tr_b16 %4, %8 offset:64\n\tds_read_b64_tr_b16 %5, %8 offset:2368\n\t"
                         "ds_read_b64_tr_b16 %6, %8 offset:96\n\tds_read_b64_tr_b16 %7, %8 offset:2400\n\t"
                         "s_waitcnt lgkmcnt(0)"
                         : "=&v"(l0), "=&v"(h0), "=&v"(l1), "=&v"(h1), "=&v"(l2), "=&v"(h2), "=&v"(l3), "=&v"(h3) : "v"(vk) : "memory");
            oacc[0] = MFMA16(cat4(l0, h0), pf, oacc[0]); oacc[1] = MFMA16(cat4(l1, h1), pf, oacc[1]);
            oacc[2] = MFMA16(cat4(l2, h2), pf, oacc[2]); oacc[3] = MFMA16(cat4(l3, h3), pf, oacc[3]);
        }
#pragma unroll
        for (int dt = 0; dt < 4; ++dt) {
            const u32x2 gq = gv[dt];
            const f32x4 o = oacc[dt] * inv;
            u32x2 wv; wv.x = cvt_pk_bf16(o[0] * siluf(bflo(gq.x)), o[1] * siluf(bfhi(gq.x))); wv.y = cvt_pk_bf16(o[2] * siluf(bflo(gq.y)), o[3] * siluf(bfhi(gq.y)));
            *(u32x2*)(Yd + (row0 + i) * ldd + h * 64 + dt * 16 + q4 * 4) = wv;
        }
    }
    __syncthreads();
}

constexpr size_t WS_ET = WS_XB + 9437184;
constexpr size_t WS_AB = WS_XB + 16777216;
static_assert(WS_AB + (size_t)T * 256 * 2 <= WS_RSTD0, "XB scratch overflow");

__device__ __forceinline__ void gla_prep_item(const Params& p, LAS unsigned char* L, int item) {
    unsigned char* ws = p.ws;
    const int tid = threadIdx.x, lane = tid & 63, w = tid >> 6, r16 = lane & 15, q4 = lane >> 4;
    LAS bf16_t* QG = (LAS bf16_t*)L;
    LAS bf16_t* KG = (LAS bf16_t*)(L + 17408);
    LAS bf16_t* Gs = (LAS bf16_t*)(L + 34816);
    LAS float* Gf = (LAS float*)(L + 52224);
    LAS float* GT = (LAS float*)(L + 84992);
    int b, h; unsigned row0;
    if (item < 2048) { h = item & 3; const int c = (item >> 2) & 31; b = item >> 7; row0 = (unsigned)b * 2048 + c * 64; }
    else { const int i2 = item - 2048; h = i2 & 3; b = i2 >> 2; row0 = (unsigned)T_P + b * 64; }
    bf16_t* BQ = (bf16_t*)(ws + WS_BQ); bf16_t* BKb = (bf16_t*)(ws + WS_BK); const bf16_t* GB = (const bf16_t*)(ws + WS_BLR);
    float* ET = (float*)(ws + WS_ET); bf16_t* AB = (bf16_t*)(ws + WS_AB);
    const int c = tid & 127, tg = tid >> 7;
    const int pt0 = tid >> 4, pt1 = (tid + 512) >> 4, poc = tid & 15;
    const unsigned o0 = (row0 + pt0) * 512u + h * 128 + poc * 8, o1 = (row0 + pt1) * 512u + h * 128 + poc * 8;
    const u32x4 pg0 = *(const u32x4*)(GB + o0), pg1 = *(const u32x4*)(GB + o1);
    const u32x4 pq0 = *(const u32x4*)(BQ + o0), pq1 = *(const u32x4*)(BQ + o1), pk0 = *(const u32x4*)(BKb + o0), pk1 = *(const u32x4*)(BKb + o1);
    *(LAS u32x4*)(Gs + pt0 * 136 + poc * 8) = pg0; *(LAS u32x4*)(Gs + pt1 * 136 + poc * 8) = pg1;
    lds_barrier();
    {
        float cs = 0.f;
#pragma unroll
        for (int tt = 0; tt < 16; ++tt) { cs += bf2f(Gs[(tg * 16 + tt) * 136 + c]); Gf[(tg * 16 + tt) * 128 + c] = cs; }
        GT[tg * 128 + c] = cs;
    }
    lds_barrier();
#pragma unroll
    for (int i = 0; i < 2; ++i) {
        const int t = i ? pt1 : pt0; const int tgp = t >> 4;
        const u32x4 qw = i ? pq1 : pq0, kw = i ? pk1 : pk0;
        float G[8], tot[8];
        { const f32x4 a0 = *(const LAS f32x4*)(Gf + t * 128 + poc * 8), a1 = *(const LAS f32x4*)(Gf + t * 128 + poc * 8 + 4);
          G[0] = a0[0]; G[1] = a0[1]; G[2] = a0[2]; G[3] = a0[3]; G[4] = a1[0]; G[5] = a1[1]; G[6] = a1[2]; G[7] = a1[3]; }
#pragma unroll
        for (int j = 0; j < 8; ++j) tot[j] = 0.f;
#pragma unroll
        for (int g2 = 0; g2 < 4; ++g2) {
            const f32x4 a0 = *(const LAS f32x4*)(GT + g2 * 128 + poc * 8), a1 = *(const LAS f32x4*)(GT + g2 * 128 + poc * 8 + 4);
            const float sel = (g2 < tgp) ? 1.f : 0.f;
            G[0] += sel * a0[0]; G[1] += sel * a0[1]; G[2] += sel * a0[2]; G[3] += sel * a0[3]; G[4] += sel * a1[0]; G[5] += sel * a1[1]; G[6] += sel * a1[2]; G[7] += sel * a1[3];
            tot[0] += a0[0]; tot[1] += a0[1]; tot[2] += a0[2]; tot[3] += a0[3]; tot[4] += a1[0]; tot[5] += a1[1]; tot[6] += a1[2]; tot[7] += a1[3];
        }
        if (i == 0 && tid < 16) {
            float* ep = ET + (size_t)(row0 >> 6) * 512 + h * 128 + poc * 8;
            *(f32x4*)ep = (f32x4){__expf(tot[0]), __expf(tot[1]), __expf(tot[2]), __expf(tot[3])};
            *(f32x4*)(ep + 4) = (f32x4){__expf(tot[4]), __expf(tot[5]), __expf(tot[6]), __expf(tot[7])};
        }
        float qv[8], kv[8];
        unpack8(qw, qv); unpack8(kw, kv);
#pragma unroll
        for (int j = 0; j < 8; ++j) { const float eg = __expf(G[j]); qv[j] *= eg; kv[j] *= rcpf_(eg); }
        u32x4 qo, ko;
        qo.x = cvt_pk_bf16(qv[0], qv[1]); qo.y = cvt_pk_bf16(qv[2], qv[3]); qo.z = cvt_pk_bf16(qv[4], qv[5]); qo.w = cvt_pk_bf16(qv[6], qv[7]);
        ko.x = cvt_pk_bf16(kv[0], kv[1]); ko.y = cvt_pk_bf16(kv[2], kv[3]); ko.z = cvt_pk_bf16(kv[4], kv[5]); ko.w = cvt_pk_bf16(kv[6], kv[7]);
        *(LAS u32x4*)(QG + t * 136 + poc * 8) = qo; *(LAS u32x4*)(KG + t * 136 + poc * 8) = ko;
        *(u32x4*)(BQ + (i ? o1 : o0)) = qo; *(u32x4*)(BKb + (i ? o1 : o0)) = ko;
    }
    lds_barrier();
    {
        const int it = w >> 1, jt0 = (w & 1) * 2;
        f32x4 at[2];
        at[0] = (f32x4){0.f, 0.f, 0.f, 0.f}; at[1] = (f32x4){0.f, 0.f, 0.f, 0.f};
#pragma unroll
        for (int ks = 0; ks < 4; ++ks) {
            const bf16x8 qf = *(const LAS bf16x8*)(QG + (it * 16 + r16) * 136 + ks * 32 + q4 * 8);
#pragma unroll
            for (int t2 = 0; t2 < 2; ++t2) {
                const bf16x8 kf = *(const LAS bf16x8*)(KG + ((jt0 + t2) * 16 + r16) * 136 + ks * 32 + q4 * 8);
                at[t2] = MFMA16(kf, qf, at[t2]);
            }
        }
        const int i = it * 16 + r16;
#pragma unroll
        for (int t2 = 0; t2 < 2; ++t2) {
            f32x4 v = at[t2];
#pragma unroll
            for (int jj = 0; jj < 4; ++jj) { const int j = (jt0 + t2) * 16 + q4 * 4 + jj; if (j > i) v[jj] = 0.f; }
            u32x2 wv; wv.x = cvt_pk_bf16(v[0], v[1]); wv.y = cvt_pk_bf16(v[2], v[3]);
            *(u32x2*)(AB + (size_t)(row0 + i) * 256 + h * 64 + (jt0 + t2) * 16 + q4 * 4) = wv;
        }
    }
    lds_barrier();
}

__device__ __forceinline__ void gla_scan_item(const Params& p, LAS unsigned char* L, int item, bool dummy) {
    unsigned char* ws = p.ws;
    const int tid = threadIdx.x, lane = tid & 63, w = tid >> 6, r16 = lane & 15, q4 = lane >> 4;
    LAS bf16_t* QG = (LAS bf16_t*)L;
    LAS bf16_t* KG = (LAS bf16_t*)(L + 17408);
    LAS bf16_t* Vs = (LAS bf16_t*)(L + 34816);
    LAS bf16_t* As = (LAS bf16_t*)(L + 44032);
    LAS float* GL = (LAS float*)(L + 53248);
    const unsigned lbase = (unsigned)(size_t)L;
    const bool smp = item >= 256;
    const int i2 = smp ? item - 256 : item;
    const int b = i2 >> 4, h = (i2 >> 2) & 3, sl = i2 & 3, e0 = sl * 64;
    const int nch = smp ? 1 : 32;
    const unsigned rbase = smp ? (unsigned)T_P + b * 64 : (unsigned)b * 2048;
    const bf16_t* BQ = (const bf16_t*)(ws + WS_BQ); const bf16_t* BKb = (const bf16_t*)(ws + WS_BK); bf16_t* BV = (bf16_t*)(ws + WS_BV);
    const float* ET = (const float*)(ws + WS_ET); const bf16_t* AB = (const bf16_t*)(ws + WS_AB); float* BOSQP = dummy ? p.out + 20000000 : (float*)(ws + WS_XB);
    bf16_t* BVo = dummy ? (bf16_t*)p.out : BV;
    const int pt0 = tid >> 4, pt1 = (tid + 512) >> 4, poc = tid & 15;
    const int vt = tid >> 3, veo = tid & 7;
    const int et = w & 3, ip = w >> 2;
    f32x4 Sacc[8];
#pragma unroll
    for (int d8 = 0; d8 < 8; ++d8) {
        if (smp) {
#pragma unroll
            for (int jj = 0; jj < 4; ++jj) Sacc[d8][jj] = p.in[4][((size_t)(b * 4 + h) * 128 + d8 * 16 + q4 * 4 + jj) * 256 + e0 + et * 16 + r16];
        } else Sacc[d8] = (f32x4){0.f, 0.f, 0.f, 0.f};
    }
    const int tq_ = r16 >> 2, tp_ = r16 & 3;
    const unsigned v4a = lbase + 34816u + (unsigned)(((q4 * 8 + tq_) * 72 + et * 16 + 4 * tp_) * 2);
    const unsigned k4a = lbase + 17408u + (unsigned)(((q4 * 8 + tq_) * 136 + 4 * tp_) * 2);
    struct Pre { u32x4 q0, q1, k0, k1, a, v; f32x4 e; };
    Pre PA, PB;
    PA.e = (f32x4){0.f, 0.f, 0.f, 0.f}; PB.e = (f32x4){0.f, 0.f, 0.f, 0.f};
#define GLA_PREFETCH(P, R) do { \
        const unsigned o0_ = ((R) + pt0) * 512u + h * 128 + poc * 8, o1_ = ((R) + pt1) * 512u + h * 128 + poc * 8; \
        P.q0 = *(const u32x4*)(BQ + o0_); P.q1 = *(const u32x4*)(BQ + o1_); P.k0 = *(const u32x4*)(BKb + o0_); P.k1 = *(const u32x4*)(BKb + o1_); \
        P.a = *(const u32x4*)(AB + ((R) + vt) * 256u + h * 64 + veo * 8); \
        P.v = *(const u32x4*)(BV + ((R) + vt) * 1024u + h * 256 + e0 + veo * 8); \
        if (tid < 32) P.e = *(const f32x4*)(ET + ((R) >> 6) * 512u + h * 128 + tid * 4); } while (0)
    GLA_PREFETCH(PA, rbase);
    if (nch > 1) GLA_PREFETCH(PB, rbase + 64);
    f32x4 po0 = {0.f, 0.f, 0.f, 0.f}, po1 = {0.f, 0.f, 0.f, 0.f}; unsigned prow = 0; bool pend = false;
#define GLA_STORE_OUT() do { \
            _Pragma("unroll") for (int x2 = 0; x2 < 2; ++x2) { \
                const unsigned row = prow + (ip * 2 + x2) * 16 + r16; \
                const f32x4 o = x2 ? po1 : po0; \
                u32x2 wv; wv.x = cvt_pk_bf16(o[0], o[1]); wv.y = cvt_pk_bf16(o[2], o[3]); \
                *(u32x2*)(BVo + row * 1024u + h * 256 + e0 + et * 16 + q4 * 4) = wv; \
                float ss = o[0] * o[0] + o[1] * o[1] + o[2] * o[2] + o[3] * o[3]; \
                ss += __shfl_xor(ss, 16); ss += __shfl_xor(ss, 32); \
                if (q4 == 0) BOSQP[row * 64u + h * 16 + sl * 4 + et] = ss; \
            } } while (0)
#define GLA_CHUNK(P, CI) do { \
        const unsigned r0 = rbase + (unsigned)(CI) * 64; \
        *(LAS u32x4*)(QG + pt0 * 136 + poc * 8) = P.q0; *(LAS u32x4*)(QG + pt1 * 136 + poc * 8) = P.q1; \
        *(LAS u32x4*)(KG + pt0 * 136 + poc * 8) = P.k0; *(LAS u32x4*)(KG + pt1 * 136 + poc * 8) = P.k1; \
        *(LAS u32x4*)(As + vt * 72 + veo * 8) = P.a; *(LAS u32x4*)(Vs + vt * 72 + veo * 8) = P.v; \
        if (tid < 32) *(LAS f32x4*)(GL + tid * 4) = P.e; \
        lds_barrier(); \
        if (pend) GLA_STORE_OUT(); \
        if ((CI) + 2 < nch) GLA_PREFETCH(P, r0 + 128); \
        bf16x8 vf[2]; \
        { bf16x4 a0, a1, b0, b1; \
          asm volatile("ds_read_b64_tr_b16 %0, %4\n\tds_read_b64_tr_b16 %1, %4 offset:576\n\tds_read_b64_tr_b16 %2, %4 offset:4608\n\tds_read_b64_tr_b16 %3, %4 offset:5184\n\ts_waitcnt lgkmcnt(0)" \
                       : "=&v"(a0), "=&v"(a1), "=&v"(b0), "=&v"(b1) : "v"(v4a) : "memory"); \
          vf[0] = cat4(a0, a1); vf[1] = cat4(b0, b1); } \
        f32x4 ot[2]; \
        ot[0] = (f32x4){0.f, 0.f, 0.f, 0.f}; ot[1] = (f32x4){0.f, 0.f, 0.f, 0.f}; \
        _Pragma("unroll") for (int x2 = 0; x2 < 2; ++x2) \
            _Pragma("unroll") for (int jb = 0; jb < 2; ++jb) { \
                const bf16x8 af = *(const LAS bf16x8*)(As + ((ip * 2 + x2) * 16 + r16) * 72 + jb * 32 + q4 * 8); \
                ot[x2] = MFMA16(vf[jb], af, ot[x2]); } \
        _Pragma("unroll") for (int db = 0; db < 4; ++db) { \
            const bf16x8 sf = pack8(Sacc[2 * db], Sacc[2 * db + 1]); \
            _Pragma("unroll") for (int x2 = 0; x2 < 2; ++x2) { \
                const LAS bf16_t* qp = QG + ((ip * 2 + x2) * 16 + r16) * 136 + db * 32 + q4 * 4; \
                const bf16x8 qv = cat4(*(const LAS bf16x4*)qp, *(const LAS bf16x4*)(qp + 16)); \
                ot[x2] = MFMA16(sf, qv, ot[x2]); } } \
        po0 = ot[0]; po1 = ot[1]; prow = r0; pend = true; \
        _Pragma("unroll") for (int jb = 0; jb < 2; ++jb) { \
            bf16x4 kl[8], kh[8]; \
            const unsigned ka = k4a + (unsigned)(jb * 32 * 272); \
            asm volatile("ds_read_b64_tr_b16 %0, %16 offset:0\n\t" "ds_read_b64_tr_b16 %1, %16 offset:1088\n\t" "ds_read_b64_tr_b16 %2, %16 offset:32\n\t" "ds_read_b64_tr_b16 %3, %16 offset:1120\n\t" "ds_read_b64_tr_b16 %4, %16 offset:64\n\t" "ds_read_b64_tr_b16 %5, %16 offset:1152\n\t" "ds_read_b64_tr_b16 %6, %16 offset:96\n\t" "ds_read_b64_tr_b16 %7, %16 offset:1184\n\t" "ds_read_b64_tr_b16 %8, %16 offset:128\n\t" "ds_read_b64_tr_b16 %9, %16 offset:1216\n\t" "ds_read_b64_tr_b16 %10, %16 offset:160\n\t" "ds_read_b64_tr_b16 %11, %16 offset:1248\n\t" "ds_read_b64_tr_b16 %12, %16 offset:192\n\t" "ds_read_b64_tr_b16 %13, %16 offset:1280\n\t" "ds_read_b64_tr_b16 %14, %16 offset:224\n\t" "ds_read_b64_tr_b16 %15, %16 offset:1312\n\t" "s_waitcnt lgkmcnt(0)" \
                         : "=&v"(kl[0]), "=&v"(kh[0]), "=&v"(kl[1]), "=&v"(kh[1]), "=&v"(kl[2]), "=&v"(kh[2]), "=&v"(kl[3]), "=&v"(kh[3]), "=&v"(kl[4]), "=&v"(kh[4]), "=&v"(kl[5]), "=&v"(kh[5]), "=&v"(kl[6]), "=&v"(kh[6]), "=&v"(kl[7]), "=&v"(kh[7]) : "v"(ka) : "memory"); \
            _Pragma("unroll") for (int d8 = 0; d8 < 8; ++d8) Sacc[d8] = MFMA16(cat4(kl[d8], kh[d8]), vf[jb], Sacc[d8]); } \
        _Pragma("unroll") for (int d8 = 0; d8 < 8; ++d8) { \
            const f32x4 dec = *(const LAS f32x4*)(GL + d8 * 16 + q4 * 4); \
            Sacc[d8] = Sacc[d8] * dec; } \
        lds_barrier(); \
    } while (0)
    for (int ci = 0; ci < nch; ci += 2) {
        GLA_CHUNK(PA, ci);
        if (ci + 1 < nch) GLA_CHUNK(PB, ci + 1);
    }
    if (pend) GLA_STORE_OUT();
#undef GLA_STORE_OUT
#undef GLA_PREFETCH
#undef GLA_CHUNK
    if (ip == 0 && !dummy) {
        float* og = p.out + (smp ? O_GS : O_GP);
#pragma unroll
        for (int d8 = 0; d8 < 8; ++d8)
#pragma unroll
            for (int jj = 0; jj < 4; ++jj) og[((size_t)(b * 4 + h) * 128 + d8 * 16 + q4 * 4 + jj) * 256 + e0 + et * 16 + r16] = Sacc[d8][jj];
    }
}

__device__ __forceinline__ void phase2a(const Params& p, LAS unsigned char* L) {
#ifndef NO_PREP
    for (int it = blockIdx.x; it < 2176; it += gridDim.x) gla_prep_item(p, L, it);
#endif
#ifndef NO_ATTN
    for (int it = blockIdx.x; it < 2176; it += gridDim.x) attn_item(p, L, it, (bf16_t*)(p.ws + WS_GATE), 2048);
#endif
}
__device__ __forceinline__ void phase2b(const Params& p, LAS unsigned char* L) {
#ifndef NO_SCAN
#ifdef PROBE_SCAN2
    for (int it = blockIdx.x; it < 768; it += gridDim.x) gla_scan_item(p, L, it, true);
#endif
    if (gridDim.x == 256) {
        const int xcd = blockIdx.x & 7, loc = blockIdx.x >> 3;
        const int base = (xcd * 8 + (loc >> 2)) * 4 + (loc & 3);
        gla_scan_item(p, L, base, false); gla_scan_item(p, L, 256 + base, false); gla_scan_item(p, L, 512 + base, false);
    } else {
        for (int it = blockIdx.x; it < 768; it += gridDim.x) gla_scan_item(p, L, it, false);
    }
#endif
}

__device__ __forceinline__ void phase3(const Params& p) {
    unsigned char* ws = p.ws;
    const bf16_t* BV = (const bf16_t*)(ws + WS_BV); bf16_t* Yb = (bf16_t*)(ws + WS_GATE); const float* BOSQP = (const float*)(ws + WS_XB);
    const float* gg = p.in[12];
    const long gtid = (long)blockIdx.x * NTHR + threadIdx.x, gsz = (long)gridDim.x * NTHR;
    const long total = (long)T * 128;
    for (long it = gtid; it < total; it += gsz) {
        const long row = it >> 7; const int c8 = (int)(it & 127) * 8, h = c8 >> 8;
        float sq;
        { const f32x4 s0 = *(const f32x4*)(BOSQP + row * 64 + h * 16), s1 = *(const f32x4*)(BOSQP + row * 64 + h * 16 + 4), s2 = *(const f32x4*)(BOSQP + row * 64 + h * 16 + 8), s3 = *(const f32x4*)(BOSQP + row * 64 + h * 16 + 12);
          sq = ((s0[0] + s0[1]) + (s0[2] + s0[3])) + ((s1[0] + s1[1]) + (s1[2] + s1[3])) + ((s2[0] + s2[1]) + (s2[2] + s2[3])) + ((s3[0] + s3[1]) + (s3[2] + s3[3])); }
        const float rs = rsqrtf(sq * (1.f / 256.f) + EPS);
        const u32x4 bo = *(const u32x4*)(BV + row * 1024 + c8);
        const u32x4 gt = *(const u32x4*)(Yb + row * 2048 + 1024 + c8);
        const f32x4 g0 = *(const f32x4*)(gg + (c8 & 255)), g1 = *(const f32x4*)(gg + (c8 & 255) + 4);
        u32x4 o;
        o.x = cvt_pk_bf16(bflo(bo.x) * rs * g0[0] * siluf(bflo(gt.x)), bfhi(bo.x) * rs * g0[1] * siluf(bfhi(gt.x)));
        o.y = cvt_pk_bf16(bflo(bo.y) * rs * g0[2] * siluf(bflo(gt.y)), bfhi(bo.y) * rs * g0[3] * siluf(bfhi(gt.y)));
        o.z = cvt_pk_bf16(bflo(bo.z) * rs * g1[0] * siluf(bflo(gt.z)), bfhi(bo.z) * rs * g1[1] * siluf(bfhi(gt.z)));
        o.w = cvt_pk_bf16(bflo(bo.w) * rs * g1[2] * siluf(bflo(gt.w)), bfhi(bo.w) * rs * g1[3] * siluf(bfhi(gt.w)));
        *(u32x4*)(Yb + row * 2048 + 1024 + c8) = o;
    }
}

__device__ __forceinline__ void lru_item(const Params& p, LAS unsigned char* L, int item) {
    unsigned char* ws = p.ws;
    const int tid = threadIdx.x, lane = tid & 63, w = tid >> 6, r16 = lane & 15, q4 = lane >> 4;
    LAS bf16_t* Wl = (LAS bf16_t*)L;
    LAS bf16_t* U = (LAS bf16_t*)(L + 76800);
    LAS float* Aa = (LAS float*)(L + 102400);
    LAS float* Bb = (LAS float*)(L + 126976);
    LAS float* SP = (LAS float*)(L + 151552);
    LAS float* SH = (LAS float*)(L + 153088);
    LAS float* HC = (LAS float*)(L + 154624);
    LAS float* CW = (LAS float*)(L + 155392);
    const bool smp = item >= 256;
    const int i2 = smp ? item - 256 : item;
    const int b = i2 >> 4, nb = (i2 >> 1) & 7, hf = i2 & 1;
    const int nch = smp ? 1 : 32;
    const unsigned rbase = smp ? (unsigned)T_P + b * 64 : (unsigned)b * 2048;
    const bf16_t* Z2 = (const bf16_t*)(ws + WS_Z2); bf16_t* Y2 = (bf16_t*)(ws + WS_Y2);
    const bf16_t* WA = (const bf16_t*)(ws + WS_WA) + nb * 192 * 192; const bf16_t* WI = (const bf16_t*)(ws + WS_WI) + nb * 192 * 192;
    for (int idx = tid; idx < 192 * 24; idx += NTHR) {
        const int r = idx / 24, g8 = idx % 24;
        const bf16_t* src = (r < 96) ? WA + (size_t)(hf * 96 + r) * 192 + g8 * 8 : WI + (size_t)(hf * 96 + r - 96) * 192 + g8 * 8;
        *(LAS u32x4*)(Wl + r * 200 + g8 * 8) = *(const u32x4*)src;
    }
    const bool cthr = tid < 384;
    const int cgp = tid % 24, tq = (tid / 24) & 15;
    const int chc = nb * 192 + cgp * 8;
    for (int idx = tid; idx < 5 * 192; idx += NTHR) { const int j = idx / 192, cc = idx % 192; CW[idx] = (j < 4) ? p.in[16][j * 1536 + nb * 192 + cc] : p.in[17][nb * 192 + cc]; }
    const int mt = w & 3, pg = w >> 2;
    float bra[3], bri[3], sp[3];
#pragma unroll
    for (int cp = 0; cp < 3; ++cp) {
        const int ch = nb * 192 + hf * 96 + (pg * 3 + cp) * 16 + r16;
        bra[cp] = p.in[19][ch]; bri[cp] = p.in[21][ch];
        const float lam = p.in[22][ch];
        sp[cp] = 8.f * (fmaxf(-lam, 0.f) + log1pf(__expf(-fabsf(lam))));
    }
    if (tid < 96) HC[tid] = smp ? p.in[6][b * 1536 + nb * 192 + hf * 96 + tid] : 0.f;
    const int sch0 = tid % 96, sseg0 = (tid / 96) & 3;
    const int ot0 = tid / 12, og0 = tid % 12, ot1 = (tid + 512) / 12, og1 = (tid + 512) % 12;
    const bool o1 = tid < 256;
    const int och0 = nb * 192 + hf * 96 + og0 * 8, och1 = nb * 192 + hf * 96 + og1 * 8;
    lds_barrier();
    u32x4 xr[7]; u32x4 pg0, pg1 = {0u, 0u, 0u, 0u};
#pragma unroll
    for (int r = 0; r < 7; ++r) {
        xr[r] = (u32x4){0u, 0u, 0u, 0u};
        const int pos = 4 * tq - 3 + r;
        if (cthr) {
            if (pos >= 0) xr[r] = *(const u32x4*)(Z2 + (unsigned)((rbase + pos) * 3072u + chc));
            else if (smp) {
                const float* hp = p.in[5] + ((size_t)b * 3 + (3 + pos)) * 1536 + chc;
                const f32x4 h0 = *(const f32x4*)hp, h1 = *(const f32x4*)(hp + 4);
                xr[r].x = cvt_pk_bf16(h0[0], h0[1]); xr[r].y = cvt_pk_bf16(h0[2], h0[3]); xr[r].z = cvt_pk_bf16(h1[0], h1[1]); xr[r].w = cvt_pk_bf16(h1[2], h1[3]);
            }
        }
    }
    pg0 = *(const u32x4*)(Z2 + (unsigned)((rbase + ot0) * 3072u + 1536 + och0));
    if (o1) pg1 = *(const u32x4*)(Z2 + (unsigned)((rbase + ot1) * 3072u + 1536 + och1));
    u32x4 so0 = {0u, 0u, 0u, 0u}, so1 = {0u, 0u, 0u, 0u}; unsigned sr = 0; bool spend = false;
    for (int ci = 0; ci < nch; ++ci) {
        const unsigned r0 = rbase + (unsigned)ci * 64;
        const bool more = (ci + 1 < nch);
        int sch = sch0, sseg = sseg0;
        asm volatile("" : "+v"(sch), "+v"(sseg));
        if (cthr) {
            float xv[7][8];
#pragma unroll
            for (int r = 0; r < 7; ++r) unpack8(xr[r], xv[r]);
            if (hf == 0 && !more && tq == 15) {
                float* oc = p.out + (smp ? O_CS : O_CP) + (size_t)b * 3 * 1536 + chc;
#pragma unroll
                for (int r = 0; r < 3; ++r) { *(f32x4*)(oc + r * 1536) = (f32x4){xv[4 + r][0], xv[4 + r][1], xv[4 + r][2], xv[4 + r][3]}; *(f32x4*)(oc + r * 1536 + 4) = (f32x4){xv[4 + r][4], xv[4 + r][5], xv[4 + r][6], xv[4 + r][7]}; }
            }
            float cw[5][8];
#pragma unroll
            for (int j = 0; j < 5; ++j) { const f32x4 c0 = *(const LAS f32x4*)(CW + j * 192 + cgp * 8), c1 = *(const LAS f32x4*)(CW + j * 192 + cgp * 8 + 4);
                cw[j][0] = c0[0]; cw[j][1] = c0[1]; cw[j][2] = c0[2]; cw[j][3] = c0[3]; cw[j][4] = c1[0]; cw[j][5] = c1[1]; cw[j][6] = c1[2]; cw[j][7] = c1[3]; }
#pragma unroll
            for (int tk = 0; tk < 4; ++tk) {
                float acc[8];
#pragma unroll
                for (int e = 0; e < 8; ++e) acc[e] = cw[4][e] + xv[tk][e] * cw[0][e] + xv[tk + 1][e] * cw[1][e] + xv[tk + 2][e] * cw[2][e] + xv[tk + 3][e] * cw[3][e];
                u32x4 uw; uw.x = cvt_pk_bf16(acc[0], acc[1]); uw.y = cvt_pk_bf16(acc[2], acc[3]); uw.z = cvt_pk_bf16(acc[4], acc[5]); uw.w = cvt_pk_bf16(acc[6], acc[7]);
                *(LAS u32x4*)(U + (4 * tq + tk) * 200 + cgp * 8) = uw;
            }
            if (more) {
#pragma unroll
                for (int r = 0; r < 7; ++r) xr[r] = *(const u32x4*)(Z2 + (unsigned)((r0 + 64 + 4 * tq - 3 + r) * 3072u + chc));
            }
        }
        lds_barrier();
        if (spend) { *(u32x4*)(Y2 + (unsigned)((sr + ot0) * 1536u + och0)) = so0; if (o1) *(u32x4*)(Y2 + (unsigned)((sr + ot1) * 1536u + och1)) = so1; }
        f32x4 ga[3], gi[3];
#pragma unroll
        for (int cp = 0; cp < 3; ++cp) { ga[cp] = (f32x4){0.f, 0.f, 0.f, 0.f}; gi[cp] = (f32x4){0.f, 0.f, 0.f, 0.f}; }
#pragma unroll 2
        for (int ks = 0; ks < 6; ++ks) {
            const bf16x8 uf = *(const LAS bf16x8*)(U + (mt * 16 + r16) * 200 + ks * 32 + q4 * 8);
#pragma unroll
            for (int cp = 0; cp < 3; ++cp) {
                const int ct = pg * 3 + cp;
                const bf16x8 wa = *(const LAS bf16x8*)(Wl + (ct * 16 + r16) * 200 + ks * 32 + q4 * 8), wi = *(const LAS bf16x8*)(Wl + (96 + ct * 16 + r16) * 200 + ks * 32 + q4 * 8);
                ga[cp] = MFMA16(uf, wa, ga[cp]); gi[cp] = MFMA16(uf, wi, gi[cp]);
            }
        }
#pragma unroll
        for (int cp = 0; cp < 3; ++cp) {
            const int cl = (pg * 3 + cp) * 16 + r16;
#pragma unroll
            for (int jj = 0; jj < 4; ++jj) {
                const int t = mt * 16 + q4 * 4 + jj;
                const float rg = sigmf(ga[cp][jj] + bra[cp]), ig = sigmf(gi[cp][jj] + bri[cp]);
                const float z = rg * sp[cp];
                const float a = __expf(-z);
                const float z2 = z + z;
                const float om = (z2 < 0.05f) ? z2 * (1.f - z2 * (0.5f - z2 * (0.16666667f - z2 * 0.041666668f))) : 1.f - a * a;
                const float uu = bf2f(U[t * 200 + hf * 96 + cl]);
                Aa[t * 96 + cl] = a; Bb[t * 96 + cl] = __builtin_amdgcn_sqrtf(om) * ig * uu;
            }
        }
        lds_barrier();
        if (cthr) {
            float P = 1.f, H = 0.f;
#pragma unroll
            for (int t = 0; t < 16; ++t) { const float a = Aa[(sseg * 16 + t) * 96 + sch]; H = a * H + Bb[(sseg * 16 + t) * 96 + sch]; P *= a; }
            SP[sseg * 96 + sch] = P; SH[sseg * 96 + sch] = H;
        }
        lds_barrier();
        if (cthr) {
            float hh = HC[(ci & 1) * 96 + sch];
#pragma unroll
            for (int sg = 0; sg < 3; ++sg) if (sg < sseg) hh = SP[sg * 96 + sch] * hh + SH[sg * 96 + sch];
#pragma unroll
            for (int t = 0; t < 16; ++t) { hh = Aa[(sseg * 16 + t) * 96 + sch] * hh + Bb[(sseg * 16 + t) * 96 + sch]; Bb[(sseg * 16 + t) * 96 + sch] = hh; }
            if (sseg == 3) HC[((ci + 1) & 1) * 96 + sch] = hh;
        }
        lds_barrier();
        {
            const f32x4 h0 = *(const LAS f32x4*)(Bb + ot0 * 96 + og0 * 8), h1 = *(const LAS f32x4*)(Bb + ot0 * 96 + og0 * 8 + 4);
            u32x4 o;
            o.x = cvt_pk_bf16(h0[0] * siluf(bflo(pg0.x)), h0[1] * siluf(bfhi(pg0.x)));
            o.y = cvt_pk_bf16(h0[2] * siluf(bflo(pg0.y)), h0[3] * siluf(bfhi(pg0.y)));
            o.z = cvt_pk_bf16(h1[0] * siluf(bflo(pg0.z)), h1[1] * siluf(bfhi(pg0.z)));
            o.w = cvt_pk_bf16(h1[2] * siluf(bflo(pg0.w)), h1[3] * siluf(bfhi(pg0.w)));
            so0 = o;
            if (more) pg0 = *(const u32x4*)(Z2 + (unsigned)((r0 + 64 + ot0) * 3072u + 1536 + och0));
        }
        if (o1) {
            const f32x4 h0 = *(const LAS f32x4*)(Bb + ot1 * 96 + og1 * 8), h1 = *(const LAS f32x4*)(Bb + ot1 * 96 + og1 * 8 + 4);
            u32x4 o;
            o.x = cvt_pk_bf16(h0[0] * siluf(bflo(pg1.x)), h0[1] * siluf(bfhi(pg1.x)));
            o.y = cvt_pk_bf16(h0[2] * siluf(bflo(pg1.y)), h0[3] * siluf(bfhi(pg1.y)));
            o.z = cvt_pk_bf16(h1[0] * siluf(bflo(pg1.z)), h1[1] * siluf(bfhi(pg1.z)));
            o.w = cvt_pk_bf16(h1[2] * siluf(bflo(pg1.w)), h1[3] * siluf(bfhi(pg1.w)));
            so1 = o;
            if (more) pg1 = *(const u32x4*)(Z2 + (unsigned)((r0 + 64 + ot1) * 3072u + 1536 + och1));
        }
        sr = r0; spend = true;
        lds_barrier();
    }
    if (spend) { *(u32x4*)(Y2 + (unsigned)((sr + ot0) * 1536u + och0)) = so0; if (o1) *(u32x4*)(Y2 + (unsigned)((sr + ot1) * 1536u + och1)) = so1; }
    if (tid < 96) p.out[(smp ? O_LS : O_LP) + (size_t)b * 1536 + nb * 192 + hf * 96 + tid] = HC[(nch & 1) * 96 + tid];
    lds_barrier();
}

__device__ __forceinline__ void phase6(const Params& p, LAS unsigned char* L) {
    if (gridDim.x == 256) {
        const int xcd = blockIdx.x & 7, loc = blockIdx.x >> 3;
        const int pair = xcd * 16 + (loc >> 1), hf = loc & 1;
        lru_item(p, L, pair * 2 + hf); lru_item(p, L, 256 + pair * 2 + hf); lru_item(p, L, 512 + pair * 2 + hf);
    } else {
        for (int it = blockIdx.x; it < 768; it += gridDim.x) lru_item(p, L, it);
    }
}

__device__ __forceinline__ void phase8(const Params& p) {
    const float* rsq = (const float*)(p.ws + WS_RSQ2); const float* g = p.in[24]; float* y = p.out;
    const long gtid = (long)blockIdx.x * NTHR + threadIdx.x, gsz = (long)gridDim.x * NTHR;
    const long total = (long)T * 256;
    for (long it = gtid; it < total; it += gsz) {
        const long row = it >> 8; const int c4 = (int)(it & 255) * 4;
        const float rs = rsqrtf(rsq[row] * (1.f / 1024.f) + EPS);
        const f32x4 v = *(const f32x4*)(y + row * 1024 + c4), gv = *(const f32x4*)(g + c4);
        *(f32x4*)(y + row * 1024 + c4) = v * rs * gv;
    }
}


#define XB_TMO      128
#define XB_XCNT(j)  (256  + 64 * (j))
#define XB_XSUB(j)  (1280 + 64 * (j))
#define XB_XGEN(j)  (2304 + 64 * (j))
#define XB_TOP      3328
#define XB_TOPGEN   3392
#define XCD_BAR_WORDS 3456
#define XB_SPIN_CAP (1u << 18)
__device__ __forceinline__ unsigned xb_ld(unsigned* p)              { return __hip_atomic_load(p, __ATOMIC_RELAXED, __HIP_MEMORY_SCOPE_AGENT); }
__device__ __forceinline__ unsigned xb_add(unsigned* p, unsigned v) { return __hip_atomic_fetch_add(p, v, __ATOMIC_RELAXED, __HIP_MEMORY_SCOPE_AGENT); }
__device__ __forceinline__ unsigned xb_xcc_id() { return (unsigned)__builtin_amdgcn_s_getreg((3 << 11) | 20) & 0xFu; }
#define XB_SPIN(cond, bar) do { unsigned _sp = 0; while (cond) { __builtin_amdgcn_s_sleep(1); \
    if ((++_sp & 255u) == 0u) { if (xb_ld(&(bar)[XB_TMO])) break; if (_sp > XB_SPIN_CAP) { atomicAdd(&(bar)[XB_TMO], 1u); break; } } } } while (0)
struct XcdBarrier { unsigned* bar; unsigned x; volatile LAS unsigned* st; };
__device__ __forceinline__ XcdBarrier xcd_barrier_post(unsigned* bar, volatile LAS unsigned* st) {
    XcdBarrier b; b.bar = bar; b.x = xb_xcc_id(); b.st = st;
    if (threadIdx.x == 0) (void)xb_add(&bar[XB_XCNT(b.x)], 1u);
    return b;
}
__device__ __forceinline__ void xcd_barrier_complete(unsigned* bar, unsigned x, unsigned& nloc, unsigned& nx) {
    const unsigned G = gridDim.x * gridDim.y * gridDim.z;
    unsigned sum, cnt, mine, sp = 0u;
    for (;;) {
        sum = 0u; cnt = 0u; mine = 0u;
#pragma unroll
        for (unsigned j = 0; j < 16; ++j) { const unsigned c = xb_ld(&bar[XB_XCNT(j)]); sum += c; cnt += (c > 0u) ? 1u : 0u; mine = (j == x) ? c : mine; }
        if (sum == G) break;
        __builtin_amdgcn_s_sleep(1);
        if ((++sp & 255u) == 0u) { if (xb_ld(&bar[XB_TMO])) break; if (sp > XB_SPIN_CAP) { atomicAdd(&bar[XB_TMO], 1u); break; } }
    }
    nloc = mine > 0u ? mine : 1u; nx = cnt > 0u ? cnt : 1u;
}
__device__ __forceinline__ void xcd_barrier(const XcdBarrier& b) {
    asm volatile("s_waitcnt vmcnt(0)" ::: "memory");
    __syncthreads();
    if (threadIdx.x == 0) {
        unsigned* bar = b.bar;
        __builtin_amdgcn_s_waitcnt(0);
        unsigned nloc = b.st[0], nx = b.st[1];
        if (nloc == 0u) { xcd_barrier_complete(bar, b.x, nloc, nx); b.st[0] = nloc; b.st[1] = nx; }
        const unsigned old = xb_add(&bar[XB_XSUB(b.x)], 1u);
        const unsigned gen = old / nloc;
        if (old + 1u == (gen + 1u) * nloc) {
            __builtin_amdgcn_fence(__ATOMIC_RELEASE, "agent");
            asm volatile("s_waitcnt vmcnt(0)" ::: "memory");
            const unsigned og = xb_add(&bar[XB_TOP], 1u);
            const unsigned tg = og / nx;
            if (og + 1u == (tg + 1u) * nx) xb_add(&bar[XB_TOPGEN], 1u);
            else XB_SPIN(xb_ld(&bar[XB_TOPGEN]) == tg, bar);
            __builtin_amdgcn_fence(__ATOMIC_ACQUIRE, "agent");
            xb_add(&bar[XB_XGEN(b.x)], 1u);
            asm volatile("s_waitcnt vmcnt(0)" ::: "memory");
        } else {
            XB_SPIN(xb_ld(&bar[XB_XGEN(b.x)]) == gen, bar);
            __builtin_amdgcn_fence(__ATOMIC_ACQUIRE, "agent");
            asm volatile("s_waitcnt vmcnt(0)" ::: "memory");
        }
    }
    __syncthreads();
}

__global__ void __launch_bounds__(NTHR) mega(Params p) {
    extern __shared__ __attribute__((aligned(16))) unsigned char lds_raw[];
    LAS unsigned char* L = (LAS unsigned char*)lds_raw;
    cg::grid_group grid = cg::this_grid();
    unsigned char* ws = p.ws;
    const int lo = p.ph_lo, hi = p.ph_hi;
    LAS unsigned* stw = (LAS unsigned*)(L + (LDS_BYTES - 16));
    if (threadIdx.x < 4) stw[threadIdx.x] = 0u;
    __syncthreads();
    const XcdBarrier xb = xcd_barrier_post((unsigned*)(ws + WS_BAR), (volatile LAS unsigned*)stw);
#ifndef PHMASK
#define PHMASK 0x1ff
#endif
#define IN(k) (((PHMASK >> (k)) & 1) && lo <= (k) && (k) < hi)
#define SEAM(k) do { if (IN(k) && IN((k) + 1)) xcd_barrier(xb); } while (0)
    if (hi > 1000) grid.sync();
    if (IN(0)) phase0(p);
    SEAM(0);
    if (IN(1)) {
        pg8::Gemm g{(const bf16_t*)(ws + WS_XB), (const bf16_t*)(ws + WS_WINE), T, NE_PAD, 1024};
        pg8::StaticOrder S; S.init(T, NE_PAD, gridDim.x, blockIdx.x);
        EpiInEven E{ws, p.out, (const float*)(ws + WS_RSTD0), p.in[10]};
        pg8::gemm_phase<EpiInEven>(L, g, S, E);
    }
    SEAM(1);
    if (IN(2)) { phase2a(p, L); xcd_barrier(xb); phase2b(p, L); }
    SEAM(2);
    if (IN(3)) phase3(p);
    SEAM(3);
    if (IN(4)) {
        pg8::Gemm g{(const bf16_t*)(ws + WS_GATE), (const bf16_t*)(ws + WS_WOUTE), T, 1024, 2048};
        pg8::StaticOrder S; S.init(T, 1024, gridDim.x, blockIdx.x);
        EpiOutRes<true> E{p.in[0], p.in[1], p.out, (bf16_t*)(ws + WS_XB), (float*)(ws + WS_RSQ1)};
        pg8::gemm_phase<EpiOutRes<true>>(L, g, S, E);
    }
    SEAM(4);
    if (IN(5)) {
        pg8::Gemm g{(const bf16_t*)(ws + WS_XB), (const bf16_t*)(ws + WS_WINO), T, 3072, 1024};
        pg8::StaticOrder S; S.init(T, 3072, gridDim.x, blockIdx.x);
        EpiInOdd E{(bf16_t*)(ws + WS_Z2), (const float*)(ws + WS_RSQ1)};
        pg8::gemm_phase<EpiInOdd>(L, g, S, E);
    }
    SEAM(5);
    if (IN(6)) phase6(p, L);
    SEAM(6);
    if (IN(7)) {
        pg8::Gemm g{(const bf16_t*)(ws + WS_Y2), (const bf16_t*)(ws + WS_WOUTO), T, 1024, 1536};
        pg8::StaticOrder S; S.init(T, 1024, gridDim.x, blockIdx.x);
        EpiOutRes<false> E{p.out, p.out + (size_t)T_P * 1024, p.out, nullptr, (float*)(ws + WS_RSQ2)};
        pg8::gemm_phase<EpiOutRes<false>>(L, g, S, E);
    }
    SEAM(7);
    if (IN(8)) phase8(p);
#undef IN
#undef SEAM
}

extern "C" void kernel_launch(void* const* d_in, const int* in_sizes, int n_in, void* d_out, int out_size, void* d_ws, size_t ws_size, hipStream_t stream) {
    static int grid_blocks = 0;
    if (grid_blocks == 0) {
        if (n_in != 25 || (size_t)out_size != O_END || ws_size < WS_TOTAL) { fprintf(stderr, "kernel_launch: unexpected shapes n_in %d out %d ws %zu (need %zu)\n", n_in, out_size, ws_size, (size_t)WS_END); grid_blocks = -1; return; }
        int dev = 0, cus = 0, per_cu = 0;
        (void)hipGetDevice(&dev);
        (void)hipDeviceGetAttribute(&cus, hipDeviceAttributeMultiprocessorCount, dev);
        if (hipFuncSetAttribute((const void*)mega, hipFuncAttributeMaxDynamicSharedMemorySize, LDS_BYTES) != hipSuccess) { fprintf(stderr, "kernel_launch: hipFuncSetAttribute failed\n"); }
        if (hipOccupancyMaxActiveBlocksPerMultiprocessor(&per_cu, (const void*)mega, NTHR, LDS_BYTES) != hipSuccess || per_cu < 1) per_cu = 1;
        (void)hipGetLastError();
        grid_blocks = cus * per_cu;
        if (grid_blocks <= 0) grid_blocks = 256;
    }
    if (grid_blocks < 0) return;
    Params p{};
    for (int i = 0; i < 25; ++i) p.in[i] = (const float*)d_in[i];
    p.out = (float*)d_out; p.ws = (unsigned char*)d_ws;
#if ONE_LAUNCH
#ifdef PROBE_X
    { const int seq[3][2] = {{0, PROBE_Y + 1}, {PROBE_X, PROBE_Y + 1}, {PROBE_Y + 1, 9}};
      for (int li = 0; li < 3; ++li) { if (seq[li][0] >= seq[li][1]) continue; p.ph_lo = seq[li][0]; p.ph_hi = seq[li][1]; void* args[] = {&p};
        (void)hipMemsetAsync((char*)d_ws + WS_BAR, 0, 16384, stream);
        hipError_t e = hipLaunchCooperativeKernel((const void*)mega, dim3(grid_blocks), dim3(NTHR), args, LDS_BYTES, stream);
        if (e != hipSuccess) fprintf(stderr, "cooperative launch failed: %s (grid %d)\n", hipGetErrorString(e), grid_blocks); } }
#else
    p.ph_lo = 0; p.ph_hi = 9;
    (void)hipMemsetAsync((char*)d_ws + WS_BAR, 0, 16384, stream);
    { void* args[] = {&p}; hipError_t e = hipLaunchCooperativeKernel((const void*)mega, dim3(grid_blocks), dim3(NTHR), args, LDS_BYTES, stream);
      if (e != hipSuccess) fprintf(stderr, "cooperative launch failed: %s (grid %d)\n", hipGetErrorString(e), grid_blocks); }
#endif
#else
    for (int ph = 0; ph < 9; ++ph) {
        p.ph_lo = ph; p.ph_hi = ph + 1;
        (void)hipMemsetAsync((char*)d_ws + WS_BAR, 0, 16384, stream);
        void* args[] = {&p}; hipError_t e = hipLaunchCooperativeKernel((const void*)mega, dim3(grid_blocks), dim3(NTHR), args, LDS_BYTES, stream);
        if (e != hipSuccess) fprintf(stderr, "cooperative launch %d failed: %s (grid %d)\n", ph, hipGetErrorString(e), grid_blocks);
    }
#endif
}
```

```cpp
#include <hip/hip_runtime.h>
#include <hip/hip_cooperative_groups.h>
#include <cstdio>
namespace cg = cooperative_groups;

#ifndef ONE_LAUNCH
#define ONE_LAUNCH 1
#endif

#define LAS __attribute__((address_space(3)))
typedef unsigned short bf16_t;
typedef short bf16x8 __attribute__((ext_vector_type(8)));
typedef short bf16x4 __attribute__((ext_vector_type(4)));
typedef float f32x4 __attribute__((ext_vector_type(4)));
typedef unsigned u32x4 __attribute__((ext_vector_type(4)));
typedef unsigned u32x2 __attribute__((ext_vector_type(2)));

constexpr int T_P = 32768, T_S = 2048, T = T_P + T_S, DM = 1024;
constexpr int NE_PAD = 6144;
constexpr int LDS_BYTES = 159744;
constexpr int NTHR = 512;
constexpr float EPS = 1e-6f;

constexpr size_t WS_WINE = 0;
constexpr size_t WS_WOUTE = WS_WINE + (size_t)NE_PAD * 1024 * 2;
constexpr size_t WS_WINO = WS_WOUTE + (size_t)1024 * 2048 * 2;
constexpr size_t WS_WOUTO = WS_WINO + (size_t)3072 * 1024 * 2;
constexpr size_t WS_WA = WS_WOUTO + (size_t)1024 * 1536 * 2;
constexpr size_t WS_WI = WS_WA + (size_t)8 * 192 * 192 * 2;
constexpr size_t WS_XB = WS_WI + (size_t)8 * 192 * 192 * 2;
constexpr size_t WS_RSTD0 = WS_XB + (size_t)T * 1024 * 2;
constexpr size_t WS_RSQ1 = WS_RSTD0 + (size_t)T * 4;
constexpr size_t WS_RSQ2 = WS_RSQ1 + (size_t)T * 4;
constexpr size_t WS_BOSQ = WS_RSQ2 + (size_t)T * 4;
constexpr size_t WS_Q = WS_BOSQ + (size_t)T * 16;
constexpr size_t WS_K = WS_Q + (size_t)T * 1024 * 2;
constexpr size_t WS_V = WS_K + (size_t)T * 256 * 2;
constexpr size_t WS_BQ = WS_V + (size_t)T * 256 * 2;
constexpr size_t WS_BK = WS_BQ + (size_t)T * 512 * 2;
constexpr size_t WS_BV = WS_BK + (size_t)T * 512 * 2;
constexpr size_t WS_GATE = WS_BV + (size_t)T * 1024 * 2;
constexpr size_t WS_BLR = WS_GATE + (size_t)T * 2048 * 2;
constexpr size_t WS_END = WS_BLR + (size_t)T * 512 * 2;
constexpr size_t WS_BAR = WS_END;
constexpr size_t WS_TOTAL = WS_BAR + 16384;
constexpr size_t WS_Z2 = WS_Q;
constexpr size_t WS_Y2 = WS_GATE;
static_assert(WS_Z2 + (size_t)T * 3072 * 2 <= WS_GATE, "Z2 alias");

constexpr size_t O_Y = 0;
constexpr size_t O_KP = (size_t)T * 1024;
constexpr size_t O_VP = O_KP + 524288;
constexpr size_t O_GP = O_VP + 524288;
constexpr size_t O_CP = O_GP + 2097152;
constexpr size_t O_LP = O_CP + 73728;
constexpr size_t O_KS = O_LP + 24576;
constexpr size_t O_VS = O_KS + 524288;
constexpr size_t O_GS = O_VS + 524288;
constexpr size_t O_CS = O_GS + 4194304;
constexpr size_t O_LS = O_CS + 147456;
constexpr size_t O_END = O_LS + 49152;

struct Params {
    const float* in[25];
    float* out;
    unsigned char* ws;
    int ph_lo, ph_hi;
};

__device__ __forceinline__ unsigned cvt_pk_bf16(float lo, float hi) { unsigned r; asm volatile("v_cvt_pk_bf16_f32 %0, %1, %2" : "=v"(r) : "v"(lo), "v"(hi)); return r; }
__device__ __forceinline__ bf16_t f2bf(float f) { return (bf16_t)(cvt_pk_bf16(f, 0.f) & 0xffffu); }
__device__ __forceinline__ float bf2f(bf16_t b) { return __uint_as_float(((unsigned)b) << 16); }
__device__ __forceinline__ float bflo(unsigned w) { return __uint_as_float(w << 16); }
__device__ __forceinline__ float bfhi(unsigned w) { return __uint_as_float(w & 0xffff0000u); }
__device__ __forceinline__ float rcpf_(float x) { return __builtin_amdgcn_rcpf(x); }
__device__ __forceinline__ float siluf(float x) { return x * rcpf_(1.f + __expf(-x)); }
__device__ __forceinline__ float sigmf(float x) { return rcpf_(1.f + __expf(-x)); }
__device__ __forceinline__ void lds_barrier() { asm volatile("s_waitcnt lgkmcnt(0)" ::: "memory"); __builtin_amdgcn_s_barrier(); asm volatile("" ::: "memory"); }
__device__ __forceinline__ bf16x8 pack8(const f32x4& a, const f32x4& b) {
    u32x4 p; p.x = cvt_pk_bf16(a[0], a[1]); p.y = cvt_pk_bf16(a[2], a[3]); p.z = cvt_pk_bf16(b[0], b[1]); p.w = cvt_pk_bf16(b[2], b[3]);
    return __builtin_bit_cast(bf16x8, p);
}
__device__ __forceinline__ bf16x8 cat4(const bf16x4 a, const bf16x4 b) { bf16x8 r; r[0] = a[0]; r[1] = a[1]; r[2] = a[2]; r[3] = a[3]; r[4] = b[0]; r[5] = b[1]; r[6] = b[2]; r[7] = b[3]; return r; }
__device__ __forceinline__ void unpack8(const u32x4 w, float (&v)[8]) { v[0] = bflo(w.x); v[1] = bfhi(w.x); v[2] = bflo(w.y); v[3] = bfhi(w.y); v[4] = bflo(w.z); v[5] = bfhi(w.z); v[6] = bflo(w.w); v[7] = bfhi(w.w); }
#define MFMA16(a, b, c) __builtin_amdgcn_mfma_f32_16x16x32_bf16((a), (b), (c), 0, 0, 0)

namespace pg8 {
constexpr int BM = 256, BK = 64, HALF = 128, HTB = HALF * BK * 2, STAGE_BYTES = 8 * HTB, NXCD = 8, WGM = 8;
__device__ __forceinline__ int lds_byte(int r, int c) { const int st = (r >> 4) * 2 + (c >> 5), rr = r & 15, cc = c & 31, ob = rr * 64 + cc * 2; return st * 1024 + (ob ^ (((ob >> 9) & 1) << 5)); }
__device__ __forceinline__ int perm32(int rho) { const int n = rho >> 4, i = rho & 15; return 8 * (i >> 2) + 4 * n + (i & 3); }
__device__ __forceinline__ void stage_rc(int b, int& R, int& C) { const int st = b / 1024, sb = b % 1024, swz = sb ^ (((sb >> 9) & 1) << 5); R = (st >> 1) * 16 + swz / 64; C = (st & 1) * 32 + (swz % 64) / 2; }
struct Unit { int pm, pn; };
struct Gemm { const bf16_t* A; const bf16_t* Bt; int M, N, K; };
struct StaticOrder {
    int nM, nN, nwg, G, c;
    __device__ void init(int M, int N, int G_, int c_) { nM = M / BM; nN = N / BM; nwg = nM * nN; G = G_; c = c_; }
    __device__ __forceinline__ bool next(int i, Unit& u) const {
        const long Lx = (long)i * G + c; if (Lx >= nwg) return false;
        int wgid = (int)Lx; { const int q = nwg / NXCD, r = nwg % NXCD, xcd = wgid % NXCD, off = wgid / NXCD; wgid = (xcd < r ? xcd * (q + 1) : r * (q + 1) + (xcd - r) * q) + off; }
        const int nig = WGM * nN, gid = wgid / nig, fm = gid * WGM, gsz = (nM - fm) < WGM ? (nM - fm) : WGM;
        u.pm = fm + ((wgid % nig) % gsz); u.pn = (wgid % nig) / gsz; return true;
    }
};

template <class Epi>
__device__ __forceinline__ void gemm_phase(LAS unsigned char* lds, const Gemm g, const StaticOrder& S, const Epi& E) {
    const int tid = threadIdx.x, wid = __builtin_amdgcn_readfirstlane(tid >> 6), lane = tid & 63, wr = wid >> 2, wc = wid & 3, fr = lane & 15, fq = lane >> 4;
    const int K = g.K, nt = K / BK;
    unsigned voffA[2], voffB[2];
#pragma unroll
    for (int i = 0; i < 2; ++i) { int R, C; stage_rc(tid * 16 + i * 8192, R, C); const int Rb = Epi::PERM ? ((R & ~31) + perm32(R & 31)) : R;
        voffA[i] = (unsigned)(R * K + C) * 2u; voffB[i] = (unsigned)(Rb * K + C) * 2u; }
    const size_t kstep = (size_t)(BK * 2);
    const size_t hstep = (size_t)HALF * K * 2;
    const size_t tstep = 2 * hstep;
    const unsigned ldsw = (unsigned)wid * 1024u;
    const int aoff = lds_byte(wr * 64 + fr, fq * 8), boff = lds_byte(wc * 32 + fr, fq * 8);
#define PG8_SA(b, h) (((b) * 2 + (h)) * HTB)
#define PG8_SB(b, h) ((4 + (b) * 2 + (h)) * HTB)
#define PG8_STAGE(bufoff, gbase, voff) do { _Pragma("unroll") for (int _i = 0; _i < 2; ++_i) \
        __builtin_amdgcn_global_load_lds((const unsigned*)((const char*)(gbase) + (voff)[_i]), (LAS unsigned*)(lds + (bufoff) + ldsw + _i * 8192), 16, 0, 0); } while (0)
#define PG8_LDA(dst, b, h) do { _Pragma("unroll") for (int m = 0; m < 4; ++m) _Pragma("unroll") for (int k = 0; k < 2; ++k) dst[m][k] = *(const LAS bf16x8*)(lds + PG8_SA(b, h) + aoff + m * 2048 + k * 1024); } while (0)
#define PG8_LDB(dst, b, h) do { _Pragma("unroll") for (int n = 0; n < 2; ++n) _Pragma("unroll") for (int k = 0; k < 2; ++k) dst[n][k] = *(const LAS bf16x8*)(lds + PG8_SB(b, h) + boff + n * 2048 + k * 1024); } while (0)
#define PG8_MMA(ai, bj, At, Bt) do { __builtin_amdgcn_s_setprio(1); _Pragma("unroll") for (int m = 0; m < 4; ++m) _Pragma("unroll") for (int n = 0; n < 2; ++n) _Pragma("unroll") for (int k = 0; k < 2; ++k) \
        acc[ai][bj][m][n] = __builtin_amdgcn_mfma_f32_16x16x32_bf16(Bt[n][k], At[m][k], acc[ai][bj][m][n], 0, 0, 0); __builtin_amdgcn_s_setprio(0); } while (0)
#define PG8_WAIT_V(n) asm volatile("s_waitcnt vmcnt(" #n ")" ::: "memory")
#define PG8_WAIT_L(n) asm volatile("s_waitcnt lgkmcnt(" #n ")" ::: "memory")
#define PG8_BAR __builtin_amdgcn_s_barrier()
#define PG8_SCHED __builtin_amdgcn_sched_barrier(0)
    Unit cur, nxt; int ui = 0;
    if (!S.next(0, cur)) return;
    f32x4 acc[2][2][4][2];
#pragma unroll
    for (int a = 0; a < 2; ++a)
#pragma unroll
        for (int b = 0; b < 2; ++b)
#pragma unroll
            for (int m = 0; m < 4; ++m)
#pragma unroll
                for (int n = 0; n < 2; ++n) acc[a][b][m][n] = (f32x4){0.f, 0.f, 0.f, 0.f};
    bf16x8 At[4][2], B0[2][2], B1[2][2];
    const char* cA = (const char*)g.A + (size_t)cur.pm * tstep; const char* cB = (const char*)g.Bt + (size_t)cur.pn * tstep;
    PG8_STAGE(PG8_SB(0, 0), cB, voffB); PG8_STAGE(PG8_SA(0, 0), cA, voffA); PG8_STAGE(PG8_SB(0, 1), cB + hstep, voffB); PG8_STAGE(PG8_SA(0, 1), cA + hstep, voffA);
    if (wr == 1) PG8_BAR;
    PG8_WAIT_V(4); PG8_BAR;
    PG8_STAGE(PG8_SB(1, 0), cB + kstep, voffB); PG8_STAGE(PG8_SA(1, 0), cA + kstep, voffA); PG8_STAGE(PG8_SB(1, 1), cB + hstep + kstep, voffB);
    PG8_WAIT_V(6); PG8_BAR;
    for (;;) {
        const bool has_next = S.next(ui + 1, nxt);
        const char* nA = has_next ? (const char*)g.A + (size_t)nxt.pm * tstep : cA; const char* nB = has_next ? (const char*)g.Bt + (size_t)nxt.pn * tstep : cB;
        for (int t = 0; t < nt; t += 2) {
            const bool last = (t == nt - 2);
            const char* a1 = cA + (size_t)(t + 1) * kstep;
            const char* a2 = last ? nA : cA + (size_t)(t + 2) * kstep; const char* b2 = last ? nB : cB + (size_t)(t + 2) * kstep;
            const char* a3 = a2 + kstep; const char* b3 = b2 + kstep;
            PG8_LDB(B0, 0, 0); PG8_SCHED; PG8_LDA(At, 0, 0); PG8_STAGE(PG8_SA(1, 1), a1 + hstep, voffA);
            PG8_WAIT_L(8); PG8_BAR; PG8_WAIT_L(0); PG8_MMA(0, 0, At, B0); PG8_BAR; PG8_SCHED;
            PG8_LDB(B1, 0, 1); PG8_STAGE(PG8_SB(0, 0), b2, voffB);
            PG8_BAR; PG8_WAIT_L(0); PG8_MMA(0, 1, At, B1); PG8_BAR;
            PG8_LDA(At, 0, 1); PG8_STAGE(PG8_SA(0, 0), a2, voffA);
            PG8_BAR; PG8_WAIT_L(0); PG8_MMA(1, 0, At, B0); PG8_BAR; PG8_SCHED;
            PG8_STAGE(PG8_SB(0, 1), b2 + hstep, voffB);
            PG8_WAIT_V(6); PG8_BAR; PG8_MMA(1, 1, At, B1); PG8_BAR;
            PG8_LDB(B0, 1, 0); PG8_SCHED; PG8_LDA(At, 1, 0); PG8_STAGE(PG8_SA(0, 1), a2 + hstep, voffA);
            PG8_WAIT_L(8); PG8_BAR; PG8_WAIT_L(0); PG8_MMA(0, 0, At, B0); PG8_BAR; PG8_SCHED;
            PG8_LDB(B1, 1, 1); PG8_STAGE(PG8_SB(1, 0), b3, voffB);
            PG8_BAR; PG8_WAIT_L(0); PG8_MMA(0, 1, At, B1); PG8_BAR;
            PG8_LDA(At, 1, 1); PG8_STAGE(PG8_SA(1, 0), a3, voffA);
            PG8_BAR; PG8_WAIT_L(0); PG8_MMA(1, 0, At, B0); PG8_BAR; PG8_SCHED;
            PG8_STAGE(PG8_SB(1, 1), b3 + hstep, voffB);
            PG8_WAIT_V(6); PG8_BAR; PG8_MMA(1, 1, At, B1); PG8_BAR;
        }
        if (wr == 0) PG8_BAR;
        E(acc, cur, wr, wc, fr, fq);
        if (!has_next) break;
#pragma unroll
        for (int a = 0; a < 2; ++a)
#pragma unroll
            for (int b = 0; b < 2; ++b)
#pragma unroll
                for (int m = 0; m < 4; ++m)
#pragma unroll
                    for (int n = 0; n < 2; ++n) acc[a][b][m][n] = (f32x4){0.f, 0.f, 0.f, 0.f};
        cur = nxt; cA = nA; cB = nB; ++ui;
        if (wr == 1) PG8_BAR;
    }
    PG8_WAIT_V(0);
    PG8_BAR;
#undef PG8_SA
#undef PG8_SB
#undef PG8_STAGE
#undef PG8_LDA
#undef PG8_LDB
#undef PG8_MMA
#undef PG8_WAIT_V
#undef PG8_WAIT_L
#undef PG8_BAR
#undef PG8_SCHED
}
}

typedef f32x4 AccT[2][2][4][2];

struct EpiInEven {
    static constexpr bool PERM = true;
    unsigned char* ws; float* out; const float* rstd; const float* blr_b;
    __device__ __forceinline__ void operator()(const AccT& acc, const pg8::Unit& u, int wr, int wc, int fr, int fq) const {
        const int pn = u.pn;
        bf16_t* base; int ld, coff; float sc = 1.f;
        if (pn < 4) { base = (bf16_t*)(ws + WS_Q); ld = 1024; coff = pn * 256; sc = 0.125f; }
        else if (pn == 4) { base = (bf16_t*)(ws + WS_K); ld = 256; coff = 0; }
        else if (pn == 5) { base = (bf16_t*)(ws + WS_V); ld = 256; coff = 0; }
        else if (pn < 8) { base = (bf16_t*)(ws + WS_BQ); ld = 512; coff = (pn - 6) * 256; sc = 0.08838834764831845f; }
        else if (pn < 10) { base = (bf16_t*)(ws + WS_BK); ld = 512; coff = (pn - 8) * 256; }
        else if (pn < 14) { base = (bf16_t*)(ws + WS_BV); ld = 1024; coff = (pn - 10) * 256; }
        else if (pn < 22) { base = (bf16_t*)(ws + WS_GATE); ld = 2048; coff = (pn - 14) * 256; }
        else { base = (bf16_t*)(ws + WS_BLR); ld = 512; coff = (pn - 22) * 256; }
        const int row0 = u.pm * 256 + wr * 64 + fr;
        const int ct = wc * 32 + 8 * fq;
        float rsv[8];
#pragma unroll
        for (int it = 0; it < 8; ++it) rsv[it] = rstd[row0 + (it >> 2) * 128 + (it & 3) * 16];
        if (pn >= 22) {
#pragma unroll
            for (int ai = 0; ai < 2; ++ai)
#pragma unroll
                for (int m = 0; m < 4; ++m) {
                    const int row = row0 + ai * 128 + m * 16; const float rs = rsv[ai * 4 + m];
#pragma unroll
                    for (int bj = 0; bj < 2; ++bj) {
                        const int cg = coff + ct + bj * 128;
                        const f32x4 b0 = *(const f32x4*)(blr_b + cg), b1 = *(const f32x4*)(blr_b + cg + 4);
                        f32x4 x0 = acc[ai][bj][m][0] * rs + b0, x1 = acc[ai][bj][m][1] * rs + b1;
#pragma unroll
                        for (int j = 0; j < 4; ++j) { x0[j] = (fminf(x0[j], 0.f) - __logf(1.f + __expf(-fabsf(x0[j])))) * (1.f / 16.f); x1[j] = (fminf(x1[j], 0.f) - __logf(1.f + __expf(-fabsf(x1[j])))) * (1.f / 16.f); }
                        u32x4 w; w.x = cvt_pk_bf16(x0[0], x0[1]); w.y = cvt_pk_bf16(x0[2], x0[3]); w.z = cvt_pk_bf16(x1[0], x1[1]); w.w = cvt_pk_bf16(x1[2], x1[3]);
                        *(u32x4*)(base + (size_t)row * 512 + cg) = w;
                    }
                }
            return;
        }
        const bool kv = (pn == 4 || pn == 5);
        float* okv_p = out + (pn == 4 ? O_KP : O_VP); float* okv_s = out + (pn == 4 ? O_KS : O_VS);
#pragma unroll
        for (int ai = 0; ai < 2; ++ai)
#pragma unroll
            for (int m = 0; m < 4; ++m) {
                const int row = row0 + ai * 128 + m * 16; const float rs = rsv[ai * 4 + m] * sc;
                bf16_t* rowp = base + (size_t)row * ld + coff + ct;
                float* orow = nullptr;
                if (kv) {
                    if (row >= T_P) orow = okv_s + (size_t)(row - T_P) * 256;
                    else { const int b = row >> 11, t = row & 2047; if (t >= 1920) orow = okv_p + (size_t)(b * 128 + t - 1920) * 256; }
                }
#pragma unroll
                for (int bj = 0; bj < 2; ++bj) {
                    const f32x4 v0 = acc[ai][bj][m][0] * rs, v1 = acc[ai][bj][m][1] * rs;
                    u32x4 w; w.x = cvt_pk_bf16(v0[0], v0[1]); w.y = cvt_pk_bf16(v0[2], v0[3]); w.z = cvt_pk_bf16(v1[0], v1[1]); w.w = cvt_pk_bf16(v1[2], v1[3]);
                    *(u32x4*)(rowp + bj * 128) = w;
                    if (kv && orow) { *(f32x4*)(orow + bj * 128 + ct) = v0; *(f32x4*)(orow + bj * 128 + ct + 4) = v1; }
                }
            }
    }
};

template <bool WRITE_BF>
struct EpiOutRes {
    static constexpr bool PERM = false;
    const float* xin_p; const float* xin_s; float* xo; bf16_t* xb; float* rowsq;
    __device__ __forceinline__ void operator()(const AccT& acc, const pg8::Unit& u, int wr, int wc, int fr, int fq) const {
        const int row0 = u.pm * 256 + wr * 64 + fr, col0 = u.pn * 256 + wc * 32 + 4 * fq;
        f32x4 r[3][4];
#define EOR_LOAD(S, IT) do { const int row_ = row0 + ((IT) >> 2) * 128 + ((IT) & 3) * 16; \
            const float* xr_ = (row_ < T_P) ? xin_p + (size_t)row_ * 1024 : xin_s + (size_t)(row_ - T_P) * 1024; \
            r[S][0] = *(const f32x4*)(xr_ + col0); r[S][1] = *(const f32x4*)(xr_ + col0 + 16); r[S][2] = *(const f32x4*)(xr_ + col0 + 128); r[S][3] = *(const f32x4*)(xr_ + col0 + 144); } while (0)
        EOR_LOAD(0, 0); EOR_LOAD(1, 1);
#pragma unroll
        for (int it = 0; it < 8; ++it) {
            if (it + 2 < 8) { if ((it + 2) % 3 == 0) EOR_LOAD(0, it + 2); else if ((it + 2) % 3 == 1) EOR_LOAD(1, it + 2); else EOR_LOAD(2, it + 2); }
            const int ai = it >> 2, m = it & 3;
            const int row = row0 + ai * 128 + m * 16;
            float ss = 0.f;
#pragma unroll
            for (int bj = 0; bj < 2; ++bj)
#pragma unroll
                for (int n = 0; n < 2; ++n) {
                    const int col = col0 + bj * 128 + n * 16;
                    const f32x4 v = acc[ai][bj][m][n] + r[it % 3][bj * 2 + n];
                    *(f32x4*)(xo + (size_t)row * 1024 + col) = v;
                    if (WRITE_BF) { u32x2 w; w.x = cvt_pk_bf16(v[0], v[1]); w.y = cvt_pk_bf16(v[2], v[3]); *(u32x2*)(xb + (size_t)row * 1024 + col) = w; }
                    ss += v[0] * v[0] + v[1] * v[1] + v[2] * v[2] + v[3] * v[3];
                }
            ss += __shfl_xor(ss, 16); ss += __shfl_xor(ss, 32);
            if (fq == 0) atomicAdd(rowsq + row, ss);
        }
#undef EOR_LOAD
    }
};

struct EpiInOdd {
    static constexpr bool PERM = true;
    bf16_t* z2; const float* rowsq;
    __device__ __forceinline__ void operator()(const AccT& acc, const pg8::Unit& u, int wr, int wc, int fr, int fq) const {
        const int row0 = u.pm * 256 + wr * 64 + fr, col0 = u.pn * 256 + wc * 32 + 8 * fq;
        float rsv[8];
#pragma unroll
        for (int it = 0; it < 8; ++it) rsv[it] = rowsq[row0 + (it >> 2) * 128 + (it & 3) * 16];
#pragma unroll
        for (int ai = 0; ai < 2; ++ai)
#pragma unroll
            for (int m = 0; m < 4; ++m) {
                const int row = row0 + ai * 128 + m * 16; const float rs = rsqrtf(rsv[ai * 4 + m] * (1.f / 1024.f) + EPS);
#pragma unroll
                for (int bj = 0; bj < 2; ++bj) {
                    const f32x4 v0 = acc[ai][bj][m][0] * rs, v1 = acc[ai][bj][m][1] * rs;
                    u32x4 w; w.x = cvt_pk_bf16(v0[0], v0[1]); w.y = cvt_pk_bf16(v0[2], v0[3]); w.z = cvt_pk_bf16(v1[0], v1[1]); w.w = cvt_pk_bf16(v1[2], v1[3]);
                    *(u32x4*)(z2 + (size_t)row * 3072 + col0 + bj * 128) = w;
                }
            }
    }
};

template <int MODE>
__device__ __forceinline__ void transpose_w(const float* __restrict__ src, int K, int Nsrc, bf16_t* __restrict__ dst, int Ndst, const float* __restrict__ gain, long gtid, long gsz) {
    const long total = (long)(K / 8) * Ndst;
#pragma unroll 4
    for (long it = gtid; it < total; it += gsz) {
        const int n = (int)(it % Ndst), k8 = (int)(it / Ndst);
        int sc = n;
        if (MODE == 1) { if (n < 3584) sc = n; else sc = n + 16; }
        u32x4 w = {0u, 0u, 0u, 0u};
        if (sc >= 0) {
            const float* s = src + (size_t)(k8 * 8) * Nsrc + sc;
            float v0 = s[0], v1 = s[(size_t)Nsrc], v2 = s[(size_t)2 * Nsrc], v3 = s[(size_t)3 * Nsrc], v4 = s[(size_t)4 * Nsrc], v5 = s[(size_t)5 * Nsrc], v6 = s[(size_t)6 * Nsrc], v7 = s[(size_t)7 * Nsrc];
            if (gain) { const f32x4 g0 = *(const f32x4*)(gain + k8 * 8), g1 = *(const f32x4*)(gain + k8 * 8 + 4); v0 *= g0[0]; v1 *= g0[1]; v2 *= g0[2]; v3 *= g0[3]; v4 *= g1[0]; v5 *= g1[1]; v6 *= g1[2]; v7 *= g1[3]; }
            w.x = cvt_pk_bf16(v0, v1); w.y = cvt_pk_bf16(v2, v3); w.z = cvt_pk_bf16(v4, v5); w.w = cvt_pk_bf16(v6, v7);
        }
        *(u32x4*)(dst + (size_t)n * K + k8 * 8) = w;
    }
}

__device__ __forceinline__ void phase0(const Params& p) {
    unsigned char* ws = p.ws;
    const long gtid = (long)blockIdx.x * NTHR + threadIdx.x, gsz = (long)gridDim.x * NTHR;
    transpose_w<1>(p.in[8], 1024, 5648, (bf16_t*)(ws + WS_WINE), 5632, p.in[7], gtid, gsz);
    for (long it = gtid; it < 128L * 512; it += gsz) {
        const int n = (int)(it & 511), k8 = (int)(it >> 9);
        float wl[16];
#pragma unroll
        for (int r = 0; r < 16; ++r) wl[r] = p.in[9][r * 512 + n];
        float v[8];
#pragma unroll
        for (int i = 0; i < 8; ++i) {
            const float* wr_ = p.in[8] + (size_t)(k8 * 8 + i) * 5648 + 3584;
            float a = 0.f;
#pragma unroll
            for (int r4 = 0; r4 < 4; ++r4) { const f32x4 x = *(const f32x4*)(wr_ + r4 * 4); a += x[0] * wl[r4 * 4] + x[1] * wl[r4 * 4 + 1] + x[2] * wl[r4 * 4 + 2] + x[3] * wl[r4 * 4 + 3]; }
            v[i] = a * p.in[7][k8 * 8 + i];
        }
        u32x4 w; w.x = cvt_pk_bf16(v[0], v[1]); w.y = cvt_pk_bf16(v[2], v[3]); w.z = cvt_pk_bf16(v[4], v[5]); w.w = cvt_pk_bf16(v[6], v[7]);
        *(u32x4*)((bf16_t*)(ws + WS_WINE) + (size_t)(5632 + n) * 1024 + k8 * 8) = w;
    }
    transpose_w<0>(p.in[13], 2048, 1024, (bf16_t*)(ws + WS_WOUTE), 1024, nullptr, gtid, gsz);
    transpose_w<0>(p.in[15], 1024, 3072, (bf16_t*)(ws + WS_WINO), 3072, p.in[14], gtid, gsz);
    transpose_w<0>(p.in[23], 1536, 1024, (bf16_t*)(ws + WS_WOUTO), 1024, nullptr, gtid, gsz);
    for (int nb = 0; nb < 8; ++nb) {
        transpose_w<0>(p.in[18] + nb * 192 * 192, 192, 192, (bf16_t*)(ws + WS_WA) + nb * 192 * 192, 192, nullptr, gtid, gsz);
        transpose_w<0>(p.in[20] + nb * 192 * 192, 192, 192, (bf16_t*)(ws + WS_WI) + nb * 192 * 192, 192, nullptr, gtid, gsz);
    }
    { float* z = (float*)(ws + WS_RSQ1); const long nz = (long)T * 2; for (long i = gtid; i < nz; i += gsz) z[i] = 0.f; }
    const int lane = threadIdx.x & 63; const int gw = (int)(gtid >> 6), nw = (int)(gsz >> 6);
    bf16_t* xb = (bf16_t*)(ws + WS_XB); float* rstd = (float*)(ws + WS_RSTD0);
#pragma unroll 4
    for (int row = gw; row < T; row += nw) {
        const float* xr = (row < T_P) ? p.in[0] + (size_t)row * 1024 : p.in[1] + (size_t)(row - T_P) * 1024;
        float ss = 0.f;
#pragma unroll
        for (int i = 0; i < 4; ++i) {
            const f32x4 v = *(const f32x4*)(xr + i * 256 + lane * 4);
            ss += v[0] * v[0] + v[1] * v[1] + v[2] * v[2] + v[3] * v[3];
            u32x2 w; w.x = cvt_pk_bf16(v[0], v[1]); w.y = cvt_pk_bf16(v[2], v[3]);
            *(u32x2*)(xb + (size_t)row * 1024 + i * 256 + lane * 4) = w;
        }
#pragma unroll
        for (int o = 32; o >= 1; o >>= 1) ss += __shfl_xor(ss, o);
        if (lane == 0) rstd[row] = rsqrtf(ss * (1.f / 1024.f) + EPS);
    }
}

__device__ __forceinline__ void attn_item(const Params& p, LAS unsigned char* L, int item, bf16_t* Yd, int ldd) {
    unsigned char* ws = p.ws;
    const int tid = threadIdx.x, lane = tid & 63, w = tid >> 6, r16 = lane & 15, q4 = lane >> 4;
    LAS bf16_t* Ks = (LAS bf16_t*)L;
    LAS bf16_t* Vs = (LAS bf16_t*)(L + 192 * 72 * 2);
    const unsigned vbase = (unsigned)(size_t)L + 192u * 72u * 2u;
    const bf16_t* Qb = (const bf16_t*)(ws + WS_Q); const bf16_t* Kb = (const bf16_t*)(ws + WS_K); const bf16_t* Vb = (const bf16_t*)(ws + WS_V);
    const bf16_t* Yb = (const bf16_t*)(ws + WS_GATE);
    const bool smp = item >= 2048;
    int b, c, kh; size_t row0;
    if (!smp) { kh = item & 3; c = (item >> 2) & 31; b = item >> 7; row0 = (size_t)b * 2048 + c * 64; }
    else { const int i2 = item - 2048; kh = i2 & 3; b = i2 >> 2; c = 0; row0 = (size_t)T_P + b * 64; }
    const int g = w >> 1, i0 = (w & 1) * 32, h = kh * 4 + g;
    bf16x8 qf[2][2];
#pragma unroll
    for (int qt = 0; qt < 2; ++qt) {
#pragma unroll
        for (int ks = 0; ks < 2; ++ks) qf[qt][ks] = *(const bf16x8*)(Qb + (row0 + i0 + qt * 16 + r16) * 1024 + h * 64 + ks * 32 + q4 * 8);
    }
#pragma unroll
    for (int i = 0; i < 3; ++i) {
        const int idx = tid + i * 512, key = idx >> 3, dg = idx & 7;
        u32x4 kv = {0u, 0u, 0u, 0u}, vv = {0u, 0u, 0u, 0u};
        if (!smp) {
            const int pos = c * 64 - 128 + key;
            if (pos >= 0) { const size_t r = (size_t)b * 2048 + pos; kv = *(const u32x4*)(Kb + r * 256 + kh * 64 + dg * 8); vv = *(const u32x4*)(Vb + r * 256 + kh * 64 + dg * 8); }
        } else {
            if (key < 128) {
                const size_t o = ((size_t)(b * 128 + key) * 4 + kh) * 64 + dg * 8;
                const f32x4 k0 = *(const f32x4*)(p.in[2] + o), k1 = *(const f32x4*)(p.in[2] + o + 4), v0 = *(const f32x4*)(p.in[3] + o), v1 = *(const f32x4*)(p.in[3] + o + 4);
                kv.x = cvt_pk_bf16(k0[0], k0[1]); kv.y = cvt_pk_bf16(k0[2], k0[3]); kv.z = cvt_pk_bf16(k1[0], k1[1]); kv.w = cvt_pk_bf16(k1[2], k1[3]);
                vv.x = cvt_pk_bf16(v0[0], v0[1]); vv.y = cvt_pk_bf16(v0[2], v0[3]); vv.z = cvt_pk_bf16(v1[0], v1[1]); vv.w = cvt_pk_bf16(v1[2], v1[3]);
            } else { const size_t r = (size_t)T_P + b * 64 + key - 128; kv = *(const u32x4*)(Kb + r * 256 + kh * 64 + dg * 8); vv = *(const u32x4*)(Vb + r * 256 + kh * 64 + dg * 8); }
        }
        *(LAS u32x4*)(Ks + key * 72 + dg * 8) = kv;
        *(LAS u32x4*)(Vs + key * 72 + dg * 8) = vv;
    }
    __syncthreads();
    const float slope = exp2f(-0.5f * (float)(h + 1));
    const float sink = p.in[11][h];
    const unsigned va = vbase + (unsigned)(((q4 * 4 + (r16 >> 2)) * 72 + 4 * (r16 & 3)) * 2);
#pragma unroll 1
    for (int qt = 0; qt < 2; ++qt) {
        const int i = i0 + qt * 16 + r16;
        const bf16x8 qa = qt ? qf[1][0] : qf[0][0], qb = qt ? qf[1][1] : qf[0][1];
        u32x2 gv[4];
#pragma unroll
        for (int dt = 0; dt < 4; ++dt) gv[dt] = *(const u32x2*)(Yb + (row0 + i) * 2048 + h * 64 + dt * 16 + q4 * 4);
        f32x4 sacc[12];
#pragma unroll
        for (int kt = 0; kt < 12; ++kt) {
            const bf16x8 kf0 = *(const LAS bf16x8*)(Ks + (kt * 16 + r16) * 72 + q4 * 8), kf1 = *(const LAS bf16x8*)(Ks + (kt * 16 + r16) * 72 + 32 + q4 * 8);
            f32x4 a = {0.f, 0.f, 0.f, 0.f}; a = MFMA16(kf0, qa, a); a = MFMA16(kf1, qb, a); sacc[kt] = a;
        }
        float m = -3e38f;
#pragma unroll
        for (int kt = 0; kt < 12; ++kt)
#pragma unroll
            for (int jj = 0; jj < 4; ++jj) {
                const int j = kt * 16 + q4 * 4 + jj;
                float sv = sacc[kt][jj] - slope * fabsf((float)(128 + i - j));
                if (!smp && (c * 64 - 128 + j) < 0) sv = -1e30f;
                sacc[kt][jj] = sv; m = fmaxf(m, sv);
            }
        m = fmaxf(m, __shfl_xor(m, 16)); m = fmaxf(m, __shfl_xor(m, 32)); m = fmaxf(m, sink);
        float l = 0.f;
#pragma unroll
        for (int kt = 0; kt < 12; ++kt)
#pragma unroll
            for (int jj = 0; jj < 4; ++jj) { const float pr = __expf(sacc[kt][jj] - m); sacc[kt][jj] = pr; l += pr; }
        l += __shfl_xor(l, 16); l += __shfl_xor(l, 32); l += __expf(sink - m);
        const float inv = 1.f / l;
        f32x4 oacc[4];
#pragma unroll
        for (int dt = 0; dt < 4; ++dt) oacc[dt] = (f32x4){0.f, 0.f, 0.f, 0.f};
#pragma unroll
        for (int kb = 0; kb < 6; ++kb) {
            const bf16x8 pf = pack8(sacc[2 * kb], sacc[2 * kb + 1]);
            bf16x4 l0, h0, l1, h1, l2, h2, l3, h3;
            const unsigned vk = va + (unsigned)(kb * 32 * 144);
            asm volatile("ds_read_b64_tr_b16 %0, %8\n\tds_read_b64_tr_b16 %1, %8 offset:2304\n\t"
                         "ds_read_b64_tr_b16 %2, %8 offset:32\n\tds_read_b64_tr_b16 %3, %8 offset:2336\n\t"
                         "ds_read_b64_tr_b16 %4, %8 offset:64\n\tds_read_b64_tr_b16 %5, %8 offset:2368\n\t"
                         "ds_read_b64_tr_b16 %6, %8 offset:96\n\tds_read_b64_tr_b16 %7, %8 offset:2400\n\t"
                         "s_waitcnt lgkmcnt(0)"
                         : "=&v"(l0), "=&v"(h0), "=&v"(l1), "=&v"(h1), "=&v"(l2), "=&v"(h2), "=&v"(l3), "=&v"(h3) : "v"(vk) : "memory");
            oacc[0] = MFMA16(cat4(l0, h0), pf, oacc[0]); oacc[1] = MFMA16(cat4(l1, h1), pf, oacc[1]);
            oacc[2] = MFMA16(cat4(l2, h2), pf, oacc[2]); oacc[3] = MFMA16(cat4(l3, h3), pf, oacc[3]);
        }
#pragma unroll
        for (int dt = 0; dt < 4; ++dt) {
            const u32x2 gq = gv[dt];
            const f32x4 o = oacc[dt] * inv;
            u32x2 wv; wv.x = cvt_pk_bf16(o[0] * siluf(bflo(gq.x)), o[1] * siluf(bfhi(gq.x))); wv.y = cvt_pk_bf16(o[2] * siluf(bflo(gq.y)), o[3] * siluf(bfhi(gq.y)));
            *(u32x2*)(Yd + (row0 + i) * ldd + h * 64 + dt * 16 + q4 * 4) = wv;
        }
    }
    __syncthreads();
}

constexpr size_t WS_ET = WS_XB + 9437184;
constexpr size_t WS_AB = WS_XB + 16777216;
static_assert(WS_AB + (size_t)T * 256 * 2 <= WS_RSTD0, "XB scratch overflow");

__device__ __forceinline__ void gla_prep_item(const Params& p, LAS unsigned char* L, int item) {
    unsigned char* ws = p.ws;
    const int tid = threadIdx.x, lane = tid & 63, w = tid >> 6, r16 = lane & 15, q4 = lane >> 4;
    LAS bf16_t* QG = (LAS bf16_t*)L;
    LAS bf16_t* KG = (LAS bf16_t*)(L + 17408);
    LAS bf16_t* Gs = (LAS bf16_t*)(L + 34816);
    LAS float* Gf = (LAS float*)(L + 52224);
    LAS float* GT = (LAS float*)(L + 84992);
    int b, h; unsigned row0;
    if (item < 2048) { h = item & 3; const int c = (item >> 2) & 31; b = item >> 7; row0 = (unsigned)b * 2048 + c * 64; }
    else { const int i2 = item - 2048; h = i2 & 3; b = i2 >> 2; row0 = (unsigned)T_P + b * 64; }
    bf16_t* BQ = (bf16_t*)(ws + WS_BQ); bf16_t* BKb = (bf16_t*)(ws + WS_BK); const bf16_t* GB = (const bf16_t*)(ws + WS_BLR);
    float* ET = (float*)(ws + WS_ET); bf16_t* AB = (bf16_t*)(ws + WS_AB);
    const int c = tid & 127, tg = tid >> 7;
    const int pt0 = tid >> 4, pt1 = (tid + 512) >> 4, poc = tid & 15;
    const unsigned o0 = (row0 + pt0) * 512u + h * 128 + poc * 8, o1 = (row0 + pt1) * 512u + h * 128 + poc * 8;
    const u32x4 pg0 = *(const u32x4*)(GB + o0), pg1 = *(const u32x4*)(GB + o1);
    const u32x4 pq0 = *(const u32x4*)(BQ + o0), pq1 = *(const u32x4*)(BQ + o1), pk0 = *(const u32x4*)(BKb + o0), pk1 = *(const u32x4*)(BKb + o1);
    *(LAS u32x4*)(Gs + pt0 * 136 + poc * 8) = pg0; *(LAS u32x4*)(Gs + pt1 * 136 + poc * 8) = pg1;
    lds_barrier();
    {
        float cs = 0.f;
#pragma unroll
        for (int tt = 0; tt < 16; ++tt) { cs += bf2f(Gs[(tg * 16 + tt) * 136 + c]); Gf[(tg * 16 + tt) * 128 + c] = cs; }
        GT[tg * 128 + c] = cs;
    }
    lds_barrier();
#pragma unroll
    for (int i = 0; i < 2; ++i) {
        const int t = i ? pt1 : pt0; const int tgp = t >> 4;
        const u32x4 qw = i ? pq1 : pq0, kw = i ? pk1 : pk0;
        float G[8], tot[8];
        { const f32x4 a0 = *(const LAS f32x4*)(Gf + t * 128 + poc * 8), a1 = *(const LAS f32x4*)(Gf + t * 128 + poc * 8 + 4);
          G[0] = a0[0]; G[1] = a0[1]; G[2] = a0[2]; G[3] = a0[3]; G[4] = a1[0]; G[5] = a1[1]; G[6] = a1[2]; G[7] = a1[3]; }
#pragma unroll
        for (int j = 0; j < 8; ++j) tot[j] = 0.f;
#pragma unroll
        for (int g2 = 0; g2 < 4; ++g2) {
            const f32x4 a0 = *(const LAS f32x4*)(GT + g2 * 128 + poc * 8), a1 = *(const LAS f32x4*)(GT + g2 * 128 + poc * 8 + 4);
            const float sel = (g2 < tgp) ? 1.f : 0.f;
            G[0] += sel * a0[0]; G[1] += sel * a0[1]; G[2] += sel * a0[2]; G[3] += sel * a0[3]; G[4] += sel * a1[0]; G[5] += sel * a1[1]; G[6] += sel * a1[2]; G[7] += sel * a1[3];
            tot[0] += a0[0]; tot[1] += a0[1]; tot[2] += a0[2]; tot[3] += a0[3]; tot[4] += a1[0]; tot[5] += a1[1]; tot[6] += a1[2]; tot[7] += a1[3];
        }
        if (i == 0 && tid < 16) {
            float* ep = ET + (size_t)(row0 >> 6) * 512 + h * 128 + poc * 8;
            *(f32x4*)ep = (f32x4){__expf(tot[0]), __expf(tot[1]), __expf(tot[2]), __expf(tot[3])};
            *(f32x4*)(ep + 4) = (f32x4){__expf(tot[4]), __expf(tot[5]), __expf(tot[6]), __expf(tot[7])};
        }
        float qv[8], kv[8];
        unpack8(qw, qv); unpack8(kw, kv);
#pragma unroll
        for (int j = 0; j < 8; ++j) { const float eg = __expf(G[j]); qv[j] *= eg; kv[j] *= rcpf_(eg); }
        u32x4 qo, ko;
        qo.x = cvt_pk_bf16(qv[0], qv[1]); qo.y = cvt_pk_bf16(qv[2], qv[3]); qo.z = cvt_pk_bf16(qv[4], qv[5]); qo.w = cvt_pk_bf16(qv[6], qv[7]);
        ko.x = cvt_pk_bf16(kv[0], kv[1]); ko.y = cvt_pk_bf16(kv[2], kv[3]); ko.z = cvt_pk_bf16(kv[4], kv[5]); ko.w = cvt_pk_bf16(kv[6], kv[7]);
        *(LAS u32x4*)(QG + t * 136 + poc * 8) = qo; *(LAS u32x4*)(KG + t * 136 + poc * 8) = ko;
        *(u32x4*)(BQ + (i ? o1 : o0)) = qo; *(u32x4*)(BKb + (i ? o1 : o0)) = ko;
    }
    lds_barrier();
    {
        const int it = w >> 1, jt0 = (w & 1) * 2;
        f32x4 at[2];
        at[0] = (f32x4){0.f, 0.f, 0.f, 0.f}; at[1] = (f32x4){0.f, 0.f, 0.f, 0.f};
#pragma unroll
        for (int ks = 0; ks < 4; ++ks) {
            const bf16x8 qf = *(const LAS bf16x8*)(QG + (it * 16 + r16) * 136 + ks * 32 + q4 * 8);
#pragma unroll
            for (int t2 = 0; t2 < 2; ++t2) {
                const bf16x8 kf = *(const LAS bf16x8*)(KG + ((jt0 + t2) * 16 + r16) * 136 + ks * 32 + q4 * 8);
                at[t2] = MFMA16(kf, qf, at[t2]);
            }
        }
        const int i = it * 16 + r16;
#pragma unroll
        for (int t2 = 0; t2 < 2; ++t2) {
            f32x4 v = at[t2];
#pragma unroll
            for (int jj = 0; jj < 4; ++jj) { const int j = (jt0 + t2) * 16 + q4 * 4 + jj; if (j > i) v[jj] = 0.f; }
            u32x2 wv; wv.x = cvt_pk_bf16(v[0], v[1]); wv.y = cvt_pk_bf16(v[2], v[3]);
            *(u32x2*)(AB + (size_t)(row0 + i) * 256 + h * 64 + (jt0 + t2) * 16 + q4 * 4) = wv;
        }
    }
    lds_barrier();
}

__device__ __forceinline__ void gla_scan_item(const Params& p, LAS unsigned char* L, int item, bool dummy) {
    unsigned char* ws = p.ws;
    const int tid = threadIdx.x, lane = tid & 63, w = tid >> 6, r16 = lane & 15, q4 = lane >> 4;
    LAS bf16_t* QG = (LAS bf16_t*)L;
    LAS bf16_t* KG = (LAS bf16_t*)(L + 17408);
    LAS bf16_t* Vs = (LAS bf16_t*)(L + 34816);
    LAS bf16_t* As = (LAS bf16_t*)(L + 44032);
    LAS float* GL = (LAS float*)(L + 53248);
    const unsigned lbase = (unsigned)(size_t)L;
    const bool smp = item >= 256;
    const int i2 = smp ? item - 256 : item;
    const int b = i2 >> 4, h = (i2 >> 2) & 3, sl = i2 & 3, e0 = sl * 64;
    const int nch = smp ? 1 : 32;
    const unsigned rbase = smp ? (unsigned)T_P + b * 64 : (unsigned)b * 2048;
    const bf16_t* BQ = (const bf16_t*)(ws + WS_BQ); const bf16_t* BKb = (const bf16_t*)(ws + WS_BK); bf16_t* BV = (bf16_t*)(ws + WS_BV);
    const float* ET = (const float*)(ws + WS_ET); const bf16_t* AB = (const bf16_t*)(ws + WS_AB); float* BOSQP = dummy ? p.out + 20000000 : (float*)(ws + WS_XB);
    bf16_t* BVo = dummy ? (bf16_t*)p.out : BV;
    const int pt0 = tid >> 4, pt1 = (tid + 512) >> 4, poc = tid & 15;
    const int vt = tid >> 3, veo = tid & 7;
    const int et = w & 3, ip = w >> 2;
    f32x4 Sacc[8];
#pragma unroll
    for (int d8 = 0; d8 < 8; ++d8) {
        if (smp) {
#pragma unroll
            for (int jj = 0; jj < 4; ++jj) Sacc[d8][jj] = p.in[4][((size_t)(b * 4 + h) * 128 + d8 * 16 + q4 * 4 + jj) * 256 + e0 + et * 16 + r16];
        } else Sacc[d8] = (f32x4){0.f, 0.f, 0.f, 0.f};
    }
    const int tq_ = r16 >> 2, tp_ = r16 & 3;
    const unsigned v4a = lbase + 34816u + (unsigned)(((q4 * 8 + tq_) * 72 + et * 16 + 4 * tp_) * 2);
    const unsigned k4a = lbase + 17408u + (unsigned)(((q4 * 8 + tq_) * 136 + 4 * tp_) * 2);
    struct Pre { u32x4 q0, q1, k0, k1, a, v; f32x4 e; };
    Pre PA, PB;
    PA.e = (f32x4){0.f, 0.f, 0.f, 0.f}; PB.e = (f32x4){0.f, 0.f, 0.f, 0.f};
#define GLA_PREFETCH(P, R) do { \
        const unsigned o0_ = ((R) + pt0) * 512u + h * 128 + poc * 8, o1_ = ((R) + pt1) * 512u + h * 128 + poc * 8; \
        P.q0 = *(const u32x4*)(BQ + o0_); P.q1 = *(const u32x4*)(BQ + o1_); P.k0 = *(const u32x4*)(BKb + o0_); P.k1 = *(const u32x4*)(BKb + o1_); \
        P.a = *(const u32x4*)(AB + ((R) + vt) * 256u + h * 64 + veo * 8); \
        P.v = *(const u32x4*)(BV + ((R) + vt) * 1024u + h * 256 + e0 + veo * 8); \
        if (tid < 32) P.e = *(const f32x4*)(ET + ((R) >> 6) * 512u + h * 128 + tid * 4); } while (0)
    GLA_PREFETCH(PA, rbase);
    if (nch > 1) GLA_PREFETCH(PB, rbase + 64);
    f32x4 po0 = {0.f, 0.f, 0.f, 0.f}, po1 = {0.f, 0.f, 0.f, 0.f}; unsigned prow = 0; bool pend = false;
#define GLA_STORE_OUT() do { \
            _Pragma("unroll") for (int x2 = 0; x2 < 2; ++x2) { \
                const unsigned row = prow + (ip * 2 + x2) * 16 + r16; \
                const f32x4 o = x2 ? po1 : po0; \
                u32x2 wv; wv.x = cvt_pk_bf16(o[0], o[1]); wv.y = cvt_pk_bf16(o[2], o[3]); \
                *(u32x2*)(BVo + row * 1024u + h * 256 + e0 + et * 16 + q4 * 4) = wv; \
                float ss = o[0] * o[0] + o[1] * o[1] + o[2] * o[2] + o[3] * o[3]; \
                ss += __shfl_xor(ss, 16); ss += __shfl_xor(ss, 32); \
                if (q4 == 0) BOSQP[row * 64u + h * 16 + sl * 4 + et] = ss; \
            } } while (0)
#define GLA_CHUNK(P, CI) do { \
        const unsigned r0 = rbase + (unsigned)(CI) * 64; \
        *(LAS u32x4*)(QG + pt0 * 136 + poc * 8) = P.q0; *(LAS u32x4*)(QG + pt1 * 136 + poc * 8) = P.q1; \
        *(LAS u32x4*)(KG + pt0 * 136 + poc * 8) = P.k0; *(LAS u32x4*)(KG + pt1 * 136 + poc * 8) = P.k1; \
        *(LAS u32x4*)(As + vt * 72 + veo * 8) = P.a; *(LAS u32x4*)(Vs + vt * 72 + veo * 8) = P.v; \
        if (tid < 32) *(LAS f32x4*)(GL + tid * 4) = P.e; \
        lds_barrier(); \
        if (pend) GLA_STORE_OUT(); \
        if ((CI) + 2 < nch) GLA_PREFETCH(P, r0 + 128); \
        bf16x8 vf[2]; \
        { bf16x4 a0, a1, b0, b1; \
          asm volatile("ds_read_b64_tr_b16 %0, %4\n\tds_read_b64_tr_b16 %1, %4 offset:576\n\tds_read_b64_tr_b16 %2, %4 offset:4608\n\tds_read_b64_tr_b16 %3, %4 offset:5184\n\ts_waitcnt lgkmcnt(0)" \
                       : "=&v"(a0), "=&v"(a1), "=&v"(b0), "=&v"(b1) : "v"(v4a) : "memory"); \
          vf[0] = cat4(a0, a1); vf[1] = cat4(b0, b1); } \
        f32x4 ot[2]; \
        ot[0] = (f32x4){0.f, 0.f, 0.f, 0.f}; ot[1] = (f32x4){0.f, 0.f, 0.f, 0.f}; \
        _Pragma("unroll") for (int x2 = 0; x2 < 2; ++x2) \
            _Pragma("unroll") for (int jb = 0; jb < 2; ++jb) { \
                const bf16x8 af = *(const LAS bf16x8*)(As + ((ip * 2 + x2) * 16 + r16) * 72 + jb * 32 + q4 * 8); \
                ot[x2] = MFMA16(vf[jb], af, ot[x2]); } \
        _Pragma("unroll") for (int db = 0; db < 4; ++db) { \
            const bf16x8 sf = pack8(Sacc[2 * db], Sacc[2 * db + 1]); \
            _Pragma("unroll") for (int x2 = 0; x2 < 2; ++x2) { \
                const LAS bf16_t* qp = QG + ((ip * 2 + x2) * 16 + r16) * 136 + db * 32 + q4 * 4; \
                const bf16x8 qv = cat4(*(const LAS bf16x4*)qp, *(const LAS bf16x4*)(qp + 16)); \
                ot[x2] = MFMA16(sf, qv, ot[x2]); } } \
        po0 = ot[0]; po1 = ot[1]; prow = r0; pend = true; \
        _Pragma("unroll") for (int jb = 0; jb < 2; ++jb) { \
            bf16x4 kl[8], kh[8]; \
            const unsigned ka = k4a + (unsigned)(jb * 32 * 272); \
            asm volatile("ds_read_b64_tr_b16 %0, %16 offset:0\n\t" "ds_read_b64_tr_b16 %1, %16 offset:1088\n\t" "ds_read_b64_tr_b16 %2, %16 offset:32\n\t" "ds_read_b64_tr_b16 %3, %16 offset:1120\n\t" "ds_read_b64_tr_b16 %4, %16 offset:64\n\t" "ds_read_b64_tr_b16 %5, %16 offset:1152\n\t" "ds_read_b64_tr_b16 %6, %16 offset:96\n\t" "ds_read_b64_tr_b16 %7, %16 offset:1184\n\t" "ds_read_b64_tr_b16 %8, %16 offset:128\n\t" "ds_read_b64_tr_b16 %9, %16 offset:1216\n\t" "ds_read_b64_tr_b16 %10, %16 offset:160\n\t" "ds_read_b64_tr_b16 %11, %16 offset:1248\n\t" "ds_read_b64_tr_b16 %12, %16 offset:192\n\t" "ds_read_b64_tr_b16 %13, %16 offset:1280\n\t" "ds_read_b64_tr_b16 %14, %16 offset:224\n\t" "ds_read_b64_tr_b16 %15, %16 offset:1312\n\t" "s_waitcnt lgkmcnt(0)" \
                         : "=&v"(kl[0]), "=&v"(kh[0]), "=&v"(kl[1]), "=&v"(kh[1]), "=&v"(kl[2]), "=&v"(kh[2]), "=&v"(kl[3]), "=&v"(kh[3]), "=&v"(kl[4]), "=&v"(kh[4]), "=&v"(kl[5]), "=&v"(kh[5]), "=&v"(kl[6]), "=&v"(kh[6]), "=&v"(kl[7]), "=&v"(kh[7]) : "v"(ka) : "memory"); \
            _Pragma("unroll") for (int d8 = 0; d8 < 8; ++d8) Sacc[d8] = MFMA16(cat4(kl[d8], kh[d8]), vf[jb], Sacc[d8]); } \
        _Pragma("unroll") for (int d8 = 0; d8 < 8; ++d8) { \
            const f32x4 dec = *(const LAS f32x4*)(GL + d8 * 16 + q4 * 4); \
            Sacc[d8] = Sacc[d8] * dec; } \
        lds_barrier(); \
    } while (0)
    for (int ci = 0; ci < nch; ci += 2) {
        GLA_CHUNK(PA, ci);
        if (ci + 1 < nch) GLA_CHUNK(PB, ci + 1);
    }
    if (pend) GLA_STORE_OUT();
#undef GLA_STORE_OUT
#undef GLA_PREFETCH
#undef GLA_CHUNK
    if (ip == 0 && !dummy) {
        float* og = p.out + (smp ? O_GS : O_GP);
#pragma unroll
        for (int d8 = 0; d8 < 8; ++d8)
#pragma unroll
            for (int jj = 0; jj < 4; ++jj) og[((size_t)(b * 4 + h) * 128 + d8 * 16 + q4 * 4 + jj) * 256 + e0 + et * 16 + r16] = Sacc[d8][jj];
    }
}

__device__ __forceinline__ void phase2a(const Params& p, LAS unsigned char* L) {
#ifndef NO_PREP
    for (int it = blockIdx.x; it < 2176; it += gridDim.x) gla_prep_item(p, L, it);
#endif
#ifndef NO_ATTN
    for (int it = blockIdx.x; it < 2176; it += gridDim.x) attn_item(p, L, it, (bf16_t*)(p.ws + WS_GATE), 2048);
#endif
}
__device__ __forceinline__ void phase2b(const Params& p, LAS unsigned char* L) {
#ifndef NO_SCAN
#ifdef PROBE_SCAN2
    for (int it = blockIdx.x; it < 768; it += gridDim.x) gla_scan_item(p, L, it, true);
#endif
    if (gridDim.x == 256) {
        const int xcd = blockIdx.x & 7, loc = blockIdx.x >> 3;
        const int base = (xcd * 8 + (loc >> 2)) * 4 + (loc & 3);
        gla_scan_item(p, L, base, false); gla_scan_item(p, L, 256 + base, false); gla_scan_item(p, L, 512 + base, false);
    } else {
        for (int it = blockIdx.x; it < 768; it += gridDim.x) gla_scan_item(p, L, it, false);
    }
#endif
}

__device__ __forceinline__ void phase3(const Params& p) {
    unsigned char* ws = p.ws;
    const bf16_t* BV = (const bf16_t*)(ws + WS_BV); bf16_t* Yb = (bf16_t*)(ws + WS_GATE); const float* BOSQP = (const float*)(ws + WS_XB);
    const float* gg = p.in[12];
    const long gtid = (long)blockIdx.x * NTHR + threadIdx.x, gsz = (long)gridDim.x * NTHR;
    const long total = (long)T * 128;
    for (long it = gtid; it < total; it += gsz) {
        const long row = it >> 7; const int c8 = (int)(it & 127) * 8, h = c8 >> 8;
        float sq;
        { const f32x4 s0 = *(const f32x4*)(BOSQP + row * 64 + h * 16), s1 = *(const f32x4*)(BOSQP + row * 64 + h * 16 + 4), s2 = *(const f32x4*)(BOSQP + row * 64 + h * 16 + 8), s3 = *(const f32x4*)(BOSQP + row * 64 + h * 16 + 12);
          sq = ((s0[0] + s0[1]) + (s0[2] + s0[3])) + ((s1[0] + s1[1]) + (s1[2] + s1[3])) + ((s2[0] + s2[1]) + (s2[2] + s2[3])) + ((s3[0] + s3[1]) + (s3[2] + s3[3])); }
        const float rs = rsqrtf(sq * (1.f / 256.f) + EPS);
        const u32x4 bo = *(const u32x4*)(BV + row * 1024 + c8);
        const u32x4 gt = *(const u32x4*)(Yb + row * 2048 + 1024 + c8);
        const f32x4 g0 = *(const f32x4*)(gg + (c8 & 255)), g1 = *(const f32x4*)(gg + (c8 & 255) + 4);
        u32x4 o;
        o.x = cvt_pk_bf16(bflo(bo.x) * rs * g0[0] * siluf(bflo(gt.x)), bfhi(bo.x) * rs * g0[1] * siluf(bfhi(gt.x)));
        o.y = cvt_pk_bf16(bflo(bo.y) * rs * g0[2] * siluf(bflo(gt.y)), bfhi(bo.y) * rs * g0[3] * siluf(bfhi(gt.y)));
        o.z = cvt_pk_bf16(bflo(bo.z) * rs * g1[0] * siluf(bflo(gt.z)), bfhi(bo.z) * rs * g1[1] * siluf(bfhi(gt.z)));
        o.w = cvt_pk_bf16(bflo(bo.w) * rs * g1[2] * siluf(bflo(gt.w)), bfhi(bo.w) * rs * g1[3] * siluf(bfhi(gt.w)));
        *(u32x4*)(Yb + row * 2048 + 1024 + c8) = o;
    }
}

__device__ __forceinline__ void lru_item(const Params& p, LAS unsigned char* L, int item) {
    unsigned char* ws = p.ws;
    const int tid = threadIdx.x, lane = tid & 63, w = tid >> 6, r16 = lane & 15, q4 = lane >> 4;
    LAS bf16_t* Wl = (LAS bf16_t*)L;
    LAS bf16_t* U = (LAS bf16_t*)(L + 76800);
    LAS float* Aa = (LAS float*)(L + 102400);
    LAS float* Bb = (LAS float*)(L + 126976);
    LAS float* SP = (LAS float*)(L + 151552);
    LAS float* SH = (LAS float*)(L + 153088);
    LAS float* HC = (LAS float*)(L + 154624);
    LAS float* CW = (LAS float*)(L + 155392);
    const bool smp = item >= 256;
    const int i2 = smp ? item - 256 : item;
    const int b = i2 >> 4, nb = (i2 >> 1) & 7, hf = i2 & 1;
    const int nch = smp ? 1 : 32;
    const unsigned rbase = smp ? (unsigned)T_P + b * 64 : (unsigned)b * 2048;
    const bf16_t* Z2 = (const bf16_t*)(ws + WS_Z2); bf16_t* Y2 = (bf16_t*)(ws + WS_Y2);
    const bf16_t* WA = (const bf16_t*)(ws + WS_WA) + nb * 192 * 192; const bf16_t* WI = (const bf16_t*)(ws + WS_WI) + nb * 192 * 192;
    for (int idx = tid; idx < 192 * 24; idx += NTHR) {
        const int r = idx / 24, g8 = idx % 24;
        const bf16_t* src = (r < 96) ? WA + (size_t)(hf * 96 + r) * 192 + g8 * 8 : WI + (size_t)(hf * 96 + r - 96) * 192 + g8 * 8;
        *(LAS u32x4*)(Wl + r * 200 + g8 * 8) = *(const u32x4*)src;
    }
    const bool cthr = tid < 384;
    const int cgp = tid % 24, tq = (tid / 24) & 15;
    const int chc = nb * 192 + cgp * 8;
    for (int idx = tid; idx < 5 * 192; idx += NTHR) { const int j = idx / 192, cc = idx % 192; CW[idx] = (j < 4) ? p.in[16][j * 1536 + nb * 192 + cc] : p.in[17][nb * 192 + cc]; }
    const int mt = w & 3, pg = w >> 2;
    float bra[3], bri[3], sp[3];
#pragma unroll
    for (int cp = 0; cp < 3; ++cp) {
        const int ch = nb * 192 + hf * 96 + (pg * 3 + cp) * 16 + r16;
        bra[cp] = p.in[19][ch]; bri[cp] = p.in[21][ch];
        const float lam = p.in[22][ch];
        sp[cp] = 8.f * (fmaxf(-lam, 0.f) + log1pf(__expf(-fabsf(lam))));
    }
    if (tid < 96) HC[tid] = smp ? p.in[6][b * 1536 + nb * 192 + hf * 96 + tid] : 0.f;
    const int sch0 = tid % 96, sseg0 = (tid / 96) & 3;
    const int ot0 = tid / 12, og0 = tid % 12, ot1 = (tid + 512) / 12, og1 = (tid + 512) % 12;
    const bool o1 = tid < 256;
    const int och0 = nb * 192 + hf * 96 + og0 * 8, och1 = nb * 192 + hf * 96 + og1 * 8;
    lds_barrier();
    u32x4 xr[7]; u32x4 pg0, pg1 = {0u, 0u, 0u, 0u};
#pragma unroll
    for (int r = 0; r < 7; ++r) {
        xr[r] = (u32x4){0u, 0u, 0u, 0u};
        const int pos = 4 * tq - 3 + r;
        if (cthr) {
            if (pos >= 0) xr[r] = *(const u32x4*)(Z2 + (unsigned)((rbase + pos) * 3072u + chc));
            else if (smp) {
                const float* hp = p.in[5] + ((size_t)b * 3 + (3 + pos)) * 1536 + chc;
                const f32x4 h0 = *(const f32x4*)hp, h1 = *(const f32x4*)(hp + 4);
                xr[r].x = cvt_pk_bf16(h0[0], h0[1]); xr[r].y = cvt_pk_bf16(h0[2], h0[3]); xr[r].z = cvt_pk_bf16(h1[0], h1[1]); xr[r].w = cvt_pk_bf16(h1[2], h1[3]);
            }
        }
    }
    pg0 = *(const u32x4*)(Z2 + (unsigned)((rbase + ot0) * 3072u + 1536 + och0));
    if (o1) pg1 = *(const u32x4*)(Z2 + (unsigned)((rbase + ot1) * 3072u + 1536 + och1));
    u32x4 so0 = {0u, 0u, 0u, 0u}, so1 = {0u, 0u, 0u, 0u}; unsigned sr = 0; bool spend = false;
    for (int ci = 0; ci < nch; ++ci) {
        const unsigned r0 = rbase + (unsigned)ci * 64;
        const bool more = (ci + 1 < nch);
        int sch = sch0, sseg = sseg0;
        asm volatile("" : "+v"(sch), "+v"(sseg));
        if (cthr) {
            float xv[7][8];
#pragma unroll
            for (int r = 0; r < 7; ++r) unpack8(xr[r], xv[r]);
            if (hf == 0 && !more && tq == 15) {
                float* oc = p.out + (smp ? O_CS : O_CP) + (size_t)b * 3 * 1536 + chc;
#pragma unroll
                for (int r = 0; r < 3; ++r) { *(f32x4*)(oc + r * 1536) = (f32x4){xv[4 + r][0], xv[4 + r][1], xv[4 + r][2], xv[4 + r][3]}; *(f32x4*)(oc + r * 1536 + 4) = (f32x4){xv[4 + r][4], xv[4 + r][5], xv[4 + r][6], xv[4 + r][7]}; }
            }
            float cw[5][8];
#pragma unroll
            for (int j = 0; j < 5; ++j) { const f32x4 c0 = *(const LAS f32x4*)(CW + j * 192 + cgp * 8), c1 = *(const LAS f32x4*)(CW + j * 192 + cgp * 8 + 4);
                cw[j][0] = c0[0]; cw[j][1] = c0[1]; cw[j][2] = c0[2]; cw[j][3] = c0[3]; cw[j][4] = c1[0]; cw[j][5] = c1[1]; cw[j][6] = c1[2]; cw[j][7] = c1[3]; }
#pragma unroll
            for (int tk = 0; tk < 4; ++tk) {
                float acc[8];
#pragma unroll
                for (int e = 0; e < 8; ++e) acc[e] = cw[4][e] + xv[tk][e] * cw[0][e] + xv[tk + 1][e] * cw[1][e] + xv[tk + 2][e] * cw[2][e] + xv[tk + 3][e] * cw[3][e];
                u32x4 uw; uw.x = cvt_pk_bf16(acc[0], acc[1]); uw.y = cvt_pk_bf16(acc[2], acc[3]); uw.z = cvt_pk_bf16(acc[4], acc[5]); uw.w = cvt_pk_bf16(acc[6], acc[7]);
                *(LAS u32x4*)(U + (4 * tq + tk) * 200 + cgp * 8) = uw;
            }
            if (more) {
#pragma unroll
                for (int r = 0; r < 7; ++r) xr[r] = *(const u32x4*)(Z2 + (unsigned)((r0 + 64 + 4 * tq - 3 + r) * 3072u + chc));
            }
        }
        lds_barrier();
        if (spend) { *(u32x4*)(Y2 + (unsigned)((sr + ot0) * 1536u + och0)) = so0; if (o1) *(u32x4*)(Y2 + (unsigned)((sr + ot1) * 1536u + och1)) = so1; }
        f32x4 ga[3], gi[3];
#pragma unroll
        for (int cp = 0; cp < 3; ++cp) { ga[cp] = (f32x4){0.f, 0.f, 0.f, 0.f}; gi[cp] = (f32x4){0.f, 0.f, 0.f, 0.f}; }
#pragma unroll 2
        for (int ks = 0; ks < 6; ++ks) {
            const bf16x8 uf = *(const LAS bf16x8*)(U + (mt * 16 + r16) * 200 + ks * 32 + q4 * 8);
#pragma unroll
            for (int cp = 0; cp < 3; ++cp) {
                const int ct = pg * 3 + cp;
                const bf16x8 wa = *(const LAS bf16x8*)(Wl + (ct * 16 + r16) * 200 + ks * 32 + q4 * 8), wi = *(const LAS bf16x8*)(Wl + (96 + ct * 16 + r16) * 200 + ks * 32 + q4 * 8);
                ga[cp] = MFMA16(uf, wa, ga[cp]); gi[cp] = MFMA16(uf, wi, gi[cp]);
            }
        }
#pragma unroll
        for (int cp = 0; cp < 3; ++cp) {
            const int cl = (pg * 3 + cp) * 16 + r16;
#pragma unroll
            for (int jj = 0; jj < 4; ++jj) {
                const int t = mt * 16 + q4 * 4 + jj;
                const float rg = sigmf(ga[cp][jj] + bra[cp]), ig = sigmf(gi[cp][jj] + bri[cp]);
                const float z = rg * sp[cp];
                const float a = __expf(-z);
                const float z2 = z + z;
                const float om = (z2 < 0.05f) ? z2 * (1.f - z2 * (0.5f - z2 * (0.16666667f - z2 * 0.041666668f))) : 1.f - a * a;
                const float uu = bf2f(U[t * 200 + hf * 96 + cl]);
                Aa[t * 96 + cl] = a; Bb[t * 96 + cl] = __builtin_amdgcn_sqrtf(om) * ig * uu;
            }
        }
        lds_barrier();
        if (cthr) {
            float P = 1.f, H = 0.f;
#pragma unroll
            for (int t = 0; t < 16; ++t) { const float a = Aa[(sseg * 16 + t) * 96 + sch]; H = a * H + Bb[(sseg * 16 + t) * 96 + sch]; P *= a; }
            SP[sseg * 96 + sch] = P; SH[sseg * 96 + sch] = H;
        }
        lds_barrier();
        if (cthr) {
            float hh = HC[(ci & 1) * 96 + sch];
#pragma unroll
            for (int sg = 0; sg < 3; ++sg) if (sg < sseg) hh = SP[sg * 96 + sch] * hh + SH[sg * 96 + sch];
#pragma unroll
            for (int t = 0; t < 16; ++t) { hh = Aa[(sseg * 16 + t) * 96 + sch] * hh + Bb[(sseg * 16 + t) * 96 + sch]; Bb[(sseg * 16 + t) * 96 + sch] = hh; }
            if (sseg == 3) HC[((ci + 1) & 1) * 96 + sch] = hh;
        }
        lds_barrier();
        {
            const f32x4 h0 = *(const LAS f32x4*)(Bb + ot0 * 96 + og0 * 8), h1 = *(const LAS f32x4*)(Bb + ot0 * 96 + og0 * 8 + 4);
            u32x4 o;
            o.x = cvt_pk_bf16(h0[0] * siluf(bflo(pg0.x)), h0[1] * siluf(bfhi(pg0.x)));
            o.y = cvt_pk_bf16(h0[2] * siluf(bflo(pg0.y)), h0[3] * siluf(bfhi(pg0.y)));
            o.z = cvt_pk_bf16(h1[0] * siluf(bflo(pg0.z)), h1[1] * siluf(bfhi(pg0.z)));
            o.w = cvt_pk_bf16(h1[2] * siluf(bflo(pg0.w)), h1[3] * siluf(bfhi(pg0.w)));
            so0 = o;
            if (more) pg0 = *(const u32x4*)(Z2 + (unsigned)((r0 + 64 + ot0) * 3072u + 1536 + och0));
        }
        if (o1) {
            const f32x4 h0 = *(const LAS f32x4*)(Bb + ot1 * 96 + og1 * 8), h1 = *(const LAS f32x4*)(Bb + ot1 * 96 + og1 * 8 + 4);
            u32x4 o;
            o.x = cvt_pk_bf16(h0[0] * siluf(bflo(pg1.x)), h0[1] * siluf(bfhi(pg1.x)));
            o.y = cvt_pk_bf16(h0[2] * siluf(bflo(pg1.y)), h0[3] * siluf(bfhi(pg1.y)));
            o.z = cvt_pk_bf16(h1[0] * siluf(bflo(pg1.z)), h1[1] * siluf(bfhi(pg1.z)));
            o.w = cvt_pk_bf16(h1[2] * siluf(bflo(pg1.w)), h1[3] * siluf(bfhi(pg1.w)));
            so1 = o;
            if (more) pg1 = *(const u32x4*)(Z2 + (unsigned)((r0 + 64 + ot1) * 3072u + 1536 + och1));
        }
        sr = r0; spend = true;
        lds_barrier();
    }
    if (spend) { *(u32x4*)(Y2 + (unsigned)((sr + ot0) * 1536u + och0)) = so0; if (o1) *(u32x4*)(Y2 + (unsigned)((sr + ot1) * 1536u + och1)) = so1; }
    if (tid < 96) p.out[(smp ? O_LS : O_LP) + (size_t)b * 1536 + nb * 192 + hf * 96 + tid] = HC[(nch & 1) * 96 + tid];
    lds_barrier();
}

__device__ __forceinline__ void phase6(const Params& p, LAS unsigned char* L) {
    if (gridDim.x == 256) {
        const int xcd = blockIdx.x & 7, loc = blockIdx.x >> 3;
        const int pair = xcd * 16 + (loc >> 1), hf = loc & 1;
        lru_item(p, L, pair * 2 + hf); lru_item(p, L, 256 + pair * 2 + hf); lru_item(p, L, 512 + pair * 2 + hf);
    } else {
        for (int it = blockIdx.x; it < 768; it += gridDim.x) lru_item(p, L, it);
    }
}

__device__ __forceinline__ void phase8(const Params& p) {
    const float* rsq = (const float*)(p.ws + WS_RSQ2); const float* g = p.in[24]; float* y = p.out;
    const long gtid = (long)blockIdx.x * NTHR + threadIdx.x, gsz = (long)gridDim.x * NTHR;
    const long total = (long)T * 256;
    for (long it = gtid; it < total; it += gsz) {
        const long row = it >> 8; const int c4 = (int)(it & 255) * 4;
        const float rs = rsqrtf(rsq[row] * (1.f / 1024.f) + EPS);
        const f32x4 v = *(const f32x4*)(y + row * 1024 + c4), gv = *(const f32x4*)(g + c4);
        *(f32x4*)(y + row * 1024 + c4) = v * rs * gv;
    }
}


#define XB_TMO      128
#define XB_XCNT(j)  (256  + 64 * (j))
#define XB_XSUB(j)  (1280 + 64 * (j))
#define XB_XGEN(j)  (2304 + 64 * (j))
#define XB_TOP      3328
#define XB_TOPGEN   3392
#define XCD_BAR_WORDS 3456
#define XB_SPIN_CAP (1u << 18)
__device__ __forceinline__ unsigned xb_ld(unsigned* p)              { return __hip_atomic_load(p, __ATOMIC_RELAXED, __HIP_MEMORY_SCOPE_AGENT); }
__device__ __forceinline__ unsigned xb_add(unsigned* p, unsigned v) { return __hip_atomic_fetch_add(p, v, __ATOMIC_RELAXED, __HIP_MEMORY_SCOPE_AGENT); }
__device__ __forceinline__ unsigned xb_xcc_id() { return (unsigned)__builtin_amdgcn_s_getreg((3 << 11) | 20) & 0xFu; }
#define XB_SPIN(cond, bar) do { unsigned _sp = 0; while (cond) { __builtin_amdgcn_s_sleep(1); \
    if ((++_sp & 255u) == 0u) { if (xb_ld(&(bar)[XB_TMO])) break; if (_sp > XB_SPIN_CAP) { atomicAdd(&(bar)[XB_TMO], 1u); break; } } } } while (0)
struct XcdBarrier { unsigned* bar; unsigned x; volatile LAS unsigned* st; };
__device__ __forceinline__ XcdBarrier xcd_barrier_post(unsigned* bar, volatile LAS unsigned* st) {
    XcdBarrier b; b.bar = bar; b.x = xb_xcc_id(); b.st = st;
    if (threadIdx.x == 0) (void)xb_add(&bar[XB_XCNT(b.x)], 1u);
    return b;
}
__device__ __forceinline__ void xcd_barrier_complete(unsigned* bar, unsigned x, unsigned& nloc, unsigned& nx) {
    const unsigned G = gridDim.x * gridDim.y * gridDim.z;
    unsigned sum, cnt, mine, sp = 0u;
    for (;;) {
        sum = 0u; cnt = 0u; mine = 0u;
#pragma unroll
        for (unsigned j = 0; j < 16; ++j) { const unsigned c = xb_ld(&bar[XB_XCNT(j)]); sum += c; cnt += (c > 0u) ? 1u : 0u; mine = (j == x) ? c : mine; }
        if (sum == G) break;
        __builtin_amdgcn_s_sleep(1);
        if ((++sp & 255u) == 0u) { if (xb_ld(&bar[XB_TMO])) break; if (sp > XB_SPIN_CAP) { atomicAdd(&bar[XB_TMO], 1u); break; } }
    }
    nloc = mine > 0u ? mine : 1u; nx = cnt > 0u ? cnt : 1u;
}
__device__ __forceinline__ void xcd_barrier(const XcdBarrier& b) {
    asm volatile("s_waitcnt vmcnt(0)" ::: "memory");
    __syncthreads();
    if (threadIdx.x == 0) {
        unsigned* bar = b.bar;
        __builtin_amdgcn_s_waitcnt(0);
        unsigned nloc = b.st[0], nx = b.st[1];
        if (nloc == 0u) { xcd_barrier_complete(bar, b.x, nloc, nx); b.st[0] = nloc; b.st[1] = nx; }
        const unsigned old = xb_add(&bar[XB_XSUB(b.x)], 1u);
        const unsigned gen = old / nloc;
        if (old + 1u == (gen + 1u) * nloc) {
            __builtin_amdgcn_fence(__ATOMIC_RELEASE, "agent");
            asm volatile("s_waitcnt vmcnt(0)" ::: "memory");
            const unsigned og = xb_add(&bar[XB_TOP], 1u);
            const unsigned tg = og / nx;
            if (og + 1u == (tg + 1u) * nx) xb_add(&bar[XB_TOPGEN], 1u);
            else XB_SPIN(xb_ld(&bar[XB_TOPGEN]) == tg, bar);
            __builtin_amdgcn_fence(__ATOMIC_ACQUIRE, "agent");
            xb_add(&bar[XB_XGEN(b.x)], 1u);
            asm volatile("s_waitcnt vmcnt(0)" ::: "memory");
        } else {
            XB_SPIN(xb_ld(&bar[XB_XGEN(b.x)]) == gen, bar);
            __builtin_amdgcn_fence(__ATOMIC_ACQUIRE, "agent");
            asm volatile("s_waitcnt vmcnt(0)" ::: "memory");
        }
    }
    __syncthreads();
}

__global__ void __launch_bounds__(NTHR) mega(Params p) {
    extern __shared__ __attribute__((aligned(16))) unsigned char lds_raw[];
    LAS unsigned char* L = (LAS unsigned char*)lds_raw;
    cg::grid_group grid = cg::this_grid();
    unsigned char* ws = p.ws;
    const int lo = p.ph_lo, hi = p.ph_hi;
    LAS unsigned* stw = (LAS unsigned*)(L + (LDS_BYTES - 16));
    if (threadIdx.x < 4) stw[threadIdx.x] = 0u;
    __syncthreads();
    const XcdBarrier xb = xcd_barrier_post((unsigned*)(ws + WS_BAR), (volatile LAS unsigned*)stw);
#ifndef PHMASK
#define PHMASK 0x1ff
#endif
#define IN(k) (((PHMASK >> (k)) & 1) && lo <= (k) && (k) < hi)
#define SEAM(k) do { if (IN(k) && IN((k) + 1)) xcd_barrier(xb); } while (0)
    if (hi > 1000) grid.sync();
    if (IN(0)) phase0(p);
    SEAM(0);
    if (IN(1)) {
        pg8::Gemm g{(const bf16_t*)(ws + WS_XB), (const bf16_t*)(ws + WS_WINE), T, NE_PAD, 1024};
        pg8::StaticOrder S; S.init(T, NE_PAD, gridDim.x, blockIdx.x);
        EpiInEven E{ws, p.out, (const float*)(ws + WS_RSTD0), p.in[10]};
        pg8::gemm_phase<EpiInEven>(L, g, S, E);
    }
    SEAM(1);
    if (IN(2)) { phase2a(p, L); xcd_barrier(xb); phase2b(p, L); }
    SEAM(2);
    if (IN(3)) phase3(p);
    SEAM(3);
    if (IN(4)) {
        pg8::Gemm g{(const bf16_t*)(ws + WS_GATE), (const bf16_t*)(ws + WS_WOUTE), T, 1024, 2048};
        pg8::StaticOrder S; S.init(T, 1024, gridDim.x, blockIdx.x);
        EpiOutRes<true> E{p.in[0], p.in[1], p.out, (bf16_t*)(ws + WS_XB), (float*)(ws + WS_RSQ1)};
        pg8::gemm_phase<EpiOutRes<true>>(L, g, S, E);
    }
    SEAM(4);
    if (IN(5)) {
        pg8::Gemm g{(const bf16_t*)(ws + WS_XB), (const bf16_t*)(ws + WS_WINO), T, 3072, 1024};
        pg8::StaticOrder S; S.init(T, 3072, gridDim.x, blockIdx.x);
        EpiInOdd E{(bf16_t*)(ws + WS_Z2), (const float*)(ws + WS_RSQ1)};
        pg8::gemm_phase<EpiInOdd>(L, g, S, E);
    }
    SEAM(5);
    if (IN(6)) phase6(p, L);
    SEAM(6);
    if (IN(7)) {
        pg8::Gemm g{(const bf16_t*)(ws + WS_Y2), (const bf16_t*)(ws + WS_WOUTO), T, 1024, 1536};
        pg8::StaticOrder S; S.init(T, 1024, gridDim.x, blockIdx.x);
        EpiOutRes<false> E{p.out, p.out + (size_t)T_P * 1024, p.out, nullptr, (float*)(ws + WS_RSQ2)};
        pg8::gemm_phase<EpiOutRes<false>>(L, g, S, E);
    }
    SEAM(7);
    if (IN(8)) phase8(p);
#undef IN
#undef SEAM
}

extern "C" void kernel_launch(void* const* d_in, const int* in_sizes, int n_in, void* d_out, int out_size, void* d_ws, size_t ws_size, hipStream_t stream) {
    static int grid_blocks = 0;
    if (grid_blocks == 0) {
        if (n_in != 25 || (size_t)out_size != O_END || ws_size < WS_TOTAL) { fprintf(stderr, "kernel_launch: unexpected shapes n_in %d out %d ws %zu (need %zu)\n", n_in, out_size, ws_size, (size_t)WS_END); grid_blocks = -1; return; }
        int dev = 0, cus = 0, per_cu = 0;
        (void)hipGetDevice(&dev);
        (void)hipDeviceGetAttribute(&cus, hipDeviceAttributeMultiprocessorCount, dev);
        if (hipFuncSetAttribute((const void*)mega, hipFuncAttributeMaxDynamicSharedMemorySize, LDS_BYTES) != hipSuccess) { fprintf(stderr, "kernel_launch: hipFuncSetAttribute failed\n"); }
        if (hipOccupancyMaxActiveBlocksPerMultiprocessor(&per_cu, (const void*)mega, NTHR, LDS_BYTES) != hipSuccess || per_cu < 1) per_cu = 1;
        (void)hipGetLastError();
        grid_blocks = cus * per_cu;
        if (grid_blocks <= 0) grid_blocks = 256;
    }
    if (grid_blocks < 0) return;
    Params p{};
    for (int i = 0; i < 25; ++i) p.in[i] = (const float*)d_in[i];
    p.out = (float*)d_out; p.ws = (unsigned char*)d_ws;
#if ONE_LAUNCH
#ifdef PROBE_X
    { const int seq[3][2] = {{0, PROBE_Y + 1}, {PROBE_X, PROBE_Y + 1}, {PROBE_Y + 1, 9}};
      for (int li = 0; li < 3; ++li) { if (seq[li][0] >= seq[li][1]) continue; p.ph_lo = seq[li][0]; p.ph_hi = seq[li][1]; void* args[] = {&p};
        (void)hipMemsetAsync((char*)d_ws + WS_BAR, 0, 16384, stream);
        hipError_t e = hipLaunchCooperativeKernel((const void*)mega, dim3(grid_blocks), dim3(NTHR), args, LDS_BYTES, stream);
        if (e != hipSuccess) fprintf(stderr, "cooperative launch failed: %s (grid %d)\n", hipGetErrorString(e), grid_blocks); } }
#else
    p.ph_lo = 0; p.ph_hi = 9;
    (void)hipMemsetAsync((char*)d_ws + WS_BAR, 0, 16384, stream);
    { void* args[] = {&p}; hipError_t e = hipLaunchCooperativeKernel((const void*)mega, dim3(grid_blocks), dim3(NTHR), args, LDS_BYTES, stream);
      if (e != hipSuccess) fprintf(stderr, "cooperative launch failed: %s (grid %d)\n", hipGetErrorString(e), grid_blocks); }
#endif
#else
    for (int ph = 0; ph < 9; ++ph) {
        p.ph_lo = ph; p.ph_hi = ph + 1;
        (void)hipMemsetAsync((char*)d_ws + WS_BAR, 0, 16384, stream);
        void* args[] = {&p}; hipError_t e = hipLaunchCooperativeKernel((const void*)mega, dim3(grid_blocks), dim3(NTHR), args, LDS_BYTES, stream);
        if (e != hipSuccess) fprintf(stderr, "cooperative launch %d failed: %s (grid %d)\n", ph, hipGetErrorString(e), grid_blocks);
    }
#endif
}
```

```cpp
#include <hip/hip_runtime.h>
#include <hip/hip_cooperative_groups.h>
#include <cstdio>
namespace cg = cooperative_groups;

#ifndef ONE_LAUNCH
#define ONE_LAUNCH 1
#endif

#define LAS __attribute__((address_space(3)))
typedef unsigned short bf16_t;
typedef short bf16x8 __attribute__((ext_vector_type(8)));
typedef short bf16x4 __attribute__((ext_vector_type(4)));
typedef float f32x4 __attribute__((ext_vector_type(4)));
typedef unsigned u32x4 __attribute__((ext_vector_type(4)));
typedef unsigned u32x2 __attribute__((ext_vector_type(2)));

constexpr int T_P = 32768, T_S = 2048, T = T_P + T_S, DM = 1024;
constexpr int NE_PAD = 6144;
constexpr int LDS_BYTES = 159744;
constexpr int NTHR = 512;
constexpr float EPS = 1e-6f;

constexpr size_t WS_WINE = 0;
constexpr size_t WS_WOUTE = WS_WINE + (size_t)NE_PAD * 1024 * 2;
constexpr size_t WS_WINO = WS_WOUTE + (size_t)1024 * 2048 * 2;
constexpr size_t WS_WOUTO = WS_WINO + (size_t)3072 * 1024 * 2;
constexpr size_t WS_WA = WS_WOUTO + (size_t)1024 * 1536 * 2;
constexpr size_t WS_WI = WS_WA + (size_t)8 * 192 * 192 * 2;
constexpr size_t WS_XB = WS_WI + (size_t)8 * 192 * 192 * 2;
constexpr size_t WS_RSTD0 = WS_XB + (size_t)T * 1024 * 2;
constexpr size_t WS_RSQ1 = WS_RSTD0 + (size_t)T * 4;
constexpr size_t WS_RSQ2 = WS_RSQ1 + (size_t)T * 4;
constexpr size_t WS_BOSQ = WS_RSQ2 + (size_t)T * 4;
constexpr size_t WS_Q = WS_BOSQ + (size_t)T * 16;
constexpr size_t WS_K = WS_Q + (size_t)T * 1024 * 2;
constexpr size_t WS_V = WS_K + (size_t)T * 256 * 2;
constexpr size_t WS_BQ = WS_V + (size_t)T * 256 * 2;
constexpr size_t WS_BK = WS_BQ + (size_t)T * 512 * 2;
constexpr size_t WS_BV = WS_BK + (size_t)T * 512 * 2;
constexpr size_t WS_GATE = WS_BV + (size_t)T * 1024 * 2;
constexpr size_t WS_BLR = WS_GATE + (size_t)T * 2048 * 2;
constexpr size_t WS_END = WS_BLR + (size_t)T * 512 * 2;
constexpr size_t WS_BAR = WS_END;
constexpr size_t WS_TOTAL = WS_BAR + 16384;
constexpr size_t WS_Z2 = WS_Q;
constexpr size_t WS_Y2 = WS_GATE;
static_assert(WS_Z2 + (size_t)T * 3072 * 2 <= WS_GATE, "Z2 alias");

constexpr size_t O_Y = 0;
constexpr size_t O_KP = (size_t)T * 1024;
constexpr size_t O_VP = O_KP + 524288;
constexpr size_t O_GP = O_VP + 524288;
constexpr size_t O_CP = O_GP + 2097152;
constexpr size_t O_LP = O_CP + 73728;
constexpr size_t O_KS = O_LP + 24576;
constexpr size_t O_VS = O_KS + 524288;
constexpr size_t O_GS = O_VS + 524288;
constexpr size_t O_CS = O_GS + 4194304;
constexpr size_t O_LS = O_CS + 147456;
constexpr size_t O_END = O_LS + 49152;

struct Params {
    const float* in[25];
    float* out;
    unsigned char* ws;
    int ph_lo, ph_hi;
};

__device__ __forceinline__ unsigned cvt_pk_bf16(float lo, float hi) { unsigned r; asm volatile("v_cvt_pk_bf16_f32 %0, %1, %2" : "=v"(r) : "v"(lo), "v"(hi)); return r; }
__device__ __forceinline__ bf16_t f2bf(float f) { return (bf16_t)(cvt_pk_bf16(f, 0.f) & 0xffffu); }
__device__ __forceinline__ float bf2f(bf16_t b) { return __uint_as_float(((unsigned)b) << 16); }
__device__ __forceinline__ float bflo(unsigned w) { return __uint_as_float(w << 16); }
__device__ __forceinline__ float bfhi(unsigned w) { return __uint_as_float(w & 0xffff0000u); }
__device__ __forceinline__ float rcpf_(float x) { return __builtin_amdgcn_rcpf(x); }
__device__ __forceinline__ float siluf(float x) { return x * rcpf_(1.f + __expf(-x)); }
__device__ __forceinline__ float sigmf(float x) { return rcpf_(1.f + __expf(-x)); }
__device__ __forceinline__ void lds_barrier() { asm volatile("s_waitcnt lgkmcnt(0)" ::: "memory"); __builtin_amdgcn_s_barrier(); asm volatile("" ::: "memory"); }
__device__ __forceinline__ bf16x8 pack8(const f32x4& a, const f32x4& b) {
    u32x4 p; p.x = cvt_pk_bf16(a[0], a[1]); p.y = cvt_pk_bf16(a[2], a[3]); p.z = cvt_pk_bf16(b[0], b[1]); p.w = cvt_pk_bf16(b[2], b[3]);
    return __builtin_bit_cast(bf16x8, p);
}
__device__ __forceinline__ bf16x8 cat4(const bf16x4 a, const bf16x4 b) { bf16x8 r; r[0] = a[0]; r[1] = a[1]; r[2] = a[2]; r[3] = a[3]; r[4] = b[0]; r[5] = b[1]; r[6] = b[2]; r[7] = b[3]; return r; }
__device__ __forceinline__ void unpack8(const u32x4 w, float (&v)[8]) { v[0] = bflo(w.x); v[1] = bfhi(w.x); v[2] = bflo(w.y); v[3] = bfhi(w.y); v[4] = bflo(w.z); v[5] = bfhi(w.z); v[6] = bflo(w.w); v[7] = bfhi(w.w); }
#define MFMA16(a, b, c) __builtin_amdgcn_mfma_f32_16x16x32_bf16((a), (b), (c), 0, 0, 0)

namespace pg8 {
constexpr int BM = 256, BK = 64, HALF = 128, HTB = HALF * BK * 2, STAGE_BYTES = 8 * HTB, NXCD = 8, WGM = 8;
__device__ __forceinline__ int lds_byte(int r, int c) { const int st = (r >> 4) * 2 + (c >> 5), rr = r & 15, cc = c & 31, ob = rr * 64 + cc * 2; return st * 1024 + (ob ^ (((ob >> 9) & 1) << 5)); }
__device__ __forceinline__ int perm32(int rho) { const int n = rho >> 4, i = rho & 15; return 8 * (i >> 2) + 4 * n + (i & 3); }
__device__ __forceinline__ void stage_rc(int b, int& R, int& C) { const int st = b / 1024, sb = b % 1024, swz = sb ^ (((sb >> 9) & 1) << 5); R = (st >> 1) * 16 + swz / 64; C = (st & 1) * 32 + (swz % 64) / 2; }
struct Unit { int pm, pn; };
struct Gemm { const bf16_t* A; const bf16_t* Bt; int M, N, K; };
struct StaticOrder {
    int nM, nN, nwg, G, c;
    __device__ void init(int M, int N, int G_, int c_) { nM = M / BM; nN = N / BM; nwg = nM * nN; G = G_; c = c_; }
    __device__ __forceinline__ bool next(int i, Unit& u) const {
        const long Lx = (long)i * G + c; if (Lx >= nwg) return false;
        int wgid = (int)Lx; { const int q = nwg / NXCD, r = nwg % NXCD, xcd = wgid % NXCD, off = wgid / NXCD; wgid = (xcd < r ? xcd * (q + 1) : r * (q + 1) + (xcd - r) * q) + off; }
        const int nig = WGM * nN, gid = wgid / nig, fm = gid * WGM, gsz = (nM - fm) < WGM ? (nM - fm) : WGM;
        u.pm = fm + ((wgid % nig) % gsz); u.pn = (wgid % nig) / gsz; return true;
    }
};

template <class Epi>
__device__ __forceinline__ void gemm_phase(LAS unsigned char* lds, const Gemm g, const StaticOrder& S, const Epi& E) {
    const int tid = threadIdx.x, wid = __builtin_amdgcn_readfirstlane(tid >> 6), lane = tid & 63, wr = wid >> 2, wc = wid & 3, fr = lane & 15, fq = lane >> 4;
    const int K = g.K, nt = K / BK;
    unsigned voffA[2], voffB[2];
#pragma unroll
    for (int i = 0; i < 2; ++i) { int R, C; stage_rc(tid * 16 + i * 8192, R, C); const int Rb = Epi::PERM ? ((R & ~31) + perm32(R & 31)) : R;
        voffA[i] = (unsigned)(R * K + C) * 2u; voffB[i] = (unsigned)(Rb * K + C) * 2u; }
    const size_t kstep = (size_t)(BK * 2);
    const size_t hstep = (size_t)HALF * K * 2;
    const size_t tstep = 2 * hstep;
    const unsigned ldsw = (unsigned)wid * 1024u;
    const int aoff = lds_byte(wr * 64 + fr, fq * 8), boff = lds_byte(wc * 32 + fr, fq * 8);
#define PG8_SA(b, h) (((b) * 2 + (h)) * HTB)
#define PG8_SB(b, h) ((4 + (b) * 2 + (h)) * HTB)
#define PG8_STAGE(bufoff, gbase, voff) do { _Pragma("unroll") for (int _i = 0; _i < 2; ++_i) \
        __builtin_amdgcn_global_load_lds((const unsigned*)((const char*)(gbase) + (voff)[_i]), (LAS unsigned*)(lds + (bufoff) + ldsw + _i * 8192), 16, 0, 0); } while (0)
#define PG8_LDA(dst, b, h) do { _Pragma("unroll") for (int m = 0; m < 4; ++m) _Pragma("unroll") for (int k = 0; k < 2; ++k) dst[m][k] = *(const LAS bf16x8*)(lds + PG8_SA(b, h) + aoff + m * 2048 + k * 1024); } while (0)
#define PG8_LDB(dst, b, h) do { _Pragma("unroll") for (int n = 0; n < 2; ++n) _Pragma("unroll") for (int k = 0; k < 2; ++k) dst[n][k] = *(const LAS bf16x8*)(lds + PG8_SB(b, h) + boff + n * 2048 + k * 1024); } while (0)
#define PG8_MMA(ai, bj, At, Bt) do { __builtin_amdgcn_s_setprio(1); _Pragma("unroll") for (int m = 0; m < 4; ++m) _Pragma("unroll") for (int n = 0; n < 2; ++n) _Pragma("unroll") for (int k = 0; k < 2; ++k) \
        acc[ai][bj][m][n] = __builtin_amdgcn_mfma_f32_16x16x32_bf16(Bt[n][k], At[m][k], acc[ai][bj][m][n], 0, 0, 0); __builtin_amdgcn_s_setprio(0); } while (0)
#define PG8_WAIT_V(n) asm volatile("s_waitcnt vmcnt(" #n ")" ::: "memory")
#define PG8_WAIT_L(n) asm volatile("s_waitcnt lgkmcnt(" #n ")" ::: "memory")
#define PG8_BAR __builtin_amdgcn_s_barrier()
#define PG8_SCHED __builtin_amdgcn_sched_barrier(0)
    Unit cur, nxt; int ui = 0;
    if (!S.next(0, cur)) return;
    f32x4 acc[2][2][4][2];
#pragma unroll
    for (int a = 0; a < 2; ++a)
#pragma unroll
        for (int b = 0; b < 2; ++b)
#pragma unroll
            for (int m = 0; m < 4; ++m)
#pragma unroll
                for (int n = 0; n < 2; ++n) acc[a][b][m][n] = (f32x4){0.f, 0.f, 0.f, 0.f};
    bf16x8 At[4][2], B0[2][2], B1[2][2];
    const char* cA = (const char*)g.A + (size_t)cur.pm * tstep; const char* cB = (const char*)g.Bt + (size_t)cur.pn * tstep;
    PG8_STAGE(PG8_SB(0, 0), cB, voffB); PG8_STAGE(PG8_SB(0, 1), cB + hstep, voffB); PG8_STAGE(PG8_SA(0, 0), cA, voffA); PG8_STAGE(PG8_SA(0, 1), cA + hstep, voffA);
    if (wr == 1) PG8_BAR;
    PG8_WAIT_V(2); PG8_BAR;
    PG8_STAGE(PG8_SB(1, 0), cB + kstep, voffB); PG8_STAGE(PG8_SA(1, 0), cA + kstep, voffA); PG8_STAGE(PG8_SB(1, 1), cB + hstep + kstep, voffB);
    PG8_WAIT_V(6); PG8_BAR;
    for (;;) {
        const bool has_next = S.next(ui + 1, nxt);
        const char* nA = has_next ? (const char*)g.A + (size_t)nxt.pm * tstep : cA; const char* nB = has_next ? (const char*)g.Bt + (size_t)nxt.pn * tstep : cB;
        for (int t = 0; t < nt; t += 2) {
            const bool last = (t == nt - 2);
            const char* a1 = cA + (size_t)(t + 1) * kstep;
            const char* a2 = last ? nA : cA + (size_t)(t + 2) * kstep; const char* b2 = last ? nB : cB + (size_t)(t + 2) * kstep;
            const char* a3 = a2 + kstep; const char* b3 = b2 + kstep;
            PG8_LDB(B0, 0, 0); PG8_LDB(B1, 0, 1); PG8_SCHED; PG8_LDA(At, 0, 0); PG8_STAGE(PG8_SA(1, 1), a1 + hstep, voffA);
            PG8_WAIT_V(8); PG8_WAIT_L(0); PG8_BAR; PG8_MMA(0, 0, At, B0); PG8_MMA(0, 1, At, B1); PG8_BAR; PG8_SCHED;
            PG8_LDA(At, 0, 1); PG8_STAGE(PG8_SB(0, 0), b2, voffB); PG8_STAGE(PG8_SB(0, 1), b2 + hstep, voffB); PG8_STAGE(PG8_SA(0, 0), a2, voffA);
            PG8_WAIT_V(8); PG8_WAIT_L(0); PG8_BAR; PG8_MMA(1, 0, At, B0); PG8_MMA(1, 1, At, B1); PG8_BAR; PG8_SCHED;
            PG8_LDB(B0, 1, 0); PG8_LDB(B1, 1, 1); PG8_SCHED; PG8_LDA(At, 1, 0); PG8_STAGE(PG8_SA(0, 1), a2 + hstep, voffA);
            PG8_WAIT_V(8); PG8_WAIT_L(0); PG8_BAR; PG8_MMA(0, 0, At, B0); PG8_MMA(0, 1, At, B1); PG8_BAR; PG8_SCHED;
            PG8_LDA(At, 1, 1); PG8_STAGE(PG8_SB(1, 0), b3, voffB); PG8_STAGE(PG8_SB(1, 1), b3 + hstep, voffB); PG8_STAGE(PG8_SA(1, 0), a3, voffA);
            PG8_WAIT_V(8); PG8_WAIT_L(0); PG8_BAR; PG8_MMA(1, 0, At, B0); PG8_MMA(1, 1, At, B1); PG8_BAR; PG8_SCHED;
        }
        if (wr == 0) PG8_BAR;
        E(acc, cur, wr, wc, fr, fq);
        if (!has_next) break;
#pragma unroll
        for (int a = 0; a < 2; ++a)
#pragma unroll
            for (int b = 0; b < 2; ++b)
#pragma unroll
                for (int m = 0; m < 4; ++m)
#pragma unroll
                    for (int n = 0; n < 2; ++n) acc[a][b][m][n] = (f32x4){0.f, 0.f, 0.f, 0.f};
        cur = nxt; cA = nA; cB = nB; ++ui;
        if (wr == 1) PG8_BAR;
    }
    PG8_WAIT_V(0);
    PG8_BAR;
#undef PG8_SA
#undef PG8_SB
#undef PG8_STAGE
#undef PG8_LDA
#undef PG8_LDB
#undef PG8_MMA
#undef PG8_WAIT_V
#undef PG8_WAIT_L
#undef PG8_BAR
#undef PG8_SCHED
}
}

typedef f32x4 AccT[2][2][4][2];

struct EpiInEven {
    static constexpr bool PERM = true;
    unsigned char* ws; float* out; const float* rstd; const float* blr_b;
    __device__ __forceinline__ void operator()(const AccT& acc, const pg8::Unit& u, int wr, int wc, int fr, int fq) const {
        const int pn = u.pn;
        bf16_t* base; int ld, coff; float sc = 1.f;
        if (pn < 4) { base = (bf16_t*)(ws + WS_Q); ld = 1024; coff = pn * 256; sc = 0.125f; }
        else if (pn == 4) { base = (bf16_t*)(ws + WS_K); ld = 256; coff = 0; }
        else if (pn == 5) { base = (bf16_t*)(ws + WS_V); ld = 256; coff = 0; }
        else if (pn < 8) { base = (bf16_t*)(ws + WS_BQ); ld = 512; coff = (pn - 6) * 256; sc = 0.08838834764831845f; }
        else if (pn < 10) { base = (bf16_t*)(ws + WS_BK); ld = 512; coff = (pn - 8) * 256; }
        else if (pn < 14) { base = (bf16_t*)(ws + WS_BV); ld = 1024; coff = (pn - 10) * 256; }
        else if (pn < 22) { base = (bf16_t*)(ws + WS_GATE); ld = 2048; coff = (pn - 14) * 256; }
        else { base = (bf16_t*)(ws + WS_BLR); ld = 512; coff = (pn - 22) * 256; }
        const int row0 = u.pm * 256 + wr * 64 + fr;
        const int ct = wc * 32 + 8 * fq;
        float rsv[8];
#pragma unroll
        for (int it = 0; it < 8; ++it) rsv[it] = rstd[row0 + (it >> 2) * 128 + (it & 3) * 16];
        if (pn >= 22) {
#pragma unroll
            for (int ai = 0; ai < 2; ++ai)
#pragma unroll
                for (int m = 0; m < 4; ++m) {
                    const int row = row0 + ai * 128 + m * 16; const float rs = rsv[ai * 4 + m];
#pragma unroll
                    for (int bj = 0; bj < 2; ++bj) {
                        const int cg = coff + ct + bj * 128;
                        const f32x4 b0 = *(const f32x4*)(blr_b + cg), b1 = *(const f32x4*)(blr_b + cg + 4);
                        f32x4 x0 = acc[ai][bj][m][0] * rs + b0, x1 = acc[ai][bj][m][1] * rs + b1;
#pragma unroll
                        for (int j = 0; j < 4; ++j) { x0[j] = (fminf(x0[j], 0.f) - __logf(1.f + __expf(-fabsf(x0[j])))) * (1.f / 16.f); x1[j] = (fminf(x1[j], 0.f) - __logf(1.f + __expf(-fabsf(x1[j])))) * (1.f / 16.f); }
                        u32x4 w; w.x = cvt_pk_bf16(x0[0], x0[1]); w.y = cvt_pk_bf16(x0[2], x0[3]); w.z = cvt_pk_bf16(x1[0], x1[1]); w.w = cvt_pk_bf16(x1[2], x1[3]);
                        *(u32x4*)(base + (size_t)row * 512 + cg) = w;
                    }
                }
            return;
        }
        const bool kv = (pn == 4 || pn == 5);
        float* okv_p = out + (pn == 4 ? O_KP : O_VP); float* okv_s = out + (pn == 4 ? O_KS : O_VS);
#pragma unroll
        for (int ai = 0; ai < 2; ++ai)
#pragma unroll
            for (int m = 0; m < 4; ++m) {
                const int row = row0 + ai * 128 + m * 16; const float rs = rsv[ai * 4 + m] * sc;
                bf16_t* rowp = base + (size_t)row * ld + coff + ct;
                float* orow = nullptr;
                if (kv) {
                    if (row >= T_P) orow = okv_s + (size_t)(row - T_P) * 256;
                    else { const int b = row >> 11, t = row & 2047; if (t >= 1920) orow = okv_p + (size_t)(b * 128 + t - 1920) * 256; }
                }
#pragma unroll
                for (int bj = 0; bj < 2; ++bj) {
                    const f32x4 v0 = acc[ai][bj][m][0] * rs, v1 = acc[ai][bj][m][1] * rs;
                    u32x4 w; w.x = cvt_pk_bf16(v0[0], v0[1]); w.y = cvt_pk_bf16(v0[2], v0[3]); w.z = cvt_pk_bf16(v1[0], v1[1]); w.w = cvt_pk_bf16(v1[2], v1[3]);
                    *(u32x4*)(rowp + bj * 128) = w;
                    if (kv && orow) { *(f32x4*)(orow + bj * 128 + ct) = v0; *(f32x4*)(orow + bj * 128 + ct + 4) = v1; }
                }
            }
    }
};

template <bool WRITE_BF>
struct EpiOutRes {
    static constexpr bool PERM = false;
    const float* xin_p; const float* xin_s; float* xo; bf16_t* xb; float* rowsq;
    __device__ __forceinline__ void operator()(const AccT& acc, const pg8::Unit& u, int wr, int wc, int fr, int fq) const {
        const int row0 = u.pm * 256 + wr * 64 + fr, col0 = u.pn * 256 + wc * 32 + 4 * fq;
        f32x4 r[3][4];
#define EOR_LOAD(S, IT) do { const int row_ = row0 + ((IT) >> 2) * 128 + ((IT) & 3) * 16; \
            const float* xr_ = (row_ < T_P) ? xin_p + (size_t)row_ * 1024 : xin_s + (size_t)(row_ - T_P) * 1024; \
            r[S][0] = *(const f32x4*)(xr_ + col0); r[S][1] = *(const f32x4*)(xr_ + col0 + 16); r[S][2] = *(const f32x4*)(xr_ + col0 + 128); r[S][3] = *(const f32x4*)(xr_ + col0 + 144); } while (0)
        EOR_LOAD(0, 0); EOR_LOAD(1, 1);
#pragma unroll
        for (int it = 0; it < 8; ++it) {
            if (it + 2 < 8) { if ((it + 2) % 3 == 0) EOR_LOAD(0, it + 2); else if ((it + 2) % 3 == 1) EOR_LOAD(1, it + 2); else EOR_LOAD(2, it + 2); }
            const int ai = it >> 2, m = it & 3;
            const int row = row0 + ai * 128 + m * 16;
            float ss = 0.f;
#pragma unroll
            for (int bj = 0; bj < 2; ++bj)
#pragma unroll
                for (int n = 0; n < 2; ++n) {
                    const int col = col0 + bj * 128 + n * 16;
                    const f32x4 v = acc[ai][bj][m][n] + r[it % 3][bj * 2 + n];
                    *(f32x4*)(xo + (size_t)row * 1024 + col) = v;
                    if (WRITE_BF) { u32x2 w; w.x = cvt_pk_bf16(v[0], v[1]); w.y = cvt_pk_bf16(v[2], v[3]); *(u32x2*)(xb + (size_t)row * 1024 + col) = w; }
                    ss += v[0] * v[0] + v[1] * v[1] + v[2] * v[2] + v[3] * v[3];
                }
            ss += __shfl_xor(ss, 16); ss += __shfl_xor(ss, 32);
            if (fq == 0) atomicAdd(rowsq + row, ss);
        }
#undef EOR_LOAD
    }
};

struct EpiInOdd {
    static constexpr bool PERM = true;
    bf16_t* z2; const float* rowsq;
    __device__ __forceinline__ void operator()(const AccT& acc, const pg8::Unit& u, int wr, int wc, int fr, int fq) const {
        const int row0 = u.pm * 256 + wr * 64 + fr, col0 = u.pn * 256 + wc * 32 + 8 * fq;
        float rsv[8];
#pragma unroll
        for (int it = 0; it < 8; ++it) rsv[it] = rowsq[row0 + (it >> 2) * 128 + (it & 3) * 16];
#pragma unroll
        for (int ai = 0; ai < 2; ++ai)
#pragma unroll
            for (int m = 0; m < 4; ++m) {
                const int row = row0 + ai * 128 + m * 16; const float rs = rsqrtf(rsv[ai * 4 + m] * (1.f / 1024.f) + EPS);
#pragma unroll
                for (int bj = 0; bj < 2; ++bj) {
                    const f32x4 v0 = acc[ai][bj][m][0] * rs, v1 = acc[ai][bj][m][1] * rs;
                    u32x4 w; w.x = cvt_pk_bf16(v0[0], v0[1]); w.y = cvt_pk_bf16(v0[2], v0[3]); w.z = cvt_pk_bf16(v1[0], v1[1]); w.w = cvt_pk_bf16(v1[2], v1[3]);
                    *(u32x4*)(z2 + (size_t)row * 3072 + col0 + bj * 128) = w;
                }
            }
    }
};

template <int MODE>
__device__ __forceinline__ void transpose_w(const float* __restrict__ src, int K, int Nsrc, bf16_t* __restrict__ dst, int Ndst, const float* __restrict__ gain, long gtid, long gsz) {
    const long total = (long)(K / 8) * Ndst;
#pragma unroll 4
    for (long it = gtid; it < total; it += gsz) {
        const int n = (int)(it % Ndst), k8 = (int)(it / Ndst);
        int sc = n;
        if (MODE == 1) { if (n < 3584) sc = n; else sc = n + 16; }
        u32x4 w = {0u, 0u, 0u, 0u};
        if (sc >= 0) {
            const float* s = src + (size_t)(k8 * 8) * Nsrc + sc;
            float v0 = s[0], v1 = s[(size_t)Nsrc], v2 = s[(size_t)2 * Nsrc], v3 = s[(size_t)3 * Nsrc], v4 = s[(size_t)4 * Nsrc], v5 = s[(size_t)5 * Nsrc], v6 = s[(size_t)6 * Nsrc], v7 = s[(size_t)7 * Nsrc];
            if (gain) { const f32x4 g0 = *(const f32x4*)(gain + k8 * 8), g1 = *(const f32x4*)(gain + k8 * 8 + 4); v0 *= g0[0]; v1 *= g0[1]; v2 *= g0[2]; v3 *= g0[3]; v4 *= g1[0]; v5 *= g1[1]; v6 *= g1[2]; v7 *= g1[3]; }
            w.x = cvt_pk_bf16(v0, v1); w.y = cvt_pk_bf16(v2, v3); w.z = cvt_pk_bf16(v4, v5); w.w = cvt_pk_bf16(v6, v7);
        }
        *(u32x4*)(dst + (size_t)n * K + k8 * 8) = w;
    }
}

__device__ __forceinline__ void phase0(const Params& p) {
    unsigned char* ws = p.ws;
    const long gtid = (long)blockIdx.x * NTHR + threadIdx.x, gsz = (long)gridDim.x * NTHR;
    transpose_w<1>(p.in[8], 1024, 5648, (bf16_t*)(ws + WS_WINE), 5632, p.in[7], gtid, gsz);
    for (long it = gtid; it < 128L * 512; it += gsz) {
        const int n = (int)(it & 511), k8 = (int)(it >> 9);
        float wl[16];
#pragma unroll
        for (int r = 0; r < 16; ++r) wl[r] = p.in[9][r * 512 + n];
        float v[8];
#pragma unroll
        for (int i = 0; i < 8; ++i) {
            const float* wr_ = p.in[8] + (size_t)(k8 * 8 + i) * 5648 + 3584;
            float a = 0.f;
#pragma unroll
            for (int r4 = 0; r4 < 4; ++r4) { const f32x4 x = *(const f32x4*)(wr_ + r4 * 4); a += x[0] * wl[r4 * 4] + x[1] * wl[r4 * 4 + 1] + x[2] * wl[r4 * 4 + 2] + x[3] * wl[r4 * 4 + 3]; }
            v[i] = a * p.in[7][k8 * 8 + i];
        }
        u32x4 w; w.x = cvt_pk_bf16(v[0], v[1]); w.y = cvt_pk_bf16(v[2], v[3]); w.z = cvt_pk_bf16(v[4], v[5]); w.w = cvt_pk_bf16(v[6], v[7]);
        *(u32x4*)((bf16_t*)(ws + WS_WINE) + (size_t)(5632 + n) * 1024 + k8 * 8) = w;
    }
    transpose_w<0>(p.in[13], 2048, 1024, (bf16_t*)(ws + WS_WOUTE), 1024, nullptr, gtid, gsz);
    transpose_w<0>(p.in[15], 1024, 3072, (bf16_t*)(ws + WS_WINO), 3072, p.in[14], gtid, gsz);
    transpose_w<0>(p.in[23], 1536, 1024, (bf16_t*)(ws + WS_WOUTO), 1024, nullptr, gtid, gsz);
    for (int nb = 0; nb < 8; ++nb) {
        transpose_w<0>(p.in[18] + nb * 192 * 192, 192, 192, (bf16_t*)(ws + WS_WA) + nb * 192 * 192, 192, nullptr, gtid, gsz);
        transpose_w<0>(p.in[20] + nb * 192 * 192, 192, 192, (bf16_t*)(ws + WS_WI) + nb * 192 * 192, 192, nullptr, gtid, gsz);
    }
    { float* z = (float*)(ws + WS_RSQ1); const long nz = (long)T * 2; for (long i = gtid; i < nz; i += gsz) z[i] = 0.f; }
    const int lane = threadIdx.x & 63; const int gw = (int)(gtid >> 6), nw = (int)(gsz >> 6);
    bf16_t* xb = (bf16_t*)(ws + WS_XB); float* rstd = (float*)(ws + WS_RSTD0);
#pragma unroll 4
    for (int row = gw; row < T; row += nw) {
        const float* xr = (row < T_P) ? p.in[0] + (size_t)row * 1024 : p.in[1] + (size_t)(row - T_P) * 1024;
        float ss = 0.f;
#pragma unroll
        for (int i = 0; i < 4; ++i) {
            const f32x4 v = *(const f32x4*)(xr + i * 256 + lane * 4);
            ss += v[0] * v[0] + v[1] * v[1] + v[2] * v[2] + v[3] * v[3];
            u32x2 w; w.x = cvt_pk_bf16(v[0], v[1]); w.y = cvt_pk_bf16(v[2], v[3]);
            *(u32x2*)(xb + (size_t)row * 1024 + i * 256 + lane * 4) = w;
        }
#pragma unroll
        for (int o = 32; o >= 1; o >>= 1) ss += __shfl_xor(ss, o);
        if (lane == 0) rstd[row] = rsqrtf(ss * (1.f / 1024.f) + EPS);
    }
}

__device__ __forceinline__ void attn_item(const Params& p, LAS unsigned char* L, int item, bf16_t* Yd, int ldd) {
    unsigned char* ws = p.ws;
    const int tid = threadIdx.x, lane = tid & 63, w = tid >> 6, r16 = lane & 15, q4 = lane >> 4;
    LAS bf16_t* Ks = (LAS bf16_t*)L;
    LAS bf16_t* Vs = (LAS bf16_t*)(L + 192 * 72 * 2);
    const unsigned vbase = (unsigned)(size_t)L + 192u * 72u * 2u;
    const bf16_t* Qb = (const bf16_t*)(ws + WS_Q); const bf16_t* Kb = (const bf16_t*)(ws + WS_K); const bf16_t* Vb = (const bf16_t*)(ws + WS_V);
    const bf16_t* Yb = (const bf16_t*)(ws + WS_GATE);
    const bool smp = item >= 2048;
    int b, c, kh; size_t row0;
    if (!smp) { kh = item & 3; c = (item >> 2) & 31; b = item >> 7; row0 = (size_t)b * 2048 + c * 64; }
    else { const int i2 = item - 2048; kh = i2 & 3; b = i2 >> 2; c = 0; row0 = (size_t)T_P + b * 64; }
    const int g = w >> 1, i0 = (w & 1) * 32, h = kh * 4 + g;
    bf16x8 qf[2][2];
#pragma unroll
    for (int qt = 0; qt < 2; ++qt) {
#pragma unroll
        for (int ks = 0; ks < 2; ++ks) qf[qt][ks] = *(const bf16x8*)(Qb + (row0 + i0 + qt * 16 + r16) * 1024 + h * 64 + ks * 32 + q4 * 8);
    }
#pragma unroll
    for (int i = 0; i < 3; ++i) {
        const int idx = tid + i * 512, key = idx >> 3, dg = idx & 7;
        u32x4 kv = {0u, 0u, 0u, 0u}, vv = {0u, 0u, 0u, 0u};
        if (!smp) {
            const int pos = c * 64 - 128 + key;
            if (pos >= 0) { const size_t r = (size_t)b * 2048 + pos; kv = *(const u32x4*)(Kb + r * 256 + kh * 64 + dg * 8); vv = *(const u32x4*)(Vb + r * 256 + kh * 64 + dg * 8); }
        } else {
            if (key < 128) {
                const size_t o = ((size_t)(b * 128 + key) * 4 + kh) * 64 + dg * 8;
                const f32x4 k0 = *(const f32x4*)(p.in[2] + o), k1 = *(const f32x4*)(p.in[2] + o + 4), v0 = *(const f32x4*)(p.in[3] + o), v1 = *(const f32x4*)(p.in[3] + o + 4);
                kv.x = cvt_pk_bf16(k0[0], k0[1]); kv.y = cvt_pk_bf16(k0[2], k0[3]); kv.z = cvt_pk_bf16(k1[0], k1[1]); kv.w = cvt_pk_bf16(k1[2], k1[3]);
                vv.x = cvt_pk_bf16(v0[0], v0[1]); vv.y = cvt_pk_bf16(v0[2], v0[3]); vv.z = cvt_pk_bf16(v1[0], v1[1]); vv.w = cvt_pk_bf16(v1[2], v1[3]);
            } else { const size_t r = (size_t)T_P + b * 64 + key - 128; kv = *(const u32x4*)(Kb + r * 256 + kh * 64 + dg * 8); vv = *(const u32x4*)(Vb + r * 256 + kh * 64 + dg * 8); }
        }
        *(LAS u32x4*)(Ks + key * 72 + dg * 8) = kv;
        *(LAS u32x4*)(Vs + key * 72 + dg * 8) = vv;
    }
    __syncthreads();
    const float slope = exp2f(-0.5f * (float)(h + 1));
    const float sink = p.in[11][h];
    const unsigned va = vbase + (unsigned)(((q4 * 4 + (r16 >> 2)) * 72 + 4 * (r16 & 3)) * 2);
#pragma unroll 1
    for (int qt = 0; qt < 2; ++qt) {
        const int i = i0 + qt * 16 + r16;
        const bf16x8 qa = qt ? qf[1][0] : qf[0][0], qb = qt ? qf[1][1] : qf[0][1];
        u32x2 gv[4];
#pragma unroll
        for (int dt = 0; dt < 4; ++dt) gv[dt] = *(const u32x2*)(Yb + (row0 + i) * 2048 + h * 64 + dt * 16 + q4 * 4);
        f32x4 sacc[12];
#pragma unroll
        for (int kt = 0; kt < 12; ++kt) {
            const bf16x8 kf0 = *(const LAS bf16x8*)(Ks + (kt * 16 + r16) * 72 + q4 * 8), kf1 = *(const LAS bf16x8*)(Ks + (kt * 16 + r16) * 72 + 32 + q4 * 8);
            f32x4 a = {0.f, 0.f, 0.f, 0.f}; a = MFMA16(kf0, qa, a); a = MFMA16(kf1, qb, a); sacc[kt] = a;
        }
        float m = -3e38f;
#pragma unroll
        for (int kt = 0; kt < 12; ++kt)
#pragma unroll
            for (int jj = 0; jj < 4; ++jj) {
                const int j = kt * 16 + q4 * 4 + jj;
                float sv = sacc[kt][jj] - slope * fabsf((float)(128 + i - j));
                if (!smp && (c * 64 - 128 + j) < 0) sv = -1e30f;
                sacc[kt][jj] = sv; m = fmaxf(m, sv);
            }
        m = fmaxf(m, __shfl_xor(m, 16)); m = fmaxf(m, __shfl_xor(m, 32)); m = fmaxf(m, sink);
        float l = 0.f;
#pragma unroll
        for (int kt = 0; kt < 12; ++kt)
#pragma unroll
            for (int jj = 0; jj < 4; ++jj) { const float pr = __expf(sacc[kt][jj] - m); sacc[kt][jj] = pr; l += pr; }
        l += __shfl_xor(l, 16); l += __shfl_xor(l, 32); l += __expf(sink - m);
        const float inv = 1.f / l;
        f32x4 oacc[4];
#pragma unroll
        for (int dt = 0; dt < 4; ++dt) oacc[dt] = (f32x4){0.f, 0.f, 0.f, 0.f};
#pragma unroll
        for (int kb = 0; kb < 6; ++kb) {
            const bf16x8 pf = pack8(sacc[2 * kb], sacc[2 * kb + 1]);
            bf16x4 l0, h0, l1, h1, l2, h2, l3, h3;
            const unsigned vk = va + (unsigned)(kb * 32 * 144);
            asm volatile("ds_read_b64_tr_b16 %0, %8\n\tds_read_b64_tr_b16 %1, %8 offset:2304\n\t"
                         "ds_read_b64_tr_b16 %2, %8 offset:32\n\tds_read_b64_tr_b16 %3, %8 offset:2336\n\t"
                         "ds_read_b64_tr_b16 %4, %8 offset:64\n\tds_read_b64_tr_b16 %5, %8 offset:2368\n\t"
                         "ds_read_b64_tr_b16 %6, %8 offset:96\n\tds_read_b64_tr_b16 %7, %8 offset:2400\n\t"
                         "s_waitcnt lgkmcnt(0)"
                         : "=&v"(l0), "=&v"(h0), "=&v"(l1), "=&v"(h1), "=&v"(l2), "=&v"(h2), "=&v"(l3), "=&v"(h3) : "v"(vk) : "memory");
            oacc[0] = MFMA16(cat4(l0, h0), pf, oacc[0]); oacc[1] = MFMA16(cat4(l1, h1), pf, oacc[1]);
            oacc[2] = MFMA16(cat4(l2, h2), pf, oacc[2]); oacc[3] = MFMA16(cat4(l3, h3), pf, oacc[3]);
        }
#pragma unroll
        for (int dt = 0; dt < 4; ++dt) {
            const u32x2 gq = gv[dt];
            const f32x4 o = oacc[dt] * inv;
            u32x2 wv; wv.x = cvt_pk_bf16(o[0] * siluf(bflo(gq.x)), o[1] * siluf(bfhi(gq.x))); wv.y = cvt_pk_bf16(o[2] * siluf(bflo(gq.y)), o[3] * siluf(bfhi(gq.y)));
            *(u32x2*)(Yd + (row0 + i) * ldd + h * 64 + dt * 16 + q4 * 4) = wv;
        }
    }
    __syncthreads();
}

constexpr size_t WS_ET = WS_XB + 9437184;
constexpr size_t WS_AB = WS_XB + 16777216;
static_assert(WS_AB + (size_t)T * 256 * 2 <= WS_RSTD0, "XB scratch overflow");

__device__ __forceinline__ void gla_prep_item(const Params& p, LAS unsigned char* L, int item) {
    unsigned char* ws = p.ws;
    const int tid = threadIdx.x, lane = tid & 63, w = tid >> 6, r16 = lane & 15, q4 = lane >> 4;
    LAS bf16_t* QG = (LAS bf16_t*)L;
    LAS bf16_t* KG = (LAS bf16_t*)(L + 17408);
    LAS bf16_t* Gs = (LAS bf16_t*)(L + 34816);
    LAS float* Gf = (LAS float*)(L + 52224);
    LAS float* GT = (LAS float*)(L + 84992);
    int b, h; unsigned row0;
    if (item < 2048) { h = item & 3; const int c = (item >> 2) & 31; b = item >> 7; row0 = (unsigned)b * 2048 + c * 64; }
    else { const int i2 = item - 2048; h = i2 & 3; b = i2 >> 2; row0 = (unsigned)T_P + b * 64; }
    bf16_t* BQ = (bf16_t*)(ws + WS_BQ); bf16_t* BKb = (bf16_t*)(ws + WS_BK); const bf16_t* GB = (const bf16_t*)(ws + WS_BLR);
    float* ET = (float*)(ws + WS_ET); bf16_t* AB = (bf16_t*)(ws + WS_AB);
    const int c = tid & 127, tg = tid >> 7;
    const int pt0 = tid >> 4, pt1 = (tid + 512) >> 4, poc = tid & 15;
    const unsigned o0 = (row0 + pt0) * 512u + h * 128 + poc * 8, o1 = (row0 + pt1) * 512u + h * 128 + poc * 8;
    const u32x4 pg0 = *(const u32x4*)(GB + o0), pg1 = *(const u32x4*)(GB + o1);
    const u32x4 pq0 = *(const u32x4*)(BQ + o0), pq1 = *(const u32x4*)(BQ + o1), pk0 = *(const u32x4*)(BKb + o0), pk1 = *(const u32x4*)(BKb + o1);
    *(LAS u32x4*)(Gs + pt0 * 136 + poc * 8) = pg0; *(LAS u32x4*)(Gs + pt1 * 136 + poc * 8) = pg1;
    lds_barrier();
    {
        float cs = 0.f;
#pragma unroll
        for (int tt = 0; tt < 16; ++tt) { cs += bf2f(Gs[(tg * 16 + tt) * 136 + c]); Gf[(tg * 16 + tt) * 128 + c] = cs; }
        GT[tg * 128 + c] = cs;
    }
    lds_barrier();
#pragma unroll
    for (int i = 0; i < 2; ++i) {
        const int t = i ? pt1 : pt0; const int tgp = t >> 4;
        const u32x4 qw = i ? pq1 : pq0, kw = i ? pk1 : pk0;
        float G[8], tot[8];
        { const f32x4 a0 = *(const LAS f32x4*)(Gf + t * 128 + poc * 8), a1 = *(const LAS f32x4*)(Gf + t * 128 + poc * 8 + 4);
          G[0] = a0[0]; G[1] = a0[1]; G[2] = a0[2]; G[3] = a0[3]; G[4] = a1[0]; G[5] = a1[1]; G[6] = a1[2]; G[7] = a1[3]; }
#pragma unroll
        for (int j = 0; j < 8; ++j) tot[j] = 0.f;
#pragma unroll
        for (int g2 = 0; g2 < 4; ++g2) {
            const f32x4 a0 = *(const LAS f32x4*)(GT + g2 * 128 + poc * 8), a1 = *(const LAS f32x4*)(GT + g2 * 128 + poc * 8 + 4);
            const float sel = (g2 < tgp) ? 1.f : 0.f;
            G[0] += sel * a0[0]; G[1] += sel * a0[1]; G[2] += sel * a0[2]; G[3] += sel * a0[3]; G[4] += sel * a1[0]; G[5] += sel * a1[1]; G[6] += sel * a1[2]; G[7] += sel * a1[3];
            tot[0] += a0[0]; tot[1] += a0[1]; tot[2] += a0[2]; tot[3] += a0[3]; tot[4] += a1[0]; tot[5] += a1[1]; tot[6] += a1[2]; tot[7] += a1[3];
        }
        if (i == 0 && tid < 16) {
            float* ep = ET + (size_t)(row0 >> 6) * 512 + h * 128 + poc * 8;
            *(f32x4*)ep = (f32x4){__expf(tot[0]), __expf(tot[1]), __expf(tot[2]), __expf(tot[3])};
            *(f32x4*)(ep + 4) = (f32x4){__expf(tot[4]), __expf(tot[5]), __expf(tot[6]), __expf(tot[7])};
        }
        float qv[8], kv[8];
        unpack8(qw, qv); unpack8(kw, kv);
#pragma unroll
        for (int j = 0; j < 8; ++j) { const float eg = __expf(G[j]); qv[j] *= eg; kv[j] *= rcpf_(eg); }
        u32x4 qo, ko;
        qo.x = cvt_pk_bf16(qv[0], qv[1]); qo.y = cvt_pk_bf16(qv[2], qv[3]); qo.z = cvt_pk_bf16(qv[4], qv[5]); qo.w = cvt_pk_bf16(qv[6], qv[7]);
        ko.x = cvt_pk_bf16(kv[0], kv[1]); ko.y = cvt_pk_bf16(kv[2], kv[3]); ko.z = cvt_pk_bf16(kv[4], kv[5]); ko.w = cvt_pk_bf16(kv[6], kv[7]);
        *(LAS u32x4*)(QG + t * 136 + poc * 8) = qo; *(LAS u32x4*)(KG + t * 136 + poc * 8) = ko;
        *(u32x4*)(BQ + (i ? o1 : o0)) = qo; *(u32x4*)(BKb + (i ? o1 : o0)) = ko;
    }
    lds_barrier();
    {
        const int it = w >> 1, jt0 = (w & 1) * 2;
        f32x4 at[2];
        at[0] = (f32x4){0.f, 0.f, 0.f, 0.f}; at[1] = (f32x4){0.f, 0.f, 0.f, 0.f};
#pragma unroll
        for (int ks = 0; ks < 4; ++ks) {
            const bf16x8 qf = *(const LAS bf16x8*)(QG + (it * 16 + r16) * 136 + ks * 32 + q4 * 8);
#pragma unroll
            for (int t2 = 0; t2 < 2; ++t2) {
                const bf16x8 kf = *(const LAS bf16x8*)(KG + ((jt0 + t2) * 16 + r16) * 136 + ks * 32 + q4 * 8);
                at[t2] = MFMA16(kf, qf, at[t2]);
            }
        }
        const int i = it * 16 + r16;
#pragma unroll
        for (int t2 = 0; t2 < 2; ++t2) {
            f32x4 v = at[t2];
#pragma unroll
            for (int jj = 0; jj < 4; ++jj) { const int j = (jt0 + t2) * 16 + q4 * 4 + jj; if (j > i) v[jj] = 0.f; }
            u32x2 wv; wv.x = cvt_pk_bf16(v[0], v[1]); wv.y = cvt_pk_bf16(v[2], v[3]);
            *(u32x2*)(AB + (size_t)(row0 + i) * 256 + h * 64 + (jt0 + t2) * 16 + q4 * 4) = wv;
        }
    }
    lds_barrier();
}

__device__ __forceinline__ void gla_scan_item(const Params& p, LAS unsigned char* L, int item, bool dummy) {
    unsigned char* ws = p.ws;
    const int tid = threadIdx.x, lane = tid & 63, w = tid >> 6, r16 = lane & 15, q4 = lane >> 4;
    LAS bf16_t* QG = (LAS bf16_t*)L;
    LAS bf16_t* KG = (LAS bf16_t*)(L + 17408);
    LAS bf16_t* Vs = (LAS bf16_t*)(L + 34816);
    LAS bf16_t* As = (LAS bf16_t*)(L + 44032);
    LAS float* GL = (LAS float*)(L + 53248);
    const unsigned lbase = (unsigned)(size_t)L;
    const bool smp = item >= 256;
    const int i2 = smp ? item - 256 : item;
    const int b = i2 >> 4, h = (i2 >> 2) & 3, sl = i2 & 3, e0 = sl * 64;
    const int nch = smp ? 1 : 32;
    const unsigned rbase = smp ? (unsigned)T_P + b * 64 : (unsigned)b * 2048;
    const bf16_t* BQ = (const bf16_t*)(ws + WS_BQ); const bf16_t* BKb = (const bf16_t*)(ws + WS_BK); bf16_t* BV = (bf16_t*)(ws + WS_BV);
    const float* ET = (const float*)(ws + WS_ET); const bf16_t* AB = (const bf16_t*)(ws + WS_AB); float* BOSQP = dummy ? p.out + 20000000 : (float*)(ws + WS_XB);
    bf16_t* BVo = dummy ? (bf16_t*)p.out : BV;
    const int pt0 = tid >> 4, pt1 = (tid + 512) >> 4, poc = tid & 15;
    const int vt = tid >> 3, veo = tid & 7;
    const int et = w & 3, ip = w >> 2;
    f32x4 Sacc[8];
#pragma unroll
    for (int d8 = 0; d8 < 8; ++d8) {
        if (smp) {
#pragma unroll
            for (int jj = 0; jj < 4; ++jj) Sacc[d8][jj] = p.in[4][((size_t)(b * 4 + h) * 128 + d8 * 16 + q4 * 4 + jj) * 256 + e0 + et * 16 + r16];
        } else Sacc[d8] = (f32x4){0.f, 0.f, 0.f, 0.f};
    }
    const int tq_ = r16 >> 2, tp_ = r16 & 3;
    const unsigned v4a = lbase + 34816u + (unsigned)(((q4 * 8 + tq_) * 72 + et * 16 + 4 * tp_) * 2);
    const unsigned k4a = lbase + 17408u + (unsigned)(((q4 * 8 + tq_) * 136 + 4 * tp_) * 2);
    struct Pre { u32x4 q0, q1, k0, k1, a, v; f32x4 e; };
    Pre PA, PB;
    PA.e = (f32x4){0.f, 0.f, 0.f, 0.f}; PB.e = (f32x4){0.f, 0.f, 0.f, 0.f};
#define GLA_PREFETCH(P, R) do { \
        const unsigned o0_ = ((R) + pt0) * 512u + h * 128 + poc * 8, o1_ = ((R) + pt1) * 512u + h * 128 + poc * 8; \
        P.q0 = *(const u32x4*)(BQ + o0_); P.q1 = *(const u32x4*)(BQ + o1_); P.k0 = *(const u32x4*)(BKb + o0_); P.k1 = *(const u32x4*)(BKb + o1_); \
        P.a = *(const u32x4*)(AB + ((R) + vt) * 256u + h * 64 + veo * 8); \
        P.v = *(const u32x4*)(BV + ((R) + vt) * 1024u + h * 256 + e0 + veo * 8); \
        if (tid < 32) P.e = *(const f32x4*)(ET + ((R) >> 6) * 512u + h * 128 + tid * 4); } while (0)
    GLA_PREFETCH(PA, rbase);
    if (nch > 1) GLA_PREFETCH(PB, rbase + 64);
    f32x4 po0 = {0.f, 0.f, 0.f, 0.f}, po1 = {0.f, 0.f, 0.f, 0.f}; unsigned prow = 0; bool pend = false;
#define GLA_STORE_OUT() do { \
            _Pragma("unroll") for (int x2 = 0; x2 < 2; ++x2) { \
                const unsigned row = prow + (ip * 2 + x2) * 16 + r16; \
                const f32x4 o = x2 ? po1 : po0; \
                u32x2 wv; wv.x = cvt_pk_bf16(o[0], o[1]); wv.y = cvt_pk_bf16(o[2], o[3]); \
                *(u32x2*)(BVo + row * 1024u + h * 256 + e0 + et * 16 + q4 * 4) = wv; \
                float ss = o[0] * o[0] + o[1] * o[1] + o[2] * o[2] + o[3] * o[3]; \
                ss += __shfl_xor(ss, 16); ss += __shfl_xor(ss, 32); \
                if (q4 == 0) BOSQP[row * 64u + h * 16 + sl * 4 + et] = ss; \
            } } while (0)
#define GLA_CHUNK(P, CI) do { \
        const unsigned r0 = rbase + (unsigned)(CI) * 64; \
        *(LAS u32x4*)(QG + pt0 * 136 + poc * 8) = P.q0; *(LAS u32x4*)(QG + pt1 * 136 + poc * 8) = P.q1; \
        *(LAS u32x4*)(KG + pt0 * 136 + poc * 8) = P.k0; *(LAS u32x4*)(KG + pt1 * 136 + poc * 8) = P.k1; \
        *(LAS u32x4*)(As + vt * 72 + veo * 8) = P.a; *(LAS u32x4*)(Vs + vt * 72 + veo * 8) = P.v; \
        if (tid < 32) *(LAS f32x4*)(GL + tid * 4) = P.e; \
        lds_barrier(); \
        if (pend) GLA_STORE_OUT(); \
        if ((CI) + 2 < nch) GLA_PREFETCH(P, r0 + 128); \
        bf16x8 vf[2]; \
        { bf16x4 a0, a1, b0, b1; \
          asm volatile("ds_read_b64_tr_b16 %0, %4\n\tds_read_b64_tr_b16 %1, %4 offset:576\n\tds_read_b64_tr_b16 %2, %4 offset:4608\n\tds_read_b64_tr_b16 %3, %4 offset:5184\n\ts_waitcnt lgkmcnt(0)" \
                       : "=&v"(a0), "=&v"(a1), "=&v"(b0), "=&v"(b1) : "v"(v4a) : "memory"); \
          vf[0] = cat4(a0, a1); vf[1] = cat4(b0, b1); } \
        f32x4 ot[2]; \
        ot[0] = (f32x4){0.f, 0.f, 0.f, 0.f}; ot[1] = (f32x4){0.f, 0.f, 0.f, 0.f}; \
        _Pragma("unroll") for (int x2 = 0; x2 < 2; ++x2) \
            _Pragma("unroll") for (int jb = 0; jb < 2; ++jb) { \
                const bf16x8 af = *(const LAS bf16x8*)(As + ((ip * 2 + x2) * 16 + r16) * 72 + jb * 32 + q4 * 8); \
                ot[x2] = MFMA16(vf[jb], af, ot[x2]); } \
        _Pragma("unroll") for (int db = 0; db < 4; ++db) { \
            const bf16x8 sf = pack8(Sacc[2 * db], Sacc[2 * db + 1]); \
            _Pragma("unroll") for (int x2 = 0; x2 < 2; ++x2) { \
                const LAS bf16_t* qp = QG + ((ip * 2 + x2) * 16 + r16) * 136 + db * 32 + q4 * 4; \
                const bf16x8 qv = cat4(*(const LAS bf16x4*)qp, *(const LAS bf16x4*)(qp + 16)); \
                ot[x2] = MFMA16(sf, qv, ot[x2]); } } \
        po0 = ot[0]; po1 = ot[1]; prow = r0; pend = true; \
        _Pragma("unroll") for (int jb = 0; jb < 2; ++jb) { \
            bf16x4 kl[8], kh[8]; \
            const unsigned ka = k4a + (unsigned)(jb * 32 * 272); \
            asm volatile("ds_read_b64_tr_b16 %0, %16 offset:0\n\t" "ds_read_b64_tr_b16 %1, %16 offset:1088\n\t" "ds_read_b64_tr_b16 %2, %16 offset:32\n\t" "ds_read_b64_tr_b16 %3, %16 offset:1120\n\t" "ds_read_b64_tr_b16 %4, %16 offset:64\n\t" "ds_read_b64_tr_b16 %5, %16 offset:1152\n\t" "ds_read_b64_tr_b16 %6, %16 offset:96\n\t" "ds_read_b64_tr_b16 %7, %16 offset:1184\n\t" "ds_read_b64_tr_b16 %8, %16 offset:128\n\t" "ds_read_b64_tr_b16 %9, %16 offset:1216\n\t" "ds_read_b64_tr_b16 %10, %16 offset:160\n\t" "ds_read_b64_tr_b16 %11, %16 offset:1248\n\t" "ds_read_b64_tr_b16 %12, %16 offset:192\n\t" "ds_read_b64_tr_b16 %13, %16 offset:1280\n\t" "ds_read_b64_tr_b16 %14, %16 offset:224\n\t" "ds_read_b64_tr_b16 %15, %16 offset:1312\n\t" "s_waitcnt lgkmcnt(0)" \
                         : "=&v"(kl[0]), "=&v"(kh[0]), "=&v"(kl[1]), "=&v"(kh[1]), "=&v"(kl[2]), "=&v"(kh[2]), "=&v"(kl[3]), "=&v"(kh[3]), "=&v"(kl[4]), "=&v"(kh[4]), "=&v"(kl[5]), "=&v"(kh[5]), "=&v"(kl[6]), "=&v"(kh[6]), "=&v"(kl[7]), "=&v"(kh[7]) : "v"(ka) : "memory"); \
            _Pragma("unroll") for (int d8 = 0; d8 < 8; ++d8) Sacc[d8] = MFMA16(cat4(kl[d8], kh[d8]), vf[jb], Sacc[d8]); } \
        _Pragma("unroll") for (int d8 = 0; d8 < 8; ++d8) { \
            const f32x4 dec = *(const LAS f32x4*)(GL + d8 * 16 + q4 * 4); \
            Sacc[d8] = Sacc[d8] * dec; } \
        lds_barrier(); \
    } while (0)
    for (int ci = 0; ci < nch; ci += 2) {
        GLA_CHUNK(PA, ci);
        if (ci + 1 < nch) GLA_CHUNK(PB, ci + 1);
    }
    if (pend) GLA_STORE_OUT();
#undef GLA_STORE_OUT
#undef GLA_PREFETCH
#undef GLA_CHUNK
    if (ip == 0 && !dummy) {
        float* og = p.out + (smp ? O_GS : O_GP);
#pragma unroll
        for (int d8 = 0; d8 < 8; ++d8)
#pragma unroll
            for (int jj = 0; jj < 4; ++jj) og[((size_t)(b * 4 + h) * 128 + d8 * 16 + q4 * 4 + jj) * 256 + e0 + et * 16 + r16] = Sacc[d8][jj];
    }
}

__device__ __forceinline__ void phase2a(const Params& p, LAS unsigned char* L) {
#ifndef NO_PREP
    for (int it = blockIdx.x; it < 2176; it += gridDim.x) gla_prep_item(p, L, it);
#endif
#ifndef NO_ATTN
    for (int it = blockIdx.x; it < 2176; it += gridDim.x) attn_item(p, L, it, (bf16_t*)(p.ws + WS_GATE), 2048);
#endif
}
__device__ __forceinline__ void phase2b(const Params& p, LAS unsigned char* L) {
#ifndef NO_SCAN
#ifdef PROBE_SCAN2
    for (int it = blockIdx.x; it < 768; it += gridDim.x) gla_scan_item(p, L, it, true);
#endif
    if (gridDim.x == 256) {
        const int xcd = blockIdx.x & 7, loc = blockIdx.x >> 3;
        const int base = (xcd * 8 + (loc >> 2)) * 4 + (loc & 3);
        gla_scan_item(p, L, base, false); gla_scan_item(p, L, 256 + base, false); gla_scan_item(p, L, 512 + base, false);
    } else {
        for (int it = blockIdx.x; it < 768; it += gridDim.x) gla_scan_item(p, L, it, false);
    }
#endif
}

__device__ __forceinline__ void phase3(const Params& p) {
    unsigned char* ws = p.ws;
    const bf16_t* BV = (const bf16_t*)(ws + WS_BV); bf16_t* Yb = (bf16_t*)(ws + WS_GATE); const float* BOSQP = (const float*)(ws + WS_XB);
    const float* gg = p.in[12];
    const long gtid = (long)blockIdx.x * NTHR + threadIdx.x, gsz = (long)gridDim.x * NTHR;
    const long total = (long)T * 128;
    for (long it = gtid; it < total; it += gsz) {
        const long row = it >> 7; const int c8 = (int)(it & 127) * 8, h = c8 >> 8;
        float sq;
        { const f32x4 s0 = *(const f32x4*)(BOSQP + row * 64 + h * 16), s1 = *(const f32x4*)(BOSQP + row * 64 + h * 16 + 4), s2 = *(const f32x4*)(BOSQP + row * 64 + h * 16 + 8), s3 = *(const f32x4*)(BOSQP + row * 64 + h * 16 + 12);
          sq = ((s0[0] + s0[1]) + (s0[2] + s0[3])) + ((s1[0] + s1[1]) + (s1[2] + s1[3])) + ((s2[0] + s2[1]) + (s2[2] + s2[3])) + ((s3[0] + s3[1]) + (s3[2] + s3[3])); }
        const float rs = rsqrtf(sq * (1.f / 256.f) + EPS);
        const u32x4 bo = *(const u32x4*)(BV + row * 1024 + c8);
        const u32x4 gt = *(const u32x4*)(Yb + row * 2048 + 1024 + c8);
        const f32x4 g0 = *(const f32x4*)(gg + (c8 & 255)), g1 = *(const f32x4*)(gg + (c8 & 255) + 4);
        u32x4 o;
        o.x = cvt_pk_bf16(bflo(bo.x) * rs * g0[0] * siluf(bflo(gt.x)), bfhi(bo.x) * rs * g0[1] * siluf(bfhi(gt.x)));
        o.y = cvt_pk_bf16(bflo(bo.y) * rs * g0[2] * siluf(bflo(gt.y)), bfhi(bo.y) * rs * g0[3] * siluf(bfhi(gt.y)));
        o.z = cvt_pk_bf16(bflo(bo.z) * rs * g1[0] * siluf(bflo(gt.z)), bfhi(bo.z) * rs * g1[1] * siluf(bfhi(gt.z)));
        o.w = cvt_pk_bf16(bflo(bo.w) * rs * g1[2] * siluf(bflo(gt.w)), bfhi(bo.w) * rs * g1[3] * siluf(bfhi(gt.w)));
        *(u32x4*)(Yb + row * 2048 + 1024 + c8) = o;
    }
}

__device__ __forceinline__ void lru_item(const Params& p, LAS unsigned char* L, int item) {
    unsigned char* ws = p.ws;
    const int tid = threadIdx.x, lane = tid & 63, w = tid >> 6, r16 = lane & 15, q4 = lane >> 4;
    LAS bf16_t* Wl = (LAS bf16_t*)L;
    LAS bf16_t* U = (LAS bf16_t*)(L + 76800);
    LAS float* Aa = (LAS float*)(L + 102400);
    LAS float* Bb = (LAS float*)(L + 126976);
    LAS float* SP = (LAS float*)(L + 151552);
    LAS float* SH = (LAS float*)(L + 153088);
    LAS float* HC = (LAS float*)(L + 154624);
    LAS float* CW = (LAS float*)(L + 155392);
    const bool smp = item >= 256;
    const int i2 = smp ? item - 256 : item;
    const int b = i2 >> 4, nb = (i2 >> 1) & 7, hf = i2 & 1;
    const int nch = smp ? 1 : 32;
    const unsigned rbase = smp ? (unsigned)T_P + b * 64 : (unsigned)b * 2048;
    const bf16_t* Z2 = (const bf16_t*)(ws + WS_Z2); bf16_t* Y2 = (bf16_t*)(ws + WS_Y2);
    const bf16_t* WA = (const bf16_t*)(ws + WS_WA) + nb * 192 * 192; const bf16_t* WI = (const bf16_t*)(ws + WS_WI) + nb * 192 * 192;
    for (int idx = tid; idx < 192 * 24; idx += NTHR) {
        const int r = idx / 24, g8 = idx % 24;
        const bf16_t* src = (r < 96) ? WA + (size_t)(hf * 96 + r) * 192 + g8 * 8 : WI + (size_t)(hf * 96 + r - 96) * 192 + g8 * 8;
        *(LAS u32x4*)(Wl + r * 200 + g8 * 8) = *(const u32x4*)src;
    }
    const bool cthr = tid < 384;
    const int cgp = tid % 24, tq = (tid / 24) & 15;
    const int chc = nb * 192 + cgp * 8;
    for (int idx = tid; idx < 5 * 192; idx += NTHR) { const int j = idx / 192, cc = idx % 192; CW[idx] = (j < 4) ? p.in[16][j * 1536 + nb * 192 + cc] : p.in[17][nb * 192 + cc]; }
    const int mt = w & 3, pg = w >> 2;
    float bra[3], bri[3], sp[3];
#pragma unroll
    for (int cp = 0; cp < 3; ++cp) {
        const int ch = nb * 192 + hf * 96 + (pg * 3 + cp) * 16 + r16;
        bra[cp] = p.in[19][ch]; bri[cp] = p.in[21][ch];
        const float lam = p.in[22][ch];
        sp[cp] = 8.f * (fmaxf(-lam, 0.f) + log1pf(__expf(-fabsf(lam))));
    }
    if (tid < 96) HC[tid] = smp ? p.in[6][b * 1536 + nb * 192 + hf * 96 + tid] : 0.f;
    const int sch0 = tid % 96, sseg0 = (tid / 96) & 3;
    const int ot0 = tid / 12, og0 = tid % 12, ot1 = (tid + 512) / 12, og1 = (tid + 512) % 12;
    const bool o1 = tid < 256;
    const int och0 = nb * 192 + hf * 96 + og0 * 8, och1 = nb * 192 + hf * 96 + og1 * 8;
    lds_barrier();
    u32x4 xr[7]; u32x4 pg0, pg1 = {0u, 0u, 0u, 0u};
#pragma unroll
    for (int r = 0; r < 7; ++r) {
        xr[r] = (u32x4){0u, 0u, 0u, 0u};
        const int pos = 4 * tq - 3 + r;
        if (cthr) {
            if (pos >= 0) xr[r] = *(const u32x4*)(Z2 + (unsigned)((rbase + pos) * 3072u + chc));
            else if (smp) {
                const float* hp = p.in[5] + ((size_t)b * 3 + (3 + pos)) * 1536 + chc;
                const f32x4 h0 = *(const f32x4*)hp, h1 = *(const f32x4*)(hp + 4);
                xr[r].x = cvt_pk_bf16(h0[0], h0[1]); xr[r].y = cvt_pk_bf16(h0[2], h0[3]); xr[r].z = cvt_pk_bf16(h1[0], h1[1]); xr[r].w = cvt_pk_bf16(h1[2], h1[3]);
            }
        }
    }
    pg0 = *(const u32x4*)(Z2 + (unsigned)((rbase + ot0) * 3072u + 1536 + och0));
    if (o1) pg1 = *(const u32x4*)(Z2 + (unsigned)((rbase + ot1) * 3072u + 1536 + och1));
    u32x4 so0 = {0u, 0u, 0u, 0u}, so1 = {0u, 0u, 0u, 0u}; unsigned sr = 0; bool spend = false;
    for (int ci = 0; ci < nch; ++ci) {
        const unsigned r0 = rbase + (unsigned)ci * 64;
        const bool more = (ci + 1 < nch);
        int sch = sch0, sseg = sseg0;
        asm volatile("" : "+v"(sch), "+v"(sseg));
        if (cthr) {
            float xv[7][8];
#pragma unroll
            for (int r = 0; r < 7; ++r) unpack8(xr[r], xv[r]);
            if (hf == 0 && !more && tq == 15) {
                float* oc = p.out + (smp ? O_CS : O_CP) + (size_t)b * 3 * 1536 + chc;
#pragma unroll
                for (int r = 0; r < 3; ++r) { *(f32x4*)(oc + r * 1536) = (f32x4){xv[4 + r][0], xv[4 + r][1], xv[4 + r][2], xv[4 + r][3]}; *(f32x4*)(oc + r * 1536 + 4) = (f32x4){xv[4 + r][4], xv[4 + r][5], xv[4 + r][6], xv[4 + r][7]}; }
            }
            float cw[5][8];
#pragma unroll
            for (int j = 0; j < 5; ++j) { const f32x4 c0 = *(const LAS f32x4*)(CW + j * 192 + cgp * 8), c1 = *(const LAS f32x4*)(CW + j * 192 + cgp * 8 + 4);
                cw[j][0] = c0[0]; cw[j][1] = c0[1]; cw[j][2] = c0[2]; cw[j][3] = c0[3]; cw[j][4] = c1[0]; cw[j][5] = c1[1]; cw[j][6] = c1[2]; cw[j][7] = c1[3]; }
#pragma unroll
            for (int tk = 0; tk < 4; ++tk) {
                float acc[8];
#pragma unroll
                for (int e = 0; e < 8; ++e) acc[e] = cw[4][e] + xv[tk][e] * cw[0][e] + xv[tk + 1][e] * cw[1][e] + xv[tk + 2][e] * cw[2][e] + xv[tk + 3][e] * cw[3][e];
                u32x4 uw; uw.x = cvt_pk_bf16(acc[0], acc[1]); uw.y = cvt_pk_bf16(acc[2], acc[3]); uw.z = cvt_pk_bf16(acc[4], acc[5]); uw.w = cvt_pk_bf16(acc[6], acc[7]);
                *(LAS u32x4*)(U + (4 * tq + tk) * 200 + cgp * 8) = uw;
            }
            if (more) {
#pragma unroll
                for (int r = 0; r < 7; ++r) xr[r] = *(const u32x4*)(Z2 + (unsigned)((r0 + 64 + 4 * tq - 3 + r) * 3072u + chc));
            }
        }
        lds_barrier();
        if (spend) { *(u32x4*)(Y2 + (unsigned)((sr + ot0) * 1536u + och0)) = so0; if (o1) *(u32x4*)(Y2 + (unsigned)((sr + ot1) * 1536u + och1)) = so1; }
        f32x4 ga[3], gi[3];
#pragma unroll
        for (int cp = 0; cp < 3; ++cp) { ga[cp] = (f32x4){0.f, 0.f, 0.f, 0.f}; gi[cp] = (f32x4){0.f, 0.f, 0.f, 0.f}; }
#pragma unroll 2
        for (int ks = 0; ks < 6; ++ks) {
            const bf16x8 uf = *(const LAS bf16x8*)(U + (mt * 16 + r16) * 200 + ks * 32 + q4 * 8);
#pragma unroll
            for (int cp = 0; cp < 3; ++cp) {
                const int ct = pg * 3 + cp;
                const bf16x8 wa = *(const LAS bf16x8*)(Wl + (ct * 16 + r16) * 200 + ks * 32 + q4 * 8), wi = *(const LAS bf16x8*)(Wl + (96 + ct * 16 + r16) * 200 + ks * 32 + q4 * 8);
                ga[cp] = MFMA16(uf, wa, ga[cp]); gi[cp] = MFMA16(uf, wi, gi[cp]);
            }
        }
#pragma unroll
        for (int cp = 0; cp < 3; ++cp) {
            const int cl = (pg * 3 + cp) * 16 + r16;
#pragma unroll
            for (int jj = 0; jj < 4; ++jj) {
                const int t = mt * 16 + q4 * 4 + jj;
                const float rg = sigmf(ga[cp][jj] + bra[cp]), ig = sigmf(gi[cp][jj] + bri[cp]);
                const float z = rg * sp[cp];
                const float a = __expf(-z);
                const float z2 = z + z;
                const float om = (z2 < 0.05f) ? z2 * (1.f - z2 * (0.5f - z2 * (0.16666667f - z2 * 0.041666668f))) : 1.f - a * a;
                const float uu = bf2f(U[t * 200 + hf * 96 + cl]);
                Aa[t * 96 + cl] = a; Bb[t * 96 + cl] = __builtin_amdgcn_sqrtf(om) * ig * uu;
            }
        }
        lds_barrier();
        if (cthr) {
            float P = 1.f, H = 0.f;
#pragma unroll
            for (int t = 0; t < 16; ++t) { const float a = Aa[(sseg * 16 + t) * 96 + sch]; H = a * H + Bb[(sseg * 16 + t) * 96 + sch]; P *= a; }
            SP[sseg * 96 + sch] = P; SH[sseg * 96 + sch] = H;
        }
        lds_barrier();
        if (cthr) {
            float hh = HC[(ci & 1) * 96 + sch];
#pragma unroll
            for (int sg = 0; sg < 3; ++sg) if (sg < sseg) hh = SP[sg * 96 + sch] * hh + SH[sg * 96 + sch];
#pragma unroll
            for (int t = 0; t < 16; ++t) { hh = Aa[(sseg * 16 + t) * 96 + sch] * hh + Bb[(sseg * 16 + t) * 96 + sch]; Bb[(sseg * 16 + t) * 96 + sch] = hh; }
            if (sseg == 3) HC[((ci + 1) & 1) * 96 + sch] = hh;
        }
        lds_barrier();
        {
            const f32x4 h0 = *(const LAS f32x4*)(Bb + ot0 * 96 + og0 * 8), h1 = *(const LAS f32x4*)(Bb + ot0 * 96 + og0 * 8 + 4);
            u32x4 o;
            o.x = cvt_pk_bf16(h0[0] * siluf(bflo(pg0.x)), h0[1] * siluf(bfhi(pg0.x)));
            o.y = cvt_pk_bf16(h0[2] * siluf(bflo(pg0.y)), h0[3] * siluf(bfhi(pg0.y)));
            o.z = cvt_pk_bf16(h1[0] * siluf(bflo(pg0.z)), h1[1] * siluf(bfhi(pg0.z)));
            o.w = cvt_pk_bf16(h1[2] * siluf(bflo(pg0.w)), h1[3] * siluf(bfhi(pg0.w)));
            so0 = o;
            if (more) pg0 = *(const u32x4*)(Z2 + (unsigned)((r0 + 64 + ot0) * 3072u + 1536 + och0));
        }
        if (o1) {
            const f32x4 h0 = *(const LAS f32x4*)(Bb + ot1 * 96 + og1 * 8), h1 = *(const LAS f32x4*)(Bb + ot1 * 96 + og1 * 8 + 4);
            u32x4 o;
            o.x = cvt_pk_bf16(h0[0] * siluf(bflo(pg1.x)), h0[1] * siluf(bfhi(pg1.x)));
            o.y = cvt_pk_bf16(h0[2] * siluf(bflo(pg1.y)), h0[3] * siluf(bfhi(pg1.y)));
            o.z = cvt_pk_bf16(h1[0] * siluf(bflo(pg1.z)), h1[1] * siluf(bfhi(pg1.z)));
            o.w = cvt_pk_bf16(h1[2] * siluf(bflo(pg1.w)), h1[3] * siluf(bfhi(pg1.w)));
            so1 = o;
            if (more) pg1 = *(const u32x4*)(Z2 + (unsigned)((r0 + 64 + ot1) * 3072u + 1536 + och1));
        }
        sr = r0; spend = true;
        lds_barrier();
    }
    if (spend) { *(u32x4*)(Y2 + (unsigned)((sr + ot0) * 1536u + och0)) = so0; if (o1) *(u32x4*)(Y2 + (unsigned)((sr + ot1) * 1536u + och1)) = so1; }
    if (tid < 96) p.out[(smp ? O_LS : O_LP) + (size_t)b * 1536 + nb * 192 + hf * 96 + tid] = HC[(nch & 1) * 96 + tid];
    lds_barrier();
}

__device__ __forceinline__ void phase6(const Params& p, LAS unsigned char* L) {
    if (gridDim.x == 256) {
        const int xcd = blockIdx.x & 7, loc = blockIdx.x >> 3;
        const int pair = xcd * 16 + (loc >> 1), hf = loc & 1;
        lru_item(p, L, pair * 2 + hf); lru_item(p, L, 256 + pair * 2 + hf); lru_item(p, L, 512 + pair * 2 + hf);
    } else {
        for (int it = blockIdx.x; it < 768; it += gridDim.x) lru_item(p, L, it);
    }
}

__device__ __forceinline__ void phase8(const Params& p) {
    const float* rsq = (const float*)(p.ws + WS_RSQ2); const float* g = p.in[24]; float* y = p.out;
    const long gtid = (long)blockIdx.x * NTHR + threadIdx.x, gsz = (long)gridDim.x * NTHR;
    const long total = (long)T * 256;
    for (long it = gtid; it < total; it += gsz) {
        const long row = it >> 8; const int c4 = (int)(it & 255) * 4;
        const float rs = rsqrtf(rsq[row] * (1.f / 1024.f) + EPS);
        const f32x4 v = *(const f32x4*)(y + row * 1024 + c4), gv = *(const f32x4*)(g + c4);
        *(f32x4*)(y + row * 1024 + c4) = v * rs * gv;
    }
}


#define XB_TMO      128
#define XB_XCNT(j)  (256  + 64 * (j))
#define XB_XSUB(j)  (1280 + 64 * (j))
#define XB_XGEN(j)  (2304 + 64 * (j))
#define XB_TOP      3328
#define XB_TOPGEN   3392
#define XCD_BAR_WORDS 3456
#define XB_SPIN_CAP (1u << 18)
__device__ __forceinline__ unsigned xb_ld(unsigned* p)              { return __hip_atomic_load(p, __ATOMIC_RELAXED, __HIP_MEMORY_SCOPE_AGENT); }
__device__ __forceinline__ unsigned xb_add(unsigned* p, unsigned v) { return __hip_atomic_fetch_add(p, v, __ATOMIC_RELAXED, __HIP_MEMORY_SCOPE_AGENT); }
__device__ __forceinline__ unsigned xb_xcc_id() { return (unsigned)__builtin_amdgcn_s_getreg((3 << 11) | 20) & 0xFu; }
#define XB_SPIN(cond, bar) do { unsigned _sp = 0; while (cond) { __builtin_amdgcn_s_sleep(1); \
    if ((++_sp & 255u) == 0u) { if (xb_ld(&(bar)[XB_TMO])) break; if (_sp > XB_SPIN_CAP) { atomicAdd(&(bar)[XB_TMO], 1u); break; } } } } while (0)
struct XcdBarrier { unsigned* bar; unsigned x; volatile LAS unsigned* st; };
__device__ __forceinline__ XcdBarrier xcd_barrier_post(unsigned* bar, volatile LAS unsigned* st) {
    XcdBarrier b; b.bar = bar; b.x = xb_xcc_id(); b.st = st;
    if (threadIdx.x == 0) (void)xb_add(&bar[XB_XCNT(b.x)], 1u);
    return b;
}
__device__ __forceinline__ void xcd_barrier_complete(unsigned* bar, unsigned x, unsigned& nloc, unsigned& nx) {
    const unsigned G = gridDim.x * gridDim.y * gridDim.z;
    unsigned sum, cnt, mine, sp = 0u;
    for (;;) {
        sum = 0u; cnt = 0u; mine = 0u;
#pragma unroll
        for (unsigned j = 0; j < 16; ++j) { const unsigned c = xb_ld(&bar[XB_XCNT(j)]); sum += c; cnt += (c > 0u) ? 1u : 0u; mine = (j == x) ? c : mine; }
        if (sum == G) break;
        __builtin_amdgcn_s_sleep(1);
        if ((++sp & 255u) == 0u) { if (xb_ld(&bar[XB_TMO])) break; if (sp > XB_SPIN_CAP) { atomicAdd(&bar[XB_TMO], 1u); break; } }
    }
    nloc = mine > 0u ? mine : 1u; nx = cnt > 0u ? cnt : 1u;
}
__device__ __forceinline__ void xcd_barrier(const XcdBarrier& b) {
    asm volatile("s_waitcnt vmcnt(0)" ::: "memory");
    __syncthreads();
    if (threadIdx.x == 0) {
        unsigned* bar = b.bar;
        __builtin_amdgcn_s_waitcnt(0);
        unsigned nloc = b.st[0], nx = b.st[1];
        if (nloc == 0u) { xcd_barrier_complete(bar, b.x, nloc, nx); b.st[0] = nloc; b.st[1] = nx; }
        const unsigned old = xb_add(&bar[XB_XSUB(b.x)], 1u);
        const unsigned gen = old / nloc;
        if (old + 1u == (gen + 1u) * nloc) {
            __builtin_amdgcn_fence(__ATOMIC_RELEASE, "agent");
            asm volatile("s_waitcnt vmcnt(0)" ::: "memory");
            const unsigned og = xb_add(&bar[XB_TOP], 1u);
            const unsigned tg = og / nx;
            if (og + 1u == (tg + 1u) * nx) xb_add(&bar[XB_TOPGEN], 1u);
            else XB_SPIN(xb_ld(&bar[XB_TOPGEN]) == tg, bar);
            __builtin_amdgcn_fence(__ATOMIC_ACQUIRE, "agent");
            xb_add(&bar[XB_XGEN(b.x)], 1u);
            asm volatile("s_waitcnt vmcnt(0)" ::: "memory");
        } else {
            XB_SPIN(xb_ld(&bar[XB_XGEN(b.x)]) == gen, bar);
            __builtin_amdgcn_fence(__ATOMIC_ACQUIRE, "agent");
            asm volatile("s_waitcnt vmcnt(0)" ::: "memory");
        }
    }
    __syncthreads();
}

__global__ void __launch_bounds__(NTHR) mega(Params p) {
    extern __shared__ __attribute__((aligned(16))) unsigned char lds_raw[];
    LAS unsigned char* L = (LAS unsigned char*)lds_raw;
    cg::grid_group grid = cg::this_grid();
    unsigned char* ws = p.ws;
    const int lo = p.ph_lo, hi = p.ph_hi;
    LAS unsigned* stw = (LAS unsigned*)(L + (LDS_BYTES - 16));
    if (threadIdx.x < 4) stw[threadIdx.x] = 0u;
    __syncthreads();
    const XcdBarrier xb = xcd_barrier_post((unsigned*)(ws + WS_BAR), (volatile LAS unsigned*)stw);
#ifndef PHMASK
#define PHMASK 0x1ff
#endif
#define IN(k) (((PHMASK >> (k)) & 1) && lo <= (k) && (k) < hi)
#define SEAM(k) do { if (IN(k) && IN((k) + 1)) xcd_barrier(xb); } while (0)
    if (hi > 1000) grid.sync();
    if (IN(0)) phase0(p);
    SEAM(0);
    if (IN(1)) {
        pg8::Gemm g{(const bf16_t*)(ws + WS_XB), (const bf16_t*)(ws + WS_WINE), T, NE_PAD, 1024};
        pg8::StaticOrder S; S.init(T, NE_PAD, gridDim.x, blockIdx.x);
        EpiInEven E{ws, p.out, (const float*)(ws + WS_RSTD0), p.in[10]};
        pg8::gemm_phase<EpiInEven>(L, g, S, E);
    }
    SEAM(1);
    if (IN(2)) { phase2a(p, L); xcd_barrier(xb); phase2b(p, L); }
    SEAM(2);
    if (IN(3)) phase3(p);
    SEAM(3);
    if (IN(4)) {
        pg8::Gemm g{(const bf16_t*)(ws + WS_GATE), (const bf16_t*)(ws + WS_WOUTE), T, 1024, 2048};
        pg8::StaticOrder S; S.init(T, 1024, gridDim.x, blockIdx.x);
        EpiOutRes<true> E{p.in[0], p.in[1], p.out, (bf16_t*)(ws + WS_XB), (float*)(ws + WS_RSQ1)};
        pg8::gemm_phase<EpiOutRes<true>>(L, g, S, E);
    }
    SEAM(4);
    if (IN(5)) {
        pg8::Gemm g{(const bf16_t*)(ws + WS_XB), (const bf16_t*)(ws + WS_WINO), T, 3072, 1024};
        pg8::StaticOrder S; S.init(T, 3072, gridDim.x, blockIdx.x);
        EpiInOdd E{(bf16_t*)(ws + WS_Z2), (const float*)(ws + WS_RSQ1)};
        pg8::gemm_phase<EpiInOdd>(L, g, S, E);
    }
    SEAM(5);
    if (IN(6)) phase6(p, L);
    SEAM(6);
    if (IN(7)) {
        pg8::Gemm g{(const bf16_t*)(ws + WS_Y2), (const bf16_t*)(ws + WS_WOUTO), T, 1024, 1536};
        pg8::StaticOrder S; S.init(T, 1024, gridDim.x, blockIdx.x);
        EpiOutRes<false> E{p.out, p.out + (size_t)T_P * 1024, p.out, nullptr, (float*)(ws + WS_RSQ2)};
        pg8::gemm_phase<EpiOutRes<false>>(L, g, S, E);
    }
    SEAM(7);
    if (IN(8)) phase8(p);
#undef IN
#undef SEAM
}

extern "C" void kernel_launch(void* const* d_in, const int* in_sizes, int n_in, void* d_out, int out_size, void* d_ws, size_t ws_size, hipStream_t stream) {
    static int grid_blocks = 0;
    if (grid_blocks == 0) {
        if (n_in != 25 || (size_t)out_size != O_END || ws_size < WS_TOTAL) { fprintf(stderr, "kernel_launch: unexpected shapes n_in %d out %d ws %zu (need %zu)\n", n_in, out_size, ws_size, (size_t)WS_END); grid_blocks = -1; return; }
        int dev = 0, cus = 0, per_cu = 0;
        (void)hipGetDevice(&dev);
        (void)hipDeviceGetAttribute(&cus, hipDeviceAttributeMultiprocessorCount, dev);
        if (hipFuncSetAttribute((const void*)mega, hipFuncAttributeMaxDynamicSharedMemorySize, LDS_BYTES) != hipSuccess) { fprintf(stderr, "kernel_launch: hipFuncSetAttribute failed\n"); }
        if (hipOccupancyMaxActiveBlocksPerMultiprocessor(&per_cu, (const void*)mega, NTHR, LDS_BYTES) != hipSuccess || per_cu < 1) per_cu = 1;
        (void)hipGetLastError();
        grid_blocks = cus * per_cu;
        if (grid_blocks <= 0) grid_blocks = 256;
    }
    if (grid_blocks < 0) return;
    Params p{};
    for (int i = 0; i < 25; ++i) p.in[i] = (const float*)d_in[i];
    p.out = (float*)d_out; p.ws = (unsigned char*)d_ws;
#if ONE_LAUNCH
#ifdef PROBE_X
    { const int seq[3][2] = {{0, PROBE_Y + 1}, {PROBE_X, PROBE_Y + 1}, {PROBE_Y + 1, 9}};
      for (int li = 0; li < 3; ++li) { if (seq[li][0] >= seq[li][1]) continue; p.ph_lo = seq[li][0]; p.ph_hi = seq[li][1]; void* args[] = {&p};
        (void)hipMemsetAsync((char*)d_ws + WS_BAR, 0, 16384, stream);
        hipError_t e = hipLaunchCooperativeKernel((const void*)mega, dim3(grid_blocks), dim3(NTHR), args, LDS_BYTES, stream);
        if (e != hipSuccess) fprintf(stderr, "cooperative launch failed: %s (grid %d)\n", hipGetErrorString(e), grid_blocks); } }
#else
    p.ph_lo = 0; p.ph_hi = 9;
    (void)hipMemsetAsync((char*)d_ws + WS_BAR, 0, 16384, stream);
    { void* args[] = {&p}; hipError_t e = hipLaunchCooperativeKernel((const void*)mega, dim3(grid_blocks), dim3(NTHR), args, LDS_BYTES, stream);
      if (e != hipSuccess) fprintf(stderr, "cooperative launch failed: %s (grid %d)\n", hipGetErrorString(e), grid_blocks); }
#endif
#else
    for (int ph = 0; ph < 9; ++ph) {
        p.ph_lo = ph; p.ph_hi = ph + 1;
        (void)hipMemsetAsync((char*)d_ws + WS_BAR, 0, 16384, stream);
        void* args[] = {&p}; hipError_t e = hipLaunchCooperativeKernel((const void*)mega, dim3(grid_blocks), dim3(NTHR), args, LDS_BYTES, stream);
        if (e != hipSuccess) fprintf(stderr, "cooperative launch %d failed: %s (grid %d)\n", ph, hipGetErrorString(e), grid_blocks);
    }
#endif
}
```

```cpp
#include <hip/hip_runtime.h>
#include <hip/hip_cooperative_groups.h>
#include <cstdio>
namespace cg = cooperative_groups;

#ifndef ONE_LAUNCH
#define ONE_LAUNCH 1
#endif

#define LAS __attribute__((address_space(3)))
typedef unsigned short bf16_t;
typedef short bf16x8 __attribute__((ext_vector_type(8)));
typedef short bf16x4 __attribute__((ext_vector_type(4)));
typedef float f32x4 __attribute__((ext_vector_type(4)));
typedef unsigned u32x4 __attribute__((ext_vector_type(4)));
typedef unsigned u32x2 __attribute__((ext_vector_type(2)));

constexpr int T_P = 32768, T_S = 2048, T = T_P + T_S, DM = 1024;
constexpr int NE_PAD = 6144;
constexpr int LDS_BYTES = 159744;
constexpr int NTHR = 512;
constexpr float EPS = 1e-6f;

constexpr size_t WS_WINE = 0;
constexpr size_t WS_WOUTE = WS_WINE + (size_t)NE_PAD * 1024 * 2;
constexpr size_t WS_WINO = WS_WOUTE + (size_t)1024 * 2048 * 2;
constexpr size_t WS_WOUTO = WS_WINO + (size_t)3072 * 1024 * 2;
constexpr size_t WS_WA = WS_WOUTO + (size_t)1024 * 1536 * 2;
constexpr size_t WS_WI = WS_WA + (size_t)8 * 192 * 192 * 2;
constexpr size_t WS_XB = WS_WI + (size_t)8 * 192 * 192 * 2;
constexpr size_t WS_RSTD0 = WS_XB + (size_t)T * 1024 * 2;
constexpr size_t WS_RSQ1 = WS_RSTD0 + (size_t)T * 4;
constexpr size_t WS_RSQ2 = WS_RSQ1 + (size_t)T * 4;
constexpr size_t WS_BOSQ = WS_RSQ2 + (size_t)T * 4;
constexpr size_t WS_Q = WS_BOSQ + (size_t)T * 16;
constexpr size_t WS_K = WS_Q + (size_t)T * 1024 * 2;
constexpr size_t WS_V = WS_K + (size_t)T * 256 * 2;
constexpr size_t WS_BQ = WS_V + (size_t)T * 256 * 2;
constexpr size_t WS_BK = WS_BQ + (size_t)T * 512 * 2;
constexpr size_t WS_BV = WS_BK + (size_t)T * 512 * 2;
constexpr size_t WS_GATE = WS_BV + (size_t)T * 1024 * 2;
constexpr size_t WS_BLR = WS_GATE + (size_t)T * 2048 * 2;
constexpr size_t WS_END = WS_BLR + (size_t)T * 512 * 2;
constexpr size_t WS_BAR = WS_END;
constexpr size_t WS_TOTAL = WS_BAR + 16384;
constexpr size_t WS_Z2 = WS_Q;
constexpr size_t WS_Y2 = WS_GATE;
static_assert(WS_Z2 + (size_t)T * 3072 * 2 <= WS_GATE, "Z2 alias");

constexpr size_t O_Y = 0;
constexpr size_t O_KP = (size_t)T * 1024;
constexpr size_t O_VP = O_KP + 524288;
constexpr size_t O_GP = O_VP + 524288;
constexpr size_t O_CP = O_GP + 2097152;
constexpr size_t O_LP = O_CP + 73728;
constexpr size_t O_KS = O_LP + 24576;
constexpr size_t O_VS = O_KS + 524288;
constexpr size_t O_GS = O_VS + 524288;
constexpr size_t O_CS = O_GS + 4194304;
constexpr size_t O_LS = O_CS + 147456;
constexpr size_t O_END = O_LS + 49152;

struct Params {
    const float* in[25];
    float* out;
    unsigned char* ws;
    int ph_lo, ph_hi;
};

__device__ __forceinline__ unsigned cvt_pk_bf16(float lo, float hi) { unsigned r; asm volatile("v_cvt_pk_bf16_f32 %0, %1, %2" : "=v"(r) : "v"(lo), "v"(hi)); return r; }
__device__ __forceinline__ bf16_t f2bf(float f) { return (bf16_t)(cvt_pk_bf16(f, 0.f) & 0xffffu); }
__device__ __forceinline__ float bf2f(bf16_t b) { return __uint_as_float(((unsigned)b) << 16); }
__device__ __forceinline__ float bflo(unsigned w) { return __uint_as_float(w << 16); }
__device__ __forceinline__ float bfhi(unsigned w) { return __uint_as_float(w & 0xffff0000u); }
__device__ __forceinline__ float rcpf_(float x) { return __builtin_amdgcn_rcpf(x); }
__device__ __forceinline__ float siluf(float x) { return x * rcpf_(1.f + __expf(-x)); }
__device__ __forceinline__ float sigmf(float x) { return rcpf_(1.f + __expf(-x)); }
__device__ __forceinline__ void lds_barrier() { asm volatile("s_waitcnt lgkmcnt(0)" ::: "memory"); __builtin_amdgcn_s_barrier(); asm volatile("" ::: "memory"); }
__device__ __forceinline__ bf16x8 pack8(const f32x4& a, const f32x4& b) {
    u32x4 p; p.x = cvt_pk_bf16(a[0], a[1]); p.y = cvt_pk_bf16(a[2], a[3]); p.z = cvt_pk_bf16(b[0], b[1]); p.w = cvt_pk_bf16(b[2], b[3]);
    return __builtin_bit_cast(bf16x8, p);
}
__device__ __forceinline__ bf16x8 cat4(const bf16x4 a, const bf16x4 b) { bf16x8 r; r[0] = a[0]; r[1] = a[1]; r[2] = a[2]; r[3] = a[3]; r[4] = b[0]; r[5] = b[1]; r[6] = b[2]; r[7] = b[3]; return r; }
__device__ __forceinline__ void unpack8(const u32x4 w, float (&v)[8]) { v[0] = bflo(w.x); v[1] = bfhi(w.x); v[2] = bflo(w.y); v[3] = bfhi(w.y); v[4] = bflo(w.z); v[5] = bfhi(w.z); v[6] = bflo(w.w); v[7] = bfhi(w.w); }
#define MFMA16(a, b, c) __builtin_amdgcn_mfma_f32_16x16x32_bf16((a), (b), (c), 0, 0, 0)

namespace pg8 {
constexpr int BM = 256, BK = 64, HALF = 128, HTB = HALF * BK * 2, STAGE_BYTES = 8 * HTB, NXCD = 8, WGM = 8;
__device__ __forceinline__ int lds_byte(int r, int c) { const int st = (r >> 4) * 2 + (c >> 5), rr = r & 15, cc = c & 31, ob = rr * 64 + cc * 2; return st * 1024 + (ob ^ (((ob >> 9) & 1) << 5)); }
__device__ __forceinline__ int perm32(int rho) { const int n = rho >> 4, i = rho & 15; return 8 * (i >> 2) + 4 * n + (i & 3); }
__device__ __forceinline__ void stage_rc(int b, int& R, int& C) { const int st = b / 1024, sb = b % 1024, swz = sb ^ (((sb >> 9) & 1) << 5); R = (st >> 1) * 16 + swz / 64; C = (st & 1) * 32 + (swz % 64) / 2; }
struct Unit { int pm, pn; };
struct Gemm { const bf16_t* A; const bf16_t* Bt; int M, N, K; };
struct StaticOrder {
    int nM, nN, nwg, G, c;
    __device__ void init(int M, int N, int G_, int c_) { nM = M / BM; nN = N / BM; nwg = nM * nN; G = G_; c = c_; }
    __device__ __forceinline__ bool next(int i, Unit& u) const {
        const long Lx = (long)i * G + c; if (Lx >= nwg) return false;
        int wgid = (int)Lx; { const int q = nwg / NXCD, r = nwg % NXCD, xcd = wgid % NXCD, off = wgid / NXCD; wgid = (xcd < r ? xcd * (q + 1) : r * (q + 1) + (xcd - r) * q) + off; }
        const int nig = WGM * nN, gid = wgid / nig, fm = gid * WGM, gsz = (nM - fm) < WGM ? (nM - fm) : WGM;
        u.pm = fm + ((wgid % nig) % gsz); u.pn = (wgid % nig) / gsz; return true;
    }
};

template <class Epi>
__device__ __forceinline__ void gemm_phase(LAS unsigned char* lds, const Gemm g, const StaticOrder& S, const Epi& E) {
    const int tid = threadIdx.x, wid = __builtin_amdgcn_readfirstlane(tid >> 6), lane = tid & 63, wr = wid >> 2, wc = wid & 3, fr = lane & 15, fq = lane >> 4;
    const int K = g.K, nt = K / BK;
    unsigned voffA[2], voffB[2];
#pragma unroll
    for (int i = 0; i < 2; ++i) { int R, C; stage_rc(tid * 16 + i * 8192, R, C); const int Rb = Epi::PERM ? ((R & ~31) + perm32(R & 31)) : R;
        voffA[i] = (unsigned)(R * K + C) * 2u; voffB[i] = (unsigned)(Rb * K + C) * 2u; }
    const size_t kstep = (size_t)(BK * 2);
    const size_t hstep = (size_t)HALF * K * 2;
    const size_t tstep = 2 * hstep;
    const unsigned ldsw = (unsigned)wid * 1024u;
    const int aoff = lds_byte(wr * 64 + fr, fq * 8), boff = lds_byte(wc * 32 + fr, fq * 8);
#define PG8_SA(b, h) (((b) * 2 + (h)) * HTB)
#define PG8_SB(b, h) ((4 + (b) * 2 + (h)) * HTB)
#define PG8_STAGE(bufoff, gbase, voff) do { _Pragma("unroll") for (int _i = 0; _i < 2; ++_i) \
        __builtin_amdgcn_global_load_lds((const unsigned*)((const char*)(gbase) + (voff)[_i]), (LAS unsigned*)(lds + (bufoff) + ldsw + _i * 8192), 16, 0, 0); } while (0)
#define PG8_LDA(dst, b, h) do { _Pragma("unroll") for (int m = 0; m < 4; ++m) _Pragma("unroll") for (int k = 0; k < 2; ++k) dst[m][k] = *(const LAS bf16x8*)(lds + PG8_SA(b, h) + aoff + m * 2048 + k * 1024); } while (0)
#define PG8_LDB(dst, b, h) do { _Pragma("unroll") for (int n = 0; n < 2; ++n) _Pragma("unroll") for (int k = 0; k < 2; ++k) dst[n][k] = *(const LAS bf16x8*)(lds + PG8_SB(b, h) + boff + n * 2048 + k * 1024); } while (0)
#define PG8_MMA(ai, bj, At, Bt) do { __builtin_amdgcn_s_setprio(1); _Pragma("unroll") for (int m = 0; m < 4; ++m) _Pragma("unroll") for (int n = 0; n < 2; ++n) _Pragma("unroll") for (int k = 0; k < 2; ++k) \
        acc[ai][bj][m][n] = __builtin_amdgcn_mfma_f32_16x16x32_bf16(Bt[n][k], At[m][k], acc[ai][bj][m][n], 0, 0, 0); __builtin_amdgcn_s_setprio(0); } while (0)
#define PG8_WAIT_V(n) asm volatile("s_waitcnt vmcnt(" #n ")" ::: "memory")
#define PG8_WAIT_L(n) asm volatile("s_waitcnt lgkmcnt(" #n ")" ::: "memory")
#define PG8_BAR __builtin_amdgcn_s_barrier()
#define PG8_SCHED __builtin_amdgcn_sched_barrier(0)
    Unit cur, nxt; int ui = 0;
    if (!S.next(0, cur)) return;
    f32x4 acc[2][2][4][2];
#pragma unroll
    for (int a = 0; a < 2; ++a)
#pragma unroll
        for (int b = 0; b < 2; ++b)
#pragma unroll
            for (int m = 0; m < 4; ++m)
#pragma unroll
                for (int n = 0; n < 2; ++n) acc[a][b][m][n] = (f32x4){0.f, 0.f, 0.f, 0.f};
    bf16x8 At[4][2], B0[2][2], B1[2][2];
    const char* cA = (const char*)g.A + (size_t)cur.pm * tstep; const char* cB = (const char*)g.Bt + (size_t)cur.pn * tstep;
    PG8_STAGE(PG8_SB(0, 0), cB, voffB); PG8_STAGE(PG8_SB(0, 1), cB + hstep, voffB); PG8_STAGE(PG8_SA(0, 0), cA, voffA); PG8_STAGE(PG8_SA(0, 1), cA + hstep, voffA);
    if (wr == 1) PG8_BAR;
    PG8_WAIT_V(2); PG8_BAR;
    PG8_STAGE(PG8_SB(1, 0), cB + kstep, voffB); PG8_STAGE(PG8_SA(1, 0), cA + kstep, voffA); PG8_STAGE(PG8_SB(1, 1), cB + hstep + kstep, voffB);
    PG8_WAIT_V(6); PG8_BAR;
    for (;;) {
        const bool has_next = S.next(ui + 1, nxt);
        const char* nA = has_next ? (const char*)g.A + (size_t)nxt.pm * tstep : cA; const char* nB = has_next ? (const char*)g.Bt + (size_t)nxt.pn * tstep : cB;
        for (int t = 0; t < nt; t += 2) {
            const bool last = (t == nt - 2);
            const char* a1 = cA + (size_t)(t + 1) * kstep;
            const char* a2 = last ? nA : cA + (size_t)(t + 2) * kstep; const char* b2 = last ? nB : cB + (size_t)(t + 2) * kstep;
            const char* a3 = a2 + kstep; const char* b3 = b2 + kstep;
            PG8_LDB(B0, 0, 0); PG8_LDB(B1, 0, 1); PG8_SCHED; PG8_LDA(At, 0, 0); PG8_STAGE(PG8_SA(1, 1), a1 + hstep, voffA);
            PG8_WAIT_V(8); PG8_WAIT_L(0); PG8_BAR; PG8_MMA(0, 0, At, B0); PG8_MMA(0, 1, At, B1); PG8_BAR; PG8_SCHED;
            PG8_LDA(At, 0, 1); PG8_STAGE(PG8_SB(0, 0), b2, voffB); PG8_STAGE(PG8_SB(0, 1), b2 + hstep, voffB); PG8_STAGE(PG8_SA(0, 0), a2, voffA);
            PG8_WAIT_V(8); PG8_WAIT_L(0); PG8_BAR; PG8_MMA(1, 0, At, B0); PG8_MMA(1, 1, At, B1); PG8_BAR; PG8_SCHED;
            PG8_LDB(B0, 1, 0); PG8_LDB(B1, 1, 1); PG8_SCHED; PG8_LDA(At, 1, 0); PG8_STAGE(PG8_SA(0, 1), a2 + hstep, voffA);
            PG8_WAIT_V(8); PG8_WAIT_L(0); PG8_BAR; PG8_MMA(0, 0, At, B0); PG8_MMA(0, 1, At, B1); PG8_BAR; PG8_SCHED;
            PG8_LDA(At, 1, 1); PG8_STAGE(PG8_SB(1, 0), b3, voffB); PG8_STAGE(PG8_SB(1, 1), b3 + hstep, voffB); PG8_STAGE(PG8_SA(1, 0), a3, voffA);
            PG8_WAIT_V(8); PG8_WAIT_L(0); PG8_BAR; PG8_MMA(1, 0, At, B0); PG8_MMA(1, 1, At, B1); PG8_BAR; PG8_SCHED;
        }
        if (wr == 0) PG8_BAR;
        E(acc, cur, wr, wc, fr, fq);
        if (!has_next) break;
#pragma unroll
        for (int a = 0; a < 2; ++a)
#pragma unroll
            for (int b = 0; b < 2; ++b)
#pragma unroll
                for (int m = 0; m < 4; ++m)
#pragma unroll
                    for (int n = 0; n < 2; ++n) acc[a][b][m][n] = (f32x4){0.f, 0.f, 0.f, 0.f};
        cur = nxt; cA = nA; cB = nB; ++ui;
        if (wr == 1) PG8_BAR;
    }
    PG8_WAIT_V(0);
    PG8_BAR;
#undef PG8_SA
#undef PG8_SB
#undef PG8_STAGE
#undef PG8_LDA
#undef PG8_LDB
#undef PG8_MMA
#undef PG8_WAIT_V
#undef PG8_WAIT_L
#undef PG8_BAR
#undef PG8_SCHED
}
}

typedef f32x4 AccT[2][2][4][2];

struct EpiInEven {
    static constexpr bool PERM = true;
    unsigned char* ws; float* out; const float* rstd; const float* blr_b;
    __device__ __forceinline__ void operator()(const AccT& acc, const pg8::Unit& u, int wr, int wc, int fr, int fq) const {
        const int pn = u.pn;
        bf16_t* base; int ld, coff; float sc = 1.f;
        if (pn < 4) { base = (bf16_t*)(ws + WS_Q); ld = 1024; coff = pn * 256; sc = 0.125f; }
        else if (pn == 4) { base = (bf16_t*)(ws + WS_K); ld = 256; coff = 0; }
        else if (pn == 5) { base = (bf16_t*)(ws + WS_V); ld = 256; coff = 0; }
        else if (pn < 8) { base = (bf16_t*)(ws + WS_BQ); ld = 512; coff = (pn - 6) * 256; sc = 0.08838834764831845f; }
        else if (pn < 10) { base = (bf16_t*)(ws + WS_BK); ld = 512; coff = (pn - 8) * 256; }
        else if (pn < 14) { base = (bf16_t*)(ws + WS_BV); ld = 1024; coff = (pn - 10) * 256; }
        else if (pn < 22) { base = (bf16_t*)(ws + WS_GATE); ld = 2048; coff = (pn - 14) * 256; }
        else { base = (bf16_t*)(ws + WS_BLR); ld = 512; coff = (pn - 22) * 256; }
        const int row0 = u.pm * 256 + wr * 64 + fr;
        const int ct = wc * 32 + 8 * fq;
        float rsv[8];
#pragma unroll
        for (int it = 0; it < 8; ++it) rsv[it] = rstd[row0 + (it >> 2) * 128 + (it & 3) * 16];
        if (pn >= 22) {
#pragma unroll
            for (int ai = 0; ai < 2; ++ai)
#pragma unroll
                for (int m = 0; m < 4; ++m) {
                    const int row = row0 + ai * 128 + m * 16; const float rs = rsv[ai * 4 + m];
#pragma unroll
                    for (int bj = 0; bj < 2; ++bj) {
                        const int cg = coff + ct + bj * 128;
                        const f32x4 b0 = *(const f32x4*)(blr_b + cg), b1 = *(const f32x4*)(blr_b + cg + 4);
                        f32x4 x0 = acc[ai][bj][m][0] * rs + b0, x1 = acc[ai][bj][m][1] * rs + b1;
#pragma unroll
                        for (int j = 0; j < 4; ++j) { x0[j] = (fminf(x0[j], 0.f) - __logf(1.f + __expf(-fabsf(x0[j])))) * (1.f / 16.f); x1[j] = (fminf(x1[j], 0.f) - __logf(1.f + __expf(-fabsf(x1[j])))) * (1.f / 16.f); }
                        u32x4 w; w.x = cvt_pk_bf16(x0[0], x0[1]); w.y = cvt_pk_bf16(x0[2], x0[3]); w.z = cvt_pk_bf16(x1[0], x1[1]); w.w = cvt_pk_bf16(x1[2], x1[3]);
                        *(u32x4*)(base + (size_t)row * 512 + cg) = w;
                    }
                }
            return;
        }
        const bool kv = (pn == 4 || pn == 5);
        float* okv_p = out + (pn == 4 ? O_KP : O_VP); float* okv_s = out + (pn == 4 ? O_KS : O_VS);
#pragma unroll
        for (int ai = 0; ai < 2; ++ai)
#pragma unroll
            for (int m = 0; m < 4; ++m) {
                const int row = row0 + ai * 128 + m * 16; const float rs = rsv[ai * 4 + m] * sc;
                bf16_t* rowp = base + (size_t)row * ld + coff + ct;
                float* orow = nullptr;
                if (kv) {
                    if (row >= T_P) orow = okv_s + (size_t)(row - T_P) * 256;
                    else { const int b = row >> 11, t = row & 2047; if (t >= 1920) orow = okv_p + (size_t)(b * 128 + t - 1920) * 256; }
                }
#pragma unroll
                for (int bj = 0; bj < 2; ++bj) {
                    const f32x4 v0 = acc[ai][bj][m][0] * rs, v1 = acc[ai][bj][m][1] * rs;
                    u32x4 w; w.x = cvt_pk_bf16(v0[0], v0[1]); w.y = cvt_pk_bf16(v0[2], v0[3]); w.z = cvt_pk_bf16(v1[0], v1[1]); w.w = cvt_pk_bf16(v1[2], v1[3]);
                    *(u32x4*)(rowp + bj * 128) = w;
                    if (kv && orow) { *(f32x4*)(orow + bj * 128 + ct) = v0; *(f32x4*)(orow + bj * 128 + ct + 4) = v1; }
                }
            }
    }
};

template <bool WRITE_BF>
struct EpiOutRes {
    static constexpr bool PERM = false;
    const float* xin_p; const float* xin_s; float* xo; bf16_t* xb; float* rowsq;
    __device__ __forceinline__ void operator()(const AccT& acc, const pg8::Unit& u, int wr, int wc, int fr, int fq) const {
        const int row0 = u.pm * 256 + wr * 64 + fr, col0 = u.pn * 256 + wc * 32 + 4 * fq;
        f32x4 r[3][4];
#define EOR_LOAD(S, IT) do { const int row_ = row0 + ((IT) >> 2) * 128 + ((IT) & 3) * 16; \
            const float* xr_ = (row_ < T_P) ? xin_p + (size_t)row_ * 1024 : xin_s + (size_t)(row_ - T_P) * 1024; \
            r[S][0] = *(const f32x4*)(xr_ + col0); r[S][1] = *(const f32x4*)(xr_ + col0 + 16); r[S][2] = *(const f32x4*)(xr_ + col0 + 128); r[S][3] = *(const f32x4*)(xr_ + col0 + 144); } while (0)
        EOR_LOAD(0, 0); EOR_LOAD(1, 1);
#pragma unroll
        for (int it = 0; it < 8; ++it) {
            if (it + 2 < 8) { if ((it + 2) % 3 == 0) EOR_LOAD(0, it + 2); else if ((it + 2) % 3 == 1) EOR_LOAD(1, it + 2); else EOR_LOAD(2, it + 2); }
            const int ai = it >> 2, m = it & 3;
            const int row = row0 + ai * 128 + m * 16;
            float ss = 0.f;
#pragma unroll
            for (int bj = 0; bj < 2; ++bj)
#pragma unroll
                for (int n = 0; n < 2; ++n) {
                    const int col = col0 + bj * 128 + n * 16;
                    const f32x4 v = acc[ai][bj][m][n] + r[it % 3][bj * 2 + n];
                    if (!WRITE_BF) *(f32x4*)(xo + (size_t)row * 1024 + col) = v;
                    if (WRITE_BF) { u32x2 w; w.x = cvt_pk_bf16(v[0], v[1]); w.y = cvt_pk_bf16(v[2], v[3]); *(u32x2*)(xb + (size_t)row * 1024 + col) = w; }
                    ss += v[0] * v[0] + v[1] * v[1] + v[2] * v[2] + v[3] * v[3];
                }
            ss += __shfl_xor(ss, 16); ss += __shfl_xor(ss, 32);
            if (fq == 0) atomicAdd(rowsq + row, ss);
        }
#undef EOR_LOAD
    }
};

struct EpiOutResB {
    static constexpr bool PERM = false;
    bf16_t* xb; float* rowsq;
    __device__ __forceinline__ void operator()(const AccT& acc, const pg8::Unit& u, int wr, int wc, int fr, int fq) const {
        const int row0 = u.pm * 256 + wr * 64 + fr, col0 = u.pn * 256 + wc * 32 + 4 * fq;
        u32x2 r[3][4];
#define EOB_LOAD(S, IT) do { const bf16_t* xr_ = xb + (size_t)(row0 + ((IT) >> 2) * 128 + ((IT) & 3) * 16) * 1024 + col0; \
            r[S][0] = *(const u32x2*)(xr_); r[S][1] = *(const u32x2*)(xr_ + 16); r[S][2] = *(const u32x2*)(xr_ + 128); r[S][3] = *(const u32x2*)(xr_ + 144); } while (0)
        EOB_LOAD(0, 0); EOB_LOAD(1, 1);
#pragma unroll
        for (int it = 0; it < 8; ++it) {
            if (it + 2 < 8) { if ((it + 2) % 3 == 0) EOB_LOAD(0, it + 2); else if ((it + 2) % 3 == 1) EOB_LOAD(1, it + 2); else EOB_LOAD(2, it + 2); }
            const int ai = it >> 2, m = it & 3;
            const int row = row0 + ai * 128 + m * 16;
            float ss = 0.f;
#pragma unroll
            for (int bj = 0; bj < 2; ++bj)
#pragma unroll
                for (int n = 0; n < 2; ++n) {
                    const int col = col0 + bj * 128 + n * 16;
                    const u32x2 rw = r[it % 3][bj * 2 + n];
                    f32x4 v = acc[ai][bj][m][n];
                    v[0] += bflo(rw.x); v[1] += bfhi(rw.x); v[2] += bflo(rw.y); v[3] += bfhi(rw.y);
                    u32x2 w; w.x = cvt_pk_bf16(v[0], v[1]); w.y = cvt_pk_bf16(v[2], v[3]);
                    *(u32x2*)(xb + (size_t)row * 1024 + col) = w;
                    ss += v[0] * v[0] + v[1] * v[1] + v[2] * v[2] + v[3] * v[3];
                }
            ss += __shfl_xor(ss, 16); ss += __shfl_xor(ss, 32);
            if (fq == 0) atomicAdd(rowsq + row, ss);
        }
#undef EOB_LOAD
    }
};

struct EpiInOdd {
    static constexpr bool PERM = true;
    bf16_t* z2; const float* rowsq;
    __device__ __forceinline__ void operator()(const AccT& acc, const pg8::Unit& u, int wr, int wc, int fr, int fq) const {
        const int row0 = u.pm * 256 + wr * 64 + fr, col0 = u.pn * 256 + wc * 32 + 8 * fq;
        float rsv[8];
#pragma unroll
        for (int it = 0; it < 8; ++it) rsv[it] = rowsq[row0 + (it >> 2) * 128 + (it & 3) * 16];
#pragma unroll
        for (int ai = 0; ai < 2; ++ai)
#pragma unroll
            for (int m = 0; m < 4; ++m) {
                const int row = row0 + ai * 128 + m * 16; const float rs = rsqrtf(rsv[ai * 4 + m] * (1.f / 1024.f) + EPS);
#pragma unroll
                for (int bj = 0; bj < 2; ++bj) {
                    const f32x4 v0 = acc[ai][bj][m][0] * rs, v1 = acc[ai][bj][m][1] * rs;
                    u32x4 w; w.x = cvt_pk_bf16(v0[0], v0[1]); w.y = cvt_pk_bf16(v0[2], v0[3]); w.z = cvt_pk_bf16(v1[0], v1[1]); w.w = cvt_pk_bf16(v1[2], v1[3]);
                    *(u32x4*)(z2 + (size_t)row * 3072 + col0 + bj * 128) = w;
                }
            }
    }
};

template <int MODE>
__device__ __forceinline__ void transpose_w(const float* __restrict__ src, int K, int Nsrc, bf16_t* __restrict__ dst, int Ndst, const float* __restrict__ gain, long gtid, long gsz) {
    const long total = (long)(K / 8) * Ndst;
#pragma unroll 4
    for (long it = gtid; it < total; it += gsz) {
        const int n = (int)(it % Ndst), k8 = (int)(it / Ndst);
        int sc = n;
        if (MODE == 1) { if (n < 3584) sc = n; else sc = n + 16; }
        u32x4 w = {0u, 0u, 0u, 0u};
        if (sc >= 0) {
            const float* s = src + (size_t)(k8 * 8) * Nsrc + sc;
            float v0 = s[0], v1 = s[(size_t)Nsrc], v2 = s[(size_t)2 * Nsrc], v3 = s[(size_t)3 * Nsrc], v4 = s[(size_t)4 * Nsrc], v5 = s[(size_t)5 * Nsrc], v6 = s[(size_t)6 * Nsrc], v7 = s[(size_t)7 * Nsrc];
            if (gain) { const f32x4 g0 = *(const f32x4*)(gain + k8 * 8), g1 = *(const f32x4*)(gain + k8 * 8 + 4); v0 *= g0[0]; v1 *= g0[1]; v2 *= g0[2]; v3 *= g0[3]; v4 *= g1[0]; v5 *= g1[1]; v6 *= g1[2]; v7 *= g1[3]; }
            w.x = cvt_pk_bf16(v0, v1); w.y = cvt_pk_bf16(v2, v3); w.z = cvt_pk_bf16(v4, v5); w.w = cvt_pk_bf16(v6, v7);
        }
        *(u32x4*)(dst + (size_t)n * K + k8 * 8) = w;
    }
}

__device__ __forceinline__ void phase0(const Params& p) {
    unsigned char* ws = p.ws;
    const long gtid = (long)blockIdx.x * NTHR + threadIdx.x, gsz = (long)gridDim.x * NTHR;
    transpose_w<1>(p.in[8], 1024, 5648, (bf16_t*)(ws + WS_WINE), 5632, p.in[7], gtid, gsz);
    for (long it = gtid; it < 128L * 512; it += gsz) {
        const int n = (int)(it & 511), k8 = (int)(it >> 9);
        float wl[16];
#pragma unroll
        for (int r = 0; r < 16; ++r) wl[r] = p.in[9][r * 512 + n];
        float v[8];
#pragma unroll
        for (int i = 0; i < 8; ++i) {
            const float* wr_ = p.in[8] + (size_t)(k8 * 8 + i) * 5648 + 3584;
            float a = 0.f;
#pragma unroll
            for (int r4 = 0; r4 < 4; ++r4) { const f32x4 x = *(const f32x4*)(wr_ + r4 * 4); a += x[0] * wl[r4 * 4] + x[1] * wl[r4 * 4 + 1] + x[2] * wl[r4 * 4 + 2] + x[3] * wl[r4 * 4 + 3]; }
            v[i] = a * p.in[7][k8 * 8 + i];
        }
        u32x4 w; w.x = cvt_pk_bf16(v[0], v[1]); w.y = cvt_pk_bf16(v[2], v[3]); w.z = cvt_pk_bf16(v[4], v[5]); w.w = cvt_pk_bf16(v[6], v[7]);
        *(u32x4*)((bf16_t*)(ws + WS_WINE) + (size_t)(5632 + n) * 1024 + k8 * 8) = w;
    }
    transpose_w<0>(p.in[13], 2048, 1024, (bf16_t*)(ws + WS_WOUTE), 1024, nullptr, gtid, gsz);
    transpose_w<0>(p.in[15], 1024, 3072, (bf16_t*)(ws + WS_WINO), 3072, p.in[14], gtid, gsz);
    transpose_w<0>(p.in[23], 1536, 1024, (bf16_t*)(ws + WS_WOUTO), 1024, nullptr, gtid, gsz);
    for (int nb = 0; nb < 8; ++nb) {
        transpose_w<0>(p.in[18] + nb * 192 * 192, 192, 192, (bf16_t*)(ws + WS_WA) + nb * 192 * 192, 192, nullptr, gtid, gsz);
        transpose_w<0>(p.in[20] + nb * 192 * 192, 192, 192, (bf16_t*)(ws + WS_WI) + nb * 192 * 192, 192, nullptr, gtid, gsz);
    }
    { float* z = (float*)(ws + WS_RSQ1); const long nz = (long)T * 2; for (long i = gtid; i < nz; i += gsz) z[i] = 0.f; }
    const int lane = threadIdx.x & 63; const int gw = (int)(gtid >> 6), nw = (int)(gsz >> 6);
    bf16_t* xb = (bf16_t*)(ws + WS_XB); float* rstd = (float*)(ws + WS_RSTD0);
#pragma unroll 4
    for (int row = gw; row < T; row += nw) {
        const float* xr = (row < T_P) ? p.in[0] + (size_t)row * 1024 : p.in[1] + (size_t)(row - T_P) * 1024;
        float ss = 0.f;
#pragma unroll
        for (int i = 0; i < 4; ++i) {
            const f32x4 v = *(const f32x4*)(xr + i * 256 + lane * 4);
            ss += v[0] * v[0] + v[1] * v[1] + v[2] * v[2] + v[3] * v[3];
            u32x2 w; w.x = cvt_pk_bf16(v[0], v[1]); w.y = cvt_pk_bf16(v[2], v[3]);
            *(u32x2*)(xb + (size_t)row * 1024 + i * 256 + lane * 4) = w;
        }
#pragma unroll
        for (int o = 32; o >= 1; o >>= 1) ss += __shfl_xor(ss, o);
        if (lane == 0) rstd[row] = rsqrtf(ss * (1.f / 1024.f) + EPS);
    }
}

__device__ __forceinline__ void attn_item(const Params& p, LAS unsigned char* L, int item, bf16_t* Yd, int ldd) {
    unsigned char* ws = p.ws;
    const int tid = threadIdx.x, lane = tid & 63, w = tid >> 6, r16 = lane & 15, q4 = lane >> 4;
    LAS bf16_t* Ks = (LAS bf16_t*)L;
    LAS bf16_t* Vs = (LAS bf16_t*)(L + 192 * 72 * 2);
    const unsigned vbase = (unsigned)(size_t)L + 192u * 72u * 2u;
    const bf16_t* Qb = (const bf16_t*)(ws + WS_Q); const bf16_t* Kb = (const bf16_t*)(ws + WS_K); const bf16_t* Vb = (const bf16_t*)(ws + WS_V);
    const bf16_t* Yb = (const bf16_t*)(ws + WS_GATE);
    const bool smp = item >= 2048;
    int b, c, kh; size_t row0;
    if (!smp) { kh = item & 3; c = (item >> 2) & 31; b = item >> 7; row0 = (size_t)b * 2048 + c * 64; }
    else { const int i2 = item - 2048; kh = i2 & 3; b = i2 >> 2; c = 0; row0 = (size_t)T_P + b * 64; }
    const int g = w >> 1, i0 = (w & 1) * 32, h = kh * 4 + g;
    bf16x8 qf[2][2];
#pragma unroll
    for (int qt = 0; qt < 2; ++qt) {
#pragma unroll
        for (int ks = 0; ks < 2; ++ks) qf[qt][ks] = *(const bf16x8*)(Qb + (row0 + i0 + qt * 16 + r16) * 1024 + h * 64 + ks * 32 + q4 * 8);
    }
#pragma unroll
    for (int i = 0; i < 3; ++i) {
        const int idx = tid + i * 512, key = idx >> 3, dg = idx & 7;
        u32x4 kv = {0u, 0u, 0u, 0u}, vv = {0u, 0u, 0u, 0u};
        if (!smp) {
            const int pos = c * 64 - 128 + key;
            if (pos >= 0) { const size_t r = (size_t)b * 2048 + pos; kv = *(const u32x4*)(Kb + r * 256 + kh * 64 + dg * 8); vv = *(const u32x4*)(Vb + r * 256 + kh * 64 + dg * 8); }
        } else {
            if (key < 128) {
                const size_t o = ((size_t)(b * 128 + key) * 4 + kh) * 64 + dg * 8;
                const f32x4 k0 = *(const f32x4*)(p.in[2] + o), k1 = *(const f32x4*)(p.in[2] + o + 4), v0 = *(const f32x4*)(p.in[3] + o), v1 = *(const f32x4*)(p.in[3] + o + 4);
                kv.x = cvt_pk_bf16(k0[0], k0[1]); kv.y = cvt_pk_bf16(k0[2], k0[3]); kv.z = cvt_pk_bf16(k1[0], k1[1]); kv.w = cvt_pk_bf16(k1[2], k1[3]);
                vv.x = cvt_pk_bf16(v0[0], v0[1]); vv.y = cvt_pk_bf16(v0[2], v0[3]); vv.z = cvt_pk_bf16(v1[0], v1[1]); vv.w = cvt_pk_bf16(v1[2], v1[3]);
            } else { const size_t r = (size_t)T_P + b * 64 + key - 128; kv = *(const u32x4*)(Kb + r * 256 + kh * 64 + dg * 8); vv = *(const u32x4*)(Vb + r * 256 + kh * 64 + dg * 8); }
        }
        *(LAS u32x4*)(Ks + key * 72 + dg * 8) = kv;
        *(LAS u32x4*)(Vs + key * 72 + dg * 8) = vv;
    }
    __syncthreads();
    const float slope = exp2f(-0.5f * (float)(h + 1));
    const float sink = p.in[11][h];
    const unsigned va = vbase + (unsigned)(((q4 * 4 + (r16 >> 2)) * 72 + 4 * (r16 & 3)) * 2);
#pragma unroll 1
    for (int qt = 0; qt < 2; ++qt) {
        const int i = i0 + qt * 16 + r16;
        const bf16x8 qa = qt ? qf[1][0] : qf[0][0], qb = qt ? qf[1][1] : qf[0][1];
        u32x2 gv[4];
#pragma unroll
        for (int dt = 0; dt < 4; ++dt) gv[dt] = *(const u32x2*)(Yb + (row0 + i) * 2048 + h * 64 + dt * 16 + q4 * 4);
        f32x4 sacc[12];
#pragma unroll
        for (int kt = 0; kt < 12; ++kt) {
            const bf16x8 kf0 = *(const LAS bf16x8*)(Ks + (kt * 16 + r16) * 72 + q4 * 8), kf1 = *(const LAS bf16x8*)(Ks + (kt * 16 + r16) * 72 + 32 + q4 * 8);
            f32x4 a = {0.f, 0.f, 0.f, 0.f}; a = MFMA16(kf0, qa, a); a = MFMA16(kf1, qb, a); sacc[kt] = a;
        }
        float m = -3e38f;
#pragma unroll
        for (int kt = 0; kt < 12; ++kt)
#pragma unroll
            for (int jj = 0; jj < 4; ++jj) {
                const int j = kt * 16 + q4 * 4 + jj;
                float sv = sacc[kt][jj] - slope * fabsf((float)(128 + i - j));
                if (!smp && (c * 64 - 128 + j) < 0) sv = -1e30f;
                sacc[kt][jj] = sv; m = fmaxf(m, sv);
            }
        m = fmaxf(m, __shfl_xor(m, 16)); m = fmaxf(m, __shfl_xor(m, 32)); m = fmaxf(m, sink);
        float l = 0.f;
#pragma unroll
        for (int kt = 0; kt < 12; ++kt)
#pragma unroll
            for (int jj = 0; jj < 4; ++jj) { const float pr = __expf(sacc[kt][jj] - m); sacc[kt][jj] = pr; l += pr; }
        l += __shfl_xor(l, 16); l += __shfl_xor(l, 32); l += __expf(sink - m);
        const float inv = 1.f / l;
        f32x4 oacc[4];
#pragma unroll
        for (int dt = 0; dt < 4; ++dt) oacc[dt] = (f32x4){0.f, 0.f, 0.f, 0.f};
#pragma unroll
        for (int kb = 0; kb < 6; ++kb) {
            const bf16x8 pf = pack8(sacc[2 * kb], sacc[2 * kb + 1]);
            bf16x4 l0, h0, l1, h1, l2, h2, l3, h3;
            const unsigned vk = va + (unsigned)(kb * 32 * 144);
            asm volatile("ds_read_b64_tr_b16 %0, %8\n\tds_read_b64_tr_b16 %1, %8 offset:2304\n\t"
                         "ds_read_b64_tr_b16 %2, %8 offset:32\n\tds_read_b64_tr_b16 %3, %8 offset:2336\n\t"
                         "ds_read_b64_tr_b16 %4, %8 offset:64\n\tds_read_b64_tr_b16 %5, %8 offset:2368\n\t"
                         "ds_read_b64_tr_b16 %6, %8 offset:96\n\tds_read_b64_tr_b16 %7, %8 offset:2400\n\t"
                         "s_waitcnt lgkmcnt(0)"
                         : "=&v"(l0), "=&v"(h0), "=&v"(l1), "=&v"(h1), "=&v"(l2), "=&v"(h2), "=&v"(l3), "=&v"(h3) : "v"(vk) : "memory");
            oacc[0] = MFMA16(cat4(l0, h0), pf, oacc[0]); oacc[1] = MFMA16(cat4(l1, h1), pf, oacc[1]);
            oacc[2] = MFMA16(cat4(l2, h2), pf, oacc[2]); oacc[3] = MFMA16(cat4(l3, h3), pf, oacc[3]);
        }
#pragma unroll
        for (int dt = 0; dt < 4; ++dt) {
            const u32x2 gq = gv[dt];
            const f32x4 o = oacc[dt] * inv;
            u32x2 wv; wv.x = cvt_pk_bf16(o[0] * siluf(bflo(gq.x)), o[1] * siluf(bfhi(gq.x))); wv.y = cvt_pk_bf16(o[2] * siluf(bflo(gq.y)), o[3] * siluf(bfhi(gq.y)));
            *(u32x2*)(Yd + (row0 + i) * ldd + h * 64 + dt * 16 + q4 * 4) = wv;
        }
    }
    __syncthreads();
}

constexpr size_t WS_ET = WS_XB + 9437184;
constexpr size_t WS_AB = WS_XB + 16777216;
static_assert(WS_AB + (size_t)T * 256 * 2 <= WS_RSTD0, "XB scratch overflow");

__device__ __forceinline__ void gla_prep_item(const Params& p, LAS unsigned char* L, int item) {
    unsigned char* ws = p.ws;
    const int tid = threadIdx.x, lane = tid & 63, w = tid >> 6, r16 = lane & 15, q4 = lane >> 4;
    LAS bf16_t* QG = (LAS bf16_t*)L;
    LAS bf16_t* KG = (LAS bf16_t*)(L + 17408);
    LAS bf16_t* Gs = (LAS bf16_t*)(L + 34816);
    LAS float* Gf = (LAS float*)(L + 52224);
    LAS float* GT = (LAS float*)(L + 84992);
    int b, h; unsigned row0;
    if (item < 2048) { h = item & 3; const int c = (item >> 2) & 31; b = item >> 7; row0 = (unsigned)b * 2048 + c * 64; }
    else { const int i2 = item - 2048; h = i2 & 3; b = i2 >> 2; row0 = (unsigned)T_P + b * 64; }
    bf16_t* BQ = (bf16_t*)(ws + WS_BQ); bf16_t* BKb = (bf16_t*)(ws + WS_BK); const bf16_t* GB = (const bf16_t*)(ws + WS_BLR);
    float* ET = (float*)(ws + WS_ET); bf16_t* AB = (bf16_t*)(ws + WS_AB);
    const int c = tid & 127, tg = tid >> 7;
    const int pt0 = tid >> 4, pt1 = (tid + 512) >> 4, poc = tid & 15;
    const unsigned o0 = (row0 + pt0) * 512u + h * 128 + poc * 8, o1 = (row0 + pt1) * 512u + h * 128 + poc * 8;
    const u32x4 pg0 = *(const u32x4*)(GB + o0), pg1 = *(const u32x4*)(GB + o1);
    const u32x4 pq0 = *(const u32x4*)(BQ + o0), pq1 = *(const u32x4*)(BQ + o1), pk0 = *(const u32x4*)(BKb + o0), pk1 = *(const u32x4*)(BKb + o1);
    *(LAS u32x4*)(Gs + pt0 * 136 + poc * 8) = pg0; *(LAS u32x4*)(Gs + pt1 * 136 + poc * 8) = pg1;
    lds_barrier();
    {
        float cs = 0.f;
#pragma unroll
        for (int tt = 0; tt < 16; ++tt) { cs += bf2f(Gs[(tg * 16 + tt) * 136 + c]); Gf[(tg * 16 + tt) * 128 + c] = cs; }
        GT[tg * 128 + c] = cs;
    }
    lds_barrier();
#pragma unroll
    for (int i = 0; i < 2; ++i) {
        const int t = i ? pt1 : pt0; const int tgp = t >> 4;
        const u32x4 qw = i ? pq1 : pq0, kw = i ? pk1 : pk0;
        float G[8], tot[8];
        { const f32x4 a0 = *(const LAS f32x4*)(Gf + t * 128 + poc * 8), a1 = *(const LAS f32x4*)(Gf + t * 128 + poc * 8 + 4);
          G[0] = a0[0]; G[1] = a0[1]; G[2] = a0[2]; G[3] = a0[3]; G[4] = a1[0]; G[5] = a1[1]; G[6] = a1[2]; G[7] = a1[3]; }
#pragma unroll
        for (int j = 0; j < 8; ++j) tot[j] = 0.f;
#pragma unroll
        for (int g2 = 0; g2 < 4; ++g2) {
            const f32x4 a0 = *(const LAS f32x4*)(GT + g2 * 128 + poc * 8), a1 = *(const LAS f32x4*)(GT + g2 * 128 + poc * 8 + 4);
            const float sel = (g2 < tgp) ? 1.f : 0.f;
            G[0] += sel * a0[0]; G[1] += sel * a0[1]; G[2] += sel * a0[2]; G[3] += sel * a0[3]; G[4] += sel * a1[0]; G[5] += sel * a1[1]; G[6] += sel * a1[2]; G[7] += sel * a1[3];
            tot[0] += a0[0]; tot[1] += a0[1]; tot[2] += a0[2]; tot[3] += a0[3]; tot[4] += a1[0]; tot[5] += a1[1]; tot[6] += a1[2]; tot[7] += a1[3];
        }
        if (i == 0 && tid < 16) {
            float* ep = ET + (size_t)(row0 >> 6) * 512 + h * 128 + poc * 8;
            *(f32x4*)ep = (f32x4){__expf(tot[0]), __expf(tot[1]), __expf(tot[2]), __expf(tot[3])};
            *(f32x4*)(ep + 4) = (f32x4){__expf(tot[4]), __expf(tot[5]), __expf(tot[6]), __expf(tot[7])};
        }
        float qv[8], kv[8];
        unpack8(qw, qv); unpack8(kw, kv);
#pragma unroll
        for (int j = 0; j < 8; ++j) { const float eg = __expf(G[j]); qv[j] *= eg; kv[j] *= rcpf_(eg); }
        u32x4 qo, ko;
        qo.x = cvt_pk_bf16(qv[0], qv[1]); qo.y = cvt_pk_bf16(qv[2], qv[3]); qo.z = cvt_pk_bf16(qv[4], qv[5]); qo.w = cvt_pk_bf16(qv[6], qv[7]);
        ko.x = cvt_pk_bf16(kv[0], kv[1]); ko.y = cvt_pk_bf16(kv[2], kv[3]); ko.z = cvt_pk_bf16(kv[4], kv[5]); ko.w = cvt_pk_bf16(kv[6], kv[7]);
        *(LAS u32x4*)(QG + t * 136 + poc * 8) = qo; *(LAS u32x4*)(KG + t * 136 + poc * 8) = ko;
        *(u32x4*)(BQ + (i ? o1 : o0)) = qo; *(u32x4*)(BKb + (i ? o1 : o0)) = ko;
    }
    lds_barrier();
    {
        const int it = w >> 1, jt0 = (w & 1) * 2;
        f32x4 at[2];
        at[0] = (f32x4){0.f, 0.f, 0.f, 0.f}; at[1] = (f32x4){0.f, 0.f, 0.f, 0.f};
#pragma unroll
        for (int ks = 0; ks < 4; ++ks) {
            const bf16x8 qf = *(const LAS bf16x8*)(QG + (it * 16 + r16) * 136 + ks * 32 + q4 * 8);
#pragma unroll
            for (int t2 = 0; t2 < 2; ++t2) {
                const bf16x8 kf = *(const LAS bf16x8*)(KG + ((jt0 + t2) * 16 + r16) * 136 + ks * 32 + q4 * 8);
                at[t2] = MFMA16(kf, qf, at[t2]);
            }
        }
        const int i = it * 16 + r16;
#pragma unroll
        for (int t2 = 0; t2 < 2; ++t2) {
            f32x4 v = at[t2];
#pragma unroll
            for (int jj = 0; jj < 4; ++jj) { const int j = (jt0 + t2) * 16 + q4 * 4 + jj; if (j > i) v[jj] = 0.f; }
            u32x2 wv; wv.x = cvt_pk_bf16(v[0], v[1]); wv.y = cvt_pk_bf16(v[2], v[3]);
            *(u32x2*)(AB + (size_t)(row0 + i) * 256 + h * 64 + (jt0 + t2) * 16 + q4 * 4) = wv;
        }
    }
    lds_barrier();
}

__device__ __forceinline__ void gla_scan_item(const Params& p, LAS unsigned char* L, int item, bool dummy) {
    unsigned char* ws = p.ws;
    const int tid = threadIdx.x, lane = tid & 63, w = tid >> 6, r16 = lane & 15, q4 = lane >> 4;
    LAS bf16_t* QG = (LAS bf16_t*)L;
    LAS bf16_t* KG = (LAS bf16_t*)(L + 17408);
    LAS bf16_t* Vs = (LAS bf16_t*)(L + 34816);
    LAS bf16_t* As = (LAS bf16_t*)(L + 44032);
    LAS float* GL = (LAS float*)(L + 53248);
    const unsigned lbase = (unsigned)(size_t)L;
    const bool smp = item >= 256;
    const int i2 = smp ? item - 256 : item;
    const int b = i2 >> 4, h = (i2 >> 2) & 3, sl = i2 & 3, e0 = sl * 64;
    const int nch = smp ? 1 : 32;
    const unsigned rbase = smp ? (unsigned)T_P + b * 64 : (unsigned)b * 2048;
    const bf16_t* BQ = (const bf16_t*)(ws + WS_BQ); const bf16_t* BKb = (const bf16_t*)(ws + WS_BK); bf16_t* BV = (bf16_t*)(ws + WS_BV);
    const float* ET = (const float*)(ws + WS_ET); const bf16_t* AB = (const bf16_t*)(ws + WS_AB); float* BOSQP = dummy ? p.out + 20000000 : (float*)(ws + WS_XB);
    bf16_t* BVo = dummy ? (bf16_t*)p.out : BV;
    const int pt0 = tid >> 4, pt1 = (tid + 512) >> 4, poc = tid & 15;
    const int vt = tid >> 3, veo = tid & 7;
    const int et = w & 3, ip = w >> 2;
    f32x4 Sacc[8];
#pragma unroll
    for (int d8 = 0; d8 < 8; ++d8) {
        if (smp) {
#pragma unroll
            for (int jj = 0; jj < 4; ++jj) Sacc[d8][jj] = p.in[4][((size_t)(b * 4 + h) * 128 + d8 * 16 + q4 * 4 + jj) * 256 + e0 + et * 16 + r16];
        } else Sacc[d8] = (f32x4){0.f, 0.f, 0.f, 0.f};
    }
    const int tq_ = r16 >> 2, tp_ = r16 & 3;
    const unsigned v4a = lbase + 34816u + (unsigned)(((q4 * 8 + tq_) * 72 + et * 16 + 4 * tp_) * 2);
    const unsigned k4a = lbase + 17408u + (unsigned)(((q4 * 8 + tq_) * 136 + 4 * tp_) * 2);
    struct Pre { u32x4 q0, q1, k0, k1, a, v; f32x4 e; };
    Pre PA, PB;
    PA.e = (f32x4){0.f, 0.f, 0.f, 0.f}; PB.e = (f32x4){0.f, 0.f, 0.f, 0.f};
#define GLA_PREFETCH(P, R) do { \
        const unsigned o0_ = ((R) + pt0) * 512u + h * 128 + poc * 8, o1_ = ((R) + pt1) * 512u + h * 128 + poc * 8; \
        P.q0 = *(const u32x4*)(BQ + o0_); P.q1 = *(const u32x4*)(BQ + o1_); P.k0 = *(const u32x4*)(BKb + o0_); P.k1 = *(const u32x4*)(BKb + o1_); \
        P.a = *(const u32x4*)(AB + ((R) + vt) * 256u + h * 64 + veo * 8); \
        P.v = *(const u32x4*)(BV + ((R) + vt) * 1024u + h * 256 + e0 + veo * 8); \
        if (tid < 32) P.e = *(const f32x4*)(ET + ((R) >> 6) * 512u + h * 128 + tid * 4); } while (0)
    GLA_PREFETCH(PA, rbase);
    if (nch > 1) GLA_PREFETCH(PB, rbase + 64);
    f32x4 po0 = {0.f, 0.f, 0.f, 0.f}, po1 = {0.f, 0.f, 0.f, 0.f}; unsigned prow = 0; bool pend = false;
#define GLA_STORE_OUT() do { \
            _Pragma("unroll") for (int x2 = 0; x2 < 2; ++x2) { \
                const unsigned row = prow + (ip * 2 + x2) * 16 + r16; \
                const f32x4 o = x2 ? po1 : po0; \
                u32x2 wv; wv.x = cvt_pk_bf16(o[0], o[1]); wv.y = cvt_pk_bf16(o[2], o[3]); \
                *(u32x2*)(BVo + row * 1024u + h * 256 + e0 + et * 16 + q4 * 4) = wv; \
                float ss = o[0] * o[0] + o[1] * o[1] + o[2] * o[2] + o[3] * o[3]; \
                ss += __shfl_xor(ss, 16); ss += __shfl_xor(ss, 32); \
                if (q4 == 0) BOSQP[row * 64u + h * 16 + sl * 4 + et] = ss; \
            } } while (0)
#define GLA_CHUNK(P, CI) do { \
        const unsigned r0 = rbase + (unsigned)(CI) * 64; \
        *(LAS u32x4*)(QG + pt0 * 136 + poc * 8) = P.q0; *(LAS u32x4*)(QG + pt1 * 136 + poc * 8) = P.q1; \
        *(LAS u32x4*)(KG + pt0 * 136 + poc * 8) = P.k0; *(LAS u32x4*)(KG + pt1 * 136 + poc * 8) = P.k1; \
        *(LAS u32x4*)(As + vt * 72 + veo * 8) = P.a; *(LAS u32x4*)(Vs + vt * 72 + veo * 8) = P.v; \
        if (tid < 32) *(LAS f32x4*)(GL + tid * 4) = P.e; \
        lds_barrier(); \
        if (pend) GLA_STORE_OUT(); \
        if ((CI) + 2 < nch) GLA_PREFETCH(P, r0 + 128); \
        bf16x8 vf[2]; \
        { bf16x4 a0, a1, b0, b1; \
          asm volatile("ds_read_b64_tr_b16 %0, %4\n\tds_read_b64_tr_b16 %1, %4 offset:576\n\tds_read_b64_tr_b16 %2, %4 offset:4608\n\tds_read_b64_tr_b16 %3, %4 offset:5184\n\ts_waitcnt lgkmcnt(0)" \
                       : "=&v"(a0), "=&v"(a1), "=&v"(b0), "=&v"(b1) : "v"(v4a) : "memory"); \
          vf[0] = cat4(a0, a1); vf[1] = cat4(b0, b1); } \
        f32x4 ot[2]; \
        ot[0] = (f32x4){0.f, 0.f, 0.f, 0.f}; ot[1] = (f32x4){0.f, 0.f, 0.f, 0.f}; \
        _Pragma("unroll") for (int x2 = 0; x2 < 2; ++x2) \
            _Pragma("unroll") for (int jb = 0; jb < 2; ++jb) { \
                const bf16x8 af = *(const LAS bf16x8*)(As + ((ip * 2 + x2) * 16 + r16) * 72 + jb * 32 + q4 * 8); \
                ot[x2] = MFMA16(vf[jb], af, ot[x2]); } \
        _Pragma("unroll") for (int db = 0; db < 4; ++db) { \
            const bf16x8 sf = pack8(Sacc[2 * db], Sacc[2 * db + 1]); \
            _Pragma("unroll") for (int x2 = 0; x2 < 2; ++x2) { \
                const LAS bf16_t* qp = QG + ((ip * 2 + x2) * 16 + r16) * 136 + db * 32 + q4 * 4; \
                const bf16x8 qv = cat4(*(const LAS bf16x4*)qp, *(const LAS bf16x4*)(qp + 16)); \
                ot[x2] = MFMA16(sf, qv, ot[x2]); } } \
        po0 = ot[0]; po1 = ot[1]; prow = r0; pend = true; \
        _Pragma("unroll") for (int jb = 0; jb < 2; ++jb) { \
            bf16x4 kl[8], kh[8]; \
            const unsigned ka = k4a + (unsigned)(jb * 32 * 272); \
            asm volatile("ds_read_b64_tr_b16 %0, %16 offset:0\n\t" "ds_read_b64_tr_b16 %1, %16 offset:1088\n\t" "ds_read_b64_tr_b16 %2, %16 offset:32\n\t" "ds_read_b64_tr_b16 %3, %16 offset:1120\n\t" "ds_read_b64_tr_b16 %4, %16 offset:64\n\t" "ds_read_b64_tr_b16 %5, %16 offset:1152\n\t" "ds_read_b64_tr_b16 %6, %16 offset:96\n\t" "ds_read_b64_tr_b16 %7, %16 offset:1184\n\t" "ds_read_b64_tr_b16 %8, %16 offset:128\n\t" "ds_read_b64_tr_b16 %9, %16 offset:1216\n\t" "ds_read_b64_tr_b16 %10, %16 offset:160\n\t" "ds_read_b64_tr_b16 %11, %16 offset:1248\n\t" "ds_read_b64_tr_b16 %12, %16 offset:192\n\t" "ds_read_b64_tr_b16 %13, %16 offset:1280\n\t" "ds_read_b64_tr_b16 %14, %16 offset:224\n\t" "ds_read_b64_tr_b16 %15, %16 offset:1312\n\t" "s_waitcnt lgkmcnt(0)" \
                         : "=&v"(kl[0]), "=&v"(kh[0]), "=&v"(kl[1]), "=&v"(kh[1]), "=&v"(kl[2]), "=&v"(kh[2]), "=&v"(kl[3]), "=&v"(kh[3]), "=&v"(kl[4]), "=&v"(kh[4]), "=&v"(kl[5]), "=&v"(kh[5]), "=&v"(kl[6]), "=&v"(kh[6]), "=&v"(kl[7]), "=&v"(kh[7]) : "v"(ka) : "memory"); \
            _Pragma("unroll") for (int d8 = 0; d8 < 8; ++d8) Sacc[d8] = MFMA16(cat4(kl[d8], kh[d8]), vf[jb], Sacc[d8]); } \
        _Pragma("unroll") for (int d8 = 0; d8 < 8; ++d8) { \
            const f32x4 dec = *(const LAS f32x4*)(GL + d8 * 16 + q4 * 4); \
            Sacc[d8] = Sacc[d8] * dec; } \
        lds_barrier(); \
    } while (0)
    for (int ci = 0; ci < nch; ci += 2) {
        GLA_CHUNK(PA, ci);
        if (ci + 1 < nch) GLA_CHUNK(PB, ci + 1);
    }
    if (pend) GLA_STORE_OUT();
#undef GLA_STORE_OUT
#undef GLA_PREFETCH
#undef GLA_CHUNK
    if (ip == 0 && !dummy) {
        float* og = p.out + (smp ? O_GS : O_GP);
#pragma unroll
        for (int d8 = 0; d8 < 8; ++d8)
#pragma unroll
            for (int jj = 0; jj < 4; ++jj) og[((size_t)(b * 4 + h) * 128 + d8 * 16 + q4 * 4 + jj) * 256 + e0 + et * 16 + r16] = Sacc[d8][jj];
    }
}

__device__ __forceinline__ void phase2a(const Params& p, LAS unsigned char* L) {
#ifndef NO_PREP
    for (int it = blockIdx.x; it < 2176; it += gridDim.x) gla_prep_item(p, L, it);
#endif
#ifndef NO_ATTN
    for (int it = blockIdx.x; it < 2176; it += gridDim.x) attn_item(p, L, it, (bf16_t*)(p.ws + WS_GATE), 2048);
#endif
}
__device__ __forceinline__ void phase2b(const Params& p, LAS unsigned char* L) {
#ifndef NO_SCAN
#ifdef PROBE_SCAN2
    for (int it = blockIdx.x; it < 768; it += gridDim.x) gla_scan_item(p, L, it, true);
#endif
    if (gridDim.x == 256) {
        const int xcd = blockIdx.x & 7, loc = blockIdx.x >> 3;
        const int base = (xcd * 8 + (loc >> 2)) * 4 + (loc & 3);
        gla_scan_item(p, L, base, false); gla_scan_item(p, L, 256 + base, false); gla_scan_item(p, L, 512 + base, false);
    } else {
        for (int it = blockIdx.x; it < 768; it += gridDim.x) gla_scan_item(p, L, it, false);
    }
#endif
}

__device__ __forceinline__ void phase3(const Params& p) {
    unsigned char* ws = p.ws;
    const bf16_t* BV = (const bf16_t*)(ws + WS_BV); bf16_t* Yb = (bf16_t*)(ws + WS_GATE); const float* BOSQP = (const float*)(ws + WS_XB);
    const float* gg = p.in[12];
    const long gtid = (long)blockIdx.x * NTHR + threadIdx.x, gsz = (long)gridDim.x * NTHR;
    const long total = (long)T * 128;
    for (long it = gtid; it < total; it += gsz) {
        const long row = it >> 7; const int c8 = (int)(it & 127) * 8, h = c8 >> 8;
        float sq;
        { const f32x4 s0 = *(const f32x4*)(BOSQP + row * 64 + h * 16), s1 = *(const f32x4*)(BOSQP + row * 64 + h * 16 + 4), s2 = *(const f32x4*)(BOSQP + row * 64 + h * 16 + 8), s3 = *(const f32x4*)(BOSQP + row * 64 + h * 16 + 12);
          sq = ((s0[0] + s0[1]) + (s0[2] + s0[3])) + ((s1[0] + s1[1]) + (s1[2] + s1[3])) + ((s2[0] + s2[1]) + (s2[2] + s2[3])) + ((s3[0] + s3[1]) + (s3[2] + s3[3])); }
        const float rs = rsqrtf(sq * (1.f / 256.f) + EPS);
        const u32x4 bo = *(const u32x4*)(BV + row * 1024 + c8);
        const u32x4 gt = *(const u32x4*)(Yb + row * 2048 + 1024 + c8);
        const f32x4 g0 = *(const f32x4*)(gg + (c8 & 255)), g1 = *(const f32x4*)(gg + (c8 & 255) + 4);
        u32x4 o;
        o.x = cvt_pk_bf16(bflo(bo.x) * rs * g0[0] * siluf(bflo(gt.x)), bfhi(bo.x) * rs * g0[1] * siluf(bfhi(gt.x)));
        o.y = cvt_pk_bf16(bflo(bo.y) * rs * g0[2] * siluf(bflo(gt.y)), bfhi(bo.y) * rs * g0[3] * siluf(bfhi(gt.y)));
        o.z = cvt_pk_bf16(bflo(bo.z) * rs * g1[0] * siluf(bflo(gt.z)), bfhi(bo.z) * rs * g1[1] * siluf(bfhi(gt.z)));
        o.w = cvt_pk_bf16(bflo(bo.w) * rs * g1[2] * siluf(bflo(gt.w)), bfhi(bo.w) * rs * g1[3] * siluf(bfhi(gt.w)));
        *(u32x4*)(Yb + row * 2048 + 1024 + c8) = o;
    }
}

__device__ __forceinline__ void lru_item(const Params& p, LAS unsigned char* L, int item) {
    unsigned char* ws = p.ws;
    const int tid = threadIdx.x, lane = tid & 63, w = tid >> 6, r16 = lane & 15, q4 = lane >> 4;
    LAS bf16_t* Wl = (LAS bf16_t*)L;
    LAS bf16_t* U = (LAS bf16_t*)(L + 76800);
    LAS float* Aa = (LAS float*)(L + 102400);
    LAS float* Bb = (LAS float*)(L + 126976);
    LAS float* SP = (LAS float*)(L + 151552);
    LAS float* SH = (LAS float*)(L + 153088);
    LAS float* HC = (LAS float*)(L + 154624);
    LAS float* CW = (LAS float*)(L + 155392);
    const bool smp = item >= 256;
    const int i2 = smp ? item - 256 : item;
    const int b = i2 >> 4, nb = (i2 >> 1) & 7, hf = i2 & 1;
    const int nch = smp ? 1 : 32;
    const unsigned rbase = smp ? (unsigned)T_P + b * 64 : (unsigned)b * 2048;
    const bf16_t* Z2 = (const bf16_t*)(ws + WS_Z2); bf16_t* Y2 = (bf16_t*)(ws + WS_Y2);
    const bf16_t* WA = (const bf16_t*)(ws + WS_WA) + nb * 192 * 192; const bf16_t* WI = (const bf16_t*)(ws + WS_WI) + nb * 192 * 192;
    for (int idx = tid; idx < 192 * 24; idx += NTHR) {
        const int r = idx / 24, g8 = idx % 24;
        const bf16_t* src = (r < 96) ? WA + (size_t)(hf * 96 + r) * 192 + g8 * 8 : WI + (size_t)(hf * 96 + r - 96) * 192 + g8 * 8;
        *(LAS u32x4*)(Wl + r * 200 + g8 * 8) = *(const u32x4*)src;
    }
    const bool cthr = tid < 384;
    const int cgp = tid % 24, tq = (tid / 24) & 15;
    const int chc = nb * 192 + cgp * 8;
    for (int idx = tid; idx < 5 * 192; idx += NTHR) { const int j = idx / 192, cc = idx % 192; CW[idx] = (j < 4) ? p.in[16][j * 1536 + nb * 192 + cc] : p.in[17][nb * 192 + cc]; }
    const int mt = w & 3, pg = w >> 2;
    float bra[3], bri[3], sp[3];
#pragma unroll
    for (int cp = 0; cp < 3; ++cp) {
        const int ch = nb * 192 + hf * 96 + (pg * 3 + cp) * 16 + r16;
        bra[cp] = p.in[19][ch]; bri[cp] = p.in[21][ch];
        const float lam = p.in[22][ch];
        sp[cp] = 8.f * (fmaxf(-lam, 0.f) + log1pf(__expf(-fabsf(lam))));
    }
    if (tid < 96) HC[tid] = smp ? p.in[6][b * 1536 + nb * 192 + hf * 96 + tid] : 0.f;
    const int sch0 = tid % 96, sseg0 = (tid / 96) & 3;
    const int ot0 = tid / 12, og0 = tid % 12, ot1 = (tid + 512) / 12, og1 = (tid + 512) % 12;
    const bool o1 = tid < 256;
    const int och0 = nb * 192 + hf * 96 + og0 * 8, och1 = nb * 192 + hf * 96 + og1 * 8;
    lds_barrier();
    u32x4 xr[7]; u32x4 pg0, pg1 = {0u, 0u, 0u, 0u};
#pragma unroll
    for (int r = 0; r < 7; ++r) {
        xr[r] = (u32x4){0u, 0u, 0u, 0u};
        const int pos = 4 * tq - 3 + r;
        if (cthr) {
            if (pos >= 0) xr[r] = *(const u32x4*)(Z2 + (unsigned)((rbase + pos) * 3072u + chc));
            else if (smp) {
                const float* hp = p.in[5] + ((size_t)b * 3 + (3 + pos)) * 1536 + chc;
                const f32x4 h0 = *(const f32x4*)hp, h1 = *(const f32x4*)(hp + 4);
                xr[r].x = cvt_pk_bf16(h0[0], h0[1]); xr[r].y = cvt_pk_bf16(h0[2], h0[3]); xr[r].z = cvt_pk_bf16(h1[0], h1[1]); xr[r].w = cvt_pk_bf16(h1[2], h1[3]);
            }
        }
    }
    pg0 = *(const u32x4*)(Z2 + (unsigned)((rbase + ot0) * 3072u + 1536 + och0));
    if (o1) pg1 = *(const u32x4*)(Z2 + (unsigned)((rbase + ot1) * 3072u + 1536 + och1));
    u32x4 so0 = {0u, 0u, 0u, 0u}, so1 = {0u, 0u, 0u, 0u}; unsigned sr = 0; bool spend = false;
    for (int ci = 0; ci < nch; ++ci) {
        const unsigned r0 = rbase + (unsigned)ci * 64;
        const bool more = (ci + 1 < nch);
        int sch = sch0, sseg = sseg0;
        asm volatile("" : "+v"(sch), "+v"(sseg));
        if (cthr) {
            float xv[7][8];
#pragma unroll
            for (int r = 0; r < 7; ++r) unpack8(xr[r], xv[r]);
            if (hf == 0 && !more && tq == 15) {
                float* oc = p.out + (smp ? O_CS : O_CP) + (size_t)b * 3 * 1536 + chc;
#pragma unroll
                for (int r = 0; r < 3; ++r) { *(f32x4*)(oc + r * 1536) = (f32x4){xv[4 + r][0], xv[4 + r][1], xv[4 + r][2], xv[4 + r][3]}; *(f32x4*)(oc + r * 1536 + 4) = (f32x4){xv[4 + r][4], xv[4 + r][5], xv[4 + r][6], xv[4 + r][7]}; }
            }
            float cw[5][8];
#pragma unroll
            for (int j = 0; j < 5; ++j) { const f32x4 c0 = *(const LAS f32x4*)(CW + j * 192 + cgp * 8), c1 = *(const LAS f32x4*)(CW + j * 192 + cgp * 8 + 4);
                cw[j][0] = c0[0]; cw[j][1] = c0[1]; cw[j][2] = c0[2]; cw[j][3] = c0[3]; cw[j][4] = c1[0]; cw[j][5] = c1[1]; cw[j][6] = c1[2]; cw[j][7] = c1[3]; }
#pragma unroll
            for (int tk = 0; tk < 4; ++tk) {
                float acc[8];
#pragma unroll
                for (int e = 0; e < 8; ++e) acc[e] = cw[4][e] + xv[tk][e] * cw[0][e] + xv[tk + 1][e] * cw[1][e] + xv[tk + 2][e] * cw[2][e] + xv[tk + 3][e] * cw[3][e];
                u32x4 uw; uw.x = cvt_pk_bf16(acc[0], acc[1]); uw.y = cvt_pk_bf16(acc[2], acc[3]); uw.z = cvt_pk_bf16(acc[4], acc[5]); uw.w = cvt_pk_bf16(acc[6], acc[7]);
                *(LAS u32x4*)(U + (4 * tq + tk) * 200 + cgp * 8) = uw;
            }
            if (more) {
#pragma unroll
                for (int r = 0; r < 7; ++r) xr[r] = *(const u32x4*)(Z2 + (unsigned)((r0 + 64 + 4 * tq - 3 + r) * 3072u + chc));
            }
        }
        lds_barrier();
        if (spend) { *(u32x4*)(Y2 + (unsigned)((sr + ot0) * 1536u + och0)) = so0; if (o1) *(u32x4*)(Y2 + (unsigned)((sr + ot1) * 1536u + och1)) = so1; }
        f32x4 ga[3], gi[3];
#pragma unroll
        for (int cp = 0; cp < 3; ++cp) { ga[cp] = (f32x4){0.f, 0.f, 0.f, 0.f}; gi[cp] = (f32x4){0.f, 0.f, 0.f, 0.f}; }
#pragma unroll 2
        for (int ks = 0; ks < 6; ++ks) {
            const bf16x8 uf = *(const LAS bf16x8*)(U + (mt * 16 + r16) * 200 + ks * 32 + q4 * 8);
#pragma unroll
            for (int cp = 0; cp < 3; ++cp) {
                const int ct = pg * 3 + cp;
                const bf16x8 wa = *(const LAS bf16x8*)(Wl + (ct * 16 + r16) * 200 + ks * 32 + q4 * 8), wi = *(const LAS bf16x8*)(Wl + (96 + ct * 16 + r16) * 200 + ks * 32 + q4 * 8);
                ga[cp] = MFMA16(uf, wa, ga[cp]); gi[cp] = MFMA16(uf, wi, gi[cp]);
            }
        }
#pragma unroll
        for (int cp = 0; cp < 3; ++cp) {
            const int cl = (pg * 3 + cp) * 16 + r16;
#pragma unroll
            for (int jj = 0; jj < 4; ++jj) {
                const int t = mt * 16 + q4 * 4 + jj;
                const float rg = sigmf(ga[cp][jj] + bra[cp]), ig = sigmf(gi[cp][jj] + bri[cp]);
                const float z = rg * sp[cp];
                const float a = __expf(-z);
                const float z2 = z + z;
                const float om = (z2 < 0.05f) ? z2 * (1.f - z2 * (0.5f - z2 * (0.16666667f - z2 * 0.041666668f))) : 1.f - a * a;
                const float uu = bf2f(U[t * 200 + hf * 96 + cl]);
                Aa[t * 96 + cl] = a; Bb[t * 96 + cl] = __builtin_amdgcn_sqrtf(om) * ig * uu;
            }
        }
        lds_barrier();
        if (cthr) {
            float P = 1.f, H = 0.f;
#pragma unroll
            for (int t = 0; t < 16; ++t) { const float a = Aa[(sseg * 16 + t) * 96 + sch]; H = a * H + Bb[(sseg * 16 + t) * 96 + sch]; P *= a; }
            SP[sseg * 96 + sch] = P; SH[sseg * 96 + sch] = H;
        }
        lds_barrier();
        if (cthr) {
            float hh = HC[(ci & 1) * 96 + sch];
#pragma unroll
            for (int sg = 0; sg < 3; ++sg) if (sg < sseg) hh = SP[sg * 96 + sch] * hh + SH[sg * 96 + sch];
#pragma unroll
            for (int t = 0; t < 16; ++t) { hh = Aa[(sseg * 16 + t) * 96 + sch] * hh + Bb[(sseg * 16 + t) * 96 + sch]; Bb[(sseg * 16 + t) * 96 + sch] = hh; }
            if (sseg == 3) HC[((ci + 1) & 1) * 96 + sch] = hh;
        }
        lds_barrier();
        {
            const f32x4 h0 = *(const LAS f32x4*)(Bb + ot0 * 96 + og0 * 8), h1 = *(const LAS f32x4*)(Bb + ot0 * 96 + og0 * 8 + 4);
            u32x4 o;
            o.x = cvt_pk_bf16(h0[0] * siluf(bflo(pg0.x)), h0[1] * siluf(bfhi(pg0.x)));
            o.y = cvt_pk_bf16(h0[2] * siluf(bflo(pg0.y)), h0[3] * siluf(bfhi(pg0.y)));
            o.z = cvt_pk_bf16(h1[0] * siluf(bflo(pg0.z)), h1[1] * siluf(bfhi(pg0.z)));
            o.w = cvt_pk_bf16(h1[2] * siluf(bflo(pg0.w)), h1[3] * siluf(bfhi(pg0.w)));
            so0 = o;
            if (more) pg0 = *(const u32x4*)(Z2 + (unsigned)((r0 + 64 + ot0) * 3072u + 1536 + och0));
        }
        if (o1) {
            const f32x4 h0 = *(const LAS f32x4*)(Bb + ot1 * 96 + og1 * 8), h1 = *(const LAS f32x4*)(Bb + ot1 * 96 + og1 * 8 + 4);
            u32x4 o;
            o.x = cvt_pk_bf16(h0[0] * siluf(bflo(pg1.x)), h0[1] * siluf(bfhi(pg1.x)));
            o.y = cvt_pk_bf16(h0[2] * siluf(bflo(pg1.y)), h0[3] * siluf(bfhi(pg1.y)));
            o.z = cvt_pk_bf16(h1[0] * siluf(bflo(pg1.z)), h1[1] * siluf(bfhi(pg1.z)));
            o.w = cvt_pk_bf16(h1[2] * siluf(bflo(pg1.w)), h1[3] * siluf(bfhi(pg1.w)));
            so1 = o;
            if (more) pg1 = *(const u32x4*)(Z2 + (unsigned)((r0 + 64 + ot1) * 3072u + 1536 + och1));
        }
        sr = r0; spend = true;
        lds_barrier();
    }
    if (spend) { *(u32x4*)(Y2 + (unsigned)((sr + ot0) * 1536u + och0)) = so0; if (o1) *(u32x4*)(Y2 + (unsigned)((sr + ot1) * 1536u + och1)) = so1; }
    if (tid < 96) p.out[(smp ? O_LS : O_LP) + (size_t)b * 1536 + nb * 192 + hf * 96 + tid] = HC[(nch & 1) * 96 + tid];
    lds_barrier();
}

__device__ __forceinline__ void phase6(const Params& p, LAS unsigned char* L) {
    if (gridDim.x == 256) {
        const int xcd = blockIdx.x & 7, loc = blockIdx.x >> 3;
        const int pair = xcd * 16 + (loc >> 1), hf = loc & 1;
        lru_item(p, L, pair * 2 + hf); lru_item(p, L, 256 + pair * 2 + hf); lru_item(p, L, 512 + pair * 2 + hf);
    } else {
        for (int it = blockIdx.x; it < 768; it += gridDim.x) lru_item(p, L, it);
    }
}

__device__ __forceinline__ void phase8(const Params& p) {
    const float* rsq = (const float*)(p.ws + WS_RSQ2); const float* g = p.in[24]; float* y = p.out; const bf16_t* xb = (const bf16_t*)(p.ws + WS_XB);
    const long gtid = (long)blockIdx.x * NTHR + threadIdx.x, gsz = (long)gridDim.x * NTHR;
    const long total = (long)T * 128;
    for (long it = gtid; it < total; it += gsz) {
        const long row = it >> 7; const int c8 = (int)(it & 127) * 8;
        const float rs = rsqrtf(rsq[row] * (1.f / 1024.f) + EPS);
        const u32x4 xw = *(const u32x4*)(xb + row * 1024 + c8);
        const f32x4 g0 = *(const f32x4*)(g + c8), g1 = *(const f32x4*)(g + c8 + 4);
        f32x4 o0, o1;
        o0[0] = bflo(xw.x) * rs * g0[0]; o0[1] = bfhi(xw.x) * rs * g0[1]; o0[2] = bflo(xw.y) * rs * g0[2]; o0[3] = bfhi(xw.y) * rs * g0[3];
        o1[0] = bflo(xw.z) * rs * g1[0]; o1[1] = bfhi(xw.z) * rs * g1[1]; o1[2] = bflo(xw.w) * rs * g1[2]; o1[3] = bfhi(xw.w) * rs * g1[3];
        *(f32x4*)(y + row * 1024 + c8) = o0; *(f32x4*)(y + row * 1024 + c8 + 4) = o1;
    }
}

#define XB_TMO      128
#define XB_XCNT(j)  (256  + 64 * (j))
#define XB_XSUB(j)  (1280 + 64 * (j))
#define XB_XGEN(j)  (2304 + 64 * (j))
#define XB_TOP      3328
#define XB_TOPGEN   3392
#define XCD_BAR_WORDS 3456
#define XB_SPIN_CAP (1u << 18)
__device__ __forceinline__ unsigned xb_ld(unsigned* p)              { return __hip_atomic_load(p, __ATOMIC_RELAXED, __HIP_MEMORY_SCOPE_AGENT); }
__device__ __forceinline__ unsigned xb_add(unsigned* p, unsigned v) { return __hip_atomic_fetch_add(p, v, __ATOMIC_RELAXED, __HIP_MEMORY_SCOPE_AGENT); }
__device__ __forceinline__ unsigned xb_xcc_id() { return (unsigned)__builtin_amdgcn_s_getreg((3 << 11) | 20) & 0xFu; }
#define XB_SPIN(cond, bar) do { unsigned _sp = 0; while (cond) { __builtin_amdgcn_s_sleep(1); \
    if ((++_sp & 255u) == 0u) { if (xb_ld(&(bar)[XB_TMO])) break; if (_sp > XB_SPIN_CAP) { atomicAdd(&(bar)[XB_TMO], 1u); break; } } } } while (0)
struct XcdBarrier { unsigned* bar; unsigned x; volatile LAS unsigned* st; };
__device__ __forceinline__ XcdBarrier xcd_barrier_post(unsigned* bar, volatile LAS unsigned* st) {
    XcdBarrier b; b.bar = bar; b.x = xb_xcc_id(); b.st = st;
    if (threadIdx.x == 0) (void)xb_add(&bar[XB_XCNT(b.x)], 1u);
    return b;
}
__device__ __forceinline__ void xcd_barrier_complete(unsigned* bar, unsigned x, unsigned& nloc, unsigned& nx) {
    const unsigned G = gridDim.x * gridDim.y * gridDim.z;
    unsigned sum, cnt, mine, sp = 0u;
    for (;;) {
        sum = 0u; cnt = 0u; mine = 0u;
#pragma unroll
        for (unsigned j = 0; j < 16; ++j) { const unsigned c = xb_ld(&bar[XB_XCNT(j)]); sum += c; cnt += (c > 0u) ? 1u : 0u; mine = (j == x) ? c : mine; }
        if (sum == G) break;
        __builtin_amdgcn_s_sleep(1);
        if ((++sp & 255u) == 0u) { if (xb_ld(&bar[XB_TMO])) break; if (sp > XB_SPIN_CAP) { atomicAdd(&bar[XB_TMO], 1u); break; } }
    }
    nloc = mine > 0u ? mine : 1u; nx = cnt > 0u ? cnt : 1u;
}
__device__ __forceinline__ void xcd_barrier(const XcdBarrier& b) {
    asm volatile("s_waitcnt vmcnt(0)" ::: "memory");
    __syncthreads();
    if (threadIdx.x == 0) {
        unsigned* bar = b.bar;
        __builtin_amdgcn_s_waitcnt(0);
        unsigned nloc = b.st[0], nx = b.st[1];
        if (nloc == 0u) { xcd_barrier_complete(bar, b.x, nloc, nx); b.st[0] = nloc; b.st[1] = nx; }
        const unsigned old = xb_add(&bar[XB_XSUB(b.x)], 1u);
        const unsigned gen = old / nloc;
        if (old + 1u == (gen + 1u) * nloc) {
            __builtin_amdgcn_fence(__ATOMIC_RELEASE, "agent");
            asm volatile("s_waitcnt vmcnt(0)" ::: "memory");
            const unsigned og = xb_add(&bar[XB_TOP], 1u);
            const unsigned tg = og / nx;
            if (og + 1u == (tg + 1u) * nx) xb_add(&bar[XB_TOPGEN], 1u);
            else XB_SPIN(xb_ld(&bar[XB_TOPGEN]) == tg, bar);
            __builtin_amdgcn_fence(__ATOMIC_ACQUIRE, "agent");
            xb_add(&bar[XB_XGEN(b.x)], 1u);
            asm volatile("s_waitcnt vmcnt(0)" ::: "memory");
        } else {
            XB_SPIN(xb_ld(&bar[XB_XGEN(b.x)]) == gen, bar);
            __builtin_amdgcn_fence(__ATOMIC_ACQUIRE, "agent");
            asm volatile("s_waitcnt vmcnt(0)" ::: "memory");
        }
    }
    __syncthreads();
}

__global__ void __launch_bounds__(NTHR) mega(Params p) {
    extern __shared__ __attribute__((aligned(16))) unsigned char lds_raw[];
    LAS unsigned char* L = (LAS unsigned char*)lds_raw;
    cg::grid_group grid = cg::this_grid();
    unsigned char* ws = p.ws;
    const int lo = p.ph_lo, hi = p.ph_hi;
    LAS unsigned* stw = (LAS unsigned*)(L + (LDS_BYTES - 16));
    if (threadIdx.x < 4) stw[threadIdx.x] = 0u;
    __syncthreads();
    const XcdBarrier xb = xcd_barrier_post((unsigned*)(ws + WS_BAR), (volatile LAS unsigned*)stw);
#ifndef PHMASK
#define PHMASK 0x1ff
#endif
#define IN(k) (((PHMASK >> (k)) & 1) && lo <= (k) && (k) < hi)
#define SEAM(k) do { if (IN(k) && IN((k) + 1)) xcd_barrier(xb); } while (0)
    if (hi > 1000) grid.sync();
    if (IN(0)) phase0(p);
    SEAM(0);
    if (IN(1)) {
        pg8::Gemm g{(const bf16_t*)(ws + WS_XB), (const bf16_t*)(ws + WS_WINE), T, NE_PAD, 1024};
        pg8::StaticOrder S; S.init(T, NE_PAD, gridDim.x, blockIdx.x);
        EpiInEven E{ws, p.out, (const float*)(ws + WS_RSTD0), p.in[10]};
        pg8::gemm_phase<EpiInEven>(L, g, S, E);
    }
    SEAM(1);
    if (IN(2)) { phase2a(p, L); xcd_barrier(xb); phase2b(p, L); }
    SEAM(2);
    if (IN(3)) phase3(p);
    SEAM(3);
    if (IN(4)) {
        pg8::Gemm g{(const bf16_t*)(ws + WS_GATE), (const bf16_t*)(ws + WS_WOUTE), T, 1024, 2048};
        pg8::StaticOrder S; S.init(T, 1024, gridDim.x, blockIdx.x);
        EpiOutRes<true> E{p.in[0], p.in[1], p.out, (bf16_t*)(ws + WS_XB), (float*)(ws + WS_RSQ1)};
        pg8::gemm_phase<EpiOutRes<true>>(L, g, S, E);
    }
    SEAM(4);
    if (IN(5)) {
        pg8::Gemm g{(const bf16_t*)(ws + WS_XB), (const bf16_t*)(ws + WS_WINO), T, 3072, 1024};
        pg8::StaticOrder S; S.init(T, 3072, gridDim.x, blockIdx.x);
        EpiInOdd E{(bf16_t*)(ws + WS_Z2), (const float*)(ws + WS_RSQ1)};
        pg8::gemm_phase<EpiInOdd>(L, g, S, E);
    }
    SEAM(5);
    if (IN(6)) phase6(p, L);
    SEAM(6);
    if (IN(7)) {
        pg8::Gemm g{(const bf16_t*)(ws + WS_Y2), (const bf16_t*)(ws + WS_WOUTO), T, 1024, 1536};
        pg8::StaticOrder S; S.init(T, 1024, gridDim.x, blockIdx.x);
        EpiOutResB E{(bf16_t*)(ws + WS_XB), (float*)(ws + WS_RSQ2)};
        pg8::gemm_phase<EpiOutResB>(L, g, S, E);
    }
    SEAM(7);
    if (IN(8)) phase8(p);
#undef IN
#undef SEAM
}

extern "C" void kernel_launch(void* const* d_in, const int* in_sizes, int n_in, void* d_out, int out_size, void* d_ws, size_t ws_size, hipStream_t stream) {
    static int grid_blocks = 0;
    if (grid_blocks == 0) {
        if (n_in != 25 || (size_t)out_size != O_END || ws_size < WS_TOTAL) { fprintf(stderr, "kernel_launch: unexpected shapes n_in %d out %d ws %zu (need %zu)\n", n_in, out_size, ws_size, (size_t)WS_END); grid_blocks = -1; return; }
        int dev = 0, cus = 0, per_cu = 0;
        (void)hipGetDevice(&dev);
        (void)hipDeviceGetAttribute(&cus, hipDeviceAttributeMultiprocessorCount, dev);
        if (hipFuncSetAttribute((const void*)mega, hipFuncAttributeMaxDynamicSharedMemorySize, LDS_BYTES) != hipSuccess) { fprintf(stderr, "kernel_launch: hipFuncSetAttribute failed\n"); }
        if (hipOccupancyMaxActiveBlocksPerMultiprocessor(&per_cu, (const void*)mega, NTHR, LDS_BYTES) != hipSuccess || per_cu < 1) per_cu = 1;
        (void)hipGetLastError();
        grid_blocks = cus * per_cu;
        if (grid_blocks <= 0) grid_blocks = 256;
    }
    if (grid_blocks < 0) return;
    Params p{};
    for (int i = 0; i < 25; ++i) p.in[i] = (const float*)d_in[i];
    p.out = (float*)d_out; p.ws = (unsigned char*)d_ws;
#if ONE_LAUNCH
#ifdef PROBE_X
    { const int seq[3][2] = {{0, PROBE_Y + 1}, {PROBE_X, PROBE_Y + 1}, {PROBE_Y + 1, 9}};
      for (int li = 0; li < 3; ++li) { if (seq[li][0] >= seq[li][1]) continue; p.ph_lo = seq[li][0]; p.ph_hi = seq[li][1]; void* args[] = {&p};
        (void)hipMemsetAsync((char*)d_ws + WS_BAR, 0, 16384, stream);
        hipError_t e = hipLaunchCooperativeKernel((const void*)mega, dim3(grid_blocks), dim3(NTHR), args, LDS_BYTES, stream);
        if (e != hipSuccess) fprintf(stderr, "cooperative launch failed: %s (grid %d)\n", hipGetErrorString(e), grid_blocks); } }
#else
    p.ph_lo = 0; p.ph_hi = 9;
    (void)hipMemsetAsync((char*)d_ws + WS_BAR, 0, 16384, stream);
    { void* args[] = {&p}; hipError_t e = hipLaunchCooperativeKernel((const void*)mega, dim3(grid_blocks), dim3(NTHR), args, LDS_BYTES, stream);
      if (e != hipSuccess) fprintf(stderr, "cooperative launch failed: %s (grid %d)\n", hipGetErrorString(e), grid_blocks); }
#endif
#else
    for (int ph = 0; ph < 9; ++ph) {
        p.ph_lo = ph; p.ph_hi = ph + 1;
        (void)hipMemsetAsync((char*)d_ws + WS_BAR, 0, 16384, stream);
        void* args[] = {&p}; hipError_t e = hipLaunchCooperativeKernel((const void*)mega, dim3(grid_blocks), dim3(NTHR), args, LDS_BYTES, stream);
        if (e != hipSuccess) fprintf(stderr, "cooperative launch %d failed: %s (grid %d)\n", ph, hipGetErrorString(e), grid_blocks);
    }
#endif
}
```

```cpp
#include <hip/hip_runtime.h>
#include <hip/hip_cooperative_groups.h>
#include <cstdio>
namespace cg = cooperative_groups;

#ifndef ONE_LAUNCH
#define ONE_LAUNCH 1
#endif

#define LAS __attribute__((address_space(3)))
typedef unsigned short bf16_t;
typedef short bf16x8 __attribute__((ext_vector_type(8)));
typedef short bf16x4 __attribute__((ext_vector_type(4)));
typedef float f32x4 __attribute__((ext_vector_type(4)));
typedef unsigned u32x4 __attribute__((ext_vector_type(4)));
typedef unsigned u32x2 __attribute__((ext_vector_type(2)));

constexpr int T_P = 32768, T_S = 2048, T = T_P + T_S, DM = 1024;
constexpr int NE_PAD = 6144;
constexpr int LDS_BYTES = 159744;
constexpr int NTHR = 512;
constexpr float EPS = 1e-6f;

constexpr size_t WS_WINE = 0;
constexpr size_t WS_WOUTE = WS_WINE + (size_t)NE_PAD * 1024 * 2;
constexpr size_t WS_WINO = WS_WOUTE + (size_t)1024 * 2048 * 2;
constexpr size_t WS_WOUTO = WS_WINO + (size_t)3072 * 1024 * 2;
constexpr size_t WS_WA = WS_WOUTO + (size_t)1024 * 1536 * 2;
constexpr size_t WS_WI = WS_WA + (size_t)8 * 192 * 192 * 2;
constexpr size_t WS_XB = WS_WI + (size_t)8 * 192 * 192 * 2;
constexpr size_t WS_RSTD0 = WS_XB + (size_t)T * 1024 * 2;
constexpr size_t WS_RSQ1 = WS_RSTD0 + (size_t)T * 4;
constexpr size_t WS_RSQ2 = WS_RSQ1 + (size_t)T * 4;
constexpr size_t WS_BOSQ = WS_RSQ2 + (size_t)T * 4;
constexpr size_t WS_Q = WS_BOSQ + (size_t)T * 16;
constexpr size_t WS_K = WS_Q + (size_t)T * 1024 * 2;
constexpr size_t WS_V = WS_K + (size_t)T * 256 * 2;
constexpr size_t WS_BQ = WS_V + (size_t)T * 256 * 2;
constexpr size_t WS_BK = WS_BQ + (size_t)T * 512 * 2;
constexpr size_t WS_BV = WS_BK + (size_t)T * 512 * 2;
constexpr size_t WS_GATE = WS_BV + (size_t)T * 1024 * 2;
constexpr size_t WS_BLR = WS_GATE + (size_t)T * 2048 * 2;
constexpr size_t WS_END = WS_BLR + (size_t)T * 512 * 2;
constexpr size_t WS_BAR = WS_END;
constexpr size_t WS_TOTAL = WS_BAR + 16384;
constexpr size_t WS_Z2 = WS_Q;
constexpr size_t WS_Y2 = WS_GATE;
static_assert(WS_Z2 + (size_t)T * 3072 * 2 <= WS_GATE, "Z2 alias");

constexpr size_t O_Y = 0;
constexpr size_t O_KP = (size_t)T * 1024;
constexpr size_t O_VP = O_KP + 524288;
constexpr size_t O_GP = O_VP + 524288;
constexpr size_t O_CP = O_GP + 2097152;
constexpr size_t O_LP = O_CP + 73728;
constexpr size_t O_KS = O_LP + 24576;
constexpr size_t O_VS = O_KS + 524288;
constexpr size_t O_GS = O_VS + 524288;
constexpr size_t O_CS = O_GS + 4194304;
constexpr size_t O_LS = O_CS + 147456;
constexpr size_t O_END = O_LS + 49152;

struct Params {
    const float* in[25];
    float* out;
    unsigned char* ws;
    int ph_lo, ph_hi;
};

__device__ __forceinline__ unsigned cvt_pk_bf16(float lo, float hi) { unsigned r; asm volatile("v_cvt_pk_bf16_f32 %0, %1, %2" : "=v"(r) : "v"(lo), "v"(hi)); return r; }
__device__ __forceinline__ bf16_t f2bf(float f) { return (bf16_t)(cvt_pk_bf16(f, 0.f) & 0xffffu); }
__device__ __forceinline__ float bf2f(bf16_t b) { return __uint_as_float(((unsigned)b) << 16); }
__device__ __forceinline__ float bflo(unsigned w) { return __uint_as_float(w << 16); }
__device__ __forceinline__ float bfhi(unsigned w) { return __uint_as_float(w & 0xffff0000u); }
__device__ __forceinline__ float rcpf_(float x) { return __builtin_amdgcn_rcpf(x); }
__device__ __forceinline__ float siluf(float x) { return x * rcpf_(1.f + __expf(-x)); }
__device__ __forceinline__ float sigmf(float x) { return rcpf_(1.f + __expf(-x)); }
__device__ __forceinline__ void lds_barrier() { asm volatile("s_waitcnt lgkmcnt(0)" ::: "memory"); __builtin_amdgcn_s_barrier(); asm volatile("" ::: "memory"); }
__device__ __forceinline__ bf16x8 pack8(const f32x4& a, const f32x4& b) {
    u32x4 p; p.x = cvt_pk_bf16(a[0], a[1]); p.y = cvt_pk_bf16(a[2], a[3]); p.z = cvt_pk_bf16(b[0], b[1]); p.w = cvt_pk_bf16(b[2], b[3]);
    return __builtin_bit_cast(bf16x8, p);
}
__device__ __forceinline__ bf16x8 cat4(const bf16x4 a, const bf16x4 b) { bf16x8 r; r[0] = a[0]; r[1] = a[1]; r[2] = a[2]; r[3] = a[3]; r[4] = b[0]; r[5] = b[1]; r[6] = b[2]; r[7] = b[3]; return r; }
__device__ __forceinline__ void unpack8(const u32x4 w, float (&v)[8]) { v[0] = bflo(w.x); v[1] = bfhi(w.x); v[2] = bflo(w.y); v[3] = bfhi(w.y); v[4] = bflo(w.z); v[5] = bfhi(w.z); v[6] = bflo(w.w); v[7] = bfhi(w.w); }
#define MFMA16(a, b, c) __builtin_amdgcn_mfma_f32_16x16x32_bf16((a), (b), (c), 0, 0, 0)

namespace pg8 {
constexpr int BM = 256, BK = 64, HALF = 128, HTB = HALF * BK * 2, STAGE_BYTES = 8 * HTB, NXCD = 8, WGM = 8;
__device__ __forceinline__ int lds_byte(int r, int c) { const int st = (r >> 4) * 2 + (c >> 5), rr = r & 15, cc = c & 31, ob = rr * 64 + cc * 2; return st * 1024 + (ob ^ (((ob >> 9) & 1) << 5)); }
__device__ __forceinline__ int perm32(int rho) { const int n = rho >> 4, i = rho & 15; return 8 * (i >> 2) + 4 * n + (i & 3); }
__device__ __forceinline__ void stage_rc(int b, int& R, int& C) { const int st = b / 1024, sb = b % 1024, swz = sb ^ (((sb >> 9) & 1) << 5); R = (st >> 1) * 16 + swz / 64; C = (st & 1) * 32 + (swz % 64) / 2; }
struct Unit { int pm, pn; };
struct Gemm { const bf16_t* A; const bf16_t* Bt; int M, N, K; };
struct StaticOrder {
    int nM, nN, nwg, G, c;
    __device__ void init(int M, int N, int G_, int c_) { nM = M / BM; nN = N / BM; nwg = nM * nN; G = G_; c = c_; }
    __device__ __forceinline__ bool next(int i, Unit& u) const {
        const long Lx = (long)i * G + c; if (Lx >= nwg) return false;
        int wgid = (int)Lx; { const int q = nwg / NXCD, r = nwg % NXCD, xcd = wgid % NXCD, off = wgid / NXCD; wgid = (xcd < r ? xcd * (q + 1) : r * (q + 1) + (xcd - r) * q) + off; }
        const int nig = WGM * nN, gid = wgid / nig, fm = gid * WGM, gsz = (nM - fm) < WGM ? (nM - fm) : WGM;
        u.pm = fm + ((wgid % nig) % gsz); u.pn = (wgid % nig) / gsz; return true;
    }
};

template <class Epi>
__device__ __forceinline__ void gemm_phase(LAS unsigned char* lds, const Gemm g, const StaticOrder& S, const Epi& E) {
    const int tid = threadIdx.x, wid = __builtin_amdgcn_readfirstlane(tid >> 6), lane = tid & 63, wr = wid >> 2, wc = wid & 3, fr = lane & 15, fq = lane >> 4;
    const int K = g.K, nt = K / BK;
    unsigned voffA[2], voffB[2];
#pragma unroll
    for (int i = 0; i < 2; ++i) { int R, C; stage_rc(tid * 16 + i * 8192, R, C); const int Rb = Epi::PERM ? ((R & ~31) + perm32(R & 31)) : R;
        voffA[i] = (unsigned)(R * K + C) * 2u; voffB[i] = (unsigned)(Rb * K + C) * 2u; }
    const size_t kstep = (size_t)(BK * 2);
    const size_t hstep = (size_t)HALF * K * 2;
    const size_t tstep = 2 * hstep;
    const unsigned ldsw = (unsigned)wid * 1024u;
    const int aoff = lds_byte(wr * 64 + fr, fq * 8), boff = lds_byte(wc * 32 + fr, fq * 8);
#define PG8_SA(b, h) (((b) * 2 + (h)) * HTB)
#define PG8_SB(b, h) ((4 + (b) * 2 + (h)) * HTB)
#define PG8_STAGE(bufoff, gbase, voff) do { _Pragma("unroll") for (int _i = 0; _i < 2; ++_i) \
        __builtin_amdgcn_global_load_lds((const unsigned*)((const char*)(gbase) + (voff)[_i]), (LAS unsigned*)(lds + (bufoff) + ldsw + _i * 8192), 16, 0, 0); } while (0)
#define PG8_LDA(dst, b, h) do { _Pragma("unroll") for (int m = 0; m < 4; ++m) _Pragma("unroll") for (int k = 0; k < 2; ++k) dst[m][k] = *(const LAS bf16x8*)(lds + PG8_SA(b, h) + aoff + m * 2048 + k * 1024); } while (0)
#define PG8_LDB(dst, b, h) do { _Pragma("unroll") for (int n = 0; n < 2; ++n) _Pragma("unroll") for (int k = 0; k < 2; ++k) dst[n][k] = *(const LAS bf16x8*)(lds + PG8_SB(b, h) + boff + n * 2048 + k * 1024); } while (0)
#define PG8_MMA(ai, bj, At, Bt) do { __builtin_amdgcn_s_setprio(1); _Pragma("unroll") for (int m = 0; m < 4; ++m) _Pragma("unroll") for (int n = 0; n < 2; ++n) _Pragma("unroll") for (int k = 0; k < 2; ++k) \
        acc[ai][bj][m][n] = __builtin_amdgcn_mfma_f32_16x16x32_bf16(Bt[n][k], At[m][k], acc[ai][bj][m][n], 0, 0, 0); __builtin_amdgcn_s_setprio(0); } while (0)
#define PG8_WAIT_V(n) asm volatile("s_waitcnt vmcnt(" #n ")" ::: "memory")
#define PG8_WAIT_L(n) asm volatile("s_waitcnt lgkmcnt(" #n ")" ::: "memory")
#define PG8_BAR __builtin_amdgcn_s_barrier()
#define PG8_SCHED __builtin_amdgcn_sched_barrier(0)
    Unit cur, nxt; int ui = 0;
    if (!S.next(0, cur)) return;
    f32x4 acc[2][2][4][2];
#pragma unroll
    for (int a = 0; a < 2; ++a)
#pragma unroll
        for (int b = 0; b < 2; ++b)
#pragma unroll
            for (int m = 0; m < 4; ++m)
#pragma unroll
                for (int n = 0; n < 2; ++n) acc[a][b][m][n] = (f32x4){0.f, 0.f, 0.f, 0.f};
    bf16x8 At[4][2], B0[2][2], B1[2][2];
    const char* cA = (const char*)g.A + (size_t)cur.pm * tstep; const char* cB = (const char*)g.Bt + (size_t)cur.pn * tstep;
    PG8_STAGE(PG8_SB(0, 0), cB, voffB); PG8_STAGE(PG8_SB(0, 1), cB + hstep, voffB); PG8_STAGE(PG8_SA(0, 0), cA, voffA); PG8_STAGE(PG8_SA(0, 1), cA + hstep, voffA);
    if (wr == 1) PG8_BAR;
    PG8_WAIT_V(2); PG8_BAR;
    PG8_STAGE(PG8_SB(1, 0), cB + kstep, voffB); PG8_STAGE(PG8_SA(1, 0), cA + kstep, voffA); PG8_STAGE(PG8_SB(1, 1), cB + hstep + kstep, voffB);
    PG8_WAIT_V(6); PG8_BAR;
    for (;;) {
        const bool has_next = S.next(ui + 1, nxt);
        const char* nA = has_next ? (const char*)g.A + (size_t)nxt.pm * tstep : cA; const char* nB = has_next ? (const char*)g.Bt + (size_t)nxt.pn * tstep : cB;
        for (int t = 0; t < nt; t += 2) {
            const bool last = (t == nt - 2);
            const char* a1 = cA + (size_t)(t + 1) * kstep;
            const char* a2 = last ? nA : cA + (size_t)(t + 2) * kstep; const char* b2 = last ? nB : cB + (size_t)(t + 2) * kstep;
            const char* a3 = a2 + kstep; const char* b3 = b2 + kstep;
            PG8_LDB(B0, 0, 0); PG8_LDB(B1, 0, 1); PG8_SCHED; PG8_LDA(At, 0, 0); PG8_STAGE(PG8_SA(1, 1), a1 + hstep, voffA);
            PG8_WAIT_V(8); PG8_WAIT_L(0); PG8_BAR; PG8_MMA(0, 0, At, B0); PG8_MMA(0, 1, At, B1); PG8_BAR; PG8_SCHED;
            PG8_LDA(At, 0, 1); PG8_STAGE(PG8_SB(0, 0), b2, voffB); PG8_STAGE(PG8_SB(0, 1), b2 + hstep, voffB); PG8_STAGE(PG8_SA(0, 0), a2, voffA);
            PG8_WAIT_V(8); PG8_WAIT_L(0); PG8_BAR; PG8_MMA(1, 0, At, B0); PG8_MMA(1, 1, At, B1); PG8_BAR; PG8_SCHED;
            PG8_LDB(B0, 1, 0); PG8_LDB(B1, 1, 1); PG8_SCHED; PG8_LDA(At, 1, 0); PG8_STAGE(PG8_SA(0, 1), a2 + hstep, voffA);
            PG8_WAIT_V(8); PG8_WAIT_L(0); PG8_BAR; PG8_MMA(0, 0, At, B0); PG8_MMA(0, 1, At, B1); PG8_BAR; PG8_SCHED;
            PG8_LDA(At, 1, 1); PG8_STAGE(PG8_SB(1, 0), b3, voffB); PG8_STAGE(PG8_SB(1, 1), b3 + hstep, voffB); PG8_STAGE(PG8_SA(1, 0), a3, voffA);
            PG8_WAIT_V(8); PG8_WAIT_L(0); PG8_BAR; PG8_MMA(1, 0, At, B0); PG8_MMA(1, 1, At, B1); PG8_BAR; PG8_SCHED;
        }
        if (wr == 0) PG8_BAR;
        E(acc, cur, wr, wc, fr, fq);
        if (!has_next) break;
#pragma unroll
        for (int a = 0; a < 2; ++a)
#pragma unroll
            for (int b = 0; b < 2; ++b)
#pragma unroll
                for (int m = 0; m < 4; ++m)
#pragma unroll
                    for (int n = 0; n < 2; ++n) acc[a][b][m][n] = (f32x4){0.f, 0.f, 0.f, 0.f};
        cur = nxt; cA = nA; cB = nB; ++ui;
        if (wr == 1) PG8_BAR;
    }
    PG8_WAIT_V(0);
    PG8_BAR;
#undef PG8_SA
#undef PG8_SB
#undef PG8_STAGE
#undef PG8_LDA
#undef PG8_LDB
#undef PG8_MMA
#undef PG8_WAIT_V
#undef PG8_WAIT_L
#undef PG8_BAR
#undef PG8_SCHED
}
}

typedef f32x4 AccT[2][2][4][2];

struct EpiInEven {
    static constexpr bool PERM = true;
    unsigned char* ws; float* out; const float* rstd; const float* blr_b;
    __device__ __forceinline__ void operator()(const AccT& acc, const pg8::Unit& u, int wr, int wc, int fr, int fq) const {
        const int pn = u.pn;
        bf16_t* base; int ld, coff; float sc = 1.f;
        if (pn < 4) { base = (bf16_t*)(ws + WS_Q); ld = 1024; coff = pn * 256; sc = 0.125f; }
        else if (pn == 4) { base = (bf16_t*)(ws + WS_K); ld = 256; coff = 0; }
        else if (pn == 5) { base = (bf16_t*)(ws + WS_V); ld = 256; coff = 0; }
        else if (pn < 8) { base = (bf16_t*)(ws + WS_BQ); ld = 512; coff = (pn - 6) * 256; sc = 0.08838834764831845f; }
        else if (pn < 10) { base = (bf16_t*)(ws + WS_BK); ld = 512; coff = (pn - 8) * 256; }
        else if (pn < 14) { base = (bf16_t*)(ws + WS_BV); ld = 1024; coff = (pn - 10) * 256; }
        else if (pn < 22) { base = (bf16_t*)(ws + WS_GATE); ld = 2048; coff = (pn - 14) * 256; }
        else { base = (bf16_t*)(ws + WS_BLR); ld = 512; coff = (pn - 22) * 256; }
        const int row0 = u.pm * 256 + wr * 64 + fr;
        const int ct = wc * 32 + 8 * fq;
        float rsv[8];
#pragma unroll
        for (int it = 0; it < 8; ++it) rsv[it] = rstd[row0 + (it >> 2) * 128 + (it & 3) * 16];
        if (pn >= 22) {
#pragma unroll
            for (int ai = 0; ai < 2; ++ai)
#pragma unroll
                for (int m = 0; m < 4; ++m) {
                    const int row = row0 + ai * 128 + m * 16; const float rs = rsv[ai * 4 + m];
#pragma unroll
                    for (int bj = 0; bj < 2; ++bj) {
                        const int cg = coff + ct + bj * 128;
                        const f32x4 b0 = *(const f32x4*)(blr_b + cg), b1 = *(const f32x4*)(blr_b + cg + 4);
                        f32x4 x0 = acc[ai][bj][m][0] * rs + b0, x1 = acc[ai][bj][m][1] * rs + b1;
#pragma unroll
                        for (int j = 0; j < 4; ++j) { x0[j] = (fminf(x0[j], 0.f) - __logf(1.f + __expf(-fabsf(x0[j])))) * (1.f / 16.f); x1[j] = (fminf(x1[j], 0.f) - __logf(1.f + __expf(-fabsf(x1[j])))) * (1.f / 16.f); }
                        u32x4 w; w.x = cvt_pk_bf16(x0[0], x0[1]); w.y = cvt_pk_bf16(x0[2], x0[3]); w.z = cvt_pk_bf16(x1[0], x1[1]); w.w = cvt_pk_bf16(x1[2], x1[3]);
                        *(u32x4*)(base + (size_t)row * 512 + cg) = w;
                    }
                }
            return;
        }
        const bool kv = (pn == 4 || pn == 5);
        float* okv_p = out + (pn == 4 ? O_KP : O_VP); float* okv_s = out + (pn == 4 ? O_KS : O_VS);
#pragma unroll
        for (int ai = 0; ai < 2; ++ai)
#pragma unroll
            for (int m = 0; m < 4; ++m) {
                const int row = row0 + ai * 128 + m * 16; const float rs = rsv[ai * 4 + m] * sc;
                bf16_t* rowp = base + (size_t)row * ld + coff + ct;
                float* orow = nullptr;
                if (kv) {
                    if (row >= T_P) orow = okv_s + (size_t)(row - T_P) * 256;
                    else { const int b = row >> 11, t = row & 2047; if (t >= 1920) orow = okv_p + (size_t)(b * 128 + t - 1920) * 256; }
                }
#pragma unroll
                for (int bj = 0; bj < 2; ++bj) {
                    const f32x4 v0 = acc[ai][bj][m][0] * rs, v1 = acc[ai][bj][m][1] * rs;
                    u32x4 w; w.x = cvt_pk_bf16(v0[0], v0[1]); w.y = cvt_pk_bf16(v0[2], v0[3]); w.z = cvt_pk_bf16(v1[0], v1[1]); w.w = cvt_pk_bf16(v1[2], v1[3]);
                    *(u32x4*)(rowp + bj * 128) = w;
                    if (kv && orow) { *(f32x4*)(orow + bj * 128 + ct) = v0; *(f32x4*)(orow + bj * 128 + ct + 4) = v1; }
                }
            }
    }
};

template <bool WRITE_BF>
struct EpiOutRes {
    static constexpr bool PERM = false;
    const float* xin_p; const float* xin_s; float* xo; bf16_t* xb; float* rowsq;
    __device__ __forceinline__ void operator()(const AccT& acc, const pg8::Unit& u, int wr, int wc, int fr, int fq) const {
        const int row0 = u.pm * 256 + wr * 64 + fr, col0 = u.pn * 256 + wc * 32 + 4 * fq;
        f32x4 r[3][4];
#define EOR_LOAD(S, IT) do { const int row_ = row0 + ((IT) >> 2) * 128 + ((IT) & 3) * 16; \
            const float* xr_ = (row_ < T_P) ? xin_p + (size_t)row_ * 1024 : xin_s + (size_t)(row_ - T_P) * 1024; \
            r[S][0] = *(const f32x4*)(xr_ + col0); r[S][1] = *(const f32x4*)(xr_ + col0 + 16); r[S][2] = *(const f32x4*)(xr_ + col0 + 128); r[S][3] = *(const f32x4*)(xr_ + col0 + 144); } while (0)
        EOR_LOAD(0, 0); EOR_LOAD(1, 1);
#pragma unroll
        for (int it = 0; it < 8; ++it) {
            if (it + 2 < 8) { if ((it + 2) % 3 == 0) EOR_LOAD(0, it + 2); else if ((it + 2) % 3 == 1) EOR_LOAD(1, it + 2); else EOR_LOAD(2, it + 2); }
            const int ai = it >> 2, m = it & 3;
            const int row = row0 + ai * 128 + m * 16;
            float ss = 0.f;
#pragma unroll
            for (int bj = 0; bj < 2; ++bj)
#pragma unroll
                for (int n = 0; n < 2; ++n) {
                    const int col = col0 + bj * 128 + n * 16;
                    const f32x4 v = acc[ai][bj][m][n] + r[it % 3][bj * 2 + n];
                    if (!WRITE_BF) *(f32x4*)(xo + (size_t)row * 1024 + col) = v;
                    if (WRITE_BF) { u32x2 w; w.x = cvt_pk_bf16(v[0], v[1]); w.y = cvt_pk_bf16(v[2], v[3]); *(u32x2*)(xb + (size_t)row * 1024 + col) = w; }
                    ss += v[0] * v[0] + v[1] * v[1] + v[2] * v[2] + v[3] * v[3];
                }
            ss += __shfl_xor(ss, 16); ss += __shfl_xor(ss, 32);
            if (fq == 0) atomicAdd(rowsq + row, ss);
        }
#undef EOR_LOAD
    }
};

struct EpiOutResB {
    static constexpr bool PERM = false;
    bf16_t* xb; float* rowsq;
    __device__ __forceinline__ void operator()(const AccT& acc, const pg8::Unit& u, int wr, int wc, int fr, int fq) const {
        const int row0 = u.pm * 256 + wr * 64 + fr, col0 = u.pn * 256 + wc * 32 + 4 * fq;
        u32x2 r[3][4];
#define EOB_LOAD(S, IT) do { const bf16_t* xr_ = xb + (size_t)(row0 + ((IT) >> 2) * 128 + ((IT) & 3) * 16) * 1024 + col0; \
            r[S][0] = *(const u32x2*)(xr_); r[S][1] = *(const u32x2*)(xr_ + 16); r[S][2] = *(const u32x2*)(xr_ + 128); r[S][3] = *(const u32x2*)(xr_ + 144); } while (0)
        EOB_LOAD(0, 0); EOB_LOAD(1, 1);
#pragma unroll
        for (int it = 0; it < 8; ++it) {
            if (it + 2 < 8) { if ((it + 2) % 3 == 0) EOB_LOAD(0, it + 2); else if ((it + 2) % 3 == 1) EOB_LOAD(1, it + 2); else EOB_LOAD(2, it + 2); }
            const int ai = it >> 2, m = it & 3;
            const int row = row0 + ai * 128 + m * 16;
            float ss = 0.f;
#pragma unroll
            for (int bj = 0; bj < 2; ++bj)
#pragma unroll
                for (int n = 0; n < 2; ++n) {
                    const int col = col0 + bj * 128 + n * 16;
                    const u32x2 rw = r[it % 3][bj * 2 + n];
                    f32x4 v = acc[ai][bj][m][n];
                    v[0] += bflo(rw.x); v[1] += bfhi(rw.x); v[2] += bflo(rw.y); v[3] += bfhi(rw.y);
                    u32x2 w; w.x = cvt_pk_bf16(v[0], v[1]); w.y = cvt_pk_bf16(v[2], v[3]);
                    *(u32x2*)(xb + (size_t)row * 1024 + col) = w;
                    ss += v[0] * v[0] + v[1] * v[1] + v[2] * v[2] + v[3] * v[3];
                }
            ss += __shfl_xor(ss, 16); ss += __shfl_xor(ss, 32);
            if (fq == 0) atomicAdd(rowsq + row, ss);
        }
#undef EOB_LOAD
    }
};

struct EpiInOdd {
    static constexpr bool PERM = true;
    bf16_t* z2; const float* rowsq;
    __device__ __forceinline__ void operator()(const AccT& acc, const pg8::Unit& u, int wr, int wc, int fr, int fq) const {
        const int row0 = u.pm * 256 + wr * 64 + fr, col0 = u.pn * 256 + wc * 32 + 8 * fq;
        float rsv[8];
#pragma unroll
        for (int it = 0; it < 8; ++it) rsv[it] = rowsq[row0 + (it >> 2) * 128 + (it & 3) * 16];
#pragma unroll
        for (int ai = 0; ai < 2; ++ai)
#pragma unroll
            for (int m = 0; m < 4; ++m) {
                const int row = row0 + ai * 128 + m * 16; const float rs = rsqrtf(rsv[ai * 4 + m] * (1.f / 1024.f) + EPS);
#pragma unroll
                for (int bj = 0; bj < 2; ++bj) {
                    const f32x4 v0 = acc[ai][bj][m][0] * rs, v1 = acc[ai][bj][m][1] * rs;
                    u32x4 w; w.x = cvt_pk_bf16(v0[0], v0[1]); w.y = cvt_pk_bf16(v0[2], v0[3]); w.z = cvt_pk_bf16(v1[0], v1[1]); w.w = cvt_pk_bf16(v1[2], v1[3]);
                    *(u32x4*)(z2 + (size_t)row * 3072 + col0 + bj * 128) = w;
                }
            }
    }
};

template <int MODE>
__device__ __forceinline__ void transpose_w(const float* __restrict__ src, int K, int Nsrc, bf16_t* __restrict__ dst, int Ndst, const float* __restrict__ gain, long gtid, long gsz) {
    const long total = (long)(K / 8) * Ndst;
#pragma unroll 4
    for (long it = gtid; it < total; it += gsz) {
        const int n = (int)(it % Ndst), k8 = (int)(it / Ndst);
        int sc = n;
        if (MODE == 1) { if (n < 3584) sc = n; else sc = n + 16; }
        u32x4 w = {0u, 0u, 0u, 0u};
        if (sc >= 0) {
            const float* s = src + (size_t)(k8 * 8) * Nsrc + sc;
            float v0 = s[0], v1 = s[(size_t)Nsrc], v2 = s[(size_t)2 * Nsrc], v3 = s[(size_t)3 * Nsrc], v4 = s[(size_t)4 * Nsrc], v5 = s[(size_t)5 * Nsrc], v6 = s[(size_t)6 * Nsrc], v7 = s[(size_t)7 * Nsrc];
            if (gain) { const f32x4 g0 = *(const f32x4*)(gain + k8 * 8), g1 = *(const f32x4*)(gain + k8 * 8 + 4); v0 *= g0[0]; v1 *= g0[1]; v2 *= g0[2]; v3 *= g0[3]; v4 *= g1[0]; v5 *= g1[1]; v6 *= g1[2]; v7 *= g1[3]; }
            w.x = cvt_pk_bf16(v0, v1); w.y = cvt_pk_bf16(v2, v3); w.z = cvt_pk_bf16(v4, v5); w.w = cvt_pk_bf16(v6, v7);
        }
        *(u32x4*)(dst + (size_t)n * K + k8 * 8) = w;
    }
}

__device__ __forceinline__ void phase0(const Params& p) {
    unsigned char* ws = p.ws;
    const long gtid = (long)blockIdx.x * NTHR + threadIdx.x, gsz = (long)gridDim.x * NTHR;
    transpose_w<1>(p.in[8], 1024, 5648, (bf16_t*)(ws + WS_WINE), 5632, p.in[7], gtid, gsz);
    for (long it = gtid; it < 128L * 512; it += gsz) {
        const int n = (int)(it & 511), k8 = (int)(it >> 9);
        float wl[16];
#pragma unroll
        for (int r = 0; r < 16; ++r) wl[r] = p.in[9][r * 512 + n];
        float v[8];
#pragma unroll
        for (int i = 0; i < 8; ++i) {
            const float* wr_ = p.in[8] + (size_t)(k8 * 8 + i) * 5648 + 3584;
            float a = 0.f;
#pragma unroll
            for (int r4 = 0; r4 < 4; ++r4) { const f32x4 x = *(const f32x4*)(wr_ + r4 * 4); a += x[0] * wl[r4 * 4] + x[1] * wl[r4 * 4 + 1] + x[2] * wl[r4 * 4 + 2] + x[3] * wl[r4 * 4 + 3]; }
            v[i] = a * p.in[7][k8 * 8 + i];
        }
        u32x4 w; w.x = cvt_pk_bf16(v[0], v[1]); w.y = cvt_pk_bf16(v[2], v[3]); w.z = cvt_pk_bf16(v[4], v[5]); w.w = cvt_pk_bf16(v[6], v[7]);
        *(u32x4*)((bf16_t*)(ws + WS_WINE) + (size_t)(5632 + n) * 1024 + k8 * 8) = w;
    }
    transpose_w<0>(p.in[13], 2048, 1024, (bf16_t*)(ws + WS_WOUTE), 1024, nullptr, gtid, gsz);
    transpose_w<0>(p.in[15], 1024, 3072, (bf16_t*)(ws + WS_WINO), 3072, p.in[14], gtid, gsz);
    transpose_w<0>(p.in[23], 1536, 1024, (bf16_t*)(ws + WS_WOUTO), 1024, nullptr, gtid, gsz);
    for (int nb = 0; nb < 8; ++nb) {
        transpose_w<0>(p.in[18] + nb * 192 * 192, 192, 192, (bf16_t*)(ws + WS_WA) + nb * 192 * 192, 192, nullptr, gtid, gsz);
        transpose_w<0>(p.in[20] + nb * 192 * 192, 192, 192, (bf16_t*)(ws + WS_WI) + nb * 192 * 192, 192, nullptr, gtid, gsz);
    }
    { float* z = (float*)(ws + WS_RSQ1); const long nz = (long)T * 2; for (long i = gtid; i < nz; i += gsz) z[i] = 0.f; }
    const int lane = threadIdx.x & 63; const int gw = (int)(gtid >> 6), nw = (int)(gsz >> 6);
    bf16_t* xb = (bf16_t*)(ws + WS_XB); float* rstd = (float*)(ws + WS_RSTD0);
#pragma unroll 4
    for (int row = gw; row < T; row += nw) {
        const float* xr = (row < T_P) ? p.in[0] + (size_t)row * 1024 : p.in[1] + (size_t)(row - T_P) * 1024;
        float ss = 0.f;
#pragma unroll
        for (int i = 0; i < 4; ++i) {
            const f32x4 v = *(const f32x4*)(xr + i * 256 + lane * 4);
            ss += v[0] * v[0] + v[1] * v[1] + v[2] * v[2] + v[3] * v[3];
            u32x2 w; w.x = cvt_pk_bf16(v[0], v[1]); w.y = cvt_pk_bf16(v[2], v[3]);
            *(u32x2*)(xb + (size_t)row * 1024 + i * 256 + lane * 4) = w;
        }
#pragma unroll
        for (int o = 32; o >= 1; o >>= 1) ss += __shfl_xor(ss, o);
        if (lane == 0) rstd[row] = rsqrtf(ss * (1.f / 1024.f) + EPS);
    }
}

__device__ __forceinline__ void attn_item(const Params& p, LAS unsigned char* L, int item, bf16_t* Yd, int ldd) {
    unsigned char* ws = p.ws;
    const int tid = threadIdx.x, lane = tid & 63, w = tid >> 6, r16 = lane & 15, q4 = lane >> 4;
    LAS bf16_t* Ks = (LAS bf16_t*)L;
    LAS bf16_t* Vs = (LAS bf16_t*)(L + 192 * 72 * 2);
    const unsigned vbase = (unsigned)(size_t)L + 192u * 72u * 2u;
    const bf16_t* Qb = (const bf16_t*)(ws + WS_Q); const bf16_t* Kb = (const bf16_t*)(ws + WS_K); const bf16_t* Vb = (const bf16_t*)(ws + WS_V);
    const bf16_t* Yb = (const bf16_t*)(ws + WS_GATE);
    const bool smp = item >= 2048;
    int b, c, kh; size_t row0;
    if (!smp) { kh = item & 3; c = (item >> 2) & 31; b = item >> 7; row0 = (size_t)b * 2048 + c * 64; }
    else { const int i2 = item - 2048; kh = i2 & 3; b = i2 >> 2; c = 0; row0 = (size_t)T_P + b * 64; }
    const int g = w >> 1, i0 = (w & 1) * 32, h = kh * 4 + g;
    bf16x8 qf[2][2];
#pragma unroll
    for (int qt = 0; qt < 2; ++qt) {
#pragma unroll
        for (int ks = 0; ks < 2; ++ks) qf[qt][ks] = *(const bf16x8*)(Qb + (row0 + i0 + qt * 16 + r16) * 1024 + h * 64 + ks * 32 + q4 * 8);
    }
#pragma unroll
    for (int i = 0; i < 3; ++i) {
        const int idx = tid + i * 512, key = idx >> 3, dg = idx & 7;
        u32x4 kv = {0u, 0u, 0u, 0u}, vv = {0u, 0u, 0u, 0u};
        if (!smp) {
            const int pos = c * 64 - 128 + key;
            if (pos >= 0) { const size_t r = (size_t)b * 2048 + pos; kv = *(const u32x4*)(Kb + r * 256 + kh * 64 + dg * 8); vv = *(const u32x4*)(Vb + r * 256 + kh * 64 + dg * 8); }
        } else {
            if (key < 128) {
                const size_t o = ((size_t)(b * 128 + key) * 4 + kh) * 64 + dg * 8;
                const f32x4 k0 = *(const f32x4*)(p.in[2] + o), k1 = *(const f32x4*)(p.in[2] + o + 4), v0 = *(const f32x4*)(p.in[3] + o), v1 = *(const f32x4*)(p.in[3] + o + 4);
                kv.x = cvt_pk_bf16(k0[0], k0[1]); kv.y = cvt_pk_bf16(k0[2], k0[3]); kv.z = cvt_pk_bf16(k1[0], k1[1]); kv.w = cvt_pk_bf16(k1[2], k1[3]);
                vv.x = cvt_pk_bf16(v0[0], v0[1]); vv.y = cvt_pk_bf16(v0[2], v0[3]); vv.z = cvt_pk_bf16(v1[0], v1[1]); vv.w = cvt_pk_bf16(v1[2], v1[3]);
            } else { const size_t r = (size_t)T_P + b * 64 + key - 128; kv = *(const u32x4*)(Kb + r * 256 + kh * 64 + dg * 8); vv = *(const u32x4*)(Vb + r * 256 + kh * 64 + dg * 8); }
        }
        *(LAS u32x4*)(Ks + key * 72 + dg * 8) = kv;
        *(LAS u32x4*)(Vs + key * 72 + dg * 8) = vv;
    }
    __syncthreads();
    const float slope = exp2f(-0.5f * (float)(h + 1));
    const float sink = p.in[11][h];
    const unsigned va = vbase + (unsigned)(((q4 * 4 + (r16 >> 2)) * 72 + 4 * (r16 & 3)) * 2);
#pragma unroll 1
    for (int qt = 0; qt < 2; ++qt) {
        const int i = i0 + qt * 16 + r16;
        const bf16x8 qa = qt ? qf[1][0] : qf[0][0], qb = qt ? qf[1][1] : qf[0][1];
        u32x2 gv[4];
#pragma unroll
        for (int dt = 0; dt < 4; ++dt) gv[dt] = *(const u32x2*)(Yb + (row0 + i) * 2048 + h * 64 + dt * 16 + q4 * 4);
        f32x4 sacc[12];
#pragma unroll
        for (int kt = 0; kt < 12; ++kt) {
            const bf16x8 kf0 = *(const LAS bf16x8*)(Ks + (kt * 16 + r16) * 72 + q4 * 8), kf1 = *(const LAS bf16x8*)(Ks + (kt * 16 + r16) * 72 + 32 + q4 * 8);
            f32x4 a = {0.f, 0.f, 0.f, 0.f}; a = MFMA16(kf0, qa, a); a = MFMA16(kf1, qb, a); sacc[kt] = a;
        }
        float m = -3e38f;
#pragma unroll
        for (int kt = 0; kt < 12; ++kt)
#pragma unroll
            for (int jj = 0; jj < 4; ++jj) {
                const int j = kt * 16 + q4 * 4 + jj;
                float sv = sacc[kt][jj] - slope * fabsf((float)(128 + i - j));
                if (!smp && (c * 64 - 128 + j) < 0) sv = -1e30f;
                sacc[kt][jj] = sv; m = fmaxf(m, sv);
            }
        m = fmaxf(m, __shfl_xor(m, 16)); m = fmaxf(m, __shfl_xor(m, 32)); m = fmaxf(m, sink);
        float l = 0.f;
#pragma unroll
        for (int kt = 0; kt < 12; ++kt)
#pragma unroll
            for (int jj = 0; jj < 4; ++jj) { const float pr = __expf(sacc[kt][jj] - m); sacc[kt][jj] = pr; l += pr; }
        l += __shfl_xor(l, 16); l += __shfl_xor(l, 32); l += __expf(sink - m);
        const float inv = 1.f / l;
        f32x4 oacc[4];
#pragma unroll
        for (int dt = 0; dt < 4; ++dt) oacc[dt] = (f32x4){0.f, 0.f, 0.f, 0.f};
#pragma unroll
        for (int kb = 0; kb < 6; ++kb) {
            const bf16x8 pf = pack8(sacc[2 * kb], sacc[2 * kb + 1]);
            bf16x4 l0, h0, l1, h1, l2, h2, l3, h3;
            const unsigned vk = va + (unsigned)(kb * 32 * 144);
            asm volatile("ds_read_b64_tr_b16 %0, %8\n\tds_read_b64_tr_b16 %1, %8 offset:2304\n\t"
                         "ds_read_b64_tr_b16 %2, %8 offset:32\n\tds_read_b64_tr_b16 %3, %8 offset:2336\n\t"
                         "ds_read_b64_tr_b16 %4, %8 offset:64\n\tds_read_b64_tr_b16 %5, %8 offset:2368\n\t"
                         "ds_read_b64_tr_b16 %6, %8 offset:96\n\tds_read_b64_tr_b16 %7, %8 offset:2400\n\t"
                         "s_waitcnt lgkmcnt(0)"
                         : "=&v"(l0), "=&v"(h0), "=&v"(l1), "=&v"(h1), "=&v"(l2), "=&v"(h2), "=&v"(l3), "=&v"(h3) : "v"(vk) : "memory");
            oacc[0] = MFMA16(cat4(l0, h0), pf, oacc[0]); oacc[1] = MFMA16(cat4(l1, h1), pf, oacc[1]);
            oacc[2] = MFMA16(cat4(l2, h2), pf, oacc[2]); oacc[3] = MFMA16(cat4(l3, h3), pf, oacc[3]);
        }
#pragma unroll
        for (int dt = 0; dt < 4; ++dt) {
            const u32x2 gq = gv[dt];
            const f32x4 o = oacc[dt] * inv;
            u32x2 wv; wv.x = cvt_pk_bf16(o[0] * siluf(bflo(gq.x)), o[1] * siluf(bfhi(gq.x))); wv.y = cvt_pk_bf16(o[2] * siluf(bflo(gq.y)), o[3] * siluf(bfhi(gq.y)));
            *(u32x2*)(Yd + (row0 + i) * ldd + h * 64 + dt * 16 + q4 * 4) = wv;
        }
    }
    __syncthreads();
}

constexpr size_t SC_SQ = 0;
constexpr size_t SC_ET = 9437184;
constexpr size_t SC_AB = 16777216;
static_assert(SC_AB + (size_t)T * 256 * 2 <= (size_t)T * 1024 * 4, "scratch must fit in the y region of d_out");

__device__ __forceinline__ void gla_prep_item(const Params& p, LAS unsigned char* L, int item) {
    unsigned char* ws = p.ws;
    const int tid = threadIdx.x, lane = tid & 63, w = tid >> 6, r16 = lane & 15, q4 = lane >> 4;
    LAS bf16_t* QG = (LAS bf16_t*)L;
    LAS bf16_t* KG = (LAS bf16_t*)(L + 17408);
    LAS bf16_t* Gs = (LAS bf16_t*)(L + 34816);
    LAS float* Gf = (LAS float*)(L + 52224);
    LAS float* GT = (LAS float*)(L + 84992);
    int b, h; unsigned row0;
    if (item < 2048) { h = item & 3; const int c = (item >> 2) & 31; b = item >> 7; row0 = (unsigned)b * 2048 + c * 64; }
    else { const int i2 = item - 2048; h = i2 & 3; b = i2 >> 2; row0 = (unsigned)T_P + b * 64; }
    bf16_t* BQ = (bf16_t*)(ws + WS_BQ); bf16_t* BKb = (bf16_t*)(ws + WS_BK); const bf16_t* GB = (const bf16_t*)(ws + WS_BLR);
    float* ET = (float*)((unsigned char*)p.out + SC_ET); bf16_t* AB = (bf16_t*)((unsigned char*)p.out + SC_AB);
    const int c = tid & 127, tg = tid >> 7;
    const int pt0 = tid >> 4, pt1 = (tid + 512) >> 4, poc = tid & 15;
    const unsigned o0 = (row0 + pt0) * 512u + h * 128 + poc * 8, o1 = (row0 + pt1) * 512u + h * 128 + poc * 8;
    const u32x4 pg0 = *(const u32x4*)(GB + o0), pg1 = *(const u32x4*)(GB + o1);
    const u32x4 pq0 = *(const u32x4*)(BQ + o0), pq1 = *(const u32x4*)(BQ + o1), pk0 = *(const u32x4*)(BKb + o0), pk1 = *(const u32x4*)(BKb + o1);
    *(LAS u32x4*)(Gs + pt0 * 136 + poc * 8) = pg0; *(LAS u32x4*)(Gs + pt1 * 136 + poc * 8) = pg1;
    lds_barrier();
    {
        float cs = 0.f;
#pragma unroll
        for (int tt = 0; tt < 16; ++tt) { cs += bf2f(Gs[(tg * 16 + tt) * 136 + c]); Gf[(tg * 16 + tt) * 128 + c] = cs; }
        GT[tg * 128 + c] = cs;
    }
    lds_barrier();
#pragma unroll
    for (int i = 0; i < 2; ++i) {
        const int t = i ? pt1 : pt0; const int tgp = t >> 4;
        const u32x4 qw = i ? pq1 : pq0, kw = i ? pk1 : pk0;
        float G[8], tot[8];
        { const f32x4 a0 = *(const LAS f32x4*)(Gf + t * 128 + poc * 8), a1 = *(const LAS f32x4*)(Gf + t * 128 + poc * 8 + 4);
          G[0] = a0[0]; G[1] = a0[1]; G[2] = a0[2]; G[3] = a0[3]; G[4] = a1[0]; G[5] = a1[1]; G[6] = a1[2]; G[7] = a1[3]; }
#pragma unroll
        for (int j = 0; j < 8; ++j) tot[j] = 0.f;
#pragma unroll
        for (int g2 = 0; g2 < 4; ++g2) {
            const f32x4 a0 = *(const LAS f32x4*)(GT + g2 * 128 + poc * 8), a1 = *(const LAS f32x4*)(GT + g2 * 128 + poc * 8 + 4);
            const float sel = (g2 < tgp) ? 1.f : 0.f;
            G[0] += sel * a0[0]; G[1] += sel * a0[1]; G[2] += sel * a0[2]; G[3] += sel * a0[3]; G[4] += sel * a1[0]; G[5] += sel * a1[1]; G[6] += sel * a1[2]; G[7] += sel * a1[3];
            tot[0] += a0[0]; tot[1] += a0[1]; tot[2] += a0[2]; tot[3] += a0[3]; tot[4] += a1[0]; tot[5] += a1[1]; tot[6] += a1[2]; tot[7] += a1[3];
        }
        if (i == 0 && tid < 16) {
            float* ep = ET + (size_t)(row0 >> 6) * 512 + h * 128 + poc * 8;
            *(f32x4*)ep = (f32x4){__expf(tot[0]), __expf(tot[1]), __expf(tot[2]), __expf(tot[3])};
            *(f32x4*)(ep + 4) = (f32x4){__expf(tot[4]), __expf(tot[5]), __expf(tot[6]), __expf(tot[7])};
        }
        float qv[8], kv[8];
        unpack8(qw, qv); unpack8(kw, kv);
#pragma unroll
        for (int j = 0; j < 8; ++j) { const float eg = __expf(G[j]); qv[j] *= eg; kv[j] *= rcpf_(eg); }
        u32x4 qo, ko;
        qo.x = cvt_pk_bf16(qv[0], qv[1]); qo.y = cvt_pk_bf16(qv[2], qv[3]); qo.z = cvt_pk_bf16(qv[4], qv[5]); qo.w = cvt_pk_bf16(qv[6], qv[7]);
        ko.x = cvt_pk_bf16(kv[0], kv[1]); ko.y = cvt_pk_bf16(kv[2], kv[3]); ko.z = cvt_pk_bf16(kv[4], kv[5]); ko.w = cvt_pk_bf16(kv[6], kv[7]);
        *(LAS u32x4*)(QG + t * 136 + poc * 8) = qo; *(LAS u32x4*)(KG + t * 136 + poc * 8) = ko;
        *(u32x4*)(BQ + (i ? o1 : o0)) = qo; *(u32x4*)(BKb + (i ? o1 : o0)) = ko;
    }
    lds_barrier();
    {
        const int it = w >> 1, jt0 = (w & 1) * 2;
        f32x4 at[2];
        at[0] = (f32x4){0.f, 0.f, 0.f, 0.f}; at[1] = (f32x4){0.f, 0.f, 0.f, 0.f};
#pragma unroll
        for (int ks = 0; ks < 4; ++ks) {
            const bf16x8 qf = *(const LAS bf16x8*)(QG + (it * 16 + r16) * 136 + ks * 32 + q4 * 8);
#pragma unroll
            for (int t2 = 0; t2 < 2; ++t2) {
                const bf16x8 kf = *(const LAS bf16x8*)(KG + ((jt0 + t2) * 16 + r16) * 136 + ks * 32 + q4 * 8);
                at[t2] = MFMA16(kf, qf, at[t2]);
            }
        }
        const int i = it * 16 + r16;
#pragma unroll
        for (int t2 = 0; t2 < 2; ++t2) {
            f32x4 v = at[t2];
#pragma unroll
            for (int jj = 0; jj < 4; ++jj) { const int j = (jt0 + t2) * 16 + q4 * 4 + jj; if (j > i) v[jj] = 0.f; }
            u32x2 wv; wv.x = cvt_pk_bf16(v[0], v[1]); wv.y = cvt_pk_bf16(v[2], v[3]);
            *(u32x2*)(AB + (size_t)(row0 + i) * 256 + h * 64 + (jt0 + t2) * 16 + q4 * 4) = wv;
        }
    }
    lds_barrier();
}

__device__ __forceinline__ void gla_scan_item(const Params& p, LAS unsigned char* L, int item, bool dummy) {
    unsigned char* ws = p.ws;
    const int tid = threadIdx.x, lane = tid & 63, w = tid >> 6, r16 = lane & 15, q4 = lane >> 4;
    LAS bf16_t* QG = (LAS bf16_t*)L;
    LAS bf16_t* KG = (LAS bf16_t*)(L + 17408);
    LAS bf16_t* Vs = (LAS bf16_t*)(L + 34816);
    LAS bf16_t* As = (LAS bf16_t*)(L + 44032);
    LAS float* GL = (LAS float*)(L + 53248);
    const unsigned lbase = (unsigned)(size_t)L;
    const bool smp = item >= 256;
    const int i2 = smp ? item - 256 : item;
    const int b = i2 >> 4, h = (i2 >> 2) & 3, sl = i2 & 3, e0 = sl * 64;
    const int nch = smp ? 1 : 32;
    const unsigned rbase = smp ? (unsigned)T_P + b * 64 : (unsigned)b * 2048;
    const bf16_t* BQ = (const bf16_t*)(ws + WS_BQ); const bf16_t* BKb = (const bf16_t*)(ws + WS_BK); bf16_t* BV = (bf16_t*)(ws + WS_BV);
    const float* ET = (const float*)((unsigned char*)p.out + SC_ET); const bf16_t* AB = (const bf16_t*)((unsigned char*)p.out + SC_AB); float* BOSQP = dummy ? p.out + 20000000 : (float*)((unsigned char*)p.out + SC_SQ);
    bf16_t* BVo = dummy ? (bf16_t*)((unsigned char*)p.out + 67108864) : BV;
    const int pt0 = tid >> 4, pt1 = (tid + 512) >> 4, poc = tid & 15;
    const int vt = tid >> 3, veo = tid & 7;
    const int et = w & 3, ip = w >> 2;
    f32x4 Sacc[8];
#pragma unroll
    for (int d8 = 0; d8 < 8; ++d8) {
        if (smp) {
#pragma unroll
            for (int jj = 0; jj < 4; ++jj) Sacc[d8][jj] = p.in[4][((size_t)(b * 4 + h) * 128 + d8 * 16 + q4 * 4 + jj) * 256 + e0 + et * 16 + r16];
        } else Sacc[d8] = (f32x4){0.f, 0.f, 0.f, 0.f};
    }
    const int tq_ = r16 >> 2, tp_ = r16 & 3;
    const unsigned v4a = lbase + 34816u + (unsigned)(((q4 * 8 + tq_) * 72 + et * 16 + 4 * tp_) * 2);
    const unsigned k4a = lbase + 17408u + (unsigned)(((q4 * 8 + tq_) * 136 + 4 * tp_) * 2);
    struct Pre { u32x4 q0, q1, k0, k1, a, v; f32x4 e; };
    Pre PA, PB;
    PA.e = (f32x4){0.f, 0.f, 0.f, 0.f}; PB.e = (f32x4){0.f, 0.f, 0.f, 0.f};
#define GLA_PREFETCH(P, R) do { \
        const unsigned o0_ = ((R) + pt0) * 512u + h * 128 + poc * 8, o1_ = ((R) + pt1) * 512u + h * 128 + poc * 8; \
        P.q0 = *(const u32x4*)(BQ + o0_); P.q1 = *(const u32x4*)(BQ + o1_); P.k0 = *(const u32x4*)(BKb + o0_); P.k1 = *(const u32x4*)(BKb + o1_); \
        P.a = *(const u32x4*)(AB + ((R) + vt) * 256u + h * 64 + veo * 8); \
        P.v = *(const u32x4*)(BV + ((R) + vt) * 1024u + h * 256 + e0 + veo * 8); \
        if (tid < 32) P.e = *(const f32x4*)(ET + ((R) >> 6) * 512u + h * 128 + tid * 4); } while (0)
    GLA_PREFETCH(PA, rbase);
    if (nch > 1) GLA_PREFETCH(PB, rbase + 64);
    f32x4 po0 = {0.f, 0.f, 0.f, 0.f}, po1 = {0.f, 0.f, 0.f, 0.f}; unsigned prow = 0; bool pend = false;
#define GLA_STORE_OUT() do { \
            _Pragma("unroll") for (int x2 = 0; x2 < 2; ++x2) { \
                const unsigned row = prow + (ip * 2 + x2) * 16 + r16; \
                const f32x4 o = x2 ? po1 : po0; \
                u32x2 wv; wv.x = cvt_pk_bf16(o[0], o[1]); wv.y = cvt_pk_bf16(o[2], o[3]); \
                *(u32x2*)(BVo + row * 1024u + h * 256 + e0 + et * 16 + q4 * 4) = wv; \
                float ss = o[0] * o[0] + o[1] * o[1] + o[2] * o[2] + o[3] * o[3]; \
                ss += __shfl_xor(ss, 16); ss += __shfl_xor(ss, 32); \
                if (q4 == 0) BOSQP[row * 64u + h * 16 + sl * 4 + et] = ss; \
            } } while (0)
#define GLA_CHUNK(P, CI) do { \
        const unsigned r0 = rbase + (unsigned)(CI) * 64; \
        *(LAS u32x4*)(QG + pt0 * 136 + poc * 8) = P.q0; *(LAS u32x4*)(QG + pt1 * 136 + poc * 8) = P.q1; \
        *(LAS u32x4*)(KG + pt0 * 136 + poc * 8) = P.k0; *(LAS u32x4*)(KG + pt1 * 136 + poc * 8) = P.k1; \
        *(LAS u32x4*)(As + vt * 72 + veo * 8) = P.a; *(LAS u32x4*)(Vs + vt * 72 + veo * 8) = P.v; \
        if (tid < 32) *(LAS f32x4*)(GL + tid * 4) = P.e; \
        lds_barrier(); \
        if (pend) GLA_STORE_OUT(); \
        if ((CI) + 2 < nch) GLA_PREFETCH(P, r0 + 128); \
        bf16x8 vf[2]; \
        { bf16x4 a0, a1, b0, b1; \
          asm volatile("ds_read_b64_tr_b16 %0, %4\n\tds_read_b64_tr_b16 %1, %4 offset:576\n\tds_read_b64_tr_b16 %2, %4 offset:4608\n\tds_read_b64_tr_b16 %3, %4 offset:5184\n\ts_waitcnt lgkmcnt(0)" \
                       : "=&v"(a0), "=&v"(a1), "=&v"(b0), "=&v"(b1) : "v"(v4a) : "memory"); \
          vf[0] = cat4(a0, a1); vf[1] = cat4(b0, b1); } \
        f32x4 ot[2]; \
        ot[0] = (f32x4){0.f, 0.f, 0.f, 0.f}; ot[1] = (f32x4){0.f, 0.f, 0.f, 0.f}; \
        _Pragma("unroll") for (int x2 = 0; x2 < 2; ++x2) \
            _Pragma("unroll") for (int jb = 0; jb < 2; ++jb) { \
                const bf16x8 af = *(const LAS bf16x8*)(As + ((ip * 2 + x2) * 16 + r16) * 72 + jb * 32 + q4 * 8); \
                ot[x2] = MFMA16(vf[jb], af, ot[x2]); } \
        _Pragma("unroll") for (int db = 0; db < 4; ++db) { \
            const bf16x8 sf = pack8(Sacc[2 * db], Sacc[2 * db + 1]); \
            _Pragma("unroll") for (int x2 = 0; x2 < 2; ++x2) { \
                const LAS bf16_t* qp = QG + ((ip * 2 + x2) * 16 + r16) * 136 + db * 32 + q4 * 4; \
                const bf16x8 qv = cat4(*(const LAS bf16x4*)qp, *(const LAS bf16x4*)(qp + 16)); \
                ot[x2] = MFMA16(sf, qv, ot[x2]); } } \
        po0 = ot[0]; po1 = ot[1]; prow = r0; pend = true; \
        _Pragma("unroll") for (int jb = 0; jb < 2; ++jb) { \
            bf16x4 kl[8], kh[8]; \
            const unsigned ka = k4a + (unsigned)(jb * 32 * 272); \
            asm volatile("ds_read_b64_tr_b16 %0, %16 offset:0\n\t" "ds_read_b64_tr_b16 %1, %16 offset:1088\n\t" "ds_read_b64_tr_b16 %2, %16 offset:32\n\t" "ds_read_b64_tr_b16 %3, %16 offset:1120\n\t" "ds_read_b64_tr_b16 %4, %16 offset:64\n\t" "ds_read_b64_tr_b16 %5, %16 offset:1152\n\t" "ds_read_b64_tr_b16 %6, %16 offset:96\n\t" "ds_read_b64_tr_b16 %7, %16 offset:1184\n\t" "ds_read_b64_tr_b16 %8, %16 offset:128\n\t" "ds_read_b64_tr_b16 %9, %16 offset:1216\n\t" "ds_read_b64_tr_b16 %10, %16 offset:160\n\t" "ds_read_b64_tr_b16 %11, %16 offset:1248\n\t" "ds_read_b64_tr_b16 %12, %16 offset:192\n\t" "ds_read_b64_tr_b16 %13, %16 offset:1280\n\t" "ds_read_b64_tr_b16 %14, %16 offset:224\n\t" "ds_read_b64_tr_b16 %15, %16 offset:1312\n\t" "s_waitcnt lgkmcnt(0)" \
                         : "=&v"(kl[0]), "=&v"(kh[0]), "=&v"(kl[1]), "=&v"(kh[1]), "=&v"(kl[2]), "=&v"(kh[2]), "=&v"(kl[3]), "=&v"(kh[3]), "=&v"(kl[4]), "=&v"(kh[4]), "=&v"(kl[5]), "=&v"(kh[5]), "=&v"(kl[6]), "=&v"(kh[6]), "=&v"(kl[7]), "=&v"(kh[7]) : "v"(ka) : "memory"); \
            _Pragma("unroll") for (int d8 = 0; d8 < 8; ++d8) Sacc[d8] = MFMA16(cat4(kl[d8], kh[d8]), vf[jb], Sacc[d8]); } \
        _Pragma("unroll") for (int d8 = 0; d8 < 8; ++d8) { \
            const f32x4 dec = *(const LAS f32x4*)(GL + d8 * 16 + q4 * 4); \
            Sacc[d8] = Sacc[d8] * dec; } \
        lds_barrier(); \
    } while (0)
    for (int ci = 0; ci < nch; ci += 2) {
        GLA_CHUNK(PA, ci);
        if (ci + 1 < nch) GLA_CHUNK(PB, ci + 1);
    }
    if (pend) GLA_STORE_OUT();
#undef GLA_STORE_OUT
#undef GLA_PREFETCH
#undef GLA_CHUNK
    if (ip == 0 && !dummy) {
        float* og = p.out + (smp ? O_GS : O_GP);
#pragma unroll
        for (int d8 = 0; d8 < 8; ++d8)
#pragma unroll
            for (int jj = 0; jj < 4; ++jj) og[((size_t)(b * 4 + h) * 128 + d8 * 16 + q4 * 4 + jj) * 256 + e0 + et * 16 + r16] = Sacc[d8][jj];
    }
}

__device__ __forceinline__ void phase2a(const Params& p, LAS unsigned char* L) {
#ifndef NO_PREP
    for (int it = blockIdx.x; it < 2176; it += gridDim.x) gla_prep_item(p, L, it);
#endif
#ifndef NO_ATTN
    for (int it = blockIdx.x; it < 2176; it += gridDim.x) attn_item(p, L, it, (bf16_t*)(p.ws + WS_GATE), 2048);
#endif
}
__device__ __forceinline__ void phase2b(const Params& p, LAS unsigned char* L) {
#ifndef NO_SCAN
#ifdef PROBE_SCAN2
    for (int it = blockIdx.x; it < 768; it += gridDim.x) gla_scan_item(p, L, it, true);
#endif
    if (gridDim.x == 256) {
        const int xcd = blockIdx.x & 7, loc = blockIdx.x >> 3;
        const int base = (xcd * 8 + (loc >> 2)) * 4 + (loc & 3);
        gla_scan_item(p, L, base, false); gla_scan_item(p, L, 256 + base, false); gla_scan_item(p, L, 512 + base, false);
    } else {
        for (int it = blockIdx.x; it < 768; it += gridDim.x) gla_scan_item(p, L, it, false);
    }
#endif
}

__device__ __forceinline__ void phase3(const Params& p) {
    unsigned char* ws = p.ws;
    const bf16_t* BV = (const bf16_t*)(ws + WS_BV); bf16_t* Yb = (bf16_t*)(ws + WS_GATE); const float* BOSQP = (const float*)((unsigned char*)p.out + SC_SQ);
    const float* gg = p.in[12];
    const long gtid = (long)blockIdx.x * NTHR + threadIdx.x, gsz = (long)gridDim.x * NTHR;
    const long total = (long)T * 128;
    for (long it = gtid; it < total; it += gsz) {
        const long row = it >> 7; const int c8 = (int)(it & 127) * 8, h = c8 >> 8;
        float sq;
        { const f32x4 s0 = *(const f32x4*)(BOSQP + row * 64 + h * 16), s1 = *(const f32x4*)(BOSQP + row * 64 + h * 16 + 4), s2 = *(const f32x4*)(BOSQP + row * 64 + h * 16 + 8), s3 = *(const f32x4*)(BOSQP + row * 64 + h * 16 + 12);
          sq = ((s0[0] + s0[1]) + (s0[2] + s0[3])) + ((s1[0] + s1[1]) + (s1[2] + s1[3])) + ((s2[0] + s2[1]) + (s2[2] + s2[3])) + ((s3[0] + s3[1]) + (s3[2] + s3[3])); }
        const float rs = rsqrtf(sq * (1.f / 256.f) + EPS);
        const u32x4 bo = *(const u32x4*)(BV + row * 1024 + c8);
        const u32x4 gt = *(const u32x4*)(Yb + row * 2048 + 1024 + c8);
        const f32x4 g0 = *(const f32x4*)(gg + (c8 & 255)), g1 = *(const f32x4*)(gg + (c8 & 255) + 4);
        u32x4 o;
        o.x = cvt_pk_bf16(bflo(bo.x) * rs * g0[0] * siluf(bflo(gt.x)), bfhi(bo.x) * rs * g0[1] * siluf(bfhi(gt.x)));
        o.y = cvt_pk_bf16(bflo(bo.y) * rs * g0[2] * siluf(bflo(gt.y)), bfhi(bo.y) * rs * g0[3] * siluf(bfhi(gt.y)));
        o.z = cvt_pk_bf16(bflo(bo.z) * rs * g1[0] * siluf(bflo(gt.z)), bfhi(bo.z) * rs * g1[1] * siluf(bfhi(gt.z)));
        o.w = cvt_pk_bf16(bflo(bo.w) * rs * g1[2] * siluf(bflo(gt.w)), bfhi(bo.w) * rs * g1[3] * siluf(bfhi(gt.w)));
        *(u32x4*)(Yb + row * 2048 + 1024 + c8) = o;
    }
}

__device__ __forceinline__ void lru_item(const Params& p, LAS unsigned char* L, int item) {
    unsigned char* ws = p.ws;
    const int tid = threadIdx.x, lane = tid & 63, w = tid >> 6, r16 = lane & 15, q4 = lane >> 4;
    LAS bf16_t* Wl = (LAS bf16_t*)L;
    LAS bf16_t* U = (LAS bf16_t*)(L + 76800);
    LAS float* Aa = (LAS float*)(L + 102400);
    LAS float* Bb = (LAS float*)(L + 126976);
    LAS float* SP = (LAS float*)(L + 151552);
    LAS float* SH = (LAS float*)(L + 153088);
    LAS float* HC = (LAS float*)(L + 154624);
    LAS float* CW = (LAS float*)(L + 155392);
    const bool smp = item >= 256;
    const int i2 = smp ? item - 256 : item;
    const int b = i2 >> 4, nb = (i2 >> 1) & 7, hf = i2 & 1;
    const int nch = smp ? 1 : 32;
    const unsigned rbase = smp ? (unsigned)T_P + b * 64 : (unsigned)b * 2048;
    const bf16_t* Z2 = (const bf16_t*)(ws + WS_Z2); bf16_t* Y2 = (bf16_t*)(ws + WS_Y2);
    const bf16_t* WA = (const bf16_t*)(ws + WS_WA) + nb * 192 * 192; const bf16_t* WI = (const bf16_t*)(ws + WS_WI) + nb * 192 * 192;
    for (int idx = tid; idx < 192 * 24; idx += NTHR) {
        const int r = idx / 24, g8 = idx % 24;
        const bf16_t* src = (r < 96) ? WA + (size_t)(hf * 96 + r) * 192 + g8 * 8 : WI + (size_t)(hf * 96 + r - 96) * 192 + g8 * 8;
        *(LAS u32x4*)(Wl + r * 200 + g8 * 8) = *(const u32x4*)src;
    }
    const bool cthr = tid < 384;
    const int cgp = tid % 24, tq = (tid / 24) & 15;
    const int chc = nb * 192 + cgp * 8;
    for (int idx = tid; idx < 5 * 192; idx += NTHR) { const int j = idx / 192, cc = idx % 192; CW[idx] = (j < 4) ? p.in[16][j * 1536 + nb * 192 + cc] : p.in[17][nb * 192 + cc]; }
    const int mt = w & 3, pg = w >> 2;
    float bra[3], bri[3], sp[3];
#pragma unroll
    for (int cp = 0; cp < 3; ++cp) {
        const int ch = nb * 192 + hf * 96 + (pg * 3 + cp) * 16 + r16;
        bra[cp] = p.in[19][ch]; bri[cp] = p.in[21][ch];
        const float lam = p.in[22][ch];
        sp[cp] = 8.f * (fmaxf(-lam, 0.f) + log1pf(__expf(-fabsf(lam))));
    }
    if (tid < 96) HC[tid] = smp ? p.in[6][b * 1536 + nb * 192 + hf * 96 + tid] : 0.f;
    const int sch0 = tid % 96, sseg0 = (tid / 96) & 3;
    const int ot0 = tid / 12, og0 = tid % 12, ot1 = (tid + 512) / 12, og1 = (tid + 512) % 12;
    const bool o1 = tid < 256;
    const int och0 = nb * 192 + hf * 96 + og0 * 8, och1 = nb * 192 + hf * 96 + og1 * 8;
    lds_barrier();
    u32x4 xr[7]; u32x4 pg0, pg1 = {0u, 0u, 0u, 0u};
#pragma unroll
    for (int r = 0; r < 7; ++r) {
        xr[r] = (u32x4){0u, 0u, 0u, 0u};
        const int pos = 4 * tq - 3 + r;
        if (cthr) {
            if (pos >= 0) xr[r] = *(const u32x4*)(Z2 + (unsigned)((rbase + pos) * 3072u + chc));
            else if (smp) {
                const float* hp = p.in[5] + ((size_t)b * 3 + (3 + pos)) * 1536 + chc;
                const f32x4 h0 = *(const f32x4*)hp, h1 = *(const f32x4*)(hp + 4);
                xr[r].x = cvt_pk_bf16(h0[0], h0[1]); xr[r].y = cvt_pk_bf16(h0[2], h0[3]); xr[r].z = cvt_pk_bf16(h1[0], h1[1]); xr[r].w = cvt_pk_bf16(h1[2], h1[3]);
            }
        }
    }
    pg0 = *(const u32x4*)(Z2 + (unsigned)((rbase + ot0) * 3072u + 1536 + och0));
    if (o1) pg1 = *(const u32x4*)(Z2 + (unsigned)((rbase + ot1) * 3072u + 1536 + och1));
    u32x4 so0 = {0u, 0u, 0u, 0u}, so1 = {0u, 0u, 0u, 0u}; unsigned sr = 0; bool spend = false;
    for (int ci = 0; ci < nch; ++ci) {
        const unsigned r0 = rbase + (unsigned)ci * 64;
        const bool more = (ci + 1 < nch);
        int sch = sch0, sseg = sseg0;
        asm volatile("" : "+v"(sch), "+v"(sseg));
        if (cthr) {
            float xv[7][8];
#pragma unroll
            for (int r = 0; r < 7; ++r) unpack8(xr[r], xv[r]);
            if (hf == 0 && !more && tq == 15) {
                float* oc = p.out + (smp ? O_CS : O_CP) + (size_t)b * 3 * 1536 + chc;
#pragma unroll
                for (int r = 0; r < 3; ++r) { *(f32x4*)(oc + r * 1536) = (f32x4){xv[4 + r][0], xv[4 + r][1], xv[4 + r][2], xv[4 + r][3]}; *(f32x4*)(oc + r * 1536 + 4) = (f32x4){xv[4 + r][4], xv[4 + r][5], xv[4 + r][6], xv[4 + r][7]}; }
            }
            float cw[5][8];
#pragma unroll
            for (int j = 0; j < 5; ++j) { const f32x4 c0 = *(const LAS f32x4*)(CW + j * 192 + cgp * 8), c1 = *(const LAS f32x4*)(CW + j * 192 + cgp * 8 + 4);
                cw[j][0] = c0[0]; cw[j][1] = c0[1]; cw[j][2] = c0[2]; cw[j][3] = c0[3]; cw[j][4] = c1[0]; cw[j][5] = c1[1]; cw[j][6] = c1[2]; cw[j][7] = c1[3]; }
#pragma unroll
            for (int tk = 0; tk < 4; ++tk) {
                float acc[8];
#pragma unroll
                for (int e = 0; e < 8; ++e) acc[e] = cw[4][e] + xv[tk][e] * cw[0][e] + xv[tk + 1][e] * cw[1][e] + xv[tk + 2][e] * cw[2][e] + xv[tk + 3][e] * cw[3][e];
                u32x4 uw; uw.x = cvt_pk_bf16(acc[0], acc[1]); uw.y = cvt_pk_bf16(acc[2], acc[3]); uw.z = cvt_pk_bf16(acc[4], acc[5]); uw.w = cvt_pk_bf16(acc[6], acc[7]);
                *(LAS u32x4*)(U + (4 * tq + tk) * 200 + cgp * 8) = uw;
            }
            if (more) {
#pragma unroll
                for (int r = 0; r < 7; ++r) xr[r] = *(const u32x4*)(Z2 + (unsigned)((r0 + 64 + 4 * tq - 3 + r) * 3072u + chc));
            }
        }
        lds_barrier();
        if (spend) { *(u32x4*)(Y2 + (unsigned)((sr + ot0) * 1536u + och0)) = so0; if (o1) *(u32x4*)(Y2 + (unsigned)((sr + ot1) * 1536u + och1)) = so1; }
        f32x4 ga[3], gi[3];
#pragma unroll
        for (int cp = 0; cp < 3; ++cp) { ga[cp] = (f32x4){0.f, 0.f, 0.f, 0.f}; gi[cp] = (f32x4){0.f, 0.f, 0.f, 0.f}; }
#pragma unroll 2
        for (int ks = 0; ks < 6; ++ks) {
            const bf16x8 uf = *(const LAS bf16x8*)(U + (mt * 16 + r16) * 200 + ks * 32 + q4 * 8);
#pragma unroll
            for (int cp = 0; cp < 3; ++cp) {
                const int ct = pg * 3 + cp;
                const bf16x8 wa = *(const LAS bf16x8*)(Wl + (ct * 16 + r16) * 200 + ks * 32 + q4 * 8), wi = *(const LAS bf16x8*)(Wl + (96 + ct * 16 + r16) * 200 + ks * 32 + q4 * 8);
                ga[cp] = MFMA16(uf, wa, ga[cp]); gi[cp] = MFMA16(uf, wi, gi[cp]);
            }
        }
#pragma unroll
        for (int cp = 0; cp < 3; ++cp) {
            const int cl = (pg * 3 + cp) * 16 + r16;
#pragma unroll
            for (int jj = 0; jj < 4; ++jj) {
                const int t = mt * 16 + q4 * 4 + jj;
                const float rg = sigmf(ga[cp][jj] + bra[cp]), ig = sigmf(gi[cp][jj] + bri[cp]);
                const float z = rg * sp[cp];
                const float a = __expf(-z);
                const float z2 = z + z;
                const float om = (z2 < 0.05f) ? z2 * (1.f - z2 * (0.5f - z2 * (0.16666667f - z2 * 0.041666668f))) : 1.f - a * a;
                const float uu = bf2f(U[t * 200 + hf * 96 + cl]);
                Aa[t * 96 + cl] = a; Bb[t * 96 + cl] = __builtin_amdgcn_sqrtf(om) * ig * uu;
            }
        }
        lds_barrier();
        if (cthr) {
            float P = 1.f, H = 0.f;
#pragma unroll
            for (int t = 0; t < 16; ++t) { const float a = Aa[(sseg * 16 + t) * 96 + sch]; H = a * H + Bb[(sseg * 16 + t) * 96 + sch]; P *= a; }
            SP[sseg * 96 + sch] = P; SH[sseg * 96 + sch] = H;
        }
        lds_barrier();
        if (cthr) {
            float hh = HC[(ci & 1) * 96 + sch];
#pragma unroll
            for (int sg = 0; sg < 3; ++sg) if (sg < sseg) hh = SP[sg * 96 + sch] * hh + SH[sg * 96 + sch];
#pragma unroll
            for (int t = 0; t < 16; ++t) { hh = Aa[(sseg * 16 + t) * 96 + sch] * hh + Bb[(sseg * 16 + t) * 96 + sch]; Bb[(sseg * 16 + t) * 96 + sch] = hh; }
            if (sseg == 3) HC[((ci + 1) & 1) * 96 + sch] = hh;
        }
        lds_barrier();
        {
            const f32x4 h0 = *(const LAS f32x4*)(Bb + ot0 * 96 + og0 * 8), h1 = *(const LAS f32x4*)(Bb + ot0 * 96 + og0 * 8 + 4);
            u32x4 o;
            o.x = cvt_pk_bf16(h0[0] * siluf(bflo(pg0.x)), h0[1] * siluf(bfhi(pg0.x)));
            o.y = cvt_pk_bf16(h0[2] * siluf(bflo(pg0.y)), h0[3] * siluf(bfhi(pg0.y)));
            o.z = cvt_pk_bf16(h1[0] * siluf(bflo(pg0.z)), h1[1] * siluf(bfhi(pg0.z)));
            o.w = cvt_pk_bf16(h1[2] * siluf(bflo(pg0.w)), h1[3] * siluf(bfhi(pg0.w)));
            so0 = o;
            if (more) pg0 = *(const u32x4*)(Z2 + (unsigned)((r0 + 64 + ot0) * 3072u + 1536 + och0));
        }
        if (o1) {
            const f32x4 h0 = *(const LAS f32x4*)(Bb + ot1 * 96 + og1 * 8), h1 = *(const LAS f32x4*)(Bb + ot1 * 96 + og1 * 8 + 4);
            u32x4 o;
            o.x = cvt_pk_bf16(h0[0] * siluf(bflo(pg1.x)), h0[1] * siluf(bfhi(pg1.x)));
            o.y = cvt_pk_bf16(h0[2] * siluf(bflo(pg1.y)), h0[3] * siluf(bfhi(pg1.y)));
            o.z = cvt_pk_bf16(h1[0] * siluf(bflo(pg1.z)), h1[1] * siluf(bfhi(pg1.z)));
            o.w = cvt_pk_bf16(h1[2] * siluf(bflo(pg1.w)), h1[3] * siluf(bfhi(pg1.w)));
            so1 = o;
            if (more) pg1 = *(const u32x4*)(Z2 + (unsigned)((r0 + 64 + ot1) * 3072u + 1536 + och1));
        }
        sr = r0; spend = true;
        lds_barrier();
    }
    if (spend) { *(u32x4*)(Y2 + (unsigned)((sr + ot0) * 1536u + och0)) = so0; if (o1) *(u32x4*)(Y2 + (unsigned)((sr + ot1) * 1536u + och1)) = so1; }
    if (tid < 96) p.out[(smp ? O_LS : O_LP) + (size_t)b * 1536 + nb * 192 + hf * 96 + tid] = HC[(nch & 1) * 96 + tid];
    lds_barrier();
}

__device__ __forceinline__ void phase6(const Params& p, LAS unsigned char* L) {
    if (gridDim.x == 256) {
        const int xcd = blockIdx.x & 7, loc = blockIdx.x >> 3;
        const int pair = xcd * 16 + (loc >> 1), hf = loc & 1;
        lru_item(p, L, pair * 2 + hf); lru_item(p, L, 256 + pair * 2 + hf); lru_item(p, L, 512 + pair * 2 + hf);
    } else {
        for (int it = blockIdx.x; it < 768; it += gridDim.x) lru_item(p, L, it);
    }
}

__device__ __forceinline__ void phase8(const Params& p) {
    const float* rsq = (const float*)(p.ws + WS_RSQ2); const float* g = p.in[24]; float* y = p.out; const bf16_t* xb = (const bf16_t*)(p.ws + WS_XB);
    const long gtid = (long)blockIdx.x * NTHR + threadIdx.x, gsz = (long)gridDim.x * NTHR;
    const long total = (long)T * 128;
    for (long it = gtid; it < total; it += gsz) {
        const long row = it >> 7; const int c8 = (int)(it & 127) * 8;
        const float rs = rsqrtf(rsq[row] * (1.f / 1024.f) + EPS);
        const u32x4 xw = *(const u32x4*)(xb + row * 1024 + c8);
        const f32x4 g0 = *(const f32x4*)(g + c8), g1 = *(const f32x4*)(g + c8 + 4);
        f32x4 o0, o1;
        o0[0] = bflo(xw.x) * rs * g0[0]; o0[1] = bfhi(xw.x) * rs * g0[1]; o0[2] = bflo(xw.y) * rs * g0[2]; o0[3] = bfhi(xw.y) * rs * g0[3];
        o1[0] = bflo(xw.z) * rs * g1[0]; o1[1] = bfhi(xw.z) * rs * g1[1]; o1[2] = bflo(xw.w) * rs * g1[2]; o1[3] = bfhi(xw.w) * rs * g1[3];
        *(f32x4*)(y + row * 1024 + c8) = o0; *(f32x4*)(y + row * 1024 + c8 + 4) = o1;
    }
}

#define XB_TMO      128
#define XB_XCNT(j)  (256  + 64 * (j))
#define XB_XSUB(j)  (1280 + 64 * (j))
#define XB_XGEN(j)  (2304 + 64 * (j))
#define XB_TOP      3328
#define XB_TOPGEN   3392
#define XCD_BAR_WORDS 3456
#define XB_SPIN_CAP (1u << 18)
__device__ __forceinline__ unsigned xb_ld(unsigned* p)              { return __hip_atomic_load(p, __ATOMIC_RELAXED, __HIP_MEMORY_SCOPE_AGENT); }
__device__ __forceinline__ unsigned xb_add(unsigned* p, unsigned v) { return __hip_atomic_fetch_add(p, v, __ATOMIC_RELAXED, __HIP_MEMORY_SCOPE_AGENT); }
__device__ __forceinline__ unsigned xb_xcc_id() { return (unsigned)__builtin_amdgcn_s_getreg((3 << 11) | 20) & 0xFu; }
#define XB_SPIN(cond, bar) do { unsigned _sp = 0; while (cond) { __builtin_amdgcn_s_sleep(1); \
    if ((++_sp & 255u) == 0u) { if (xb_ld(&(bar)[XB_TMO])) break; if (_sp > XB_SPIN_CAP) { atomicAdd(&(bar)[XB_TMO], 1u); break; } } } } while (0)
struct XcdBarrier { unsigned* bar; unsigned x; volatile LAS unsigned* st; };
__device__ __forceinline__ XcdBarrier xcd_barrier_post(unsigned* bar, volatile LAS unsigned* st) {
    XcdBarrier b; b.bar = bar; b.x = xb_xcc_id(); b.st = st;
    if (threadIdx.x == 0) (void)xb_add(&bar[XB_XCNT(b.x)], 1u);
    return b;
}
__device__ __forceinline__ void xcd_barrier_complete(unsigned* bar, unsigned x, unsigned& nloc, unsigned& nx) {
    const unsigned G = gridDim.x * gridDim.y * gridDim.z;
    unsigned sum, cnt, mine, sp = 0u;
    for (;;) {
        sum = 0u; cnt = 0u; mine = 0u;
#pragma unroll
        for (unsigned j = 0; j < 16; ++j) { const unsigned c = xb_ld(&bar[XB_XCNT(j)]); sum += c; cnt += (c > 0u) ? 1u : 0u; mine = (j == x) ? c : mine; }
        if (sum == G) break;
        __builtin_amdgcn_s_sleep(1);
        if ((++sp & 255u) == 0u) { if (xb_ld(&bar[XB_TMO])) break; if (sp > XB_SPIN_CAP) { atomicAdd(&bar[XB_TMO], 1u); break; } }
    }
    nloc = mine > 0u ? mine : 1u; nx = cnt > 0u ? cnt : 1u;
}
__device__ __forceinline__ void xcd_barrier(const XcdBarrier& b) {
    asm volatile("s_waitcnt vmcnt(0)" ::: "memory");
    __syncthreads();
    if (threadIdx.x == 0) {
        unsigned* bar = b.bar;
        __builtin_amdgcn_s_waitcnt(0);
        unsigned nloc = b.st[0], nx = b.st[1];
        if (nloc == 0u) { xcd_barrier_complete(bar, b.x, nloc, nx); b.st[0] = nloc; b.st[1] = nx; }
        const unsigned old = xb_add(&bar[XB_XSUB(b.x)], 1u);
        const unsigned gen = old / nloc;
        if (old + 1u == (gen + 1u) * nloc) {
            __builtin_amdgcn_fence(__ATOMIC_RELEASE, "agent");
            asm volatile("s_waitcnt vmcnt(0)" ::: "memory");
            const unsigned og = xb_add(&bar[XB_TOP], 1u);
            const unsigned tg = og / nx;
            if (og + 1u == (tg + 1u) * nx) xb_add(&bar[XB_TOPGEN], 1u);
            else XB_SPIN(xb_ld(&bar[XB_TOPGEN]) == tg, bar);
            __builtin_amdgcn_fence(__ATOMIC_ACQUIRE, "agent");
            xb_add(&bar[XB_XGEN(b.x)], 1u);
            asm volatile("s_waitcnt vmcnt(0)" ::: "memory");
        } else {
            XB_SPIN(xb_ld(&bar[XB_XGEN(b.x)]) == gen, bar);
            __builtin_amdgcn_fence(__ATOMIC_ACQUIRE, "agent");
            asm volatile("s_waitcnt vmcnt(0)" ::: "memory");
        }
    }
    __syncthreads();
}

__global__ void __launch_bounds__(NTHR) mega(Params p) {
    extern __shared__ __attribute__((aligned(16))) unsigned char lds_raw[];
    LAS unsigned char* L = (LAS unsigned char*)lds_raw;
    cg::grid_group grid = cg::this_grid();
    unsigned char* ws = p.ws;
    const int lo = p.ph_lo, hi = p.ph_hi;
    LAS unsigned* stw = (LAS unsigned*)(L + (LDS_BYTES - 16));
    if (threadIdx.x < 4) stw[threadIdx.x] = 0u;
    __syncthreads();
    const XcdBarrier xb = xcd_barrier_post((unsigned*)(ws + WS_BAR), (volatile LAS unsigned*)stw);
#ifndef PHMASK
#define PHMASK 0x1ff
#endif
#define IN(k) (((PHMASK >> (k)) & 1) && lo <= (k) && (k) < hi)
#define SEAM(k) do { if (IN(k) && IN((k) + 1)) xcd_barrier(xb); } while (0)
    if (hi > 1000) grid.sync();
    if (IN(0)) phase0(p);
    SEAM(0);
    if (IN(1)) {
        pg8::Gemm g{(const bf16_t*)(ws + WS_XB), (const bf16_t*)(ws + WS_WINE), T, NE_PAD, 1024};
        pg8::StaticOrder S; S.init(T, NE_PAD, gridDim.x, blockIdx.x);
        EpiInEven E{ws, p.out, (const float*)(ws + WS_RSTD0), p.in[10]};
        pg8::gemm_phase<EpiInEven>(L, g, S, E);
    }
    SEAM(1);
    if (IN(2)) { phase2a(p, L); xcd_barrier(xb); phase2b(p, L); }
    SEAM(2);
    if (IN(3)) phase3(p);
    SEAM(3);
    if (IN(4)) {
        pg8::Gemm g{(const bf16_t*)(ws + WS_GATE), (const bf16_t*)(ws + WS_WOUTE), T, 1024, 2048};
        pg8::StaticOrder S; S.init(T, 1024, gridDim.x, blockIdx.x);
        EpiOutResB E{(bf16_t*)(ws + WS_XB), (float*)(ws + WS_RSQ1)};
        pg8::gemm_phase<EpiOutResB>(L, g, S, E);
    }
    SEAM(4);
    if (IN(5)) {
        pg8::Gemm g{(const bf16_t*)(ws + WS_XB), (const bf16_t*)(ws + WS_WINO), T, 3072, 1024};
        pg8::StaticOrder S; S.init(T, 3072, gridDim.x, blockIdx.x);
        EpiInOdd E{(bf16_t*)(ws + WS_Z2), (const float*)(ws + WS_RSQ1)};
        pg8::gemm_phase<EpiInOdd>(L, g, S, E);
    }
    SEAM(5);
    if (IN(6)) phase6(p, L);
    SEAM(6);
    if (IN(7)) {
        pg8::Gemm g{(const bf16_t*)(ws + WS_Y2), (const bf16_t*)(ws + WS_WOUTO), T, 1024, 1536};
        pg8::StaticOrder S; S.init(T, 1024, gridDim.x, blockIdx.x);
        EpiOutResB E{(bf16_t*)(ws + WS_XB), (float*)(ws + WS_RSQ2)};
        pg8::gemm_phase<EpiOutResB>(L, g, S, E);
    }
    SEAM(7);
    if (IN(8)) phase8(p);
#undef IN
#undef SEAM
}

extern "C" void kernel_launch(void* const* d_in, const int* in_sizes, int n_in, void* d_out, int out_size, void* d_ws, size_t ws_size, hipStream_t stream) {
    static int grid_blocks = 0;
    if (grid_blocks == 0) {
        if (n_in != 25 || (size_t)out_size != O_END || ws_size < WS_TOTAL) { fprintf(stderr, "kernel_launch: unexpected shapes n_in %d out %d ws %zu (need %zu)\n", n_in, out_size, ws_size, (size_t)WS_END); grid_blocks = -1; return; }
        int dev = 0, cus = 0, per_cu = 0;
        (void)hipGetDevice(&dev);
        (void)hipDeviceGetAttribute(&cus, hipDeviceAttributeMultiprocessorCount, dev);
        if (hipFuncSetAttribute((const void*)mega, hipFuncAttributeMaxDynamicSharedMemorySize, LDS_BYTES) != hipSuccess) { fprintf(stderr, "kernel_launch: hipFuncSetAttribute failed\n"); }
        if (hipOccupancyMaxActiveBlocksPerMultiprocessor(&per_cu, (const void*)mega, NTHR, LDS_BYTES) != hipSuccess || per_cu < 1) per_cu = 1;
        (void)hipGetLastError();
        grid_blocks = cus * per_cu;
        if (grid_blocks <= 0) grid_blocks = 256;
    }
    if (grid_blocks < 0) return;
    Params p{};
    for (int i = 0; i < 25; ++i) p.in[i] = (const float*)d_in[i];
    p.out = (float*)d_out; p.ws = (unsigned char*)d_ws;
#if ONE_LAUNCH
#ifdef PROBE_X
    { const int seq[3][2] = {{0, PROBE_Y + 1}, {PROBE_X, PROBE_Y + 1}, {PROBE_Y + 1, 9}};
      for (int li = 0; li < 3; ++li) { if (seq[li][0] >= seq[li][1]) continue; p.ph_lo = seq[li][0]; p.ph_hi = seq[li][1]; void* args[] = {&p};
        (void)hipMemsetAsync((char*)d_ws + WS_BAR, 0, 16384, stream);
        hipError_t e = hipLaunchCooperativeKernel((const void*)mega, dim3(grid_blocks), dim3(NTHR), args, LDS_BYTES, stream);
        if (e != hipSuccess) fprintf(stderr, "cooperative launch failed: %s (grid %d)\n", hipGetErrorString(e), grid_blocks); } }
#else
    p.ph_lo = 0; p.ph_hi = 9;
    (void)hipMemsetAsync((char*)d_ws + WS_BAR, 0, 16384, stream);
    { void* args[] = {&p}; hipError_t e = hipLaunchCooperativeKernel((const void*)mega, dim3(grid_blocks), dim3(NTHR), args, LDS_BYTES, stream);
      if (e != hipSuccess) fprintf(stderr, "cooperative launch failed: %s (grid %d)\n", hipGetErrorString(e), grid_blocks); }
#endif
#else
    for (int ph = 0; ph < 9; ++ph) {
        p.ph_lo = ph; p.ph_hi = ph + 1;
        (void)hipMemsetAsync((char*)d_ws + WS_BAR, 0, 16384, stream);
        void* args[] = {&p}; hipError_t e = hipLaunchCooperativeKernel((const void*)mega, dim3(grid_blocks), dim3(NTHR), args, LDS_BYTES, stream);
        if (e != hipSuccess) fprintf(stderr, "cooperative launch %d failed: %s (grid %d)\n", ph, hipGetErrorString(e), grid_blocks);
    }
#endif
}
```

```cpp
#include <hip/hip_runtime.h>
#include <hip/hip_cooperative_groups.h>
#include <cstdio>
namespace cg = cooperative_groups;

#ifndef ONE_LAUNCH
#define ONE_LAUNCH 1
#endif

#define LAS __attribute__((address_space(3)))
typedef unsigned short bf16_t;
typedef short bf16x8 __attribute__((ext_vector_type(8)));
typedef short bf16x4 __attribute__((ext_vector_type(4)));
typedef float f32x4 __attribute__((ext_vector_type(4)));
typedef unsigned u32x4 __attribute__((ext_vector_type(4)));
typedef unsigned u32x2 __attribute__((ext_vector_type(2)));

constexpr int T_P = 32768, T_S = 2048, T = T_P + T_S, DM = 1024;
constexpr int NE_PAD = 6144;
constexpr int LDS_BYTES = 159744;
constexpr int NTHR = 512;
constexpr float EPS = 1e-6f;

constexpr size_t WS_WINE = 0;
constexpr size_t WS_WOUTE = WS_WINE + (size_t)NE_PAD * 1024 * 2;
constexpr size_t WS_WINO = WS_WOUTE + (size_t)1024 * 2048 * 2;
constexpr size_t WS_WOUTO = WS_WINO + (size_t)3072 * 1024 * 2;
constexpr size_t WS_WA = WS_WOUTO + (size_t)1024 * 1536 * 2;
constexpr size_t WS_WI = WS_WA + (size_t)8 * 192 * 192 * 2;
constexpr size_t WS_XB = WS_WI + (size_t)8 * 192 * 192 * 2;
constexpr size_t WS_RSTD0 = WS_XB + (size_t)T * 1024 * 2;
constexpr size_t WS_RSQ1 = WS_RSTD0 + (size_t)T * 4;
constexpr size_t WS_RSQ2 = WS_RSQ1 + (size_t)T * 4;
constexpr size_t WS_BOSQ = WS_RSQ2 + (size_t)T * 4;
constexpr size_t WS_Q = WS_BOSQ + (size_t)T * 16;
constexpr size_t WS_K = WS_Q + (size_t)T * 1024 * 2;
constexpr size_t WS_V = WS_K + (size_t)T * 256 * 2;
constexpr size_t WS_BQ = WS_V + (size_t)T * 256 * 2;
constexpr size_t WS_BK = WS_BQ + (size_t)T * 512 * 2;
constexpr size_t WS_BV = WS_BK + (size_t)T * 512 * 2;
constexpr size_t WS_GATE = WS_BV + (size_t)T * 1024 * 2;
constexpr size_t WS_BLR = WS_GATE + (size_t)T * 2048 * 2;
constexpr size_t WS_END = WS_BLR + (size_t)T * 512 * 2;
constexpr size_t WS_BAR = WS_END;
constexpr size_t WS_TOTAL = WS_BAR + 16384;
constexpr size_t WS_Z2 = WS_Q;
constexpr size_t WS_Y2 = WS_GATE;
static_assert(WS_Z2 + (size_t)T * 3072 * 2 <= WS_GATE, "Z2 alias");

constexpr size_t O_Y = 0;
constexpr size_t O_KP = (size_t)T * 1024;
constexpr size_t O_VP = O_KP + 524288;
constexpr size_t O_GP = O_VP + 524288;
constexpr size_t O_CP = O_GP + 2097152;
constexpr size_t O_LP = O_CP + 73728;
constexpr size_t O_KS = O_LP + 24576;
constexpr size_t O_VS = O_KS + 524288;
constexpr size_t O_GS = O_VS + 524288;
constexpr size_t O_CS = O_GS + 4194304;
constexpr size_t O_LS = O_CS + 147456;
constexpr size_t O_END = O_LS + 49152;

struct Params {
    const float* in[25];
    float* out;
    unsigned char* ws;
    int ph_lo, ph_hi;
};

__device__ __forceinline__ unsigned cvt_pk_bf16(float lo, float hi) { unsigned r; asm volatile("v_cvt_pk_bf16_f32 %0, %1, %2" : "=v"(r) : "v"(lo), "v"(hi)); return r; }
__device__ __forceinline__ bf16_t f2bf(float f) { return (bf16_t)(cvt_pk_bf16(f, 0.f) & 0xffffu); }
__device__ __forceinline__ float bf2f(bf16_t b) { return __uint_as_float(((unsigned)b) << 16); }
__device__ __forceinline__ float bflo(unsigned w) { return __uint_as_float(w << 16); }
__device__ __forceinline__ float bfhi(unsigned w) { return __uint_as_float(w & 0xffff0000u); }
__device__ __forceinline__ float rcpf_(float x) { return __builtin_amdgcn_rcpf(x); }
__device__ __forceinline__ float siluf(float x) { return x * rcpf_(1.f + __expf(-x)); }
__device__ __forceinline__ float sigmf(float x) { return rcpf_(1.f + __expf(-x)); }
__device__ __forceinline__ void lds_barrier() { asm volatile("s_waitcnt lgkmcnt(0)" ::: "memory"); __builtin_amdgcn_s_barrier(); asm volatile("" ::: "memory"); }
__device__ __forceinline__ bf16x8 pack8(const f32x4& a, const f32x4& b) {
    u32x4 p; p.x = cvt_pk_bf16(a[0], a[1]); p.y = cvt_pk_bf16(a[2], a[3]); p.z = cvt_pk_bf16(b[0], b[1]); p.w = cvt_pk_bf16(b[2], b[3]);
    return __builtin_bit_cast(bf16x8, p);
}
__device__ __forceinline__ bf16x8 cat4(const bf16x4 a, const bf16x4 b) { bf16x8 r; r[0] = a[0]; r[1] = a[1]; r[2] = a[2]; r[3] = a[3]; r[4] = b[0]; r[5] = b[1]; r[6] = b[2]; r[7] = b[3]; return r; }
__device__ __forceinline__ void unpack8(const u32x4 w, float (&v)[8]) { v[0] = bflo(w.x); v[1] = bfhi(w.x); v[2] = bflo(w.y); v[3] = bfhi(w.y); v[4] = bflo(w.z); v[5] = bfhi(w.z); v[6] = bflo(w.w); v[7] = bfhi(w.w); }
#define MFMA16(a, b, c) __builtin_amdgcn_mfma_f32_16x16x32_bf16((a), (b), (c), 0, 0, 0)

namespace pg8 {
constexpr int BM = 256, BK = 64, HALF = 128, HTB = HALF * BK * 2, STAGE_BYTES = 8 * HTB, NXCD = 8, WGM = 8;
__device__ __forceinline__ int lds_byte(int r, int c) { const int st = (r >> 4) * 2 + (c >> 5), rr = r & 15, cc = c & 31, ob = rr * 64 + cc * 2; return st * 1024 + (ob ^ (((ob >> 9) & 1) << 5)); }
__device__ __forceinline__ int perm32(int rho) { const int n = rho >> 4, i = rho & 15; return 8 * (i >> 2) + 4 * n + (i & 3); }
__device__ __forceinline__ void stage_rc(int b, int& R, int& C) { const int st = b / 1024, sb = b % 1024, swz = sb ^ (((sb >> 9) & 1) << 5); R = (st >> 1) * 16 + swz / 64; C = (st & 1) * 32 + (swz % 64) / 2; }
struct Unit { int pm, pn; };
struct Gemm { const bf16_t* A; const bf16_t* Bt; int M, N, K; };
struct StaticOrder {
    int nM, nN, nwg, G, c;
    __device__ void init(int M, int N, int G_, int c_) { nM = M / BM; nN = N / BM; nwg = nM * nN; G = G_; c = c_; }
    __device__ __forceinline__ bool next(int i, Unit& u) const {
        const long Lx = (long)i * G + c; if (Lx >= nwg) return false;
        int wgid = (int)Lx; { const int q = nwg / NXCD, r = nwg % NXCD, xcd = wgid % NXCD, off = wgid / NXCD; wgid = (xcd < r ? xcd * (q + 1) : r * (q + 1) + (xcd - r) * q) + off; }
        const int nig = WGM * nN, gid = wgid / nig, fm = gid * WGM, gsz = (nM - fm) < WGM ? (nM - fm) : WGM;
        u.pm = fm + ((wgid % nig) % gsz); u.pn = (wgid % nig) / gsz; return true;
    }
};

template <class Epi>
__device__ __forceinline__ void gemm_phase(LAS unsigned char* lds, const Gemm g, const StaticOrder& S, const Epi& E) {
    const int tid = threadIdx.x, wid = __builtin_amdgcn_readfirstlane(tid >> 6), lane = tid & 63, wr = wid >> 2, wc = wid & 3, fr = lane & 15, fq = lane >> 4;
    const int K = g.K, nt = K / BK;
    unsigned voffA[2], voffB[2];
#pragma unroll
    for (int i = 0; i < 2; ++i) { int R, C; stage_rc(tid * 16 + i * 8192, R, C); const int Rb = Epi::PERM ? ((R & ~31) + perm32(R & 31)) : R;
        voffA[i] = (unsigned)(R * K + C) * 2u; voffB[i] = (unsigned)(Rb * K + C) * 2u; }
    const size_t kstep = (size_t)(BK * 2);
    const size_t hstep = (size_t)HALF * K * 2;
    const size_t tstep = 2 * hstep;
    const unsigned ldsw = (unsigned)wid * 1024u;
    const int aoff = lds_byte(wr * 64 + fr, fq * 8), boff = lds_byte(wc * 32 + fr, fq * 8);
#define PG8_SA(b, h) (((b) * 2 + (h)) * HTB)
#define PG8_SB(b, h) ((4 + (b) * 2 + (h)) * HTB)
#define PG8_STAGE(bufoff, gbase, voff) do { _Pragma("unroll") for (int _i = 0; _i < 2; ++_i) \
        __builtin_amdgcn_global_load_lds((const unsigned*)((const char*)(gbase) + (voff)[_i]), (LAS unsigned*)(lds + (bufoff) + ldsw + _i * 8192), 16, 0, 0); } while (0)
#define PG8_LDA(dst, b, h) do { _Pragma("unroll") for (int m = 0; m < 4; ++m) _Pragma("unroll") for (int k = 0; k < 2; ++k) dst[m][k] = *(const LAS bf16x8*)(lds + PG8_SA(b, h) + aoff + m * 2048 + k * 1024); } while (0)
#define PG8_LDB(dst, b, h) do { _Pragma("unroll") for (int n = 0; n < 2; ++n) _Pragma("unroll") for (int k = 0; k < 2; ++k) dst[n][k] = *(const LAS bf16x8*)(lds + PG8_SB(b, h) + boff + n * 2048 + k * 1024); } while (0)
#define PG8_MMA(ai, bj, At, Bt) do { __builtin_amdgcn_s_setprio(1); _Pragma("unroll") for (int m = 0; m < 4; ++m) _Pragma("unroll") for (int n = 0; n < 2; ++n) _Pragma("unroll") for (int k = 0; k < 2; ++k) \
        acc[ai][bj][m][n] = __builtin_amdgcn_mfma_f32_16x16x32_bf16(Bt[n][k], At[m][k], acc[ai][bj][m][n], 0, 0, 0); __builtin_amdgcn_s_setprio(0); } while (0)
#define PG8_WAIT_V(n) asm volatile("s_waitcnt vmcnt(" #n ")" ::: "memory")
#define PG8_WAIT_L(n) asm volatile("s_waitcnt lgkmcnt(" #n ")" ::: "memory")
#define PG8_BAR __builtin_amdgcn_s_barrier()
#define PG8_SCHED __builtin_amdgcn_sched_barrier(0)
    Unit cur, nxt; int ui = 0;
    if (!S.next(0, cur)) return;
    f32x4 acc[2][2][4][2];
#pragma unroll
    for (int a = 0; a < 2; ++a)
#pragma unroll
        for (int b = 0; b < 2; ++b)
#pragma unroll
            for (int m = 0; m < 4; ++m)
#pragma unroll
                for (int n = 0; n < 2; ++n) acc[a][b][m][n] = (f32x4){0.f, 0.f, 0.f, 0.f};
    bf16x8 At[4][2], B0[2][2], B1[2][2];
    const char* cA = (const char*)g.A + (size_t)cur.pm * tstep; const char* cB = (const char*)g.Bt + (size_t)cur.pn * tstep;
    PG8_STAGE(PG8_SB(0, 0), cB, voffB); PG8_STAGE(PG8_SB(0, 1), cB + hstep, voffB); PG8_STAGE(PG8_SA(0, 0), cA, voffA); PG8_STAGE(PG8_SA(0, 1), cA + hstep, voffA);
    if (wr == 1) PG8_BAR;
    PG8_WAIT_V(2); PG8_BAR;
    PG8_STAGE(PG8_SB(1, 0), cB + kstep, voffB); PG8_STAGE(PG8_SA(1, 0), cA + kstep, voffA); PG8_STAGE(PG8_SB(1, 1), cB + hstep + kstep, voffB);
    PG8_WAIT_V(6); PG8_BAR;
    for (;;) {
        const bool has_next = S.next(ui + 1, nxt);
        const char* nA = has_next ? (const char*)g.A + (size_t)nxt.pm * tstep : cA; const char* nB = has_next ? (const char*)g.Bt + (size_t)nxt.pn * tstep : cB;
        for (int t = 0; t < nt; t += 2) {
            const bool last = (t == nt - 2);
            const char* a1 = cA + (size_t)(t + 1) * kstep;
            const char* a2 = last ? nA : cA + (size_t)(t + 2) * kstep; const char* b2 = last ? nB : cB + (size_t)(t + 2) * kstep;
            const char* a3 = a2 + kstep; const char* b3 = b2 + kstep;
            PG8_LDB(B0, 0, 0); PG8_LDB(B1, 0, 1); PG8_SCHED; PG8_LDA(At, 0, 0); PG8_STAGE(PG8_SA(1, 1), a1 + hstep, voffA);
            PG8_WAIT_V(8); PG8_WAIT_L(0); PG8_BAR; PG8_MMA(0, 0, At, B0); PG8_MMA(0, 1, At, B1); PG8_BAR; PG8_SCHED;
            PG8_LDA(At, 0, 1); PG8_STAGE(PG8_SB(0, 0), b2, voffB); PG8_STAGE(PG8_SB(0, 1), b2 + hstep, voffB); PG8_STAGE(PG8_SA(0, 0), a2, voffA);
            PG8_WAIT_V(8); PG8_WAIT_L(0); PG8_BAR; PG8_MMA(1, 0, At, B0); PG8_MMA(1, 1, At, B1); PG8_BAR; PG8_SCHED;
            PG8_LDB(B0, 1, 0); PG8_LDB(B1, 1, 1); PG8_SCHED; PG8_LDA(At, 1, 0); PG8_STAGE(PG8_SA(0, 1), a2 + hstep, voffA);
            PG8_WAIT_V(8); PG8_WAIT_L(0); PG8_BAR; PG8_MMA(0, 0, At, B0); PG8_MMA(0, 1, At, B1); PG8_BAR; PG8_SCHED;
            PG8_LDA(At, 1, 1); PG8_STAGE(PG8_SB(1, 0), b3, voffB); PG8_STAGE(PG8_SB(1, 1), b3 + hstep, voffB); PG8_STAGE(PG8_SA(1, 0), a3, voffA);
            PG8_WAIT_V(8); PG8_WAIT_L(0); PG8_BAR; PG8_MMA(1, 0, At, B0); PG8_MMA(1, 1, At, B1); PG8_BAR; PG8_SCHED;
        }
        if (wr == 0) PG8_BAR;
        E(acc, cur, wr, wc, fr, fq);
        if (!has_next) break;
#pragma unroll
        for (int a = 0; a < 2; ++a)
#pragma unroll
            for (int b = 0; b < 2; ++b)
#pragma unroll
                for (int m = 0; m < 4; ++m)
#pragma unroll
                    for (int n = 0; n < 2; ++n) acc[a][b][m][n] = (f32x4){0.f, 0.f, 0.f, 0.f};
        cur = nxt; cA = nA; cB = nB; ++ui;
        if (wr == 1) PG8_BAR;
    }
    PG8_WAIT_V(0);
    PG8_BAR;
#undef PG8_SA
#undef PG8_SB
#undef PG8_STAGE
#undef PG8_LDA
#undef PG8_LDB
#undef PG8_MMA
#undef PG8_WAIT_V
#undef PG8_WAIT_L
#undef PG8_BAR
#undef PG8_SCHED
}
}

typedef f32x4 AccT[2][2][4][2];

struct EpiInEven {
    static constexpr bool PERM = true;
    unsigned char* ws; float* out; const float* rstd; const float* blr_b;
    __device__ __forceinline__ void operator()(const AccT& acc, const pg8::Unit& u, int wr, int wc, int fr, int fq) const {
        const int pn = u.pn;
        bf16_t* base; int ld, coff; float sc = 1.f;
        if (pn < 4) { base = (bf16_t*)(ws + WS_Q); ld = 1024; coff = pn * 256; sc = 0.125f; }
        else if (pn == 4) { base = (bf16_t*)(ws + WS_K); ld = 256; coff = 0; }
        else if (pn == 5) { base = (bf16_t*)(ws + WS_V); ld = 256; coff = 0; }
        else if (pn < 8) { base = (bf16_t*)(ws + WS_BQ); ld = 512; coff = (pn - 6) * 256; sc = 0.08838834764831845f; }
        else if (pn < 10) { base = (bf16_t*)(ws + WS_BK); ld = 512; coff = (pn - 8) * 256; }
        else if (pn < 14) { base = (bf16_t*)(ws + WS_BV); ld = 1024; coff = (pn - 10) * 256; }
        else if (pn < 22) { base = (bf16_t*)(ws + WS_GATE); ld = 2048; coff = (pn - 14) * 256; }
        else { base = (bf16_t*)(ws + WS_BLR); ld = 512; coff = (pn - 22) * 256; }
        const int row0 = u.pm * 256 + wr * 64 + fr;
        const int ct = wc * 32 + 8 * fq;
        float rsv[8];
#pragma unroll
        for (int it = 0; it < 8; ++it) rsv[it] = rstd[row0 + (it >> 2) * 128 + (it & 3) * 16];
        if (pn >= 22) {
#pragma unroll
            for (int ai = 0; ai < 2; ++ai)
#pragma unroll
                for (int m = 0; m < 4; ++m) {
                    const int row = row0 + ai * 128 + m * 16; const float rs = rsv[ai * 4 + m];
#pragma unroll
                    for (int bj = 0; bj < 2; ++bj) {
                        const int cg = coff + ct + bj * 128;
                        const f32x4 b0 = *(const f32x4*)(blr_b + cg), b1 = *(const f32x4*)(blr_b + cg + 4);
                        f32x4 x0 = acc[ai][bj][m][0] * rs + b0, x1 = acc[ai][bj][m][1] * rs + b1;
#pragma unroll
                        for (int j = 0; j < 4; ++j) { x0[j] = (fminf(x0[j], 0.f) - __logf(1.f + __expf(-fabsf(x0[j])))) * (1.f / 16.f); x1[j] = (fminf(x1[j], 0.f) - __logf(1.f + __expf(-fabsf(x1[j])))) * (1.f / 16.f); }
                        u32x4 w; w.x = cvt_pk_bf16(x0[0], x0[1]); w.y = cvt_pk_bf16(x0[2], x0[3]); w.z = cvt_pk_bf16(x1[0], x1[1]); w.w = cvt_pk_bf16(x1[2], x1[3]);
                        *(u32x4*)(base + (size_t)row * 512 + cg) = w;
                    }
                }
            return;
        }
        const bool kv = (pn == 4 || pn == 5);
        float* okv_p = out + (pn == 4 ? O_KP : O_VP); float* okv_s = out + (pn == 4 ? O_KS : O_VS);
#pragma unroll
        for (int ai = 0; ai < 2; ++ai)
#pragma unroll
            for (int m = 0; m < 4; ++m) {
                const int row = row0 + ai * 128 + m * 16; const float rs = rsv[ai * 4 + m] * sc;
                bf16_t* rowp = base + (size_t)row * ld + coff + ct;
                float* orow = nullptr;
                if (kv) {
                    if (row >= T_P) orow = okv_s + (size_t)(row - T_P) * 256;
                    else { const int b = row >> 11, t = row & 2047; if (t >= 1920) orow = okv_p + (size_t)(b * 128 + t - 1920) * 256; }
                }
#pragma unroll
                for (int bj = 0; bj < 2; ++bj) {
                    const f32x4 v0 = acc[ai][bj][m][0] * rs, v1 = acc[ai][bj][m][1] * rs;
                    u32x4 w; w.x = cvt_pk_bf16(v0[0], v0[1]); w.y = cvt_pk_bf16(v0[2], v0[3]); w.z = cvt_pk_bf16(v1[0], v1[1]); w.w = cvt_pk_bf16(v1[2], v1[3]);
                    *(u32x4*)(rowp + bj * 128) = w;
                    if (kv && orow) { *(f32x4*)(orow + bj * 128 + ct) = v0; *(f32x4*)(orow + bj * 128 + ct + 4) = v1; }
                }
            }
    }
};

template <bool WRITE_BF>
struct EpiOutRes {
    static constexpr bool PERM = false;
    const float* xin_p; const float* xin_s; float* xo; bf16_t* xb; float* rowsq;
    __device__ __forceinline__ void operator()(const AccT& acc, const pg8::Unit& u, int wr, int wc, int fr, int fq) const {
        const int row0 = u.pm * 256 + wr * 64 + fr, col0 = u.pn * 256 + wc * 32 + 4 * fq;
        f32x4 r[3][4];
#define EOR_LOAD(S, IT) do { const int row_ = row0 + ((IT) >> 2) * 128 + ((IT) & 3) * 16; \
            const float* xr_ = (row_ < T_P) ? xin_p + (size_t)row_ * 1024 : xin_s + (size_t)(row_ - T_P) * 1024; \
            r[S][0] = *(const f32x4*)(xr_ + col0); r[S][1] = *(const f32x4*)(xr_ + col0 + 16); r[S][2] = *(const f32x4*)(xr_ + col0 + 128); r[S][3] = *(const f32x4*)(xr_ + col0 + 144); } while (0)
        EOR_LOAD(0, 0); EOR_LOAD(1, 1);
#pragma unroll
        for (int it = 0; it < 8; ++it) {
            if (it + 2 < 8) { if ((it + 2) % 3 == 0) EOR_LOAD(0, it + 2); else if ((it + 2) % 3 == 1) EOR_LOAD(1, it + 2); else EOR_LOAD(2, it + 2); }
            const int ai = it >> 2, m = it & 3;
            const int row = row0 + ai * 128 + m * 16;
            float ss = 0.f;
#pragma unroll
            for (int bj = 0; bj < 2; ++bj)
#pragma unroll
                for (int n = 0; n < 2; ++n) {
                    const int col = col0 + bj * 128 + n * 16;
                    const f32x4 v = acc[ai][bj][m][n] + r[it % 3][bj * 2 + n];
                    if (!WRITE_BF) *(f32x4*)(xo + (size_t)row * 1024 + col) = v;
                    if (WRITE_BF) { u32x2 w; w.x = cvt_pk_bf16(v[0], v[1]); w.y = cvt_pk_bf16(v[2], v[3]); *(u32x2*)(xb + (size_t)row * 1024 + col) = w; }
                    ss += v[0] * v[0] + v[1] * v[1] + v[2] * v[2] + v[3] * v[3];
                }
            ss += __shfl_xor(ss, 16); ss += __shfl_xor(ss, 32);
            if (fq == 0) atomicAdd(rowsq + row, ss);
        }
#undef EOR_LOAD
    }
};

struct EpiOutResB {
    static constexpr bool PERM = false;
    bf16_t* xb; float* rowsq;
    __device__ __forceinline__ void operator()(const AccT& acc, const pg8::Unit& u, int wr, int wc, int fr, int fq) const {
        const int row0 = u.pm * 256 + wr * 64 + fr, col0 = u.pn * 256 + wc * 32 + 4 * fq;
        u32x2 r[3][4];
#define EOB_LOAD(S, IT) do { const bf16_t* xr_ = xb + (size_t)(row0 + ((IT) >> 2) * 128 + ((IT) & 3) * 16) * 1024 + col0; \
            r[S][0] = *(const u32x2*)(xr_); r[S][1] = *(const u32x2*)(xr_ + 16); r[S][2] = *(const u32x2*)(xr_ + 128); r[S][3] = *(const u32x2*)(xr_ + 144); } while (0)
        EOB_LOAD(0, 0); EOB_LOAD(1, 1);
#pragma unroll
        for (int it = 0; it < 8; ++it) {
            if (it + 2 < 8) { if ((it + 2) % 3 == 0) EOB_LOAD(0, it + 2); else if ((it + 2) % 3 == 1) EOB_LOAD(1, it + 2); else EOB_LOAD(2, it + 2); }
            const int ai = it >> 2, m = it & 3;
            const int row = row0 + ai * 128 + m * 16;
            float ss = 0.f;
#pragma unroll
            for (int bj = 0; bj < 2; ++bj)
#pragma unroll
                for (int n = 0; n < 2; ++n) {
                    const int col = col0 + bj * 128 + n * 16;
                    const u32x2 rw = r[it % 3][bj * 2 + n];
                    f32x4 v = acc[ai][bj][m][n];
                    v[0] += bflo(rw.x); v[1] += bfhi(rw.x); v[2] += bflo(rw.y); v[3] += bfhi(rw.y);
                    u32x2 w; w.x = cvt_pk_bf16(v[0], v[1]); w.y = cvt_pk_bf16(v[2], v[3]);
                    *(u32x2*)(xb + (size_t)row * 1024 + col) = w;
                    ss += v[0] * v[0] + v[1] * v[1] + v[2] * v[2] + v[3] * v[3];
                }
            ss += __shfl_xor(ss, 16); ss += __shfl_xor(ss, 32);
            if (fq == 0) atomicAdd(rowsq + row, ss);
        }
#undef EOB_LOAD
    }
};

struct EpiInOdd {
    static constexpr bool PERM = true;
    bf16_t* z2; const float* rowsq;
    __device__ __forceinline__ void operator()(const AccT& acc, const pg8::Unit& u, int wr, int wc, int fr, int fq) const {
        const int row0 = u.pm * 256 + wr * 64 + fr, col0 = u.pn * 256 + wc * 32 + 8 * fq;
        float rsv[8];
#pragma unroll
        for (int it = 0; it < 8; ++it) rsv[it] = rowsq[row0 + (it >> 2) * 128 + (it & 3) * 16];
#pragma unroll
        for (int ai = 0; ai < 2; ++ai)
#pragma unroll
            for (int m = 0; m < 4; ++m) {
                const int row = row0 + ai * 128 + m * 16; const float rs = rsqrtf(rsv[ai * 4 + m] * (1.f / 1024.f) + EPS);
#pragma unroll
                for (int bj = 0; bj < 2; ++bj) {
                    const f32x4 v0 = acc[ai][bj][m][0] * rs, v1 = acc[ai][bj][m][1] * rs;
                    u32x4 w; w.x = cvt_pk_bf16(v0[0], v0[1]); w.y = cvt_pk_bf16(v0[2], v0[3]); w.z = cvt_pk_bf16(v1[0], v1[1]); w.w = cvt_pk_bf16(v1[2], v1[3]);
                    *(u32x4*)(z2 + (size_t)row * 3072 + col0 + bj * 128) = w;
                }
            }
    }
};

template <int MODE>
__device__ __forceinline__ void transpose_w(const float* __restrict__ src, int K, int Nsrc, bf16_t* __restrict__ dst, int Ndst, const float* __restrict__ gain, long gtid, long gsz) {
    const long total = (long)(K / 8) * Ndst;
#pragma unroll 4
    for (long it = gtid; it < total; it += gsz) {
        const int n = (int)(it % Ndst), k8 = (int)(it / Ndst);
        int sc = n;
        if (MODE == 1) { if (n < 3584) sc = n; else sc = n + 16; }
        u32x4 w = {0u, 0u, 0u, 0u};
        if (sc >= 0) {
            const float* s = src + (size_t)(k8 * 8) * Nsrc + sc;
            float v0 = s[0], v1 = s[(size_t)Nsrc], v2 = s[(size_t)2 * Nsrc], v3 = s[(size_t)3 * Nsrc], v4 = s[(size_t)4 * Nsrc], v5 = s[(size_t)5 * Nsrc], v6 = s[(size_t)6 * Nsrc], v7 = s[(size_t)7 * Nsrc];
            if (gain) { const f32x4 g0 = *(const f32x4*)(gain + k8 * 8), g1 = *(const f32x4*)(gain + k8 * 8 + 4); v0 *= g0[0]; v1 *= g0[1]; v2 *= g0[2]; v3 *= g0[3]; v4 *= g1[0]; v5 *= g1[1]; v6 *= g1[2]; v7 *= g1[3]; }
            w.x = cvt_pk_bf16(v0, v1); w.y = cvt_pk_bf16(v2, v3); w.z = cvt_pk_bf16(v4, v5); w.w = cvt_pk_bf16(v6, v7);
        }
        *(u32x4*)(dst + (size_t)n * K + k8 * 8) = w;
    }
}

__device__ __forceinline__ void phase0(const Params& p) {
    unsigned char* ws = p.ws;
    const long gtid = (long)blockIdx.x * NTHR + threadIdx.x, gsz = (long)gridDim.x * NTHR;
    transpose_w<1>(p.in[8], 1024, 5648, (bf16_t*)(ws + WS_WINE), 5632, p.in[7], gtid, gsz);
    for (long it = gtid; it < 128L * 512; it += gsz) {
        const int n = (int)(it & 511), k8 = (int)(it >> 9);
        float wl[16];
#pragma unroll
        for (int r = 0; r < 16; ++r) wl[r] = p.in[9][r * 512 + n];
        float v[8];
#pragma unroll
        for (int i = 0; i < 8; ++i) {
            const float* wr_ = p.in[8] + (size_t)(k8 * 8 + i) * 5648 + 3584;
            float a = 0.f;
#pragma unroll
            for (int r4 = 0; r4 < 4; ++r4) { const f32x4 x = *(const f32x4*)(wr_ + r4 * 4); a += x[0] * wl[r4 * 4] + x[1] * wl[r4 * 4 + 1] + x[2] * wl[r4 * 4 + 2] + x[3] * wl[r4 * 4 + 3]; }
            v[i] = a * p.in[7][k8 * 8 + i];
        }
        u32x4 w; w.x = cvt_pk_bf16(v[0], v[1]); w.y = cvt_pk_bf16(v[2], v[3]); w.z = cvt_pk_bf16(v[4], v[5]); w.w = cvt_pk_bf16(v[6], v[7]);
        *(u32x4*)((bf16_t*)(ws + WS_WINE) + (size_t)(5632 + n) * 1024 + k8 * 8) = w;
    }
    transpose_w<0>(p.in[13], 2048, 1024, (bf16_t*)(ws + WS_WOUTE), 1024, nullptr, gtid, gsz);
    transpose_w<0>(p.in[15], 1024, 3072, (bf16_t*)(ws + WS_WINO), 3072, p.in[14], gtid, gsz);
    transpose_w<0>(p.in[23], 1536, 1024, (bf16_t*)(ws + WS_WOUTO), 1024, nullptr, gtid, gsz);
    for (int nb = 0; nb < 8; ++nb) {
        transpose_w<0>(p.in[18] + nb * 192 * 192, 192, 192, (bf16_t*)(ws + WS_WA) + nb * 192 * 192, 192, nullptr, gtid, gsz);
        transpose_w<0>(p.in[20] + nb * 192 * 192, 192, 192, (bf16_t*)(ws + WS_WI) + nb * 192 * 192, 192, nullptr, gtid, gsz);
    }
    { float* z = (float*)(ws + WS_RSQ1); const long nz = (long)T * 2; for (long i = gtid; i < nz; i += gsz) z[i] = 0.f; }
    const int lane = threadIdx.x & 63; const int gw = (int)(gtid >> 6), nw = (int)(gsz >> 6);
    bf16_t* xb = (bf16_t*)(ws + WS_XB); float* rstd = (float*)(ws + WS_RSTD0);
#pragma unroll 4
    for (int row = gw; row < T; row += nw) {
        const float* xr = (row < T_P) ? p.in[0] + (size_t)row * 1024 : p.in[1] + (size_t)(row - T_P) * 1024;
        float ss = 0.f;
#pragma unroll
        for (int i = 0; i < 4; ++i) {
            const f32x4 v = *(const f32x4*)(xr + i * 256 + lane * 4);
            ss += v[0] * v[0] + v[1] * v[1] + v[2] * v[2] + v[3] * v[3];
            u32x2 w; w.x = cvt_pk_bf16(v[0], v[1]); w.y = cvt_pk_bf16(v[2], v[3]);
            *(u32x2*)(xb + (size_t)row * 1024 + i * 256 + lane * 4) = w;
        }
#pragma unroll
        for (int o = 32; o >= 1; o >>= 1) ss += __shfl_xor(ss, o);
        if (lane == 0) rstd[row] = rsqrtf(ss * (1.f / 1024.f) + EPS);
    }
}

__device__ __forceinline__ void attn_item(const Params& p, LAS unsigned char* L, int item, bf16_t* Yd, int ldd) {
    unsigned char* ws = p.ws;
    const int tid = threadIdx.x, lane = tid & 63, w = tid >> 6, r16 = lane & 15, q4 = lane >> 4;
    LAS bf16_t* Ks = (LAS bf16_t*)L;
    LAS bf16_t* Vs = (LAS bf16_t*)(L + 192 * 72 * 2);
    const unsigned vbase = (unsigned)(size_t)L + 192u * 72u * 2u;
    const bf16_t* Qb = (const bf16_t*)(ws + WS_Q); const bf16_t* Kb = (const bf16_t*)(ws + WS_K); const bf16_t* Vb = (const bf16_t*)(ws + WS_V);
    const bf16_t* Yb = (const bf16_t*)(ws + WS_GATE);
    const bool smp = item >= 2048;
    int b, c, kh; size_t row0;
    if (!smp) { kh = item & 3; c = (item >> 2) & 31; b = item >> 7; row0 = (size_t)b * 2048 + c * 64; }
    else { const int i2 = item - 2048; kh = i2 & 3; b = i2 >> 2; c = 0; row0 = (size_t)T_P + b * 64; }
    const int g = w >> 1, i0 = (w & 1) * 32, h = kh * 4 + g;
    bf16x8 qf[2][2];
#pragma unroll
    for (int qt = 0; qt < 2; ++qt) {
#pragma unroll
        for (int ks = 0; ks < 2; ++ks) qf[qt][ks] = *(const bf16x8*)(Qb + (row0 + i0 + qt * 16 + r16) * 1024 + h * 64 + ks * 32 + q4 * 8);
    }
#pragma unroll
    for (int i = 0; i < 3; ++i) {
        const int idx = tid + i * 512, key = idx >> 3, dg = idx & 7;
        u32x4 kv = {0u, 0u, 0u, 0u}, vv = {0u, 0u, 0u, 0u};
        if (!smp) {
            const int pos = c * 64 - 128 + key;
            if (pos >= 0) { const size_t r = (size_t)b * 2048 + pos; kv = *(const u32x4*)(Kb + r * 256 + kh * 64 + dg * 8); vv = *(const u32x4*)(Vb + r * 256 + kh * 64 + dg * 8); }
        } else {
            if (key < 128) {
                const size_t o = ((size_t)(b * 128 + key) * 4 + kh) * 64 + dg * 8;
                const f32x4 k0 = *(const f32x4*)(p.in[2] + o), k1 = *(const f32x4*)(p.in[2] + o + 4), v0 = *(const f32x4*)(p.in[3] + o), v1 = *(const f32x4*)(p.in[3] + o + 4);
                kv.x = cvt_pk_bf16(k0[0], k0[1]); kv.y = cvt_pk_bf16(k0[2], k0[3]); kv.z = cvt_pk_bf16(k1[0], k1[1]); kv.w = cvt_pk_bf16(k1[2], k1[3]);
                vv.x = cvt_pk_bf16(v0[0], v0[1]); vv.y = cvt_pk_bf16(v0[2], v0[3]); vv.z = cvt_pk_bf16(v1[0], v1[1]); vv.w = cvt_pk_bf16(v1[2], v1[3]);
            } else { const size_t r = (size_t)T_P + b * 64 + key - 128; kv = *(const u32x4*)(Kb + r * 256 + kh * 64 + dg * 8); vv = *(const u32x4*)(Vb + r * 256 + kh * 64 + dg * 8); }
        }
        *(LAS u32x4*)(Ks + key * 72 + dg * 8) = kv;
        *(LAS u32x4*)(Vs + key * 72 + dg * 8) = vv;
    }
    __syncthreads();
    const float slope = exp2f(-0.5f * (float)(h + 1));
    const float sink = p.in[11][h];
    const unsigned va = vbase + (unsigned)(((q4 * 4 + (r16 >> 2)) * 72 + 4 * (r16 & 3)) * 2);
#pragma unroll 1
    for (int qt = 0; qt < 2; ++qt) {
        const int i = i0 + qt * 16 + r16;
        const bf16x8 qa = qt ? qf[1][0] : qf[0][0], qb = qt ? qf[1][1] : qf[0][1];
        u32x2 gv[4];
#pragma unroll
        for (int dt = 0; dt < 4; ++dt) gv[dt] = *(const u32x2*)(Yb + (row0 + i) * 2048 + h * 64 + dt * 16 + q4 * 4);
        f32x4 sacc[12];
#pragma unroll
        for (int kt = 0; kt < 12; ++kt) {
            const bf16x8 kf0 = *(const LAS bf16x8*)(Ks + (kt * 16 + r16) * 72 + q4 * 8), kf1 = *(const LAS bf16x8*)(Ks + (kt * 16 + r16) * 72 + 32 + q4 * 8);
            f32x4 a = {0.f, 0.f, 0.f, 0.f}; a = MFMA16(kf0, qa, a); a = MFMA16(kf1, qb, a); sacc[kt] = a;
        }
        float m = -3e38f;
#pragma unroll
        for (int kt = 0; kt < 12; ++kt)
#pragma unroll
            for (int jj = 0; jj < 4; ++jj) {
                const int j = kt * 16 + q4 * 4 + jj;
                float sv = sacc[kt][jj] - slope * fabsf((float)(128 + i - j));
                if (!smp && (c * 64 - 128 + j) < 0) sv = -1e30f;
                sacc[kt][jj] = sv; m = fmaxf(m, sv);
            }
        m = fmaxf(m, __shfl_xor(m, 16)); m = fmaxf(m, __shfl_xor(m, 32)); m = fmaxf(m, sink);
        float l = 0.f;
#pragma unroll
        for (int kt = 0; kt < 12; ++kt)
#pragma unroll
            for (int jj = 0; jj < 4; ++jj) { const float pr = __expf(sacc[kt][jj] - m); sacc[kt][jj] = pr; l += pr; }
        l += __shfl_xor(l, 16); l += __shfl_xor(l, 32); l += __expf(sink - m);
        const float inv = 1.f / l;
        f32x4 oacc[4];
#pragma unroll
        for (int dt = 0; dt < 4; ++dt) oacc[dt] = (f32x4){0.f, 0.f, 0.f, 0.f};
#pragma unroll
        for (int kb = 0; kb < 6; ++kb) {
            const bf16x8 pf = pack8(sacc[2 * kb], sacc[2 * kb + 1]);
            bf16x4 l0, h0, l1, h1, l2, h2, l3, h3;
            const unsigned vk = va + (unsigned)(kb * 32 * 144);
            asm volatile("ds_read_b64_tr_b16 %0, %8\n\tds_read_b64_tr_b16 %1, %8 offset:2304\n\t"
                         "ds_read_b64_tr_b16 %2, %8 offset:32\n\tds_read_b64_tr_b16 %3, %8 offset:2336\n\t"
                         "ds_read_b64_tr_b16 %4, %8 offset:64\n\tds_read_b64_tr_b16 %5, %8 offset:2368\n\t"
                         "ds_read_b64_tr_b16 %6, %8 offset:96\n\tds_read_b64_tr_b16 %7, %8 offset:2400\n\t"
                         "s_waitcnt lgkmcnt(0)"
                         : "=&v"(l0), "=&v"(h0), "=&v"(l1), "=&v"(h1), "=&v"(l2), "=&v"(h2), "=&v"(l3), "=&v"(h3) : "v"(vk) : "memory");
            oacc[0] = MFMA16(cat4(l0, h0), pf, oacc[0]); oacc[1] = MFMA16(cat4(l1, h1), pf, oacc[1]);
            oacc[2] = MFMA16(cat4(l2, h2), pf, oacc[2]); oacc[3] = MFMA16(cat4(l3, h3), pf, oacc[3]);
        }
#pragma unroll
        for (int dt = 0; dt < 4; ++dt) {
            const u32x2 gq = gv[dt];
            const f32x4 o = oacc[dt] * inv;
            u32x2 wv; wv.x = cvt_pk_bf16(o[0] * siluf(bflo(gq.x)), o[1] * siluf(bfhi(gq.x))); wv.y = cvt_pk_bf16(o[2] * siluf(bflo(gq.y)), o[3] * siluf(bfhi(gq.y)));
            *(u32x2*)(Yd + (row0 + i) * ldd + h * 64 + dt * 16 + q4 * 4) = wv;
        }
    }
    __syncthreads();
}

constexpr size_t SC_SQ = 0;
constexpr size_t SC_ET = 9437184;
constexpr size_t SC_AB = 16777216;
static_assert(SC_AB + (size_t)T * 256 * 2 <= (size_t)T * 1024 * 4, "scratch must fit in the y region of d_out");

struct PrepRegs { u32x4 g0, g1, q0, q1, k0, k1; };
__device__ __forceinline__ unsigned prep_row0(int item, int& h) {
    if (item < 2048) { h = item & 3; const int c = (item >> 2) & 31; const int b = item >> 7; return (unsigned)b * 2048 + c * 64; }
    const int i2 = item - 2048; h = i2 & 3; return (unsigned)T_P + (i2 >> 2) * 64;
}
__device__ __forceinline__ void prep_load(const Params& p, int item, PrepRegs& R) {
    const int tid = threadIdx.x; int h; const unsigned row0 = prep_row0(item, h);
    const bf16_t* BQ = (const bf16_t*)(p.ws + WS_BQ); const bf16_t* BKb = (const bf16_t*)(p.ws + WS_BK); const bf16_t* GB = (const bf16_t*)(p.ws + WS_BLR);
    const int pt0 = tid >> 4, pt1 = (tid + 512) >> 4, poc = tid & 15;
    const unsigned o0 = (row0 + pt0) * 512u + h * 128 + poc * 8, o1 = (row0 + pt1) * 512u + h * 128 + poc * 8;
    R.g0 = *(const u32x4*)(GB + o0); R.g1 = *(const u32x4*)(GB + o1);
    R.q0 = *(const u32x4*)(BQ + o0); R.q1 = *(const u32x4*)(BQ + o1); R.k0 = *(const u32x4*)(BKb + o0); R.k1 = *(const u32x4*)(BKb + o1);
}
__device__ __forceinline__ void gla_prep_item(const Params& p, LAS unsigned char* L, int item, const PrepRegs& cur, int next_item, PrepRegs& nxt) {
    unsigned char* ws = p.ws;
    const int tid = threadIdx.x, lane = tid & 63, w = tid >> 6, r16 = lane & 15, q4 = lane >> 4;
    LAS bf16_t* QG = (LAS bf16_t*)L;
    LAS bf16_t* KG = (LAS bf16_t*)(L + 17408);
    LAS bf16_t* Gs = (LAS bf16_t*)(L + 34816);
    LAS float* Gf = (LAS float*)(L + 52224);
    LAS float* GT = (LAS float*)(L + 84992);
    int h; const unsigned row0 = prep_row0(item, h);
    bf16_t* BQ = (bf16_t*)(ws + WS_BQ); bf16_t* BKb = (bf16_t*)(ws + WS_BK);
    float* ET = (float*)((unsigned char*)p.out + SC_ET); bf16_t* AB = (bf16_t*)((unsigned char*)p.out + SC_AB);
    const int c = tid & 127, tg = tid >> 7;
    const int pt0 = tid >> 4, pt1 = (tid + 512) >> 4, poc = tid & 15;
    const unsigned o0 = (row0 + pt0) * 512u + h * 128 + poc * 8, o1 = (row0 + pt1) * 512u + h * 128 + poc * 8;
    const u32x4 pq0 = cur.q0, pq1 = cur.q1, pk0 = cur.k0, pk1 = cur.k1;
    *(LAS u32x4*)(Gs + pt0 * 136 + poc * 8) = cur.g0; *(LAS u32x4*)(Gs + pt1 * 136 + poc * 8) = cur.g1;
    lds_barrier();
    if (next_item >= 0) prep_load(p, next_item, nxt);
    {
        float cs = 0.f;
#pragma unroll
        for (int tt = 0; tt < 16; ++tt) { cs += bf2f(Gs[(tg * 16 + tt) * 136 + c]); Gf[(tg * 16 + tt) * 128 + c] = cs; }
        GT[tg * 128 + c] = cs;
    }
    lds_barrier();
#pragma unroll
    for (int i = 0; i < 2; ++i) {
        const int t = i ? pt1 : pt0; const int tgp = t >> 4;
        const u32x4 qw = i ? pq1 : pq0, kw = i ? pk1 : pk0;
        float G[8], tot[8];
        { const f32x4 a0 = *(const LAS f32x4*)(Gf + t * 128 + poc * 8), a1 = *(const LAS f32x4*)(Gf + t * 128 + poc * 8 + 4);
          G[0] = a0[0]; G[1] = a0[1]; G[2] = a0[2]; G[3] = a0[3]; G[4] = a1[0]; G[5] = a1[1]; G[6] = a1[2]; G[7] = a1[3]; }
#pragma unroll
        for (int j = 0; j < 8; ++j) tot[j] = 0.f;
#pragma unroll
        for (int g2 = 0; g2 < 4; ++g2) {
            const f32x4 a0 = *(const LAS f32x4*)(GT + g2 * 128 + poc * 8), a1 = *(const LAS f32x4*)(GT + g2 * 128 + poc * 8 + 4);
            const float sel = (g2 < tgp) ? 1.f : 0.f;
            G[0] += sel * a0[0]; G[1] += sel * a0[1]; G[2] += sel * a0[2]; G[3] += sel * a0[3]; G[4] += sel * a1[0]; G[5] += sel * a1[1]; G[6] += sel * a1[2]; G[7] += sel * a1[3];
            tot[0] += a0[0]; tot[1] += a0[1]; tot[2] += a0[2]; tot[3] += a0[3]; tot[4] += a1[0]; tot[5] += a1[1]; tot[6] += a1[2]; tot[7] += a1[3];
        }
        if (i == 0 && tid < 16) {
            float* ep = ET + (size_t)(row0 >> 6) * 512 + h * 128 + poc * 8;
            *(f32x4*)ep = (f32x4){__expf(tot[0]), __expf(tot[1]), __expf(tot[2]), __expf(tot[3])};
            *(f32x4*)(ep + 4) = (f32x4){__expf(tot[4]), __expf(tot[5]), __expf(tot[6]), __expf(tot[7])};
        }
        float qv[8], kv[8];
        unpack8(qw, qv); unpack8(kw, kv);
#pragma unroll
        for (int j = 0; j < 8; ++j) { const float eg = __expf(G[j]); qv[j] *= eg; kv[j] *= rcpf_(eg); }
        u32x4 qo, ko;
        qo.x = cvt_pk_bf16(qv[0], qv[1]); qo.y = cvt_pk_bf16(qv[2], qv[3]); qo.z = cvt_pk_bf16(qv[4], qv[5]); qo.w = cvt_pk_bf16(qv[6], qv[7]);
        ko.x = cvt_pk_bf16(kv[0], kv[1]); ko.y = cvt_pk_bf16(kv[2], kv[3]); ko.z = cvt_pk_bf16(kv[4], kv[5]); ko.w = cvt_pk_bf16(kv[6], kv[7]);
        *(LAS u32x4*)(QG + t * 136 + poc * 8) = qo; *(LAS u32x4*)(KG + t * 136 + poc * 8) = ko;
        *(u32x4*)(BQ + (i ? o1 : o0)) = qo; *(u32x4*)(BKb + (i ? o1 : o0)) = ko;
    }
    lds_barrier();
    {
        const int it = w >> 1, jt0 = (w & 1) * 2;
        f32x4 at[2];
        at[0] = (f32x4){0.f, 0.f, 0.f, 0.f}; at[1] = (f32x4){0.f, 0.f, 0.f, 0.f};
#pragma unroll
        for (int ks = 0; ks < 4; ++ks) {
            const bf16x8 qf = *(const LAS bf16x8*)(QG + (it * 16 + r16) * 136 + ks * 32 + q4 * 8);
#pragma unroll
            for (int t2 = 0; t2 < 2; ++t2) {
                const bf16x8 kf = *(const LAS bf16x8*)(KG + ((jt0 + t2) * 16 + r16) * 136 + ks * 32 + q4 * 8);
                at[t2] = MFMA16(kf, qf, at[t2]);
            }
        }
        const int i = it * 16 + r16;
#pragma unroll
        for (int t2 = 0; t2 < 2; ++t2) {
            f32x4 v = at[t2];
#pragma unroll
            for (int jj = 0; jj < 4; ++jj) { const int j = (jt0 + t2) * 16 + q4 * 4 + jj; if (j > i) v[jj] = 0.f; }
            u32x2 wv; wv.x = cvt_pk_bf16(v[0], v[1]); wv.y = cvt_pk_bf16(v[2], v[3]);
            *(u32x2*)(AB + (size_t)(row0 + i) * 256 + h * 64 + (jt0 + t2) * 16 + q4 * 4) = wv;
        }
    }
    lds_barrier();
}

__device__ __forceinline__ void gla_scan_item(const Params& p, LAS unsigned char* L, int item, bool dummy) {
    unsigned char* ws = p.ws;
    const int tid = threadIdx.x, lane = tid & 63, w = tid >> 6, r16 = lane & 15, q4 = lane >> 4;
    LAS bf16_t* QG = (LAS bf16_t*)L;
    LAS bf16_t* KG = (LAS bf16_t*)(L + 17408);
    LAS bf16_t* Vs = (LAS bf16_t*)(L + 34816);
    LAS bf16_t* As = (LAS bf16_t*)(L + 44032);
    LAS float* GL = (LAS float*)(L + 53248);
    const unsigned lbase = (unsigned)(size_t)L;
    const bool smp = item >= 256;
    const int i2 = smp ? item - 256 : item;
    const int b = i2 >> 4, h = (i2 >> 2) & 3, sl = i2 & 3, e0 = sl * 64;
    const int nch = smp ? 1 : 32;
    const unsigned rbase = smp ? (unsigned)T_P + b * 64 : (unsigned)b * 2048;
    const bf16_t* BQ = (const bf16_t*)(ws + WS_BQ); const bf16_t* BKb = (const bf16_t*)(ws + WS_BK); bf16_t* BV = (bf16_t*)(ws + WS_BV);
    const float* ET = (const float*)((unsigned char*)p.out + SC_ET); const bf16_t* AB = (const bf16_t*)((unsigned char*)p.out + SC_AB); float* BOSQP = dummy ? p.out + 20000000 : (float*)((unsigned char*)p.out + SC_SQ);
    bf16_t* BVo = dummy ? (bf16_t*)((unsigned char*)p.out + 67108864) : BV;
    const int pt0 = tid >> 4, pt1 = (tid + 512) >> 4, poc = tid & 15;
    const int vt = tid >> 3, veo = tid & 7;
    const int et = w & 3, ip = w >> 2;
    f32x4 Sacc[8];
#pragma unroll
    for (int d8 = 0; d8 < 8; ++d8) {
        if (smp) {
#pragma unroll
            for (int jj = 0; jj < 4; ++jj) Sacc[d8][jj] = p.in[4][((size_t)(b * 4 + h) * 128 + d8 * 16 + q4 * 4 + jj) * 256 + e0 + et * 16 + r16];
        } else Sacc[d8] = (f32x4){0.f, 0.f, 0.f, 0.f};
    }
    const int tq_ = r16 >> 2, tp_ = r16 & 3;
    const unsigned v4a = lbase + 34816u + (unsigned)(((q4 * 8 + tq_) * 72 + et * 16 + 4 * tp_) * 2);
    const unsigned k4a = lbase + 17408u + (unsigned)(((q4 * 8 + tq_) * 136 + 4 * tp_) * 2);
    struct Pre { u32x4 q0, q1, k0, k1, a, v; f32x4 e; };
    Pre PA, PB;
    PA.e = (f32x4){0.f, 0.f, 0.f, 0.f}; PB.e = (f32x4){0.f, 0.f, 0.f, 0.f};
#define GLA_PREFETCH(P, R) do { \
        const unsigned o0_ = ((R) + pt0) * 512u + h * 128 + poc * 8, o1_ = ((R) + pt1) * 512u + h * 128 + poc * 8; \
        P.q0 = *(const u32x4*)(BQ + o0_); P.q1 = *(const u32x4*)(BQ + o1_); P.k0 = *(const u32x4*)(BKb + o0_); P.k1 = *(const u32x4*)(BKb + o1_); \
        P.a = *(const u32x4*)(AB + ((R) + vt) * 256u + h * 64 + veo * 8); \
        P.v = *(const u32x4*)(BV + ((R) + vt) * 1024u + h * 256 + e0 + veo * 8); \
        if (tid < 32) P.e = *(const f32x4*)(ET + ((R) >> 6) * 512u + h * 128 + tid * 4); } while (0)
    GLA_PREFETCH(PA, rbase);
    if (nch > 1) GLA_PREFETCH(PB, rbase + 64);
    f32x4 po0 = {0.f, 0.f, 0.f, 0.f}, po1 = {0.f, 0.f, 0.f, 0.f}; unsigned prow = 0; bool pend = false;
#define GLA_STORE_OUT() do { \
            _Pragma("unroll") for (int x2 = 0; x2 < 2; ++x2) { \
                const unsigned row = prow + (ip * 2 + x2) * 16 + r16; \
                const f32x4 o = x2 ? po1 : po0; \
                u32x2 wv; wv.x = cvt_pk_bf16(o[0], o[1]); wv.y = cvt_pk_bf16(o[2], o[3]); \
                *(u32x2*)(BVo + row * 1024u + h * 256 + e0 + et * 16 + q4 * 4) = wv; \
                float ss = o[0] * o[0] + o[1] * o[1] + o[2] * o[2] + o[3] * o[3]; \
                ss += __shfl_xor(ss, 16); ss += __shfl_xor(ss, 32); \
                if (q4 == 0) BOSQP[row * 64u + h * 16 + sl * 4 + et] = ss; \
            } } while (0)
#define GLA_CHUNK(P, CI) do { \
        const unsigned r0 = rbase + (unsigned)(CI) * 64; \
        *(LAS u32x4*)(QG + pt0 * 136 + poc * 8) = P.q0; *(LAS u32x4*)(QG + pt1 * 136 + poc * 8) = P.q1; \
        *(LAS u32x4*)(KG + pt0 * 136 + poc * 8) = P.k0; *(LAS u32x4*)(KG + pt1 * 136 + poc * 8) = P.k1; \
        *(LAS u32x4*)(As + vt * 72 + veo * 8) = P.a; *(LAS u32x4*)(Vs + vt * 72 + veo * 8) = P.v; \
        if (tid < 32) *(LAS f32x4*)(GL + tid * 4) = P.e; \
        lds_barrier(); \
        if (pend) GLA_STORE_OUT(); \
        if ((CI) + 2 < nch) GLA_PREFETCH(P, r0 + 128); \
        bf16x8 vf[2]; \
        { bf16x4 a0, a1, b0, b1; \
          asm volatile("ds_read_b64_tr_b16 %0, %4\n\tds_read_b64_tr_b16 %1, %4 offset:576\n\tds_read_b64_tr_b16 %2, %4 offset:4608\n\tds_read_b64_tr_b16 %3, %4 offset:5184\n\ts_waitcnt lgkmcnt(0)" \
                       : "=&v"(a0), "=&v"(a1), "=&v"(b0), "=&v"(b1) : "v"(v4a) : "memory"); \
          vf[0] = cat4(a0, a1); vf[1] = cat4(b0, b1); } \
        f32x4 ot[2]; \
        ot[0] = (f32x4){0.f, 0.f, 0.f, 0.f}; ot[1] = (f32x4){0.f, 0.f, 0.f, 0.f}; \
        _Pragma("unroll") for (int x2 = 0; x2 < 2; ++x2) \
            _Pragma("unroll") for (int jb = 0; jb < 2; ++jb) { \
                const bf16x8 af = *(const LAS bf16x8*)(As + ((ip * 2 + x2) * 16 + r16) * 72 + jb * 32 + q4 * 8); \
                ot[x2] = MFMA16(vf[jb], af, ot[x2]); } \
        _Pragma("unroll") for (int db = 0; db < 4; ++db) { \
            const bf16x8 sf = pack8(Sacc[2 * db], Sacc[2 * db + 1]); \
            _Pragma("unroll") for (int x2 = 0; x2 < 2; ++x2) { \
                const LAS bf16_t* qp = QG + ((ip * 2 + x2) * 16 + r16) * 136 + db * 32 + q4 * 4; \
                const bf16x8 qv = cat4(*(const LAS bf16x4*)qp, *(const LAS bf16x4*)(qp + 16)); \
                ot[x2] = MFMA16(sf, qv, ot[x2]); } } \
        po0 = ot[0]; po1 = ot[1]; prow = r0; pend = true; \
        _Pragma("unroll") for (int jb = 0; jb < 2; ++jb) { \
            bf16x4 kl[8], kh[8]; \
            const unsigned ka = k4a + (unsigned)(jb * 32 * 272); \
            asm volatile("ds_read_b64_tr_b16 %0, %16 offset:0\n\t" "ds_read_b64_tr_b16 %1, %16 offset:1088\n\t" "ds_read_b64_tr_b16 %2, %16 offset:32\n\t" "ds_read_b64_tr_b16 %3, %16 offset:1120\n\t" "ds_read_b64_tr_b16 %4, %16 offset:64\n\t" "ds_read_b64_tr_b16 %5, %16 offset:1152\n\t" "ds_read_b64_tr_b16 %6, %16 offset:96\n\t" "ds_read_b64_tr_b16 %7, %16 offset:1184\n\t" "ds_read_b64_tr_b16 %8, %16 offset:128\n\t" "ds_read_b64_tr_b16 %9, %16 offset:1216\n\t" "ds_read_b64_tr_b16 %10, %16 offset:160\n\t" "ds_read_b64_tr_b16 %11, %16 offset:1248\n\t" "ds_read_b64_tr_b16 %12, %16 offset:192\n\t" "ds_read_b64_tr_b16 %13, %16 offset:1280\n\t" "ds_read_b64_tr_b16 %14, %16 offset:224\n\t" "ds_read_b64_tr_b16 %15, %16 offset:1312\n\t" "s_waitcnt lgkmcnt(0)" \
                         : "=&v"(kl[0]), "=&v"(kh[0]), "=&v"(kl[1]), "=&v"(kh[1]), "=&v"(kl[2]), "=&v"(kh[2]), "=&v"(kl[3]), "=&v"(kh[3]), "=&v"(kl[4]), "=&v"(kh[4]), "=&v"(kl[5]), "=&v"(kh[5]), "=&v"(kl[6]), "=&v"(kh[6]), "=&v"(kl[7]), "=&v"(kh[7]) : "v"(ka) : "memory"); \
            _Pragma("unroll") for (int d8 = 0; d8 < 8; ++d8) Sacc[d8] = MFMA16(cat4(kl[d8], kh[d8]), vf[jb], Sacc[d8]); } \
        _Pragma("unroll") for (int d8 = 0; d8 < 8; ++d8) { \
            const f32x4 dec = *(const LAS f32x4*)(GL + d8 * 16 + q4 * 4); \
            Sacc[d8] = Sacc[d8] * dec; } \
        lds_barrier(); \
    } while (0)
    for (int ci = 0; ci < nch; ci += 2) {
        GLA_CHUNK(PA, ci);
        if (ci + 1 < nch) GLA_CHUNK(PB, ci + 1);
    }
    if (pend) GLA_STORE_OUT();
#undef GLA_STORE_OUT
#undef GLA_PREFETCH
#undef GLA_CHUNK
    if (ip == 0 && !dummy) {
        float* og = p.out + (smp ? O_GS : O_GP);
#pragma unroll
        for (int d8 = 0; d8 < 8; ++d8)
#pragma unroll
            for (int jj = 0; jj < 4; ++jj) og[((size_t)(b * 4 + h) * 128 + d8 * 16 + q4 * 4 + jj) * 256 + e0 + et * 16 + r16] = Sacc[d8][jj];
    }
}

__device__ __forceinline__ void phase2a(const Params& p, LAS unsigned char* L) {
#ifndef NO_PREP
    {
        PrepRegs RA, RB; const int G = gridDim.x; int it = blockIdx.x;
        if (it < 2176) prep_load(p, it, RA);
        while (it < 2176) {
            int nx = it + G; gla_prep_item(p, L, it, RA, nx < 2176 ? nx : -1, RB); it = nx;
            if (it >= 2176) break;
            nx = it + G; gla_prep_item(p, L, it, RB, nx < 2176 ? nx : -1, RA); it = nx;
        }
    }
#endif
#ifndef NO_ATTN
    for (int it = blockIdx.x; it < 2176; it += gridDim.x) attn_item(p, L, it, (bf16_t*)(p.ws + WS_GATE), 2048);
#endif
}
__device__ __forceinline__ void phase2b(const Params& p, LAS unsigned char* L) {
#ifndef NO_SCAN
#ifdef PROBE_SCAN2
    for (int it = blockIdx.x; it < 768; it += gridDim.x) gla_scan_item(p, L, it, true);
#endif
    if (gridDim.x == 256) {
        const int xcd = blockIdx.x & 7, loc = blockIdx.x >> 3;
        const int base = (xcd * 8 + (loc >> 2)) * 4 + (loc & 3);
        gla_scan_item(p, L, base, false); gla_scan_item(p, L, 256 + base, false); gla_scan_item(p, L, 512 + base, false);
    } else {
        for (int it = blockIdx.x; it < 768; it += gridDim.x) gla_scan_item(p, L, it, false);
    }
#endif
}

__device__ __forceinline__ void phase3(const Params& p) {
    unsigned char* ws = p.ws;
    const bf16_t* BV = (const bf16_t*)(ws + WS_BV); bf16_t* Yb = (bf16_t*)(ws + WS_GATE); const float* BOSQP = (const float*)((unsigned char*)p.out + SC_SQ);
    const float* gg = p.in[12];
    const long gtid = (long)blockIdx.x * NTHR + threadIdx.x, gsz = (long)gridDim.x * NTHR;
    const long total = (long)T * 128;
    for (long it = gtid; it < total; it += gsz) {
        const long row = it >> 7; const int c8 = (int)(it & 127) * 8, h = c8 >> 8;
        float sq;
        { const f32x4 s0 = *(const f32x4*)(BOSQP + row * 64 + h * 16), s1 = *(const f32x4*)(BOSQP + row * 64 + h * 16 + 4), s2 = *(const f32x4*)(BOSQP + row * 64 + h * 16 + 8), s3 = *(const f32x4*)(BOSQP + row * 64 + h * 16 + 12);
          sq = ((s0[0] + s0[1]) + (s0[2] + s0[3])) + ((s1[0] + s1[1]) + (s1[2] + s1[3])) + ((s2[0] + s2[1]) + (s2[2] + s2[3])) + ((s3[0] + s3[1]) + (s3[2] + s3[3])); }
        const float rs = rsqrtf(sq * (1.f / 256.f) + EPS);
        const u32x4 bo = *(const u32x4*)(BV + row * 1024 + c8);
        const u32x4 gt = *(const u32x4*)(Yb + row * 2048 + 1024 + c8);
        const f32x4 g0 = *(const f32x4*)(gg + (c8 & 255)), g1 = *(const f32x4*)(gg + (c8 & 255) + 4);
        u32x4 o;
        o.x = cvt_pk_bf16(bflo(bo.x) * rs * g0[0] * siluf(bflo(gt.x)), bfhi(bo.x) * rs * g0[1] * siluf(bfhi(gt.x)));
        o.y = cvt_pk_bf16(bflo(bo.y) * rs * g0[2] * siluf(bflo(gt.y)), bfhi(bo.y) * rs * g0[3] * siluf(bfhi(gt.y)));
        o.z = cvt_pk_bf16(bflo(bo.z) * rs * g1[0] * siluf(bflo(gt.z)), bfhi(bo.z) * rs * g1[1] * siluf(bfhi(gt.z)));
        o.w = cvt_pk_bf16(bflo(bo.w) * rs * g1[2] * siluf(bflo(gt.w)), bfhi(bo.w) * rs * g1[3] * siluf(bfhi(gt.w)));
        *(u32x4*)(Yb + row * 2048 + 1024 + c8) = o;
    }
}

__device__ __forceinline__ void lru_item(const Params& p, LAS unsigned char* L, int item) {
    unsigned char* ws = p.ws;
    const int tid = threadIdx.x, lane = tid & 63, w = tid >> 6, r16 = lane & 15, q4 = lane >> 4;
    LAS bf16_t* Wl = (LAS bf16_t*)L;
    LAS bf16_t* U = (LAS bf16_t*)(L + 76800);
    LAS float* Aa = (LAS float*)(L + 102400);
    LAS float* Bb = (LAS float*)(L + 126976);
    LAS float* SP = (LAS float*)(L + 151552);
    LAS float* SH = (LAS float*)(L + 153088);
    LAS float* HC = (LAS float*)(L + 154624);
    LAS float* CW = (LAS float*)(L + 155392);
    const bool smp = item >= 256;
    const int i2 = smp ? item - 256 : item;
    const int b = i2 >> 4, nb = (i2 >> 1) & 7, hf = i2 & 1;
    const int nch = smp ? 1 : 32;
    const unsigned rbase = smp ? (unsigned)T_P + b * 64 : (unsigned)b * 2048;
    const bf16_t* Z2 = (const bf16_t*)(ws + WS_Z2); bf16_t* Y2 = (bf16_t*)(ws + WS_Y2);
    const bf16_t* WA = (const bf16_t*)(ws + WS_WA) + nb * 192 * 192; const bf16_t* WI = (const bf16_t*)(ws + WS_WI) + nb * 192 * 192;
    for (int idx = tid; idx < 192 * 24; idx += NTHR) {
        const int r = idx / 24, g8 = idx % 24;
        const bf16_t* src = (r < 96) ? WA + (size_t)(hf * 96 + r) * 192 + g8 * 8 : WI + (size_t)(hf * 96 + r - 96) * 192 + g8 * 8;
        *(LAS u32x4*)(Wl + r * 200 + g8 * 8) = *(const u32x4*)src;
    }
    const bool cthr = tid < 384;
    const int cgp = tid % 24, tq = (tid / 24) & 15;
    const int chc = nb * 192 + cgp * 8;
    for (int idx = tid; idx < 5 * 192; idx += NTHR) { const int j = idx / 192, cc = idx % 192; CW[idx] = (j < 4) ? p.in[16][j * 1536 + nb * 192 + cc] : p.in[17][nb * 192 + cc]; }
    const int mt = w & 3, pg = w >> 2;
    float bra[3], bri[3], sp[3];
#pragma unroll
    for (int cp = 0; cp < 3; ++cp) {
        const int ch = nb * 192 + hf * 96 + (pg * 3 + cp) * 16 + r16;
        bra[cp] = p.in[19][ch]; bri[cp] = p.in[21][ch];
        const float lam = p.in[22][ch];
        sp[cp] = 8.f * (fmaxf(-lam, 0.f) + log1pf(__expf(-fabsf(lam))));
    }
    if (tid < 96) HC[tid] = smp ? p.in[6][b * 1536 + nb * 192 + hf * 96 + tid] : 0.f;
    const int sch0 = tid % 96, sseg0 = (tid / 96) & 3;
    const int ot0 = tid / 12, og0 = tid % 12, ot1 = (tid + 512) / 12, og1 = (tid + 512) % 12;
    const bool o1 = tid < 256;
    const int och0 = nb * 192 + hf * 96 + og0 * 8, och1 = nb * 192 + hf * 96 + og1 * 8;
    lds_barrier();
    u32x4 xr[7]; u32x4 pg0, pg1 = {0u, 0u, 0u, 0u};
#pragma unroll
    for (int r = 0; r < 7; ++r) {
        xr[r] = (u32x4){0u, 0u, 0u, 0u};
        const int pos = 4 * tq - 3 + r;
        if (cthr) {
            if (pos >= 0) xr[r] = *(const u32x4*)(Z2 + (unsigned)((rbase + pos) * 3072u + chc));
            else if (smp) {
                const float* hp = p.in[5] + ((size_t)b * 3 + (3 + pos)) * 1536 + chc;
                const f32x4 h0 = *(const f32x4*)hp, h1 = *(const f32x4*)(hp + 4);
                xr[r].x = cvt_pk_bf16(h0[0], h0[1]); xr[r].y = cvt_pk_bf16(h0[2], h0[3]); xr[r].z = cvt_pk_bf16(h1[0], h1[1]); xr[r].w = cvt_pk_bf16(h1[2], h1[3]);
            }
        }
    }
    pg0 = *(const u32x4*)(Z2 + (unsigned)((rbase + ot0) * 3072u + 1536 + och0));
    if (o1) pg1 = *(const u32x4*)(Z2 + (unsigned)((rbase + ot1) * 3072u + 1536 + och1));
    u32x4 so0 = {0u, 0u, 0u, 0u}, so1 = {0u, 0u, 0u, 0u}; unsigned sr = 0; bool spend = false;
    for (int ci = 0; ci < nch; ++ci) {
        const unsigned r0 = rbase + (unsigned)ci * 64;
        const bool more = (ci + 1 < nch);
        int sch = sch0, sseg = sseg0;
        asm volatile("" : "+v"(sch), "+v"(sseg));
        if (cthr) {
            float xv[7][8];
#pragma unroll
            for (int r = 0; r < 7; ++r) unpack8(xr[r], xv[r]);
            if (hf == 0 && !more && tq == 15) {
                float* oc = p.out + (smp ? O_CS : O_CP) + (size_t)b * 3 * 1536 + chc;
#pragma unroll
                for (int r = 0; r < 3; ++r) { *(f32x4*)(oc + r * 1536) = (f32x4){xv[4 + r][0], xv[4 + r][1], xv[4 + r][2], xv[4 + r][3]}; *(f32x4*)(oc + r * 1536 + 4) = (f32x4){xv[4 + r][4], xv[4 + r][5], xv[4 + r][6], xv[4 + r][7]}; }
            }
            float cw[5][8];
#pragma unroll
            for (int j = 0; j < 5; ++j) { const f32x4 c0 = *(const LAS f32x4*)(CW + j * 192 + cgp * 8), c1 = *(const LAS f32x4*)(CW + j * 192 + cgp * 8 + 4);
                cw[j][0] = c0[0]; cw[j][1] = c0[1]; cw[j][2] = c0[2]; cw[j][3] = c0[3]; cw[j][4] = c1[0]; cw[j][5] = c1[1]; cw[j][6] = c1[2]; cw[j][7] = c1[3]; }
#pragma unroll
            for (int tk = 0; tk < 4; ++tk) {
                float acc[8];
#pragma unroll
                for (int e = 0; e < 8; ++e) acc[e] = cw[4][e] + xv[tk][e] * cw[0][e] + xv[tk + 1][e] * cw[1][e] + xv[tk + 2][e] * cw[2][e] + xv[tk + 3][e] * cw[3][e];
                u32x4 uw; uw.x = cvt_pk_bf16(acc[0], acc[1]); uw.y = cvt_pk_bf16(acc[2], acc[3]); uw.z = cvt_pk_bf16(acc[4], acc[5]); uw.w = cvt_pk_bf16(acc[6], acc[7]);
                *(LAS u32x4*)(U + (4 * tq + tk) * 200 + cgp * 8) = uw;
            }
            if (more) {
#pragma unroll
                for (int r = 0; r < 7; ++r) xr[r] = *(const u32x4*)(Z2 + (unsigned)((r0 + 64 + 4 * tq - 3 + r) * 3072u + chc));
            }
        }
        lds_barrier();
        if (spend) { *(u32x4*)(Y2 + (unsigned)((sr + ot0) * 1536u + och0)) = so0; if (o1) *(u32x4*)(Y2 + (unsigned)((sr + ot1) * 1536u + och1)) = so1; }
        f32x4 ga[3], gi[3];
#pragma unroll
        for (int cp = 0; cp < 3; ++cp) { ga[cp] = (f32x4){0.f, 0.f, 0.f, 0.f}; gi[cp] = (f32x4){0.f, 0.f, 0.f, 0.f}; }
#pragma unroll 2
        for (int ks = 0; ks < 6; ++ks) {
            const bf16x8 uf = *(const LAS bf16x8*)(U + (mt * 16 + r16) * 200 + ks * 32 + q4 * 8);
#pragma unroll
            for (int cp = 0; cp < 3; ++cp) {
                const int ct = pg * 3 + cp;
                const bf16x8 wa = *(const LAS bf16x8*)(Wl + (ct * 16 + r16) * 200 + ks * 32 + q4 * 8), wi = *(const LAS bf16x8*)(Wl + (96 + ct * 16 + r16) * 200 + ks * 32 + q4 * 8);
                ga[cp] = MFMA16(uf, wa, ga[cp]); gi[cp] = MFMA16(uf, wi, gi[cp]);
            }
        }
#pragma unroll
        for (int cp = 0; cp < 3; ++cp) {
            const int cl = (pg * 3 + cp) * 16 + r16;
#pragma unroll
            for (int jj = 0; jj < 4; ++jj) {
                const int t = mt * 16 + q4 * 4 + jj;
                const float rg = sigmf(ga[cp][jj] + bra[cp]), ig = sigmf(gi[cp][jj] + bri[cp]);
                const float z = rg * sp[cp];
                const float a = __expf(-z);
                const float z2 = z + z;
                const float om = (z2 < 0.05f) ? z2 * (1.f - z2 * (0.5f - z2 * (0.16666667f - z2 * 0.041666668f))) : 1.f - a * a;
                const float uu = bf2f(U[t * 200 + hf * 96 + cl]);
                Aa[t * 96 + cl] = a; Bb[t * 96 + cl] = __builtin_amdgcn_sqrtf(om) * ig * uu;
            }
        }
        lds_barrier();
        if (cthr) {
            float P = 1.f, H = 0.f;
#pragma unroll
            for (int t = 0; t < 16; ++t) { const float a = Aa[(sseg * 16 + t) * 96 + sch]; H = a * H + Bb[(sseg * 16 + t) * 96 + sch]; P *= a; }
            SP[sseg * 96 + sch] = P; SH[sseg * 96 + sch] = H;
        }
        lds_barrier();
        if (cthr) {
            float hh = HC[(ci & 1) * 96 + sch];
#pragma unroll
            for (int sg = 0; sg < 3; ++sg) if (sg < sseg) hh = SP[sg * 96 + sch] * hh + SH[sg * 96 + sch];
#pragma unroll
            for (int t = 0; t < 16; ++t) { hh = Aa[(sseg * 16 + t) * 96 + sch] * hh + Bb[(sseg * 16 + t) * 96 + sch]; Bb[(sseg * 16 + t) * 96 + sch] = hh; }
            if (sseg == 3) HC[((ci + 1) & 1) * 96 + sch] = hh;
        }
        lds_barrier();
        {
            const f32x4 h0 = *(const LAS f32x4*)(Bb + ot0 * 96 + og0 * 8), h1 = *(const LAS f32x4*)(Bb + ot0 * 96 + og0 * 8 + 4);
            u32x4 o;
            o.x = cvt_pk_bf16(h0[0] * siluf(bflo(pg0.x)), h0[1] * siluf(bfhi(pg0.x)));
            o.y = cvt_pk_bf16(h0[2] * siluf(bflo(pg0.y)), h0[3] * siluf(bfhi(pg0.y)));
            o.z = cvt_pk_bf16(h1[0] * siluf(bflo(pg0.z)), h1[1] * siluf(bfhi(pg0.z)));
            o.w = cvt_pk_bf16(h1[2] * siluf(bflo(pg0.w)), h1[3] * siluf(bfhi(pg0.w)));
            so0 = o;
            if (more) pg0 = *(const u32x4*)(Z2 + (unsigned)((r0 + 64 + ot0) * 3072u + 1536 + och0));
        }
        if (o1) {
            const f32x4 h0 = *(const LAS f32x4*)(Bb + ot1 * 96 + og1 * 8), h1 = *(const LAS f32x4*)(Bb + ot1 * 96 + og1 * 8 + 4);
            u32x4 o;
            o.x = cvt_pk_bf16(h0[0] * siluf(bflo(pg1.x)), h0[1] * siluf(bfhi(pg1.x)));
            o.y = cvt_pk_bf16(h0[2] * siluf(bflo(pg1.y)), h0[3] * siluf(bfhi(pg1.y)));
            o.z = cvt_pk_bf16(h1[0] * siluf(bflo(pg1.z)), h1[1] * siluf(bfhi(pg1.z)));
            o.w = cvt_pk_bf16(h1[2] * siluf(bflo(pg1.w)), h1[3] * siluf(bfhi(pg1.w)));
            so1 = o;
            if (more) pg1 = *(const u32x4*)(Z2 + (unsigned)((r0 + 64 + ot1) * 3072u + 1536 + och1));
        }
        sr = r0; spend = true;
        lds_barrier();
    }
    if (spend) { *(u32x4*)(Y2 + (unsigned)((sr + ot0) * 1536u + och0)) = so0; if (o1) *(u32x4*)(Y2 + (unsigned)((sr + ot1) * 1536u + och1)) = so1; }
    if (tid < 96) p.out[(smp ? O_LS : O_LP) + (size_t)b * 1536 + nb * 192 + hf * 96 + tid] = HC[(nch & 1) * 96 + tid];
    lds_barrier();
}

__device__ __forceinline__ void phase6(const Params& p, LAS unsigned char* L) {
    if (gridDim.x == 256) {
        const int xcd = blockIdx.x & 7, loc = blockIdx.x >> 3;
        const int pair = xcd * 16 + (loc >> 1), hf = loc & 1;
        lru_item(p, L, pair * 2 + hf); lru_item(p, L, 256 + pair * 2 + hf); lru_item(p, L, 512 + pair * 2 + hf);
    } else {
        for (int it = blockIdx.x; it < 768; it += gridDim.x) lru_item(p, L, it);
    }
}

__device__ __forceinline__ void phase8(const Params& p) {
    const float* rsq = (const float*)(p.ws + WS_RSQ2); const float* g = p.in[24]; float* y = p.out; const bf16_t* xb = (const bf16_t*)(p.ws + WS_XB);
    const long gtid = (long)blockIdx.x * NTHR + threadIdx.x, gsz = (long)gridDim.x * NTHR;
    const long total = (long)T * 128;
    for (long it = gtid; it < total; it += gsz) {
        const long row = it >> 7; const int c8 = (int)(it & 127) * 8;
        const float rs = rsqrtf(rsq[row] * (1.f / 1024.f) + EPS);
        const u32x4 xw = *(const u32x4*)(xb + row * 1024 + c8);
        const f32x4 g0 = *(const f32x4*)(g + c8), g1 = *(const f32x4*)(g + c8 + 4);
        f32x4 o0, o1;
        o0[0] = bflo(xw.x) * rs * g0[0]; o0[1] = bfhi(xw.x) * rs * g0[1]; o0[2] = bflo(xw.y) * rs * g0[2]; o0[3] = bfhi(xw.y) * rs * g0[3];
        o1[0] = bflo(xw.z) * rs * g1[0]; o1[1] = bfhi(xw.z) * rs * g1[1]; o1[2] = bflo(xw.w) * rs * g1[2]; o1[3] = bfhi(xw.w) * rs * g1[3];
        *(f32x4*)(y + row * 1024 + c8) = o0; *(f32x4*)(y + row * 1024 + c8 + 4) = o1;
    }
}

#define XB_TMO      128
#define XB_XCNT(j)  (256  + 64 * (j))
#define XB_XSUB(j)  (1280 + 64 * (j))
#define XB_XGEN(j)  (2304 + 64 * (j))
#define XB_TOP      3328
#define XB_TOPGEN   3392
#define XCD_BAR_WORDS 3456
#define XB_SPIN_CAP (1u << 18)
__device__ __forceinline__ unsigned xb_ld(unsigned* p)              { return __hip_atomic_load(p, __ATOMIC_RELAXED, __HIP_MEMORY_SCOPE_AGENT); }
__device__ __forceinline__ unsigned xb_add(unsigned* p, unsigned v) { return __hip_atomic_fetch_add(p, v, __ATOMIC_RELAXED, __HIP_MEMORY_SCOPE_AGENT); }
__device__ __forceinline__ unsigned xb_xcc_id() { return (unsigned)__builtin_amdgcn_s_getreg((3 << 11) | 20) & 0xFu; }
#define XB_SPIN(cond, bar) do { unsigned _sp = 0; while (cond) { __builtin_amdgcn_s_sleep(1); \
    if ((++_sp & 255u) == 0u) { if (xb_ld(&(bar)[XB_TMO])) break; if (_sp > XB_SPIN_CAP) { atomicAdd(&(bar)[XB_TMO], 1u); break; } } } } while (0)
struct XcdBarrier { unsigned* bar; unsigned x; volatile LAS unsigned* st; };
__device__ __forceinline__ XcdBarrier xcd_barrier_post(unsigned* bar, volatile LAS unsigned* st) {
    XcdBarrier b; b.bar = bar; b.x = xb_xcc_id(); b.st = st;
    if (threadIdx.x == 0) (void)xb_add(&bar[XB_XCNT(b.x)], 1u);
    return b;
}
__device__ __forceinline__ void xcd_barrier_complete(unsigned* bar, unsigned x, unsigned& nloc, unsigned& nx) {
    const unsigned G = gridDim.x * gridDim.y * gridDim.z;
    unsigned sum, cnt, mine, sp = 0u;
    for (;;) {
        sum = 0u; cnt = 0u; mine = 0u;
#pragma unroll
        for (unsigned j = 0; j < 16; ++j) { const unsigned c = xb_ld(&bar[XB_XCNT(j)]); sum += c; cnt += (c > 0u) ? 1u : 0u; mine = (j == x) ? c : mine; }
        if (sum == G) break;
        __builtin_amdgcn_s_sleep(1);
        if ((++sp & 255u) == 0u) { if (xb_ld(&bar[XB_TMO])) break; if (sp > XB_SPIN_CAP) { atomicAdd(&bar[XB_TMO], 1u); break; } }
    }
    nloc = mine > 0u ? mine : 1u; nx = cnt > 0u ? cnt : 1u;
}
__device__ __forceinline__ void xcd_barrier(const XcdBarrier& b) {
    asm volatile("s_waitcnt vmcnt(0)" ::: "memory");
    __syncthreads();
    if (threadIdx.x == 0) {
        unsigned* bar = b.bar;
        __builtin_amdgcn_s_waitcnt(0);
        unsigned nloc = b.st[0], nx = b.st[1];
        if (nloc == 0u) { xcd_barrier_complete(bar, b.x, nloc, nx); b.st[0] = nloc; b.st[1] = nx; }
        const unsigned old = xb_add(&bar[XB_XSUB(b.x)], 1u);
        const unsigned gen = old / nloc;
        if (old + 1u == (gen + 1u) * nloc) {
            __builtin_amdgcn_fence(__ATOMIC_RELEASE, "agent");
            asm volatile("s_waitcnt vmcnt(0)" ::: "memory");
            const unsigned og = xb_add(&bar[XB_TOP], 1u);
            const unsigned tg = og / nx;
            if (og + 1u == (tg + 1u) * nx) xb_add(&bar[XB_TOPGEN], 1u);
            else XB_SPIN(xb_ld(&bar[XB_TOPGEN]) == tg, bar);
            __builtin_amdgcn_fence(__ATOMIC_ACQUIRE, "agent");
            xb_add(&bar[XB_XGEN(b.x)], 1u);
            asm volatile("s_waitcnt vmcnt(0)" ::: "memory");
        } else {
            XB_SPIN(xb_ld(&bar[XB_XGEN(b.x)]) == gen, bar);
            __builtin_amdgcn_fence(__ATOMIC_ACQUIRE, "agent");
            asm volatile("s_waitcnt vmcnt(0)" ::: "memory");
        }
    }
    __syncthreads();
}

__global__ void __launch_bounds__(NTHR) mega(Params p) {
    extern __shared__ __attribute__((aligned(16))) unsigned char lds_raw[];
    LAS unsigned char* L = (LAS unsigned char*)lds_raw;
    cg::grid_group grid = cg::this_grid();
    unsigned char* ws = p.ws;
    const int lo = p.ph_lo, hi = p.ph_hi;
    LAS unsigned* stw = (LAS unsigned*)(L + (LDS_BYTES - 16));
    if (threadIdx.x < 4) stw[threadIdx.x] = 0u;
    __syncthreads();
    const XcdBarrier xb = xcd_barrier_post((unsigned*)(ws + WS_BAR), (volatile LAS unsigned*)stw);
#ifndef PHMASK
#define PHMASK 0x1ff
#endif
#define IN(k) (((PHMASK >> (k)) & 1) && lo <= (k) && (k) < hi)
#define SEAM(k) do { if (IN(k) && IN((k) + 1)) xcd_barrier(xb); } while (0)
    if (hi > 1000) grid.sync();
    if (IN(0)) phase0(p);
    SEAM(0);
    if (IN(1)) {
        pg8::Gemm g{(const bf16_t*)(ws + WS_XB), (const bf16_t*)(ws + WS_WINE), T, NE_PAD, 1024};
        pg8::StaticOrder S; S.init(T, NE_PAD, gridDim.x, blockIdx.x);
        EpiInEven E{ws, p.out, (const float*)(ws + WS_RSTD0), p.in[10]};
        pg8::gemm_phase<EpiInEven>(L, g, S, E);
    }
    SEAM(1);
    if (IN(2)) { phase2a(p, L); xcd_barrier(xb); phase2b(p, L); }
    SEAM(2);
    if (IN(3)) phase3(p);
    SEAM(3);
    if (IN(4)) {
        pg8::Gemm g{(const bf16_t*)(ws + WS_GATE), (const bf16_t*)(ws + WS_WOUTE), T, 1024, 2048};
        pg8::StaticOrder S; S.init(T, 1024, gridDim.x, blockIdx.x);
        EpiOutResB E{(bf16_t*)(ws + WS_XB), (float*)(ws + WS_RSQ1)};
        pg8::gemm_phase<EpiOutResB>(L, g, S, E);
    }
    SEAM(4);
    if (IN(5)) {
        pg8::Gemm g{(const bf16_t*)(ws + WS_XB), (const bf16_t*)(ws + WS_WINO), T, 3072, 1024};
        pg8::StaticOrder S; S.init(T, 3072, gridDim.x, blockIdx.x);
        EpiInOdd E{(bf16_t*)(ws + WS_Z2), (const float*)(ws + WS_RSQ1)};
        pg8::gemm_phase<EpiInOdd>(L, g, S, E);
    }
    SEAM(5);
    if (IN(6)) phase6(p, L);
    SEAM(6);
    if (IN(7)) {
        pg8::Gemm g{(const bf16_t*)(ws + WS_Y2), (const bf16_t*)(ws + WS_WOUTO), T, 1024, 1536};
        pg8::StaticOrder S; S.init(T, 1024, gridDim.x, blockIdx.x);
        EpiOutResB E{(bf16_t*)(ws + WS_XB), (float*)(ws + WS_RSQ2)};
        pg8::gemm_phase<EpiOutResB>(L, g, S, E);
    }
    SEAM(7);
    if (IN(8)) phase8(p);
#undef IN
#undef SEAM
}

extern "C" void kernel_launch(void* const* d_in, const int* in_sizes, int n_in, void* d_out, int out_size, void* d_ws, size_t ws_size, hipStream_t stream) {
    static int grid_blocks = 0;
    if (grid_blocks == 0) {
        if (n_in != 25 || (size_t)out_size != O_END || ws_size < WS_TOTAL) { fprintf(stderr, "kernel_launch: unexpected shapes n_in %d out %d ws %zu (need %zu)\n", n_in, out_size, ws_size, (size_t)WS_END); grid_blocks = -1; return; }
        int dev = 0, cus = 0, per_cu = 0;
        (void)hipGetDevice(&dev);
        (void)hipDeviceGetAttribute(&cus, hipDeviceAttributeMultiprocessorCount, dev);
        if (hipFuncSetAttribute((const void*)mega, hipFuncAttributeMaxDynamicSharedMemorySize, LDS_BYTES) != hipSuccess) { fprintf(stderr, "kernel_launch: hipFuncSetAttribute failed\n"); }
        if (hipOccupancyMaxActiveBlocksPerMultiprocessor(&per_cu, (const void*)mega, NTHR, LDS_BYTES) != hipSuccess || per_cu < 1) per_cu = 1;
        (void)hipGetLastError();
        grid_blocks = cus * per_cu;
        if (grid_blocks <= 0) grid_blocks = 256;
    }
    if (grid_blocks < 0) return;
    Params p{};
    for (int i = 0; i < 25; ++i) p.in[i] = (const float*)d_in[i];
    p.out = (float*)d_out; p.ws = (unsigned char*)d_ws;
#if ONE_LAUNCH
#ifdef PROBE_X
    { const int seq[3][2] = {{0, PROBE_Y + 1}, {PROBE_X, PROBE_Y + 1}, {PROBE_Y + 1, 9}};
      for (int li = 0; li < 3; ++li) { if (seq[li][0] >= seq[li][1]) continue; p.ph_lo = seq[li][0]; p.ph_hi = seq[li][1]; void* args[] = {&p};
        (void)hipMemsetAsync((char*)d_ws + WS_BAR, 0, 16384, stream);
        hipError_t e = hipLaunchCooperativeKernel((const void*)mega, dim3(grid_blocks), dim3(NTHR), args, LDS_BYTES, stream);
        if (e != hipSuccess) fprintf(stderr, "cooperative launch failed: %s (grid %d)\n", hipGetErrorString(e), grid_blocks); } }
#else
    p.ph_lo = 0; p.ph_hi = 9;
    (void)hipMemsetAsync((char*)d_ws + WS_BAR, 0, 16384, stream);
    { void* args[] = {&p}; hipError_t e = hipLaunchCooperativeKernel((const void*)mega, dim3(grid_blocks), dim3(NTHR), args, LDS_BYTES, stream);
      if (e != hipSuccess) fprintf(stderr, "cooperative launch failed: %s (grid %d)\n", hipGetErrorString(e), grid_blocks); }
#endif
#else
    for (int ph = 0; ph < 9; ++ph) {
        p.ph_lo = ph; p.ph_hi = ph + 1;
        (void)hipMemsetAsync((char*)d_ws + WS_BAR, 0, 16384, stream);
        void* args[] = {&p}; hipError_t e = hipLaunchCooperativeKernel((const void*)mega, dim3(grid_blocks), dim3(NTHR), args, LDS_BYTES, stream);
        if (e != hipSuccess) fprintf(stderr, "cooperative launch %d failed: %s (grid %d)\n", ph, hipGetErrorString(e), grid_blocks);
    }
#endif
}
```

```cpp
#include <hip/hip_runtime.h>
#include <hip/hip_cooperative_groups.h>
#include <cstdio>
namespace cg = cooperative_groups;

#ifndef ONE_LAUNCH
#define ONE_LAUNCH 1
#endif

#define LAS __attribute__((address_space(3)))
typedef unsigned short bf16_t;
typedef short bf16x8 __attribute__((ext_vector_type(8)));
typedef short bf16x4 __attribute__((ext_vector_type(4)));
typedef float f32x4 __attribute__((ext_vector_type(4)));
typedef unsigned u32x4 __attribute__((ext_vector_type(4)));
typedef unsigned u32x2 __attribute__((ext_vector_type(2)));

constexpr int T_P = 32768, T_S = 2048, T = T_P + T_S, DM = 1024;
constexpr int NE_PAD = 6144;
constexpr int LDS_BYTES = 159744;
constexpr int NTHR = 512;
constexpr float EPS = 1e-6f;

constexpr size_t WS_WINE = 0;
constexpr size_t WS_WOUTE = WS_WINE + (size_t)NE_PAD * 1024 * 2;
constexpr size_t WS_WINO = WS_WOUTE + (size_t)1024 * 2048 * 2;
constexpr size_t WS_WOUTO = WS_WINO + (size_t)3072 * 1024 * 2;
constexpr size_t WS_WA = WS_WOUTO + (size_t)1024 * 1536 * 2;
constexpr size_t WS_WI = WS_WA + (size_t)8 * 192 * 192 * 2;
constexpr size_t WS_XB = WS_WI + (size_t)8 * 192 * 192 * 2;
constexpr size_t WS_RSTD0 = WS_XB + (size_t)T * 1024 * 2;
constexpr size_t WS_RSQ1 = WS_RSTD0 + (size_t)T * 4;
constexpr size_t WS_RSQ2 = WS_RSQ1 + (size_t)T * 4;
constexpr size_t WS_BOSQ = WS_RSQ2 + (size_t)T * 4;
constexpr size_t WS_Q = WS_BOSQ + (size_t)T * 16;
constexpr size_t WS_K = WS_Q + (size_t)T * 1024 * 2;
constexpr size_t WS_V = WS_K + (size_t)T * 256 * 2;
constexpr size_t WS_BQ = WS_V + (size_t)T * 256 * 2;
constexpr size_t WS_BK = WS_BQ + (size_t)T * 512 * 2;
constexpr size_t WS_BV = WS_BK + (size_t)T * 512 * 2;
constexpr size_t WS_GATE = WS_BV + (size_t)T * 1024 * 2;
constexpr size_t WS_BLR = WS_GATE + (size_t)T * 2048 * 2;
constexpr size_t WS_END = WS_BLR + (size_t)T * 512 * 2;
constexpr size_t WS_BAR = WS_END;
constexpr size_t WS_TOTAL = WS_BAR + 16384;
constexpr size_t WS_Z2 = WS_Q;
constexpr size_t WS_Y2 = WS_GATE;
static_assert(WS_Z2 + (size_t)T * 3072 * 2 <= WS_GATE, "Z2 alias");

constexpr size_t O_Y = 0;
constexpr size_t O_KP = (size_t)T * 1024;
constexpr size_t O_VP = O_KP + 524288;
constexpr size_t O_GP = O_VP + 524288;
constexpr size_t O_CP = O_GP + 2097152;
constexpr size_t O_LP = O_CP + 73728;
constexpr size_t O_KS = O_LP + 24576;
constexpr size_t O_VS = O_KS + 524288;
constexpr size_t O_GS = O_VS + 524288;
constexpr size_t O_CS = O_GS + 4194304;
constexpr size_t O_LS = O_CS + 147456;
constexpr size_t O_END = O_LS + 49152;

struct Params {
    const float* in[25];
    float* out;
    unsigned char* ws;
    int ph_lo, ph_hi;
};

__device__ __forceinline__ unsigned cvt_pk_bf16(float lo, float hi) { unsigned r; asm volatile("v_cvt_pk_bf16_f32 %0, %1, %2" : "=v"(r) : "v"(lo), "v"(hi)); return r; }
__device__ __forceinline__ bf16_t f2bf(float f) { return (bf16_t)(cvt_pk_bf16(f, 0.f) & 0xffffu); }
__device__ __forceinline__ float bf2f(bf16_t b) { return __uint_as_float(((unsigned)b) << 16); }
__device__ __forceinline__ float bflo(unsigned w) { return __uint_as_float(w << 16); }
__device__ __forceinline__ float bfhi(unsigned w) { return __uint_as_float(w & 0xffff0000u); }
__device__ __forceinline__ float rcpf_(float x) { return __builtin_amdgcn_rcpf(x); }
__device__ __forceinline__ float siluf(float x) { return x * rcpf_(1.f + __expf(-x)); }
__device__ __forceinline__ float sigmf(float x) { return rcpf_(1.f + __expf(-x)); }
__device__ __forceinline__ void lds_barrier() { asm volatile("s_waitcnt lgkmcnt(0)" ::: "memory"); __builtin_amdgcn_s_barrier(); asm volatile("" ::: "memory"); }
__device__ __forceinline__ bf16x8 pack8(const f32x4& a, const f32x4& b) {
    u32x4 p; p.x = cvt_pk_bf16(a[0], a[1]); p.y = cvt_pk_bf16(a[2], a[3]); p.z = cvt_pk_bf16(b[0], b[1]); p.w = cvt_pk_bf16(b[2], b[3]);
    return __builtin_bit_cast(bf16x8, p);
}
__device__ __forceinline__ bf16x8 cat4(const bf16x4 a, const bf16x4 b) { bf16x8 r; r[0] = a[0]; r[1] = a[1]; r[2] = a[2]; r[3] = a[3]; r[4] = b[0]; r[5] = b[1]; r[6] = b[2]; r[7] = b[3]; return r; }
__device__ __forceinline__ void unpack8(const u32x4 w, float (&v)[8]) { v[0] = bflo(w.x); v[1] = bfhi(w.x); v[2] = bflo(w.y); v[3] = bfhi(w.y); v[4] = bflo(w.z); v[5] = bfhi(w.z); v[6] = bflo(w.w); v[7] = bfhi(w.w); }
#define MFMA16(a, b, c) __builtin_amdgcn_mfma_f32_16x16x32_bf16((a), (b), (c), 0, 0, 0)

namespace pg8 {
constexpr int BM = 256, BK = 64, HALF = 128, HTB = HALF * BK * 2, STAGE_BYTES = 8 * HTB, NXCD = 8, WGM = 8;
__device__ __forceinline__ int lds_byte(int r, int c) { const int st = (r >> 4) * 2 + (c >> 5), rr = r & 15, cc = c & 31, ob = rr * 64 + cc * 2; return st * 1024 + (ob ^ (((ob >> 9) & 1) << 5)); }
__device__ __forceinline__ int perm32(int rho) { const int n = rho >> 4, i = rho & 15; return 8 * (i >> 2) + 4 * n + (i & 3); }
__device__ __forceinline__ void stage_rc(int b, int& R, int& C) { const int st = b / 1024, sb = b % 1024, swz = sb ^ (((sb >> 9) & 1) << 5); R = (st >> 1) * 16 + swz / 64; C = (st & 1) * 32 + (swz % 64) / 2; }
struct Unit { int pm, pn; };
struct Gemm { const bf16_t* A; const bf16_t* Bt; int M, N, K; };
struct StaticOrder {
    int nM, nN, nwg, G, c;
    __device__ void init(int M, int N, int G_, int c_) { nM = M / BM; nN = N / BM; nwg = nM * nN; G = G_; c = c_; }
    __device__ __forceinline__ bool next(int i, Unit& u) const {
        const long Lx = (long)i * G + c; if (Lx >= nwg) return false;
        int wgid = (int)Lx; { const int q = nwg / NXCD, r = nwg % NXCD, xcd = wgid % NXCD, off = wgid / NXCD; wgid = (xcd < r ? xcd * (q + 1) : r * (q + 1) + (xcd - r) * q) + off; }
        const int nig = WGM * nN, gid = wgid / nig, fm = gid * WGM, gsz = (nM - fm) < WGM ? (nM - fm) : WGM;
        u.pm = fm + ((wgid % nig) % gsz); u.pn = (wgid % nig) / gsz; return true;
    }
};

template <class Epi>
__device__ __forceinline__ void gemm_phase(LAS unsigned char* lds, const Gemm g, const StaticOrder& S, const Epi& E) {
    const int tid = threadIdx.x, wid = __builtin_amdgcn_readfirstlane(tid >> 6), lane = tid & 63, wr = wid >> 2, wc = wid & 3, fr = lane & 15, fq = lane >> 4;
    const int K = g.K, nt = K / BK;
    unsigned voffA[2], voffB[2];
#pragma unroll
    for (int i = 0; i < 2; ++i) { int R, C; stage_rc(tid * 16 + i * 8192, R, C); const int Rb = Epi::PERM ? ((R & ~31) + perm32(R & 31)) : R;
        voffA[i] = (unsigned)(R * K + C) * 2u; voffB[i] = (unsigned)(Rb * K + C) * 2u; }
    const size_t kstep = (size_t)(BK * 2);
    const size_t hstep = (size_t)HALF * K * 2;
    const size_t tstep = 2 * hstep;
    const unsigned ldsw = (unsigned)wid * 1024u;
    const int aoff = lds_byte(wr * 64 + fr, fq * 8), boff = lds_byte(wc * 32 + fr, fq * 8);
#define PG8_SA(b, h) (((b) * 2 + (h)) * HTB)
#define PG8_SB(b, h) ((4 + (b) * 2 + (h)) * HTB)
#define PG8_STAGE(bufoff, gbase, voff) do { _Pragma("unroll") for (int _i = 0; _i < 2; ++_i) \
        __builtin_amdgcn_global_load_lds((const unsigned*)((const char*)(gbase) + (voff)[_i]), (LAS unsigned*)(lds + (bufoff) + ldsw + _i * 8192), 16, 0, 0); } while (0)
#define PG8_LDA(dst, b, h) do { _Pragma("unroll") for (int m = 0; m < 4; ++m) _Pragma("unroll") for (int k = 0; k < 2; ++k) dst[m][k] = *(const LAS bf16x8*)(lds + PG8_SA(b, h) + aoff + m * 2048 + k * 1024); } while (0)
#define PG8_LDB(dst, b, h) do { _Pragma("unroll") for (int n = 0; n < 2; ++n) _Pragma("unroll") for (int k = 0; k < 2; ++k) dst[n][k] = *(const LAS bf16x8*)(lds + PG8_SB(b, h) + boff + n * 2048 + k * 1024); } while (0)
#define PG8_MMA(ai, bj, At, Bt) do { __builtin_amdgcn_s_setprio(1); _Pragma("unroll") for (int m = 0; m < 4; ++m) _Pragma("unroll") for (int n = 0; n < 2; ++n) _Pragma("unroll") for (int k = 0; k < 2; ++k) \
        acc[ai][bj][m][n] = __builtin_amdgcn_mfma_f32_16x16x32_bf16(Bt[n][k], At[m][k], acc[ai][bj][m][n], 0, 0, 0); __builtin_amdgcn_s_setprio(0); } while (0)
#define PG8_WAIT_V(n) asm volatile("s_waitcnt vmcnt(" #n ")" ::: "memory")
#define PG8_WAIT_L(n) asm volatile("s_waitcnt lgkmcnt(" #n ")" ::: "memory")
#define PG8_BAR __builtin_amdgcn_s_barrier()
#define PG8_SCHED __builtin_amdgcn_sched_barrier(0)
    Unit cur, nxt; int ui = 0;
    if (!S.next(0, cur)) return;
    f32x4 acc[2][2][4][2];
#pragma unroll
    for (int a = 0; a < 2; ++a)
#pragma unroll
        for (int b = 0; b < 2; ++b)
#pragma unroll
            for (int m = 0; m < 4; ++m)
#pragma unroll
                for (int n = 0; n < 2; ++n) acc[a][b][m][n] = (f32x4){0.f, 0.f, 0.f, 0.f};
    bf16x8 At[4][2], B0[2][2], B1[2][2];
    const char* cA = (const char*)g.A + (size_t)cur.pm * tstep; const char* cB = (const char*)g.Bt + (size_t)cur.pn * tstep;
    PG8_STAGE(PG8_SB(0, 0), cB, voffB); PG8_STAGE(PG8_SB(0, 1), cB + hstep, voffB); PG8_STAGE(PG8_SA(0, 0), cA, voffA); PG8_STAGE(PG8_SA(0, 1), cA + hstep, voffA);
    if (wr == 1) PG8_BAR;
    PG8_WAIT_V(2); PG8_BAR;
    PG8_STAGE(PG8_SB(1, 0), cB + kstep, voffB); PG8_STAGE(PG8_SA(1, 0), cA + kstep, voffA); PG8_STAGE(PG8_SB(1, 1), cB + hstep + kstep, voffB);
    PG8_WAIT_V(6); PG8_BAR;
    for (;;) {
        const bool has_next = S.next(ui + 1, nxt);
        const char* nA = has_next ? (const char*)g.A + (size_t)nxt.pm * tstep : cA; const char* nB = has_next ? (const char*)g.Bt + (size_t)nxt.pn * tstep : cB;
        for (int t = 0; t < nt; t += 2) {
            const bool last = (t == nt - 2);
            const char* a1 = cA + (size_t)(t + 1) * kstep;
            const char* a2 = last ? nA : cA + (size_t)(t + 2) * kstep; const char* b2 = last ? nB : cB + (size_t)(t + 2) * kstep;
            const char* a3 = a2 + kstep; const char* b3 = b2 + kstep;
            PG8_LDB(B0, 0, 0); PG8_LDB(B1, 0, 1); PG8_SCHED; PG8_LDA(At, 0, 0); PG8_STAGE(PG8_SA(1, 1), a1 + hstep, voffA);
            PG8_WAIT_V(8); PG8_WAIT_L(0); PG8_BAR; PG8_MMA(0, 0, At, B0); PG8_MMA(0, 1, At, B1); PG8_BAR; PG8_SCHED;
            PG8_LDA(At, 0, 1); PG8_STAGE(PG8_SB(0, 0), b2, voffB); PG8_STAGE(PG8_SB(0, 1), b2 + hstep, voffB); PG8_STAGE(PG8_SA(0, 0), a2, voffA);
            PG8_WAIT_V(8); PG8_WAIT_L(0); PG8_BAR; PG8_MMA(1, 0, At, B0); PG8_MMA(1, 1, At, B1); PG8_BAR; PG8_SCHED;
            PG8_LDB(B0, 1, 0); PG8_LDB(B1, 1, 1); PG8_SCHED; PG8_LDA(At, 1, 0); PG8_STAGE(PG8_SA(0, 1), a2 + hstep, voffA);
            PG8_WAIT_V(8); PG8_WAIT_L(0); PG8_BAR; PG8_MMA(0, 0, At, B0); PG8_MMA(0, 1, At, B1); PG8_BAR; PG8_SCHED;
            PG8_LDA(At, 1, 1); PG8_STAGE(PG8_SB(1, 0), b3, voffB); PG8_STAGE(PG8_SB(1, 1), b3 + hstep, voffB); PG8_STAGE(PG8_SA(1, 0), a3, voffA);
            PG8_WAIT_V(8); PG8_WAIT_L(0); PG8_BAR; PG8_MMA(1, 0, At, B0); PG8_MMA(1, 1, At, B1); PG8_BAR; PG8_SCHED;
        }
        if (wr == 0) PG8_BAR;
        E(acc, cur, wr, wc, fr, fq);
        if (!has_next) break;
#pragma unroll
        for (int a = 0; a < 2; ++a)
#pragma unroll
            for (int b = 0; b < 2; ++b)
#pragma unroll
                for (int m = 0; m < 4; ++m)
#pragma unroll
                    for (int n = 0; n < 2; ++n) acc[a][b][m][n] = (f32x4){0.f, 0.f, 0.f, 0.f};
        cur = nxt; cA = nA; cB = nB; ++ui;
        if (wr == 1) PG8_BAR;
    }
    PG8_WAIT_V(0);
    PG8_BAR;
#undef PG8_SA
#undef PG8_SB
#undef PG8_STAGE
#undef PG8_LDA
#undef PG8_LDB
#undef PG8_MMA
#undef PG8_WAIT_V
#undef PG8_WAIT_L
#undef PG8_BAR
#undef PG8_SCHED
}
}

typedef f32x4 AccT[2][2][4][2];

struct EpiInEven {
    static constexpr bool PERM = true;
    unsigned char* ws; float* out; const float* rstd; const float* blr_b;
    __device__ __forceinline__ void operator()(const AccT& acc, const pg8::Unit& u, int wr, int wc, int fr, int fq) const {
        const int pn = u.pn;
        bf16_t* base; int ld, coff; float sc = 1.f;
        if (pn < 4) { base = (bf16_t*)(ws + WS_Q); ld = 1024; coff = pn * 256; sc = 0.125f * 1.4426950408889634f; }
        else if (pn == 4) { base = (bf16_t*)(ws + WS_K); ld = 256; coff = 0; }
        else if (pn == 5) { base = (bf16_t*)(ws + WS_V); ld = 256; coff = 0; }
        else if (pn < 8) { base = (bf16_t*)(ws + WS_BQ); ld = 512; coff = (pn - 6) * 256; sc = 0.08838834764831845f; }
        else if (pn < 10) { base = (bf16_t*)(ws + WS_BK); ld = 512; coff = (pn - 8) * 256; }
        else if (pn < 14) { base = (bf16_t*)(ws + WS_BV); ld = 1024; coff = (pn - 10) * 256; }
        else if (pn < 22) { base = (bf16_t*)(ws + WS_GATE); ld = 2048; coff = (pn - 14) * 256; }
        else { base = (bf16_t*)(ws + WS_BLR); ld = 512; coff = (pn - 22) * 256; }
        const int row0 = u.pm * 256 + wr * 64 + fr;
        const int ct = wc * 32 + 8 * fq;
        float rsv[8];
#pragma unroll
        for (int it = 0; it < 8; ++it) rsv[it] = rstd[row0 + (it >> 2) * 128 + (it & 3) * 16];
        if (pn >= 22) {
#pragma unroll
            for (int ai = 0; ai < 2; ++ai)
#pragma unroll
                for (int m = 0; m < 4; ++m) {
                    const int row = row0 + ai * 128 + m * 16; const float rs = rsv[ai * 4 + m];
#pragma unroll
                    for (int bj = 0; bj < 2; ++bj) {
                        const int cg = coff + ct + bj * 128;
                        const f32x4 b0 = *(const f32x4*)(blr_b + cg), b1 = *(const f32x4*)(blr_b + cg + 4);
                        f32x4 x0 = acc[ai][bj][m][0] * rs + b0, x1 = acc[ai][bj][m][1] * rs + b1;
#pragma unroll
                        for (int j = 0; j < 4; ++j) { x0[j] = (fminf(x0[j], 0.f) - __logf(1.f + __expf(-fabsf(x0[j])))) * (1.f / 16.f); x1[j] = (fminf(x1[j], 0.f) - __logf(1.f + __expf(-fabsf(x1[j])))) * (1.f / 16.f); }
                        u32x4 w; w.x = cvt_pk_bf16(x0[0], x0[1]); w.y = cvt_pk_bf16(x0[2], x0[3]); w.z = cvt_pk_bf16(x1[0], x1[1]); w.w = cvt_pk_bf16(x1[2], x1[3]);
                        *(u32x4*)(base + (size_t)row * 512 + cg) = w;
                    }
                }
            return;
        }
        const bool kv = (pn == 4 || pn == 5);
        float* okv_p = out + (pn == 4 ? O_KP : O_VP); float* okv_s = out + (pn == 4 ? O_KS : O_VS);
#pragma unroll
        for (int ai = 0; ai < 2; ++ai)
#pragma unroll
            for (int m = 0; m < 4; ++m) {
                const int row = row0 + ai * 128 + m * 16; const float rs = rsv[ai * 4 + m] * sc;
                bf16_t* rowp = base + (size_t)row * ld + coff + ct;
                float* orow = nullptr;
                if (kv) {
                    if (row >= T_P) orow = okv_s + (size_t)(row - T_P) * 256;
                    else { const int b = row >> 11, t = row & 2047; if (t >= 1920) orow = okv_p + (size_t)(b * 128 + t - 1920) * 256; }
                }
#pragma unroll
                for (int bj = 0; bj < 2; ++bj) {
                    const f32x4 v0 = acc[ai][bj][m][0] * rs, v1 = acc[ai][bj][m][1] * rs;
                    u32x4 w; w.x = cvt_pk_bf16(v0[0], v0[1]); w.y = cvt_pk_bf16(v0[2], v0[3]); w.z = cvt_pk_bf16(v1[0], v1[1]); w.w = cvt_pk_bf16(v1[2], v1[3]);
                    *(u32x4*)(rowp + bj * 128) = w;
                    if (kv && orow) { *(f32x4*)(orow + bj * 128 + ct) = v0; *(f32x4*)(orow + bj * 128 + ct + 4) = v1; }
                }
            }
    }
};

template <bool WRITE_BF>
struct EpiOutRes {
    static constexpr bool PERM = false;
    const float* xin_p; const float* xin_s; float* xo; bf16_t* xb; float* rowsq;
    __device__ __forceinline__ void operator()(const AccT& acc, const pg8::Unit& u, int wr, int wc, int fr, int fq) const {
        const int row0 = u.pm * 256 + wr * 64 + fr, col0 = u.pn * 256 + wc * 32 + 4 * fq;
        f32x4 r[3][4];
#define EOR_LOAD(S, IT) do { const int row_ = row0 + ((IT) >> 2) * 128 + ((IT) & 3) * 16; \
            const float* xr_ = (row_ < T_P) ? xin_p + (size_t)row_ * 1024 : xin_s + (size_t)(row_ - T_P) * 1024; \
            r[S][0] = *(const f32x4*)(xr_ + col0); r[S][1] = *(const f32x4*)(xr_ + col0 + 16); r[S][2] = *(const f32x4*)(xr_ + col0 + 128); r[S][3] = *(const f32x4*)(xr_ + col0 + 144); } while (0)
        EOR_LOAD(0, 0); EOR_LOAD(1, 1);
#pragma unroll
        for (int it = 0; it < 8; ++it) {
            if (it + 2 < 8) { if ((it + 2) % 3 == 0) EOR_LOAD(0, it + 2); else if ((it + 2) % 3 == 1) EOR_LOAD(1, it + 2); else EOR_LOAD(2, it + 2); }
            const int ai = it >> 2, m = it & 3;
            const int row = row0 + ai * 128 + m * 16;
            float ss = 0.f;
#pragma unroll
            for (int bj = 0; bj < 2; ++bj)
#pragma unroll
                for (int n = 0; n < 2; ++n) {
                    const int col = col0 + bj * 128 + n * 16;
                    const f32x4 v = acc[ai][bj][m][n] + r[it % 3][bj * 2 + n];
                    if (!WRITE_BF) *(f32x4*)(xo + (size_t)row * 1024 + col) = v;
                    if (WRITE_BF) { u32x2 w; w.x = cvt_pk_bf16(v[0], v[1]); w.y = cvt_pk_bf16(v[2], v[3]); *(u32x2*)(xb + (size_t)row * 1024 + col) = w; }
                    ss += v[0] * v[0] + v[1] * v[1] + v[2] * v[2] + v[3] * v[3];
                }
            ss += __shfl_xor(ss, 16); ss += __shfl_xor(ss, 32);
            if (fq == 0) atomicAdd(rowsq + row, ss);
        }
#undef EOR_LOAD
    }
};

struct EpiOutResB {
    static constexpr bool PERM = false;
    bf16_t* xb; float* rowsq;
    __device__ __forceinline__ void operator()(const AccT& acc, const pg8::Unit& u, int wr, int wc, int fr, int fq) const {
        const int row0 = u.pm * 256 + wr * 64 + fr, col0 = u.pn * 256 + wc * 32 + 4 * fq;
        u32x2 r[3][4];
#define EOB_LOAD(S, IT) do { const bf16_t* xr_ = xb + (size_t)(row0 + ((IT) >> 2) * 128 + ((IT) & 3) * 16) * 1024 + col0; \
            r[S][0] = *(const u32x2*)(xr_); r[S][1] = *(const u32x2*)(xr_ + 16); r[S][2] = *(const u32x2*)(xr_ + 128); r[S][3] = *(const u32x2*)(xr_ + 144); } while (0)
        EOB_LOAD(0, 0); EOB_LOAD(1, 1);
#pragma unroll
        for (int it = 0; it < 8; ++it) {
            if (it + 2 < 8) { if ((it + 2) % 3 == 0) EOB_LOAD(0, it + 2); else if ((it + 2) % 3 == 1) EOB_LOAD(1, it + 2); else EOB_LOAD(2, it + 2); }
            const int ai = it >> 2, m = it & 3;
            const int row = row0 + ai * 128 + m * 16;
            float ss = 0.f;
#pragma unroll
            for (int bj = 0; bj < 2; ++bj)
#pragma unroll
                for (int n = 0; n < 2; ++n) {
                    const int col = col0 + bj * 128 + n * 16;
                    const u32x2 rw = r[it % 3][bj * 2 + n];
                    f32x4 v = acc[ai][bj][m][n];
                    v[0] += bflo(rw.x); v[1] += bfhi(rw.x); v[2] += bflo(rw.y); v[3] += bfhi(rw.y);
                    u32x2 w; w.x = cvt_pk_bf16(v[0], v[1]); w.y = cvt_pk_bf16(v[2], v[3]);
                    *(u32x2*)(xb + (size_t)row * 1024 + col) = w;
                    ss += v[0] * v[0] + v[1] * v[1] + v[2] * v[2] + v[3] * v[3];
                }
            ss += __shfl_xor(ss, 16); ss += __shfl_xor(ss, 32);
            if (fq == 0) atomicAdd(rowsq + row, ss);
        }
#undef EOB_LOAD
    }
};

struct EpiInOdd {
    static constexpr bool PERM = true;
    bf16_t* z2; const float* rowsq;
    __device__ __forceinline__ void operator()(const AccT& acc, const pg8::Unit& u, int wr, int wc, int fr, int fq) const {
        const int row0 = u.pm * 256 + wr * 64 + fr, col0 = u.pn * 256 + wc * 32 + 8 * fq;
        float rsv[8];
#pragma unroll
        for (int it = 0; it < 8; ++it) rsv[it] = rowsq[row0 + (it >> 2) * 128 + (it & 3) * 16];
#pragma unroll
        for (int ai = 0; ai < 2; ++ai)
#pragma unroll
            for (int m = 0; m < 4; ++m) {
                const int row = row0 + ai * 128 + m * 16; const float rs = rsqrtf(rsv[ai * 4 + m] * (1.f / 1024.f) + EPS);
#pragma unroll
                for (int bj = 0; bj < 2; ++bj) {
                    const f32x4 v0 = acc[ai][bj][m][0] * rs, v1 = acc[ai][bj][m][1] * rs;
                    u32x4 w; w.x = cvt_pk_bf16(v0[0], v0[1]); w.y = cvt_pk_bf16(v0[2], v0[3]); w.z = cvt_pk_bf16(v1[0], v1[1]); w.w = cvt_pk_bf16(v1[2], v1[3]);
                    *(u32x4*)(z2 + (size_t)row * 3072 + col0 + bj * 128) = w;
                }
            }
    }
};

template <int MODE>
__device__ __forceinline__ void transpose_w(const float* __restrict__ src, int K, int Nsrc, bf16_t* __restrict__ dst, int Ndst, const float* __restrict__ gain, long gtid, long gsz) {
    const long total = (long)(K / 8) * Ndst;
#pragma unroll 4
    for (long it = gtid; it < total; it += gsz) {
        const int n = (int)(it % Ndst), k8 = (int)(it / Ndst);
        int sc = n;
        if (MODE == 1) { if (n < 3584) sc = n; else sc = n + 16; }
        u32x4 w = {0u, 0u, 0u, 0u};
        if (sc >= 0) {
            const float* s = src + (size_t)(k8 * 8) * Nsrc + sc;
            float v0 = s[0], v1 = s[(size_t)Nsrc], v2 = s[(size_t)2 * Nsrc], v3 = s[(size_t)3 * Nsrc], v4 = s[(size_t)4 * Nsrc], v5 = s[(size_t)5 * Nsrc], v6 = s[(size_t)6 * Nsrc], v7 = s[(size_t)7 * Nsrc];
            if (gain) { const f32x4 g0 = *(const f32x4*)(gain + k8 * 8), g1 = *(const f32x4*)(gain + k8 * 8 + 4); v0 *= g0[0]; v1 *= g0[1]; v2 *= g0[2]; v3 *= g0[3]; v4 *= g1[0]; v5 *= g1[1]; v6 *= g1[2]; v7 *= g1[3]; }
            w.x = cvt_pk_bf16(v0, v1); w.y = cvt_pk_bf16(v2, v3); w.z = cvt_pk_bf16(v4, v5); w.w = cvt_pk_bf16(v6, v7);
        }
        *(u32x4*)(dst + (size_t)n * K + k8 * 8) = w;
    }
}

__device__ __forceinline__ void phase0(const Params& p) {
    unsigned char* ws = p.ws;
    const long gtid = (long)blockIdx.x * NTHR + threadIdx.x, gsz = (long)gridDim.x * NTHR;
    transpose_w<1>(p.in[8], 1024, 5648, (bf16_t*)(ws + WS_WINE), 5632, p.in[7], gtid, gsz);
    for (long it = gtid; it < 128L * 512; it += gsz) {
        const int n = (int)(it & 511), k8 = (int)(it >> 9);
        float wl[16];
#pragma unroll
        for (int r = 0; r < 16; ++r) wl[r] = p.in[9][r * 512 + n];
        float v[8];
#pragma unroll
        for (int i = 0; i < 8; ++i) {
            const float* wr_ = p.in[8] + (size_t)(k8 * 8 + i) * 5648 + 3584;
            float a = 0.f;
#pragma unroll
            for (int r4 = 0; r4 < 4; ++r4) { const f32x4 x = *(const f32x4*)(wr_ + r4 * 4); a += x[0] * wl[r4 * 4] + x[1] * wl[r4 * 4 + 1] + x[2] * wl[r4 * 4 + 2] + x[3] * wl[r4 * 4 + 3]; }
            v[i] = a * p.in[7][k8 * 8 + i];
        }
        u32x4 w; w.x = cvt_pk_bf16(v[0], v[1]); w.y = cvt_pk_bf16(v[2], v[3]); w.z = cvt_pk_bf16(v[4], v[5]); w.w = cvt_pk_bf16(v[6], v[7]);
        *(u32x4*)((bf16_t*)(ws + WS_WINE) + (size_t)(5632 + n) * 1024 + k8 * 8) = w;
    }
    transpose_w<0>(p.in[13], 2048, 1024, (bf16_t*)(ws + WS_WOUTE), 1024, nullptr, gtid, gsz);
    transpose_w<0>(p.in[15], 1024, 3072, (bf16_t*)(ws + WS_WINO), 3072, p.in[14], gtid, gsz);
    transpose_w<0>(p.in[23], 1536, 1024, (bf16_t*)(ws + WS_WOUTO), 1024, nullptr, gtid, gsz);
    for (int nb = 0; nb < 8; ++nb) {
        transpose_w<0>(p.in[18] + nb * 192 * 192, 192, 192, (bf16_t*)(ws + WS_WA) + nb * 192 * 192, 192, nullptr, gtid, gsz);
        transpose_w<0>(p.in[20] + nb * 192 * 192, 192, 192, (bf16_t*)(ws + WS_WI) + nb * 192 * 192, 192, nullptr, gtid, gsz);
    }
    { float* z = (float*)(ws + WS_RSQ1); const long nz = (long)T * 2; for (long i = gtid; i < nz; i += gsz) z[i] = 0.f; }
    const int lane = threadIdx.x & 63; const int gw = (int)(gtid >> 6), nw = (int)(gsz >> 6);
    bf16_t* xb = (bf16_t*)(ws + WS_XB); float* rstd = (float*)(ws + WS_RSTD0);
#pragma unroll 4
    for (int row = gw; row < T; row += nw) {
        const float* xr = (row < T_P) ? p.in[0] + (size_t)row * 1024 : p.in[1] + (size_t)(row - T_P) * 1024;
        float ss = 0.f;
#pragma unroll
        for (int i = 0; i < 4; ++i) {
            const f32x4 v = *(const f32x4*)(xr + i * 256 + lane * 4);
            ss += v[0] * v[0] + v[1] * v[1] + v[2] * v[2] + v[3] * v[3];
            u32x2 w; w.x = cvt_pk_bf16(v[0], v[1]); w.y = cvt_pk_bf16(v[2], v[3]);
            *(u32x2*)(xb + (size_t)row * 1024 + i * 256 + lane * 4) = w;
        }
#pragma unroll
        for (int o = 32; o >= 1; o >>= 1) ss += __shfl_xor(ss, o);
        if (lane == 0) rstd[row] = rsqrtf(ss * (1.f / 1024.f) + EPS);
    }
}

__device__ __forceinline__ void attn_item(const Params& p, LAS unsigned char* L, int item, bf16_t* Yd, int ldd) {
    unsigned char* ws = p.ws;
    const int tid = threadIdx.x, lane = tid & 63, w = tid >> 6, r16 = lane & 15, q4 = lane >> 4;
    LAS bf16_t* Ks = (LAS bf16_t*)L;
    LAS bf16_t* Vs = (LAS bf16_t*)(L + 192 * 72 * 2);
    const unsigned vbase = (unsigned)(size_t)L + 192u * 72u * 2u;
    const bf16_t* Qb = (const bf16_t*)(ws + WS_Q); const bf16_t* Kb = (const bf16_t*)(ws + WS_K); const bf16_t* Vb = (const bf16_t*)(ws + WS_V);
    const bf16_t* Yb = (const bf16_t*)(ws + WS_GATE);
    const bool smp = item >= 2048;
    int b, c, kh; size_t row0;
    if (!smp) { kh = item & 3; c = (item >> 2) & 31; b = item >> 7; row0 = (size_t)b * 2048 + c * 64; }
    else { const int i2 = item - 2048; kh = i2 & 3; b = i2 >> 2; c = 0; row0 = (size_t)T_P + b * 64; }
    const int g = w >> 1, i0 = (w & 1) * 32, h = kh * 4 + g;
    bf16x8 qf[2][2];
#pragma unroll
    for (int qt = 0; qt < 2; ++qt) {
#pragma unroll
        for (int ks = 0; ks < 2; ++ks) qf[qt][ks] = *(const bf16x8*)(Qb + (row0 + i0 + qt * 16 + r16) * 1024 + h * 64 + ks * 32 + q4 * 8);
    }
#pragma unroll
    for (int i = 0; i < 3; ++i) {
        const int idx = tid + i * 512, key = idx >> 3, dg = idx & 7;
        u32x4 kv = {0u, 0u, 0u, 0u}, vv = {0u, 0u, 0u, 0u};
        if (!smp) {
            const int pos = c * 64 - 128 + key;
            if (pos >= 0) { const size_t r = (size_t)b * 2048 + pos; kv = *(const u32x4*)(Kb + r * 256 + kh * 64 + dg * 8); vv = *(const u32x4*)(Vb + r * 256 + kh * 64 + dg * 8); }
        } else {
            if (key < 128) {
                const size_t o = ((size_t)(b * 128 + key) * 4 + kh) * 64 + dg * 8;
                const f32x4 k0 = *(const f32x4*)(p.in[2] + o), k1 = *(const f32x4*)(p.in[2] + o + 4), v0 = *(const f32x4*)(p.in[3] + o), v1 = *(const f32x4*)(p.in[3] + o + 4);
                kv.x = cvt_pk_bf16(k0[0], k0[1]); kv.y = cvt_pk_bf16(k0[2], k0[3]); kv.z = cvt_pk_bf16(k1[0], k1[1]); kv.w = cvt_pk_bf16(k1[2], k1[3]);
                vv.x = cvt_pk_bf16(v0[0], v0[1]); vv.y = cvt_pk_bf16(v0[2], v0[3]); vv.z = cvt_pk_bf16(v1[0], v1[1]); vv.w = cvt_pk_bf16(v1[2], v1[3]);
            } else { const size_t r = (size_t)T_P + b * 64 + key - 128; kv = *(const u32x4*)(Kb + r * 256 + kh * 64 + dg * 8); vv = *(const u32x4*)(Vb + r * 256 + kh * 64 + dg * 8); }
        }
        *(LAS u32x4*)(Ks + key * 72 + dg * 8) = kv;
        *(LAS u32x4*)(Vs + key * 72 + dg * 8) = vv;
    }
    __syncthreads();
    const float slope = exp2f(-0.5f * (float)(h + 1)) * 1.4426950408889634f;
    const float sink = p.in[11][h] * 1.4426950408889634f;
    const unsigned va = vbase + (unsigned)(((q4 * 4 + (r16 >> 2)) * 72 + 4 * (r16 & 3)) * 2);
#pragma unroll 1
    for (int qt = 0; qt < 2; ++qt) {
        const int i = i0 + qt * 16 + r16;
        const bf16x8 qa = qt ? qf[1][0] : qf[0][0], qb = qt ? qf[1][1] : qf[0][1];
        u32x2 gv[4];
#pragma unroll
        for (int dt = 0; dt < 4; ++dt) gv[dt] = *(const u32x2*)(Yb + (row0 + i) * 2048 + h * 64 + dt * 16 + q4 * 4);
        f32x4 sacc[12];
#pragma unroll
        for (int kt = 0; kt < 12; ++kt) {
            const bf16x8 kf0 = *(const LAS bf16x8*)(Ks + (kt * 16 + r16) * 72 + q4 * 8), kf1 = *(const LAS bf16x8*)(Ks + (kt * 16 + r16) * 72 + 32 + q4 * 8);
            f32x4 a = {0.f, 0.f, 0.f, 0.f}; a = MFMA16(kf0, qa, a); a = MFMA16(kf1, qb, a); sacc[kt] = a;
        }
        const float dbase = (float)(128 + i - q4 * 4);
#pragma unroll
        for (int kt = 0; kt < 12; ++kt)
#pragma unroll
            for (int jj = 0; jj < 4; ++jj) sacc[kt][jj] = fmaf(-slope, fabsf(dbase - (float)(kt * 16 + jj)), sacc[kt][jj]);
        if (!smp && c < 2) {
#pragma unroll
            for (int kt = 0; kt < 8; ++kt)
#pragma unroll
                for (int jj = 0; jj < 4; ++jj) { const int j = kt * 16 + q4 * 4 + jj; if ((c * 64 - 128 + j) < 0) sacc[kt][jj] = -1e30f; }
        }
        float m = -3e38f;
#pragma unroll
        for (int kt = 0; kt < 12; ++kt)
#pragma unroll
            for (int jj = 0; jj < 4; ++jj) m = fmaxf(m, sacc[kt][jj]);
        m = fmaxf(m, __shfl_xor(m, 16)); m = fmaxf(m, __shfl_xor(m, 32)); m = fmaxf(m, sink);
        float l = 0.f;
#pragma unroll
        for (int kt = 0; kt < 12; ++kt)
#pragma unroll
            for (int jj = 0; jj < 4; ++jj) { const float pr = __builtin_amdgcn_exp2f(sacc[kt][jj] - m); sacc[kt][jj] = pr; l += pr; }
        l += __shfl_xor(l, 16); l += __shfl_xor(l, 32); l += __builtin_amdgcn_exp2f(sink - m);
        const float inv = 1.f / l;
        f32x4 oacc[4];
#pragma unroll
        for (int dt = 0; dt < 4; ++dt) oacc[dt] = (f32x4){0.f, 0.f, 0.f, 0.f};
#pragma unroll
        for (int kb = 0; kb < 6; ++kb) {
            const bf16x8 pf = pack8(sacc[2 * kb], sacc[2 * kb + 1]);
            bf16x4 l0, h0, l1, h1, l2, h2, l3, h3;
            const unsigned vk = va + (unsigned)(kb * 32 * 144);
            asm volatile("ds_read_b64_tr_b16 %0, %8\n\tds_read_b64_tr_b16 %1, %8 offset:2304\n\t"
                         "ds_read_b64_tr_b16 %2, %8 offset:32\n\tds_read_b64_tr_b16 %3, %8 offset:2336\n\t"
                         "ds_read_b64_tr_b16 %4, %8 offset:64\n\tds_read_b64_tr_b16 %5, %8 offset:2368\n\t"
                         "ds_read_b64_tr_b16 %6, %8 offset:96\n\tds_read_b64_tr_b16 %7, %8 offset:2400\n\t"
                         "s_waitcnt lgkmcnt(0)"
                         : "=&v"(l0), "=&v"(h0), "=&v"(l1), "=&v"(h1), "=&v"(l2), "=&v"(h2), "=&v"(l3), "=&v"(h3) : "v"(vk) : "memory");
            oacc[0] = MFMA16(cat4(l0, h0), pf, oacc[0]); oacc[1] = MFMA16(cat4(l1, h1), pf, oacc[1]);
            oacc[2] = MFMA16(cat4(l2, h2), pf, oacc[2]); oacc[3] = MFMA16(cat4(l3, h3), pf, oacc[3]);
        }
#pragma unroll
        for (int dt = 0; dt < 4; ++dt) {
            const u32x2 gq = gv[dt];
            const f32x4 o = oacc[dt] * inv;
            u32x2 wv; wv.x = cvt_pk_bf16(o[0] * siluf(bflo(gq.x)), o[1] * siluf(bfhi(gq.x))); wv.y = cvt_pk_bf16(o[2] * siluf(bflo(gq.y)), o[3] * siluf(bfhi(gq.y)));
            *(u32x2*)(Yd + (row0 + i) * ldd + h * 64 + dt * 16 + q4 * 4) = wv;
        }
    }
    __syncthreads();
}

constexpr size_t SC_SQ = 0;
constexpr size_t SC_ET = 9437184;
constexpr size_t SC_AB = 16777216;
static_assert(SC_AB + (size_t)T * 256 * 2 <= (size_t)T * 1024 * 4, "scratch must fit in the y region of d_out");

struct PrepRegs { u32x4 g0, g1, q0, q1, k0, k1; };
__device__ __forceinline__ unsigned prep_row0(int item, int& h) {
    if (item < 2048) { h = item & 3; const int c = (item >> 2) & 31; const int b = item >> 7; return (unsigned)b * 2048 + c * 64; }
    const int i2 = item - 2048; h = i2 & 3; return (unsigned)T_P + (i2 >> 2) * 64;
}
__device__ __forceinline__ void prep_load(const Params& p, int item, PrepRegs& R) {
    const int tid = threadIdx.x; int h; const unsigned row0 = prep_row0(item, h);
    const bf16_t* BQ = (const bf16_t*)(p.ws + WS_BQ); const bf16_t* BKb = (const bf16_t*)(p.ws + WS_BK); const bf16_t* GB = (const bf16_t*)(p.ws + WS_BLR);
    const int pt0 = tid >> 4, pt1 = (tid + 512) >> 4, poc = tid & 15;
    const unsigned o0 = (row0 + pt0) * 512u + h * 128 + poc * 8, o1 = (row0 + pt1) * 512u + h * 128 + poc * 8;
    R.g0 = *(const u32x4*)(GB + o0); R.g1 = *(const u32x4*)(GB + o1);
    R.q0 = *(const u32x4*)(BQ + o0); R.q1 = *(const u32x4*)(BQ + o1); R.k0 = *(const u32x4*)(BKb + o0); R.k1 = *(const u32x4*)(BKb + o1);
}
__device__ __forceinline__ void gla_prep_item(const Params& p, LAS unsigned char* L, int item, const PrepRegs& cur, int next_item, PrepRegs& nxt) {
    unsigned char* ws = p.ws;
    const int tid = threadIdx.x, lane = tid & 63, w = tid >> 6, r16 = lane & 15, q4 = lane >> 4;
    LAS bf16_t* QG = (LAS bf16_t*)L;
    LAS bf16_t* KG = (LAS bf16_t*)(L + 17408);
    LAS bf16_t* Gs = (LAS bf16_t*)(L + 34816);
    LAS float* Gf = (LAS float*)(L + 52224);
    LAS float* GT = (LAS float*)(L + 84992);
    int h; const unsigned row0 = prep_row0(item, h);
    bf16_t* BQ = (bf16_t*)(ws + WS_BQ); bf16_t* BKb = (bf16_t*)(ws + WS_BK);
    float* ET = (float*)((unsigned char*)p.out + SC_ET); bf16_t* AB = (bf16_t*)((unsigned char*)p.out + SC_AB);
    const int c = tid & 127, tg = tid >> 7;
    const int pt0 = tid >> 4, pt1 = (tid + 512) >> 4, poc = tid & 15;
    const unsigned o0 = (row0 + pt0) * 512u + h * 128 + poc * 8, o1 = (row0 + pt1) * 512u + h * 128 + poc * 8;
    const u32x4 pq0 = cur.q0, pq1 = cur.q1, pk0 = cur.k0, pk1 = cur.k1;
    *(LAS u32x4*)(Gs + pt0 * 136 + poc * 8) = cur.g0; *(LAS u32x4*)(Gs + pt1 * 136 + poc * 8) = cur.g1;
    lds_barrier();
    if (next_item >= 0) prep_load(p, next_item, nxt);
    {
        float cs = 0.f;
#pragma unroll
        for (int tt = 0; tt < 16; ++tt) { cs += bf2f(Gs[(tg * 16 + tt) * 136 + c]); Gf[(tg * 16 + tt) * 128 + c] = cs; }
        GT[tg * 128 + c] = cs;
    }
    lds_barrier();
#pragma unroll
    for (int i = 0; i < 2; ++i) {
        const int t = i ? pt1 : pt0; const int tgp = t >> 4;
        const u32x4 qw = i ? pq1 : pq0, kw = i ? pk1 : pk0;
        float G[8], tot[8];
        { const f32x4 a0 = *(const LAS f32x4*)(Gf + t * 128 + poc * 8), a1 = *(const LAS f32x4*)(Gf + t * 128 + poc * 8 + 4);
          G[0] = a0[0]; G[1] = a0[1]; G[2] = a0[2]; G[3] = a0[3]; G[4] = a1[0]; G[5] = a1[1]; G[6] = a1[2]; G[7] = a1[3]; }
#pragma unroll
        for (int j = 0; j < 8; ++j) tot[j] = 0.f;
#pragma unroll
        for (int g2 = 0; g2 < 4; ++g2) {
            const f32x4 a0 = *(const LAS f32x4*)(GT + g2 * 128 + poc * 8), a1 = *(const LAS f32x4*)(GT + g2 * 128 + poc * 8 + 4);
            const float sel = (g2 < tgp) ? 1.f : 0.f;
            G[0] += sel * a0[0]; G[1] += sel * a0[1]; G[2] += sel * a0[2]; G[3] += sel * a0[3]; G[4] += sel * a1[0]; G[5] += sel * a1[1]; G[6] += sel * a1[2]; G[7] += sel * a1[3];
            tot[0] += a0[0]; tot[1] += a0[1]; tot[2] += a0[2]; tot[3] += a0[3]; tot[4] += a1[0]; tot[5] += a1[1]; tot[6] += a1[2]; tot[7] += a1[3];
        }
        if (i == 0 && tid < 16) {
            float* ep = ET + (size_t)(row0 >> 6) * 512 + h * 128 + poc * 8;
            *(f32x4*)ep = (f32x4){__expf(tot[0]), __expf(tot[1]), __expf(tot[2]), __expf(tot[3])};
            *(f32x4*)(ep + 4) = (f32x4){__expf(tot[4]), __expf(tot[5]), __expf(tot[6]), __expf(tot[7])};
        }
        float qv[8], kv[8];
        unpack8(qw, qv); unpack8(kw, kv);
#pragma unroll
        for (int j = 0; j < 8; ++j) { const float eg = __expf(G[j]); qv[j] *= eg; kv[j] *= rcpf_(eg); }
        u32x4 qo, ko;
        qo.x = cvt_pk_bf16(qv[0], qv[1]); qo.y = cvt_pk_bf16(qv[2], qv[3]); qo.z = cvt_pk_bf16(qv[4], qv[5]); qo.w = cvt_pk_bf16(qv[6], qv[7]);
        ko.x = cvt_pk_bf16(kv[0], kv[1]); ko.y = cvt_pk_bf16(kv[2], kv[3]); ko.z = cvt_pk_bf16(kv[4], kv[5]); ko.w = cvt_pk_bf16(kv[6], kv[7]);
        *(LAS u32x4*)(QG + t * 136 + poc * 8) = qo; *(LAS u32x4*)(KG + t * 136 + poc * 8) = ko;
        *(u32x4*)(BQ + (i ? o1 : o0)) = qo; *(u32x4*)(BKb + (i ? o1 : o0)) = ko;
    }
    lds_barrier();
    {
        const int it = w >> 1, jt0 = (w & 1) * 2;
        f32x4 at[2];
        at[0] = (f32x4){0.f, 0.f, 0.f, 0.f}; at[1] = (f32x4){0.f, 0.f, 0.f, 0.f};
#pragma unroll
        for (int ks = 0; ks < 4; ++ks) {
            const bf16x8 qf = *(const LAS bf16x8*)(QG + (it * 16 + r16) * 136 + ks * 32 + q4 * 8);
#pragma unroll
            for (int t2 = 0; t2 < 2; ++t2) {
                const bf16x8 kf = *(const LAS bf16x8*)(KG + ((jt0 + t2) * 16 + r16) * 136 + ks * 32 + q4 * 8);
                at[t2] = MFMA16(kf, qf, at[t2]);
            }
        }
        const int i = it * 16 + r16;
#pragma unroll
        for (int t2 = 0; t2 < 2; ++t2) {
            f32x4 v = at[t2];
#pragma unroll
            for (int jj = 0; jj < 4; ++jj) { const int j = (jt0 + t2) * 16 + q4 * 4 + jj; if (j > i) v[jj] = 0.f; }
            u32x2 wv; wv.x = cvt_pk_bf16(v[0], v[1]); wv.y = cvt_pk_bf16(v[2], v[3]);
            *(u32x2*)(AB + (size_t)(row0 + i) * 256 + h * 64 + (jt0 + t2) * 16 + q4 * 4) = wv;
        }
    }
    lds_barrier();
}

__device__ __forceinline__ void gla_scan_item(const Params& p, LAS unsigned char* L, int item, bool dummy) {
    unsigned char* ws = p.ws;
    const int tid = threadIdx.x, lane = tid & 63, w = tid >> 6, r16 = lane & 15, q4 = lane >> 4;
    LAS bf16_t* QG = (LAS bf16_t*)L;
    LAS bf16_t* KG = (LAS bf16_t*)(L + 17408);
    LAS bf16_t* Vs = (LAS bf16_t*)(L + 34816);
    LAS bf16_t* As = (LAS bf16_t*)(L + 44032);
    LAS float* GL = (LAS float*)(L + 53248);
    const unsigned lbase = (unsigned)(size_t)L;
    const bool smp = item >= 256;
    const int i2 = smp ? item - 256 : item;
    const int b = i2 >> 4, h = (i2 >> 2) & 3, sl = i2 & 3, e0 = sl * 64;
    const int nch = smp ? 1 : 32;
    const unsigned rbase = smp ? (unsigned)T_P + b * 64 : (unsigned)b * 2048;
    const bf16_t* BQ = (const bf16_t*)(ws + WS_BQ); const bf16_t* BKb = (const bf16_t*)(ws + WS_BK); bf16_t* BV = (bf16_t*)(ws + WS_BV);
    const float* ET = (const float*)((unsigned char*)p.out + SC_ET); const bf16_t* AB = (const bf16_t*)((unsigned char*)p.out + SC_AB); float* BOSQP = dummy ? p.out + 20000000 : (float*)((unsigned char*)p.out + SC_SQ);
    bf16_t* BVo = dummy ? (bf16_t*)((unsigned char*)p.out + 67108864) : BV;
    const int pt0 = tid >> 4, pt1 = (tid + 512) >> 4, poc = tid & 15;
    const int vt = tid >> 3, veo = tid & 7;
    const int et = w & 3, ip = w >> 2;
    f32x4 Sacc[8];
#pragma unroll
    for (int d8 = 0; d8 < 8; ++d8) {
        if (smp) {
#pragma unroll
            for (int jj = 0; jj < 4; ++jj) Sacc[d8][jj] = p.in[4][((size_t)(b * 4 + h) * 128 + d8 * 16 + q4 * 4 + jj) * 256 + e0 + et * 16 + r16];
        } else Sacc[d8] = (f32x4){0.f, 0.f, 0.f, 0.f};
    }
    const int tq_ = r16 >> 2, tp_ = r16 & 3;
    const unsigned v4a = lbase + 34816u + (unsigned)(((q4 * 8 + tq_) * 72 + et * 16 + 4 * tp_) * 2);
    const unsigned k4a = lbase + 17408u + (unsigned)(((q4 * 8 + tq_) * 136 + 4 * tp_) * 2);
    struct Pre { u32x4 q0, q1, k0, k1, a, v; f32x4 e; };
    Pre PA, PB;
    PA.e = (f32x4){0.f, 0.f, 0.f, 0.f}; PB.e = (f32x4){0.f, 0.f, 0.f, 0.f};
#define GLA_PREFETCH(P, R) do { \
        const unsigned o0_ = ((R) + pt0) * 512u + h * 128 + poc * 8, o1_ = ((R) + pt1) * 512u + h * 128 + poc * 8; \
        P.q0 = *(const u32x4*)(BQ + o0_); P.q1 = *(const u32x4*)(BQ + o1_); P.k0 = *(const u32x4*)(BKb + o0_); P.k1 = *(const u32x4*)(BKb + o1_); \
        P.a = *(const u32x4*)(AB + ((R) + vt) * 256u + h * 64 + veo * 8); \
        P.v = *(const u32x4*)(BV + ((R) + vt) * 1024u + h * 256 + e0 + veo * 8); \
        if (tid < 32) P.e = *(const f32x4*)(ET + ((R) >> 6) * 512u + h * 128 + tid * 4); } while (0)
    GLA_PREFETCH(PA, rbase);
    if (nch > 1) GLA_PREFETCH(PB, rbase + 64);
    f32x4 po0 = {0.f, 0.f, 0.f, 0.f}, po1 = {0.f, 0.f, 0.f, 0.f}; unsigned prow = 0; bool pend = false;
#define GLA_STORE_OUT() do { \
            _Pragma("unroll") for (int x2 = 0; x2 < 2; ++x2) { \
                const unsigned row = prow + (ip * 2 + x2) * 16 + r16; \
                const f32x4 o = x2 ? po1 : po0; \
                u32x2 wv; wv.x = cvt_pk_bf16(o[0], o[1]); wv.y = cvt_pk_bf16(o[2], o[3]); \
                *(u32x2*)(BVo + row * 1024u + h * 256 + e0 + et * 16 + q4 * 4) = wv; \
                float ss = o[0] * o[0] + o[1] * o[1] + o[2] * o[2] + o[3] * o[3]; \
                ss += __shfl_xor(ss, 16); ss += __shfl_xor(ss, 32); \
                if (q4 == 0) BOSQP[row * 64u + h * 16 + sl * 4 + et] = ss; \
            } } while (0)
#define GLA_CHUNK(P, CI) do { \
        const unsigned r0 = rbase + (unsigned)(CI) * 64; \
        *(LAS u32x4*)(QG + pt0 * 136 + poc * 8) = P.q0; *(LAS u32x4*)(QG + pt1 * 136 + poc * 8) = P.q1; \
        *(LAS u32x4*)(KG + pt0 * 136 + poc * 8) = P.k0; *(LAS u32x4*)(KG + pt1 * 136 + poc * 8) = P.k1; \
        *(LAS u32x4*)(As + vt * 72 + veo * 8) = P.a; *(LAS u32x4*)(Vs + vt * 72 + veo * 8) = P.v; \
        if (tid < 32) *(LAS f32x4*)(GL + tid * 4) = P.e; \
        lds_barrier(); \
        if (pend) GLA_STORE_OUT(); \
        if ((CI) + 2 < nch) GLA_PREFETCH(P, r0 + 128); \
        bf16x8 vf[2]; \
        { bf16x4 a0, a1, b0, b1; \
          asm volatile("ds_read_b64_tr_b16 %0, %4\n\tds_read_b64_tr_b16 %1, %4 offset:576\n\tds_read_b64_tr_b16 %2, %4 offset:4608\n\tds_read_b64_tr_b16 %3, %4 offset:5184\n\ts_waitcnt lgkmcnt(0)" \
                       : "=&v"(a0), "=&v"(a1), "=&v"(b0), "=&v"(b1) : "v"(v4a) : "memory"); \
          vf[0] = cat4(a0, a1); vf[1] = cat4(b0, b1); } \
        f32x4 ot[2]; \
        ot[0] = (f32x4){0.f, 0.f, 0.f, 0.f}; ot[1] = (f32x4){0.f, 0.f, 0.f, 0.f}; \
        _Pragma("unroll") for (int x2 = 0; x2 < 2; ++x2) \
            _Pragma("unroll") for (int jb = 0; jb < 2; ++jb) { \
                const bf16x8 af = *(const LAS bf16x8*)(As + ((ip * 2 + x2) * 16 + r16) * 72 + jb * 32 + q4 * 8); \
                ot[x2] = MFMA16(vf[jb], af, ot[x2]); } \
        _Pragma("unroll") for (int db = 0; db < 4; ++db) { \
            const bf16x8 sf = pack8(Sacc[2 * db], Sacc[2 * db + 1]); \
            _Pragma("unroll") for (int x2 = 0; x2 < 2; ++x2) { \
                const LAS bf16_t* qp = QG + ((ip * 2 + x2) * 16 + r16) * 136 + db * 32 + q4 * 4; \
                const bf16x8 qv = cat4(*(const LAS bf16x4*)qp, *(const LAS bf16x4*)(qp + 16)); \
                ot[x2] = MFMA16(sf, qv, ot[x2]); } } \
        po0 = ot[0]; po1 = ot[1]; prow = r0; pend = true; \
        _Pragma("unroll") for (int jb = 0; jb < 2; ++jb) { \
            bf16x4 kl[8], kh[8]; \
            const unsigned ka = k4a + (unsigned)(jb * 32 * 272); \
            asm volatile("ds_read_b64_tr_b16 %0, %16 offset:0\n\t" "ds_read_b64_tr_b16 %1, %16 offset:1088\n\t" "ds_read_b64_tr_b16 %2, %16 offset:32\n\t" "ds_read_b64_tr_b16 %3, %16 offset:1120\n\t" "ds_read_b64_tr_b16 %4, %16 offset:64\n\t" "ds_read_b64_tr_b16 %5, %16 offset:1152\n\t" "ds_read_b64_tr_b16 %6, %16 offset:96\n\t" "ds_read_b64_tr_b16 %7, %16 offset:1184\n\t" "ds_read_b64_tr_b16 %8, %16 offset:128\n\t" "ds_read_b64_tr_b16 %9, %16 offset:1216\n\t" "ds_read_b64_tr_b16 %10, %16 offset:160\n\t" "ds_read_b64_tr_b16 %11, %16 offset:1248\n\t" "ds_read_b64_tr_b16 %12, %16 offset:192\n\t" "ds_read_b64_tr_b16 %13, %16 offset:1280\n\t" "ds_read_b64_tr_b16 %14, %16 offset:224\n\t" "ds_read_b64_tr_b16 %15, %16 offset:1312\n\t" "s_waitcnt lgkmcnt(0)" \
                         : "=&v"(kl[0]), "=&v"(kh[0]), "=&v"(kl[1]), "=&v"(kh[1]), "=&v"(kl[2]), "=&v"(kh[2]), "=&v"(kl[3]), "=&v"(kh[3]), "=&v"(kl[4]), "=&v"(kh[4]), "=&v"(kl[5]), "=&v"(kh[5]), "=&v"(kl[6]), "=&v"(kh[6]), "=&v"(kl[7]), "=&v"(kh[7]) : "v"(ka) : "memory"); \
            _Pragma("unroll") for (int d8 = 0; d8 < 8; ++d8) Sacc[d8] = MFMA16(cat4(kl[d8], kh[d8]), vf[jb], Sacc[d8]); } \
        _Pragma("unroll") for (int d8 = 0; d8 < 8; ++d8) { \
            const f32x4 dec = *(const LAS f32x4*)(GL + d8 * 16 + q4 * 4); \
            Sacc[d8] = Sacc[d8] * dec; } \
        lds_barrier(); \
    } while (0)
    for (int ci = 0; ci < nch; ci += 2) {
        GLA_CHUNK(PA, ci);
        if (ci + 1 < nch) GLA_CHUNK(PB, ci + 1);
    }
    if (pend) GLA_STORE_OUT();
#undef GLA_STORE_OUT
#undef GLA_PREFETCH
#undef GLA_CHUNK
    if (ip == 0 && !dummy) {
        float* og = p.out + (smp ? O_GS : O_GP);
#pragma unroll
        for (int d8 = 0; d8 < 8; ++d8)
#pragma unroll
            for (int jj = 0; jj < 4; ++jj) og[((size_t)(b * 4 + h) * 128 + d8 * 16 + q4 * 4 + jj) * 256 + e0 + et * 16 + r16] = Sacc[d8][jj];
    }
}

__device__ __forceinline__ void phase2a(const Params& p, LAS unsigned char* L) {
#ifndef NO_PREP
    {
        PrepRegs RA, RB; const int G = gridDim.x; int it = blockIdx.x;
        if (it < 2176) prep_load(p, it, RA);
        while (it < 2176) {
            int nx = it + G; gla_prep_item(p, L, it, RA, nx < 2176 ? nx : -1, RB); it = nx;
            if (it >= 2176) break;
            nx = it + G; gla_prep_item(p, L, it, RB, nx < 2176 ? nx : -1, RA); it = nx;
        }
    }
#endif
#ifndef NO_ATTN
    for (int it = blockIdx.x; it < 2176; it += gridDim.x) attn_item(p, L, it, (bf16_t*)(p.ws + WS_GATE), 2048);
#endif
}
__device__ __forceinline__ void phase2b(const Params& p, LAS unsigned char* L) {
#ifndef NO_SCAN
#ifdef PROBE_SCAN2
    for (int it = blockIdx.x; it < 768; it += gridDim.x) gla_scan_item(p, L, it, true);
#endif
    if (gridDim.x == 256) {
        const int xcd = blockIdx.x & 7, loc = blockIdx.x >> 3;
        const int base = (xcd * 8 + (loc >> 2)) * 4 + (loc & 3);
        gla_scan_item(p, L, base, false); gla_scan_item(p, L, 256 + base, false); gla_scan_item(p, L, 512 + base, false);
    } else {
        for (int it = blockIdx.x; it < 768; it += gridDim.x) gla_scan_item(p, L, it, false);
    }
#endif
}

__device__ __forceinline__ void phase3(const Params& p) {
    unsigned char* ws = p.ws;
    const bf16_t* BV = (const bf16_t*)(ws + WS_BV); bf16_t* Yb = (bf16_t*)(ws + WS_GATE); const float* BOSQP = (const float*)((unsigned char*)p.out + SC_SQ);
    const float* gg = p.in[12];
    const long gtid = (long)blockIdx.x * NTHR + threadIdx.x, gsz = (long)gridDim.x * NTHR;
    const long total = (long)T * 128;
    for (long it = gtid; it < total; it += gsz) {
        const long row = it >> 7; const int c8 = (int)(it & 127) * 8, h = c8 >> 8;
        float sq;
        { const f32x4 s0 = *(const f32x4*)(BOSQP + row * 64 + h * 16), s1 = *(const f32x4*)(BOSQP + row * 64 + h * 16 + 4), s2 = *(const f32x4*)(BOSQP + row * 64 + h * 16 + 8), s3 = *(const f32x4*)(BOSQP + row * 64 + h * 16 + 12);
          sq = ((s0[0] + s0[1]) + (s0[2] + s0[3])) + ((s1[0] + s1[1]) + (s1[2] + s1[3])) + ((s2[0] + s2[1]) + (s2[2] + s2[3])) + ((s3[0] + s3[1]) + (s3[2] + s3[3])); }
        const float rs = rsqrtf(sq * (1.f / 256.f) + EPS);
        const u32x4 bo = *(const u32x4*)(BV + row * 1024 + c8);
        const u32x4 gt = *(const u32x4*)(Yb + row * 2048 + 1024 + c8);
        const f32x4 g0 = *(const f32x4*)(gg + (c8 & 255)), g1 = *(const f32x4*)(gg + (c8 & 255) + 4);
        u32x4 o;
        o.x = cvt_pk_bf16(bflo(bo.x) * rs * g0[0] * siluf(bflo(gt.x)), bfhi(bo.x) * rs * g0[1] * siluf(bfhi(gt.x)));
        o.y = cvt_pk_bf16(bflo(bo.y) * rs * g0[2] * siluf(bflo(gt.y)), bfhi(bo.y) * rs * g0[3] * siluf(bfhi(gt.y)));
        o.z = cvt_pk_bf16(bflo(bo.z) * rs * g1[0] * siluf(bflo(gt.z)), bfhi(bo.z) * rs * g1[1] * siluf(bfhi(gt.z)));
        o.w = cvt_pk_bf16(bflo(bo.w) * rs * g1[2] * siluf(bflo(gt.w)), bfhi(bo.w) * rs * g1[3] * siluf(bfhi(gt.w)));
        *(u32x4*)(Yb + row * 2048 + 1024 + c8) = o;
    }
}

__device__ __forceinline__ void lru_item(const Params& p, LAS unsigned char* L, int item) {
    unsigned char* ws = p.ws;
    const int tid = threadIdx.x, lane = tid & 63, w = tid >> 6, r16 = lane & 15, q4 = lane >> 4;
    LAS bf16_t* Wl = (LAS bf16_t*)L;
    LAS bf16_t* U = (LAS bf16_t*)(L + 76800);
    LAS float* Aa = (LAS float*)(L + 102400);
    LAS float* Bb = (LAS float*)(L + 126976);
    LAS float* SP = (LAS float*)(L + 151552);
    LAS float* SH = (LAS float*)(L + 153088);
    LAS float* HC = (LAS float*)(L + 154624);
    LAS float* CW = (LAS float*)(L + 155392);
    const bool smp = item >= 256;
    const int i2 = smp ? item - 256 : item;
    const int b = i2 >> 4, nb = (i2 >> 1) & 7, hf = i2 & 1;
    const int nch = smp ? 1 : 32;
    const unsigned rbase = smp ? (unsigned)T_P + b * 64 : (unsigned)b * 2048;
    const bf16_t* Z2 = (const bf16_t*)(ws + WS_Z2); bf16_t* Y2 = (bf16_t*)(ws + WS_Y2);
    const bf16_t* WA = (const bf16_t*)(ws + WS_WA) + nb * 192 * 192; const bf16_t* WI = (const bf16_t*)(ws + WS_WI) + nb * 192 * 192;
    for (int idx = tid; idx < 192 * 24; idx += NTHR) {
        const int r = idx / 24, g8 = idx % 24;
        const bf16_t* src = (r < 96) ? WA + (size_t)(hf * 96 + r) * 192 + g8 * 8 : WI + (size_t)(hf * 96 + r - 96) * 192 + g8 * 8;
        *(LAS u32x4*)(Wl + r * 200 + g8 * 8) = *(const u32x4*)src;
    }
    const bool cthr = tid < 384;
    const int cgp = tid % 24, tq = (tid / 24) & 15;
    const int chc = nb * 192 + cgp * 8;
    for (int idx = tid; idx < 5 * 192; idx += NTHR) { const int j = idx / 192, cc = idx % 192; CW[idx] = (j < 4) ? p.in[16][j * 1536 + nb * 192 + cc] : p.in[17][nb * 192 + cc]; }
    const int mt = w & 3, pg = w >> 2;
    float bra[3], bri[3], sp[3];
#pragma unroll
    for (int cp = 0; cp < 3; ++cp) {
        const int ch = nb * 192 + hf * 96 + (pg * 3 + cp) * 16 + r16;
        bra[cp] = p.in[19][ch]; bri[cp] = p.in[21][ch];
        const float lam = p.in[22][ch];
        sp[cp] = 8.f * (fmaxf(-lam, 0.f) + log1pf(__expf(-fabsf(lam))));
    }
    if (tid < 96) HC[tid] = smp ? p.in[6][b * 1536 + nb * 192 + hf * 96 + tid] : 0.f;
    const int sch0 = tid % 96, sseg0 = (tid / 96) & 3;
    const int ot0 = tid / 12, og0 = tid % 12, ot1 = (tid + 512) / 12, og1 = (tid + 512) % 12;
    const bool o1 = tid < 256;
    const int och0 = nb * 192 + hf * 96 + og0 * 8, och1 = nb * 192 + hf * 96 + og1 * 8;
    lds_barrier();
    u32x4 xr[7]; u32x4 pg0, pg1 = {0u, 0u, 0u, 0u};
#pragma unroll
    for (int r = 0; r < 7; ++r) {
        xr[r] = (u32x4){0u, 0u, 0u, 0u};
        const int pos = 4 * tq - 3 + r;
        if (cthr) {
            if (pos >= 0) xr[r] = *(const u32x4*)(Z2 + (unsigned)((rbase + pos) * 3072u + chc));
            else if (smp) {
                const float* hp = p.in[5] + ((size_t)b * 3 + (3 + pos)) * 1536 + chc;
                const f32x4 h0 = *(const f32x4*)hp, h1 = *(const f32x4*)(hp + 4);
                xr[r].x = cvt_pk_bf16(h0[0], h0[1]); xr[r].y = cvt_pk_bf16(h0[2], h0[3]); xr[r].z = cvt_pk_bf16(h1[0], h1[1]); xr[r].w = cvt_pk_bf16(h1[2], h1[3]);
            }
        }
    }
    pg0 = *(const u32x4*)(Z2 + (unsigned)((rbase + ot0) * 3072u + 1536 + och0));
    if (o1) pg1 = *(const u32x4*)(Z2 + (unsigned)((rbase + ot1) * 3072u + 1536 + och1));
    u32x4 so0 = {0u, 0u, 0u, 0u}, so1 = {0u, 0u, 0u, 0u}; unsigned sr = 0; bool spend = false;
    for (int ci = 0; ci < nch; ++ci) {
        const unsigned r0 = rbase + (unsigned)ci * 64;
        const bool more = (ci + 1 < nch);
        int sch = sch0, sseg = sseg0;
        asm volatile("" : "+v"(sch), "+v"(sseg));
        if (cthr) {
            float xv[7][8];
#pragma unroll
            for (int r = 0; r < 7; ++r) unpack8(xr[r], xv[r]);
            if (hf == 0 && !more && tq == 15) {
                float* oc = p.out + (smp ? O_CS : O_CP) + (size_t)b * 3 * 1536 + chc;
#pragma unroll
                for (int r = 0; r < 3; ++r) { *(f32x4*)(oc + r * 1536) = (f32x4){xv[4 + r][0], xv[4 + r][1], xv[4 + r][2], xv[4 + r][3]}; *(f32x4*)(oc + r * 1536 + 4) = (f32x4){xv[4 + r][4], xv[4 + r][5], xv[4 + r][6], xv[4 + r][7]}; }
            }
            float cw[5][8];
#pragma unroll
            for (int j = 0; j < 5; ++j) { const f32x4 c0 = *(const LAS f32x4*)(CW + j * 192 + cgp * 8), c1 = *(const LAS f32x4*)(CW + j * 192 + cgp * 8 + 4);
                cw[j][0] = c0[0]; cw[j][1] = c0[1]; cw[j][2] = c0[2]; cw[j][3] = c0[3]; cw[j][4] = c1[0]; cw[j][5] = c1[1]; cw[j][6] = c1[2]; cw[j][7] = c1[3]; }
#pragma unroll
            for (int tk = 0; tk < 4; ++tk) {
                float acc[8];
#pragma unroll
                for (int e = 0; e < 8; ++e) acc[e] = fmaf(xv[tk + 3][e], cw[3][e], fmaf(xv[tk + 2][e], cw[2][e], fmaf(xv[tk + 1][e], cw[1][e], fmaf(xv[tk][e], cw[0][e], cw[4][e]))));
                u32x4 uw; uw.x = cvt_pk_bf16(acc[0], acc[1]); uw.y = cvt_pk_bf16(acc[2], acc[3]); uw.z = cvt_pk_bf16(acc[4], acc[5]); uw.w = cvt_pk_bf16(acc[6], acc[7]);
                *(LAS u32x4*)(U + (4 * tq + tk) * 200 + cgp * 8) = uw;
            }
            if (more) {
#pragma unroll
                for (int r = 0; r < 7; ++r) xr[r] = *(const u32x4*)(Z2 + (unsigned)((r0 + 64 + 4 * tq - 3 + r) * 3072u + chc));
            }
        }
        lds_barrier();
        if (spend) { *(u32x4*)(Y2 + (unsigned)((sr + ot0) * 1536u + och0)) = so0; if (o1) *(u32x4*)(Y2 + (unsigned)((sr + ot1) * 1536u + och1)) = so1; }
        f32x4 ga[3], gi[3];
#pragma unroll
        for (int cp = 0; cp < 3; ++cp) { ga[cp] = (f32x4){0.f, 0.f, 0.f, 0.f}; gi[cp] = (f32x4){0.f, 0.f, 0.f, 0.f}; }
#pragma unroll 2
        for (int ks = 0; ks < 6; ++ks) {
            const bf16x8 uf = *(const LAS bf16x8*)(U + (mt * 16 + r16) * 200 + ks * 32 + q4 * 8);
#pragma unroll
            for (int cp = 0; cp < 3; ++cp) {
                const int ct = pg * 3 + cp;
                const bf16x8 wa = *(const LAS bf16x8*)(Wl + (ct * 16 + r16) * 200 + ks * 32 + q4 * 8), wi = *(const LAS bf16x8*)(Wl + (96 + ct * 16 + r16) * 200 + ks * 32 + q4 * 8);
                ga[cp] = MFMA16(uf, wa, ga[cp]); gi[cp] = MFMA16(uf, wi, gi[cp]);
            }
        }
#pragma unroll
        for (int cp = 0; cp < 3; ++cp) {
            const int cl = (pg * 3 + cp) * 16 + r16;
#pragma unroll
            for (int jj = 0; jj < 4; ++jj) {
                const int t = mt * 16 + q4 * 4 + jj;
                const float rg = sigmf(ga[cp][jj] + bra[cp]), ig = sigmf(gi[cp][jj] + bri[cp]);
                const float z = rg * sp[cp];
                const float a = __expf(-z);
                const float z2 = z + z;
                const float om = (z2 < 0.05f) ? z2 * (1.f - z2 * (0.5f - z2 * (0.16666667f - z2 * 0.041666668f))) : 1.f - a * a;
                const float uu = bf2f(U[t * 200 + hf * 96 + cl]);
                Aa[t * 96 + cl] = a; Bb[t * 96 + cl] = __builtin_amdgcn_sqrtf(om) * ig * uu;
            }
        }
        lds_barrier();
        if (cthr) {
            float P = 1.f, H = 0.f;
#pragma unroll
            for (int t = 0; t < 16; ++t) { const float a = Aa[(sseg * 16 + t) * 96 + sch]; H = a * H + Bb[(sseg * 16 + t) * 96 + sch]; P *= a; }
            SP[sseg * 96 + sch] = P; SH[sseg * 96 + sch] = H;
        }
        lds_barrier();
        if (cthr) {
            float hh = HC[(ci & 1) * 96 + sch];
#pragma unroll
            for (int sg = 0; sg < 3; ++sg) if (sg < sseg) hh = SP[sg * 96 + sch] * hh + SH[sg * 96 + sch];
#pragma unroll
            for (int t = 0; t < 16; ++t) { hh = Aa[(sseg * 16 + t) * 96 + sch] * hh + Bb[(sseg * 16 + t) * 96 + sch]; Bb[(sseg * 16 + t) * 96 + sch] = hh; }
            if (sseg == 3) HC[((ci + 1) & 1) * 96 + sch] = hh;
        }
        lds_barrier();
        {
            const f32x4 h0 = *(const LAS f32x4*)(Bb + ot0 * 96 + og0 * 8), h1 = *(const LAS f32x4*)(Bb + ot0 * 96 + og0 * 8 + 4);
            u32x4 o;
            o.x = cvt_pk_bf16(h0[0] * siluf(bflo(pg0.x)), h0[1] * siluf(bfhi(pg0.x)));
            o.y = cvt_pk_bf16(h0[2] * siluf(bflo(pg0.y)), h0[3] * siluf(bfhi(pg0.y)));
            o.z = cvt_pk_bf16(h1[0] * siluf(bflo(pg0.z)), h1[1] * siluf(bfhi(pg0.z)));
            o.w = cvt_pk_bf16(h1[2] * siluf(bflo(pg0.w)), h1[3] * siluf(bfhi(pg0.w)));
            so0 = o;
            if (more) pg0 = *(const u32x4*)(Z2 + (unsigned)((r0 + 64 + ot0) * 3072u + 1536 + och0));
        }
        if (o1) {
            const f32x4 h0 = *(const LAS f32x4*)(Bb + ot1 * 96 + og1 * 8), h1 = *(const LAS f32x4*)(Bb + ot1 * 96 + og1 * 8 + 4);
            u32x4 o;
            o.x = cvt_pk_bf16(h0[0] * siluf(bflo(pg1.x)), h0[1] * siluf(bfhi(pg1.x)));
            o.y = cvt_pk_bf16(h0[2] * siluf(bflo(pg1.y)), h0[3] * siluf(bfhi(pg1.y)));
            o.z = cvt_pk_bf16(h1[0] * siluf(bflo(pg1.z)), h1[1] * siluf(bfhi(pg1.z)));
            o.w = cvt_pk_bf16(h1[2] * siluf(bflo(pg1.w)), h1[3] * siluf(bfhi(pg1.w)));
            so1 = o;
            if (more) pg1 = *(const u32x4*)(Z2 + (unsigned)((r0 + 64 + ot1) * 3072u + 1536 + och1));
        }
        sr = r0; spend = true;
        lds_barrier();
    }
    if (spend) { *(u32x4*)(Y2 + (unsigned)((sr + ot0) * 1536u + och0)) = so0; if (o1) *(u32x4*)(Y2 + (unsigned)((sr + ot1) * 1536u + och1)) = so1; }
    if (tid < 96) p.out[(smp ? O_LS : O_LP) + (size_t)b * 1536 + nb * 192 + hf * 96 + tid] = HC[(nch & 1) * 96 + tid];
    lds_barrier();
}

__device__ __forceinline__ void phase6(const Params& p, LAS unsigned char* L) {
    if (gridDim.x == 256) {
        const int xcd = blockIdx.x & 7, loc = blockIdx.x >> 3;
        const int pair = xcd * 16 + (loc >> 1), hf = loc & 1;
        lru_item(p, L, pair * 2 + hf); lru_item(p, L, 256 + pair * 2 + hf); lru_item(p, L, 512 + pair * 2 + hf);
    } else {
        for (int it = blockIdx.x; it < 768; it += gridDim.x) lru_item(p, L, it);
    }
}

__device__ __forceinline__ void phase8(const Params& p) {
    const float* rsq = (const float*)(p.ws + WS_RSQ2); const float* g = p.in[24]; float* y = p.out; const bf16_t* xb = (const bf16_t*)(p.ws + WS_XB);
    const long gtid = (long)blockIdx.x * NTHR + threadIdx.x, gsz = (long)gridDim.x * NTHR;
    const long total = (long)T * 128;
    for (long it = gtid; it < total; it += gsz) {
        const long row = it >> 7; const int c8 = (int)(it & 127) * 8;
        const float rs = rsqrtf(rsq[row] * (1.f / 1024.f) + EPS);
        const u32x4 xw = *(const u32x4*)(xb + row * 1024 + c8);
        const f32x4 g0 = *(const f32x4*)(g + c8), g1 = *(const f32x4*)(g + c8 + 4);
        f32x4 o0, o1;
        o0[0] = bflo(xw.x) * rs * g0[0]; o0[1] = bfhi(xw.x) * rs * g0[1]; o0[2] = bflo(xw.y) * rs * g0[2]; o0[3] = bfhi(xw.y) * rs * g0[3];
        o1[0] = bflo(xw.z) * rs * g1[0]; o1[1] = bfhi(xw.z) * rs * g1[1]; o1[2] = bflo(xw.w) * rs * g1[2]; o1[3] = bfhi(xw.w) * rs * g1[3];
        *(f32x4*)(y + row * 1024 + c8) = o0; *(f32x4*)(y + row * 1024 + c8 + 4) = o1;
    }
}

#define XB_TMO      128
#define XB_XCNT(j)  (256  + 64 * (j))
#define XB_XSUB(j)  (1280 + 64 * (j))
#define XB_XGEN(j)  (2304 + 64 * (j))
#define XB_TOP      3328
#define XB_TOPGEN   3392
#define XCD_BAR_WORDS 3456
#define XB_SPIN_CAP (1u << 18)
__device__ __forceinline__ unsigned xb_ld(unsigned* p)              { return __hip_atomic_load(p, __ATOMIC_RELAXED, __HIP_MEMORY_SCOPE_AGENT); }
__device__ __forceinline__ unsigned xb_add(unsigned* p, unsigned v) { return __hip_atomic_fetch_add(p, v, __ATOMIC_RELAXED, __HIP_MEMORY_SCOPE_AGENT); }
__device__ __forceinline__ unsigned xb_xcc_id() { return (unsigned)__builtin_amdgcn_s_getreg((3 << 11) | 20) & 0xFu; }
#define XB_SPIN(cond, bar) do { unsigned _sp = 0; while (cond) { __builtin_amdgcn_s_sleep(1); \
    if ((++_sp & 255u) == 0u) { if (xb_ld(&(bar)[XB_TMO])) break; if (_sp > XB_SPIN_CAP) { atomicAdd(&(bar)[XB_TMO], 1u); break; } } } } while (0)
struct XcdBarrier { unsigned* bar; unsigned x; volatile LAS unsigned* st; };
__device__ __forceinline__ XcdBarrier xcd_barrier_post(unsigned* bar, volatile LAS unsigned* st) {
    XcdBarrier b; b.bar = bar; b.x = xb_xcc_id(); b.st = st;
    if (threadIdx.x == 0) (void)xb_add(&bar[XB_XCNT(b.x)], 1u);
    return b;
}
__device__ __forceinline__ void xcd_barrier_complete(unsigned* bar, unsigned x, unsigned& nloc, unsigned& nx) {
    const unsigned G = gridDim.x * gridDim.y * gridDim.z;
    unsigned sum, cnt, mine, sp = 0u;
    for (;;) {
        sum = 0u; cnt = 0u; mine = 0u;
#pragma unroll
        for (unsigned j = 0; j < 16; ++j) { const unsigned c = xb_ld(&bar[XB_XCNT(j)]); sum += c; cnt += (c > 0u) ? 1u : 0u; mine = (j == x) ? c : mine; }
        if (sum == G) break;
        __builtin_amdgcn_s_sleep(1);
        if ((++sp & 255u) == 0u) { if (xb_ld(&bar[XB_TMO])) break; if (sp > XB_SPIN_CAP) { atomicAdd(&bar[XB_TMO], 1u); break; } }
    }
    nloc = mine > 0u ? mine : 1u; nx = cnt > 0u ? cnt : 1u;
}
__device__ __forceinline__ void xcd_barrier(const XcdBarrier& b) {
    asm volatile("s_waitcnt vmcnt(0)" ::: "memory");
    __syncthreads();
    if (threadIdx.x == 0) {
        unsigned* bar = b.bar;
        __builtin_amdgcn_s_waitcnt(0);
        unsigned nloc = b.st[0], nx = b.st[1];
        if (nloc == 0u) { xcd_barrier_complete(bar, b.x, nloc, nx); b.st[0] = nloc; b.st[1] = nx; }
        const unsigned old = xb_add(&bar[XB_XSUB(b.x)], 1u);
        const unsigned gen = old / nloc;
        if (old + 1u == (gen + 1u) * nloc) {
            __builtin_amdgcn_fence(__ATOMIC_RELEASE, "agent");
            asm volatile("s_waitcnt vmcnt(0)" ::: "memory");
            const unsigned og = xb_add(&bar[XB_TOP], 1u);
            const unsigned tg = og / nx;
            if (og + 1u == (tg + 1u) * nx) xb_add(&bar[XB_TOPGEN], 1u);
            else XB_SPIN(xb_ld(&bar[XB_TOPGEN]) == tg, bar);
            __builtin_amdgcn_fence(__ATOMIC_ACQUIRE, "agent");
            xb_add(&bar[XB_XGEN(b.x)], 1u);
            asm volatile("s_waitcnt vmcnt(0)" ::: "memory");
        } else {
            XB_SPIN(xb_ld(&bar[XB_XGEN(b.x)]) == gen, bar);
            __builtin_amdgcn_fence(__ATOMIC_ACQUIRE, "agent");
            asm volatile("s_waitcnt vmcnt(0)" ::: "memory");
        }
    }
    __syncthreads();
}

__global__ void __launch_bounds__(NTHR) mega(Params p) {
    extern __shared__ __attribute__((aligned(16))) unsigned char lds_raw[];
    LAS unsigned char* L = (LAS unsigned char*)lds_raw;
    cg::grid_group grid = cg::this_grid();
    unsigned char* ws = p.ws;
    const int lo = p.ph_lo, hi = p.ph_hi;
    LAS unsigned* stw = (LAS unsigned*)(L + (LDS_BYTES - 16));
    if (threadIdx.x < 4) stw[threadIdx.x] = 0u;
    __syncthreads();
    const XcdBarrier xb = xcd_barrier_post((unsigned*)(ws + WS_BAR), (volatile LAS unsigned*)stw);
#ifndef PHMASK
#define PHMASK 0x1ff
#endif
#define IN(k) (((PHMASK >> (k)) & 1) && lo <= (k) && (k) < hi)
#define SEAM(k) do { if (IN(k) && IN((k) + 1)) xcd_barrier(xb); } while (0)
    if (hi > 1000) grid.sync();
    if (IN(0)) phase0(p);
    SEAM(0);
    if (IN(1)) {
        pg8::Gemm g{(const bf16_t*)(ws + WS_XB), (const bf16_t*)(ws + WS_WINE), T, NE_PAD, 1024};
        pg8::StaticOrder S; S.init(T, NE_PAD, gridDim.x, blockIdx.x);
        EpiInEven E{ws, p.out, (const float*)(ws + WS_RSTD0), p.in[10]};
        pg8::gemm_phase<EpiInEven>(L, g, S, E);
    }
    SEAM(1);
    if (IN(2)) { phase2a(p, L); xcd_barrier(xb); phase2b(p, L); }
    SEAM(2);
    if (IN(3)) phase3(p);
    SEAM(3);
    if (IN(4)) {
        pg8::Gemm g{(const bf16_t*)(ws + WS_GATE), (const bf16_t*)(ws + WS_WOUTE), T, 1024, 2048};
        pg8::StaticOrder S; S.init(T, 1024, gridDim.x, blockIdx.x);
        EpiOutResB E{(bf16_t*)(ws + WS_XB), (float*)(ws + WS_RSQ1)};
        pg8::gemm_phase<EpiOutResB>(L, g, S, E);
    }
    SEAM(4);
    if (IN(5)) {
        pg8::Gemm g{(const bf16_t*)(ws + WS_XB), (const bf16_t*)(ws + WS_WINO), T, 3072, 1024};
        pg8::StaticOrder S; S.init(T, 3072, gridDim.x, blockIdx.x);
        EpiInOdd E{(bf16_t*)(ws + WS_Z2), (const float*)(ws + WS_RSQ1)};
        pg8::gemm_phase<EpiInOdd>(L, g, S, E);
    }
    SEAM(5);
    if (IN(6)) phase6(p, L);
    SEAM(6);
    if (IN(7)) {
        pg8::Gemm g{(const bf16_t*)(ws + WS_Y2), (const bf16_t*)(ws + WS_WOUTO), T, 1024, 1536};
        pg8::StaticOrder S; S.init(T, 1024, gridDim.x, blockIdx.x);
        EpiOutResB E{(bf16_t*)(ws + WS_XB), (float*)(ws + WS_RSQ2)};
        pg8::gemm_phase<EpiOutResB>(L, g, S, E);
    }
    SEAM(7);
    if (IN(8)) phase8(p);
#undef IN
#undef SEAM
}

extern "C" void kernel_launch(void* const* d_in, const int* in_sizes, int n_in, void* d_out, int out_size, void* d_ws, size_t ws_size, hipStream_t stream) {
    static int grid_blocks = 0;
    if (grid_blocks == 0) {
        if (n_in != 25 || (size_t)out_size != O_END || ws_size < WS_TOTAL) { fprintf(stderr, "kernel_launch: unexpected shapes n_in %d out %d ws %zu (need %zu)\n", n_in, out_size, ws_size, (size_t)WS_END); grid_blocks = -1; return; }
        int dev = 0, cus = 0, per_cu = 0;
        (void)hipGetDevice(&dev);
        (void)hipDeviceGetAttribute(&cus, hipDeviceAttributeMultiprocessorCount, dev);
        if (hipFuncSetAttribute((const void*)mega, hipFuncAttributeMaxDynamicSharedMemorySize, LDS_BYTES) != hipSuccess) { fprintf(stderr, "kernel_launch: hipFuncSetAttribute failed\n"); }
        if (hipOccupancyMaxActiveBlocksPerMultiprocessor(&per_cu, (const void*)mega, NTHR, LDS_BYTES) != hipSuccess || per_cu < 1) per_cu = 1;
        (void)hipGetLastError();
        grid_blocks = cus * per_cu;
        if (grid_blocks <= 0) grid_blocks = 256;
    }
    if (grid_blocks < 0) return;
    Params p{};
    for (int i = 0; i < 25; ++i) p.in[i] = (const float*)d_in[i];
    p.out = (float*)d_out; p.ws = (unsigned char*)d_ws;
#if ONE_LAUNCH
#ifdef PROBE_X
    { const int seq[3][2] = {{0, PROBE_Y + 1}, {PROBE_X, PROBE_Y + 1}, {PROBE_Y + 1, 9}};
      for (int li = 0; li < 3; ++li) { if (seq[li][0] >= seq[li][1]) continue; p.ph_lo = seq[li][0]; p.ph_hi = seq[li][1]; void* args[] = {&p};
        (void)hipMemsetAsync((char*)d_ws + WS_BAR, 0, 16384, stream);
        hipError_t e = hipLaunchCooperativeKernel((const void*)mega, dim3(grid_blocks), dim3(NTHR), args, LDS_BYTES, stream);
        if (e != hipSuccess) fprintf(stderr, "cooperative launch failed: %s (grid %d)\n", hipGetErrorString(e), grid_blocks); } }
#else
    p.ph_lo = 0; p.ph_hi = 9;
    (void)hipMemsetAsync((char*)d_ws + WS_BAR, 0, 16384, stream);
    { void* args[] = {&p}; hipError_t e = hipLaunchCooperativeKernel((const void*)mega, dim3(grid_blocks), dim3(NTHR), args, LDS_BYTES, stream);
      if (e != hipSuccess) fprintf(stderr, "cooperative launch failed: %s (grid %d)\n", hipGetErrorString(e), grid_blocks); }
#endif
#else
    for (int ph = 0; ph < 9; ++ph) {
        p.ph_lo = ph; p.ph_hi = ph + 1;
        (void)hipMemsetAsync((char*)d_ws + WS_BAR, 0, 16384, stream);
        void* args[] = {&p}; hipError_t e = hipLaunchCooperativeKernel((const void*)mega, dim3(grid_blocks), dim3(NTHR), args, LDS_BYTES, stream);
        if (e != hipSuccess) fprintf(stderr, "cooperative launch %d failed: %s (grid %d)\n", ph, hipGetErrorString(e), grid_blocks);
    }
#endif
}
```

```cpp
#include <hip/hip_runtime.h>
#include <hip/hip_cooperative_groups.h>
#include <cstdio>
namespace cg = cooperative_groups;

#ifndef ONE_LAUNCH
#define ONE_LAUNCH 1
#endif

#define LAS __attribute__((address_space(3)))
typedef unsigned short bf16_t;
typedef short bf16x8 __attribute__((ext_vector_type(8)));
typedef short bf16x4 __attribute__((ext_vector_type(4)));
typedef float f32x4 __attribute__((ext_vector_type(4)));
typedef unsigned u32x4 __attribute__((ext_vector_type(4)));
typedef unsigned u32x2 __attribute__((ext_vector_type(2)));

constexpr int T_P = 32768, T_S = 2048, T = T_P + T_S, DM = 1024;
constexpr int NE_PAD = 6144;
constexpr int LDS_BYTES = 159744;
constexpr int NTHR = 512;
constexpr float EPS = 1e-6f;

constexpr size_t WS_WINE = 0;
constexpr size_t WS_WOUTE = WS_WINE + (size_t)NE_PAD * 1024 * 2;
constexpr size_t WS_WINO = WS_WOUTE + (size_t)1024 * 2048 * 2;
constexpr size_t WS_WOUTO = WS_WINO + (size_t)3072 * 1024 * 2;
constexpr size_t WS_WA = WS_WOUTO + (size_t)1024 * 1536 * 2;
constexpr size_t WS_WI = WS_WA + (size_t)8 * 192 * 192 * 2;
constexpr size_t WS_XB = WS_WI + (size_t)8 * 192 * 192 * 2;
constexpr size_t WS_RSTD0 = WS_XB + (size_t)T * 1024 * 2;
constexpr size_t WS_RSQ1 = WS_RSTD0 + (size_t)T * 4;
constexpr size_t WS_RSQ2 = WS_RSQ1 + (size_t)T * 4;
constexpr size_t WS_BOSQ = WS_RSQ2 + (size_t)T * 4;
constexpr size_t WS_Q = WS_BOSQ + (size_t)T * 16;
constexpr size_t WS_K = WS_Q + (size_t)T * 1024 * 2;
constexpr size_t WS_V = WS_K + (size_t)T * 256 * 2;
constexpr size_t WS_BQ = WS_V + (size_t)T * 256 * 2;
constexpr size_t WS_BK = WS_BQ + (size_t)T * 512 * 2;
constexpr size_t WS_BV = WS_BK + (size_t)T * 512 * 2;
constexpr size_t WS_GATE = WS_BV + (size_t)T * 1024 * 2;
constexpr size_t WS_BLR = WS_GATE + (size_t)T * 2048 * 2;
constexpr size_t WS_END = WS_BLR + (size_t)T * 512 * 2;
constexpr size_t WS_BAR = WS_END;
constexpr size_t WS_TOTAL = WS_BAR + 16384;
constexpr size_t WS_Z2 = WS_Q;
constexpr size_t WS_Y2 = WS_GATE;
static_assert(WS_Z2 + (size_t)T * 3072 * 2 <= WS_GATE, "Z2 alias");

constexpr size_t O_Y = 0;
constexpr size_t O_KP = (size_t)T * 1024;
constexpr size_t O_VP = O_KP + 524288;
constexpr size_t O_GP = O_VP + 524288;
constexpr size_t O_CP = O_GP + 2097152;
constexpr size_t O_LP = O_CP + 73728;
constexpr size_t O_KS = O_LP + 24576;
constexpr size_t O_VS = O_KS + 524288;
constexpr size_t O_GS = O_VS + 524288;
constexpr size_t O_CS = O_GS + 4194304;
constexpr size_t O_LS = O_CS + 147456;
constexpr size_t O_END = O_LS + 49152;

struct Params {
    const float* in[25];
    float* out;
    unsigned char* ws;
    int ph_lo, ph_hi;
};

__device__ __forceinline__ unsigned cvt_pk_bf16(float lo, float hi) { unsigned r; asm volatile("v_cvt_pk_bf16_f32 %0, %1, %2" : "=v"(r) : "v"(lo), "v"(hi)); return r; }
__device__ __forceinline__ bf16_t f2bf(float f) { return (bf16_t)(cvt_pk_bf16(f, 0.f) & 0xffffu); }
__device__ __forceinline__ float bf2f(bf16_t b) { return __uint_as_float(((unsigned)b) << 16); }
__device__ __forceinline__ float bflo(unsigned w) { return __uint_as_float(w << 16); }
__device__ __forceinline__ float bfhi(unsigned w) { return __uint_as_float(w & 0xffff0000u); }
__device__ __forceinline__ float rcpf_(float x) { return __builtin_amdgcn_rcpf(x); }
__device__ __forceinline__ float siluf(float x) { return x * rcpf_(1.f + __expf(-x)); }
__device__ __forceinline__ float sigmf(float x) { return rcpf_(1.f + __expf(-x)); }
__device__ __forceinline__ void lds_barrier() { asm volatile("s_waitcnt lgkmcnt(0)" ::: "memory"); __builtin_amdgcn_s_barrier(); asm volatile("" ::: "memory"); }
__device__ __forceinline__ bf16x8 pack8(const f32x4& a, const f32x4& b) {
    u32x4 p; p.x = cvt_pk_bf16(a[0], a[1]); p.y = cvt_pk_bf16(a[2], a[3]); p.z = cvt_pk_bf16(b[0], b[1]); p.w = cvt_pk_bf16(b[2], b[3]);
    return __builtin_bit_cast(bf16x8, p);
}
__device__ __forceinline__ bf16x8 cat4(const bf16x4 a, const bf16x4 b) { bf16x8 r; r[0] = a[0]; r[1] = a[1]; r[2] = a[2]; r[3] = a[3]; r[4] = b[0]; r[5] = b[1]; r[6] = b[2]; r[7] = b[3]; return r; }
__device__ __forceinline__ void unpack8(const u32x4 w, float (&v)[8]) { v[0] = bflo(w.x); v[1] = bfhi(w.x); v[2] = bflo(w.y); v[3] = bfhi(w.y); v[4] = bflo(w.z); v[5] = bfhi(w.z); v[6] = bflo(w.w); v[7] = bfhi(w.w); }
#define MFMA16(a, b, c) __builtin_amdgcn_mfma_f32_16x16x32_bf16((a), (b), (c), 0, 0, 0)

namespace pg8 {
constexpr int BM = 256, BK = 64, HALF = 128, HTB = HALF * BK * 2, STAGE_BYTES = 8 * HTB, NXCD = 8, WGM = 8;
__device__ __forceinline__ int lds_byte(int r, int c) { const int st = (r >> 4) * 2 + (c >> 5), rr = r & 15, cc = c & 31, ob = rr * 64 + cc * 2; return st * 1024 + (ob ^ (((ob >> 9) & 1) << 5)); }
__device__ __forceinline__ int perm32(int rho) { const int n = rho >> 4, i = rho & 15; return 8 * (i >> 2) + 4 * n + (i & 3); }
__device__ __forceinline__ void stage_rc(int b, int& R, int& C) { const int st = b / 1024, sb = b % 1024, swz = sb ^ (((sb >> 9) & 1) << 5); R = (st >> 1) * 16 + swz / 64; C = (st & 1) * 32 + (swz % 64) / 2; }
struct Unit { int pm, pn; };
struct Gemm { const bf16_t* A; const bf16_t* Bt; int M, N, K; };
struct StaticOrder {
    int nM, nN, nwg, G, c;
    __device__ void init(int M, int N, int G_, int c_) { nM = M / BM; nN = N / BM; nwg = nM * nN; G = G_; c = c_; }
    __device__ __forceinline__ bool next(int i, Unit& u) const {
        const long Lx = (long)i * G + c; if (Lx >= nwg) return false;
        int wgid = (int)Lx; { const int q = nwg / NXCD, r = nwg % NXCD, xcd = wgid % NXCD, off = wgid / NXCD; wgid = (xcd < r ? xcd * (q + 1) : r * (q + 1) + (xcd - r) * q) + off; }
        const int nig = WGM * nN, gid = wgid / nig, fm = gid * WGM, gsz = (nM - fm) < WGM ? (nM - fm) : WGM;
        u.pm = fm + ((wgid % nig) % gsz); u.pn = (wgid % nig) / gsz; return true;
    }
};

template <class Epi>
__device__ __forceinline__ void gemm_phase(LAS unsigned char* lds, const Gemm g, const StaticOrder& S, const Epi& E) {
    const int tid = threadIdx.x, wid = __builtin_amdgcn_readfirstlane(tid >> 6), lane = tid & 63, wr = wid >> 2, wc = wid & 3, fr = lane & 15, fq = lane >> 4;
    const int K = g.K, nt = K / BK;
    unsigned voffA[2], voffB[2];
#pragma unroll
    for (int i = 0; i < 2; ++i) { int R, C; stage_rc(tid * 16 + i * 8192, R, C); const int Rb = Epi::PERM ? ((R & ~31) + perm32(R & 31)) : R;
        voffA[i] = (unsigned)(R * K + C) * 2u; voffB[i] = (unsigned)(Rb * K + C) * 2u; }
    const size_t kstep = (size_t)(BK * 2);
    const size_t hstep = (size_t)HALF * K * 2;
    const size_t tstep = 2 * hstep;
    const unsigned ldsw = (unsigned)wid * 1024u;
    const int aoff = lds_byte(wr * 64 + fr, fq * 8), boff = lds_byte(wc * 32 + fr, fq * 8);
#define PG8_SA(b, h) (((b) * 2 + (h)) * HTB)
#define PG8_SB(b, h) ((4 + (b) * 2 + (h)) * HTB)
#define PG8_STAGE(bufoff, gbase, voff) do { _Pragma("unroll") for (int _i = 0; _i < 2; ++_i) \
        __builtin_amdgcn_global_load_lds((const unsigned*)((const char*)(gbase) + (voff)[_i]), (LAS unsigned*)(lds + (bufoff) + ldsw + _i * 8192), 16, 0, 0); } while (0)
#define PG8_LDA(dst, b, h) do { _Pragma("unroll") for (int m = 0; m < 4; ++m) _Pragma("unroll") for (int k = 0; k < 2; ++k) dst[m][k] = *(const LAS bf16x8*)(lds + PG8_SA(b, h) + aoff + m * 2048 + k * 1024); } while (0)
#define PG8_LDB(dst, b, h) do { _Pragma("unroll") for (int n = 0; n < 2; ++n) _Pragma("unroll") for (int k = 0; k < 2; ++k) dst[n][k] = *(const LAS bf16x8*)(lds + PG8_SB(b, h) + boff + n * 2048 + k * 1024); } while (0)
#define PG8_MMA(ai, bj, At, Bt) do { __builtin_amdgcn_s_setprio(1); _Pragma("unroll") for (int m = 0; m < 4; ++m) _Pragma("unroll") for (int n = 0; n < 2; ++n) _Pragma("unroll") for (int k = 0; k < 2; ++k) \
        acc[ai][bj][m][n] = __builtin_amdgcn_mfma_f32_16x16x32_bf16(Bt[n][k], At[m][k], acc[ai][bj][m][n], 0, 0, 0); __builtin_amdgcn_s_setprio(0); } while (0)
#define PG8_WAIT_V(n) asm volatile("s_waitcnt vmcnt(" #n ")" ::: "memory")
#define PG8_WAIT_L(n) asm volatile("s_waitcnt lgkmcnt(" #n ")" ::: "memory")
#define PG8_BAR __builtin_amdgcn_s_barrier()
#define PG8_SCHED __builtin_amdgcn_sched_barrier(0)
    Unit cur, nxt; int ui = 0;
    if (!S.next(0, cur)) return;
    f32x4 acc[2][2][4][2];
#pragma unroll
    for (int a = 0; a < 2; ++a)
#pragma unroll
        for (int b = 0; b < 2; ++b)
#pragma unroll
            for (int m = 0; m < 4; ++m)
#pragma unroll
                for (int n = 0; n < 2; ++n) acc[a][b][m][n] = (f32x4){0.f, 0.f, 0.f, 0.f};
    bf16x8 At[4][2], B0[2][2], B1[2][2];
    const char* cA = (const char*)g.A + (size_t)cur.pm * tstep; const char* cB = (const char*)g.Bt + (size_t)cur.pn * tstep;
    PG8_STAGE(PG8_SB(0, 0), cB, voffB); PG8_STAGE(PG8_SB(0, 1), cB + hstep, voffB); PG8_STAGE(PG8_SA(0, 0), cA, voffA); PG8_STAGE(PG8_SA(0, 1), cA + hstep, voffA);
    if (wr == 1) PG8_BAR;
    PG8_WAIT_V(2); PG8_BAR;
    PG8_STAGE(PG8_SB(1, 0), cB + kstep, voffB); PG8_STAGE(PG8_SA(1, 0), cA + kstep, voffA); PG8_STAGE(PG8_SB(1, 1), cB + hstep + kstep, voffB);
    PG8_WAIT_V(6); PG8_BAR;
    for (;;) {
        const bool has_next = S.next(ui + 1, nxt);
        const char* nA = has_next ? (const char*)g.A + (size_t)nxt.pm * tstep : cA; const char* nB = has_next ? (const char*)g.Bt + (size_t)nxt.pn * tstep : cB;
        for (int t = 0; t < nt; t += 2) {
            const bool last = (t == nt - 2);
            const char* a1 = cA + (size_t)(t + 1) * kstep;
            const char* a2 = last ? nA : cA + (size_t)(t + 2) * kstep; const char* b2 = last ? nB : cB + (size_t)(t + 2) * kstep;
            const char* a3 = a2 + kstep; const char* b3 = b2 + kstep;
            PG8_LDB(B0, 0, 0); PG8_LDB(B1, 0, 1); PG8_SCHED; PG8_LDA(At, 0, 0); PG8_STAGE(PG8_SA(1, 1), a1 + hstep, voffA);
            PG8_WAIT_V(8); PG8_WAIT_L(0); PG8_BAR; PG8_MMA(0, 0, At, B0); PG8_MMA(0, 1, At, B1); PG8_BAR; PG8_SCHED;
            PG8_LDA(At, 0, 1); PG8_STAGE(PG8_SB(0, 0), b2, voffB); PG8_STAGE(PG8_SB(0, 1), b2 + hstep, voffB); PG8_STAGE(PG8_SA(0, 0), a2, voffA);
            PG8_WAIT_V(8); PG8_WAIT_L(0); PG8_BAR; PG8_MMA(1, 0, At, B0); PG8_MMA(1, 1, At, B1); PG8_BAR; PG8_SCHED;
            PG8_LDB(B0, 1, 0); PG8_LDB(B1, 1, 1); PG8_SCHED; PG8_LDA(At, 1, 0); PG8_STAGE(PG8_SA(0, 1), a2 + hstep, voffA);
            PG8_WAIT_V(8); PG8_WAIT_L(0); PG8_BAR; PG8_MMA(0, 0, At, B0); PG8_MMA(0, 1, At, B1); PG8_BAR; PG8_SCHED;
            PG8_LDA(At, 1, 1); PG8_STAGE(PG8_SB(1, 0), b3, voffB); PG8_STAGE(PG8_SB(1, 1), b3 + hstep, voffB); PG8_STAGE(PG8_SA(1, 0), a3, voffA);
            PG8_WAIT_V(8); PG8_WAIT_L(0); PG8_BAR; PG8_MMA(1, 0, At, B0); PG8_MMA(1, 1, At, B1); PG8_BAR; PG8_SCHED;
        }
        if (wr == 0) PG8_BAR;
        E(acc, cur, wr, wc, fr, fq);
        if (!has_next) break;
#pragma unroll
        for (int a = 0; a < 2; ++a)
#pragma unroll
            for (int b = 0; b < 2; ++b)
#pragma unroll
                for (int m = 0; m < 4; ++m)
#pragma unroll
                    for (int n = 0; n < 2; ++n) acc[a][b][m][n] = (f32x4){0.f, 0.f, 0.f, 0.f};
        cur = nxt; cA = nA; cB = nB; ++ui;
        if (wr == 1) PG8_BAR;
    }
    PG8_WAIT_V(0);
    PG8_BAR;
#undef PG8_SA
#undef PG8_SB
#undef PG8_STAGE
#undef PG8_LDA
#undef PG8_LDB
#undef PG8_MMA
#undef PG8_WAIT_V
#undef PG8_WAIT_L
#undef PG8_BAR
#undef PG8_SCHED
}
}

typedef f32x4 AccT[2][2][4][2];

struct EpiInEven {
    static constexpr bool PERM = true;
    unsigned char* ws; float* out; const float* rstd; const float* blr_b;
    __device__ __forceinline__ void operator()(const AccT& acc, const pg8::Unit& u, int wr, int wc, int fr, int fq) const {
        const int pn = u.pn;
        bf16_t* base; int ld, coff; float sc = 1.f;
        if (pn < 4) { base = (bf16_t*)(ws + WS_Q); ld = 1024; coff = pn * 256; sc = 0.125f * 1.4426950408889634f; }
        else if (pn == 4) { base = (bf16_t*)(ws + WS_K); ld = 256; coff = 0; }
        else if (pn == 5) { base = (bf16_t*)(ws + WS_V); ld = 256; coff = 0; }
        else if (pn < 8) { base = (bf16_t*)(ws + WS_BQ); ld = 512; coff = (pn - 6) * 256; sc = 0.08838834764831845f; }
        else if (pn < 10) { base = (bf16_t*)(ws + WS_BK); ld = 512; coff = (pn - 8) * 256; }
        else if (pn < 14) { base = (bf16_t*)(ws + WS_BV); ld = 1024; coff = (pn - 10) * 256; }
        else if (pn < 22) { base = (bf16_t*)(ws + WS_GATE); ld = 2048; coff = (pn - 14) * 256; }
        else { base = (bf16_t*)(ws + WS_BLR); ld = 512; coff = (pn - 22) * 256; }
        const int row0 = u.pm * 256 + wr * 64 + fr;
        const int ct = wc * 32 + 8 * fq;
        float rsv[8];
#pragma unroll
        for (int it = 0; it < 8; ++it) rsv[it] = rstd[row0 + (it >> 2) * 128 + (it & 3) * 16];
        if (pn >= 22) {
#pragma unroll
            for (int ai = 0; ai < 2; ++ai)
#pragma unroll
                for (int m = 0; m < 4; ++m) {
                    const int row = row0 + ai * 128 + m * 16; const float rs = rsv[ai * 4 + m];
#pragma unroll
                    for (int bj = 0; bj < 2; ++bj) {
                        const int cg = coff + ct + bj * 128;
                        const f32x4 b0 = *(const f32x4*)(blr_b + cg), b1 = *(const f32x4*)(blr_b + cg + 4);
                        f32x4 x0 = acc[ai][bj][m][0] * rs + b0, x1 = acc[ai][bj][m][1] * rs + b1;
#pragma unroll
                        for (int j = 0; j < 4; ++j) { x0[j] = (fminf(x0[j], 0.f) - __logf(1.f + __expf(-fabsf(x0[j])))) * (1.f / 16.f); x1[j] = (fminf(x1[j], 0.f) - __logf(1.f + __expf(-fabsf(x1[j])))) * (1.f / 16.f); }
                        u32x4 w; w.x = cvt_pk_bf16(x0[0], x0[1]); w.y = cvt_pk_bf16(x0[2], x0[3]); w.z = cvt_pk_bf16(x1[0], x1[1]); w.w = cvt_pk_bf16(x1[2], x1[3]);
                        *(u32x4*)(base + (size_t)row * 512 + cg) = w;
                    }
                }
            return;
        }
        const bool kv = (pn == 4 || pn == 5);
        float* okv_p = out + (pn == 4 ? O_KP : O_VP); float* okv_s = out + (pn == 4 ? O_KS : O_VS);
#pragma unroll
        for (int ai = 0; ai < 2; ++ai)
#pragma unroll
            for (int m = 0; m < 4; ++m) {
                const int row = row0 + ai * 128 + m * 16; const float rs = rsv[ai * 4 + m] * sc;
                bf16_t* rowp = base + (size_t)row * ld + coff + ct;
                float* orow = nullptr;
                if (kv) {
                    if (row >= T_P) orow = okv_s + (size_t)(row - T_P) * 256;
                    else { const int b = row >> 11, t = row & 2047; if (t >= 1920) orow = okv_p + (size_t)(b * 128 + t - 1920) * 256; }
                }
#pragma unroll
                for (int bj = 0; bj < 2; ++bj) {
                    const f32x4 v0 = acc[ai][bj][m][0] * rs, v1 = acc[ai][bj][m][1] * rs;
                    u32x4 w; w.x = cvt_pk_bf16(v0[0], v0[1]); w.y = cvt_pk_bf16(v0[2], v0[3]); w.z = cvt_pk_bf16(v1[0], v1[1]); w.w = cvt_pk_bf16(v1[2], v1[3]);
                    *(u32x4*)(rowp + bj * 128) = w;
                    if (kv && orow) { *(f32x4*)(orow + bj * 128 + ct) = v0; *(f32x4*)(orow + bj * 128 + ct + 4) = v1; }
                }
            }
    }
};

template <bool WRITE_BF>
struct EpiOutRes {
    static constexpr bool PERM = false;
    const float* xin_p; const float* xin_s; float* xo; bf16_t* xb; float* rowsq;
    __device__ __forceinline__ void operator()(const AccT& acc, const pg8::Unit& u, int wr, int wc, int fr, int fq) const {
        const int row0 = u.pm * 256 + wr * 64 + fr, col0 = u.pn * 256 + wc * 32 + 4 * fq;
        f32x4 r[3][4];
#define EOR_LOAD(S, IT) do { const int row_ = row0 + ((IT) >> 2) * 128 + ((IT) & 3) * 16; \
            const float* xr_ = (row_ < T_P) ? xin_p + (size_t)row_ * 1024 : xin_s + (size_t)(row_ - T_P) * 1024; \
            r[S][0] = *(const f32x4*)(xr_ + col0); r[S][1] = *(const f32x4*)(xr_ + col0 + 16); r[S][2] = *(const f32x4*)(xr_ + col0 + 128); r[S][3] = *(const f32x4*)(xr_ + col0 + 144); } while (0)
        EOR_LOAD(0, 0); EOR_LOAD(1, 1);
#pragma unroll
        for (int it = 0; it < 8; ++it) {
            if (it + 2 < 8) { if ((it + 2) % 3 == 0) EOR_LOAD(0, it + 2); else if ((it + 2) % 3 == 1) EOR_LOAD(1, it + 2); else EOR_LOAD(2, it + 2); }
            const int ai = it >> 2, m = it & 3;
            const int row = row0 + ai * 128 + m * 16;
            float ss = 0.f;
#pragma unroll
            for (int bj = 0; bj < 2; ++bj)
#pragma unroll
                for (int n = 0; n < 2; ++n) {
                    const int col = col0 + bj * 128 + n * 16;
                    const f32x4 v = acc[ai][bj][m][n] + r[it % 3][bj * 2 + n];
                    if (!WRITE_BF) *(f32x4*)(xo + (size_t)row * 1024 + col) = v;
                    if (WRITE_BF) { u32x2 w; w.x = cvt_pk_bf16(v[0], v[1]); w.y = cvt_pk_bf16(v[2], v[3]); *(u32x2*)(xb + (size_t)row * 1024 + col) = w; }
                    ss += v[0] * v[0] + v[1] * v[1] + v[2] * v[2] + v[3] * v[3];
                }
            ss += __shfl_xor(ss, 16); ss += __shfl_xor(ss, 32);
            if (fq == 0) atomicAdd(rowsq + row, ss);
        }
#undef EOR_LOAD
    }
};

struct EpiOutResB {
    static constexpr bool PERM = false;
    bf16_t* xb; float* rowsq;
    __device__ __forceinline__ void operator()(const AccT& acc, const pg8::Unit& u, int wr, int wc, int fr, int fq) const {
        const int row0 = u.pm * 256 + wr * 64 + fr, col0 = u.pn * 256 + wc * 32 + 4 * fq;
        u32x2 r[3][4];
#define EOB_LOAD(S, IT) do { const bf16_t* xr_ = xb + (size_t)(row0 + ((IT) >> 2) * 128 + ((IT) & 3) * 16) * 1024 + col0; \
            r[S][0] = *(const u32x2*)(xr_); r[S][1] = *(const u32x2*)(xr_ + 16); r[S][2] = *(const u32x2*)(xr_ + 128); r[S][3] = *(const u32x2*)(xr_ + 144); } while (0)
        EOB_LOAD(0, 0); EOB_LOAD(1, 1);
#pragma unroll
        for (int it = 0; it < 8; ++it) {
            if (it + 2 < 8) { if ((it + 2) % 3 == 0) EOB_LOAD(0, it + 2); else if ((it + 2) % 3 == 1) EOB_LOAD(1, it + 2); else EOB_LOAD(2, it + 2); }
            const int ai = it >> 2, m = it & 3;
            const int row = row0 + ai * 128 + m * 16;
            float ss = 0.f;
#pragma unroll
            for (int bj = 0; bj < 2; ++bj)
#pragma unroll
                for (int n = 0; n < 2; ++n) {
                    const int col = col0 + bj * 128 + n * 16;
                    const u32x2 rw = r[it % 3][bj * 2 + n];
                    f32x4 v = acc[ai][bj][m][n];
                    v[0] += bflo(rw.x); v[1] += bfhi(rw.x); v[2] += bflo(rw.y); v[3] += bfhi(rw.y);
                    u32x2 w; w.x = cvt_pk_bf16(v[0], v[1]); w.y = cvt_pk_bf16(v[2], v[3]);
                    *(u32x2*)(xb + (size_t)row * 1024 + col) = w;
                    ss += v[0] * v[0] + v[1] * v[1] + v[2] * v[2] + v[3] * v[3];
                }
            ss += __shfl_xor(ss, 16); ss += __shfl_xor(ss, 32);
            if (fq == 0) atomicAdd(rowsq + row, ss);
        }
#undef EOB_LOAD
    }
};

struct EpiInOdd {
    static constexpr bool PERM = true;
    bf16_t* z2; const float* rowsq;
    __device__ __forceinline__ void operator()(const AccT& acc, const pg8::Unit& u, int wr, int wc, int fr, int fq) const {
        const int row0 = u.pm * 256 + wr * 64 + fr, col0 = u.pn * 256 + wc * 32 + 8 * fq;
        float rsv[8];
#pragma unroll
        for (int it = 0; it < 8; ++it) rsv[it] = rowsq[row0 + (it >> 2) * 128 + (it & 3) * 16];
#pragma unroll
        for (int ai = 0; ai < 2; ++ai)
#pragma unroll
            for (int m = 0; m < 4; ++m) {
                const int row = row0 + ai * 128 + m * 16; const float rs = rsqrtf(rsv[ai * 4 + m] * (1.f / 1024.f) + EPS);
#pragma unroll
                for (int bj = 0; bj < 2; ++bj) {
                    const f32x4 v0 = acc[ai][bj][m][0] * rs, v1 = acc[ai][bj][m][1] * rs;
                    u32x4 w; w.x = cvt_pk_bf16(v0[0], v0[1]); w.y = cvt_pk_bf16(v0[2], v0[3]); w.z = cvt_pk_bf16(v1[0], v1[1]); w.w = cvt_pk_bf16(v1[2], v1[3]);
                    *(u32x4*)(z2 + (size_t)row * 3072 + col0 + bj * 128) = w;
                }
            }
    }
};

template <int MODE>
__device__ __forceinline__ void transpose_w(const float* __restrict__ src, int K, int Nsrc, bf16_t* __restrict__ dst, int Ndst, const float* __restrict__ gain, long gtid, long gsz) {
    const long total = (long)(K / 8) * Ndst;
#pragma unroll 4
    for (long it = gtid; it < total; it += gsz) {
        const int n = (int)(it % Ndst), k8 = (int)(it / Ndst);
        int sc = n;
        if (MODE == 1) { if (n < 3584) sc = n; else sc = n + 16; }
        u32x4 w = {0u, 0u, 0u, 0u};
        if (sc >= 0) {
            const float* s = src + (size_t)(k8 * 8) * Nsrc + sc;
            float v0 = s[0], v1 = s[(size_t)Nsrc], v2 = s[(size_t)2 * Nsrc], v3 = s[(size_t)3 * Nsrc], v4 = s[(size_t)4 * Nsrc], v5 = s[(size_t)5 * Nsrc], v6 = s[(size_t)6 * Nsrc], v7 = s[(size_t)7 * Nsrc];
            if (gain) { const f32x4 g0 = *(const f32x4*)(gain + k8 * 8), g1 = *(const f32x4*)(gain + k8 * 8 + 4); v0 *= g0[0]; v1 *= g0[1]; v2 *= g0[2]; v3 *= g0[3]; v4 *= g1[0]; v5 *= g1[1]; v6 *= g1[2]; v7 *= g1[3]; }
            w.x = cvt_pk_bf16(v0, v1); w.y = cvt_pk_bf16(v2, v3); w.z = cvt_pk_bf16(v4, v5); w.w = cvt_pk_bf16(v6, v7);
        }
        *(u32x4*)(dst + (size_t)n * K + k8 * 8) = w;
    }
}

__device__ __forceinline__ void phase0(const Params& p) {
    unsigned char* ws = p.ws;
    const long gtid = (long)blockIdx.x * NTHR + threadIdx.x, gsz = (long)gridDim.x * NTHR;
    transpose_w<1>(p.in[8], 1024, 5648, (bf16_t*)(ws + WS_WINE), 5632, p.in[7], gtid, gsz);
    for (long it = gtid; it < 128L * 512; it += gsz) {
        const int n = (int)(it & 511), k8 = (int)(it >> 9);
        float wl[16];
#pragma unroll
        for (int r = 0; r < 16; ++r) wl[r] = p.in[9][r * 512 + n];
        float v[8];
#pragma unroll
        for (int i = 0; i < 8; ++i) {
            const float* wr_ = p.in[8] + (size_t)(k8 * 8 + i) * 5648 + 3584;
            float a = 0.f;
#pragma unroll
            for (int r4 = 0; r4 < 4; ++r4) { const f32x4 x = *(const f32x4*)(wr_ + r4 * 4); a += x[0] * wl[r4 * 4] + x[1] * wl[r4 * 4 + 1] + x[2] * wl[r4 * 4 + 2] + x[3] * wl[r4 * 4 + 3]; }
            v[i] = a * p.in[7][k8 * 8 + i];
        }
        u32x4 w; w.x = cvt_pk_bf16(v[0], v[1]); w.y = cvt_pk_bf16(v[2], v[3]); w.z = cvt_pk_bf16(v[4], v[5]); w.w = cvt_pk_bf16(v[6], v[7]);
        *(u32x4*)((bf16_t*)(ws + WS_WINE) + (size_t)(5632 + n) * 1024 + k8 * 8) = w;
    }
    transpose_w<0>(p.in[13], 2048, 1024, (bf16_t*)(ws + WS_WOUTE), 1024, nullptr, gtid, gsz);
    transpose_w<0>(p.in[15], 1024, 3072, (bf16_t*)(ws + WS_WINO), 3072, p.in[14], gtid, gsz);
    transpose_w<0>(p.in[23], 1536, 1024, (bf16_t*)(ws + WS_WOUTO), 1024, nullptr, gtid, gsz);
    for (int nb = 0; nb < 8; ++nb) {
        transpose_w<0>(p.in[18] + nb * 192 * 192, 192, 192, (bf16_t*)(ws + WS_WA) + nb * 192 * 192, 192, nullptr, gtid, gsz);
        transpose_w<0>(p.in[20] + nb * 192 * 192, 192, 192, (bf16_t*)(ws + WS_WI) + nb * 192 * 192, 192, nullptr, gtid, gsz);
    }
    { float* z = (float*)(ws + WS_RSQ1); const long nz = (long)T * 2; for (long i = gtid; i < nz; i += gsz) z[i] = 0.f; }
    const int lane = threadIdx.x & 63; const int gw = (int)(gtid >> 6), nw = (int)(gsz >> 6);
    bf16_t* xb = (bf16_t*)(ws + WS_XB); float* rstd = (float*)(ws + WS_RSTD0);
#pragma unroll 4
    for (int row = gw; row < T; row += nw) {
        const float* xr = (row < T_P) ? p.in[0] + (size_t)row * 1024 : p.in[1] + (size_t)(row - T_P) * 1024;
        float ss = 0.f;
#pragma unroll
        for (int i = 0; i < 4; ++i) {
            const f32x4 v = *(const f32x4*)(xr + i * 256 + lane * 4);
            ss += v[0] * v[0] + v[1] * v[1] + v[2] * v[2] + v[3] * v[3];
            u32x2 w; w.x = cvt_pk_bf16(v[0], v[1]); w.y = cvt_pk_bf16(v[2], v[3]);
            *(u32x2*)(xb + (size_t)row * 1024 + i * 256 + lane * 4) = w;
        }
#pragma unroll
        for (int o = 32; o >= 1; o >>= 1) ss += __shfl_xor(ss, o);
        if (lane == 0) rstd[row] = rsqrtf(ss * (1.f / 1024.f) + EPS);
    }
}

__device__ __forceinline__ void attn_item(const Params& p, LAS unsigned char* L, int item, bf16_t* Yd, int ldd) {
    unsigned char* ws = p.ws;
    const int tid = threadIdx.x, lane = tid & 63, w = tid >> 6, r16 = lane & 15, q4 = lane >> 4;
    LAS bf16_t* Ks = (LAS bf16_t*)L;
    LAS bf16_t* Vs = (LAS bf16_t*)(L + 192 * 72 * 2);
    const unsigned vbase = (unsigned)(size_t)L + 192u * 72u * 2u;
    const bf16_t* Qb = (const bf16_t*)(ws + WS_Q); const bf16_t* Kb = (const bf16_t*)(ws + WS_K); const bf16_t* Vb = (const bf16_t*)(ws + WS_V);
    const bf16_t* Yb = (const bf16_t*)(ws + WS_GATE);
    const bool smp = item >= 2048;
    int b, c, kh; size_t row0;
    if (!smp) { kh = item & 3; c = (item >> 2) & 31; b = item >> 7; row0 = (size_t)b * 2048 + c * 64; }
    else { const int i2 = item - 2048; kh = i2 & 3; b = i2 >> 2; c = 0; row0 = (size_t)T_P + b * 64; }
    const int g = w >> 1, i0 = (w & 1) * 32, h = kh * 4 + g;
    bf16x8 qf[2][2];
#pragma unroll
    for (int qt = 0; qt < 2; ++qt) {
#pragma unroll
        for (int ks = 0; ks < 2; ++ks) qf[qt][ks] = *(const bf16x8*)(Qb + (row0 + i0 + qt * 16 + r16) * 1024 + h * 64 + ks * 32 + q4 * 8);
    }
#pragma unroll
    for (int i = 0; i < 3; ++i) {
        const int idx = tid + i * 512, key = idx >> 3, dg = idx & 7;
        u32x4 kv = {0u, 0u, 0u, 0u}, vv = {0u, 0u, 0u, 0u};
        if (!smp) {
            const int pos = c * 64 - 128 + key;
            if (pos >= 0) { const size_t r = (size_t)b * 2048 + pos; kv = *(const u32x4*)(Kb + r * 256 + kh * 64 + dg * 8); vv = *(const u32x4*)(Vb + r * 256 + kh * 64 + dg * 8); }
        } else {
            if (key < 128) {
                const size_t o = ((size_t)(b * 128 + key) * 4 + kh) * 64 + dg * 8;
                const f32x4 k0 = *(const f32x4*)(p.in[2] + o), k1 = *(const f32x4*)(p.in[2] + o + 4), v0 = *(const f32x4*)(p.in[3] + o), v1 = *(const f32x4*)(p.in[3] + o + 4);
                kv.x = cvt_pk_bf16(k0[0], k0[1]); kv.y = cvt_pk_bf16(k0[2], k0[3]); kv.z = cvt_pk_bf16(k1[0], k1[1]); kv.w = cvt_pk_bf16(k1[2], k1[3]);
                vv.x = cvt_pk_bf16(v0[0], v0[1]); vv.y = cvt_pk_bf16(v0[2], v0[3]); vv.z = cvt_pk_bf16(v1[0], v1[1]); vv.w = cvt_pk_bf16(v1[2], v1[3]);
            } else { const size_t r = (size_t)T_P + b * 64 + key - 128; kv = *(const u32x4*)(Kb + r * 256 + kh * 64 + dg * 8); vv = *(const u32x4*)(Vb + r * 256 + kh * 64 + dg * 8); }
        }
        *(LAS u32x4*)(Ks + key * 72 + dg * 8) = kv;
        *(LAS u32x4*)(Vs + key * 72 + dg * 8) = vv;
    }
    __syncthreads();
    const float slope = exp2f(-0.5f * (float)(h + 1)) * 1.4426950408889634f;
    const float sink = p.in[11][h] * 1.4426950408889634f;
    const unsigned va = vbase + (unsigned)(((q4 * 4 + (r16 >> 2)) * 72 + 4 * (r16 & 3)) * 2);
#pragma unroll 1
    for (int qt = 0; qt < 2; ++qt) {
        const int i = i0 + qt * 16 + r16;
        const bf16x8 qa = qt ? qf[1][0] : qf[0][0], qb = qt ? qf[1][1] : qf[0][1];
        u32x2 gv[4];
#pragma unroll
        for (int dt = 0; dt < 4; ++dt) gv[dt] = *(const u32x2*)(Yb + (row0 + i) * 2048 + h * 64 + dt * 16 + q4 * 4);
        f32x4 sacc[12];
#pragma unroll
        for (int kt = 0; kt < 12; ++kt) {
            const bf16x8 kf0 = *(const LAS bf16x8*)(Ks + (kt * 16 + r16) * 72 + q4 * 8), kf1 = *(const LAS bf16x8*)(Ks + (kt * 16 + r16) * 72 + 32 + q4 * 8);
            f32x4 a = {0.f, 0.f, 0.f, 0.f}; a = MFMA16(kf0, qa, a); a = MFMA16(kf1, qb, a); sacc[kt] = a;
        }
        const float dbase = (float)(128 + i - q4 * 4);
#pragma unroll
        for (int kt = 0; kt < 12; ++kt)
#pragma unroll
            for (int jj = 0; jj < 4; ++jj) sacc[kt][jj] = fmaf(-slope, fabsf(dbase - (float)(kt * 16 + jj)), sacc[kt][jj]);
        if (!smp && c < 2) {
#pragma unroll
            for (int kt = 0; kt < 8; ++kt)
#pragma unroll
                for (int jj = 0; jj < 4; ++jj) { const int j = kt * 16 + q4 * 4 + jj; if ((c * 64 - 128 + j) < 0) sacc[kt][jj] = -1e30f; }
        }
        float m = -3e38f;
#pragma unroll
        for (int kt = 0; kt < 12; ++kt)
#pragma unroll
            for (int jj = 0; jj < 4; ++jj) m = fmaxf(m, sacc[kt][jj]);
        m = fmaxf(m, __shfl_xor(m, 16)); m = fmaxf(m, __shfl_xor(m, 32)); m = fmaxf(m, sink);
        float l = 0.f;
#pragma unroll
        for (int kt = 0; kt < 12; ++kt)
#pragma unroll
            for (int jj = 0; jj < 4; ++jj) { const float pr = __builtin_amdgcn_exp2f(sacc[kt][jj] - m); sacc[kt][jj] = pr; l += pr; }
        l += __shfl_xor(l, 16); l += __shfl_xor(l, 32); l += __builtin_amdgcn_exp2f(sink - m);
        const float inv = 1.f / l;
        f32x4 oacc[4];
#pragma unroll
        for (int dt = 0; dt < 4; ++dt) oacc[dt] = (f32x4){0.f, 0.f, 0.f, 0.f};
#pragma unroll
        for (int kb = 0; kb < 6; ++kb) {
            const bf16x8 pf = pack8(sacc[2 * kb], sacc[2 * kb + 1]);
            bf16x4 l0, h0, l1, h1, l2, h2, l3, h3;
            const unsigned vk = va + (unsigned)(kb * 32 * 144);
            asm volatile("ds_read_b64_tr_b16 %0, %8\n\tds_read_b64_tr_b16 %1, %8 offset:2304\n\t"
                         "ds_read_b64_tr_b16 %2, %8 offset:32\n\tds_read_b64_tr_b16 %3, %8 offset:2336\n\t"
                         "ds_read_b64_tr_b16 %4, %8 offset:64\n\tds_read_b64_tr_b16 %5, %8 offset:2368\n\t"
                         "ds_read_b64_tr_b16 %6, %8 offset:96\n\tds_read_b64_tr_b16 %7, %8 offset:2400\n\t"
                         "s_waitcnt lgkmcnt(0)"
                         : "=&v"(l0), "=&v"(h0), "=&v"(l1), "=&v"(h1), "=&v"(l2), "=&v"(h2), "=&v"(l3), "=&v"(h3) : "v"(vk) : "memory");
            oacc[0] = MFMA16(cat4(l0, h0), pf, oacc[0]); oacc[1] = MFMA16(cat4(l1, h1), pf, oacc[1]);
            oacc[2] = MFMA16(cat4(l2, h2), pf, oacc[2]); oacc[3] = MFMA16(cat4(l3, h3), pf, oacc[3]);
        }
#pragma unroll
        for (int dt = 0; dt < 4; ++dt) {
            const u32x2 gq = gv[dt];
            const f32x4 o = oacc[dt] * inv;
            u32x2 wv; wv.x = cvt_pk_bf16(o[0] * siluf(bflo(gq.x)), o[1] * siluf(bfhi(gq.x))); wv.y = cvt_pk_bf16(o[2] * siluf(bflo(gq.y)), o[3] * siluf(bfhi(gq.y)));
            *(u32x2*)(Yd + (row0 + i) * ldd + h * 64 + dt * 16 + q4 * 4) = wv;
        }
    }
    __syncthreads();
}

constexpr size_t SC_SQ = 0;
constexpr size_t SC_ET = 9437184;
constexpr size_t SC_AB = 16777216;
static_assert(SC_AB + (size_t)T * 256 * 2 <= (size_t)T * 1024 * 4, "scratch must fit in the y region of d_out");

struct PrepRegs { u32x4 g0, g1, q0, q1, k0, k1; };
__device__ __forceinline__ unsigned prep_row0(int item, int& h) {
    if (item < 2048) { h = item & 3; const int c = (item >> 2) & 31; const int b = item >> 7; return (unsigned)b * 2048 + c * 64; }
    const int i2 = item - 2048; h = i2 & 3; return (unsigned)T_P + (i2 >> 2) * 64;
}
__device__ __forceinline__ void prep_load(const Params& p, int item, PrepRegs& R) {
    const int tid = threadIdx.x; int h; const unsigned row0 = prep_row0(item, h);
    const bf16_t* BQ = (const bf16_t*)(p.ws + WS_BQ); const bf16_t* BKb = (const bf16_t*)(p.ws + WS_BK); const bf16_t* GB = (const bf16_t*)(p.ws + WS_BLR);
    const int pt0 = tid >> 4, pt1 = (tid + 512) >> 4, poc = tid & 15;
    const unsigned o0 = (row0 + pt0) * 512u + h * 128 + poc * 8, o1 = (row0 + pt1) * 512u + h * 128 + poc * 8;
    R.g0 = *(const u32x4*)(GB + o0); R.g1 = *(const u32x4*)(GB + o1);
    R.q0 = *(const u32x4*)(BQ + o0); R.q1 = *(const u32x4*)(BQ + o1); R.k0 = *(const u32x4*)(BKb + o0); R.k1 = *(const u32x4*)(BKb + o1);
}
__device__ __forceinline__ void gla_prep_item(const Params& p, LAS unsigned char* L, int item, const PrepRegs& cur, int next_item, PrepRegs& nxt) {
    unsigned char* ws = p.ws;
    const int tid = threadIdx.x, lane = tid & 63, w = tid >> 6, r16 = lane & 15, q4 = lane >> 4;
    LAS bf16_t* QG = (LAS bf16_t*)L;
    LAS bf16_t* KG = (LAS bf16_t*)(L + 17408);
    LAS bf16_t* Gs = (LAS bf16_t*)(L + 34816);
    LAS float* Gf = (LAS float*)(L + 52224);
    LAS float* GT = (LAS float*)(L + 84992);
    int h; const unsigned row0 = prep_row0(item, h);
    bf16_t* BQ = (bf16_t*)(ws + WS_BQ); bf16_t* BKb = (bf16_t*)(ws + WS_BK);
    float* ET = (float*)((unsigned char*)p.out + SC_ET); bf16_t* AB = (bf16_t*)((unsigned char*)p.out + SC_AB);
    const int c = tid & 127, tg = tid >> 7;
    const int pt0 = tid >> 4, pt1 = (tid + 512) >> 4, poc = tid & 15;
    const unsigned o0 = (row0 + pt0) * 512u + h * 128 + poc * 8, o1 = (row0 + pt1) * 512u + h * 128 + poc * 8;
    const u32x4 pq0 = cur.q0, pq1 = cur.q1, pk0 = cur.k0, pk1 = cur.k1;
    *(LAS u32x4*)(Gs + pt0 * 136 + poc * 8) = cur.g0; *(LAS u32x4*)(Gs + pt1 * 136 + poc * 8) = cur.g1;
    lds_barrier();
    if (next_item >= 0) prep_load(p, next_item, nxt);
    {
        float cs = 0.f;
#pragma unroll
        for (int tt = 0; tt < 16; ++tt) { cs += bf2f(Gs[(tg * 16 + tt) * 136 + c]); Gf[(tg * 16 + tt) * 128 + c] = cs; }
        GT[tg * 128 + c] = cs;
    }
    lds_barrier();
#pragma unroll
    for (int i = 0; i < 2; ++i) {
        const int t = i ? pt1 : pt0; const int tgp = t >> 4;
        const u32x4 qw = i ? pq1 : pq0, kw = i ? pk1 : pk0;
        float G[8], tot[8];
        { const f32x4 a0 = *(const LAS f32x4*)(Gf + t * 128 + poc * 8), a1 = *(const LAS f32x4*)(Gf + t * 128 + poc * 8 + 4);
          G[0] = a0[0]; G[1] = a0[1]; G[2] = a0[2]; G[3] = a0[3]; G[4] = a1[0]; G[5] = a1[1]; G[6] = a1[2]; G[7] = a1[3]; }
#pragma unroll
        for (int j = 0; j < 8; ++j) tot[j] = 0.f;
#pragma unroll
        for (int g2 = 0; g2 < 4; ++g2) {
            const f32x4 a0 = *(const LAS f32x4*)(GT + g2 * 128 + poc * 8), a1 = *(const LAS f32x4*)(GT + g2 * 128 + poc * 8 + 4);
            const float sel = (g2 < tgp) ? 1.f : 0.f;
            G[0] += sel * a0[0]; G[1] += sel * a0[1]; G[2] += sel * a0[2]; G[3] += sel * a0[3]; G[4] += sel * a1[0]; G[5] += sel * a1[1]; G[6] += sel * a1[2]; G[7] += sel * a1[3];
            tot[0] += a0[0]; tot[1] += a0[1]; tot[2] += a0[2]; tot[3] += a0[3]; tot[4] += a1[0]; tot[5] += a1[1]; tot[6] += a1[2]; tot[7] += a1[3];
        }
        if (i == 0 && tid < 16) {
            float* ep = ET + (size_t)(row0 >> 6) * 512 + h * 128 + poc * 8;
            *(f32x4*)ep = (f32x4){__expf(tot[0]), __expf(tot[1]), __expf(tot[2]), __expf(tot[3])};
            *(f32x4*)(ep + 4) = (f32x4){__expf(tot[4]), __expf(tot[5]), __expf(tot[6]), __expf(tot[7])};
        }
        float qv[8], kv[8];
        unpack8(qw, qv); unpack8(kw, kv);
#pragma unroll
        for (int j = 0; j < 8; ++j) { const float eg = __expf(G[j]); qv[j] *= eg; kv[j] *= rcpf_(eg); }
        u32x4 qo, ko;
        qo.x = cvt_pk_bf16(qv[0], qv[1]); qo.y = cvt_pk_bf16(qv[2], qv[3]); qo.z = cvt_pk_bf16(qv[4], qv[5]); qo.w = cvt_pk_bf16(qv[6], qv[7]);
        ko.x = cvt_pk_bf16(kv[0], kv[1]); ko.y = cvt_pk_bf16(kv[2], kv[3]); ko.z = cvt_pk_bf16(kv[4], kv[5]); ko.w = cvt_pk_bf16(kv[6], kv[7]);
        *(LAS u32x4*)(QG + t * 136 + poc * 8) = qo; *(LAS u32x4*)(KG + t * 136 + poc * 8) = ko;
        *(u32x4*)(BQ + (i ? o1 : o0)) = qo; *(u32x4*)(BKb + (i ? o1 : o0)) = ko;
    }
    lds_barrier();
    {
        const int it = w >> 1, jt0 = (w & 1) * 2;
        f32x4 at[2];
        at[0] = (f32x4){0.f, 0.f, 0.f, 0.f}; at[1] = (f32x4){0.f, 0.f, 0.f, 0.f};
#pragma unroll
        for (int ks = 0; ks < 4; ++ks) {
            const bf16x8 qf = *(const LAS bf16x8*)(QG + (it * 16 + r16) * 136 + ks * 32 + q4 * 8);
#pragma unroll
            for (int t2 = 0; t2 < 2; ++t2) {
                const bf16x8 kf = *(const LAS bf16x8*)(KG + ((jt0 + t2) * 16 + r16) * 136 + ks * 32 + q4 * 8);
                at[t2] = MFMA16(kf, qf, at[t2]);
            }
        }
        const int i = it * 16 + r16;
#pragma unroll
        for (int t2 = 0; t2 < 2; ++t2) {
            f32x4 v = at[t2];
#pragma unroll
            for (int jj = 0; jj < 4; ++jj) { const int j = (jt0 + t2) * 16 + q4 * 4 + jj; if (j > i) v[jj] = 0.f; }
            u32x2 wv; wv.x = cvt_pk_bf16(v[0], v[1]); wv.y = cvt_pk_bf16(v[2], v[3]);
            *(u32x2*)(AB + (size_t)(row0 + i) * 256 + h * 64 + (jt0 + t2) * 16 + q4 * 4) = wv;
        }
    }
    lds_barrier();
}

__device__ __forceinline__ void gla_scan_item(const Params& p, LAS unsigned char* L, int item, bool dummy) {
    unsigned char* ws = p.ws;
    const int tid = threadIdx.x, lane = tid & 63, w = tid >> 6, r16 = lane & 15, q4 = lane >> 4;
    LAS bf16_t* QG = (LAS bf16_t*)L;
    LAS bf16_t* KG = (LAS bf16_t*)(L + 17408);
    LAS bf16_t* Vs = (LAS bf16_t*)(L + 34816);
    LAS bf16_t* As = (LAS bf16_t*)(L + 44032);
    LAS float* GL = (LAS float*)(L + 53248);
    const unsigned lbase = (unsigned)(size_t)L;
    const bool smp = item >= 256;
    const int i2 = smp ? item - 256 : item;
    const int b = i2 >> 4, h = (i2 >> 2) & 3, sl = i2 & 3, e0 = sl * 64;
    const int nch = smp ? 1 : 32;
    const unsigned rbase = smp ? (unsigned)T_P + b * 64 : (unsigned)b * 2048;
    const bf16_t* BQ = (const bf16_t*)(ws + WS_BQ); const bf16_t* BKb = (const bf16_t*)(ws + WS_BK); bf16_t* BV = (bf16_t*)(ws + WS_BV);
    const float* ET = (const float*)((unsigned char*)p.out + SC_ET); const bf16_t* AB = (const bf16_t*)((unsigned char*)p.out + SC_AB); float* BOSQP = dummy ? p.out + 20000000 : (float*)((unsigned char*)p.out + SC_SQ);
    bf16_t* BVo = dummy ? (bf16_t*)((unsigned char*)p.out + 67108864) : BV;
    const int pt0 = tid >> 4, pt1 = (tid + 512) >> 4, poc = tid & 15;
    const int vt = tid >> 3, veo = tid & 7;
    const int et = w & 3, ip = w >> 2;
    f32x4 Sacc[8];
#pragma unroll
    for (int d8 = 0; d8 < 8; ++d8) {
        if (smp) {
#pragma unroll
            for (int jj = 0; jj < 4; ++jj) Sacc[d8][jj] = p.in[4][((size_t)(b * 4 + h) * 128 + d8 * 16 + q4 * 4 + jj) * 256 + e0 + et * 16 + r16];
        } else Sacc[d8] = (f32x4){0.f, 0.f, 0.f, 0.f};
    }
    const int tq_ = r16 >> 2, tp_ = r16 & 3;
    const unsigned v4a = lbase + 34816u + (unsigned)(((q4 * 8 + tq_) * 72 + et * 16 + 4 * tp_) * 2);
    const unsigned k4a = lbase + 17408u + (unsigned)(((q4 * 8 + tq_) * 136 + 4 * tp_) * 2);
    struct Pre { u32x4 q0, q1, k0, k1, a, v; f32x4 e; };
    Pre PA, PB;
    PA.e = (f32x4){0.f, 0.f, 0.f, 0.f}; PB.e = (f32x4){0.f, 0.f, 0.f, 0.f};
#define GLA_PREFETCH(P, R) do { \
        const unsigned o0_ = ((R) + pt0) * 512u + h * 128 + poc * 8, o1_ = ((R) + pt1) * 512u + h * 128 + poc * 8; \
        P.q0 = *(const u32x4*)(BQ + o0_); P.q1 = *(const u32x4*)(BQ + o1_); P.k0 = *(const u32x4*)(BKb + o0_); P.k1 = *(const u32x4*)(BKb + o1_); \
        P.a = *(const u32x4*)(AB + ((R) + vt) * 256u + h * 64 + veo * 8); \
        P.v = *(const u32x4*)(BV + ((R) + vt) * 1024u + h * 256 + e0 + veo * 8); \
        if (tid < 32) P.e = *(const f32x4*)(ET + ((R) >> 6) * 512u + h * 128 + tid * 4); } while (0)
    GLA_PREFETCH(PA, rbase);
    if (nch > 1) GLA_PREFETCH(PB, rbase + 64);
    f32x4 po0 = {0.f, 0.f, 0.f, 0.f}, po1 = {0.f, 0.f, 0.f, 0.f}; unsigned prow = 0; bool pend = false;
#define GLA_STORE_OUT() do { \
            _Pragma("unroll") for (int x2 = 0; x2 < 2; ++x2) { \
                const unsigned row = prow + (ip * 2 + x2) * 16 + r16; \
                const f32x4 o = x2 ? po1 : po0; \
                u32x2 wv; wv.x = cvt_pk_bf16(o[0], o[1]); wv.y = cvt_pk_bf16(o[2], o[3]); \
                *(u32x2*)(BVo + row * 1024u + h * 256 + e0 + et * 16 + q4 * 4) = wv; \
                float ss = o[0] * o[0] + o[1] * o[1] + o[2] * o[2] + o[3] * o[3]; \
                ss += __shfl_xor(ss, 16); ss += __shfl_xor(ss, 32); \
                if (q4 == 0) BOSQP[row * 64u + h * 16 + sl * 4 + et] = ss; \
            } } while (0)
#define GLA_CHUNK(P, CI) do { \
        const unsigned r0 = rbase + (unsigned)(CI) * 64; \
        *(LAS u32x4*)(QG + pt0 * 136 + poc * 8) = P.q0; *(LAS u32x4*)(QG + pt1 * 136 + poc * 8) = P.q1; \
        *(LAS u32x4*)(KG + pt0 * 136 + poc * 8) = P.k0; *(LAS u32x4*)(KG + pt1 * 136 + poc * 8) = P.k1; \
        *(LAS u32x4*)(As + vt * 72 + veo * 8) = P.a; *(LAS u32x4*)(Vs + vt * 72 + veo * 8) = P.v; \
        if (tid < 32) *(LAS f32x4*)(GL + tid * 4) = P.e; \
        lds_barrier(); \
        if (pend) GLA_STORE_OUT(); \
        if ((CI) + 2 < nch) GLA_PREFETCH(P, r0 + 128); \
        bf16x8 vf[2]; \
        { bf16x4 a0, a1, b0, b1; \
          asm volatile("ds_read_b64_tr_b16 %0, %4\n\tds_read_b64_tr_b16 %1, %4 offset:576\n\tds_read_b64_tr_b16 %2, %4 offset:4608\n\tds_read_b64_tr_b16 %3, %4 offset:5184\n\ts_waitcnt lgkmcnt(0)" \
                       : "=&v"(a0), "=&v"(a1), "=&v"(b0), "=&v"(b1) : "v"(v4a) : "memory"); \
          vf[0] = cat4(a0, a1); vf[1] = cat4(b0, b1); } \
        f32x4 ot[2]; \
        ot[0] = (f32x4){0.f, 0.f, 0.f, 0.f}; ot[1] = (f32x4){0.f, 0.f, 0.f, 0.f}; \
        _Pragma("unroll") for (int x2 = 0; x2 < 2; ++x2) \
            _Pragma("unroll") for (int jb = 0; jb < 2; ++jb) { \
                const bf16x8 af = *(const LAS bf16x8*)(As + ((ip * 2 + x2) * 16 + r16) * 72 + jb * 32 + q4 * 8); \
                ot[x2] = MFMA16(vf[jb], af, ot[x2]); } \
        _Pragma("unroll") for (int db = 0; db < 4; ++db) { \
            const bf16x8 sf = pack8(Sacc[2 * db], Sacc[2 * db + 1]); \
            _Pragma("unroll") for (int x2 = 0; x2 < 2; ++x2) { \
                const LAS bf16_t* qp = QG + ((ip * 2 + x2) * 16 + r16) * 136 + db * 32 + q4 * 4; \
                const bf16x8 qv = cat4(*(const LAS bf16x4*)qp, *(const LAS bf16x4*)(qp + 16)); \
                ot[x2] = MFMA16(sf, qv, ot[x2]); } } \
        po0 = ot[0]; po1 = ot[1]; prow = r0; pend = true; \
        _Pragma("unroll") for (int jb = 0; jb < 2; ++jb) { \
            bf16x4 kl[8], kh[8]; \
            const unsigned ka = k4a + (unsigned)(jb * 32 * 272); \
            asm volatile("ds_read_b64_tr_b16 %0, %16 offset:0\n\t" "ds_read_b64_tr_b16 %1, %16 offset:1088\n\t" "ds_read_b64_tr_b16 %2, %16 offset:32\n\t" "ds_read_b64_tr_b16 %3, %16 offset:1120\n\t" "ds_read_b64_tr_b16 %4, %16 offset:64\n\t" "ds_read_b64_tr_b16 %5, %16 offset:1152\n\t" "ds_read_b64_tr_b16 %6, %16 offset:96\n\t" "ds_read_b64_tr_b16 %7, %16 offset:1184\n\t" "ds_read_b64_tr_b16 %8, %16 offset:128\n\t" "ds_read_b64_tr_b16 %9, %16 offset:1216\n\t" "ds_read_b64_tr_b16 %10, %16 offset:160\n\t" "ds_read_b64_tr_b16 %11, %16 offset:1248\n\t" "ds_read_b64_tr_b16 %12, %16 offset:192\n\t" "ds_read_b64_tr_b16 %13, %16 offset:1280\n\t" "ds_read_b64_tr_b16 %14, %16 offset:224\n\t" "ds_read_b64_tr_b16 %15, %16 offset:1312\n\t" "s_waitcnt lgkmcnt(0)" \
                         : "=&v"(kl[0]), "=&v"(kh[0]), "=&v"(kl[1]), "=&v"(kh[1]), "=&v"(kl[2]), "=&v"(kh[2]), "=&v"(kl[3]), "=&v"(kh[3]), "=&v"(kl[4]), "=&v"(kh[4]), "=&v"(kl[5]), "=&v"(kh[5]), "=&v"(kl[6]), "=&v"(kh[6]), "=&v"(kl[7]), "=&v"(kh[7]) : "v"(ka) : "memory"); \
            _Pragma("unroll") for (int d8 = 0; d8 < 8; ++d8) Sacc[d8] = MFMA16(cat4(kl[d8], kh[d8]), vf[jb], Sacc[d8]); } \
        _Pragma("unroll") for (int d8 = 0; d8 < 8; ++d8) { \
            const f32x4 dec = *(const LAS f32x4*)(GL + d8 * 16 + q4 * 4); \
            Sacc[d8] = Sacc[d8] * dec; } \
        lds_barrier(); \
    } while (0)
    for (int ci = 0; ci < nch; ci += 2) {
        GLA_CHUNK(PA, ci);
        if (ci + 1 < nch) GLA_CHUNK(PB, ci + 1);
    }
    if (pend) GLA_STORE_OUT();
#undef GLA_STORE_OUT
#undef GLA_PREFETCH
#undef GLA_CHUNK
    if (ip == 0 && !dummy) {
        float* og = p.out + (smp ? O_GS : O_GP);
#pragma unroll
        for (int d8 = 0; d8 < 8; ++d8)
#pragma unroll
            for (int jj = 0; jj < 4; ++jj) og[((size_t)(b * 4 + h) * 128 + d8 * 16 + q4 * 4 + jj) * 256 + e0 + et * 16 + r16] = Sacc[d8][jj];
    }
}

__device__ __forceinline__ void phase2a(const Params& p, LAS unsigned char* L) {
#ifndef NO_PREP
    {
        PrepRegs RA, RB; const int G = gridDim.x; int it = blockIdx.x;
        if (it < 2176) prep_load(p, it, RA);
        while (it < 2176) {
            int nx = it + G; gla_prep_item(p, L, it, RA, nx < 2176 ? nx : -1, RB); it = nx;
            if (it >= 2176) break;
            nx = it + G; gla_prep_item(p, L, it, RB, nx < 2176 ? nx : -1, RA); it = nx;
        }
    }
#endif
#ifndef NO_ATTN
    for (int it = gridDim.x - 1 - blockIdx.x; it < 2176; it += gridDim.x) attn_item(p, L, it, (bf16_t*)(p.ws + WS_GATE), 2048);
#endif
}
__device__ __forceinline__ void phase2b(const Params& p, LAS unsigned char* L) {
#ifndef NO_SCAN
#ifdef PROBE_SCAN2
    for (int it = blockIdx.x; it < 768; it += gridDim.x) gla_scan_item(p, L, it, true);
#endif
    if (gridDim.x == 256) {
        const int xcd = blockIdx.x & 7, loc = blockIdx.x >> 3;
        const int base = (xcd * 8 + (loc >> 2)) * 4 + (loc & 3);
        gla_scan_item(p, L, base, false); gla_scan_item(p, L, 256 + base, false); gla_scan_item(p, L, 512 + base, false);
    } else {
        for (int it = blockIdx.x; it < 768; it += gridDim.x) gla_scan_item(p, L, it, false);
    }
#endif
}

__device__ __forceinline__ void phase3(const Params& p) {
    unsigned char* ws = p.ws;
    const bf16_t* BV = (const bf16_t*)(ws + WS_BV); bf16_t* Yb = (bf16_t*)(ws + WS_GATE); const float* BOSQP = (const float*)((unsigned char*)p.out + SC_SQ);
    const float* gg = p.in[12];
    const long gtid = (long)blockIdx.x * NTHR + threadIdx.x, gsz = (long)gridDim.x * NTHR;
    const long total = (long)T * 128;
    for (long it = gtid; it < total; it += gsz) {
        const long row = it >> 7; const int c8 = (int)(it & 127) * 8, h = c8 >> 8;
        float sq;
        { const f32x4 s0 = *(const f32x4*)(BOSQP + row * 64 + h * 16), s1 = *(const f32x4*)(BOSQP + row * 64 + h * 16 + 4), s2 = *(const f32x4*)(BOSQP + row * 64 + h * 16 + 8), s3 = *(const f32x4*)(BOSQP + row * 64 + h * 16 + 12);
          sq = ((s0[0] + s0[1]) + (s0[2] + s0[3])) + ((s1[0] + s1[1]) + (s1[2] + s1[3])) + ((s2[0] + s2[1]) + (s2[2] + s2[3])) + ((s3[0] + s3[1]) + (s3[2] + s3[3])); }
        const float rs = rsqrtf(sq * (1.f / 256.f) + EPS);
        const u32x4 bo = *(const u32x4*)(BV + row * 1024 + c8);
        const u32x4 gt = *(const u32x4*)(Yb + row * 2048 + 1024 + c8);
        const f32x4 g0 = *(const f32x4*)(gg + (c8 & 255)), g1 = *(const f32x4*)(gg + (c8 & 255) + 4);
        u32x4 o;
        o.x = cvt_pk_bf16(bflo(bo.x) * rs * g0[0] * siluf(bflo(gt.x)), bfhi(bo.x) * rs * g0[1] * siluf(bfhi(gt.x)));
        o.y = cvt_pk_bf16(bflo(bo.y) * rs * g0[2] * siluf(bflo(gt.y)), bfhi(bo.y) * rs * g0[3] * siluf(bfhi(gt.y)));
        o.z = cvt_pk_bf16(bflo(bo.z) * rs * g1[0] * siluf(bflo(gt.z)), bfhi(bo.z) * rs * g1[1] * siluf(bfhi(gt.z)));
        o.w = cvt_pk_bf16(bflo(bo.w) * rs * g1[2] * siluf(bflo(gt.w)), bfhi(bo.w) * rs * g1[3] * siluf(bfhi(gt.w)));
        *(u32x4*)(Yb + row * 2048 + 1024 + c8) = o;
    }
}

__device__ __forceinline__ void lru_item(const Params& p, LAS unsigned char* L, int item) {
    unsigned char* ws = p.ws;
    const int tid = threadIdx.x, lane = tid & 63, w = tid >> 6, r16 = lane & 15, q4 = lane >> 4;
    LAS bf16_t* Wl = (LAS bf16_t*)L;
    LAS bf16_t* U = (LAS bf16_t*)(L + 76800);
    LAS float* Aa = (LAS float*)(L + 102400);
    LAS float* Bb = (LAS float*)(L + 126976);
    LAS float* SP = (LAS float*)(L + 151552);
    LAS float* SH = (LAS float*)(L + 153088);
    LAS float* HC = (LAS float*)(L + 154624);
    LAS float* CW = (LAS float*)(L + 155392);
    const bool smp = item >= 256;
    const int i2 = smp ? item - 256 : item;
    const int b = i2 >> 4, nb = (i2 >> 1) & 7, hf = i2 & 1;
    const int nch = smp ? 1 : 32;
    const unsigned rbase = smp ? (unsigned)T_P + b * 64 : (unsigned)b * 2048;
    const bf16_t* Z2 = (const bf16_t*)(ws + WS_Z2); bf16_t* Y2 = (bf16_t*)(ws + WS_Y2);
    const bf16_t* WA = (const bf16_t*)(ws + WS_WA) + nb * 192 * 192; const bf16_t* WI = (const bf16_t*)(ws + WS_WI) + nb * 192 * 192;
    for (int idx = tid; idx < 192 * 24; idx += NTHR) {
        const int r = idx / 24, g8 = idx % 24;
        const bf16_t* src = (r < 96) ? WA + (size_t)(hf * 96 + r) * 192 + g8 * 8 : WI + (size_t)(hf * 96 + r - 96) * 192 + g8 * 8;
        *(LAS u32x4*)(Wl + r * 200 + g8 * 8) = *(const u32x4*)src;
    }
    const bool cthr = tid < 384;
    const int cgp = tid % 24, tq = (tid / 24) & 15;
    const int chc = nb * 192 + cgp * 8;
    for (int idx = tid; idx < 5 * 192; idx += NTHR) { const int j = idx / 192, cc = idx % 192; CW[idx] = (j < 4) ? p.in[16][j * 1536 + nb * 192 + cc] : p.in[17][nb * 192 + cc]; }
    const int mt = w & 3, pg = w >> 2;
    float bra[3], bri[3], sp[3];
#pragma unroll
    for (int cp = 0; cp < 3; ++cp) {
        const int ch = nb * 192 + hf * 96 + (pg * 3 + cp) * 16 + r16;
        bra[cp] = p.in[19][ch]; bri[cp] = p.in[21][ch];
        const float lam = p.in[22][ch];
        sp[cp] = 8.f * (fmaxf(-lam, 0.f) + log1pf(__expf(-fabsf(lam))));
    }
    if (tid < 96) HC[tid] = smp ? p.in[6][b * 1536 + nb * 192 + hf * 96 + tid] : 0.f;
    const int sch0 = tid % 96, sseg0 = (tid / 96) & 3;
    const int ot0 = tid / 12, og0 = tid % 12, ot1 = (tid + 512) / 12, og1 = (tid + 512) % 12;
    const bool o1 = tid < 256;
    const int och0 = nb * 192 + hf * 96 + og0 * 8, och1 = nb * 192 + hf * 96 + og1 * 8;
    lds_barrier();
    u32x4 xr[7]; u32x4 pg0, pg1 = {0u, 0u, 0u, 0u};
#pragma unroll
    for (int r = 0; r < 7; ++r) {
        xr[r] = (u32x4){0u, 0u, 0u, 0u};
        const int pos = 4 * tq - 3 + r;
        if (cthr) {
            if (pos >= 0) xr[r] = *(const u32x4*)(Z2 + (unsigned)((rbase + pos) * 3072u + chc));
            else if (smp) {
                const float* hp = p.in[5] + ((size_t)b * 3 + (3 + pos)) * 1536 + chc;
                const f32x4 h0 = *(const f32x4*)hp, h1 = *(const f32x4*)(hp + 4);
                xr[r].x = cvt_pk_bf16(h0[0], h0[1]); xr[r].y = cvt_pk_bf16(h0[2], h0[3]); xr[r].z = cvt_pk_bf16(h1[0], h1[1]); xr[r].w = cvt_pk_bf16(h1[2], h1[3]);
            }
        }
    }
    pg0 = *(const u32x4*)(Z2 + (unsigned)((rbase + ot0) * 3072u + 1536 + och0));
    if (o1) pg1 = *(const u32x4*)(Z2 + (unsigned)((rbase + ot1) * 3072u + 1536 + och1));
    u32x4 so0 = {0u, 0u, 0u, 0u}, so1 = {0u, 0u, 0u, 0u}; unsigned sr = 0; bool spend = false;
    for (int ci = 0; ci < nch; ++ci) {
        const unsigned r0 = rbase + (unsigned)ci * 64;
        const bool more = (ci + 1 < nch);
        int sch = sch0, sseg = sseg0;
        asm volatile("" : "+v"(sch), "+v"(sseg));
        if (cthr) {
            float xv[7][8];
#pragma unroll
            for (int r = 0; r < 7; ++r) unpack8(xr[r], xv[r]);
            if (hf == 0 && !more && tq == 15) {
                float* oc = p.out + (smp ? O_CS : O_CP) + (size_t)b * 3 * 1536 + chc;
#pragma unroll
                for (int r = 0; r < 3; ++r) { *(f32x4*)(oc + r * 1536) = (f32x4){xv[4 + r][0], xv[4 + r][1], xv[4 + r][2], xv[4 + r][3]}; *(f32x4*)(oc + r * 1536 + 4) = (f32x4){xv[4 + r][4], xv[4 + r][5], xv[4 + r][6], xv[4 + r][7]}; }
            }
            float cw[5][8];
#pragma unroll
            for (int j = 0; j < 5; ++j) { const f32x4 c0 = *(const LAS f32x4*)(CW + j * 192 + cgp * 8), c1 = *(const LAS f32x4*)(CW + j * 192 + cgp * 8 + 4);
                cw[j][0] = c0[0]; cw[j][1] = c0[1]; cw[j][2] = c0[2]; cw[j][3] = c0[3]; cw[j][4] = c1[0]; cw[j][5] = c1[1]; cw[j][6] = c1[2]; cw[j][7] = c1[3]; }
#pragma unroll
            for (int tk = 0; tk < 4; ++tk) {
                float acc[8];
#pragma unroll
                for (int e = 0; e < 8; ++e) acc[e] = fmaf(xv[tk + 3][e], cw[3][e], fmaf(xv[tk + 2][e], cw[2][e], fmaf(xv[tk + 1][e], cw[1][e], fmaf(xv[tk][e], cw[0][e], cw[4][e]))));
                u32x4 uw; uw.x = cvt_pk_bf16(acc[0], acc[1]); uw.y = cvt_pk_bf16(acc[2], acc[3]); uw.z = cvt_pk_bf16(acc[4], acc[5]); uw.w = cvt_pk_bf16(acc[6], acc[7]);
                *(LAS u32x4*)(U + (4 * tq + tk) * 200 + cgp * 8) = uw;
            }
            if (more) {
#pragma unroll
                for (int r = 0; r < 7; ++r) xr[r] = *(const u32x4*)(Z2 + (unsigned)((r0 + 64 + 4 * tq - 3 + r) * 3072u + chc));
            }
        }
        lds_barrier();
        if (spend) { *(u32x4*)(Y2 + (unsigned)((sr + ot0) * 1536u + och0)) = so0; if (o1) *(u32x4*)(Y2 + (unsigned)((sr + ot1) * 1536u + och1)) = so1; }
        f32x4 ga[3], gi[3];
#pragma unroll
        for (int cp = 0; cp < 3; ++cp) { ga[cp] = (f32x4){0.f, 0.f, 0.f, 0.f}; gi[cp] = (f32x4){0.f, 0.f, 0.f, 0.f}; }
#pragma unroll 2
        for (int ks = 0; ks < 6; ++ks) {
            const bf16x8 uf = *(const LAS bf16x8*)(U + (mt * 16 + r16) * 200 + ks * 32 + q4 * 8);
#pragma unroll
            for (int cp = 0; cp < 3; ++cp) {
                const int ct = pg * 3 + cp;
                const bf16x8 wa = *(const LAS bf16x8*)(Wl + (ct * 16 + r16) * 200 + ks * 32 + q4 * 8), wi = *(const LAS bf16x8*)(Wl + (96 + ct * 16 + r16) * 200 + ks * 32 + q4 * 8);
                ga[cp] = MFMA16(uf, wa, ga[cp]); gi[cp] = MFMA16(uf, wi, gi[cp]);
            }
        }
#pragma unroll
        for (int cp = 0; cp < 3; ++cp) {
            const int cl = (pg * 3 + cp) * 16 + r16;
#pragma unroll
            for (int jj = 0; jj < 4; ++jj) {
                const int t = mt * 16 + q4 * 4 + jj;
                const float rg = sigmf(ga[cp][jj] + bra[cp]), ig = sigmf(gi[cp][jj] + bri[cp]);
                const float z = rg * sp[cp];
                const float a = __expf(-z);
                const float z2 = z + z;
                const float om = (z2 < 0.05f) ? z2 * (1.f - z2 * (0.5f - z2 * (0.16666667f - z2 * 0.041666668f))) : 1.f - a * a;
                const float uu = bf2f(U[t * 200 + hf * 96 + cl]);
                Aa[t * 96 + cl] = a; Bb[t * 96 + cl] = __builtin_amdgcn_sqrtf(om) * ig * uu;
            }
        }
        lds_barrier();
        if (cthr) {
            float P = 1.f, H = 0.f;
#pragma unroll
            for (int t = 0; t < 16; ++t) { const float a = Aa[(sseg * 16 + t) * 96 + sch]; H = a * H + Bb[(sseg * 16 + t) * 96 + sch]; P *= a; }
            SP[sseg * 96 + sch] = P; SH[sseg * 96 + sch] = H;
        }
        lds_barrier();
        if (cthr) {
            float hh = HC[(ci & 1) * 96 + sch];
#pragma unroll
            for (int sg = 0; sg < 3; ++sg) if (sg < sseg) hh = SP[sg * 96 + sch] * hh + SH[sg * 96 + sch];
#pragma unroll
            for (int t = 0; t < 16; ++t) { hh = Aa[(sseg * 16 + t) * 96 + sch] * hh + Bb[(sseg * 16 + t) * 96 + sch]; Bb[(sseg * 16 + t) * 96 + sch] = hh; }
            if (sseg == 3) HC[((ci + 1) & 1) * 96 + sch] = hh;
        }
        lds_barrier();
        {
            const f32x4 h0 = *(const LAS f32x4*)(Bb + ot0 * 96 + og0 * 8), h1 = *(const LAS f32x4*)(Bb + ot0 * 96 + og0 * 8 + 4);
            u32x4 o;
            o.x = cvt_pk_bf16(h0[0] * siluf(bflo(pg0.x)), h0[1] * siluf(bfhi(pg0.x)));
            o.y = cvt_pk_bf16(h0[2] * siluf(bflo(pg0.y)), h0[3] * siluf(bfhi(pg0.y)));
            o.z = cvt_pk_bf16(h1[0] * siluf(bflo(pg0.z)), h1[1] * siluf(bfhi(pg0.z)));
            o.w = cvt_pk_bf16(h1[2] * siluf(bflo(pg0.w)), h1[3] * siluf(bfhi(pg0.w)));
            so0 = o;
            if (more) pg0 = *(const u32x4*)(Z2 + (unsigned)((r0 + 64 + ot0) * 3072u + 1536 + och0));
        }
        if (o1) {
            const f32x4 h0 = *(const LAS f32x4*)(Bb + ot1 * 96 + og1 * 8), h1 = *(const LAS f32x4*)(Bb + ot1 * 96 + og1 * 8 + 4);
            u32x4 o;
            o.x = cvt_pk_bf16(h0[0] * siluf(bflo(pg1.x)), h0[1] * siluf(bfhi(pg1.x)));
            o.y = cvt_pk_bf16(h0[2] * siluf(bflo(pg1.y)), h0[3] * siluf(bfhi(pg1.y)));
            o.z = cvt_pk_bf16(h1[0] * siluf(bflo(pg1.z)), h1[1] * siluf(bfhi(pg1.z)));
            o.w = cvt_pk_bf16(h1[2] * siluf(bflo(pg1.w)), h1[3] * siluf(bfhi(pg1.w)));
            so1 = o;
            if (more) pg1 = *(const u32x4*)(Z2 + (unsigned)((r0 + 64 + ot1) * 3072u + 1536 + och1));
        }
        sr = r0; spend = true;
        lds_barrier();
    }
    if (spend) { *(u32x4*)(Y2 + (unsigned)((sr + ot0) * 1536u + och0)) = so0; if (o1) *(u32x4*)(Y2 + (unsigned)((sr + ot1) * 1536u + och1)) = so1; }
    if (tid < 96) p.out[(smp ? O_LS : O_LP) + (size_t)b * 1536 + nb * 192 + hf * 96 + tid] = HC[(nch & 1) * 96 + tid];
    lds_barrier();
}

__device__ __forceinline__ void phase6(const Params& p, LAS unsigned char* L) {
    if (gridDim.x == 256) {
        const int xcd = blockIdx.x & 7, loc = blockIdx.x >> 3;
        const int pair = xcd * 16 + (loc >> 1), hf = loc & 1;
        lru_item(p, L, pair * 2 + hf); lru_item(p, L, 256 + pair * 2 + hf); lru_item(p, L, 512 + pair * 2 + hf);
    } else {
        for (int it = blockIdx.x; it < 768; it += gridDim.x) lru_item(p, L, it);
    }
}

__device__ __forceinline__ void phase8(const Params& p) {
    const float* rsq = (const float*)(p.ws + WS_RSQ2); const float* g = p.in[24]; float* y = p.out; const bf16_t* xb = (const bf16_t*)(p.ws + WS_XB);
    const long gtid = (long)blockIdx.x * NTHR + threadIdx.x, gsz = (long)gridDim.x * NTHR;
    const long total = (long)T * 128;
    for (long it = gtid; it < total; it += gsz) {
        const long row = it >> 7; const int c8 = (int)(it & 127) * 8;
        const float rs = rsqrtf(rsq[row] * (1.f / 1024.f) + EPS);
        const u32x4 xw = *(const u32x4*)(xb + row * 1024 + c8);
        const f32x4 g0 = *(const f32x4*)(g + c8), g1 = *(const f32x4*)(g + c8 + 4);
        f32x4 o0, o1;
        o0[0] = bflo(xw.x) * rs * g0[0]; o0[1] = bfhi(xw.x) * rs * g0[1]; o0[2] = bflo(xw.y) * rs * g0[2]; o0[3] = bfhi(xw.y) * rs * g0[3];
        o1[0] = bflo(xw.z) * rs * g1[0]; o1[1] = bfhi(xw.z) * rs * g1[1]; o1[2] = bflo(xw.w) * rs * g1[2]; o1[3] = bfhi(xw.w) * rs * g1[3];
        *(f32x4*)(y + row * 1024 + c8) = o0; *(f32x4*)(y + row * 1024 + c8 + 4) = o1;
    }
}

#define XB_TMO      128
#define XB_XCNT(j)  (256  + 64 * (j))
#define XB_XSUB(j)  (1280 + 64 * (j))
#define XB_XGEN(j)  (2304 + 64 * (j))
#define XB_TOP      3328
#define XB_TOPGEN   3392
#define XCD_BAR_WORDS 3456
#define XB_SPIN_CAP (1u << 18)
__device__ __forceinline__ unsigned xb_ld(unsigned* p)              { return __hip_atomic_load(p, __ATOMIC_RELAXED, __HIP_MEMORY_SCOPE_AGENT); }
__device__ __forceinline__ unsigned xb_add(unsigned* p, unsigned v) { return __hip_atomic_fetch_add(p, v, __ATOMIC_RELAXED, __HIP_MEMORY_SCOPE_AGENT); }
__device__ __forceinline__ unsigned xb_xcc_id() { return (unsigned)__builtin_amdgcn_s_getreg((3 << 11) | 20) & 0xFu; }
#define XB_SPIN(cond, bar) do { unsigned _sp = 0; while (cond) { __builtin_amdgcn_s_sleep(1); \
    if ((++_sp & 255u) == 0u) { if (xb_ld(&(bar)[XB_TMO])) break; if (_sp > XB_SPIN_CAP) { atomicAdd(&(bar)[XB_TMO], 1u); break; } } } } while (0)
struct XcdBarrier { unsigned* bar; unsigned x; volatile LAS unsigned* st; };
__device__ __forceinline__ XcdBarrier xcd_barrier_post(unsigned* bar, volatile LAS unsigned* st) {
    XcdBarrier b; b.bar = bar; b.x = xb_xcc_id(); b.st = st;
    if (threadIdx.x == 0) (void)xb_add(&bar[XB_XCNT(b.x)], 1u);
    return b;
}
__device__ __forceinline__ void xcd_barrier_complete(unsigned* bar, unsigned x, unsigned& nloc, unsigned& nx) {
    const unsigned G = gridDim.x * gridDim.y * gridDim.z;
    unsigned sum, cnt, mine, sp = 0u;
    for (;;) {
        sum = 0u; cnt = 0u; mine = 0u;
#pragma unroll
        for (unsigned j = 0; j < 16; ++j) { const unsigned c = xb_ld(&bar[XB_XCNT(j)]); sum += c; cnt += (c > 0u) ? 1u : 0u; mine = (j == x) ? c : mine; }
        if (sum == G) break;
        __builtin_amdgcn_s_sleep(1);
        if ((++sp & 255u) == 0u) { if (xb_ld(&bar[XB_TMO])) break; if (sp > XB_SPIN_CAP) { atomicAdd(&bar[XB_TMO], 1u); break; } }
    }
    nloc = mine > 0u ? mine : 1u; nx = cnt > 0u ? cnt : 1u;
}
__device__ __forceinline__ void xcd_barrier(const XcdBarrier& b) {
    asm volatile("s_waitcnt vmcnt(0)" ::: "memory");
    __syncthreads();
    if (threadIdx.x == 0) {
        unsigned* bar = b.bar;
        __builtin_amdgcn_s_waitcnt(0);
        unsigned nloc = b.st[0], nx = b.st[1];
        if (nloc == 0u) { xcd_barrier_complete(bar, b.x, nloc, nx); b.st[0] = nloc; b.st[1] = nx; }
        const unsigned old = xb_add(&bar[XB_XSUB(b.x)], 1u);
        const unsigned gen = old / nloc;
        if (old + 1u == (gen + 1u) * nloc) {
            __builtin_amdgcn_fence(__ATOMIC_RELEASE, "agent");
            asm volatile("s_waitcnt vmcnt(0)" ::: "memory");
            const unsigned og = xb_add(&bar[XB_TOP], 1u);
            const unsigned tg = og / nx;
            if (og + 1u == (tg + 1u) * nx) xb_add(&bar[XB_TOPGEN], 1u);
            else XB_SPIN(xb_ld(&bar[XB_TOPGEN]) == tg, bar);
            __builtin_amdgcn_fence(__ATOMIC_ACQUIRE, "agent");
            xb_add(&bar[XB_XGEN(b.x)], 1u);
            asm volatile("s_waitcnt vmcnt(0)" ::: "memory");
        } else {
            XB_SPIN(xb_ld(&bar[XB_XGEN(b.x)]) == gen, bar);
            __builtin_amdgcn_fence(__ATOMIC_ACQUIRE, "agent");
            asm volatile("s_waitcnt vmcnt(0)" ::: "memory");
        }
    }
    __syncthreads();
}

__global__ void __launch_bounds__(NTHR) mega(Params p) {
    extern __shared__ __attribute__((aligned(16))) unsigned char lds_raw[];
    LAS unsigned char* L = (LAS unsigned char*)lds_raw;
    cg::grid_group grid = cg::this_grid();
    unsigned char* ws = p.ws;
    const int lo = p.ph_lo, hi = p.ph_hi;
    LAS unsigned* stw = (LAS unsigned*)(L + (LDS_BYTES - 16));
    if (threadIdx.x < 4) stw[threadIdx.x] = 0u;
    __syncthreads();
    const XcdBarrier xb = xcd_barrier_post((unsigned*)(ws + WS_BAR), (volatile LAS unsigned*)stw);
#ifndef PHMASK
#define PHMASK 0x1ff
#endif
#define IN(k) (((PHMASK >> (k)) & 1) && lo <= (k) && (k) < hi)
#define SEAM(k) do { if (IN(k) && IN((k) + 1)) xcd_barrier(xb); } while (0)
    if (hi > 1000) grid.sync();
    if (IN(0)) phase0(p);
    SEAM(0);
    if (IN(1)) {
        pg8::Gemm g{(const bf16_t*)(ws + WS_XB), (const bf16_t*)(ws + WS_WINE), T, NE_PAD, 1024};
        pg8::StaticOrder S; S.init(T, NE_PAD, gridDim.x, blockIdx.x);
        EpiInEven E{ws, p.out, (const float*)(ws + WS_RSTD0), p.in[10]};
        pg8::gemm_phase<EpiInEven>(L, g, S, E);
    }
    SEAM(1);
    if (IN(2)) { phase2a(p, L); xcd_barrier(xb); phase2b(p, L); }
    SEAM(2);
    if (IN(3)) phase3(p);
    SEAM(3);
    if (IN(4)) {
        pg8::Gemm g{(const bf16_t*)(ws + WS_GATE), (const bf16_t*)(ws + WS_WOUTE), T, 1024, 2048};
        pg8::StaticOrder S; S.init(T, 1024, gridDim.x, blockIdx.x);
        EpiOutResB E{(bf16_t*)(ws + WS_XB), (float*)(ws + WS_RSQ1)};
        pg8::gemm_phase<EpiOutResB>(L, g, S, E);
    }
    SEAM(4);
    if (IN(5)) {
        pg8::Gemm g{(const bf16_t*)(ws + WS_XB), (const bf16_t*)(ws + WS_WINO), T, 3072, 1024};
        pg8::StaticOrder S; S.init(T, 3072, gridDim.x, blockIdx.x);
        EpiInOdd E{(bf16_t*)(ws + WS_Z2), (const float*)(ws + WS_RSQ1)};
        pg8::gemm_phase<EpiInOdd>(L, g, S, E);
    }
    SEAM(5);
    if (IN(6)) phase6(p, L);
    SEAM(6);
    if (IN(7)) {
        pg8::Gemm g{(const bf16_t*)(ws + WS_Y2), (const bf16_t*)(ws + WS_WOUTO), T, 1024, 1536};
        pg8::StaticOrder S; S.init(T, 1024, gridDim.x, blockIdx.x);
        EpiOutResB E{(bf16_t*)(ws + WS_XB), (float*)(ws + WS_RSQ2)};
        pg8::gemm_phase<EpiOutResB>(L, g, S, E);
    }
    SEAM(7);
    if (IN(8)) phase8(p);
#undef IN
#undef SEAM
}

extern "C" void kernel_launch(void* const* d_in, const int* in_sizes, int n_in, void* d_out, int out_size, void* d_ws, size_t ws_size, hipStream_t stream) {
    static int grid_blocks = 0;
    if (grid_blocks == 0) {
        if (n_in != 25 || (size_t)out_size != O_END || ws_size < WS_TOTAL) { fprintf(stderr, "kernel_launch: unexpected shapes n_in %d out %d ws %zu (need %zu)\n", n_in, out_size, ws_size, (size_t)WS_END); grid_blocks = -1; return; }
        int dev = 0, cus = 0, per_cu = 0;
        (void)hipGetDevice(&dev);
        (void)hipDeviceGetAttribute(&cus, hipDeviceAttributeMultiprocessorCount, dev);
        if (hipFuncSetAttribute((const void*)mega, hipFuncAttributeMaxDynamicSharedMemorySize, LDS_BYTES) != hipSuccess) { fprintf(stderr, "kernel_launch: hipFuncSetAttribute failed\n"); }
        if (hipOccupancyMaxActiveBlocksPerMultiprocessor(&per_cu, (const void*)mega, NTHR, LDS_BYTES) != hipSuccess || per_cu < 1) per_cu = 1;
        (void)hipGetLastError();
        grid_blocks = cus * per_cu;
        if (grid_blocks <= 0) grid_blocks = 256;
    }
    if (grid_blocks < 0) return;
    Params p{};
    for (int i = 0; i < 25; ++i) p.in[i] = (const float*)d_in[i];
    p.out = (float*)d_out; p.ws = (unsigned char*)d_ws;
#if ONE_LAUNCH
#ifdef PROBE_X
    { const int seq[3][2] = {{0, PROBE_Y + 1}, {PROBE_X, PROBE_Y + 1}, {PROBE_Y + 1, 9}};
      for (int li = 0; li < 3; ++li) { if (seq[li][0] >= seq[li][1]) continue; p.ph_lo = seq[li][0]; p.ph_hi = seq[li][1]; void* args[] = {&p};
        (void)hipMemsetAsync((char*)d_ws + WS_BAR, 0, 16384, stream);
        hipError_t e = hipLaunchCooperativeKernel((const void*)mega, dim3(grid_blocks), dim3(NTHR), args, LDS_BYTES, stream);
        if (e != hipSuccess) fprintf(stderr, "cooperative launch failed: %s (grid %d)\n", hipGetErrorString(e), grid_blocks); } }
#else
    p.ph_lo = 0; p.ph_hi = 9;
    (void)hipMemsetAsync((char*)d_ws + WS_BAR, 0, 16384, stream);
    { void* args[] = {&p}; hipError_t e = hipLaunchCooperativeKernel((const void*)mega, dim3(grid_blocks), dim3(NTHR), args, LDS_BYTES, stream);
      if (e != hipSuccess) fprintf(stderr, "cooperative launch failed: %s (grid %d)\n", hipGetErrorString(e), grid_blocks); }
#endif
#else
    for (int ph = 0; ph < 9; ++ph) {
        p.ph_lo = ph; p.ph_hi = ph + 1;
        (void)hipMemsetAsync((char*)d_ws + WS_BAR, 0, 16384, stream);
        void* args[] = {&p}; hipError_t e = hipLaunchCooperativeKernel((const void*)mega, dim3(grid_blocks), dim3(NTHR), args, LDS_BYTES, stream);
        if (e != hipSuccess) fprintf(stderr, "cooperative launch %d failed: %s (grid %d)\n", ph, hipGetErrorString(e), grid_blocks);
    }
#endif
}
```

```cpp
#include <hip/hip_runtime.h>
#include <hip/hip_cooperative_groups.h>
#include <cstdio>
namespace cg = cooperative_groups;

#ifndef ONE_LAUNCH
#define ONE_LAUNCH 1
#endif

#define LAS __attribute__((address_space(3)))
typedef unsigned short bf16_t;
typedef short bf16x8 __attribute__((ext_vector_type(8)));
typedef short bf16x4 __attribute__((ext_vector_type(4)));
typedef float f32x4 __attribute__((ext_vector_type(4)));
typedef unsigned u32x4 __attribute__((ext_vector_type(4)));
typedef unsigned u32x2 __attribute__((ext_vector_type(2)));

constexpr int T_P = 32768, T_S = 2048, T = T_P + T_S, DM = 1024;
constexpr int NE_PAD = 6144;
constexpr int LDS_BYTES = 159744;
constexpr int NTHR = 512;
constexpr float EPS = 1e-6f;

constexpr size_t WS_WINE = 0;
constexpr size_t WS_WOUTE = WS_WINE + (size_t)NE_PAD * 1024 * 2;
constexpr size_t WS_WINO = WS_WOUTE + (size_t)1024 * 2048 * 2;
constexpr size_t WS_WOUTO = WS_WINO + (size_t)3072 * 1024 * 2;
constexpr size_t WS_WA = WS_WOUTO + (size_t)1024 * 1536 * 2;
constexpr size_t WS_WI = WS_WA + (size_t)8 * 192 * 192 * 2;
constexpr size_t WS_XB = WS_WI + (size_t)8 * 192 * 192 * 2;
constexpr size_t WS_RSTD0 = WS_XB + (size_t)T * 1024 * 2;
constexpr size_t WS_RSQ1 = WS_RSTD0 + (size_t)T * 4;
constexpr size_t WS_RSQ2 = WS_RSQ1 + (size_t)T * 4;
constexpr size_t WS_BOSQ = WS_RSQ2 + (size_t)T * 4;
constexpr size_t WS_Q = WS_BOSQ + (size_t)T * 16;
constexpr size_t WS_K = WS_Q + (size_t)T * 1024 * 2;
constexpr size_t WS_V = WS_K + (size_t)T * 256 * 2;
constexpr size_t WS_BQ = WS_V + (size_t)T * 256 * 2;
constexpr size_t WS_BK = WS_BQ + (size_t)T * 512 * 2;
constexpr size_t WS_BV = WS_BK + (size_t)T * 512 * 2;
constexpr size_t WS_GATE = WS_BV + (size_t)T * 1024 * 2;
constexpr size_t WS_BLR = WS_GATE + (size_t)T * 2048 * 2;
constexpr size_t WS_END = WS_BLR + (size_t)T * 512 * 2;
constexpr size_t WS_BAR = WS_END;
constexpr size_t WS_TOTAL = WS_BAR + 16384;
constexpr size_t WS_Z2 = WS_Q;
constexpr size_t WS_Y2 = WS_GATE;
static_assert(WS_Z2 + (size_t)T * 3072 * 2 <= WS_GATE, "Z2 alias");

constexpr size_t O_Y = 0;
constexpr size_t O_KP = (size_t)T * 1024;
constexpr size_t O_VP = O_KP + 524288;
constexpr size_t O_GP = O_VP + 524288;
constexpr size_t O_CP = O_GP + 2097152;
constexpr size_t O_LP = O_CP + 73728;
constexpr size_t O_KS = O_LP + 24576;
constexpr size_t O_VS = O_KS + 524288;
constexpr size_t O_GS = O_VS + 524288;
constexpr size_t O_CS = O_GS + 4194304;
constexpr size_t O_LS = O_CS + 147456;
constexpr size_t O_END = O_LS + 49152;

struct Params {
    const float* in[25];
    float* out;
    unsigned char* ws;
    int ph_lo, ph_hi;
};

__device__ __forceinline__ unsigned cvt_pk_bf16(float lo, float hi) { unsigned r; asm volatile("v_cvt_pk_bf16_f32 %0, %1, %2" : "=v"(r) : "v"(lo), "v"(hi)); return r; }
__device__ __forceinline__ bf16_t f2bf(float f) { return (bf16_t)(cvt_pk_bf16(f, 0.f) & 0xffffu); }
__device__ __forceinline__ float bf2f(bf16_t b) { return __uint_as_float(((unsigned)b) << 16); }
__device__ __forceinline__ float bflo(unsigned w) { return __uint_as_float(w << 16); }
__device__ __forceinline__ float bfhi(unsigned w) { return __uint_as_float(w & 0xffff0000u); }
__device__ __forceinline__ float rcpf_(float x) { return __builtin_amdgcn_rcpf(x); }
__device__ __forceinline__ float siluf(float x) { return x * rcpf_(1.f + __expf(-x)); }
__device__ __forceinline__ float sigmf(float x) { return rcpf_(1.f + __expf(-x)); }
__device__ __forceinline__ void lds_barrier() { asm volatile("s_waitcnt lgkmcnt(0)" ::: "memory"); __builtin_amdgcn_s_barrier(); asm volatile("" ::: "memory"); }
__device__ __forceinline__ bf16x8 pack8(const f32x4& a, const f32x4& b) {
    u32x4 p; p.x = cvt_pk_bf16(a[0], a[1]); p.y = cvt_pk_bf16(a[2], a[3]); p.z = cvt_pk_bf16(b[0], b[1]); p.w = cvt_pk_bf16(b[2], b[3]);
    return __builtin_bit_cast(bf16x8, p);
}
__device__ __forceinline__ bf16x8 cat4(const bf16x4 a, const bf16x4 b) { bf16x8 r; r[0] = a[0]; r[1] = a[1]; r[2] = a[2]; r[3] = a[3]; r[4] = b[0]; r[5] = b[1]; r[6] = b[2]; r[7] = b[3]; return r; }
__device__ __forceinline__ void unpack8(const u32x4 w, float (&v)[8]) { v[0] = bflo(w.x); v[1] = bfhi(w.x); v[2] = bflo(w.y); v[3] = bfhi(w.y); v[4] = bflo(w.z); v[5] = bfhi(w.z); v[6] = bflo(w.w); v[7] = bfhi(w.w); }
#define MFMA16(a, b, c) __builtin_amdgcn_mfma_f32_16x16x32_bf16((a), (b), (c), 0, 0, 0)

namespace pg8 {
constexpr int BM = 256, BK = 64, HALF = 128, HTB = HALF * BK * 2, STAGE_BYTES = 8 * HTB, NXCD = 8, WGM = 8;
__device__ __forceinline__ int lds_byte(int r, int c) { const int st = (r >> 4) * 2 + (c >> 5), rr = r & 15, cc = c & 31, ob = rr * 64 + cc * 2; return st * 1024 + (ob ^ (((ob >> 9) & 1) << 5)); }
__device__ __forceinline__ int perm32(int rho) { const int n = rho >> 4, i = rho & 15; return 8 * (i >> 2) + 4 * n + (i & 3); }
__device__ __forceinline__ void stage_rc(int b, int& R, int& C) { const int st = b / 1024, sb = b % 1024, swz = sb ^ (((sb >> 9) & 1) << 5); R = (st >> 1) * 16 + swz / 64; C = (st & 1) * 32 + (swz % 64) / 2; }
struct Unit { int pm, pn; unsigned koff; int aux; };
struct Gemm { const bf16_t* A; const bf16_t* Bt; int M, N, K, ld; };
struct StaticOrder {
    int nM, nN, nwg, G, c, nrun;
    __device__ void init(int M, int N, int G_, int c_, int nrun_ = -1) { nM = M / BM; nN = N / BM; nwg = nM * nN; G = G_; c = c_; nrun = (nrun_ < 0 || nrun_ > nwg) ? nwg : nrun_; }
    __device__ __forceinline__ void map(int Lx, Unit& u) const {
        int wgid = Lx; { const int q = nwg / NXCD, r = nwg % NXCD, xcd = wgid % NXCD, off = wgid / NXCD; wgid = (xcd < r ? xcd * (q + 1) : r * (q + 1) + (xcd - r) * q) + off; }
        const int nig = WGM * nN, gid = wgid / nig, fm = gid * WGM, gsz = (nM - fm) < WGM ? (nM - fm) : WGM;
        u.pm = fm + ((wgid % nig) % gsz); u.pn = (wgid % nig) / gsz; u.koff = 0u; u.aux = 0;
    }
    __device__ __forceinline__ bool next(int i, Unit& u) const {
        const long Lx = (long)i * G + c; if (Lx >= nrun) return false;
        map((int)Lx, u); return true;
    }
};
struct SliceOrder {
    StaticOrder base; int first, nsl; unsigned kbytes;
    __device__ __forceinline__ bool next(int i, Unit& u) const {
        if (i != 0 || base.c >= 32 * nsl) return false;
        const int ui = base.c / nsl, sl = base.c % nsl;
        base.map(first + ui, u); u.koff = (unsigned)sl * kbytes; u.aux = sl * 32 + ui; return true;
    }
};

template <class Epi, class Sched>
__device__ __forceinline__ void gemm_phase(LAS unsigned char* lds, const Gemm g, const Sched& S, const Epi& E) {
    const int tid = threadIdx.x, wid = __builtin_amdgcn_readfirstlane(tid >> 6), lane = tid & 63, wr = wid >> 2, wc = wid & 3, fr = lane & 15, fq = lane >> 4;
    const int K = g.K, ld = g.ld, nt = K / BK;
    unsigned voffA[2], voffB[2];
#pragma unroll
    for (int i = 0; i < 2; ++i) { int R, C; stage_rc(tid * 16 + i * 8192, R, C); const int Rb = Epi::PERM ? ((R & ~31) + perm32(R & 31)) : R;
        voffA[i] = (unsigned)(R * ld + C) * 2u; voffB[i] = (unsigned)(Rb * ld + C) * 2u; }
    const size_t kstep = (size_t)(BK * 2);
    const size_t hstep = (size_t)HALF * ld * 2;
    const size_t tstep = 2 * hstep;
    const unsigned ldsw = (unsigned)wid * 1024u;
    const int aoff = lds_byte(wr * 64 + fr, fq * 8), boff = lds_byte(wc * 32 + fr, fq * 8);
#define PG8_SA(b, h) (((b) * 2 + (h)) * HTB)
#define PG8_SB(b, h) ((4 + (b) * 2 + (h)) * HTB)
#define PG8_STAGE(bufoff, gbase, voff) do { _Pragma("unroll") for (int _i = 0; _i < 2; ++_i) \
        __builtin_amdgcn_global_load_lds((const unsigned*)((const char*)(gbase) + (voff)[_i]), (LAS unsigned*)(lds + (bufoff) + ldsw + _i * 8192), 16, 0, 0); } while (0)
#define PG8_LDA(dst, b, h) do { _Pragma("unroll") for (int m = 0; m < 4; ++m) _Pragma("unroll") for (int k = 0; k < 2; ++k) dst[m][k] = *(const LAS bf16x8*)(lds + PG8_SA(b, h) + aoff + m * 2048 + k * 1024); } while (0)
#define PG8_LDB(dst, b, h) do { _Pragma("unroll") for (int n = 0; n < 2; ++n) _Pragma("unroll") for (int k = 0; k < 2; ++k) dst[n][k] = *(const LAS bf16x8*)(lds + PG8_SB(b, h) + boff + n * 2048 + k * 1024); } while (0)
#define PG8_MMA(ai, bj, At, Bt) do { __builtin_amdgcn_s_setprio(1); _Pragma("unroll") for (int m = 0; m < 4; ++m) _Pragma("unroll") for (int n = 0; n < 2; ++n) _Pragma("unroll") for (int k = 0; k < 2; ++k) \
        acc[ai][bj][m][n] = __builtin_amdgcn_mfma_f32_16x16x32_bf16(Bt[n][k], At[m][k], acc[ai][bj][m][n], 0, 0, 0); __builtin_amdgcn_s_setprio(0); } while (0)
#define PG8_WAIT_V(n) asm volatile("s_waitcnt vmcnt(" #n ")" ::: "memory")
#define PG8_WAIT_L(n) asm volatile("s_waitcnt lgkmcnt(" #n ")" ::: "memory")
#define PG8_BAR __builtin_amdgcn_s_barrier()
#define PG8_SCHED __builtin_amdgcn_sched_barrier(0)
    Unit cur, nxt; int ui = 0;
    if (!S.next(0, cur)) return;
    f32x4 acc[2][2][4][2];
#pragma unroll
    for (int a = 0; a < 2; ++a)
#pragma unroll
        for (int b = 0; b < 2; ++b)
#pragma unroll
            for (int m = 0; m < 4; ++m)
#pragma unroll
                for (int n = 0; n < 2; ++n) acc[a][b][m][n] = (f32x4){0.f, 0.f, 0.f, 0.f};
    bf16x8 At[4][2], B0[2][2], B1[2][2];
    const char* cA = (const char*)g.A + (size_t)cur.pm * tstep + cur.koff; const char* cB = (const char*)g.Bt + (size_t)cur.pn * tstep + cur.koff;
    PG8_STAGE(PG8_SB(0, 0), cB, voffB); PG8_STAGE(PG8_SB(0, 1), cB + hstep, voffB); PG8_STAGE(PG8_SA(0, 0), cA, voffA); PG8_STAGE(PG8_SA(0, 1), cA + hstep, voffA);
    if (wr == 1) PG8_BAR;
    PG8_WAIT_V(2); PG8_BAR;
    PG8_STAGE(PG8_SB(1, 0), cB + kstep, voffB); PG8_STAGE(PG8_SA(1, 0), cA + kstep, voffA); PG8_STAGE(PG8_SB(1, 1), cB + hstep + kstep, voffB);
    PG8_WAIT_V(6); PG8_BAR;
    for (;;) {
        const bool has_next = S.next(ui + 1, nxt);
        const char* nA = has_next ? (const char*)g.A + (size_t)nxt.pm * tstep + nxt.koff : cA; const char* nB = has_next ? (const char*)g.Bt + (size_t)nxt.pn * tstep + nxt.koff : cB;
        for (int t = 0; t < nt; t += 2) {
            const bool last = (t == nt - 2);
            const char* a1 = cA + (size_t)(t + 1) * kstep;
            const char* a2 = last ? nA : cA + (size_t)(t + 2) * kstep; const char* b2 = last ? nB : cB + (size_t)(t + 2) * kstep;
            const char* a3 = a2 + kstep; const char* b3 = b2 + kstep;
            PG8_LDB(B0, 0, 0); PG8_LDB(B1, 0, 1); PG8_SCHED; PG8_LDA(At, 0, 0); PG8_STAGE(PG8_SA(1, 1), a1 + hstep, voffA);
            PG8_WAIT_V(8); PG8_WAIT_L(0); PG8_BAR; PG8_MMA(0, 0, At, B0); PG8_MMA(0, 1, At, B1); PG8_BAR; PG8_SCHED;
            PG8_LDA(At, 0, 1); PG8_STAGE(PG8_SB(0, 0), b2, voffB); PG8_STAGE(PG8_SB(0, 1), b2 + hstep, voffB); PG8_STAGE(PG8_SA(0, 0), a2, voffA);
            PG8_WAIT_V(8); PG8_WAIT_L(0); PG8_BAR; PG8_MMA(1, 0, At, B0); PG8_MMA(1, 1, At, B1); PG8_BAR; PG8_SCHED;
            PG8_LDB(B0, 1, 0); PG8_LDB(B1, 1, 1); PG8_SCHED; PG8_LDA(At, 1, 0); PG8_STAGE(PG8_SA(0, 1), a2 + hstep, voffA);
            PG8_WAIT_V(8); PG8_WAIT_L(0); PG8_BAR; PG8_MMA(0, 0, At, B0); PG8_MMA(0, 1, At, B1); PG8_BAR; PG8_SCHED;
            PG8_LDA(At, 1, 1); PG8_STAGE(PG8_SB(1, 0), b3, voffB); PG8_STAGE(PG8_SB(1, 1), b3 + hstep, voffB); PG8_STAGE(PG8_SA(1, 0), a3, voffA);
            PG8_WAIT_V(8); PG8_WAIT_L(0); PG8_BAR; PG8_MMA(1, 0, At, B0); PG8_MMA(1, 1, At, B1); PG8_BAR; PG8_SCHED;
        }
        if (wr == 0) PG8_BAR;
        E(acc, cur, wr, wc, fr, fq);
        if (!has_next) break;
#pragma unroll
        for (int a = 0; a < 2; ++a)
#pragma unroll
            for (int b = 0; b < 2; ++b)
#pragma unroll
                for (int m = 0; m < 4; ++m)
#pragma unroll
                    for (int n = 0; n < 2; ++n) acc[a][b][m][n] = (f32x4){0.f, 0.f, 0.f, 0.f};
        cur = nxt; cA = nA; cB = nB; ++ui;
        if (wr == 1) PG8_BAR;
    }
    PG8_WAIT_V(0);
    PG8_BAR;
#undef PG8_SA
#undef PG8_SB
#undef PG8_STAGE
#undef PG8_LDA
#undef PG8_LDB
#undef PG8_MMA
#undef PG8_WAIT_V
#undef PG8_WAIT_L
#undef PG8_BAR
#undef PG8_SCHED
}
}

typedef f32x4 AccT[2][2][4][2];

struct EpiInEven {
    static constexpr bool PERM = true;
    unsigned char* ws; float* out; const float* rstd; const float* blr_b;
    __device__ __forceinline__ void operator()(const AccT& acc, const pg8::Unit& u, int wr, int wc, int fr, int fq) const {
        const int pn = u.pn;
        bf16_t* base; int ld, coff; float sc = 1.f;
        if (pn < 4) { base = (bf16_t*)(ws + WS_Q); ld = 1024; coff = pn * 256; sc = 0.125f * 1.4426950408889634f; }
        else if (pn == 4) { base = (bf16_t*)(ws + WS_K); ld = 256; coff = 0; }
        else if (pn == 5) { base = (bf16_t*)(ws + WS_V); ld = 256; coff = 0; }
        else if (pn < 8) { base = (bf16_t*)(ws + WS_BQ); ld = 512; coff = (pn - 6) * 256; sc = 0.08838834764831845f; }
        else if (pn < 10) { base = (bf16_t*)(ws + WS_BK); ld = 512; coff = (pn - 8) * 256; }
        else if (pn < 14) { base = (bf16_t*)(ws + WS_BV); ld = 1024; coff = (pn - 10) * 256; }
        else if (pn < 22) { base = (bf16_t*)(ws + WS_GATE); ld = 2048; coff = (pn - 14) * 256; }
        else { base = (bf16_t*)(ws + WS_BLR); ld = 512; coff = (pn - 22) * 256; }
        const int row0 = u.pm * 256 + wr * 64 + fr;
        const int ct = wc * 32 + 8 * fq;
        float rsv[8];
#pragma unroll
        for (int it = 0; it < 8; ++it) rsv[it] = rstd[row0 + (it >> 2) * 128 + (it & 3) * 16];
        if (pn >= 22) {
#pragma unroll
            for (int ai = 0; ai < 2; ++ai)
#pragma unroll
                for (int m = 0; m < 4; ++m) {
                    const int row = row0 + ai * 128 + m * 16; const float rs = rsv[ai * 4 + m];
#pragma unroll
                    for (int bj = 0; bj < 2; ++bj) {
                        const int cg = coff + ct + bj * 128;
                        const f32x4 b0 = *(const f32x4*)(blr_b + cg), b1 = *(const f32x4*)(blr_b + cg + 4);
                        f32x4 x0 = acc[ai][bj][m][0] * rs + b0, x1 = acc[ai][bj][m][1] * rs + b1;
#pragma unroll
                        for (int j = 0; j < 4; ++j) { x0[j] = (fminf(x0[j], 0.f) - __logf(1.f + __expf(-fabsf(x0[j])))) * (1.f / 16.f); x1[j] = (fminf(x1[j], 0.f) - __logf(1.f + __expf(-fabsf(x1[j])))) * (1.f / 16.f); }
                        u32x4 w; w.x = cvt_pk_bf16(x0[0], x0[1]); w.y = cvt_pk_bf16(x0[2], x0[3]); w.z = cvt_pk_bf16(x1[0], x1[1]); w.w = cvt_pk_bf16(x1[2], x1[3]);
                        *(u32x4*)(base + (size_t)row * 512 + cg) = w;
                    }
                }
            return;
        }
        const bool kv = (pn == 4 || pn == 5);
        float* okv_p = out + (pn == 4 ? O_KP : O_VP); float* okv_s = out + (pn == 4 ? O_KS : O_VS);
#pragma unroll
        for (int ai = 0; ai < 2; ++ai)
#pragma unroll
            for (int m = 0; m < 4; ++m) {
                const int row = row0 + ai * 128 + m * 16; const float rs = rsv[ai * 4 + m] * sc;
                bf16_t* rowp = base + (size_t)row * ld + coff + ct;
                float* orow = nullptr;
                if (kv) {
                    if (row >= T_P) orow = okv_s + (size_t)(row - T_P) * 256;
                    else { const int b = row >> 11, t = row & 2047; if (t >= 1920) orow = okv_p + (size_t)(b * 128 + t - 1920) * 256; }
                }
#pragma unroll
                for (int bj = 0; bj < 2; ++bj) {
                    const f32x4 v0 = acc[ai][bj][m][0] * rs, v1 = acc[ai][bj][m][1] * rs;
                    u32x4 w; w.x = cvt_pk_bf16(v0[0], v0[1]); w.y = cvt_pk_bf16(v0[2], v0[3]); w.z = cvt_pk_bf16(v1[0], v1[1]); w.w = cvt_pk_bf16(v1[2], v1[3]);
                    *(u32x4*)(rowp + bj * 128) = w;
                    if (kv && orow) { *(f32x4*)(orow + bj * 128 + ct) = v0; *(f32x4*)(orow + bj * 128 + ct + 4) = v1; }
                }
            }
    }
};

template <bool WRITE_BF>
struct EpiOutRes {
    static constexpr bool PERM = false;
    const float* xin_p; const float* xin_s; float* xo; bf16_t* xb; float* rowsq;
    __device__ __forceinline__ void operator()(const AccT& acc, const pg8::Unit& u, int wr, int wc, int fr, int fq) const {
        const int row0 = u.pm * 256 + wr * 64 + fr, col0 = u.pn * 256 + wc * 32 + 4 * fq;
        f32x4 r[3][4];
#define EOR_LOAD(S, IT) do { const int row_ = row0 + ((IT) >> 2) * 128 + ((IT) & 3) * 16; \
            const float* xr_ = (row_ < T_P) ? xin_p + (size_t)row_ * 1024 : xin_s + (size_t)(row_ - T_P) * 1024; \
            r[S][0] = *(const f32x4*)(xr_ + col0); r[S][1] = *(const f32x4*)(xr_ + col0 + 16); r[S][2] = *(const f32x4*)(xr_ + col0 + 128); r[S][3] = *(const f32x4*)(xr_ + col0 + 144); } while (0)
        EOR_LOAD(0, 0); EOR_LOAD(1, 1);
#pragma unroll
        for (int it = 0; it < 8; ++it) {
            if (it + 2 < 8) { if ((it + 2) % 3 == 0) EOR_LOAD(0, it + 2); else if ((it + 2) % 3 == 1) EOR_LOAD(1, it + 2); else EOR_LOAD(2, it + 2); }
            const int ai = it >> 2, m = it & 3;
            const int row = row0 + ai * 128 + m * 16;
            float ss = 0.f;
#pragma unroll
            for (int bj = 0; bj < 2; ++bj)
#pragma unroll
                for (int n = 0; n < 2; ++n) {
                    const int col = col0 + bj * 128 + n * 16;
                    const f32x4 v = acc[ai][bj][m][n] + r[it % 3][bj * 2 + n];
                    if (!WRITE_BF) *(f32x4*)(xo + (size_t)row * 1024 + col) = v;
                    if (WRITE_BF) { u32x2 w; w.x = cvt_pk_bf16(v[0], v[1]); w.y = cvt_pk_bf16(v[2], v[3]); *(u32x2*)(xb + (size_t)row * 1024 + col) = w; }
                    ss += v[0] * v[0] + v[1] * v[1] + v[2] * v[2] + v[3] * v[3];
                }
            ss += __shfl_xor(ss, 16); ss += __shfl_xor(ss, 32);
            if (fq == 0) atomicAdd(rowsq + row, ss);
        }
#undef EOR_LOAD
    }
};

struct EpiOutResB {
    static constexpr bool PERM = false;
    bf16_t* xb; float* rowsq;
    __device__ __forceinline__ void operator()(const AccT& acc, const pg8::Unit& u, int wr, int wc, int fr, int fq) const {
        const int row0 = u.pm * 256 + wr * 64 + fr, col0 = u.pn * 256 + wc * 32 + 4 * fq;
        u32x2 r[3][4];
#define EOB_LOAD(S, IT) do { const bf16_t* xr_ = xb + (size_t)(row0 + ((IT) >> 2) * 128 + ((IT) & 3) * 16) * 1024 + col0; \
            r[S][0] = *(const u32x2*)(xr_); r[S][1] = *(const u32x2*)(xr_ + 16); r[S][2] = *(const u32x2*)(xr_ + 128); r[S][3] = *(const u32x2*)(xr_ + 144); } while (0)
        EOB_LOAD(0, 0); EOB_LOAD(1, 1);
#pragma unroll
        for (int it = 0; it < 8; ++it) {
            if (it + 2 < 8) { if ((it + 2) % 3 == 0) EOB_LOAD(0, it + 2); else if ((it + 2) % 3 == 1) EOB_LOAD(1, it + 2); else EOB_LOAD(2, it + 2); }
            const int ai = it >> 2, m = it & 3;
            const int row = row0 + ai * 128 + m * 16;
            float ss = 0.f;
#pragma unroll
            for (int bj = 0; bj < 2; ++bj)
#pragma unroll
                for (int n = 0; n < 2; ++n) {
                    const int col = col0 + bj * 128 + n * 16;
                    const u32x2 rw = r[it % 3][bj * 2 + n];
                    f32x4 v = acc[ai][bj][m][n];
                    v[0] += bflo(rw.x); v[1] += bfhi(rw.x); v[2] += bflo(rw.y); v[3] += bfhi(rw.y);
                    u32x2 w; w.x = cvt_pk_bf16(v[0], v[1]); w.y = cvt_pk_bf16(v[2], v[3]);
                    *(u32x2*)(xb + (size_t)row * 1024 + col) = w;
                    ss += v[0] * v[0] + v[1] * v[1] + v[2] * v[2] + v[3] * v[3];
                }
            ss += __shfl_xor(ss, 16); ss += __shfl_xor(ss, 32);
            if (fq == 0) atomicAdd(rowsq + row, ss);
        }
#undef EOB_LOAD
    }
};

struct EpiInOdd {
    static constexpr bool PERM = true;
    bf16_t* z2; const float* rowsq;
    __device__ __forceinline__ void operator()(const AccT& acc, const pg8::Unit& u, int wr, int wc, int fr, int fq) const {
        const int row0 = u.pm * 256 + wr * 64 + fr, col0 = u.pn * 256 + wc * 32 + 8 * fq;
        float rsv[8];
#pragma unroll
        for (int it = 0; it < 8; ++it) rsv[it] = rowsq[row0 + (it >> 2) * 128 + (it & 3) * 16];
#pragma unroll
        for (int ai = 0; ai < 2; ++ai)
#pragma unroll
            for (int m = 0; m < 4; ++m) {
                const int row = row0 + ai * 128 + m * 16; const float rs = rsqrtf(rsv[ai * 4 + m] * (1.f / 1024.f) + EPS);
#pragma unroll
                for (int bj = 0; bj < 2; ++bj) {
                    const f32x4 v0 = acc[ai][bj][m][0] * rs, v1 = acc[ai][bj][m][1] * rs;
                    u32x4 w; w.x = cvt_pk_bf16(v0[0], v0[1]); w.y = cvt_pk_bf16(v0[2], v0[3]); w.z = cvt_pk_bf16(v1[0], v1[1]); w.w = cvt_pk_bf16(v1[2], v1[3]);
                    *(u32x4*)(z2 + (size_t)row * 3072 + col0 + bj * 128) = w;
                }
            }
    }
};

struct EpiPartial {
    static constexpr bool PERM = false;
    float* P;
    __device__ __forceinline__ void operator()(const AccT& acc, const pg8::Unit& u, int wr, int wc, int fr, int fq) const {
        float* base = P + (size_t)u.aux * 65536 + (size_t)(wr * 64 + fr) * 256 + wc * 32 + 4 * fq;
#pragma unroll
        for (int ai = 0; ai < 2; ++ai)
#pragma unroll
            for (int m = 0; m < 4; ++m)
#pragma unroll
                for (int bj = 0; bj < 2; ++bj)
#pragma unroll
                    for (int n = 0; n < 2; ++n) *(f32x4*)(base + (size_t)(ai * 128 + m * 16) * 256 + bj * 128 + n * 16) = acc[ai][bj][m][n];
    }
};
__device__ __forceinline__ void splitk_reduce(const pg8::StaticOrder& S, int first, int nsl, const float* P, bf16_t* xb, float* rowsq) {
    const int lane = threadIdx.x & 63;
    const int gw = (int)((blockIdx.x * NTHR + threadIdx.x) >> 6), nw = (int)((gridDim.x * NTHR) >> 6);
    for (int ri = gw; ri < 32 * 256; ri += nw) {
        const int ui = ri >> 8, r = ri & 255;
        pg8::Unit u; S.map(first + ui, u);
        const int row = u.pm * 256 + r, col = u.pn * 256 + lane * 4;
        const u32x2 rw = *(const u32x2*)(xb + (size_t)row * 1024 + col);
        f32x4 v = {bflo(rw.x), bfhi(rw.x), bflo(rw.y), bfhi(rw.y)};
        for (int sl = 0; sl < nsl; ++sl) v += *(const f32x4*)(P + ((size_t)(sl * 32 + ui) * 256 + r) * 256 + lane * 4);
        u32x2 w; w.x = cvt_pk_bf16(v[0], v[1]); w.y = cvt_pk_bf16(v[2], v[3]);
        *(u32x2*)(xb + (size_t)row * 1024 + col) = w;
        float ss = v[0] * v[0] + v[1] * v[1] + v[2] * v[2] + v[3] * v[3];
#pragma unroll
        for (int o = 32; o >= 1; o >>= 1) ss += __shfl_xor(ss, o);
        if (lane == 0) atomicAdd(rowsq + row, ss);
    }
}

template <int MODE>
__device__ __forceinline__ void transpose_w(const float* __restrict__ src, int K, int Nsrc, bf16_t* __restrict__ dst, int Ndst, const float* __restrict__ gain, long gtid, long gsz) {
    const long total = (long)(K / 8) * Ndst;
#pragma unroll 4
    for (long it = gtid; it < total; it += gsz) {
        const int n = (int)(it % Ndst), k8 = (int)(it / Ndst);
        int sc = n;
        if (MODE == 1) { if (n < 3584) sc = n; else sc = n + 16; }
        u32x4 w = {0u, 0u, 0u, 0u};
        if (sc >= 0) {
            const float* s = src + (size_t)(k8 * 8) * Nsrc + sc;
            float v0 = s[0], v1 = s[(size_t)Nsrc], v2 = s[(size_t)2 * Nsrc], v3 = s[(size_t)3 * Nsrc], v4 = s[(size_t)4 * Nsrc], v5 = s[(size_t)5 * Nsrc], v6 = s[(size_t)6 * Nsrc], v7 = s[(size_t)7 * Nsrc];
            if (gain) { const f32x4 g0 = *(const f32x4*)(gain + k8 * 8), g1 = *(const f32x4*)(gain + k8 * 8 + 4); v0 *= g0[0]; v1 *= g0[1]; v2 *= g0[2]; v3 *= g0[3]; v4 *= g1[0]; v5 *= g1[1]; v6 *= g1[2]; v7 *= g1[3]; }
            w.x = cvt_pk_bf16(v0, v1); w.y = cvt_pk_bf16(v2, v3); w.z = cvt_pk_bf16(v4, v5); w.w = cvt_pk_bf16(v6, v7);
        }
        *(u32x4*)(dst + (size_t)n * K + k8 * 8) = w;
    }
}

__device__ __forceinline__ void phase0(const Params& p) {
    unsigned char* ws = p.ws;
    const long gtid = (long)blockIdx.x * NTHR + threadIdx.x, gsz = (long)gridDim.x * NTHR;
    transpose_w<1>(p.in[8], 1024, 5648, (bf16_t*)(ws + WS_WINE), 5632, p.in[7], gtid, gsz);
    for (long it = gtid; it < 128L * 512; it += gsz) {
        const int n = (int)(it & 511), k8 = (int)(it >> 9);
        float wl[16];
#pragma unroll
        for (int r = 0; r < 16; ++r) wl[r] = p.in[9][r * 512 + n];
        float v[8];
#pragma unroll
        for (int i = 0; i < 8; ++i) {
            const float* wr_ = p.in[8] + (size_t)(k8 * 8 + i) * 5648 + 3584;
            float a = 0.f;
#pragma unroll
            for (int r4 = 0; r4 < 4; ++r4) { const f32x4 x = *(const f32x4*)(wr_ + r4 * 4); a += x[0] * wl[r4 * 4] + x[1] * wl[r4 * 4 + 1] + x[2] * wl[r4 * 4 + 2] + x[3] * wl[r4 * 4 + 3]; }
            v[i] = a * p.in[7][k8 * 8 + i];
        }
        u32x4 w; w.x = cvt_pk_bf16(v[0], v[1]); w.y = cvt_pk_bf16(v[2], v[3]); w.z = cvt_pk_bf16(v[4], v[5]); w.w = cvt_pk_bf16(v[6], v[7]);
        *(u32x4*)((bf16_t*)(ws + WS_WINE) + (size_t)(5632 + n) * 1024 + k8 * 8) = w;
    }
    transpose_w<0>(p.in[13], 2048, 1024, (bf16_t*)(ws + WS_WOUTE), 1024, nullptr, gtid, gsz);
    transpose_w<0>(p.in[15], 1024, 3072, (bf16_t*)(ws + WS_WINO), 3072, p.in[14], gtid, gsz);
    transpose_w<0>(p.in[23], 1536, 1024, (bf16_t*)(ws + WS_WOUTO), 1024, nullptr, gtid, gsz);
    for (int nb = 0; nb < 8; ++nb) {
        transpose_w<0>(p.in[18] + nb * 192 * 192, 192, 192, (bf16_t*)(ws + WS_WA) + nb * 192 * 192, 192, nullptr, gtid, gsz);
        transpose_w<0>(p.in[20] + nb * 192 * 192, 192, 192, (bf16_t*)(ws + WS_WI) + nb * 192 * 192, 192, nullptr, gtid, gsz);
    }
    { float* z = (float*)(ws + WS_RSQ1); const long nz = (long)T * 2; for (long i = gtid; i < nz; i += gsz) z[i] = 0.f; }
    const int lane = threadIdx.x & 63; const int gw = (int)(gtid >> 6), nw = (int)(gsz >> 6);
    bf16_t* xb = (bf16_t*)(ws + WS_XB); float* rstd = (float*)(ws + WS_RSTD0);
#pragma unroll 4
    for (int row = gw; row < T; row += nw) {
        const float* xr = (row < T_P) ? p.in[0] + (size_t)row * 1024 : p.in[1] + (size_t)(row - T_P) * 1024;
        float ss = 0.f;
#pragma unroll
        for (int i = 0; i < 4; ++i) {
            const f32x4 v = *(const f32x4*)(xr + i * 256 + lane * 4);
            ss += v[0] * v[0] + v[1] * v[1] + v[2] * v[2] + v[3] * v[3];
            u32x2 w; w.x = cvt_pk_bf16(v[0], v[1]); w.y = cvt_pk_bf16(v[2], v[3]);
            *(u32x2*)(xb + (size_t)row * 1024 + i * 256 + lane * 4) = w;
        }
#pragma unroll
        for (int o = 32; o >= 1; o >>= 1) ss += __shfl_xor(ss, o);
        if (lane == 0) rstd[row] = rsqrtf(ss * (1.f / 1024.f) + EPS);
    }
}

__device__ __forceinline__ void attn_item(const Params& p, LAS unsigned char* L, int item, bf16_t* Yd, int ldd) {
    unsigned char* ws = p.ws;
    const int tid = threadIdx.x, lane = tid & 63, w = tid >> 6, r16 = lane & 15, q4 = lane >> 4;
    LAS bf16_t* Ks = (LAS bf16_t*)L;
    LAS bf16_t* Vs = (LAS bf16_t*)(L + 192 * 72 * 2);
    const unsigned vbase = (unsigned)(size_t)L + 192u * 72u * 2u;
    const bf16_t* Qb = (const bf16_t*)(ws + WS_Q); const bf16_t* Kb = (const bf16_t*)(ws + WS_K); const bf16_t* Vb = (const bf16_t*)(ws + WS_V);
    const bf16_t* Yb = (const bf16_t*)(ws + WS_GATE);
    const bool smp = item >= 2048;
    int b, c, kh; size_t row0;
    if (!smp) { kh = item & 3; c = (item >> 2) & 31; b = item >> 7; row0 = (size_t)b * 2048 + c * 64; }
    else { const int i2 = item - 2048; kh = i2 & 3; b = i2 >> 2; c = 0; row0 = (size_t)T_P + b * 64; }
    const int g = w >> 1, i0 = (w & 1) * 32, h = kh * 4 + g;
    bf16x8 qf[2][2];
#pragma unroll
    for (int qt = 0; qt < 2; ++qt) {
#pragma unroll
        for (int ks = 0; ks < 2; ++ks) qf[qt][ks] = *(const bf16x8*)(Qb + (row0 + i0 + qt * 16 + r16) * 1024 + h * 64 + ks * 32 + q4 * 8);
    }
#pragma unroll
    for (int i = 0; i < 3; ++i) {
        const int idx = tid + i * 512, key = idx >> 3, dg = idx & 7;
        u32x4 kv = {0u, 0u, 0u, 0u}, vv = {0u, 0u, 0u, 0u};
        if (!smp) {
            const int pos = c * 64 - 128 + key;
            if (pos >= 0) { const size_t r = (size_t)b * 2048 + pos; kv = *(const u32x4*)(Kb + r * 256 + kh * 64 + dg * 8); vv = *(const u32x4*)(Vb + r * 256 + kh * 64 + dg * 8); }
        } else {
            if (key < 128) {
                const size_t o = ((size_t)(b * 128 + key) * 4 + kh) * 64 + dg * 8;
                const f32x4 k0 = *(const f32x4*)(p.in[2] + o), k1 = *(const f32x4*)(p.in[2] + o + 4), v0 = *(const f32x4*)(p.in[3] + o), v1 = *(const f32x4*)(p.in[3] + o + 4);
                kv.x = cvt_pk_bf16(k0[0], k0[1]); kv.y = cvt_pk_bf16(k0[2], k0[3]); kv.z = cvt_pk_bf16(k1[0], k1[1]); kv.w = cvt_pk_bf16(k1[2], k1[3]);
                vv.x = cvt_pk_bf16(v0[0], v0[1]); vv.y = cvt_pk_bf16(v0[2], v0[3]); vv.z = cvt_pk_bf16(v1[0], v1[1]); vv.w = cvt_pk_bf16(v1[2], v1[3]);
            } else { const size_t r = (size_t)T_P + b * 64 + key - 128; kv = *(const u32x4*)(Kb + r * 256 + kh * 64 + dg * 8); vv = *(const u32x4*)(Vb + r * 256 + kh * 64 + dg * 8); }
        }
        *(LAS u32x4*)(Ks + key * 72 + dg * 8) = kv;
        *(LAS u32x4*)(Vs + key * 72 + dg * 8) = vv;
    }
    __syncthreads();
    const float slope = exp2f(-0.5f * (float)(h + 1)) * 1.4426950408889634f;
    const float sink = p.in[11][h] * 1.4426950408889634f;
    const unsigned va = vbase + (unsigned)(((q4 * 4 + (r16 >> 2)) * 72 + 4 * (r16 & 3)) * 2);
#pragma unroll 1
    for (int qt = 0; qt < 2; ++qt) {
        const int i = i0 + qt * 16 + r16;
        const bf16x8 qa = qt ? qf[1][0] : qf[0][0], qb = qt ? qf[1][1] : qf[0][1];
        u32x2 gv[4];
#pragma unroll
        for (int dt = 0; dt < 4; ++dt) gv[dt] = *(const u32x2*)(Yb + (row0 + i) * 2048 + h * 64 + dt * 16 + q4 * 4);
        f32x4 sacc[12];
#pragma unroll
        for (int kt = 0; kt < 12; ++kt) {
            const bf16x8 kf0 = *(const LAS bf16x8*)(Ks + (kt * 16 + r16) * 72 + q4 * 8), kf1 = *(const LAS bf16x8*)(Ks + (kt * 16 + r16) * 72 + 32 + q4 * 8);
            f32x4 a = {0.f, 0.f, 0.f, 0.f}; a = MFMA16(kf0, qa, a); a = MFMA16(kf1, qb, a); sacc[kt] = a;
        }
        const float dbase = (float)(128 + i - q4 * 4);
#pragma unroll
        for (int kt = 0; kt < 12; ++kt)
#pragma unroll
            for (int jj = 0; jj < 4; ++jj) sacc[kt][jj] = fmaf(-slope, fabsf(dbase - (float)(kt * 16 + jj)), sacc[kt][jj]);
        if (!smp && c < 2) {
#pragma unroll
            for (int kt = 0; kt < 8; ++kt)
#pragma unroll
                for (int jj = 0; jj < 4; ++jj) { const int j = kt * 16 + q4 * 4 + jj; if ((c * 64 - 128 + j) < 0) sacc[kt][jj] = -1e30f; }
        }
        float m = -3e38f;
#pragma unroll
        for (int kt = 0; kt < 12; ++kt)
#pragma unroll
            for (int jj = 0; jj < 4; ++jj) m = fmaxf(m, sacc[kt][jj]);
        m = fmaxf(m, __shfl_xor(m, 16)); m = fmaxf(m, __shfl_xor(m, 32)); m = fmaxf(m, sink);
        float l = 0.f;
#pragma unroll
        for (int kt = 0; kt < 12; ++kt)
#pragma unroll
            for (int jj = 0; jj < 4; ++jj) { const float pr = __builtin_amdgcn_exp2f(sacc[kt][jj] - m); sacc[kt][jj] = pr; l += pr; }
        l += __shfl_xor(l, 16); l += __shfl_xor(l, 32); l += __builtin_amdgcn_exp2f(sink - m);
        const float inv = 1.f / l;
        f32x4 oacc[4];
#pragma unroll
        for (int dt = 0; dt < 4; ++dt) oacc[dt] = (f32x4){0.f, 0.f, 0.f, 0.f};
#pragma unroll
        for (int kb = 0; kb < 6; ++kb) {
            const bf16x8 pf = pack8(sacc[2 * kb], sacc[2 * kb + 1]);
            bf16x4 l0, h0, l1, h1, l2, h2, l3, h3;
            const unsigned vk = va + (unsigned)(kb * 32 * 144);
            asm volatile("ds_read_b64_tr_b16 %0, %8\n\tds_read_b64_tr_b16 %1, %8 offset:2304\n\t"
                         "ds_read_b64_tr_b16 %2, %8 offset:32\n\tds_read_b64_tr_b16 %3, %8 offset:2336\n\t"
                         "ds_read_b64_tr_b16 %4, %8 offset:64\n\tds_read_b64_tr_b16 %5, %8 offset:2368\n\t"
                         "ds_read_b64_tr_b16 %6, %8 offset:96\n\tds_read_b64_tr_b16 %7, %8 offset:2400\n\t"
                         "s_waitcnt lgkmcnt(0)"
                         : "=&v"(l0), "=&v"(h0), "=&v"(l1), "=&v"(h1), "=&v"(l2), "=&v"(h2), "=&v"(l3), "=&v"(h3) : "v"(vk) : "memory");
            oacc[0] = MFMA16(cat4(l0, h0), pf, oacc[0]); oacc[1] = MFMA16(cat4(l1, h1), pf, oacc[1]);
            oacc[2] = MFMA16(cat4(l2, h2), pf, oacc[2]); oacc[3] = MFMA16(cat4(l3, h3), pf, oacc[3]);
        }
#pragma unroll
        for (int dt = 0; dt < 4; ++dt) {
            const u32x2 gq = gv[dt];
            const f32x4 o = oacc[dt] * inv;
            u32x2 wv; wv.x = cvt_pk_bf16(o[0] * siluf(bflo(gq.x)), o[1] * siluf(bfhi(gq.x))); wv.y = cvt_pk_bf16(o[2] * siluf(bflo(gq.y)), o[3] * siluf(bfhi(gq.y)));
            *(u32x2*)(Yd + (row0 + i) * ldd + h * 64 + dt * 16 + q4 * 4) = wv;
        }
    }
    __syncthreads();
}

constexpr size_t SC_SQ = 0;
constexpr size_t SC_ET = 9437184;
constexpr size_t SC_AB = 16777216;
static_assert(SC_AB + (size_t)T * 256 * 2 <= (size_t)T * 1024 * 4, "scratch must fit in the y region of d_out");

struct PrepRegs { u32x4 g0, g1, q0, q1, k0, k1; };
__device__ __forceinline__ unsigned prep_row0(int item, int& h) {
    if (item < 2048) { h = item & 3; const int c = (item >> 2) & 31; const int b = item >> 7; return (unsigned)b * 2048 + c * 64; }
    const int i2 = item - 2048; h = i2 & 3; return (unsigned)T_P + (i2 >> 2) * 64;
}
__device__ __forceinline__ void prep_load(const Params& p, int item, PrepRegs& R) {
    const int tid = threadIdx.x; int h; const unsigned row0 = prep_row0(item, h);
    const bf16_t* BQ = (const bf16_t*)(p.ws + WS_BQ); const bf16_t* BKb = (const bf16_t*)(p.ws + WS_BK); const bf16_t* GB = (const bf16_t*)(p.ws + WS_BLR);
    const int pt0 = tid >> 4, pt1 = (tid + 512) >> 4, poc = tid & 15;
    const unsigned o0 = (row0 + pt0) * 512u + h * 128 + poc * 8, o1 = (row0 + pt1) * 512u + h * 128 + poc * 8;
    R.g0 = *(const u32x4*)(GB + o0); R.g1 = *(const u32x4*)(GB + o1);
    R.q0 = *(const u32x4*)(BQ + o0); R.q1 = *(const u32x4*)(BQ + o1); R.k0 = *(const u32x4*)(BKb + o0); R.k1 = *(const u32x4*)(BKb + o1);
}
__device__ __forceinline__ void gla_prep_item(const Params& p, LAS unsigned char* L, int item, const PrepRegs& cur, int next_item, PrepRegs& nxt) {
    unsigned char* ws = p.ws;
    const int tid = threadIdx.x, lane = tid & 63, w = tid >> 6, r16 = lane & 15, q4 = lane >> 4;
    LAS bf16_t* QG = (LAS bf16_t*)L;
    LAS bf16_t* KG = (LAS bf16_t*)(L + 17408);
    LAS bf16_t* Gs = (LAS bf16_t*)(L + 34816);
    LAS float* Gf = (LAS float*)(L + 52224);
    LAS float* GT = (LAS float*)(L + 84992);
    int h; const unsigned row0 = prep_row0(item, h);
    bf16_t* BQ = (bf16_t*)(ws + WS_BQ); bf16_t* BKb = (bf16_t*)(ws + WS_BK);
    float* ET = (float*)((unsigned char*)p.out + SC_ET); bf16_t* AB = (bf16_t*)((unsigned char*)p.out + SC_AB);
    const int c = tid & 127, tg = tid >> 7;
    const int pt0 = tid >> 4, pt1 = (tid + 512) >> 4, poc = tid & 15;
    const unsigned o0 = (row0 + pt0) * 512u + h * 128 + poc * 8, o1 = (row0 + pt1) * 512u + h * 128 + poc * 8;
    const u32x4 pq0 = cur.q0, pq1 = cur.q1, pk0 = cur.k0, pk1 = cur.k1;
    *(LAS u32x4*)(Gs + pt0 * 136 + poc * 8) = cur.g0; *(LAS u32x4*)(Gs + pt1 * 136 + poc * 8) = cur.g1;
    lds_barrier();
    if (next_item >= 0) prep_load(p, next_item, nxt);
    {
        float cs = 0.f;
#pragma unroll
        for (int tt = 0; tt < 16; ++tt) { cs += bf2f(Gs[(tg * 16 + tt) * 136 + c]); Gf[(tg * 16 + tt) * 128 + c] = cs; }
        GT[tg * 128 + c] = cs;
    }
    lds_barrier();
#pragma unroll
    for (int i = 0; i < 2; ++i) {
        const int t = i ? pt1 : pt0; const int tgp = t >> 4;
        const u32x4 qw = i ? pq1 : pq0, kw = i ? pk1 : pk0;
        float G[8], tot[8];
        { const f32x4 a0 = *(const LAS f32x4*)(Gf + t * 128 + poc * 8), a1 = *(const LAS f32x4*)(Gf + t * 128 + poc * 8 + 4);
          G[0] = a0[0]; G[1] = a0[1]; G[2] = a0[2]; G[3] = a0[3]; G[4] = a1[0]; G[5] = a1[1]; G[6] = a1[2]; G[7] = a1[3]; }
#pragma unroll
        for (int j = 0; j < 8; ++j) tot[j] = 0.f;
#pragma unroll
        for (int g2 = 0; g2 < 4; ++g2) {
            const f32x4 a0 = *(const LAS f32x4*)(GT + g2 * 128 + poc * 8), a1 = *(const LAS f32x4*)(GT + g2 * 128 + poc * 8 + 4);
            const float sel = (g2 < tgp) ? 1.f : 0.f;
            G[0] += sel * a0[0]; G[1] += sel * a0[1]; G[2] += sel * a0[2]; G[3] += sel * a0[3]; G[4] += sel * a1[0]; G[5] += sel * a1[1]; G[6] += sel * a1[2]; G[7] += sel * a1[3];
            tot[0] += a0[0]; tot[1] += a0[1]; tot[2] += a0[2]; tot[3] += a0[3]; tot[4] += a1[0]; tot[5] += a1[1]; tot[6] += a1[2]; tot[7] += a1[3];
        }
        if (i == 0 && tid < 16) {
            float* ep = ET + (size_t)(row0 >> 6) * 512 + h * 128 + poc * 8;
            *(f32x4*)ep = (f32x4){__expf(tot[0]), __expf(tot[1]), __expf(tot[2]), __expf(tot[3])};
            *(f32x4*)(ep + 4) = (f32x4){__expf(tot[4]), __expf(tot[5]), __expf(tot[6]), __expf(tot[7])};
        }
        float qv[8], kv[8];
        unpack8(qw, qv); unpack8(kw, kv);
#pragma unroll
        for (int j = 0; j < 8; ++j) { const float eg = __expf(G[j]); qv[j] *= eg; kv[j] *= rcpf_(eg); }
        u32x4 qo, ko;
        qo.x = cvt_pk_bf16(qv[0], qv[1]); qo.y = cvt_pk_bf16(qv[2], qv[3]); qo.z = cvt_pk_bf16(qv[4], qv[5]); qo.w = cvt_pk_bf16(qv[6], qv[7]);
        ko.x = cvt_pk_bf16(kv[0], kv[1]); ko.y = cvt_pk_bf16(kv[2], kv[3]); ko.z = cvt_pk_bf16(kv[4], kv[5]); ko.w = cvt_pk_bf16(kv[6], kv[7]);
        *(LAS u32x4*)(QG + t * 136 + poc * 8) = qo; *(LAS u32x4*)(KG + t * 136 + poc * 8) = ko;
        *(u32x4*)(BQ + (i ? o1 : o0)) = qo; *(u32x4*)(BKb + (i ? o1 : o0)) = ko;
    }
    lds_barrier();
    {
        const int it = w >> 1, jt0 = (w & 1) * 2;
        f32x4 at[2];
        at[0] = (f32x4){0.f, 0.f, 0.f, 0.f}; at[1] = (f32x4){0.f, 0.f, 0.f, 0.f};
#pragma unroll
        for (int ks = 0; ks < 4; ++ks) {
            const bf16x8 qf = *(const LAS bf16x8*)(QG + (it * 16 + r16) * 136 + ks * 32 + q4 * 8);
#pragma unroll
            for (int t2 = 0; t2 < 2; ++t2) {
                const bf16x8 kf = *(const LAS bf16x8*)(KG + ((jt0 + t2) * 16 + r16) * 136 + ks * 32 + q4 * 8);
                at[t2] = MFMA16(kf, qf, at[t2]);
            }
        }
        const int i = it * 16 + r16;
#pragma unroll
        for (int t2 = 0; t2 < 2; ++t2) {
            f32x4 v = at[t2];
#pragma unroll
            for (int jj = 0; jj < 4; ++jj) { const int j = (jt0 + t2) * 16 + q4 * 4 + jj; if (j > i) v[jj] = 0.f; }
            u32x2 wv; wv.x = cvt_pk_bf16(v[0], v[1]); wv.y = cvt_pk_bf16(v[2], v[3]);
            *(u32x2*)(AB + (size_t)(row0 + i) * 256 + h * 64 + (jt0 + t2) * 16 + q4 * 4) = wv;
        }
    }
    lds_barrier();
}

__device__ __forceinline__ void gla_scan_item(const Params& p, LAS unsigned char* L, int item, bool dummy) {
    unsigned char* ws = p.ws;
    const int tid = threadIdx.x, lane = tid & 63, w = tid >> 6, r16 = lane & 15, q4 = lane >> 4;
    LAS bf16_t* QG = (LAS bf16_t*)L;
    LAS bf16_t* KG = (LAS bf16_t*)(L + 17408);
    LAS bf16_t* Vs = (LAS bf16_t*)(L + 34816);
    LAS bf16_t* As = (LAS bf16_t*)(L + 44032);
    LAS float* GL = (LAS float*)(L + 53248);
    const unsigned lbase = (unsigned)(size_t)L;
    const bool smp = item >= 256;
    const int i2 = smp ? item - 256 : item;
    const int b = i2 >> 4, h = (i2 >> 2) & 3, sl = i2 & 3, e0 = sl * 64;
    const int nch = smp ? 1 : 32;
    const unsigned rbase = smp ? (unsigned)T_P + b * 64 : (unsigned)b * 2048;
    const bf16_t* BQ = (const bf16_t*)(ws + WS_BQ); const bf16_t* BKb = (const bf16_t*)(ws + WS_BK); bf16_t* BV = (bf16_t*)(ws + WS_BV);
    const float* ET = (const float*)((unsigned char*)p.out + SC_ET); const bf16_t* AB = (const bf16_t*)((unsigned char*)p.out + SC_AB); float* BOSQP = dummy ? p.out + 20000000 : (float*)((unsigned char*)p.out + SC_SQ);
    bf16_t* BVo = dummy ? (bf16_t*)((unsigned char*)p.out + 67108864) : BV;
    const int pt0 = tid >> 4, pt1 = (tid + 512) >> 4, poc = tid & 15;
    const int vt = tid >> 3, veo = tid & 7;
    const int et = w & 3, ip = w >> 2;
    f32x4 Sacc[8];
#pragma unroll
    for (int d8 = 0; d8 < 8; ++d8) {
        if (smp) {
#pragma unroll
            for (int jj = 0; jj < 4; ++jj) Sacc[d8][jj] = p.in[4][((size_t)(b * 4 + h) * 128 + d8 * 16 + q4 * 4 + jj) * 256 + e0 + et * 16 + r16];
        } else Sacc[d8] = (f32x4){0.f, 0.f, 0.f, 0.f};
    }
    const int tq_ = r16 >> 2, tp_ = r16 & 3;
    const unsigned v4a = lbase + 34816u + (unsigned)(((q4 * 8 + tq_) * 72 + et * 16 + 4 * tp_) * 2);
    const unsigned k4a = lbase + 17408u + (unsigned)(((q4 * 8 + tq_) * 136 + 4 * tp_) * 2);
    struct Pre { u32x4 q0, q1, k0, k1, a, v; f32x4 e; };
    Pre PA, PB;
    PA.e = (f32x4){0.f, 0.f, 0.f, 0.f}; PB.e = (f32x4){0.f, 0.f, 0.f, 0.f};
#define GLA_PREFETCH(P, R) do { \
        const unsigned o0_ = ((R) + pt0) * 512u + h * 128 + poc * 8, o1_ = ((R) + pt1) * 512u + h * 128 + poc * 8; \
        P.q0 = *(const u32x4*)(BQ + o0_); P.q1 = *(const u32x4*)(BQ + o1_); P.k0 = *(const u32x4*)(BKb + o0_); P.k1 = *(const u32x4*)(BKb + o1_); \
        P.a = *(const u32x4*)(AB + ((R) + vt) * 256u + h * 64 + veo * 8); \
        P.v = *(const u32x4*)(BV + ((R) + vt) * 1024u + h * 256 + e0 + veo * 8); \
        if (tid < 32) P.e = *(const f32x4*)(ET + ((R) >> 6) * 512u + h * 128 + tid * 4); } while (0)
    GLA_PREFETCH(PA, rbase);
    if (nch > 1) GLA_PREFETCH(PB, rbase + 64);
    f32x4 po0 = {0.f, 0.f, 0.f, 0.f}, po1 = {0.f, 0.f, 0.f, 0.f}; unsigned prow = 0; bool pend = false;
#define GLA_STORE_OUT() do { \
            _Pragma("unroll") for (int x2 = 0; x2 < 2; ++x2) { \
                const unsigned row = prow + (ip * 2 + x2) * 16 + r16; \
                const f32x4 o = x2 ? po1 : po0; \
                u32x2 wv; wv.x = cvt_pk_bf16(o[0], o[1]); wv.y = cvt_pk_bf16(o[2], o[3]); \
                *(u32x2*)(BVo + row * 1024u + h * 256 + e0 + et * 16 + q4 * 4) = wv; \
                float ss = o[0] * o[0] + o[1] * o[1] + o[2] * o[2] + o[3] * o[3]; \
                ss += __shfl_xor(ss, 16); ss += __shfl_xor(ss, 32); \
                if (q4 == 0) BOSQP[row * 64u + h * 16 + sl * 4 + et] = ss; \
            } } while (0)
#define GLA_CHUNK(P, CI) do { \
        const unsigned r0 = rbase + (unsigned)(CI) * 64; \
        *(LAS u32x4*)(QG + pt0 * 136 + poc * 8) = P.q0; *(LAS u32x4*)(QG + pt1 * 136 + poc * 8) = P.q1; \
        *(LAS u32x4*)(KG + pt0 * 136 + poc * 8) = P.k0; *(LAS u32x4*)(KG + pt1 * 136 + poc * 8) = P.k1; \
        *(LAS u32x4*)(As + vt * 72 + veo * 8) = P.a; *(LAS u32x4*)(Vs + vt * 72 + veo * 8) = P.v; \
        if (tid < 32) *(LAS f32x4*)(GL + tid * 4) = P.e; \
        lds_barrier(); \
        if (pend) GLA_STORE_OUT(); \
        if ((CI) + 2 < nch) GLA_PREFETCH(P, r0 + 128); \
        bf16x8 vf[2]; \
        { bf16x4 a0, a1, b0, b1; \
          asm volatile("ds_read_b64_tr_b16 %0, %4\n\tds_read_b64_tr_b16 %1, %4 offset:576\n\tds_read_b64_tr_b16 %2, %4 offset:4608\n\tds_read_b64_tr_b16 %3, %4 offset:5184\n\ts_waitcnt lgkmcnt(0)" \
                       : "=&v"(a0), "=&v"(a1), "=&v"(b0), "=&v"(b1) : "v"(v4a) : "memory"); \
          vf[0] = cat4(a0, a1); vf[1] = cat4(b0, b1); } \
        f32x4 ot[2]; \
        ot[0] = (f32x4){0.f, 0.f, 0.f, 0.f}; ot[1] = (f32x4){0.f, 0.f, 0.f, 0.f}; \
        _Pragma("unroll") for (int x2 = 0; x2 < 2; ++x2) \
            _Pragma("unroll") for (int jb = 0; jb < 2; ++jb) { \
                const bf16x8 af = *(const LAS bf16x8*)(As + ((ip * 2 + x2) * 16 + r16) * 72 + jb * 32 + q4 * 8); \
                ot[x2] = MFMA16(vf[jb], af, ot[x2]); } \
        _Pragma("unroll") for (int db = 0; db < 4; ++db) { \
            const bf16x8 sf = pack8(Sacc[2 * db], Sacc[2 * db + 1]); \
            _Pragma("unroll") for (int x2 = 0; x2 < 2; ++x2) { \
                const LAS bf16_t* qp = QG + ((ip * 2 + x2) * 16 + r16) * 136 + db * 32 + q4 * 4; \
                const bf16x8 qv = cat4(*(const LAS bf16x4*)qp, *(const LAS bf16x4*)(qp + 16)); \
                ot[x2] = MFMA16(sf, qv, ot[x2]); } } \
        po0 = ot[0]; po1 = ot[1]; prow = r0; pend = true; \
        _Pragma("unroll") for (int jb = 0; jb < 2; ++jb) { \
            bf16x4 kl[8], kh[8]; \
            const unsigned ka = k4a + (unsigned)(jb * 32 * 272); \
            asm volatile("ds_read_b64_tr_b16 %0, %16 offset:0\n\t" "ds_read_b64_tr_b16 %1, %16 offset:1088\n\t" "ds_read_b64_tr_b16 %2, %16 offset:32\n\t" "ds_read_b64_tr_b16 %3, %16 offset:1120\n\t" "ds_read_b64_tr_b16 %4, %16 offset:64\n\t" "ds_read_b64_tr_b16 %5, %16 offset:1152\n\t" "ds_read_b64_tr_b16 %6, %16 offset:96\n\t" "ds_read_b64_tr_b16 %7, %16 offset:1184\n\t" "ds_read_b64_tr_b16 %8, %16 offset:128\n\t" "ds_read_b64_tr_b16 %9, %16 offset:1216\n\t" "ds_read_b64_tr_b16 %10, %16 offset:160\n\t" "ds_read_b64_tr_b16 %11, %16 offset:1248\n\t" "ds_read_b64_tr_b16 %12, %16 offset:192\n\t" "ds_read_b64_tr_b16 %13, %16 offset:1280\n\t" "ds_read_b64_tr_b16 %14, %16 offset:224\n\t" "ds_read_b64_tr_b16 %15, %16 offset:1312\n\t" "s_waitcnt lgkmcnt(0)" \
                         : "=&v"(kl[0]), "=&v"(kh[0]), "=&v"(kl[1]), "=&v"(kh[1]), "=&v"(kl[2]), "=&v"(kh[2]), "=&v"(kl[3]), "=&v"(kh[3]), "=&v"(kl[4]), "=&v"(kh[4]), "=&v"(kl[5]), "=&v"(kh[5]), "=&v"(kl[6]), "=&v"(kh[6]), "=&v"(kl[7]), "=&v"(kh[7]) : "v"(ka) : "memory"); \
            _Pragma("unroll") for (int d8 = 0; d8 < 8; ++d8) Sacc[d8] = MFMA16(cat4(kl[d8], kh[d8]), vf[jb], Sacc[d8]); } \
        _Pragma("unroll") for (int d8 = 0; d8 < 8; ++d8) { \
            const f32x4 dec = *(const LAS f32x4*)(GL + d8 * 16 + q4 * 4); \
            Sacc[d8] = Sacc[d8] * dec; } \
        lds_barrier(); \
    } while (0)
    for (int ci = 0; ci < nch; ci += 2) {
        GLA_CHUNK(PA, ci);
        if (ci + 1 < nch) GLA_CHUNK(PB, ci + 1);
    }
    if (pend) GLA_STORE_OUT();
#undef GLA_STORE_OUT
#undef GLA_PREFETCH
#undef GLA_CHUNK
    if (ip == 0 && !dummy) {
        float* og = p.out + (smp ? O_GS : O_GP);
#pragma unroll
        for (int d8 = 0; d8 < 8; ++d8)
#pragma unroll
            for (int jj = 0; jj < 4; ++jj) og[((size_t)(b * 4 + h) * 128 + d8 * 16 + q4 * 4 + jj) * 256 + e0 + et * 16 + r16] = Sacc[d8][jj];
    }
}

__device__ __forceinline__ void phase2a(const Params& p, LAS unsigned char* L) {
#ifndef NO_PREP
    {
        PrepRegs RA, RB; const int G = gridDim.x; int it = blockIdx.x;
        if (it < 2176) prep_load(p, it, RA);
        while (it < 2176) {
            int nx = it + G; gla_prep_item(p, L, it, RA, nx < 2176 ? nx : -1, RB); it = nx;
            if (it >= 2176) break;
            nx = it + G; gla_prep_item(p, L, it, RB, nx < 2176 ? nx : -1, RA); it = nx;
        }
    }
#endif
#ifndef NO_ATTN
    for (int it = gridDim.x - 1 - blockIdx.x; it < 2176; it += gridDim.x) attn_item(p, L, it, (bf16_t*)(p.ws + WS_GATE), 2048);
#endif
}
__device__ __forceinline__ void phase2b(const Params& p, LAS unsigned char* L) {
#ifndef NO_SCAN
#ifdef PROBE_SCAN2
    for (int it = blockIdx.x; it < 768; it += gridDim.x) gla_scan_item(p, L, it, true);
#endif
    if (gridDim.x == 256) {
        const int xcd = blockIdx.x & 7, loc = blockIdx.x >> 3;
        const int base = (xcd * 8 + (loc >> 2)) * 4 + (loc & 3);
        gla_scan_item(p, L, base, false); gla_scan_item(p, L, 256 + base, false); gla_scan_item(p, L, 512 + base, false);
    } else {
        for (int it = blockIdx.x; it < 768; it += gridDim.x) gla_scan_item(p, L, it, false);
    }
#endif
}

__device__ __forceinline__ void phase3(const Params& p) {
    unsigned char* ws = p.ws;
    const bf16_t* BV = (const bf16_t*)(ws + WS_BV); bf16_t* Yb = (bf16_t*)(ws + WS_GATE); const float* BOSQP = (const float*)((unsigned char*)p.out + SC_SQ);
    const float* gg = p.in[12];
    const long gtid = (long)blockIdx.x * NTHR + threadIdx.x, gsz = (long)gridDim.x * NTHR;
    const long total = (long)T * 128;
    for (long it = gtid; it < total; it += gsz) {
        const long row = it >> 7; const int c8 = (int)(it & 127) * 8, h = c8 >> 8;
        float sq;
        { const f32x4 s0 = *(const f32x4*)(BOSQP + row * 64 + h * 16), s1 = *(const f32x4*)(BOSQP + row * 64 + h * 16 + 4), s2 = *(const f32x4*)(BOSQP + row * 64 + h * 16 + 8), s3 = *(const f32x4*)(BOSQP + row * 64 + h * 16 + 12);
          sq = ((s0[0] + s0[1]) + (s0[2] + s0[3])) + ((s1[0] + s1[1]) + (s1[2] + s1[3])) + ((s2[0] + s2[1]) + (s2[2] + s2[3])) + ((s3[0] + s3[1]) + (s3[2] + s3[3])); }
        const float rs = rsqrtf(sq * (1.f / 256.f) + EPS);
        const u32x4 bo = *(const u32x4*)(BV + row * 1024 + c8);
        const u32x4 gt = *(const u32x4*)(Yb + row * 2048 + 1024 + c8);
        const f32x4 g0 = *(const f32x4*)(gg + (c8 & 255)), g1 = *(const f32x4*)(gg + (c8 & 255) + 4);
        u32x4 o;
        o.x = cvt_pk_bf16(bflo(bo.x) * rs * g0[0] * siluf(bflo(gt.x)), bfhi(bo.x) * rs * g0[1] * siluf(bfhi(gt.x)));
        o.y = cvt_pk_bf16(bflo(bo.y) * rs * g0[2] * siluf(bflo(gt.y)), bfhi(bo.y) * rs * g0[3] * siluf(bfhi(gt.y)));
        o.z = cvt_pk_bf16(bflo(bo.z) * rs * g1[0] * siluf(bflo(gt.z)), bfhi(bo.z) * rs * g1[1] * siluf(bfhi(gt.z)));
        o.w = cvt_pk_bf16(bflo(bo.w) * rs * g1[2] * siluf(bflo(gt.w)), bfhi(bo.w) * rs * g1[3] * siluf(bfhi(gt.w)));
        *(u32x4*)(Yb + row * 2048 + 1024 + c8) = o;
    }
}

__device__ __forceinline__ void lru_item(const Params& p, LAS unsigned char* L, int item) {
    unsigned char* ws = p.ws;
    const int tid = threadIdx.x, lane = tid & 63, w = tid >> 6, r16 = lane & 15, q4 = lane >> 4;
    LAS bf16_t* Wl = (LAS bf16_t*)L;
    LAS bf16_t* U = (LAS bf16_t*)(L + 76800);
    LAS float* Aa = (LAS float*)(L + 102400);
    LAS float* Bb = (LAS float*)(L + 126976);
    LAS float* SP = (LAS float*)(L + 151552);
    LAS float* SH = (LAS float*)(L + 153088);
    LAS float* HC = (LAS float*)(L + 154624);
    LAS float* CW = (LAS float*)(L + 155392);
    const bool smp = item >= 256;
    const int i2 = smp ? item - 256 : item;
    const int b = i2 >> 4, nb = (i2 >> 1) & 7, hf = i2 & 1;
    const int nch = smp ? 1 : 32;
    const unsigned rbase = smp ? (unsigned)T_P + b * 64 : (unsigned)b * 2048;
    const bf16_t* Z2 = (const bf16_t*)(ws + WS_Z2); bf16_t* Y2 = (bf16_t*)(ws + WS_Y2);
    const bf16_t* WA = (const bf16_t*)(ws + WS_WA) + nb * 192 * 192; const bf16_t* WI = (const bf16_t*)(ws + WS_WI) + nb * 192 * 192;
    for (int idx = tid; idx < 192 * 24; idx += NTHR) {
        const int r = idx / 24, g8 = idx % 24;
        const bf16_t* src = (r < 96) ? WA + (size_t)(hf * 96 + r) * 192 + g8 * 8 : WI + (size_t)(hf * 96 + r - 96) * 192 + g8 * 8;
        *(LAS u32x4*)(Wl + r * 200 + g8 * 8) = *(const u32x4*)src;
    }
    const bool cthr = tid < 384;
    const int cgp = tid % 24, tq = (tid / 24) & 15;
    const int chc = nb * 192 + cgp * 8;
    for (int idx = tid; idx < 5 * 192; idx += NTHR) { const int j = idx / 192, cc = idx % 192; CW[idx] = (j < 4) ? p.in[16][j * 1536 + nb * 192 + cc] : p.in[17][nb * 192 + cc]; }
    const int mt = w & 3, pg = w >> 2;
    float bra[3], bri[3], sp[3];
#pragma unroll
    for (int cp = 0; cp < 3; ++cp) {
        const int ch = nb * 192 + hf * 96 + (pg * 3 + cp) * 16 + r16;
        bra[cp] = p.in[19][ch]; bri[cp] = p.in[21][ch];
        const float lam = p.in[22][ch];
        sp[cp] = 8.f * (fmaxf(-lam, 0.f) + log1pf(__expf(-fabsf(lam))));
    }
    if (tid < 96) HC[tid] = smp ? p.in[6][b * 1536 + nb * 192 + hf * 96 + tid] : 0.f;
    const int sch0 = tid % 96, sseg0 = (tid / 96) & 3;
    const int ot0 = tid / 12, og0 = tid % 12, ot1 = (tid + 512) / 12, og1 = (tid + 512) % 12;
    const bool o1 = tid < 256;
    const int och0 = nb * 192 + hf * 96 + og0 * 8, och1 = nb * 192 + hf * 96 + og1 * 8;
    lds_barrier();
    u32x4 xr[7]; u32x4 pg0, pg1 = {0u, 0u, 0u, 0u};
#pragma unroll
    for (int r = 0; r < 7; ++r) {
        xr[r] = (u32x4){0u, 0u, 0u, 0u};
        const int pos = 4 * tq - 3 + r;
        if (cthr) {
            if (pos >= 0) xr[r] = *(const u32x4*)(Z2 + (unsigned)((rbase + pos) * 3072u + chc));
            else if (smp) {
                const float* hp = p.in[5] + ((size_t)b * 3 + (3 + pos)) * 1536 + chc;
                const f32x4 h0 = *(const f32x4*)hp, h1 = *(const f32x4*)(hp + 4);
                xr[r].x = cvt_pk_bf16(h0[0], h0[1]); xr[r].y = cvt_pk_bf16(h0[2], h0[3]); xr[r].z = cvt_pk_bf16(h1[0], h1[1]); xr[r].w = cvt_pk_bf16(h1[2], h1[3]);
            }
        }
    }
    pg0 = *(const u32x4*)(Z2 + (unsigned)((rbase + ot0) * 3072u + 1536 + och0));
    if (o1) pg1 = *(const u32x4*)(Z2 + (unsigned)((rbase + ot1) * 3072u + 1536 + och1));
    u32x4 so0 = {0u, 0u, 0u, 0u}, so1 = {0u, 0u, 0u, 0u}; unsigned sr = 0; bool spend = false;
    for (int ci = 0; ci < nch; ++ci) {
        const unsigned r0 = rbase + (unsigned)ci * 64;
        const bool more = (ci + 1 < nch);
        int sch = sch0, sseg = sseg0;
        asm volatile("" : "+v"(sch), "+v"(sseg));
        if (cthr) {
            float xv[7][8];
#pragma unroll
            for (int r = 0; r < 7; ++r) unpack8(xr[r], xv[r]);
            if (hf == 0 && !more && tq == 15) {
                float* oc = p.out + (smp ? O_CS : O_CP) + (size_t)b * 3 * 1536 + chc;
#pragma unroll
                for (int r = 0; r < 3; ++r) { *(f32x4*)(oc + r * 1536) = (f32x4){xv[4 + r][0], xv[4 + r][1], xv[4 + r][2], xv[4 + r][3]}; *(f32x4*)(oc + r * 1536 + 4) = (f32x4){xv[4 + r][4], xv[4 + r][5], xv[4 + r][6], xv[4 + r][7]}; }
            }
            float cw[5][8];
#pragma unroll
            for (int j = 0; j < 5; ++j) { const f32x4 c0 = *(const LAS f32x4*)(CW + j * 192 + cgp * 8), c1 = *(const LAS f32x4*)(CW + j * 192 + cgp * 8 + 4);
                cw[j][0] = c0[0]; cw[j][1] = c0[1]; cw[j][2] = c0[2]; cw[j][3] = c0[3]; cw[j][4] = c1[0]; cw[j][5] = c1[1]; cw[j][6] = c1[2]; cw[j][7] = c1[3]; }
#pragma unroll
            for (int tk = 0; tk < 4; ++tk) {
                float acc[8];
#pragma unroll
                for (int e = 0; e < 8; ++e) acc[e] = fmaf(xv[tk + 3][e], cw[3][e], fmaf(xv[tk + 2][e], cw[2][e], fmaf(xv[tk + 1][e], cw[1][e], fmaf(xv[tk][e], cw[0][e], cw[4][e]))));
                u32x4 uw; uw.x = cvt_pk_bf16(acc[0], acc[1]); uw.y = cvt_pk_bf16(acc[2], acc[3]); uw.z = cvt_pk_bf16(acc[4], acc[5]); uw.w = cvt_pk_bf16(acc[6], acc[7]);
                *(LAS u32x4*)(U + (4 * tq + tk) * 200 + cgp * 8) = uw;
            }
            if (more) {
#pragma unroll
                for (int r = 0; r < 7; ++r) xr[r] = *(const u32x4*)(Z2 + (unsigned)((r0 + 64 + 4 * tq - 3 + r) * 3072u + chc));
            }
        }
        lds_barrier();
        if (spend) { *(u32x4*)(Y2 + (unsigned)((sr + ot0) * 1536u + och0)) = so0; if (o1) *(u32x4*)(Y2 + (unsigned)((sr + ot1) * 1536u + och1)) = so1; }
        f32x4 ga[3], gi[3];
#pragma unroll
        for (int cp = 0; cp < 3; ++cp) { ga[cp] = (f32x4){0.f, 0.f, 0.f, 0.f}; gi[cp] = (f32x4){0.f, 0.f, 0.f, 0.f}; }
#pragma unroll 2
        for (int ks = 0; ks < 6; ++ks) {
            const bf16x8 uf = *(const LAS bf16x8*)(U + (mt * 16 + r16) * 200 + ks * 32 + q4 * 8);
#pragma unroll
            for (int cp = 0; cp < 3; ++cp) {
                const int ct = pg * 3 + cp;
                const bf16x8 wa = *(const LAS bf16x8*)(Wl + (ct * 16 + r16) * 200 + ks * 32 + q4 * 8), wi = *(const LAS bf16x8*)(Wl + (96 + ct * 16 + r16) * 200 + ks * 32 + q4 * 8);
                ga[cp] = MFMA16(uf, wa, ga[cp]); gi[cp] = MFMA16(uf, wi, gi[cp]);
            }
        }
#pragma unroll
        for (int cp = 0; cp < 3; ++cp) {
            const int cl = (pg * 3 + cp) * 16 + r16;
#pragma unroll
            for (int jj = 0; jj < 4; ++jj) {
                const int t = mt * 16 + q4 * 4 + jj;
                const float rg = sigmf(ga[cp][jj] + bra[cp]), ig = sigmf(gi[cp][jj] + bri[cp]);
                const float z = rg * sp[cp];
                const float a = __expf(-z);
                const float z2 = z + z;
                const float om = (z2 < 0.05f) ? z2 * (1.f - z2 * (0.5f - z2 * (0.16666667f - z2 * 0.041666668f))) : 1.f - a * a;
                const float uu = bf2f(U[t * 200 + hf * 96 + cl]);
                Aa[t * 96 + cl] = a; Bb[t * 96 + cl] = __builtin_amdgcn_sqrtf(om) * ig * uu;
            }
        }
        lds_barrier();
        if (cthr) {
            float P = 1.f, H = 0.f;
#pragma unroll
            for (int t = 0; t < 16; ++t) { const float a = Aa[(sseg * 16 + t) * 96 + sch]; H = a * H + Bb[(sseg * 16 + t) * 96 + sch]; P *= a; }
            SP[sseg * 96 + sch] = P; SH[sseg * 96 + sch] = H;
        }
        lds_barrier();
        if (cthr) {
            float hh = HC[(ci & 1) * 96 + sch];
#pragma unroll
            for (int sg = 0; sg < 3; ++sg) if (sg < sseg) hh = SP[sg * 96 + sch] * hh + SH[sg * 96 + sch];
#pragma unroll
            for (int t = 0; t < 16; ++t) { hh = Aa[(sseg * 16 + t) * 96 + sch] * hh + Bb[(sseg * 16 + t) * 96 + sch]; Bb[(sseg * 16 + t) * 96 + sch] = hh; }
            if (sseg == 3) HC[((ci + 1) & 1) * 96 + sch] = hh;
        }
        lds_barrier();
        {
            const f32x4 h0 = *(const LAS f32x4*)(Bb + ot0 * 96 + og0 * 8), h1 = *(const LAS f32x4*)(Bb + ot0 * 96 + og0 * 8 + 4);
            u32x4 o;
            o.x = cvt_pk_bf16(h0[0] * siluf(bflo(pg0.x)), h0[1] * siluf(bfhi(pg0.x)));
            o.y = cvt_pk_bf16(h0[2] * siluf(bflo(pg0.y)), h0[3] * siluf(bfhi(pg0.y)));
            o.z = cvt_pk_bf16(h1[0] * siluf(bflo(pg0.z)), h1[1] * siluf(bfhi(pg0.z)));
            o.w = cvt_pk_bf16(h1[2] * siluf(bflo(pg0.w)), h1[3] * siluf(bfhi(pg0.w)));
            so0 = o;
            if (more) pg0 = *(const u32x4*)(Z2 + (unsigned)((r0 + 64 + ot0) * 3072u + 1536 + och0));
        }
        if (o1) {
            const f32x4 h0 = *(const LAS f32x4*)(Bb + ot1 * 96 + og1 * 8), h1 = *(const LAS f32x4*)(Bb + ot1 * 96 + og1 * 8 + 4);
            u32x4 o;
            o.x = cvt_pk_bf16(h0[0] * siluf(bflo(pg1.x)), h0[1] * siluf(bfhi(pg1.x)));
            o.y = cvt_pk_bf16(h0[2] * siluf(bflo(pg1.y)), h0[3] * siluf(bfhi(pg1.y)));
            o.z = cvt_pk_bf16(h1[0] * siluf(bflo(pg1.z)), h1[1] * siluf(bfhi(pg1.z)));
            o.w = cvt_pk_bf16(h1[2] * siluf(bflo(pg1.w)), h1[3] * siluf(bfhi(pg1.w)));
            so1 = o;
            if (more) pg1 = *(const u32x4*)(Z2 + (unsigned)((r0 + 64 + ot1) * 3072u + 1536 + och1));
        }
        sr = r0; spend = true;
        lds_barrier();
    }
    if (spend) { *(u32x4*)(Y2 + (unsigned)((sr + ot0) * 1536u + och0)) = so0; if (o1) *(u32x4*)(Y2 + (unsigned)((sr + ot1) * 1536u + och1)) = so1; }
    if (tid < 96) p.out[(smp ? O_LS : O_LP) + (size_t)b * 1536 + nb * 192 + hf * 96 + tid] = HC[(nch & 1) * 96 + tid];
    lds_barrier();
}

__device__ __forceinline__ void phase6(const Params& p, LAS unsigned char* L) {
    if (gridDim.x == 256) {
        const int xcd = blockIdx.x & 7, loc = blockIdx.x >> 3;
        const int pair = xcd * 16 + (loc >> 1), hf = loc & 1;
        lru_item(p, L, pair * 2 + hf); lru_item(p, L, 256 + pair * 2 + hf); lru_item(p, L, 512 + pair * 2 + hf);
    } else {
        for (int it = blockIdx.x; it < 768; it += gridDim.x) lru_item(p, L, it);
    }
}

__device__ __forceinline__ void phase8(const Params& p) {
    const float* rsq = (const float*)(p.ws + WS_RSQ2); const float* g = p.in[24]; float* y = p.out; const bf16_t* xb = (const bf16_t*)(p.ws + WS_XB);
    const long gtid = (long)blockIdx.x * NTHR + threadIdx.x, gsz = (long)gridDim.x * NTHR;
    const long total = (long)T * 128;
    for (long it = gtid; it < total; it += gsz) {
        const long row = it >> 7; const int c8 = (int)(it & 127) * 8;
        const float rs = rsqrtf(rsq[row] * (1.f / 1024.f) + EPS);
        const u32x4 xw = *(const u32x4*)(xb + row * 1024 + c8);
        const f32x4 g0 = *(const f32x4*)(g + c8), g1 = *(const f32x4*)(g + c8 + 4);
        f32x4 o0, o1;
        o0[0] = bflo(xw.x) * rs * g0[0]; o0[1] = bfhi(xw.x) * rs * g0[1]; o0[2] = bflo(xw.y) * rs * g0[2]; o0[3] = bfhi(xw.y) * rs * g0[3];
        o1[0] = bflo(xw.z) * rs * g1[0]; o1[1] = bfhi(xw.z) * rs * g1[1]; o1[2] = bflo(xw.w) * rs * g1[2]; o1[3] = bfhi(xw.w) * rs * g1[3];
        *(f32x4*)(y + row * 1024 + c8) = o0; *(f32x4*)(y + row * 1024 + c8 + 4) = o1;
    }
}

#define XB_TMO      128
#define XB_XCNT(j)  (256  + 64 * (j))
#define XB_XSUB(j)  (1280 + 64 * (j))
#define XB_XGEN(j)  (2304 + 64 * (j))
#define XB_TOP      3328
#define XB_TOPGEN   3392
#define XCD_BAR_WORDS 3456
#define XB_SPIN_CAP (1u << 18)
__device__ __forceinline__ unsigned xb_ld(unsigned* p)              { return __hip_atomic_load(p, __ATOMIC_RELAXED, __HIP_MEMORY_SCOPE_AGENT); }
__device__ __forceinline__ unsigned xb_add(unsigned* p, unsigned v) { return __hip_atomic_fetch_add(p, v, __ATOMIC_RELAXED, __HIP_MEMORY_SCOPE_AGENT); }
__device__ __forceinline__ unsigned xb_xcc_id() { return (unsigned)__builtin_amdgcn_s_getreg((3 << 11) | 20) & 0xFu; }
#define XB_SPIN(cond, bar) do { unsigned _sp = 0; while (cond) { __builtin_amdgcn_s_sleep(1); \
    if ((++_sp & 255u) == 0u) { if (xb_ld(&(bar)[XB_TMO])) break; if (_sp > XB_SPIN_CAP) { atomicAdd(&(bar)[XB_TMO], 1u); break; } } } } while (0)
struct XcdBarrier { unsigned* bar; unsigned x; volatile LAS unsigned* st; };
__device__ __forceinline__ XcdBarrier xcd_barrier_post(unsigned* bar, volatile LAS unsigned* st) {
    XcdBarrier b; b.bar = bar; b.x = xb_xcc_id(); b.st = st;
    if (threadIdx.x == 0) (void)xb_add(&bar[XB_XCNT(b.x)], 1u);
    return b;
}
__device__ __forceinline__ void xcd_barrier_complete(unsigned* bar, unsigned x, unsigned& nloc, unsigned& nx) {
    const unsigned G = gridDim.x * gridDim.y * gridDim.z;
    unsigned sum, cnt, mine, sp = 0u;
    for (;;) {
        sum = 0u; cnt = 0u; mine = 0u;
#pragma unroll
        for (unsigned j = 0; j < 16; ++j) { const unsigned c = xb_ld(&bar[XB_XCNT(j)]); sum += c; cnt += (c > 0u) ? 1u : 0u; mine = (j == x) ? c : mine; }
        if (sum == G) break;
        __builtin_amdgcn_s_sleep(1);
        if ((++sp & 255u) == 0u) { if (xb_ld(&bar[XB_TMO])) break; if (sp > XB_SPIN_CAP) { atomicAdd(&bar[XB_TMO], 1u); break; } }
    }
    nloc = mine > 0u ? mine : 1u; nx = cnt > 0u ? cnt : 1u;
}
__device__ __forceinline__ void xcd_barrier(const XcdBarrier& b) {
    asm volatile("s_waitcnt vmcnt(0)" ::: "memory");
    __syncthreads();
    if (threadIdx.x == 0) {
        unsigned* bar = b.bar;
        __builtin_amdgcn_s_waitcnt(0);
        unsigned nloc = b.st[0], nx = b.st[1];
        if (nloc == 0u) { xcd_barrier_complete(bar, b.x, nloc, nx); b.st[0] = nloc; b.st[1] = nx; }
        const unsigned old = xb_add(&bar[XB_XSUB(b.x)], 1u);
        const unsigned gen = old / nloc;
        if (old + 1u == (gen + 1u) * nloc) {
            __builtin_amdgcn_fence(__ATOMIC_RELEASE, "agent");
            asm volatile("s_waitcnt vmcnt(0)" ::: "memory");
            const unsigned og = xb_add(&bar[XB_TOP], 1u);
            const unsigned tg = og / nx;
            if (og + 1u == (tg + 1u) * nx) xb_add(&bar[XB_TOPGEN], 1u);
            else XB_SPIN(xb_ld(&bar[XB_TOPGEN]) == tg, bar);
            __builtin_amdgcn_fence(__ATOMIC_ACQUIRE, "agent");
            xb_add(&bar[XB_XGEN(b.x)], 1u);
            asm volatile("s_waitcnt vmcnt(0)" ::: "memory");
        } else {
            XB_SPIN(xb_ld(&bar[XB_XGEN(b.x)]) == gen, bar);
            __builtin_amdgcn_fence(__ATOMIC_ACQUIRE, "agent");
            asm volatile("s_waitcnt vmcnt(0)" ::: "memory");
        }
    }
    __syncthreads();
}

__global__ void __launch_bounds__(NTHR) mega(Params p) {
    extern __shared__ __attribute__((aligned(16))) unsigned char lds_raw[];
    LAS unsigned char* L = (LAS unsigned char*)lds_raw;
    cg::grid_group grid = cg::this_grid();
    unsigned char* ws = p.ws;
    const int lo = p.ph_lo, hi = p.ph_hi;
    LAS unsigned* stw = (LAS unsigned*)(L + (LDS_BYTES - 16));
    if (threadIdx.x < 4) stw[threadIdx.x] = 0u;
    __syncthreads();
    const XcdBarrier xb = xcd_barrier_post((unsigned*)(ws + WS_BAR), (volatile LAS unsigned*)stw);
#ifndef PHMASK
#define PHMASK 0x1ff
#endif
#define IN(k) (((PHMASK >> (k)) & 1) && lo <= (k) && (k) < hi)
#define SEAM(k) do { if (IN(k) && IN((k) + 1)) xcd_barrier(xb); } while (0)
    if (hi > 1000) grid.sync();
    if (IN(0)) phase0(p);
    SEAM(0);
    if (IN(1)) {
        pg8::Gemm g{(const bf16_t*)(ws + WS_XB), (const bf16_t*)(ws + WS_WINE), T, NE_PAD, 1024, 1024};
        pg8::StaticOrder S; S.init(T, NE_PAD, gridDim.x, blockIdx.x);
        EpiInEven E{ws, p.out, (const float*)(ws + WS_RSTD0), p.in[10]};
        pg8::gemm_phase<EpiInEven, pg8::StaticOrder>(L, g, S, E);
    }
    SEAM(1);
    if (IN(2)) { phase2a(p, L); xcd_barrier(xb); phase2b(p, L); }
    SEAM(2);
    if (IN(3)) phase3(p);
    SEAM(3);
    if (IN(4)) {
        const bool split = (gridDim.x == 256);
        pg8::Gemm g{(const bf16_t*)(ws + WS_GATE), (const bf16_t*)(ws + WS_WOUTE), T, 1024, 2048, 2048};
        pg8::StaticOrder S; S.init(T, 1024, gridDim.x, blockIdx.x, split ? 512 : -1);
        EpiOutResB E{(bf16_t*)(ws + WS_XB), (float*)(ws + WS_RSQ1)};
        pg8::gemm_phase<EpiOutResB, pg8::StaticOrder>(L, g, S, E);
        if (split) {
            pg8::Gemm gs{(const bf16_t*)(ws + WS_GATE), (const bf16_t*)(ws + WS_WOUTE), T, 1024, 256, 2048};
            pg8::SliceOrder SS{S, 512, 8, 512u};
            EpiPartial EP{(float*)(ws + WS_Q)};
            pg8::gemm_phase<EpiPartial, pg8::SliceOrder>(L, gs, SS, EP);
            xcd_barrier(xb);
            splitk_reduce(S, 512, 8, (const float*)(ws + WS_Q), (bf16_t*)(ws + WS_XB), (float*)(ws + WS_RSQ1));
        }
    }
    SEAM(4);
    if (IN(5)) {
        pg8::Gemm g{(const bf16_t*)(ws + WS_XB), (const bf16_t*)(ws + WS_WINO), T, 3072, 1024, 1024};
        pg8::StaticOrder S; S.init(T, 3072, gridDim.x, blockIdx.x);
        EpiInOdd E{(bf16_t*)(ws + WS_Z2), (const float*)(ws + WS_RSQ1)};
        pg8::gemm_phase<EpiInOdd, pg8::StaticOrder>(L, g, S, E);
    }
    SEAM(5);
    if (IN(6)) phase6(p, L);
    SEAM(6);
    if (IN(7)) {
        const bool split = (gridDim.x == 256);
        pg8::Gemm g{(const bf16_t*)(ws + WS_Y2), (const bf16_t*)(ws + WS_WOUTO), T, 1024, 1536, 1536};
        pg8::StaticOrder S; S.init(T, 1024, gridDim.x, blockIdx.x, split ? 512 : -1);
        EpiOutResB E{(bf16_t*)(ws + WS_XB), (float*)(ws + WS_RSQ2)};
        pg8::gemm_phase<EpiOutResB, pg8::StaticOrder>(L, g, S, E);
        if (split) {
            pg8::Gemm gs{(const bf16_t*)(ws + WS_Y2), (const bf16_t*)(ws + WS_WOUTO), T, 1024, 256, 1536};
            pg8::SliceOrder SS{S, 512, 6, 512u};
            EpiPartial EP{(float*)(ws + WS_Q)};
            pg8::gemm_phase<EpiPartial, pg8::SliceOrder>(L, gs, SS, EP);
            xcd_barrier(xb);
            splitk_reduce(S, 512, 6, (const float*)(ws + WS_Q), (bf16_t*)(ws + WS_XB), (float*)(ws + WS_RSQ2));
        }
    }
    SEAM(7);
    if (IN(8)) phase8(p);
#undef IN
#undef SEAM
}

extern "C" void kernel_launch(void* const* d_in, const int* in_sizes, int n_in, void* d_out, int out_size, void* d_ws, size_t ws_size, hipStream_t stream) {
    static int grid_blocks = 0;
    if (grid_blocks == 0) {
        if (n_in != 25 || (size_t)out_size != O_END || ws_size < WS_TOTAL) { fprintf(stderr, "kernel_launch: unexpected shapes n_in %d out %d ws %zu (need %zu)\n", n_in, out_size, ws_size, (size_t)WS_END); grid_blocks = -1; return; }
        int dev = 0, cus = 0, per_cu = 0;
        (void)hipGetDevice(&dev);
        (void)hipDeviceGetAttribute(&cus, hipDeviceAttributeMultiprocessorCount, dev);
        if (hipFuncSetAttribute((const void*)mega, hipFuncAttributeMaxDynamicSharedMemorySize, LDS_BYTES) != hipSuccess) { fprintf(stderr, "kernel_launch: hipFuncSetAttribute failed\n"); }
        if (hipOccupancyMaxActiveBlocksPerMultiprocessor(&per_cu, (const void*)mega, NTHR, LDS_BYTES) != hipSuccess || per_cu < 1) per_cu = 1;
        (void)hipGetLastError();
        grid_blocks = cus * per_cu;
        if (grid_blocks <= 0) grid_blocks = 256;
    }
    if (grid_blocks < 0) return;
    Params p{};
    for (int i = 0; i < 25; ++i) p.in[i] = (const float*)d_in[i];
    p.out = (float*)d_out; p.ws = (unsigned char*)d_ws;
#if ONE_LAUNCH
#ifdef PROBE_X
    { const int seq[3][2] = {{0, PROBE_Y + 1}, {PROBE_X, PROBE_Y + 1}, {PROBE_Y + 1, 9}};
      for (int li = 0; li < 3; ++li) { if (seq[li][0] >= seq[li][1]) continue; p.ph_lo = seq[li][0]; p.ph_hi = seq[li][1]; void* args[] = {&p};
        (void)hipMemsetAsync((char*)d_ws + WS_BAR, 0, 16384, stream);
        hipError_t e = hipLaunchCooperativeKernel((const void*)mega, dim3(grid_blocks), dim3(NTHR), args, LDS_BYTES, stream);
        if (e != hipSuccess) fprintf(stderr, "cooperative launch failed: %s (grid %d)\n", hipGetErrorString(e), grid_blocks); } }
#else
    p.ph_lo = 0; p.ph_hi = 9;
    (void)hipMemsetAsync((char*)d_ws + WS_BAR, 0, 16384, stream);
    { void* args[] = {&p}; hipError_t e = hipLaunchCooperativeKernel((const void*)mega, dim3(grid_blocks), dim3(NTHR), args, LDS_BYTES, stream);
      if (e != hipSuccess) fprintf(stderr, "cooperative launch failed: %s (grid %d)\n", hipGetErrorString(e), grid_blocks); }
#endif
#else
    for (int ph = 0; ph < 9; ++ph) {
        p.ph_lo = ph; p.ph_hi = ph + 1;
        (void)hipMemsetAsync((char*)d_ws + WS_BAR, 0, 16384, stream);
        void* args[] = {&p}; hipError_t e = hipLaunchCooperativeKernel((const void*)mega, dim3(grid_blocks), dim3(NTHR), args, LDS_BYTES, stream);
        if (e != hipSuccess) fprintf(stderr, "cooperative launch %d failed: %s (grid %d)\n", ph, hipGetErrorString(e), grid_blocks);
    }
#endif
}
```

```cpp
#include <hip/hip_runtime.h>
#include <hip/hip_cooperative_groups.h>
#include <cstdio>
namespace cg = cooperative_groups;

#ifndef ONE_LAUNCH
#define ONE_LAUNCH 1
#endif

#define LAS __attribute__((address_space(3)))
typedef unsigned short bf16_t;
typedef short bf16x8 __attribute__((ext_vector_type(8)));
typedef short bf16x4 __attribute__((ext_vector_type(4)));
typedef float f32x4 __attribute__((ext_vector_type(4)));
typedef unsigned u32x4 __attribute__((ext_vector_type(4)));
typedef unsigned u32x2 __attribute__((ext_vector_type(2)));

constexpr int T_P = 32768, T_S = 2048, T = T_P + T_S, DM = 1024;
constexpr int NE_PAD = 6144;
constexpr int LDS_BYTES = 159744;
constexpr int NTHR = 512;
constexpr float EPS = 1e-6f;

constexpr size_t WS_WINE = 0;
constexpr size_t WS_WOUTE = WS_WINE + (size_t)NE_PAD * 1024 * 2;
constexpr size_t WS_WINO = WS_WOUTE + (size_t)1024 * 2048 * 2;
constexpr size_t WS_WOUTO = WS_WINO + (size_t)3072 * 1024 * 2;
constexpr size_t WS_WA = WS_WOUTO + (size_t)1024 * 1536 * 2;
constexpr size_t WS_WI = WS_WA + (size_t)8 * 192 * 192 * 2;
constexpr size_t WS_XB = WS_WI + (size_t)8 * 192 * 192 * 2;
constexpr size_t WS_RSTD0 = WS_XB + (size_t)T * 1024 * 2;
constexpr size_t WS_RSQ1 = WS_RSTD0 + (size_t)T * 4;
constexpr size_t WS_RSQ2 = WS_RSQ1 + (size_t)T * 4;
constexpr size_t WS_BOSQ = WS_RSQ2 + (size_t)T * 4;
constexpr size_t WS_Q = WS_BOSQ + (size_t)T * 16;
constexpr size_t WS_K = WS_Q + (size_t)T * 1024 * 2;
constexpr size_t WS_V = WS_K + (size_t)T * 256 * 2;
constexpr size_t WS_BQ = WS_V + (size_t)T * 256 * 2;
constexpr size_t WS_BK = WS_BQ + (size_t)T * 512 * 2;
constexpr size_t WS_BV = WS_BK + (size_t)T * 512 * 2;
constexpr size_t WS_GATE = WS_BV + (size_t)T * 1024 * 2;
constexpr size_t WS_BLR = WS_GATE + (size_t)T * 2048 * 2;
constexpr size_t WS_END = WS_BLR + (size_t)T * 512 * 2;
constexpr size_t WS_BAR = WS_END;
constexpr size_t WS_TOTAL = WS_BAR + 16384;
constexpr size_t WS_Z2 = WS_Q;
constexpr size_t WS_Y2 = WS_GATE;
static_assert(WS_Z2 + (size_t)T * 3072 * 2 <= WS_GATE, "Z2 alias");

constexpr size_t O_Y = 0;
constexpr size_t O_KP = (size_t)T * 1024;
constexpr size_t O_VP = O_KP + 524288;
constexpr size_t O_GP = O_VP + 524288;
constexpr size_t O_CP = O_GP + 2097152;
constexpr size_t O_LP = O_CP + 73728;
constexpr size_t O_KS = O_LP + 24576;
constexpr size_t O_VS = O_KS + 524288;
constexpr size_t O_GS = O_VS + 524288;
constexpr size_t O_CS = O_GS + 4194304;
constexpr size_t O_LS = O_CS + 147456;
constexpr size_t O_END = O_LS + 49152;

struct Params {
    const float* in[25];
    float* out;
    unsigned char* ws;
    int ph_lo, ph_hi;
};

__device__ __forceinline__ unsigned cvt_pk_bf16(float lo, float hi) { unsigned r; asm volatile("v_cvt_pk_bf16_f32 %0, %1, %2" : "=v"(r) : "v"(lo), "v"(hi)); return r; }
__device__ __forceinline__ bf16_t f2bf(float f) { return (bf16_t)(cvt_pk_bf16(f, 0.f) & 0xffffu); }
__device__ __forceinline__ float bf2f(bf16_t b) { return __uint_as_float(((unsigned)b) << 16); }
__device__ __forceinline__ float bflo(unsigned w) { return __uint_as_float(w << 16); }
__device__ __forceinline__ float bfhi(unsigned w) { return __uint_as_float(w & 0xffff0000u); }
__device__ __forceinline__ float rcpf_(float x) { return __builtin_amdgcn_rcpf(x); }
__device__ __forceinline__ float siluf(float x) { return x * rcpf_(1.f + __expf(-x)); }
__device__ __forceinline__ float sigmf(float x) { return rcpf_(1.f + __expf(-x)); }
__device__ __forceinline__ void lds_barrier() { asm volatile("s_waitcnt lgkmcnt(0)" ::: "memory"); __builtin_amdgcn_s_barrier(); asm volatile("" ::: "memory"); }
__device__ __forceinline__ bf16x8 pack8(const f32x4& a, const f32x4& b) {
    u32x4 p; p.x = cvt_pk_bf16(a[0], a[1]); p.y = cvt_pk_bf16(a[2], a[3]); p.z = cvt_pk_bf16(b[0], b[1]); p.w = cvt_pk_bf16(b[2], b[3]);
    return __builtin_bit_cast(bf16x8, p);
}
__device__ __forceinline__ bf16x8 cat4(const bf16x4 a, const bf16x4 b) { bf16x8 r; r[0] = a[0]; r[1] = a[1]; r[2] = a[2]; r[3] = a[3]; r[4] = b[0]; r[5] = b[1]; r[6] = b[2]; r[7] = b[3]; return r; }
__device__ __forceinline__ void unpack8(const u32x4 w, float (&v)[8]) { v[0] = bflo(w.x); v[1] = bfhi(w.x); v[2] = bflo(w.y); v[3] = bfhi(w.y); v[4] = bflo(w.z); v[5] = bfhi(w.z); v[6] = bflo(w.w); v[7] = bfhi(w.w); }
#define MFMA16(a, b, c) __builtin_amdgcn_mfma_f32_16x16x32_bf16((a), (b), (c), 0, 0, 0)

namespace pg8 {
constexpr int BM = 256, BK = 64, HALF = 128, HTB = HALF * BK * 2, STAGE_BYTES = 8 * HTB, NXCD = 8, WGM = 8;
__device__ __forceinline__ int lds_byte(int r, int c) { const int st = (r >> 4) * 2 + (c >> 5), rr = r & 15, cc = c & 31, ob = rr * 64 + cc * 2; return st * 1024 + (ob ^ (((ob >> 9) & 1) << 5)); }
__device__ __forceinline__ int perm32(int rho) { const int n = rho >> 4, i = rho & 15; return 8 * (i >> 2) + 4 * n + (i & 3); }
__device__ __forceinline__ void stage_rc(int b, int& R, int& C) { const int st = b / 1024, sb = b % 1024, swz = sb ^ (((sb >> 9) & 1) << 5); R = (st >> 1) * 16 + swz / 64; C = (st & 1) * 32 + (swz % 64) / 2; }
struct Unit { int pm, pn; unsigned koff; int aux; };
struct Gemm { const bf16_t* A; const bf16_t* Bt; int M, N, K, ld; };
struct StaticOrder {
    int nM, nN, nwg, G, c, nrun;
    __device__ void init(int M, int N, int G_, int c_, int nrun_ = -1) { nM = M / BM; nN = N / BM; nwg = nM * nN; G = G_; c = c_; nrun = (nrun_ < 0 || nrun_ > nwg) ? nwg : nrun_; }
    __device__ __forceinline__ void map(int Lx, Unit& u) const {
        int wgid = Lx; { const int q = nwg / NXCD, r = nwg % NXCD, xcd = wgid % NXCD, off = wgid / NXCD; wgid = (xcd < r ? xcd * (q + 1) : r * (q + 1) + (xcd - r) * q) + off; }
        const int nig = WGM * nN, gid = wgid / nig, fm = gid * WGM, gsz = (nM - fm) < WGM ? (nM - fm) : WGM;
        u.pm = fm + ((wgid % nig) % gsz); u.pn = (wgid % nig) / gsz; u.koff = 0u; u.aux = 0;
    }
    __device__ __forceinline__ bool next(int i, Unit& u) const {
        const long Lx = (long)i * G + c; if (Lx >= nrun) return false;
        map((int)Lx, u); return true;
    }
};
struct SliceOrder {
    StaticOrder base; int first, nsl; unsigned kbytes;
    __device__ __forceinline__ bool next(int i, Unit& u) const {
        if (i != 0 || base.c >= 32 * nsl) return false;
        const int ui = base.c / nsl, sl = base.c % nsl;
        base.map(first + ui, u); u.koff = (unsigned)sl * kbytes; u.aux = sl * 32 + ui; return true;
    }
};

template <class Epi, class Sched>
__device__ __forceinline__ void gemm_phase(LAS unsigned char* lds, const Gemm g, const Sched& S, const Epi& E) {
    const int tid = threadIdx.x, wid = __builtin_amdgcn_readfirstlane(tid >> 6), lane = tid & 63, wr = wid >> 2, wc = wid & 3, fr = lane & 15, fq = lane >> 4;
    const int K = g.K, ld = g.ld, nt = K / BK;
    unsigned voffA[2], voffB[2];
#pragma unroll
    for (int i = 0; i < 2; ++i) { int R, C; stage_rc(tid * 16 + i * 8192, R, C); const int Rb = Epi::PERM ? ((R & ~31) + perm32(R & 31)) : R;
        voffA[i] = (unsigned)(R * ld + C) * 2u; voffB[i] = (unsigned)(Rb * ld + C) * 2u; }
    const size_t kstep = (size_t)(BK * 2);
    const size_t hstep = (size_t)HALF * ld * 2;
    const size_t tstep = 2 * hstep;
    const unsigned ldsw = (unsigned)wid * 1024u;
    const int aoff = lds_byte(wr * 64 + fr, fq * 8), boff = lds_byte(wc * 32 + fr, fq * 8);
#define PG8_SA(b, h) (((b) * 2 + (h)) * HTB)
#define PG8_SB(b, h) ((4 + (b) * 2 + (h)) * HTB)
#define PG8_STAGE(bufoff, gbase, voff) do { _Pragma("unroll") for (int _i = 0; _i < 2; ++_i) \
        __builtin_amdgcn_global_load_lds((const unsigned*)((const char*)(gbase) + (voff)[_i]), (LAS unsigned*)(lds + (bufoff) + ldsw + _i * 8192), 16, 0, 0); } while (0)
#define PG8_LDA(dst, b, h) do { _Pragma("unroll") for (int m = 0; m < 4; ++m) _Pragma("unroll") for (int k = 0; k < 2; ++k) dst[m][k] = *(const LAS bf16x8*)(lds + PG8_SA(b, h) + aoff + m * 2048 + k * 1024); } while (0)
#define PG8_LDB(dst, b, h) do { _Pragma("unroll") for (int n = 0; n < 2; ++n) _Pragma("unroll") for (int k = 0; k < 2; ++k) dst[n][k] = *(const LAS bf16x8*)(lds + PG8_SB(b, h) + boff + n * 2048 + k * 1024); } while (0)
#define PG8_MMA(ai, bj, At, Bt) do { __builtin_amdgcn_s_setprio(1); _Pragma("unroll") for (int m = 0; m < 4; ++m) _Pragma("unroll") for (int n = 0; n < 2; ++n) _Pragma("unroll") for (int k = 0; k < 2; ++k) \
        acc[ai][bj][m][n] = __builtin_amdgcn_mfma_f32_16x16x32_bf16(Bt[n][k], At[m][k], acc[ai][bj][m][n], 0, 0, 0); __builtin_amdgcn_s_setprio(0); } while (0)
#define PG8_WAIT_V(n) asm volatile("s_waitcnt vmcnt(" #n ")" ::: "memory")
#define PG8_WAIT_L(n) asm volatile("s_waitcnt lgkmcnt(" #n ")" ::: "memory")
#define PG8_BAR __builtin_amdgcn_s_barrier()
#define PG8_SCHED __builtin_amdgcn_sched_barrier(0)
    Unit cur, nxt; int ui = 0;
    if (!S.next(0, cur)) return;
    f32x4 acc[2][2][4][2];
#pragma unroll
    for (int a = 0; a < 2; ++a)
#pragma unroll
        for (int b = 0; b < 2; ++b)
#pragma unroll
            for (int m = 0; m < 4; ++m)
#pragma unroll
                for (int n = 0; n < 2; ++n) acc[a][b][m][n] = (f32x4){0.f, 0.f, 0.f, 0.f};
    bf16x8 At[4][2], B0[2][2], B1[2][2];
    const char* cA = (const char*)g.A + (size_t)cur.pm * tstep + cur.koff; const char* cB = (const char*)g.Bt + (size_t)cur.pn * tstep + cur.koff;
    PG8_STAGE(PG8_SB(0, 0), cB, voffB); PG8_STAGE(PG8_SB(0, 1), cB + hstep, voffB); PG8_STAGE(PG8_SA(0, 0), cA, voffA); PG8_STAGE(PG8_SA(0, 1), cA + hstep, voffA);
    if (wr == 1) PG8_BAR;
    PG8_WAIT_V(2); PG8_BAR;
    PG8_STAGE(PG8_SB(1, 0), cB + kstep, voffB); PG8_STAGE(PG8_SA(1, 0), cA + kstep, voffA); PG8_STAGE(PG8_SB(1, 1), cB + hstep + kstep, voffB);
    PG8_WAIT_V(6); PG8_BAR;
    for (;;) {
        const bool has_next = S.next(ui + 1, nxt);
        const char* nA = has_next ? (const char*)g.A + (size_t)nxt.pm * tstep + nxt.koff : cA; const char* nB = has_next ? (const char*)g.Bt + (size_t)nxt.pn * tstep + nxt.koff : cB;
        for (int t = 0; t < nt; t += 2) {
            const bool last = (t == nt - 2);
            const char* a1 = cA + (size_t)(t + 1) * kstep;
            const char* a2 = last ? nA : cA + (size_t)(t + 2) * kstep; const char* b2 = last ? nB : cB + (size_t)(t + 2) * kstep;
            const char* a3 = a2 + kstep; const char* b3 = b2 + kstep;
            PG8_LDB(B0, 0, 0); PG8_LDB(B1, 0, 1); PG8_SCHED; PG8_LDA(At, 0, 0); PG8_STAGE(PG8_SA(1, 1), a1 + hstep, voffA);
            PG8_WAIT_V(8); PG8_WAIT_L(0); PG8_BAR; PG8_MMA(0, 0, At, B0); PG8_MMA(0, 1, At, B1); PG8_BAR; PG8_SCHED;
            PG8_LDA(At, 0, 1); PG8_STAGE(PG8_SB(0, 0), b2, voffB); PG8_STAGE(PG8_SB(0, 1), b2 + hstep, voffB); PG8_STAGE(PG8_SA(0, 0), a2, voffA);
            PG8_WAIT_V(8); PG8_WAIT_L(0); PG8_BAR; PG8_MMA(1, 0, At, B0); PG8_MMA(1, 1, At, B1); PG8_BAR; PG8_SCHED;
            PG8_LDB(B0, 1, 0); PG8_LDB(B1, 1, 1); PG8_SCHED; PG8_LDA(At, 1, 0); PG8_STAGE(PG8_SA(0, 1), a2 + hstep, voffA);
            PG8_WAIT_V(8); PG8_WAIT_L(0); PG8_BAR; PG8_MMA(0, 0, At, B0); PG8_MMA(0, 1, At, B1); PG8_BAR; PG8_SCHED;
            PG8_LDA(At, 1, 1); PG8_STAGE(PG8_SB(1, 0), b3, voffB); PG8_STAGE(PG8_SB(1, 1), b3 + hstep, voffB); PG8_STAGE(PG8_SA(1, 0), a3, voffA);
            PG8_WAIT_V(8); PG8_WAIT_L(0); PG8_BAR; PG8_MMA(1, 0, At, B0); PG8_MMA(1, 1, At, B1); PG8_BAR; PG8_SCHED;
        }
        if (wr == 0) PG8_BAR;
        E(acc, cur, wr, wc, fr, fq);
        if (!has_next) break;
#pragma unroll
        for (int a = 0; a < 2; ++a)
#pragma unroll
            for (int b = 0; b < 2; ++b)
#pragma unroll
                for (int m = 0; m < 4; ++m)
#pragma unroll
                    for (int n = 0; n < 2; ++n) acc[a][b][m][n] = (f32x4){0.f, 0.f, 0.f, 0.f};
        cur = nxt; cA = nA; cB = nB; ++ui;
        if (wr == 1) PG8_BAR;
    }
    PG8_WAIT_V(0);
    PG8_BAR;
#undef PG8_SA
#undef PG8_SB
#undef PG8_STAGE
#undef PG8_LDA
#undef PG8_LDB
#undef PG8_MMA
#undef PG8_WAIT_V
#undef PG8_WAIT_L
#undef PG8_BAR
#undef PG8_SCHED
}
}

typedef f32x4 AccT[2][2][4][2];

struct EpiInEven {
    static constexpr bool PERM = true;
    unsigned char* ws; float* out; const float* rstd; const float* blr_b;
    __device__ __forceinline__ void operator()(const AccT& acc, const pg8::Unit& u, int wr, int wc, int fr, int fq) const {
        const int pn = u.pn;
        bf16_t* base; int ld, coff; float sc = 1.f;
        if (pn < 4) { base = (bf16_t*)(ws + WS_Q); ld = 1024; coff = pn * 256; sc = 0.125f * 1.4426950408889634f; }
        else if (pn == 4) { base = (bf16_t*)(ws + WS_K); ld = 256; coff = 0; }
        else if (pn == 5) { base = (bf16_t*)(ws + WS_V); ld = 256; coff = 0; }
        else if (pn < 8) { base = (bf16_t*)(ws + WS_BQ); ld = 512; coff = (pn - 6) * 256; sc = 0.08838834764831845f; }
        else if (pn < 10) { base = (bf16_t*)(ws + WS_BK); ld = 512; coff = (pn - 8) * 256; }
        else if (pn < 14) { base = (bf16_t*)(ws + WS_BV); ld = 1024; coff = (pn - 10) * 256; }
        else if (pn < 22) { base = (bf16_t*)(ws + WS_GATE); ld = 2048; coff = (pn - 14) * 256; }
        else { base = (bf16_t*)(ws + WS_BLR); ld = 512; coff = (pn - 22) * 256; }
        const int row0 = u.pm * 256 + wr * 64 + fr;
        const int ct = wc * 32 + 8 * fq;
        float rsv[8];
#pragma unroll
        for (int it = 0; it < 8; ++it) rsv[it] = rstd[row0 + (it >> 2) * 128 + (it & 3) * 16];
        if (pn >= 22) {
#pragma unroll
            for (int ai = 0; ai < 2; ++ai)
#pragma unroll
                for (int m = 0; m < 4; ++m) {
                    const int row = row0 + ai * 128 + m * 16; const float rs = rsv[ai * 4 + m];
#pragma unroll
                    for (int bj = 0; bj < 2; ++bj) {
                        const int cg = coff + ct + bj * 128;
                        const f32x4 b0 = *(const f32x4*)(blr_b + cg), b1 = *(const f32x4*)(blr_b + cg + 4);
                        f32x4 x0 = acc[ai][bj][m][0] * rs + b0, x1 = acc[ai][bj][m][1] * rs + b1;
#pragma unroll
                        for (int j = 0; j < 4; ++j) { x0[j] = (fminf(x0[j], 0.f) - __logf(1.f + __expf(-fabsf(x0[j])))) * (1.f / 16.f); x1[j] = (fminf(x1[j], 0.f) - __logf(1.f + __expf(-fabsf(x1[j])))) * (1.f / 16.f); }
                        u32x4 w; w.x = cvt_pk_bf16(x0[0], x0[1]); w.y = cvt_pk_bf16(x0[2], x0[3]); w.z = cvt_pk_bf16(x1[0], x1[1]); w.w = cvt_pk_bf16(x1[2], x1[3]);
                        *(u32x4*)(base + (size_t)row * 512 + cg) = w;
                    }
                }
            return;
        }
        const bool kv = (pn == 4 || pn == 5);
        float* okv_p = out + (pn == 4 ? O_KP : O_VP); float* okv_s = out + (pn == 4 ? O_KS : O_VS);
#pragma unroll
        for (int ai = 0; ai < 2; ++ai)
#pragma unroll
            for (int m = 0; m < 4; ++m) {
                const int row = row0 + ai * 128 + m * 16; const float rs = rsv[ai * 4 + m] * sc;
                bf16_t* rowp = base + (size_t)row * ld + coff + ct;
                float* orow = nullptr;
                if (kv) {
                    if (row >= T_P) orow = okv_s + (size_t)(row - T_P) * 256;
                    else { const int b = row >> 11, t = row & 2047; if (t >= 1920) orow = okv_p + (size_t)(b * 128 + t - 1920) * 256; }
                }
#pragma unroll
                for (int bj = 0; bj < 2; ++bj) {
                    const f32x4 v0 = acc[ai][bj][m][0] * rs, v1 = acc[ai][bj][m][1] * rs;
                    u32x4 w; w.x = cvt_pk_bf16(v0[0], v0[1]); w.y = cvt_pk_bf16(v0[2], v0[3]); w.z = cvt_pk_bf16(v1[0], v1[1]); w.w = cvt_pk_bf16(v1[2], v1[3]);
                    *(u32x4*)(rowp + bj * 128) = w;
                    if (kv && orow) { *(f32x4*)(orow + bj * 128 + ct) = v0; *(f32x4*)(orow + bj * 128 + ct + 4) = v1; }
                }
            }
    }
};

template <bool WRITE_BF>
struct EpiOutRes {
    static constexpr bool PERM = false;
    const float* xin_p; const float* xin_s; float* xo; bf16_t* xb; float* rowsq;
    __device__ __forceinline__ void operator()(const AccT& acc, const pg8::Unit& u, int wr, int wc, int fr, int fq) const {
        const int row0 = u.pm * 256 + wr * 64 + fr, col0 = u.pn * 256 + wc * 32 + 4 * fq;
        f32x4 r[3][4];
#define EOR_LOAD(S, IT) do { const int row_ = row0 + ((IT) >> 2) * 128 + ((IT) & 3) * 16; \
            const float* xr_ = (row_ < T_P) ? xin_p + (size_t)row_ * 1024 : xin_s + (size_t)(row_ - T_P) * 1024; \
            r[S][0] = *(const f32x4*)(xr_ + col0); r[S][1] = *(const f32x4*)(xr_ + col0 + 16); r[S][2] = *(const f32x4*)(xr_ + col0 + 128); r[S][3] = *(const f32x4*)(xr_ + col0 + 144); } while (0)
        EOR_LOAD(0, 0); EOR_LOAD(1, 1);
#pragma unroll
        for (int it = 0; it < 8; ++it) {
            if (it + 2 < 8) { if ((it + 2) % 3 == 0) EOR_LOAD(0, it + 2); else if ((it + 2) % 3 == 1) EOR_LOAD(1, it + 2); else EOR_LOAD(2, it + 2); }
            const int ai = it >> 2, m = it & 3;
            const int row = row0 + ai * 128 + m * 16;
            float ss = 0.f;
#pragma unroll
            for (int bj = 0; bj < 2; ++bj)
#pragma unroll
                for (int n = 0; n < 2; ++n) {
                    const int col = col0 + bj * 128 + n * 16;
                    const f32x4 v = acc[ai][bj][m][n] + r[it % 3][bj * 2 + n];
                    if (!WRITE_BF) *(f32x4*)(xo + (size_t)row * 1024 + col) = v;
                    if (WRITE_BF) { u32x2 w; w.x = cvt_pk_bf16(v[0], v[1]); w.y = cvt_pk_bf16(v[2], v[3]); *(u32x2*)(xb + (size_t)row * 1024 + col) = w; }
                    ss += v[0] * v[0] + v[1] * v[1] + v[2] * v[2] + v[3] * v[3];
                }
            ss += __shfl_xor(ss, 16); ss += __shfl_xor(ss, 32);
            if (fq == 0) atomicAdd(rowsq + row, ss);
        }
#undef EOR_LOAD
    }
};

struct EpiOutResB {
    static constexpr bool PERM = false;
    bf16_t* xb; float* rowsq;
    __device__ __forceinline__ void operator()(const AccT& acc, const pg8::Unit& u, int wr, int wc, int fr, int fq) const {
        const int row0 = u.pm * 256 + wr * 64 + fr, col0 = u.pn * 256 + wc * 32 + 4 * fq;
        u32x2 r[3][4];
#define EOB_LOAD(S, IT) do { const bf16_t* xr_ = xb + (size_t)(row0 + ((IT) >> 2) * 128 + ((IT) & 3) * 16) * 1024 + col0; \
            r[S][0] = *(const u32x2*)(xr_); r[S][1] = *(const u32x2*)(xr_ + 16); r[S][2] = *(const u32x2*)(xr_ + 128); r[S][3] = *(const u32x2*)(xr_ + 144); } while (0)
        EOB_LOAD(0, 0); EOB_LOAD(1, 1);
#pragma unroll
        for (int it = 0; it < 8; ++it) {
            if (it + 2 < 8) { if ((it + 2) % 3 == 0) EOB_LOAD(0, it + 2); else if ((it + 2) % 3 == 1) EOB_LOAD(1, it + 2); else EOB_LOAD(2, it + 2); }
            const int ai = it >> 2, m = it & 3;
            const int row = row0 + ai * 128 + m * 16;
            float ss = 0.f;
#pragma unroll
            for (int bj = 0; bj < 2; ++bj)
#pragma unroll
                for (int n = 0; n < 2; ++n) {
                    const int col = col0 + bj * 128 + n * 16;
                    const u32x2 rw = r[it % 3][bj * 2 + n];
                    f32x4 v = acc[ai][bj][m][n];
                    v[0] += bflo(rw.x); v[1] += bfhi(rw.x); v[2] += bflo(rw.y); v[3] += bfhi(rw.y);
                    u32x2 w; w.x = cvt_pk_bf16(v[0], v[1]); w.y = cvt_pk_bf16(v[2], v[3]);
                    *(u32x2*)(xb + (size_t)row * 1024 + col) = w;
                    ss += v[0] * v[0] + v[1] * v[1] + v[2] * v[2] + v[3] * v[3];
                }
            ss += __shfl_xor(ss, 16); ss += __shfl_xor(ss, 32);
            if (fq == 0) atomicAdd(rowsq + row, ss);
        }
#undef EOB_LOAD
    }
};

struct EpiInOdd {
    static constexpr bool PERM = true;
    bf16_t* z2; const float* rowsq;
    __device__ __forceinline__ void operator()(const AccT& acc, const pg8::Unit& u, int wr, int wc, int fr, int fq) const {
        const int row0 = u.pm * 256 + wr * 64 + fr, col0 = u.pn * 256 + wc * 32 + 8 * fq;
        float rsv[8];
#pragma unroll
        for (int it = 0; it < 8; ++it) rsv[it] = rowsq[row0 + (it >> 2) * 128 + (it & 3) * 16];
#pragma unroll
        for (int ai = 0; ai < 2; ++ai)
#pragma unroll
            for (int m = 0; m < 4; ++m) {
                const int row = row0 + ai * 128 + m * 16; const float rs = rsqrtf(rsv[ai * 4 + m] * (1.f / 1024.f) + EPS);
#pragma unroll
                for (int bj = 0; bj < 2; ++bj) {
                    const f32x4 v0 = acc[ai][bj][m][0] * rs, v1 = acc[ai][bj][m][1] * rs;
                    u32x4 w; w.x = cvt_pk_bf16(v0[0], v0[1]); w.y = cvt_pk_bf16(v0[2], v0[3]); w.z = cvt_pk_bf16(v1[0], v1[1]); w.w = cvt_pk_bf16(v1[2], v1[3]);
                    *(u32x4*)(z2 + (size_t)row * 3072 + col0 + bj * 128) = w;
                }
            }
    }
};

struct EpiPartial {
    static constexpr bool PERM = false;
    float* P;
    __device__ __forceinline__ void operator()(const AccT& acc, const pg8::Unit& u, int wr, int wc, int fr, int fq) const {
        float* base = P + (size_t)u.aux * 65536 + (size_t)(wr * 64 + fr) * 256 + wc * 32 + 4 * fq;
#pragma unroll
        for (int ai = 0; ai < 2; ++ai)
#pragma unroll
            for (int m = 0; m < 4; ++m)
#pragma unroll
                for (int bj = 0; bj < 2; ++bj)
#pragma unroll
                    for (int n = 0; n < 2; ++n) *(f32x4*)(base + (size_t)(ai * 128 + m * 16) * 256 + bj * 128 + n * 16) = acc[ai][bj][m][n];
    }
};
__device__ __forceinline__ void splitk_reduce(const pg8::StaticOrder& S, int first, int nsl, const float* P, bf16_t* xb, float* rowsq) {
    const int lane = threadIdx.x & 63;
    const int gw = (int)((blockIdx.x * NTHR + threadIdx.x) >> 6), nw = (int)((gridDim.x * NTHR) >> 6);
    for (int ri = gw; ri < 32 * 256; ri += nw) {
        const int ui = ri >> 8, r = ri & 255;
        pg8::Unit u; S.map(first + ui, u);
        const int row = u.pm * 256 + r, col = u.pn * 256 + lane * 4;
        const u32x2 rw = *(const u32x2*)(xb + (size_t)row * 1024 + col);
        f32x4 v = {bflo(rw.x), bfhi(rw.x), bflo(rw.y), bfhi(rw.y)};
        for (int sl = 0; sl < nsl; ++sl) v += *(const f32x4*)(P + ((size_t)(sl * 32 + ui) * 256 + r) * 256 + lane * 4);
        u32x2 w; w.x = cvt_pk_bf16(v[0], v[1]); w.y = cvt_pk_bf16(v[2], v[3]);
        *(u32x2*)(xb + (size_t)row * 1024 + col) = w;
        float ss = v[0] * v[0] + v[1] * v[1] + v[2] * v[2] + v[3] * v[3];
#pragma unroll
        for (int o = 32; o >= 1; o >>= 1) ss += __shfl_xor(ss, o);
        if (lane == 0) atomicAdd(rowsq + row, ss);
    }
}

template <int MODE>
__device__ __forceinline__ void transpose_w(const float* __restrict__ src, int K, int Nsrc, bf16_t* __restrict__ dst, int Ndst, const float* __restrict__ gain, long gtid, long gsz, float wscale = 1.f) {
    const long total = (long)(K / 8) * Ndst;
#pragma unroll 4
    for (long it = gtid; it < total; it += gsz) {
        const int n = (int)(it % Ndst), k8 = (int)(it / Ndst);
        int sc = n;
        if (MODE == 1) { if (n < 3584) sc = n; else sc = n + 16; }
        u32x4 w = {0u, 0u, 0u, 0u};
        if (sc >= 0) {
            const float* s = src + (size_t)(k8 * 8) * Nsrc + sc;
            float v0 = s[0], v1 = s[(size_t)Nsrc], v2 = s[(size_t)2 * Nsrc], v3 = s[(size_t)3 * Nsrc], v4 = s[(size_t)4 * Nsrc], v5 = s[(size_t)5 * Nsrc], v6 = s[(size_t)6 * Nsrc], v7 = s[(size_t)7 * Nsrc];
            if (gain) { const f32x4 g0 = *(const f32x4*)(gain + k8 * 8), g1 = *(const f32x4*)(gain + k8 * 8 + 4); v0 *= g0[0]; v1 *= g0[1]; v2 *= g0[2]; v3 *= g0[3]; v4 *= g1[0]; v5 *= g1[1]; v6 *= g1[2]; v7 *= g1[3]; }
            w.x = cvt_pk_bf16(v0 * wscale, v1 * wscale); w.y = cvt_pk_bf16(v2 * wscale, v3 * wscale); w.z = cvt_pk_bf16(v4 * wscale, v5 * wscale); w.w = cvt_pk_bf16(v6 * wscale, v7 * wscale);
        }
        *(u32x4*)(dst + (size_t)n * K + k8 * 8) = w;
    }
}

__device__ __forceinline__ void phase0(const Params& p) {
    unsigned char* ws = p.ws;
    const long gtid = (long)blockIdx.x * NTHR + threadIdx.x, gsz = (long)gridDim.x * NTHR;
    transpose_w<1>(p.in[8], 1024, 5648, (bf16_t*)(ws + WS_WINE), 5632, p.in[7], gtid, gsz);
    for (long it = gtid; it < 128L * 512; it += gsz) {
        const int n = (int)(it & 511), k8 = (int)(it >> 9);
        float wl[16];
#pragma unroll
        for (int r = 0; r < 16; ++r) wl[r] = p.in[9][r * 512 + n];
        float v[8];
#pragma unroll
        for (int i = 0; i < 8; ++i) {
            const float* wr_ = p.in[8] + (size_t)(k8 * 8 + i) * 5648 + 3584;
            float a = 0.f;
#pragma unroll
            for (int r4 = 0; r4 < 4; ++r4) { const f32x4 x = *(const f32x4*)(wr_ + r4 * 4); a += x[0] * wl[r4 * 4] + x[1] * wl[r4 * 4 + 1] + x[2] * wl[r4 * 4 + 2] + x[3] * wl[r4 * 4 + 3]; }
            v[i] = a * p.in[7][k8 * 8 + i];
        }
        u32x4 w; w.x = cvt_pk_bf16(v[0], v[1]); w.y = cvt_pk_bf16(v[2], v[3]); w.z = cvt_pk_bf16(v[4], v[5]); w.w = cvt_pk_bf16(v[6], v[7]);
        *(u32x4*)((bf16_t*)(ws + WS_WINE) + (size_t)(5632 + n) * 1024 + k8 * 8) = w;
    }
    transpose_w<0>(p.in[13], 2048, 1024, (bf16_t*)(ws + WS_WOUTE), 1024, nullptr, gtid, gsz);
    transpose_w<0>(p.in[15], 1024, 3072, (bf16_t*)(ws + WS_WINO), 3072, p.in[14], gtid, gsz);
    transpose_w<0>(p.in[23], 1536, 1024, (bf16_t*)(ws + WS_WOUTO), 1024, nullptr, gtid, gsz);
    for (int nb = 0; nb < 8; ++nb) {
        transpose_w<0>(p.in[18] + nb * 192 * 192, 192, 192, (bf16_t*)(ws + WS_WA) + nb * 192 * 192, 192, nullptr, gtid, gsz, 1.4426950408889634f);
        transpose_w<0>(p.in[20] + nb * 192 * 192, 192, 192, (bf16_t*)(ws + WS_WI) + nb * 192 * 192, 192, nullptr, gtid, gsz, 1.4426950408889634f);
    }
    { float* z = (float*)(ws + WS_RSQ1); const long nz = (long)T * 2; for (long i = gtid; i < nz; i += gsz) z[i] = 0.f; }
    const int lane = threadIdx.x & 63; const int gw = (int)(gtid >> 6), nw = (int)(gsz >> 6);
    bf16_t* xb = (bf16_t*)(ws + WS_XB); float* rstd = (float*)(ws + WS_RSTD0);
#pragma unroll 4
    for (int row = gw; row < T; row += nw) {
        const float* xr = (row < T_P) ? p.in[0] + (size_t)row * 1024 : p.in[1] + (size_t)(row - T_P) * 1024;
        float ss = 0.f;
#pragma unroll
        for (int i = 0; i < 4; ++i) {
            const f32x4 v = *(const f32x4*)(xr + i * 256 + lane * 4);
            ss += v[0] * v[0] + v[1] * v[1] + v[2] * v[2] + v[3] * v[3];
            u32x2 w; w.x = cvt_pk_bf16(v[0], v[1]); w.y = cvt_pk_bf16(v[2], v[3]);
            *(u32x2*)(xb + (size_t)row * 1024 + i * 256 + lane * 4) = w;
        }
#pragma unroll
        for (int o = 32; o >= 1; o >>= 1) ss += __shfl_xor(ss, o);
        if (lane == 0) rstd[row] = rsqrtf(ss * (1.f / 1024.f) + EPS);
    }
}

__device__ __forceinline__ void attn_item(const Params& p, LAS unsigned char* L, int item, bf16_t* Yd, int ldd) {
    unsigned char* ws = p.ws;
    const int tid = threadIdx.x, lane = tid & 63, w = tid >> 6, r16 = lane & 15, q4 = lane >> 4;
    LAS bf16_t* Ks = (LAS bf16_t*)L;
    LAS bf16_t* Vs = (LAS bf16_t*)(L + 192 * 72 * 2);
    const unsigned vbase = (unsigned)(size_t)L + 192u * 72u * 2u;
    const bf16_t* Qb = (const bf16_t*)(ws + WS_Q); const bf16_t* Kb = (const bf16_t*)(ws + WS_K); const bf16_t* Vb = (const bf16_t*)(ws + WS_V);
    const bf16_t* Yb = (const bf16_t*)(ws + WS_GATE);
    const bool smp = item >= 2048;
    int b, c, kh; size_t row0;
    if (!smp) { kh = item & 3; c = (item >> 2) & 31; b = item >> 7; row0 = (size_t)b * 2048 + c * 64; }
    else { const int i2 = item - 2048; kh = i2 & 3; b = i2 >> 2; c = 0; row0 = (size_t)T_P + b * 64; }
    const int g = w >> 1, i0 = (w & 1) * 32, h = kh * 4 + g;
    bf16x8 qf[2][2];
#pragma unroll
    for (int qt = 0; qt < 2; ++qt) {
#pragma unroll
        for (int ks = 0; ks < 2; ++ks) qf[qt][ks] = *(const bf16x8*)(Qb + (row0 + i0 + qt * 16 + r16) * 1024 + h * 64 + ks * 32 + q4 * 8);
    }
#pragma unroll
    for (int i = 0; i < 3; ++i) {
        const int idx = tid + i * 512, key = idx >> 3, dg = idx & 7;
        u32x4 kv = {0u, 0u, 0u, 0u}, vv = {0u, 0u, 0u, 0u};
        if (!smp) {
            const int pos = c * 64 - 128 + key;
            if (pos >= 0) { const size_t r = (size_t)b * 2048 + pos; kv = *(const u32x4*)(Kb + r * 256 + kh * 64 + dg * 8); vv = *(const u32x4*)(Vb + r * 256 + kh * 64 + dg * 8); }
        } else {
            if (key < 128) {
                const size_t o = ((size_t)(b * 128 + key) * 4 + kh) * 64 + dg * 8;
                const f32x4 k0 = *(const f32x4*)(p.in[2] + o), k1 = *(const f32x4*)(p.in[2] + o + 4), v0 = *(const f32x4*)(p.in[3] + o), v1 = *(const f32x4*)(p.in[3] + o + 4);
                kv.x = cvt_pk_bf16(k0[0], k0[1]); kv.y = cvt_pk_bf16(k0[2], k0[3]); kv.z = cvt_pk_bf16(k1[0], k1[1]); kv.w = cvt_pk_bf16(k1[2], k1[3]);
                vv.x = cvt_pk_bf16(v0[0], v0[1]); vv.y = cvt_pk_bf16(v0[2], v0[3]); vv.z = cvt_pk_bf16(v1[0], v1[1]); vv.w = cvt_pk_bf16(v1[2], v1[3]);
            } else { const size_t r = (size_t)T_P + b * 64 + key - 128; kv = *(const u32x4*)(Kb + r * 256 + kh * 64 + dg * 8); vv = *(const u32x4*)(Vb + r * 256 + kh * 64 + dg * 8); }
        }
        *(LAS u32x4*)(Ks + key * 72 + dg * 8) = kv;
        *(LAS u32x4*)(Vs + key * 72 + dg * 8) = vv;
    }
    __syncthreads();
    const float slope = exp2f(-0.5f * (float)(h + 1)) * 1.4426950408889634f;
    const float sink = p.in[11][h] * 1.4426950408889634f;
    const unsigned va = vbase + (unsigned)(((q4 * 4 + (r16 >> 2)) * 72 + 4 * (r16 & 3)) * 2);
#pragma unroll 1
    for (int qt = 0; qt < 2; ++qt) {
        const int i = i0 + qt * 16 + r16;
        const bf16x8 qa = qt ? qf[1][0] : qf[0][0], qb = qt ? qf[1][1] : qf[0][1];
        u32x2 gv[4];
#pragma unroll
        for (int dt = 0; dt < 4; ++dt) gv[dt] = *(const u32x2*)(Yb + (row0 + i) * 2048 + h * 64 + dt * 16 + q4 * 4);
        f32x4 sacc[12];
#pragma unroll
        for (int kt = 0; kt < 12; ++kt) {
            const bf16x8 kf0 = *(const LAS bf16x8*)(Ks + (kt * 16 + r16) * 72 + q4 * 8), kf1 = *(const LAS bf16x8*)(Ks + (kt * 16 + r16) * 72 + 32 + q4 * 8);
            f32x4 a = {0.f, 0.f, 0.f, 0.f}; a = MFMA16(kf0, qa, a); a = MFMA16(kf1, qb, a); sacc[kt] = a;
        }
        const float dbase = (float)(128 + i - q4 * 4);
#pragma unroll
        for (int kt = 0; kt < 12; ++kt)
#pragma unroll
            for (int jj = 0; jj < 4; ++jj) sacc[kt][jj] = fmaf(-slope, fabsf(dbase - (float)(kt * 16 + jj)), sacc[kt][jj]);
        if (!smp && c < 2) {
#pragma unroll
            for (int kt = 0; kt < 8; ++kt)
#pragma unroll
                for (int jj = 0; jj < 4; ++jj) { const int j = kt * 16 + q4 * 4 + jj; if ((c * 64 - 128 + j) < 0) sacc[kt][jj] = -1e30f; }
        }
        float m = -3e38f;
#pragma unroll
        for (int kt = 0; kt < 12; ++kt)
#pragma unroll
            for (int jj = 0; jj < 4; ++jj) m = fmaxf(m, sacc[kt][jj]);
        m = fmaxf(m, __shfl_xor(m, 16)); m = fmaxf(m, __shfl_xor(m, 32)); m = fmaxf(m, sink);
        float l = 0.f;
#pragma unroll
        for (int kt = 0; kt < 12; ++kt)
#pragma unroll
            for (int jj = 0; jj < 4; ++jj) { const float pr = __builtin_amdgcn_exp2f(sacc[kt][jj] - m); sacc[kt][jj] = pr; l += pr; }
        l += __shfl_xor(l, 16); l += __shfl_xor(l, 32); l += __builtin_amdgcn_exp2f(sink - m);
        const float inv = 1.f / l;
        f32x4 oacc[4];
#pragma unroll
        for (int dt = 0; dt < 4; ++dt) oacc[dt] = (f32x4){0.f, 0.f, 0.f, 0.f};
#pragma unroll
        for (int kb = 0; kb < 6; ++kb) {
            const bf16x8 pf = pack8(sacc[2 * kb], sacc[2 * kb + 1]);
            bf16x4 l0, h0, l1, h1, l2, h2, l3, h3;
            const unsigned vk = va + (unsigned)(kb * 32 * 144);
            asm volatile("ds_read_b64_tr_b16 %0, %8\n\tds_read_b64_tr_b16 %1, %8 offset:2304\n\t"
                         "ds_read_b64_tr_b16 %2, %8 offset:32\n\tds_read_b64_tr_b16 %3, %8 offset:2336\n\t"
                         "ds_read_b64_tr_b16 %4, %8 offset:64\n\tds_read_b64_tr_b16 %5, %8 offset:2368\n\t"
                         "ds_read_b64_tr_b16 %6, %8 offset:96\n\tds_read_b64_tr_b16 %7, %8 offset:2400\n\t"
                         "s_waitcnt lgkmcnt(0)"
                         : "=&v"(l0), "=&v"(h0), "=&v"(l1), "=&v"(h1), "=&v"(l2), "=&v"(h2), "=&v"(l3), "=&v"(h3) : "v"(vk) : "memory");
            oacc[0] = MFMA16(cat4(l0, h0), pf, oacc[0]); oacc[1] = MFMA16(cat4(l1, h1), pf, oacc[1]);
            oacc[2] = MFMA16(cat4(l2, h2), pf, oacc[2]); oacc[3] = MFMA16(cat4(l3, h3), pf, oacc[3]);
        }
#pragma unroll
        for (int dt = 0; dt < 4; ++dt) {
            const u32x2 gq = gv[dt];
            const f32x4 o = oacc[dt] * inv;
            u32x2 wv; wv.x = cvt_pk_bf16(o[0] * siluf(bflo(gq.x)), o[1] * siluf(bfhi(gq.x))); wv.y = cvt_pk_bf16(o[2] * siluf(bflo(gq.y)), o[3] * siluf(bfhi(gq.y)));
            *(u32x2*)(Yd + (row0 + i) * ldd + h * 64 + dt * 16 + q4 * 4) = wv;
        }
    }
    __syncthreads();
}

constexpr size_t SC_SQ = 0;
constexpr size_t SC_ET = 9437184;
constexpr size_t SC_AB = 16777216;
static_assert(SC_AB + (size_t)T * 256 * 2 <= (size_t)T * 1024 * 4, "scratch must fit in the y region of d_out");

struct PrepRegs { u32x4 g0, g1, q0, q1, k0, k1; };
__device__ __forceinline__ unsigned prep_row0(int item, int& h) {
    if (item < 2048) { h = item & 3; const int c = (item >> 2) & 31; const int b = item >> 7; return (unsigned)b * 2048 + c * 64; }
    const int i2 = item - 2048; h = i2 & 3; return (unsigned)T_P + (i2 >> 2) * 64;
}
__device__ __forceinline__ void prep_load(const Params& p, int item, PrepRegs& R) {
    const int tid = threadIdx.x; int h; const unsigned row0 = prep_row0(item, h);
    const bf16_t* BQ = (const bf16_t*)(p.ws + WS_BQ); const bf16_t* BKb = (const bf16_t*)(p.ws + WS_BK); const bf16_t* GB = (const bf16_t*)(p.ws + WS_BLR);
    const int pt0 = tid >> 4, pt1 = (tid + 512) >> 4, poc = tid & 15;
    const unsigned o0 = (row0 + pt0) * 512u + h * 128 + poc * 8, o1 = (row0 + pt1) * 512u + h * 128 + poc * 8;
    R.g0 = *(const u32x4*)(GB + o0); R.g1 = *(const u32x4*)(GB + o1);
    R.q0 = *(const u32x4*)(BQ + o0); R.q1 = *(const u32x4*)(BQ + o1); R.k0 = *(const u32x4*)(BKb + o0); R.k1 = *(const u32x4*)(BKb + o1);
}
__device__ __forceinline__ void gla_prep_item(const Params& p, LAS unsigned char* L, int item, const PrepRegs& cur, int next_item, PrepRegs& nxt) {
    unsigned char* ws = p.ws;
    const int tid = threadIdx.x, lane = tid & 63, w = tid >> 6, r16 = lane & 15, q4 = lane >> 4;
    LAS bf16_t* QG = (LAS bf16_t*)L;
    LAS bf16_t* KG = (LAS bf16_t*)(L + 17408);
    LAS bf16_t* Gs = (LAS bf16_t*)(L + 34816);
    LAS float* Gf = (LAS float*)(L + 52224);
    LAS float* GT = (LAS float*)(L + 84992);
    int h; const unsigned row0 = prep_row0(item, h);
    bf16_t* BQ = (bf16_t*)(ws + WS_BQ); bf16_t* BKb = (bf16_t*)(ws + WS_BK);
    float* ET = (float*)((unsigned char*)p.out + SC_ET); bf16_t* AB = (bf16_t*)((unsigned char*)p.out + SC_AB);
    const int c = tid & 127, tg = tid >> 7;
    const int pt0 = tid >> 4, pt1 = (tid + 512) >> 4, poc = tid & 15;
    const unsigned o0 = (row0 + pt0) * 512u + h * 128 + poc * 8, o1 = (row0 + pt1) * 512u + h * 128 + poc * 8;
    const u32x4 pq0 = cur.q0, pq1 = cur.q1, pk0 = cur.k0, pk1 = cur.k1;
    *(LAS u32x4*)(Gs + pt0 * 136 + poc * 8) = cur.g0; *(LAS u32x4*)(Gs + pt1 * 136 + poc * 8) = cur.g1;
    lds_barrier();
    if (next_item >= 0) prep_load(p, next_item, nxt);
    {
        float cs = 0.f;
#pragma unroll
        for (int tt = 0; tt < 16; ++tt) { cs += bf2f(Gs[(tg * 16 + tt) * 136 + c]); Gf[(tg * 16 + tt) * 128 + c] = cs; }
        GT[tg * 128 + c] = cs;
    }
    lds_barrier();
#pragma unroll
    for (int i = 0; i < 2; ++i) {
        const int t = i ? pt1 : pt0; const int tgp = t >> 4;
        const u32x4 qw = i ? pq1 : pq0, kw = i ? pk1 : pk0;
        float G[8], tot[8];
        { const f32x4 a0 = *(const LAS f32x4*)(Gf + t * 128 + poc * 8), a1 = *(const LAS f32x4*)(Gf + t * 128 + poc * 8 + 4);
          G[0] = a0[0]; G[1] = a0[1]; G[2] = a0[2]; G[3] = a0[3]; G[4] = a1[0]; G[5] = a1[1]; G[6] = a1[2]; G[7] = a1[3]; }
#pragma unroll
        for (int j = 0; j < 8; ++j) tot[j] = 0.f;
#pragma unroll
        for (int g2 = 0; g2 < 4; ++g2) {
            const f32x4 a0 = *(const LAS f32x4*)(GT + g2 * 128 + poc * 8), a1 = *(const LAS f32x4*)(GT + g2 * 128 + poc * 8 + 4);
            const float sel = (g2 < tgp) ? 1.f : 0.f;
            G[0] += sel * a0[0]; G[1] += sel * a0[1]; G[2] += sel * a0[2]; G[3] += sel * a0[3]; G[4] += sel * a1[0]; G[5] += sel * a1[1]; G[6] += sel * a1[2]; G[7] += sel * a1[3];
            tot[0] += a0[0]; tot[1] += a0[1]; tot[2] += a0[2]; tot[3] += a0[3]; tot[4] += a1[0]; tot[5] += a1[1]; tot[6] += a1[2]; tot[7] += a1[3];
        }
        if (i == 0 && tid < 16) {
            float* ep = ET + (size_t)(row0 >> 6) * 512 + h * 128 + poc * 8;
            *(f32x4*)ep = (f32x4){__expf(tot[0]), __expf(tot[1]), __expf(tot[2]), __expf(tot[3])};
            *(f32x4*)(ep + 4) = (f32x4){__expf(tot[4]), __expf(tot[5]), __expf(tot[6]), __expf(tot[7])};
        }
        float qv[8], kv[8];
        unpack8(qw, qv); unpack8(kw, kv);
#pragma unroll
        for (int j = 0; j < 8; ++j) { const float eg = __expf(G[j]); qv[j] *= eg; kv[j] *= rcpf_(eg); }
        u32x4 qo, ko;
        qo.x = cvt_pk_bf16(qv[0], qv[1]); qo.y = cvt_pk_bf16(qv[2], qv[3]); qo.z = cvt_pk_bf16(qv[4], qv[5]); qo.w = cvt_pk_bf16(qv[6], qv[7]);
        ko.x = cvt_pk_bf16(kv[0], kv[1]); ko.y = cvt_pk_bf16(kv[2], kv[3]); ko.z = cvt_pk_bf16(kv[4], kv[5]); ko.w = cvt_pk_bf16(kv[6], kv[7]);
        *(LAS u32x4*)(QG + t * 136 + poc * 8) = qo; *(LAS u32x4*)(KG + t * 136 + poc * 8) = ko;
        *(u32x4*)(BQ + (i ? o1 : o0)) = qo; *(u32x4*)(BKb + (i ? o1 : o0)) = ko;
    }
    lds_barrier();
    {
        const int it = w >> 1, jt0 = (w & 1) * 2;
        f32x4 at[2];
        at[0] = (f32x4){0.f, 0.f, 0.f, 0.f}; at[1] = (f32x4){0.f, 0.f, 0.f, 0.f};
#pragma unroll
        for (int ks = 0; ks < 4; ++ks) {
            const bf16x8 qf = *(const LAS bf16x8*)(QG + (it * 16 + r16) * 136 + ks * 32 + q4 * 8);
#pragma unroll
            for (int t2 = 0; t2 < 2; ++t2) {
                const bf16x8 kf = *(const LAS bf16x8*)(KG + ((jt0 + t2) * 16 + r16) * 136 + ks * 32 + q4 * 8);
                at[t2] = MFMA16(kf, qf, at[t2]);
            }
        }
        const int i = it * 16 + r16;
#pragma unroll
        for (int t2 = 0; t2 < 2; ++t2) {
            f32x4 v = at[t2];
#pragma unroll
            for (int jj = 0; jj < 4; ++jj) { const int j = (jt0 + t2) * 16 + q4 * 4 + jj; if (j > i) v[jj] = 0.f; }
            u32x2 wv; wv.x = cvt_pk_bf16(v[0], v[1]); wv.y = cvt_pk_bf16(v[2], v[3]);
            *(u32x2*)(AB + (size_t)(row0 + i) * 256 + h * 64 + (jt0 + t2) * 16 + q4 * 4) = wv;
        }
    }
    lds_barrier();
}

__device__ __forceinline__ void gla_scan_item(const Params& p, LAS unsigned char* L, int item, bool dummy) {
    unsigned char* ws = p.ws;
    const int tid = threadIdx.x, lane = tid & 63, w = tid >> 6, r16 = lane & 15, q4 = lane >> 4;
    LAS bf16_t* QG = (LAS bf16_t*)L;
    LAS bf16_t* KG = (LAS bf16_t*)(L + 17408);
    LAS bf16_t* Vs = (LAS bf16_t*)(L + 34816);
    LAS bf16_t* As = (LAS bf16_t*)(L + 44032);
    LAS float* GL = (LAS float*)(L + 53248);
    const unsigned lbase = (unsigned)(size_t)L;
    const bool smp = item >= 256;
    const int i2 = smp ? item - 256 : item;
    const int b = i2 >> 4, h = (i2 >> 2) & 3, sl = i2 & 3, e0 = sl * 64;
    const int nch = smp ? 1 : 32;
    const unsigned rbase = smp ? (unsigned)T_P + b * 64 : (unsigned)b * 2048;
    const bf16_t* BQ = (const bf16_t*)(ws + WS_BQ); const bf16_t* BKb = (const bf16_t*)(ws + WS_BK); bf16_t* BV = (bf16_t*)(ws + WS_BV);
    const float* ET = (const float*)((unsigned char*)p.out + SC_ET); const bf16_t* AB = (const bf16_t*)((unsigned char*)p.out + SC_AB); float* BOSQP = dummy ? p.out + 20000000 : (float*)((unsigned char*)p.out + SC_SQ);
    bf16_t* BVo = dummy ? (bf16_t*)((unsigned char*)p.out + 67108864) : BV;
    const int pt0 = tid >> 4, pt1 = (tid + 512) >> 4, poc = tid & 15;
    const int vt = tid >> 3, veo = tid & 7;
    const int et = w & 3, ip = w >> 2;
    f32x4 Sacc[8];
#pragma unroll
    for (int d8 = 0; d8 < 8; ++d8) {
        if (smp) {
#pragma unroll
            for (int jj = 0; jj < 4; ++jj) Sacc[d8][jj] = p.in[4][((size_t)(b * 4 + h) * 128 + d8 * 16 + q4 * 4 + jj) * 256 + e0 + et * 16 + r16];
        } else Sacc[d8] = (f32x4){0.f, 0.f, 0.f, 0.f};
    }
    const int tq_ = r16 >> 2, tp_ = r16 & 3;
    const unsigned v4a = lbase + 34816u + (unsigned)(((q4 * 8 + tq_) * 72 + et * 16 + 4 * tp_) * 2);
    const unsigned k4a = lbase + 17408u + (unsigned)(((q4 * 8 + tq_) * 136 + 4 * tp_) * 2);
    struct Pre { u32x4 q0, q1, k0, k1, a, v; f32x4 e; };
    Pre PA, PB;
    PA.e = (f32x4){0.f, 0.f, 0.f, 0.f}; PB.e = (f32x4){0.f, 0.f, 0.f, 0.f};
#define GLA_PREFETCH(P, R) do { \
        const unsigned o0_ = ((R) + pt0) * 512u + h * 128 + poc * 8, o1_ = ((R) + pt1) * 512u + h * 128 + poc * 8; \
        P.q0 = *(const u32x4*)(BQ + o0_); P.q1 = *(const u32x4*)(BQ + o1_); P.k0 = *(const u32x4*)(BKb + o0_); P.k1 = *(const u32x4*)(BKb + o1_); \
        P.a = *(const u32x4*)(AB + ((R) + vt) * 256u + h * 64 + veo * 8); \
        P.v = *(const u32x4*)(BV + ((R) + vt) * 1024u + h * 256 + e0 + veo * 8); \
        if (tid < 32) P.e = *(const f32x4*)(ET + ((R) >> 6) * 512u + h * 128 + tid * 4); } while (0)
    GLA_PREFETCH(PA, rbase);
    if (nch > 1) GLA_PREFETCH(PB, rbase + 64);
    f32x4 po0 = {0.f, 0.f, 0.f, 0.f}, po1 = {0.f, 0.f, 0.f, 0.f}; unsigned prow = 0; bool pend = false;
#define GLA_STORE_OUT() do { \
            _Pragma("unroll") for (int x2 = 0; x2 < 2; ++x2) { \
                const unsigned row = prow + (ip * 2 + x2) * 16 + r16; \
                const f32x4 o = x2 ? po1 : po0; \
                u32x2 wv; wv.x = cvt_pk_bf16(o[0], o[1]); wv.y = cvt_pk_bf16(o[2], o[3]); \
                *(u32x2*)(BVo + row * 1024u + h * 256 + e0 + et * 16 + q4 * 4) = wv; \
                float ss = o[0] * o[0] + o[1] * o[1] + o[2] * o[2] + o[3] * o[3]; \
                ss += __shfl_xor(ss, 16); ss += __shfl_xor(ss, 32); \
                if (q4 == 0) BOSQP[row * 64u + h * 16 + sl * 4 + et] = ss; \
            } } while (0)
#define GLA_CHUNK(P, CI) do { \
        const unsigned r0 = rbase + (unsigned)(CI) * 64; \
        *(LAS u32x4*)(QG + pt0 * 136 + poc * 8) = P.q0; *(LAS u32x4*)(QG + pt1 * 136 + poc * 8) = P.q1; \
        *(LAS u32x4*)(KG + pt0 * 136 + poc * 8) = P.k0; *(LAS u32x4*)(KG + pt1 * 136 + poc * 8) = P.k1; \
        *(LAS u32x4*)(As + vt * 72 + veo * 8) = P.a; *(LAS u32x4*)(Vs + vt * 72 + veo * 8) = P.v; \
        if (tid < 32) *(LAS f32x4*)(GL + tid * 4) = P.e; \
        lds_barrier(); \
        if (pend) GLA_STORE_OUT(); \
        if ((CI) + 2 < nch) GLA_PREFETCH(P, r0 + 128); \
        bf16x8 vf[2]; \
        { bf16x4 a0, a1, b0, b1; \
          asm volatile("ds_read_b64_tr_b16 %0, %4\n\tds_read_b64_tr_b16 %1, %4 offset:576\n\tds_read_b64_tr_b16 %2, %4 offset:4608\n\tds_read_b64_tr_b16 %3, %4 offset:5184\n\ts_waitcnt lgkmcnt(0)" \
                       : "=&v"(a0), "=&v"(a1), "=&v"(b0), "=&v"(b1) : "v"(v4a) : "memory"); \
          vf[0] = cat4(a0, a1); vf[1] = cat4(b0, b1); } \
        f32x4 ot[2]; \
        ot[0] = (f32x4){0.f, 0.f, 0.f, 0.f}; ot[1] = (f32x4){0.f, 0.f, 0.f, 0.f}; \
        _Pragma("unroll") for (int x2 = 0; x2 < 2; ++x2) \
            _Pragma("unroll") for (int jb = 0; jb < 2; ++jb) { \
                const bf16x8 af = *(const LAS bf16x8*)(As + ((ip * 2 + x2) * 16 + r16) * 72 + jb * 32 + q4 * 8); \
                ot[x2] = MFMA16(vf[jb], af, ot[x2]); } \
        _Pragma("unroll") for (int db = 0; db < 4; ++db) { \
            const bf16x8 sf = pack8(Sacc[2 * db], Sacc[2 * db + 1]); \
            _Pragma("unroll") for (int x2 = 0; x2 < 2; ++x2) { \
                const LAS bf16_t* qp = QG + ((ip * 2 + x2) * 16 + r16) * 136 + db * 32 + q4 * 4; \
                const bf16x8 qv = cat4(*(const LAS bf16x4*)qp, *(const LAS bf16x4*)(qp + 16)); \
                ot[x2] = MFMA16(sf, qv, ot[x2]); } } \
        po0 = ot[0]; po1 = ot[1]; prow = r0; pend = true; \
        _Pragma("unroll") for (int jb = 0; jb < 2; ++jb) { \
            bf16x4 kl[8], kh[8]; \
            const unsigned ka = k4a + (unsigned)(jb * 32 * 272); \
            asm volatile("ds_read_b64_tr_b16 %0, %16 offset:0\n\t" "ds_read_b64_tr_b16 %1, %16 offset:1088\n\t" "ds_read_b64_tr_b16 %2, %16 offset:32\n\t" "ds_read_b64_tr_b16 %3, %16 offset:1120\n\t" "ds_read_b64_tr_b16 %4, %16 offset:64\n\t" "ds_read_b64_tr_b16 %5, %16 offset:1152\n\t" "ds_read_b64_tr_b16 %6, %16 offset:96\n\t" "ds_read_b64_tr_b16 %7, %16 offset:1184\n\t" "ds_read_b64_tr_b16 %8, %16 offset:128\n\t" "ds_read_b64_tr_b16 %9, %16 offset:1216\n\t" "ds_read_b64_tr_b16 %10, %16 offset:160\n\t" "ds_read_b64_tr_b16 %11, %16 offset:1248\n\t" "ds_read_b64_tr_b16 %12, %16 offset:192\n\t" "ds_read_b64_tr_b16 %13, %16 offset:1280\n\t" "ds_read_b64_tr_b16 %14, %16 offset:224\n\t" "ds_read_b64_tr_b16 %15, %16 offset:1312\n\t" "s_waitcnt lgkmcnt(0)" \
                         : "=&v"(kl[0]), "=&v"(kh[0]), "=&v"(kl[1]), "=&v"(kh[1]), "=&v"(kl[2]), "=&v"(kh[2]), "=&v"(kl[3]), "=&v"(kh[3]), "=&v"(kl[4]), "=&v"(kh[4]), "=&v"(kl[5]), "=&v"(kh[5]), "=&v"(kl[6]), "=&v"(kh[6]), "=&v"(kl[7]), "=&v"(kh[7]) : "v"(ka) : "memory"); \
            _Pragma("unroll") for (int d8 = 0; d8 < 8; ++d8) Sacc[d8] = MFMA16(cat4(kl[d8], kh[d8]), vf[jb], Sacc[d8]); } \
        _Pragma("unroll") for (int d8 = 0; d8 < 8; ++d8) { \
            const f32x4 dec = *(const LAS f32x4*)(GL + d8 * 16 + q4 * 4); \
            Sacc[d8] = Sacc[d8] * dec; } \
        lds_barrier(); \
    } while (0)
    for (int ci = 0; ci < nch; ci += 2) {
        GLA_CHUNK(PA, ci);
        if (ci + 1 < nch) GLA_CHUNK(PB, ci + 1);
    }
    if (pend) GLA_STORE_OUT();
#undef GLA_STORE_OUT
#undef GLA_PREFETCH
#undef GLA_CHUNK
    if (ip == 0 && !dummy) {
        float* og = p.out + (smp ? O_GS : O_GP);
#pragma unroll
        for (int d8 = 0; d8 < 8; ++d8)
#pragma unroll
            for (int jj = 0; jj < 4; ++jj) og[((size_t)(b * 4 + h) * 128 + d8 * 16 + q4 * 4 + jj) * 256 + e0 + et * 16 + r16] = Sacc[d8][jj];
    }
}

__device__ __forceinline__ void phase2a(const Params& p, LAS unsigned char* L) {
#ifndef NO_PREP
    {
        PrepRegs RA, RB; const int G = gridDim.x; int it = blockIdx.x;
        if (it < 2176) prep_load(p, it, RA);
        while (it < 2176) {
            int nx = it + G; gla_prep_item(p, L, it, RA, nx < 2176 ? nx : -1, RB); it = nx;
            if (it >= 2176) break;
            nx = it + G; gla_prep_item(p, L, it, RB, nx < 2176 ? nx : -1, RA); it = nx;
        }
    }
#endif
#ifndef NO_ATTN
    for (int it = gridDim.x - 1 - blockIdx.x; it < 2176; it += gridDim.x) attn_item(p, L, it, (bf16_t*)(p.ws + WS_GATE), 2048);
#endif
}
__device__ __forceinline__ void phase2b(const Params& p, LAS unsigned char* L) {
#ifndef NO_SCAN
#ifdef PROBE_SCAN2
    for (int it = blockIdx.x; it < 768; it += gridDim.x) gla_scan_item(p, L, it, true);
#endif
    if (gridDim.x == 256) {
        const int xcd = blockIdx.x & 7, loc = blockIdx.x >> 3;
        const int base = (xcd * 8 + (loc >> 2)) * 4 + (loc & 3);
        gla_scan_item(p, L, base, false); gla_scan_item(p, L, 256 + base, false); gla_scan_item(p, L, 512 + base, false);
    } else {
        for (int it = blockIdx.x; it < 768; it += gridDim.x) gla_scan_item(p, L, it, false);
    }
#endif
}

__device__ __forceinline__ void phase3(const Params& p) {
    unsigned char* ws = p.ws;
    const bf16_t* BV = (const bf16_t*)(ws + WS_BV); bf16_t* Yb = (bf16_t*)(ws + WS_GATE); const float* BOSQP = (const float*)((unsigned char*)p.out + SC_SQ);
    const float* gg = p.in[12];
    const long gtid = (long)blockIdx.x * NTHR + threadIdx.x, gsz = (long)gridDim.x * NTHR;
    const long total = (long)T * 128;
    for (long it = gtid; it < total; it += gsz) {
        const long row = it >> 7; const int c8 = (int)(it & 127) * 8, h = c8 >> 8;
        float sq;
        { const f32x4 s0 = *(const f32x4*)(BOSQP + row * 64 + h * 16), s1 = *(const f32x4*)(BOSQP + row * 64 + h * 16 + 4), s2 = *(const f32x4*)(BOSQP + row * 64 + h * 16 + 8), s3 = *(const f32x4*)(BOSQP + row * 64 + h * 16 + 12);
          sq = ((s0[0] + s0[1]) + (s0[2] + s0[3])) + ((s1[0] + s1[1]) + (s1[2] + s1[3])) + ((s2[0] + s2[1]) + (s2[2] + s2[3])) + ((s3[0] + s3[1]) + (s3[2] + s3[3])); }
        const float rs = rsqrtf(sq * (1.f / 256.f) + EPS);
        const u32x4 bo = *(const u32x4*)(BV + row * 1024 + c8);
        const u32x4 gt = *(const u32x4*)(Yb + row * 2048 + 1024 + c8);
        const f32x4 g0 = *(const f32x4*)(gg + (c8 & 255)), g1 = *(const f32x4*)(gg + (c8 & 255) + 4);
        u32x4 o;
        o.x = cvt_pk_bf16(bflo(bo.x) * rs * g0[0] * siluf(bflo(gt.x)), bfhi(bo.x) * rs * g0[1] * siluf(bfhi(gt.x)));
        o.y = cvt_pk_bf16(bflo(bo.y) * rs * g0[2] * siluf(bflo(gt.y)), bfhi(bo.y) * rs * g0[3] * siluf(bfhi(gt.y)));
        o.z = cvt_pk_bf16(bflo(bo.z) * rs * g1[0] * siluf(bflo(gt.z)), bfhi(bo.z) * rs * g1[1] * siluf(bfhi(gt.z)));
        o.w = cvt_pk_bf16(bflo(bo.w) * rs * g1[2] * siluf(bflo(gt.w)), bfhi(bo.w) * rs * g1[3] * siluf(bfhi(gt.w)));
        *(u32x4*)(Yb + row * 2048 + 1024 + c8) = o;
    }
}

__device__ __forceinline__ void lru_item(const Params& p, LAS unsigned char* L, int item) {
    unsigned char* ws = p.ws;
    const int tid = threadIdx.x, lane = tid & 63, w = tid >> 6, r16 = lane & 15, q4 = lane >> 4;
    LAS bf16_t* Wl = (LAS bf16_t*)L;
    LAS bf16_t* U = (LAS bf16_t*)(L + 76800);
    LAS float* Aa = (LAS float*)(L + 102400);
    LAS float* Bb = (LAS float*)(L + 126976);
    LAS float* SP = (LAS float*)(L + 151552);
    LAS float* SH = (LAS float*)(L + 153088);
    LAS float* HC = (LAS float*)(L + 154624);
    LAS float* CW = (LAS float*)(L + 155392);
    const bool smp = item >= 256;
    const int i2 = smp ? item - 256 : item;
    const int b = i2 >> 4, nb = (i2 >> 1) & 7, hf = i2 & 1;
    const int nch = smp ? 1 : 32;
    const unsigned rbase = smp ? (unsigned)T_P + b * 64 : (unsigned)b * 2048;
    const bf16_t* Z2 = (const bf16_t*)(ws + WS_Z2); bf16_t* Y2 = (bf16_t*)(ws + WS_Y2);
    const bf16_t* WA = (const bf16_t*)(ws + WS_WA) + nb * 192 * 192; const bf16_t* WI = (const bf16_t*)(ws + WS_WI) + nb * 192 * 192;
    for (int idx = tid; idx < 192 * 24; idx += NTHR) {
        const int r = idx / 24, g8 = idx % 24;
        const bf16_t* src = (r < 96) ? WA + (size_t)(hf * 96 + r) * 192 + g8 * 8 : WI + (size_t)(hf * 96 + r - 96) * 192 + g8 * 8;
        *(LAS u32x4*)(Wl + r * 200 + g8 * 8) = *(const u32x4*)src;
    }
    const bool cthr = tid < 384;
    const int cgp = tid % 24, tq = (tid / 24) & 15;
    const int chc = nb * 192 + cgp * 8;
    for (int idx = tid; idx < 5 * 192; idx += NTHR) { const int j = idx / 192, cc = idx % 192; CW[idx] = (j < 4) ? p.in[16][j * 1536 + nb * 192 + cc] : p.in[17][nb * 192 + cc]; }
    const int mt = w & 3, pg = w >> 2;
    float bra[3], bri[3], sp[3], spl[3];
#pragma unroll
    for (int cp = 0; cp < 3; ++cp) {
        const int ch = nb * 192 + hf * 96 + (pg * 3 + cp) * 16 + r16;
        bra[cp] = p.in[19][ch] * 1.4426950408889634f; bri[cp] = p.in[21][ch] * 1.4426950408889634f;
        const float lam = p.in[22][ch];
        sp[cp] = 16.f * (fmaxf(-lam, 0.f) + log1pf(__expf(-fabsf(lam))));
        spl[cp] = sp[cp] * (0.5f * 1.4426950408889634f);
    }
    if (tid < 96) HC[tid] = smp ? p.in[6][b * 1536 + nb * 192 + hf * 96 + tid] : 0.f;
    const int sch0 = tid % 96, sseg0 = (tid / 96) & 3;
    const int ot0 = tid / 12, og0 = tid % 12, ot1 = (tid + 512) / 12, og1 = (tid + 512) % 12;
    const bool o1 = tid < 256;
    const int och0 = nb * 192 + hf * 96 + og0 * 8, och1 = nb * 192 + hf * 96 + og1 * 8;
    lds_barrier();
    u32x4 xr[7]; u32x4 pg0, pg1 = {0u, 0u, 0u, 0u};
#pragma unroll
    for (int r = 0; r < 7; ++r) {
        xr[r] = (u32x4){0u, 0u, 0u, 0u};
        const int pos = 4 * tq - 3 + r;
        if (cthr) {
            if (pos >= 0) xr[r] = *(const u32x4*)(Z2 + (unsigned)((rbase + pos) * 3072u + chc));
            else if (smp) {
                const float* hp = p.in[5] + ((size_t)b * 3 + (3 + pos)) * 1536 + chc;
                const f32x4 h0 = *(const f32x4*)hp, h1 = *(const f32x4*)(hp + 4);
                xr[r].x = cvt_pk_bf16(h0[0], h0[1]); xr[r].y = cvt_pk_bf16(h0[2], h0[3]); xr[r].z = cvt_pk_bf16(h1[0], h1[1]); xr[r].w = cvt_pk_bf16(h1[2], h1[3]);
            }
        }
    }
    pg0 = *(const u32x4*)(Z2 + (unsigned)((rbase + ot0) * 3072u + 1536 + och0));
    if (o1) pg1 = *(const u32x4*)(Z2 + (unsigned)((rbase + ot1) * 3072u + 1536 + och1));
    u32x4 so0 = {0u, 0u, 0u, 0u}, so1 = {0u, 0u, 0u, 0u}; unsigned sr = 0; bool spend = false;
    for (int ci = 0; ci < nch; ++ci) {
        const unsigned r0 = rbase + (unsigned)ci * 64;
        const bool more = (ci + 1 < nch);
        int sch = sch0, sseg = sseg0;
        asm volatile("" : "+v"(sch), "+v"(sseg));
        if (cthr) {
            float xv[7][8];
#pragma unroll
            for (int r = 0; r < 7; ++r) unpack8(xr[r], xv[r]);
            if (hf == 0 && !more && tq == 15) {
                float* oc = p.out + (smp ? O_CS : O_CP) + (size_t)b * 3 * 1536 + chc;
#pragma unroll
                for (int r = 0; r < 3; ++r) { *(f32x4*)(oc + r * 1536) = (f32x4){xv[4 + r][0], xv[4 + r][1], xv[4 + r][2], xv[4 + r][3]}; *(f32x4*)(oc + r * 1536 + 4) = (f32x4){xv[4 + r][4], xv[4 + r][5], xv[4 + r][6], xv[4 + r][7]}; }
            }
            float cw[5][8];
#pragma unroll
            for (int j = 0; j < 5; ++j) { const f32x4 c0 = *(const LAS f32x4*)(CW + j * 192 + cgp * 8), c1 = *(const LAS f32x4*)(CW + j * 192 + cgp * 8 + 4);
                cw[j][0] = c0[0]; cw[j][1] = c0[1]; cw[j][2] = c0[2]; cw[j][3] = c0[3]; cw[j][4] = c1[0]; cw[j][5] = c1[1]; cw[j][6] = c1[2]; cw[j][7] = c1[3]; }
#pragma unroll
            for (int tk = 0; tk < 4; ++tk) {
                float acc[8];
#pragma unroll
                for (int e = 0; e < 8; ++e) acc[e] = fmaf(xv[tk + 3][e], cw[3][e], fmaf(xv[tk + 2][e], cw[2][e], fmaf(xv[tk + 1][e], cw[1][e], fmaf(xv[tk][e], cw[0][e], cw[4][e]))));
                u32x4 uw; uw.x = cvt_pk_bf16(acc[0], acc[1]); uw.y = cvt_pk_bf16(acc[2], acc[3]); uw.z = cvt_pk_bf16(acc[4], acc[5]); uw.w = cvt_pk_bf16(acc[6], acc[7]);
                *(LAS u32x4*)(U + (4 * tq + tk) * 200 + cgp * 8) = uw;
            }
            if (more) {
#pragma unroll
                for (int r = 0; r < 7; ++r) xr[r] = *(const u32x4*)(Z2 + (unsigned)((r0 + 64 + 4 * tq - 3 + r) * 3072u + chc));
            }
        }
        lds_barrier();
        if (spend) { *(u32x4*)(Y2 + (unsigned)((sr + ot0) * 1536u + och0)) = so0; if (o1) *(u32x4*)(Y2 + (unsigned)((sr + ot1) * 1536u + och1)) = so1; }
        f32x4 ga[3], gi[3];
#pragma unroll
        for (int cp = 0; cp < 3; ++cp) { ga[cp] = (f32x4){0.f, 0.f, 0.f, 0.f}; gi[cp] = (f32x4){0.f, 0.f, 0.f, 0.f}; }
#pragma unroll 2
        for (int ks = 0; ks < 6; ++ks) {
            const bf16x8 uf = *(const LAS bf16x8*)(U + (mt * 16 + r16) * 200 + ks * 32 + q4 * 8);
#pragma unroll
            for (int cp = 0; cp < 3; ++cp) {
                const int ct = pg * 3 + cp;
                const bf16x8 wa = *(const LAS bf16x8*)(Wl + (ct * 16 + r16) * 200 + ks * 32 + q4 * 8), wi = *(const LAS bf16x8*)(Wl + (96 + ct * 16 + r16) * 200 + ks * 32 + q4 * 8);
                ga[cp] = MFMA16(uf, wa, ga[cp]); gi[cp] = MFMA16(uf, wi, gi[cp]);
            }
        }
#pragma unroll
        for (int cp = 0; cp < 3; ++cp) {
            const int cl = (pg * 3 + cp) * 16 + r16;
#pragma unroll
            for (int jj = 0; jj < 4; ++jj) {
                const int t = mt * 16 + q4 * 4 + jj;
                const float rg = rcpf_(1.f + __builtin_amdgcn_exp2f(-(ga[cp][jj] + bra[cp]))), ig = rcpf_(1.f + __builtin_amdgcn_exp2f(-(gi[cp][jj] + bri[cp])));
                const float a = __builtin_amdgcn_exp2f(-(rg * spl[cp]));
                const float z2 = rg * sp[cp];
                const float om = (z2 < 0.05f) ? z2 * (1.f - z2 * (0.5f - z2 * (0.16666667f - z2 * 0.041666668f))) : 1.f - a * a;
                const float uu = bf2f(U[t * 200 + hf * 96 + cl]);
                Aa[t * 96 + cl] = a; Bb[t * 96 + cl] = __builtin_amdgcn_sqrtf(om) * ig * uu;
            }
        }
        lds_barrier();
        if (cthr) {
            float P = 1.f, H = 0.f;
#pragma unroll
            for (int t = 0; t < 16; ++t) {
                const int ix = (sseg * 16 + t) * 96 + sch;
                const float a = Aa[ix]; H = a * H + Bb[ix]; P *= a; Aa[ix] = P; Bb[ix] = H;
            }
            SP[sseg * 96 + sch] = P; SH[sseg * 96 + sch] = H;
        }
        lds_barrier();
        if (tid < 96) {
            float cc = HC[(ci & 1) * 96 + tid];
            const float p0 = SP[tid], p1 = SP[96 + tid], p2 = SP[192 + tid], p3 = SP[288 + tid];
            const float h0 = SH[tid], h1 = SH[96 + tid], h2 = SH[192 + tid], h3 = SH[288 + tid];
            SP[tid] = cc; cc = p0 * cc + h0; SP[96 + tid] = cc; cc = p1 * cc + h1; SP[192 + tid] = cc; cc = p2 * cc + h2; SP[288 + tid] = cc; cc = p3 * cc + h3;
            HC[((ci + 1) & 1) * 96 + tid] = cc;
        }
        lds_barrier();
        {
            const int ix = ot0 * 96 + og0 * 8, cx = (ot0 >> 4) * 96 + og0 * 8;
            f32x4 h0 = *(const LAS f32x4*)(Bb + ix), h1 = *(const LAS f32x4*)(Bb + ix + 4);
            h0 += *(const LAS f32x4*)(Aa + ix) * *(const LAS f32x4*)(SP + cx); h1 += *(const LAS f32x4*)(Aa + ix + 4) * *(const LAS f32x4*)(SP + cx + 4);
            u32x4 o;
            o.x = cvt_pk_bf16(h0[0] * siluf(bflo(pg0.x)), h0[1] * siluf(bfhi(pg0.x)));
            o.y = cvt_pk_bf16(h0[2] * siluf(bflo(pg0.y)), h0[3] * siluf(bfhi(pg0.y)));
            o.z = cvt_pk_bf16(h1[0] * siluf(bflo(pg0.z)), h1[1] * siluf(bfhi(pg0.z)));
            o.w = cvt_pk_bf16(h1[2] * siluf(bflo(pg0.w)), h1[3] * siluf(bfhi(pg0.w)));
            so0 = o;
            if (more) pg0 = *(const u32x4*)(Z2 + (unsigned)((r0 + 64 + ot0) * 3072u + 1536 + och0));
        }
        if (o1) {
            const int ix = ot1 * 96 + og1 * 8, cx = (ot1 >> 4) * 96 + og1 * 8;
            f32x4 h0 = *(const LAS f32x4*)(Bb + ix), h1 = *(const LAS f32x4*)(Bb + ix + 4);
            h0 += *(const LAS f32x4*)(Aa + ix) * *(const LAS f32x4*)(SP + cx); h1 += *(const LAS f32x4*)(Aa + ix + 4) * *(const LAS f32x4*)(SP + cx + 4);
            u32x4 o;
            o.x = cvt_pk_bf16(h0[0] * siluf(bflo(pg1.x)), h0[1] * siluf(bfhi(pg1.x)));
            o.y = cvt_pk_bf16(h0[2] * siluf(bflo(pg1.y)), h0[3] * siluf(bfhi(pg1.y)));
            o.z = cvt_pk_bf16(h1[0] * siluf(bflo(pg1.z)), h1[1] * siluf(bfhi(pg1.z)));
            o.w = cvt_pk_bf16(h1[2] * siluf(bflo(pg1.w)), h1[3] * siluf(bfhi(pg1.w)));
            so1 = o;
            if (more) pg1 = *(const u32x4*)(Z2 + (unsigned)((r0 + 64 + ot1) * 3072u + 1536 + och1));
        }
        sr = r0; spend = true;
        lds_barrier();
    }
    if (spend) { *(u32x4*)(Y2 + (unsigned)((sr + ot0) * 1536u + och0)) = so0; if (o1) *(u32x4*)(Y2 + (unsigned)((sr + ot1) * 1536u + och1)) = so1; }
    if (tid < 96) p.out[(smp ? O_LS : O_LP) + (size_t)b * 1536 + nb * 192 + hf * 96 + tid] = HC[(nch & 1) * 96 + tid];
    lds_barrier();
}

__device__ __forceinline__ void phase6(const Params& p, LAS unsigned char* L) {
    if (gridDim.x == 256) {
        const int xcd = blockIdx.x & 7, loc = blockIdx.x >> 3;
        const int pair = xcd * 16 + (loc >> 1), hf = loc & 1;
        lru_item(p, L, pair * 2 + hf); lru_item(p, L, 256 + pair * 2 + hf); lru_item(p, L, 512 + pair * 2 + hf);
    } else {
        for (int it = blockIdx.x; it < 768; it += gridDim.x) lru_item(p, L, it);
    }
}

__device__ __forceinline__ void phase8(const Params& p) {
    const float* rsq = (const float*)(p.ws + WS_RSQ2); const float* g = p.in[24]; float* y = p.out; const bf16_t* xb = (const bf16_t*)(p.ws + WS_XB);
    const long gtid = (long)blockIdx.x * NTHR + threadIdx.x, gsz = (long)gridDim.x * NTHR;
    const long total = (long)T * 128;
    for (long it = gtid; it < total; it += gsz) {
        const long row = it >> 7; const int c8 = (int)(it & 127) * 8;
        const float rs = rsqrtf(rsq[row] * (1.f / 1024.f) + EPS);
        const u32x4 xw = *(const u32x4*)(xb + row * 1024 + c8);
        const f32x4 g0 = *(const f32x4*)(g + c8), g1 = *(const f32x4*)(g + c8 + 4);
        f32x4 o0, o1;
        o0[0] = bflo(xw.x) * rs * g0[0]; o0[1] = bfhi(xw.x) * rs * g0[1]; o0[2] = bflo(xw.y) * rs * g0[2]; o0[3] = bfhi(xw.y) * rs * g0[3];
        o1[0] = bflo(xw.z) * rs * g1[0]; o1[1] = bfhi(xw.z) * rs * g1[1]; o1[2] = bflo(xw.w) * rs * g1[2]; o1[3] = bfhi(xw.w) * rs * g1[3];
        *(f32x4*)(y + row * 1024 + c8) = o0; *(f32x4*)(y + row * 1024 + c8 + 4) = o1;
    }
}

#define XB_TMO      128
#define XB_XCNT(j)  (256  + 64 * (j))
#define XB_XSUB(j)  (1280 + 64 * (j))
#define XB_XGEN(j)  (2304 + 64 * (j))
#define XB_TOP      3328
#define XB_TOPGEN   3392
#define XCD_BAR_WORDS 3456
#define XB_SPIN_CAP (1u << 18)
__device__ __forceinline__ unsigned xb_ld(unsigned* p)              { return __hip_atomic_load(p, __ATOMIC_RELAXED, __HIP_MEMORY_SCOPE_AGENT); }
__device__ __forceinline__ unsigned xb_add(unsigned* p, unsigned v) { return __hip_atomic_fetch_add(p, v, __ATOMIC_RELAXED, __HIP_MEMORY_SCOPE_AGENT); }
__device__ __forceinline__ unsigned xb_xcc_id() { return (unsigned)__builtin_amdgcn_s_getreg((3 << 11) | 20) & 0xFu; }
#define XB_SPIN(cond, bar) do { unsigned _sp = 0; while (cond) { __builtin_amdgcn_s_sleep(1); \
    if ((++_sp & 255u) == 0u) { if (xb_ld(&(bar)[XB_TMO])) break; if (_sp > XB_SPIN_CAP) { atomicAdd(&(bar)[XB_TMO], 1u); break; } } } } while (0)
struct XcdBarrier { unsigned* bar; unsigned x; volatile LAS unsigned* st; };
__device__ __forceinline__ XcdBarrier xcd_barrier_post(unsigned* bar, volatile LAS unsigned* st) {
    XcdBarrier b; b.bar = bar; b.x = xb_xcc_id(); b.st = st;
    if (threadIdx.x == 0) (void)xb_add(&bar[XB_XCNT(b.x)], 1u);
    return b;
}
__device__ __forceinline__ void xcd_barrier_complete(unsigned* bar, unsigned x, unsigned& nloc, unsigned& nx) {
    const unsigned G = gridDim.x * gridDim.y * gridDim.z;
    unsigned sum, cnt, mine, sp = 0u;
    for (;;) {
        sum = 0u; cnt = 0u; mine = 0u;
#pragma unroll
        for (unsigned j = 0; j < 16; ++j) { const unsigned c = xb_ld(&bar[XB_XCNT(j)]); sum += c; cnt += (c > 0u) ? 1u : 0u; mine = (j == x) ? c : mine; }
        if (sum == G) break;
        __builtin_amdgcn_s_sleep(1);
        if ((++sp & 255u) == 0u) { if (xb_ld(&bar[XB_TMO])) break; if (sp > XB_SPIN_CAP) { atomicAdd(&bar[XB_TMO], 1u); break; } }
    }
    nloc = mine > 0u ? mine : 1u; nx = cnt > 0u ? cnt : 1u;
}
__device__ __forceinline__ void xcd_barrier(const XcdBarrier& b) {
    asm volatile("s_waitcnt vmcnt(0)" ::: "memory");
    __syncthreads();
    if (threadIdx.x == 0) {
        unsigned* bar = b.bar;
        __builtin_amdgcn_s_waitcnt(0);
        unsigned nloc = b.st[0], nx = b.st[1];
        if (nloc == 0u) { xcd_barrier_complete(bar, b.x, nloc, nx); b.st[0] = nloc; b.st[1] = nx; }
        const unsigned old = xb_add(&bar[XB_XSUB(b.x)], 1u);
        const unsigned gen = old / nloc;
        if (old + 1u == (gen + 1u) * nloc) {
            __builtin_amdgcn_fence(__ATOMIC_RELEASE, "agent");
            asm volatile("s_waitcnt vmcnt(0)" ::: "memory");
            const unsigned og = xb_add(&bar[XB_TOP], 1u);
            const unsigned tg = og / nx;
            if (og + 1u == (tg + 1u) * nx) xb_add(&bar[XB_TOPGEN], 1u);
            else XB_SPIN(xb_ld(&bar[XB_TOPGEN]) == tg, bar);
            __builtin_amdgcn_fence(__ATOMIC_ACQUIRE, "agent");
            xb_add(&bar[XB_XGEN(b.x)], 1u);
            asm volatile("s_waitcnt vmcnt(0)" ::: "memory");
        } else {
            XB_SPIN(xb_ld(&bar[XB_XGEN(b.x)]) == gen, bar);
            __builtin_amdgcn_fence(__ATOMIC_ACQUIRE, "agent");
            asm volatile("s_waitcnt vmcnt(0)" ::: "memory");
        }
    }
    __syncthreads();
}

__global__ void __launch_bounds__(NTHR) mega(Params p) {
    extern __shared__ __attribute__((aligned(16))) unsigned char lds_raw[];
    LAS unsigned char* L = (LAS unsigned char*)lds_raw;
    cg::grid_group grid = cg::this_grid();
    unsigned char* ws = p.ws;
    const int lo = p.ph_lo, hi = p.ph_hi;
    LAS unsigned* stw = (LAS unsigned*)(L + (LDS_BYTES - 16));
    if (threadIdx.x < 4) stw[threadIdx.x] = 0u;
    __syncthreads();
    const XcdBarrier xb = xcd_barrier_post((unsigned*)(ws + WS_BAR), (volatile LAS unsigned*)stw);
#ifndef PHMASK
#define PHMASK 0x1ff
#endif
#define IN(k) (((PHMASK >> (k)) & 1) && lo <= (k) && (k) < hi)
#define SEAM(k) do { if (IN(k) && IN((k) + 1)) xcd_barrier(xb); } while (0)
    if (hi > 1000) grid.sync();
    if (IN(0)) phase0(p);
    SEAM(0);
    if (IN(1)) {
        pg8::Gemm g{(const bf16_t*)(ws + WS_XB), (const bf16_t*)(ws + WS_WINE), T, NE_PAD, 1024, 1024};
        pg8::StaticOrder S; S.init(T, NE_PAD, gridDim.x, blockIdx.x);
        EpiInEven E{ws, p.out, (const float*)(ws + WS_RSTD0), p.in[10]};
        pg8::gemm_phase<EpiInEven, pg8::StaticOrder>(L, g, S, E);
    }
    SEAM(1);
    if (IN(2)) { phase2a(p, L); xcd_barrier(xb); phase2b(p, L); }
    SEAM(2);
    if (IN(3)) phase3(p);
    SEAM(3);
    if (IN(4)) {
        const bool split = (gridDim.x == 256);
        pg8::Gemm g{(const bf16_t*)(ws + WS_GATE), (const bf16_t*)(ws + WS_WOUTE), T, 1024, 2048, 2048};
        pg8::StaticOrder S; S.init(T, 1024, gridDim.x, blockIdx.x, split ? 512 : -1);
        EpiOutResB E{(bf16_t*)(ws + WS_XB), (float*)(ws + WS_RSQ1)};
        pg8::gemm_phase<EpiOutResB, pg8::StaticOrder>(L, g, S, E);
        if (split) {
            pg8::Gemm gs{(const bf16_t*)(ws + WS_GATE), (const bf16_t*)(ws + WS_WOUTE), T, 1024, 256, 2048};
            pg8::SliceOrder SS{S, 512, 8, 512u};
            EpiPartial EP{(float*)(ws + WS_Q)};
            pg8::gemm_phase<EpiPartial, pg8::SliceOrder>(L, gs, SS, EP);
            xcd_barrier(xb);
            splitk_reduce(S, 512, 8, (const float*)(ws + WS_Q), (bf16_t*)(ws + WS_XB), (float*)(ws + WS_RSQ1));
        }
    }
    SEAM(4);
    if (IN(5)) {
        pg8::Gemm g{(const bf16_t*)(ws + WS_XB), (const bf16_t*)(ws + WS_WINO), T, 3072, 1024, 1024};
        pg8::StaticOrder S; S.init(T, 3072, gridDim.x, blockIdx.x);
        EpiInOdd E{(bf16_t*)(ws + WS_Z2), (const float*)(ws + WS_RSQ1)};
        pg8::gemm_phase<EpiInOdd, pg8::StaticOrder>(L, g, S, E);
    }
    SEAM(5);
    if (IN(6)) phase6(p, L);
    SEAM(6);
    if (IN(7)) {
        const bool split = (gridDim.x == 256);
        pg8::Gemm g{(const bf16_t*)(ws + WS_Y2), (const bf16_t*)(ws + WS_WOUTO), T, 1024, 1536, 1536};
        pg8::StaticOrder S; S.init(T, 1024, gridDim.x, blockIdx.x, split ? 512 : -1);
        EpiOutResB E{(bf16_t*)(ws + WS_XB), (float*)(ws + WS_RSQ2)};
        pg8::gemm_phase<EpiOutResB, pg8::StaticOrder>(L, g, S, E);
        if (split) {
            pg8::Gemm gs{(const bf16_t*)(ws + WS_Y2), (const bf16_t*)(ws + WS_WOUTO), T, 1024, 256, 1536};
            pg8::SliceOrder SS{S, 512, 6, 512u};
            EpiPartial EP{(float*)(ws + WS_Q)};
            pg8::gemm_phase<EpiPartial, pg8::SliceOrder>(L, gs, SS, EP);
            xcd_barrier(xb);
            splitk_reduce(S, 512, 6, (const float*)(ws + WS_Q), (bf16_t*)(ws + WS_XB), (float*)(ws + WS_RSQ2));
        }
    }
    SEAM(7);
    if (IN(8)) phase8(p);
#undef IN
#undef SEAM
}

extern "C" void kernel_launch(void* const* d_in, const int* in_sizes, int n_in, void* d_out, int out_size, void* d_ws, size_t ws_size, hipStream_t stream) {
    static int grid_blocks = 0;
    if (grid_blocks == 0) {
        if (n_in != 25 || (size_t)out_size != O_END || ws_size < WS_TOTAL) { fprintf(stderr, "kernel_launch: unexpected shapes n_in %d out %d ws %zu (need %zu)\n", n_in, out_size, ws_size, (size_t)WS_END); grid_blocks = -1; return; }
        int dev = 0, cus = 0, per_cu = 0;
        (void)hipGetDevice(&dev);
        (void)hipDeviceGetAttribute(&cus, hipDeviceAttributeMultiprocessorCount, dev);
        if (hipFuncSetAttribute((const void*)mega, hipFuncAttributeMaxDynamicSharedMemorySize, LDS_BYTES) != hipSuccess) { fprintf(stderr, "kernel_launch: hipFuncSetAttribute failed\n"); }
        if (hipOccupancyMaxActiveBlocksPerMultiprocessor(&per_cu, (const void*)mega, NTHR, LDS_BYTES) != hipSuccess || per_cu < 1) per_cu = 1;
        (void)hipGetLastError();
        grid_blocks = cus * per_cu;
        if (grid_blocks <= 0) grid_blocks = 256;
    }
    if (grid_blocks < 0) return;
    Params p{};
    for (int i = 0; i < 25; ++i) p.in[i] = (const float*)d_in[i];
    p.out = (float*)d_out; p.ws = (unsigned char*)d_ws;
#if ONE_LAUNCH
#ifdef PROBE_X
    { const int seq[3][2] = {{0, PROBE_Y + 1}, {PROBE_X, PROBE_Y + 1}, {PROBE_Y + 1, 9}};
      for (int li = 0; li < 3; ++li) { if (seq[li][0] >= seq[li][1]) continue; p.ph_lo = seq[li][0]; p.ph_hi = seq[li][1]; void* args[] = {&p};
        (void)hipMemsetAsync((char*)d_ws + WS_BAR, 0, 16384, stream);
        hipError_t e = hipLaunchCooperativeKernel((const void*)mega, dim3(grid_blocks), dim3(NTHR), args, LDS_BYTES, stream);
        if (e != hipSuccess) fprintf(stderr, "cooperative launch failed: %s (grid %d)\n", hipGetErrorString(e), grid_blocks); } }
#else
    p.ph_lo = 0; p.ph_hi = 9;
    (void)hipMemsetAsync((char*)d_ws + WS_BAR, 0, 16384, stream);
    { void* args[] = {&p}; hipError_t e = hipLaunchCooperativeKernel((const void*)mega, dim3(grid_blocks), dim3(NTHR), args, LDS_BYTES, stream);
      if (e != hipSuccess) fprintf(stderr, "cooperative launch failed: %s (grid %d)\n", hipGetErrorString(e), grid_blocks); }
#endif
#else
    for (int ph = 0; ph < 9; ++ph) {
        p.ph_lo = ph; p.ph_hi = ph + 1;
        (void)hipMemsetAsync((char*)d_ws + WS_BAR, 0, 16384, stream);
        void* args[] = {&p}; hipError_t e = hipLaunchCooperativeKernel((const void*)mega, dim3(grid_blocks), dim3(NTHR), args, LDS_BYTES, stream);
        if (e != hipSuccess) fprintf(stderr, "cooperative launch %d failed: %s (grid %d)\n", ph, hipGetErrorString(e), grid_blocks);
    }
#endif
}
```
